# Optimizing an MI355X kernel written in HIP

```python
import math, functools
import jax, jax.numpy as jnp
from jax import lax
import numpy as np

D_MODEL = 1024
BATCH = 4
SEQ = 4096
DEPTH = 1
DEC_BATCH = 32
DEC_SEQ = 1
PAST_LEN = 8192
PAGE_SIZE = 128

A_HEADS = 4
A_HEAD_DIM = 64
A_QK_DIM = 2 * A_HEAD_DIM
A_V_DIM = 2 * A_HEAD_DIM
A_WIDTH = A_HEADS * A_V_DIM
R_HEAD = 64
R_HEADS = 8
R_WIDTH = R_HEADS * R_HEAD
R_LORA_W = 64
R_LORA_A = 64
R_LORA_G = 128
R_SHIFT_W = 3 * R_WIDTH + R_LORA_W + R_LORA_A + R_LORA_G
D_FF = -(-8 * D_MODEL // (3 * 256)) * 256
OFF_Q = 0
OFF_K = OFF_Q + A_HEADS * A_QK_DIM
OFF_V = OFF_K + A_HEADS * A_QK_DIM
OFF_R = OFF_V + A_WIDTH
OFF_G = OFF_R + R_SHIFT_W
IN_WIDTH = OFF_G + 2 * D_MODEL
Q_BLOCK = 128
NORM_EPS = 1e-6
GN_EPS = 64e-5

kernel_name = "griffin_diffattn_rwkv7_swiglu_step"


def _rms_norm(x, g, eps=NORM_EPS):
    xf = x.astype(jnp.float32)
    y = xf * lax.rsqrt(jnp.mean(xf * xf, axis=-1, keepdims=True) + eps)
    return (y * g.astype(jnp.float32)).astype(x.dtype)


def _alibi_slopes():
    return jnp.exp2(-8.0 * jnp.arange(1, A_HEADS + 1, dtype=jnp.float32) / A_HEADS)


def _diff_attn_core(q, k, v, q_pos, k_pos, lam):
    s = jnp.einsum("bqhcd,bkhcd->bhcqk", q, k, preferred_element_type=jnp.float32) * (A_HEAD_DIM ** -0.5)
    dist = q_pos[:, None] - k_pos[None, :]
    bias = -_alibi_slopes()[:, None, None] * dist.astype(jnp.float32)
    s = jnp.where(dist >= 0, s + bias[None, :, None], -jnp.inf)
    p = jax.nn.softmax(s, axis=-1)
    pd = p[:, :, 0] - lam * p[:, :, 1]
    return jnp.einsum("bhqk,bkhd->bqhd", pd.astype(v.dtype), v)


def _prompt_attend(q, k, v, lam):
    b, s = q.shape[:2]
    nb = s // Q_BLOCK
    qb = jnp.moveaxis(q.reshape(b, nb, Q_BLOCK, A_HEADS, 2, A_HEAD_DIM), 1, 0)
    k_pos = jnp.arange(s)

    def one_block(args):
        q_blk, i = args
        q_pos = i * Q_BLOCK + jnp.arange(Q_BLOCK)
        return _diff_attn_core(q_blk, k, v, q_pos, k_pos, lam)

    o = lax.map(one_block, (qb, jnp.arange(nb)))
    return jnp.moveaxis(o, 0, 1).reshape(b, s, A_HEADS, A_V_DIM)


def _sample_attend(q, k, v, lam, pool_k, pool_v, page_table):
    db, t = q.shape[:2]
    past = page_table.shape[1] * PAGE_SIZE
    past_k = pool_k[page_table].reshape(db, past, A_HEADS, 2, A_HEAD_DIM)
    past_v = pool_v[page_table].reshape(db, past, A_HEADS, A_V_DIM)
    k_all = jnp.concatenate([past_k.astype(k.dtype), k], axis=1)
    v_all = jnp.concatenate([past_v.astype(v.dtype), v], axis=1)
    q_pos = past + jnp.arange(t)
    k_pos = jnp.arange(past + t)
    return _diff_attn_core(q, k_all, v_all, q_pos, k_pos, lam)


def _rwkv7(p_cols, shift_prev, wkv0, p):
    b, t, _ = p_cols.shape
    f32 = jnp.float32
    prev = jnp.concatenate([shift_prev[:, None].astype(p_cols.dtype), p_cols[:, :-1]], axis=1)
    m = (p_cols + (prev - p_cols) * p["shift_mu"].astype(p_cols.dtype)).astype(f32)
    r, k, v, xw, xa, xg = jnp.split(
        m, [R_WIDTH, 2 * R_WIDTH, 3 * R_WIDTH, 3 * R_WIDTH + R_LORA_W,
            3 * R_WIDTH + R_LORA_W + R_LORA_A], axis=-1)
    w_raw = -jax.nn.softplus(-(p["w0"].astype(f32) + jnp.tanh(xw) @ p["w2"].astype(f32))) - 0.5
    decay = jnp.exp(-jnp.exp(w_raw))
    a = jax.nn.sigmoid(p["a0"].astype(f32) + xa @ p["a2"].astype(f32))
    g = jax.nn.sigmoid(xg) @ p["g2"].astype(f32)

    def hs(z):
        return z.reshape(b, t, R_HEADS, R_HEAD)

    kk = hs(k * p["k_k"].astype(f32))
    kk = kk * lax.rsqrt(jnp.maximum(jnp.sum(kk * kk, axis=-1, keepdims=True), 1e-24))
    k = k * (1.0 + (a - 1.0) * p["k_a"].astype(f32))
    r, decay, k, v, a = hs(r), hs(decay), hs(k), hs(v), hs(a)

    def step(S, inp):
        r_t, w_t, k_t, v_t, kk_t, a_t = inp
        sa = jnp.einsum("bhij,bhj->bhi", S, -kk_t)
        S = (S * w_t[:, :, None, :] + sa[..., None] * (kk_t * a_t)[:, :, None, :]
             + v_t[..., None] * k_t[:, :, None, :])
        return S, jnp.einsum("bhij,bhj->bhi", S, r_t)

    seq = tuple(jnp.moveaxis(z, 1, 0) for z in (r, decay, k, v, kk, a))
    S_fin, y = lax.scan(step, wkv0.astype(f32), seq)
    y = jnp.moveaxis(y, 0, 1)
    mu = jnp.mean(y, axis=-1, keepdims=True)
    var = jnp.mean(jnp.square(y - mu), axis=-1, keepdims=True)
    yn = ((y - mu) * lax.rsqrt(var + GN_EPS) * p["gn_w"].astype(f32).reshape(R_HEADS, R_HEAD)
          + p["gn_b"].astype(f32).reshape(R_HEADS, R_HEAD))
    bonus = jnp.sum(r * k * p["r_k"].astype(f32), axis=-1, keepdims=True) * v
    out = ((yn + bonus).reshape(b, t, R_WIDTH) * g).astype(p_cols.dtype) @ p["w_pb"]
    return out, S_fin.astype(wkv0.dtype), p_cols[:, -1].astype(shift_prev.dtype)


def _layer(x, shift_prev, wkv0, attend, l, p):
    b, t, _ = x.shape
    lambda_init = 0.8 - 0.6 * math.exp(-0.3 * l)
    h = _rms_norm(x, p["norm_mix"])
    proj = h @ p["w_in"]
    q = _rms_norm(proj[..., OFF_Q:OFF_K].reshape(b, t, A_HEADS, 2, A_HEAD_DIM), p["q_gain"])
    k = _rms_norm(proj[..., OFF_K:OFF_V].reshape(b, t, A_HEADS, 2, A_HEAD_DIM), p["k_gain"])
    v = proj[..., OFF_V:OFF_R].reshape(b, t, A_HEADS, A_V_DIM)
    f32 = jnp.float32
    lam = (jnp.exp(jnp.sum(p["lambda_q1"].astype(f32) * p["lambda_k1"].astype(f32)))
           - jnp.exp(jnp.sum(p["lambda_q2"].astype(f32) * p["lambda_k2"].astype(f32)))
           + lambda_init)
    o = attend(q, k, v, lam)
    o = _rms_norm(o, p["attn_out_gain"]) * (1.0 - lambda_init)
    y_a = o.reshape(b, t, A_WIDTH).astype(x.dtype) @ p["w_pa"]
    y_b, wkv_new, shift_new = _rwkv7(proj[..., OFF_R:OFF_G], shift_prev, wkv0, p)
    gates = jax.nn.sigmoid(proj[..., OFF_G:].astype(f32))
    merged = (gates[..., :D_MODEL] * y_a.astype(f32) + gates[..., D_MODEL:] * y_b.astype(f32)).astype(x.dtype)
    x = x + merged @ p["w_out"]
    hf = _rms_norm(x, p["norm_ffn"])
    x = x + (jax.nn.silu(hf @ p["w_gate"]) * (hf @ p["w_up"])) @ p["w_down"]
    return x, k.reshape(b, t, A_HEADS, A_QK_DIM), v, wkv_new, shift_new


def setup_inputs(seed: int = 0) -> dict:
    key = jax.random.key(seed)
    ks = iter(jax.random.split(key, 48))
    f32 = jnp.float32

    def nrm(shape, scale):
        return jax.random.normal(next(ks), shape, f32) * scale

    def gain(shape):
        return 1.0 + nrm(shape, 0.02)

    n_pages = PAST_LEN // PAGE_SIZE
    n_pool = -(-5 * DEC_BATCH * n_pages // 4)
    d = {}
    d["x_prompt"] = nrm((BATCH, SEQ, D_MODEL), 1.0)
    d["x_sample"] = nrm((DEC_BATCH, DEC_SEQ, D_MODEL), 1.0)
    d["cache_k"] = nrm((DEPTH, n_pool, PAGE_SIZE, A_HEADS, A_QK_DIM), 1.0)
    d["cache_v"] = nrm((DEPTH, n_pool, PAGE_SIZE, A_HEADS, A_V_DIM), 1.0)
    d["page_table"] = jax.random.permutation(next(ks), n_pool)[:DEC_BATCH * n_pages].reshape(
        DEC_BATCH, n_pages).astype(jnp.int32)
    d["state_wkv"] = nrm((DEPTH, DEC_BATCH, R_HEADS, R_HEAD, R_HEAD), 0.5)
    d["state_shift"] = nrm((DEPTH, DEC_BATCH, R_SHIFT_W), 1.0)
    d["norm_mix"] = gain((DEPTH, D_MODEL))
    d["w_in"] = nrm((DEPTH, D_MODEL, IN_WIDTH), D_MODEL ** -0.5)
    d["q_gain"] = gain((DEPTH, A_HEAD_DIM))
    d["k_gain"] = gain((DEPTH, A_HEAD_DIM))
    d["lambda_q1"] = nrm((DEPTH, A_HEAD_DIM), 0.1)
    d["lambda_k1"] = nrm((DEPTH, A_HEAD_DIM), 0.1)
    d["lambda_q2"] = nrm((DEPTH, A_HEAD_DIM), 0.1)
    d["lambda_k2"] = nrm((DEPTH, A_HEAD_DIM), 0.1)
    d["attn_out_gain"] = gain((DEPTH, A_V_DIM))
    d["w_pa"] = nrm((DEPTH, A_WIDTH, D_MODEL), A_WIDTH ** -0.5)
    d["shift_mu"] = jax.random.uniform(next(ks), (DEPTH, R_SHIFT_W), f32)
    d["w0"] = jax.random.uniform(next(ks), (DEPTH, R_WIDTH), f32, -5.0, 1.0)
    d["w2"] = nrm((DEPTH, R_LORA_W, R_WIDTH), 0.5 * R_LORA_W ** -0.5)
    d["a0"] = nrm((DEPTH, R_WIDTH), 0.1)
    d["a2"] = nrm((DEPTH, R_LORA_A, R_WIDTH), R_LORA_A ** -0.5)
    d["g2"] = nrm((DEPTH, R_LORA_G, R_WIDTH), R_LORA_G ** -0.5)
    d["k_k"] = 0.85 + nrm((DEPTH, R_WIDTH), 0.02)
    d["k_a"] = gain((DEPTH, R_WIDTH))
    d["r_k"] = nrm((DEPTH, R_HEADS, R_HEAD), 0.1)
    d["gn_w"] = gain((DEPTH, R_WIDTH))
    d["gn_b"] = nrm((DEPTH, R_WIDTH), 0.01)
    d["w_pb"] = nrm((DEPTH, R_WIDTH, D_MODEL), R_WIDTH ** -0.5)
    d["w_out"] = nrm((DEPTH, D_MODEL, D_MODEL), D_MODEL ** -0.5)
    d["norm_ffn"] = gain((DEPTH, D_MODEL))
    d["w_gate"] = nrm((DEPTH, D_MODEL, D_FF), D_MODEL ** -0.5)
    d["w_up"] = nrm((DEPTH, D_MODEL, D_FF), D_MODEL ** -0.5)
    d["w_down"] = nrm((DEPTH, D_FF, D_MODEL), D_FF ** -0.5)
    return d


def reference(x_prompt, x_sample, cache_k, cache_v, page_table, state_wkv, state_shift,
              norm_mix, w_in, q_gain, k_gain, lambda_q1, lambda_k1, lambda_q2, lambda_k2,
              attn_out_gain, w_pa, shift_mu, w0, w2, a0, a2, g2, k_k, k_a, r_k, gn_w, gn_b,
              w_pb, w_out, norm_ffn, w_gate, w_up, w_down):
    b = x_prompt.shape[0]
    xp, xs = x_prompt, x_sample
    kp_l, vp_l, wp_l, sp_l = [], [], [], []
    ks_l, vs_l, ws_l, ss_l = [], [], [], []
    for l in range(DEPTH):
        p = {"norm_mix": norm_mix[l], "w_in": w_in[l], "q_gain": q_gain[l], "k_gain": k_gain[l],
             "lambda_q1": lambda_q1[l], "lambda_k1": lambda_k1[l], "lambda_q2": lambda_q2[l],
             "lambda_k2": lambda_k2[l], "attn_out_gain": attn_out_gain[l], "w_pa": w_pa[l],
             "shift_mu": shift_mu[l], "w0": w0[l], "w2": w2[l], "a0": a0[l], "a2": a2[l],
             "g2": g2[l], "k_k": k_k[l], "k_a": k_a[l], "r_k": r_k[l], "gn_w": gn_w[l],
             "gn_b": gn_b[l], "w_pb": w_pb[l], "w_out": w_out[l], "norm_ffn": norm_ffn[l],
             "w_gate": w_gate[l], "w_up": w_up[l], "w_down": w_down[l]}
        shift0 = jnp.zeros((b, R_SHIFT_W), xp.dtype)
        wkv_init = jnp.zeros((b, R_HEADS, R_HEAD, R_HEAD), xp.dtype)
        xp, kp, vp, wp, sp = _layer(xp, shift0, wkv_init, _prompt_attend, l, p)
        attend_s = functools.partial(_sample_attend, pool_k=cache_k[l], pool_v=cache_v[l],
                                     page_table=page_table)
        xs, ks_, vs_, ws_, ss_ = _layer(xs, state_shift[l], state_wkv[l], attend_s, l, p)
        kp_l.append(kp); vp_l.append(vp); wp_l.append(wp); sp_l.append(sp)
        ks_l.append(ks_); vs_l.append(vs_); ws_l.append(ws_); ss_l.append(ss_)
    return (xp, xs, jnp.stack(kp_l), jnp.stack(vp_l), jnp.stack(wp_l), jnp.stack(sp_l),
            jnp.stack(ks_l), jnp.stack(vs_l), jnp.stack(ws_l), jnp.stack(ss_l))
```

```cpp
#include <hip/hip_runtime.h>
#include <cstdio>
#include <cstdint>

constexpr int MP = 16384, MS = 32, MVALID = MP + MS, MTOT = 16640;
constexpr int DM = 1024, INW = 5376, FF = 2816, NGU = 2 * FF, SEQ = 4096, NBATCH = 4, RSW = 1792;
constexpr int NPAGES = 64, PAGE = 128, PAST = 8192;
constexpr size_t O_YP = 0, O_YS = 16777216, O_KP = O_YS + 32768, O_VP = O_KP + 8388608, O_WP = O_VP + 8388608, O_SP = O_WP + 131072,
                 O_KS = O_SP + 7168, O_VS = O_KS + 16384, O_WS = O_VS + 16384, O_SS = O_WS + 1048576, O_END = O_SS + 57344;
constexpr float QK_C2 = 0.125f * 1.4426950408889634f;
namespace pg8 {
#define PG8_LAS __attribute__((address_space(3)))
typedef unsigned short bf16_t;
typedef short bf16x8 __attribute__((ext_vector_type(8)));
typedef float f32x4 __attribute__((ext_vector_type(4)));
typedef unsigned u32x4 __attribute__((ext_vector_type(4)));
constexpr int BM = 256, BK = 64, HALF = 128, HTB = HALF * BK * 2  , STAGE_BYTES = 8 * HTB, NXCD = 8, WGM = 8;

__host__ __device__ __forceinline__ int lds_byte(int r, int c) { const int st = (r >> 4) * 2 + (c >> 5), rr = r & 15, cc = c & 31, ob = rr * 64 + cc * 2; return st * 1024 + (ob ^ (((ob >> 9) & 1) << 5)); }
__host__ __device__ __forceinline__ void stage_rc(int b, int& R, int& C) { const int st = b / 1024, sb = b % 1024, swz = sb ^ (((sb >> 9) & 1) << 5); R = (st >> 1) * 16 + swz / 64; C = (st & 1) * 32 + (swz % 64) / 2; }
__host__ __device__ __forceinline__ int perm32(int rho) { const int n = rho >> 4, i = rho & 15; return 8 * (i >> 2) + 4 * n + (i & 3); }

struct Unit { int pm, pn, z; };
struct Gemm { const bf16_t* A; const bf16_t* Bt; const bf16_t* A2; const bf16_t* Bt2; int M, N, K; };

struct StaticOrder {
    int nM, nN, nwg, G, c;
    __host__ __device__ void init(int M, int N, int G_, int c_) { nM = M / BM; nN = N / BM; nwg = nM * nN; G = G_; c = c_; }
    __host__ __device__ bool next(int i, Unit& u) const {
        const long L = (long)i * G + c; if (L >= nwg) return false;
        int wgid = (int)L; { const int q = nwg / NXCD, r = nwg % NXCD, xcd = wgid % NXCD, off = wgid / NXCD; wgid = (xcd < r ? xcd * (q + 1) : r * (q + 1) + (xcd - r) * q) + off; }
        const int nig = WGM * nN, gid = wgid / nig, fm = gid * WGM, gsz = (nM - fm) < WGM ? (nM - fm) : WGM;
        u.pm = fm + ((wgid % nig) % gsz); u.pn = (wgid % nig) / gsz; u.z = 0; return true;
    }
    __device__ __forceinline__ void a_ready(const Unit&) const {}
    __device__ __forceinline__ void done(const Unit&) const {}
};

typedef float f32x2_cv __attribute__((ext_vector_type(2))); typedef __bf16 bf16x2_cv __attribute__((ext_vector_type(2)));
__device__ __forceinline__ unsigned cvt_pk_bf16(float lo, float hi) { const f32x2_cv v = {lo, hi}; const bf16x2_cv b = __builtin_convertvector(v, bf16x2_cv); return __builtin_bit_cast(unsigned, b); }
typedef float f32x2 __attribute__((ext_vector_type(2)));
__device__ __forceinline__ void st_bf16x8(bf16_t* p, const f32x4 a, const f32x4 b) {
    u32x4 w; w.x = cvt_pk_bf16(a[0], a[1]); w.y = cvt_pk_bf16(a[2], a[3]); w.z = cvt_pk_bf16(b[0], b[1]); w.w = cvt_pk_bf16(b[2], b[3]); *(u32x4*)p = w;
}
__device__ __forceinline__ float sigmoidf_(float x) { return __builtin_amdgcn_rcpf(1.f + __expf(-x)); }

struct EpiProj {
    static constexpr bool PERM = true, AFTER_DRAIN = false;
    const float* rs0; const float* qg; const float* kg;
    bf16_t *QB, *KB, *VB, *PC, *GT; float* out;
    __device__ __forceinline__ void operator()(const f32x4 (&acc)[2][2][4][2], const Unit& u, int wr, int wc, int fr, int fq) const {
        const int pn = u.pn, rb = u.pm * BM + wr * 64 + fr, c8 = 64 * wc + 8 * fq;
        if (pn < 4) {
            const bool isq = pn < 2; const float* gain = isq ? qg : kg;
            f32x4 gv[2][2];
#pragma unroll
            for (int bj = 0; bj < 2; ++bj)
#pragma unroll
                for (int n = 0; n < 2; ++n) gv[bj][n] = *(const f32x4*)(gain + 32 * bj + 8 * fq + 4 * n);
            const int colg = 256 * (pn & 1) + c8;
#pragma unroll
            for (int ai = 0; ai < 2; ++ai)
#pragma unroll
                for (int m = 0; m < 4; ++m) {
                    const int row = rb + ai * HALF + m * 16; const bool ok = row < MVALID; const float rs = rs0[ok ? row : 0];
                    float ss = 0.f;
#pragma unroll
                    for (int bj = 0; bj < 2; ++bj)
#pragma unroll
                        for (int n = 0; n < 2; ++n) { const f32x4 x = acc[ai][bj][m][n] * rs; ss += (x[0] * x[0] + x[1] * x[1]) + (x[2] * x[2] + x[3] * x[3]); }
                    ss += __shfl_xor(ss, 16); ss += __shfl_xor(ss, 32);
                    const float rn = rsqrtf(ss * (1.f / 64.f) + 1e-6f) * rs;
#pragma unroll
                    for (int bj = 0; bj < 2; ++bj) {
                        const f32x4 v0 = acc[ai][bj][m][0] * rn * gv[bj][0], v1 = acc[ai][bj][m][1] * rn * gv[bj][1];
                        const size_t o = (size_t)row * 512 + colg + 32 * bj;
                        if (ok) {
                            if (isq) st_bf16x8(QB + o, v0 * QK_C2, v1 * QK_C2);
                            else { st_bf16x8(KB + o, v0, v1);
                                float* f = row < MP ? out + O_KP + o : out + O_KS + (size_t)(row - MP) * 512 + colg + 32 * bj;
                                *(f32x4*)f = v0; *(f32x4*)(f + 4) = v1; }
                        }
                    }
                }
        } else {
#pragma unroll
            for (int ai = 0; ai < 2; ++ai)
#pragma unroll
                for (int m = 0; m < 4; ++m) {
                    const int row = rb + ai * HALF + m * 16; const bool ok = row < MVALID; const float rs = rs0[ok ? row : 0];
                    if (!ok) continue;
#pragma unroll
                    for (int bj = 0; bj < 2; ++bj) {
                        f32x4 v0 = acc[ai][bj][m][0] * rs, v1 = acc[ai][bj][m][1] * rs;
                        if (pn < 6) {
                            const size_t c = (size_t)(256 * (pn - 4) + c8 + 32 * bj), o = (size_t)row * 512 + c;
                            st_bf16x8(VB + o, v0, v1);
                            float* f = row < MP ? out + O_VP + o : out + O_VS + (size_t)(row - MP) * 512 + c;
                            *(f32x4*)f = v0; *(f32x4*)(f + 4) = v1;
                        } else if (pn < 13) {
                            const size_t c = (size_t)(256 * (pn - 6) + c8 + 32 * bj);
                            st_bf16x8(PC + (size_t)row * RSW + c, v0, v1);
                            if (row >= MP) { float* f = out + O_SS + (size_t)(row - MP) * RSW + c; *(f32x4*)f = v0; *(f32x4*)(f + 4) = v1; }
                            else if ((row & (SEQ - 1)) == SEQ - 1) { float* f = out + O_SP + (size_t)(row >> 12) * RSW + c; *(f32x4*)f = v0; *(f32x4*)(f + 4) = v1; }
                        } else {
                            const size_t c = (size_t)(256 * (pn - 13) + c8 + 32 * bj);
#ifndef MK_DBG_NOSIG
#pragma unroll
                            for (int j = 0; j < 4; ++j) { v0[j] = sigmoidf_(v0[j]); v1[j] = sigmoidf_(v1[j]); }
#endif
                            st_bf16x8(GT + (size_t)row * 2048 + c, v0, v1);
                        }
                    }
                }
        }
    }
};

struct EpiMerge {
    static constexpr bool PERM = true, AFTER_DRAIN = false;
    const bf16_t* GT; float* tmp; bf16_t* MG;
    __device__ __forceinline__ void operator()(const f32x4 (&acc)[2][2][4][2], const Unit& u, int wr, int wc, int fr, int fq) const {
        const int rb = u.pm * BM + wr * 64 + fr, cb = u.pn * BM + wc * 32 + 8 * fq;
        if (u.z) asm volatile("s_waitcnt vmcnt(0)" ::: "memory");
#pragma unroll
        for (int ai = 0; ai < 2; ++ai)
#pragma unroll
            for (int m = 0; m < 4; ++m) {
                const int row = rb + ai * HALF + m * 16;
#pragma unroll
                for (int bj = 0; bj < 2; ++bj) {
                    const int col = cb + bj * HALF;
                    const u32x4 gw = *(const u32x4*)(GT + (size_t)row * 2048 + (u.z ? 1024 : 0) + col);
                    f32x4 g0, g1;
                    g0[0] = __builtin_bit_cast(float, gw.x << 16); g0[1] = __builtin_bit_cast(float, gw.x & 0xffff0000u); g0[2] = __builtin_bit_cast(float, gw.y << 16); g0[3] = __builtin_bit_cast(float, gw.y & 0xffff0000u);
                    g1[0] = __builtin_bit_cast(float, gw.z << 16); g1[1] = __builtin_bit_cast(float, gw.z & 0xffff0000u); g1[2] = __builtin_bit_cast(float, gw.w << 16); g1[3] = __builtin_bit_cast(float, gw.w & 0xffff0000u);
                    f32x4 v0 = acc[ai][bj][m][0] * g0, v1 = acc[ai][bj][m][1] * g1;
                    float* t = tmp + (size_t)row * 1024 + col;
                    if (!u.z) { *(f32x4*)t = v0; *(f32x4*)(t + 4) = v1; }
                    else {
#ifndef MK_DBG_NOTMP
 v0 += *(const f32x4*)t; v1 += *(const f32x4*)(t + 4);
#endif
 st_bf16x8(MG + (size_t)row * 1024 + col, v0, v1); }
                }
            }
    }
};
struct EpiOut {
    static constexpr bool PERM = true, AFTER_DRAIN = false;
    const float* x; float* x1; bf16_t* X1B; float* ssq;
    __device__ __forceinline__ void operator()(const f32x4 (&acc)[2][2][4][2], const Unit& u, int wr, int wc, int fr, int fq) const {
        const int rb = u.pm * BM + wr * 64 + fr, cb = u.pn * BM + wc * 32 + 8 * fq;
#pragma unroll
        for (int ai = 0; ai < 2; ++ai)
#pragma unroll
            for (int m = 0; m < 4; ++m) {
                const int row = rb + ai * HALF + m * 16; float ss = 0.f;
#pragma unroll
                for (int bj = 0; bj < 2; ++bj) {
                    const size_t o = (size_t)row * 1024 + cb + bj * HALF;
                    const f32x4 v0 = acc[ai][bj][m][0] + *(const f32x4*)(x + o), v1 = acc[ai][bj][m][1] + *(const f32x4*)(x + o + 4);
                    *(f32x4*)(x1 + o) = v0; *(f32x4*)(x1 + o + 4) = v1; st_bf16x8(X1B + o, v0, v1);
                    ss += (v0[0] * v0[0] + v0[1] * v0[1]) + (v0[2] * v0[2] + v0[3] * v0[3]) + (v1[0] * v1[0] + v1[1] * v1[1]) + (v1[2] * v1[2] + v1[3] * v1[3]);
                }
                ss += __shfl_xor(ss, 16); ss += __shfl_xor(ss, 32);
                if (fq == 0) atomicAdd(ssq + row, ss);
            }
    }
};
struct EpiGateUp {
    static constexpr bool PERM = true, AFTER_DRAIN = false;
    const float* ssq; bf16_t* HB;
    __device__ __forceinline__ void operator()(const f32x4 (&acc)[2][2][4][2], const Unit& u, int wr, int wc, int fr, int fq) const {
        const int rb = u.pm * BM + wr * 64 + fr, cb = u.pn * HALF + wc * 32 + 8 * fq;
#pragma unroll
        for (int ai = 0; ai < 2; ++ai)
#pragma unroll
            for (int m = 0; m < 4; ++m) {
                const int row = rb + ai * HALF + m * 16; if (row >= MVALID) continue;
                const float rs = rsqrtf(ssq[row] * (1.f / 1024.f) + 1e-6f);
                f32x4 h[2];
#pragma unroll
                for (int n = 0; n < 2; ++n)
#pragma unroll
                    for (int j = 0; j < 4; ++j) { const float g = acc[ai][0][m][n][j] * rs, uu = acc[ai][1][m][n][j] * rs; h[n][j] = g * sigmoidf_(g) * uu; }
                st_bf16x8(HB + (size_t)row * FF + cb, h[0], h[1]);
            }
    }
};
struct EpiDown {
    static constexpr bool PERM = true, AFTER_DRAIN = false;
    float* y;
    __device__ __forceinline__ void operator()(const f32x4 (&acc)[2][2][4][2], const Unit& u, int wr, int wc, int fr, int fq) const {
        const int rb = u.pm * BM + wr * 64 + fr, cb = u.pn * BM + wc * 32 + 8 * fq;
#pragma unroll
        for (int ai = 0; ai < 2; ++ai)
#pragma unroll
            for (int m = 0; m < 4; ++m) {
                const int row = rb + ai * HALF + m * 16;
#pragma unroll
                for (int bj = 0; bj < 2; ++bj) {
                    float* p = y + (size_t)row * 1024 + cb + bj * HALF;
                    const f32x4 v0 = acc[ai][bj][m][0] + *(const f32x4*)p, v1 = acc[ai][bj][m][1] + *(const f32x4*)(p + 4);
                    *(f32x4*)p = v0; *(f32x4*)(p + 4) = v1;
                }
            }
    }
};
struct PairOrder {
    StaticOrder base;
    __device__ __forceinline__ bool next(int i, Unit& u) const { if (!base.next(i >> 1, u)) return false; u.z = i & 1; return true; }
    __device__ __forceinline__ void a_ready(const Unit&) const {}
    __device__ __forceinline__ void done(const Unit&) const {}
};

template <class Epi, class Sched, bool ALIGN_EPI = false, bool SP2 = false>
__device__ __forceinline__ void gemm_phase(PG8_LAS unsigned char* lds, const Gemm g, const Sched& S, const Epi& E) {
    const int tid = threadIdx.x, wid = __builtin_amdgcn_readfirstlane(tid >> 6), lane = tid & 63, wr = wid >> 2, wc = wid & 3, fr = lane & 15, fq = lane >> 4;
    const int K = g.K, nt = K / BK;
    unsigned voffA[2], voffB[2];
#pragma unroll
    for (int i = 0; i < 2; ++i) { int R, C; stage_rc(tid * 16 + i * 8192, R, C); const int Rb = Epi::PERM ? ((R & ~31) + perm32(R & 31)) : R;
        voffA[i] = (unsigned)(R * K + C) * 2u; voffB[i] = (unsigned)(Rb * K + C) * 2u; }
    const size_t kstep = (size_t)(BK * 2);
    const size_t hstep = (size_t)HALF * K * 2;
    const size_t tstep = 2 * hstep;
    const unsigned ldsw = (unsigned)wid * 1024u;
    const int aoff = lds_byte(wr * 64 + fr, fq * 8), boff = lds_byte(wc * 32 + fr, fq * 8);
#define PG8_SA(b, h) (((b) * 2 + (h)) * HTB)
#define PG8_SB(b, h) ((4 + (b) * 2 + (h)) * HTB)
#define PG8_STAGE(bufoff, gbase, voff) do { _Pragma("unroll") for (int _i = 0; _i < 2; ++_i) \
        __builtin_amdgcn_global_load_lds((const unsigned*)((const char*)(gbase) + (voff)[_i]), (PG8_LAS unsigned*)(lds + (bufoff) + ldsw + _i * 8192), 16, 0, 0); } while (0)
#define PG8_LDA(dst, b, h) do { _Pragma("unroll") for (int m = 0; m < 4; ++m) _Pragma("unroll") for (int k = 0; k < 2; ++k) dst[m][k] = *(const PG8_LAS bf16x8*)(lds + PG8_SA(b, h) + aoff + m * 2048 + k * 1024); } while (0)
#define PG8_LDB(dst, b, h) do { _Pragma("unroll") for (int n = 0; n < 2; ++n) _Pragma("unroll") for (int k = 0; k < 2; ++k) dst[n][k] = *(const PG8_LAS bf16x8*)(lds + PG8_SB(b, h) + boff + n * 2048 + k * 1024); } while (0)
#define PG8_MMA(ai, bj, At, Bt) do { __builtin_amdgcn_s_setprio(1); _Pragma("unroll") for (int m = 0; m < 4; ++m) _Pragma("unroll") for (int n = 0; n < 2; ++n) _Pragma("unroll") for (int k = 0; k < 2; ++k) \
        acc[ai][bj][m][n] = __builtin_amdgcn_mfma_f32_16x16x32_bf16(Bt[n][k], At[m][k], acc[ai][bj][m][n], 0, 0, 0); __builtin_amdgcn_s_setprio(0); } while (0)
#define PG8_WAIT_V(n) asm volatile("s_waitcnt vmcnt(" #n ")" ::: "memory")
#define PG8_WAIT_L(n) asm volatile("s_waitcnt lgkmcnt(" #n ")" ::: "memory")
#define PG8_BAR __builtin_amdgcn_s_barrier()
#define PG8_SCHED __builtin_amdgcn_sched_barrier(0)
    Unit cur, nxt; int ui = 0;
    if (!S.next(0, cur)) return;
    f32x4 acc[2][2][4][2];
#pragma unroll
    for (int a = 0; a < 2; ++a)
#pragma unroll
        for (int b = 0; b < 2; ++b)
#pragma unroll
            for (int m = 0; m < 4; ++m)
#pragma unroll
                for (int n = 0; n < 2; ++n) acc[a][b][m][n] = (f32x4){0.f, 0.f, 0.f, 0.f};
    bf16x8 At[4][2], B0[2][2], B1[2][2];
    const char* cA = (const char*)(cur.z ? g.A2 : g.A) + (size_t)cur.pm * tstep; const char* cB = (const char*)(cur.z ? g.Bt2 : g.Bt) + (size_t)cur.pn * tstep;
    S.a_ready(cur);
    if constexpr (SP2) {
        PG8_STAGE(PG8_SB(0, 0), cB, voffB); PG8_STAGE(PG8_SB(0, 1), cB + hstep, voffB); PG8_STAGE(PG8_SA(0, 0), cA, voffA); PG8_STAGE(PG8_SA(0, 1), cA + hstep, voffA);
        if (wr == 1) PG8_BAR;
        PG8_WAIT_V(2); PG8_BAR;
        PG8_STAGE(PG8_SB(1, 0), cB + kstep, voffB); PG8_STAGE(PG8_SA(1, 0), cA + kstep, voffA); PG8_STAGE(PG8_SB(1, 1), cB + hstep + kstep, voffB);
        PG8_WAIT_V(6); PG8_BAR;
    } else {
        PG8_STAGE(PG8_SB(0, 0), cB, voffB); PG8_STAGE(PG8_SA(0, 0), cA, voffA); PG8_STAGE(PG8_SB(0, 1), cB + hstep, voffB); PG8_STAGE(PG8_SA(0, 1), cA + hstep, voffA);
        if (wr == 1) PG8_BAR;
        PG8_WAIT_V(4); PG8_BAR;
        PG8_STAGE(PG8_SB(1, 0), cB + kstep, voffB); PG8_STAGE(PG8_SA(1, 0), cA + kstep, voffA); PG8_STAGE(PG8_SB(1, 1), cB + hstep + kstep, voffB);
        PG8_WAIT_V(6); PG8_BAR;
    }
    for (;;) {
        const bool has_next = S.next(ui + 1, nxt);
        const char* nA = has_next ? (const char*)(nxt.z ? g.A2 : g.A) + (size_t)nxt.pm * tstep : cA; const char* nB = has_next ? (const char*)(nxt.z ? g.Bt2 : g.Bt) + (size_t)nxt.pn * tstep : cB;
        for (int t = 0; t < nt; t += 2) {
            const bool last = (t == nt - 2);
            const char* a1 = cA + (size_t)(t + 1) * kstep;
            const char* a2 = last ? nA : cA + (size_t)(t + 2) * kstep; const char* b2 = last ? nB : cB + (size_t)(t + 2) * kstep;
            const char* a3 = a2 + kstep; const char* b3 = b2 + kstep;
            if (last && has_next) S.a_ready(nxt);
            if constexpr (SP2) {
            PG8_LDB(B0, 0, 0); PG8_LDB(B1, 0, 1); PG8_SCHED; PG8_LDA(At, 0, 0); PG8_STAGE(PG8_SA(1, 1), a1 + hstep, voffA);
            PG8_WAIT_V(8); PG8_WAIT_L(0); PG8_BAR; PG8_MMA(0, 0, At, B0); PG8_MMA(0, 1, At, B1); PG8_BAR; PG8_SCHED;
            PG8_LDA(At, 0, 1); PG8_STAGE(PG8_SB(0, 0), b2, voffB); PG8_STAGE(PG8_SB(0, 1), b2 + hstep, voffB); PG8_STAGE(PG8_SA(0, 0), a2, voffA);
            PG8_WAIT_V(8); PG8_WAIT_L(0); PG8_BAR; PG8_MMA(1, 0, At, B0); PG8_MMA(1, 1, At, B1); PG8_BAR; PG8_SCHED;
            PG8_LDB(B0, 1, 0); PG8_LDB(B1, 1, 1); PG8_SCHED; PG8_LDA(At, 1, 0); PG8_STAGE(PG8_SA(0, 1), a2 + hstep, voffA);
            PG8_WAIT_V(8); PG8_WAIT_L(0); PG8_BAR; PG8_MMA(0, 0, At, B0); PG8_MMA(0, 1, At, B1); PG8_BAR; PG8_SCHED;
            PG8_LDA(At, 1, 1); PG8_STAGE(PG8_SB(1, 0), b3, voffB); PG8_STAGE(PG8_SB(1, 1), b3 + hstep, voffB); PG8_STAGE(PG8_SA(1, 0), a3, voffA);
            PG8_WAIT_V(8); PG8_WAIT_L(0); PG8_BAR; PG8_MMA(1, 0, At, B0); PG8_MMA(1, 1, At, B1); PG8_BAR; PG8_SCHED;
            } else {
            PG8_LDB(B0, 0, 0); PG8_SCHED; PG8_LDA(At, 0, 0); PG8_STAGE(PG8_SA(1, 1), a1 + hstep, voffA);
            PG8_WAIT_L(8); PG8_BAR; PG8_WAIT_L(0); PG8_MMA(0, 0, At, B0); PG8_BAR; PG8_SCHED;
            PG8_LDB(B1, 0, 1); PG8_STAGE(PG8_SB(0, 0), b2, voffB);
            PG8_BAR; PG8_WAIT_L(0); PG8_MMA(0, 1, At, B1); PG8_BAR;
            PG8_LDA(At, 0, 1); PG8_STAGE(PG8_SA(0, 0), a2, voffA);
            PG8_BAR; PG8_WAIT_L(0); PG8_MMA(1, 0, At, B0); PG8_BAR; PG8_SCHED;
            PG8_STAGE(PG8_SB(0, 1), b2 + hstep, voffB);
            PG8_WAIT_V(6); PG8_BAR; PG8_MMA(1, 1, At, B1); PG8_BAR;
            PG8_LDB(B0, 1, 0); PG8_SCHED; PG8_LDA(At, 1, 0); PG8_STAGE(PG8_SA(0, 1), a2 + hstep, voffA);
            PG8_WAIT_L(8); PG8_BAR; PG8_WAIT_L(0); PG8_MMA(0, 0, At, B0); PG8_BAR; PG8_SCHED;
            PG8_LDB(B1, 1, 1); PG8_STAGE(PG8_SB(1, 0), b3, voffB);
            PG8_BAR; PG8_WAIT_L(0); PG8_MMA(0, 1, At, B1); PG8_BAR;
            PG8_LDA(At, 1, 1); PG8_STAGE(PG8_SA(1, 0), a3, voffA);
            PG8_BAR; PG8_WAIT_L(0); PG8_MMA(1, 0, At, B0); PG8_BAR; PG8_SCHED;
            PG8_STAGE(PG8_SB(1, 1), b3 + hstep, voffB);
            PG8_WAIT_V(6); PG8_BAR; PG8_MMA(1, 1, At, B1); PG8_BAR;
            }
        }
        if constexpr (ALIGN_EPI) { if (wr == 0) PG8_BAR; }
        if constexpr (!Epi::AFTER_DRAIN) { E(acc, cur, wr, wc, fr, fq); S.done(cur); }
        if (!has_next) break;
#pragma unroll
        for (int a = 0; a < 2; ++a)
#pragma unroll
            for (int b = 0; b < 2; ++b)
#pragma unroll
                for (int m = 0; m < 4; ++m)
#pragma unroll
                    for (int n = 0; n < 2; ++n) acc[a][b][m][n] = (f32x4){0.f, 0.f, 0.f, 0.f};
        cur = nxt; cA = nA; cB = nB; ++ui;
        if constexpr (ALIGN_EPI) { if (wr == 1) PG8_BAR; }
    }
    PG8_WAIT_V(0);
    if constexpr (!ALIGN_EPI) { if (wr == 0) PG8_BAR; }
    PG8_BAR;
    if constexpr (Epi::AFTER_DRAIN) { E.fused(acc, cur, wr, wc, fr, fq, lds, wid, lane); S.done(cur); }
#undef PG8_SA
#undef PG8_SB
#undef PG8_STAGE
#undef PG8_LDA
#undef PG8_LDB
#undef PG8_MMA
#undef PG8_WAIT_V
#undef PG8_WAIT_L
#undef PG8_BAR
#undef PG8_SCHED
}
}

constexpr size_t MiB = 1u << 20;
constexpr size_t WS_CTL = 0, CTL_ZERO_BYTES = 1 * MiB;
constexpr size_t WS_WIN = 2 * MiB, WS_WPA = 13 * MiB, WS_WPB = 14 * MiB, WS_WOUT = 15 * MiB, WS_WGU = 17 * MiB, WS_WDN = 28 * MiB;
constexpr size_t WS_XB = 34 * MiB, WS_RS0 = 67 * MiB, WS_QB = 68 * MiB, WS_KB = 85 * MiB, WS_VB = 102 * MiB, WS_PC = 119 * MiB, WS_GT = 176 * MiB;
constexpr size_t WS_ON = 241 * MiB, WS_RW = 258 * MiB, WS_MG = 275 * MiB, WS_TMP = 308 * MiB, WS_X1B = 373 * MiB, WS_HB = 406 * MiB;
constexpr size_t WS_RK = 496 * MiB, RK_STRIDE = 33 * MiB;
constexpr size_t WS_BON = 728 * MiB, WS_DP = 729 * MiB, WS_END = 736 * MiB;
static_assert(WS_WIN + (size_t)INW * DM * 2 <= WS_WPA && WS_WGU + (size_t)NGU * DM * 2 <= WS_WDN && WS_WDN + (size_t)DM * FF * 2 <= WS_XB, "weights map");
static_assert(WS_XB + (size_t)MTOT * DM * 2 <= WS_RS0 && WS_QB + (size_t)MTOT * 512 * 2 <= WS_KB && WS_PC + (size_t)MTOT * RSW * 2 <= WS_GT && WS_GT + (size_t)MTOT * 2048 * 2 <= WS_ON, "act map 1");
static_assert(WS_MG + (size_t)MTOT * DM * 2 <= WS_TMP && WS_TMP + (size_t)MTOT * DM * 4 <= WS_X1B && WS_X1B + (size_t)MTOT * DM * 2 <= WS_HB && WS_HB + (size_t)MTOT * FF * 2 <= WS_RK, "act map 2");
static_assert((size_t)MTOT * 512 * 4 <= RK_STRIDE && WS_RK + 7 * RK_STRIDE <= WS_BON, "rwkv map");
constexpr int CW_TMO = 0, CW_CODE = 1;
constexpr int CW_BAR = 4096;
constexpr int CW_SSQ = 32768;
constexpr int CW_DCNT = 65536;
static_assert((CW_DCNT + 128 * 64) * 4 <= (int)CTL_ZERO_BYTES, "CTL map");

constexpr int RING_OFF = 0, RING_BYTES = 131072;
constexpr int LDSCTL_OFF = RING_BYTES, MISC_OFF = LDSCTL_OFF + 320;
constexpr int LDS_BYTES = 147456;
constexpr int NWAVES = 8;

#define GAS __attribute__((address_space(1)))
#define LAS __attribute__((address_space(3)))
typedef unsigned short bf16;
typedef unsigned v4u __attribute__((ext_vector_type(4)));
typedef unsigned v2u __attribute__((ext_vector_type(2)));
typedef float f32x4 __attribute__((ext_vector_type(4)));
typedef float f32x2 __attribute__((ext_vector_type(2)));
typedef float f32x16 __attribute__((ext_vector_type(16)));
typedef short bf16x8 __attribute__((ext_vector_type(8)));
typedef short s16x4 __attribute__((ext_vector_type(4)));
typedef GAS unsigned gu32;
#define RLX_AGENT __ATOMIC_RELAXED, __HIP_MEMORY_SCOPE_AGENT
#define LDS_WAIT() asm volatile("s_waitcnt lgkmcnt(0)" ::: "memory")
#define VM_WAIT() asm volatile("s_waitcnt vmcnt(0)" ::: "memory")
__device__ __forceinline__ unsigned pk2(float lo, float hi) { return pg8::cvt_pk_bf16(lo, hi); }
using pg8::sigmoidf_;
__device__ __forceinline__ float bf2f(unsigned short b) { return __builtin_bit_cast(float, (unsigned)b << 16); }
__device__ __forceinline__ float bflo(unsigned w) { return __builtin_bit_cast(float, w << 16); }
__device__ __forceinline__ float bfhi(unsigned w) { return __builtin_bit_cast(float, w & 0xffff0000u); }

#define XB_TMO      128
#define XB_XCNT(j)  (256  + 64 * (j))
#define XB_XSUB(j)  (1280 + 64 * (j))
#define XB_XGEN(j)  (2304 + 64 * (j))
#define XB_TOP      3328
#define XB_TOPGEN   3392
#define XCD_BAR_WORDS 3456
#define XB_SPIN_CAP (1u << 18)

__device__ __forceinline__ unsigned xb_ld(unsigned* p)              { return __hip_atomic_load(p, __ATOMIC_RELAXED, __HIP_MEMORY_SCOPE_AGENT); }
__device__ __forceinline__ unsigned xb_add(unsigned* p, unsigned v) { return __hip_atomic_fetch_add(p, v, __ATOMIC_RELAXED, __HIP_MEMORY_SCOPE_AGENT); }
__device__ __forceinline__ unsigned xb_xcc_id() { return (unsigned)__builtin_amdgcn_s_getreg((3 << 11) | 20) & 0xFu; }
#define XB_SPIN(cond, bar) do { unsigned _sp = 0; while (cond) { __builtin_amdgcn_s_sleep(1); \
    if ((++_sp & 255u) == 0u) { if (xb_ld(&(bar)[XB_TMO])) break; if (_sp > XB_SPIN_CAP) { atomicAdd(&(bar)[XB_TMO], 1u); break; } } } } while (0)

struct XcdBarrier {
    unsigned* bar; unsigned x;
    volatile LAS unsigned* st;
};

__device__ __forceinline__ XcdBarrier xcd_barrier_post(unsigned* bar, volatile LAS unsigned* st) {
    XcdBarrier b; b.bar = bar; b.x = xb_xcc_id(); b.st = st;
    if (threadIdx.x == 0) (void)xb_add(&bar[XB_XCNT(b.x)], 1u);
    return b;
}
__device__ __forceinline__ void xcd_barrier_complete(unsigned* bar, unsigned x, unsigned& nloc, unsigned& nx) {
    const unsigned G = gridDim.x * gridDim.y * gridDim.z;
    unsigned sum, cnt, mine, sp = 0u;
    for (;;) {
        sum = 0u; cnt = 0u; mine = 0u;
#pragma unroll
        for (unsigned j = 0; j < 16; ++j) { const unsigned c = xb_ld(&bar[XB_XCNT(j)]); sum += c; cnt += (c > 0u) ? 1u : 0u; mine = (j == x) ? c : mine; }
        if (sum == G) break;
        __builtin_amdgcn_s_sleep(1);
        if ((++sp & 255u) == 0u) { if (xb_ld(&bar[XB_TMO])) break; if (sp > XB_SPIN_CAP) { atomicAdd(&bar[XB_TMO], 1u); break; } }
    }
    nloc = mine > 0u ? mine : 1u; nx = cnt > 0u ? cnt : 1u;
}

__device__ __forceinline__ void xcd_barrier(const XcdBarrier& b) {
    asm volatile("s_waitcnt vmcnt(0)" ::: "memory");
    __syncthreads();
    if (threadIdx.x == 0) {
        unsigned* bar = b.bar;
        __builtin_amdgcn_s_waitcnt(0);
        unsigned nloc = b.st[0], nx = b.st[1];
        if (nloc == 0u) { xcd_barrier_complete(bar, b.x, nloc, nx); b.st[0] = nloc; b.st[1] = nx; }
        const unsigned old = xb_add(&bar[XB_XSUB(b.x)], 1u);
        const unsigned gen = old / nloc;
        if (old + 1u == (gen + 1u) * nloc) {
            __builtin_amdgcn_fence(__ATOMIC_RELEASE, "agent");
            asm volatile("s_waitcnt vmcnt(0)" ::: "memory");
            const unsigned og = xb_add(&bar[XB_TOP], 1u);
            const unsigned tg = og / nx;
            if (og + 1u == (tg + 1u) * nx) xb_add(&bar[XB_TOPGEN], 1u);
            else XB_SPIN(xb_ld(&bar[XB_TOPGEN]) == tg, bar);
            __builtin_amdgcn_fence(__ATOMIC_ACQUIRE, "agent");
            xb_add(&bar[XB_XGEN(b.x)], 1u);
            asm volatile("s_waitcnt vmcnt(0)" ::: "memory");
        } else {
            XB_SPIN(xb_ld(&bar[XB_XGEN(b.x)]) == gen, bar);
            __builtin_amdgcn_fence(__ATOMIC_ACQUIRE, "agent");
            asm volatile("s_waitcnt vmcnt(0)" ::: "memory");
        }
    }
    __syncthreads();
}

struct Args { const float* in[34]; float* out; unsigned char* ws; int ph_lo, ph_hi, li, pad; };
struct Frame {
    LAS unsigned char* lds;
    volatile LAS unsigned* MISC;
    gu32* ctl;
    int tid, lane, wave, vcu, G;
    unsigned char* ws; float* out;
};
enum { I_XP = 0, I_XS, I_CK, I_CV, I_PT, I_SWKV, I_SSH, I_NMIX, I_WIN, I_QG, I_KG, I_LQ1, I_LK1, I_LQ2, I_LK2, I_AOG, I_WPA, I_MU, I_W0, I_W2, I_A0, I_A2, I_G2,
       I_KK, I_KA, I_RK, I_GNW, I_GNB, I_WPB, I_WOUT, I_NFFN, I_WG, I_WU, I_WD };

__device__ __forceinline__ float wave_sum(float v) {
#pragma unroll
    for (int o = 1; o < 64; o <<= 1) v += __shfl_xor(v, o);
    return v;
}

__device__ __forceinline__ void p0_transpose_item(const float* W, int K, int N, bf16* WT, int drow0, const float* kgain, LAS float* scr, int k0, int n0, int lane) {
#pragma unroll 8
    for (int i = 0; i < 32; ++i) { const int kk = 2 * i + (lane >> 5); float v = W[(size_t)(k0 + kk) * N + n0 + (lane & 31)]; if (kgain) v *= kgain[k0 + kk]; scr[kk * 33 + (lane & 31)] = v; }
    LDS_WAIT(); asm volatile("" ::: "memory");
    const int c = lane & 7;
#pragma unroll
    for (int j = 0; j < 4; ++j) { const int n = (lane >> 3) + 8 * j; const LAS float* s = scr + (8 * c) * 33 + n;
        v4u o; o.x = pk2(s[0 * 33], s[1 * 33]); o.y = pk2(s[2 * 33], s[3 * 33]); o.z = pk2(s[4 * 33], s[5 * 33]); o.w = pk2(s[6 * 33], s[7 * 33]);
        *(GAS v4u*)(WT + (size_t)(drow0 + n) * K + k0 + 8 * c) = o; }
    LDS_WAIT(); asm volatile("" ::: "memory");
}
__device__ __forceinline__ void p0_prologue(Frame& F, const Args& A) {
    LAS float* scr = (LAS float*)(F.lds + RING_OFF + F.wave * 16384);
    const int gw = F.vcu * NWAVES + F.wave, NGW = F.G * NWAVES;
    bf16* Win_t = (bf16*)(F.ws + WS_WIN); bf16* Wpa_t = (bf16*)(F.ws + WS_WPA); bf16* Wpb_t = (bf16*)(F.ws + WS_WPB); bf16* Wout_t = (bf16*)(F.ws + WS_WOUT);
    bf16* Wgu_t = (bf16*)(F.ws + WS_WGU); bf16* Wdn_t = (bf16*)(F.ws + WS_WDN);
    constexpr int I_IN = (DM / 64) * (INW / 32), I_PA = (512 / 64) * (DM / 32), I_OUT = (DM / 64) * (DM / 32), I_G = (DM / 64) * (FF / 32), I_D = (FF / 64) * (DM / 32);
    constexpr int NITEMS = I_IN + 2 * I_PA + I_OUT + 2 * I_G + I_D;
    for (int it = gw; it < NITEMS; it += NGW) {
        int r = it;
        if (r < I_IN) { constexpr int nnb = INW / 32; const int kb = r / nnb, nb = r % nnb, pn = nb >> 3, q = nb & 7;
            p0_transpose_item(A.in[I_WIN], DM, INW, Win_t, 256 * pn + 32 * (4 * (q & 1) + (q >> 1)), A.in[I_NMIX], scr, 64 * kb, 32 * nb, F.lane); continue; } r -= I_IN;
        if (r < I_PA) { constexpr int nnb = DM / 32; const int kb = r / nnb, nb = r % nnb; p0_transpose_item(A.in[I_WPA], 512, DM, Wpa_t, 32 * nb, nullptr, scr, 64 * kb, 32 * nb, F.lane); continue; } r -= I_PA;
        if (r < I_PA) { constexpr int nnb = DM / 32; const int kb = r / nnb, nb = r % nnb; p0_transpose_item(A.in[I_WPB], 512, DM, Wpb_t, 32 * nb, nullptr, scr, 64 * kb, 32 * nb, F.lane); continue; } r -= I_PA;
        if (r < I_OUT) { constexpr int nnb = DM / 32; const int kb = r / nnb, nb = r % nnb; p0_transpose_item(A.in[I_WOUT], DM, DM, Wout_t, 32 * nb, nullptr, scr, 64 * kb, 32 * nb, F.lane); continue; } r -= I_OUT;
        if (r < I_G) { constexpr int nnb = FF / 32; const int kb = r / nnb, nb = r % nnb;
            p0_transpose_item(A.in[I_WG], DM, FF, Wgu_t, 256 * (nb >> 2) + 32 * (nb & 3), A.in[I_NFFN], scr, 64 * kb, 32 * nb, F.lane); continue; } r -= I_G;
        if (r < I_G) { constexpr int nnb = FF / 32; const int kb = r / nnb, nb = r % nnb;
            p0_transpose_item(A.in[I_WU], DM, FF, Wgu_t, 256 * (nb >> 2) + 128 + 32 * (nb & 3), A.in[I_NFFN], scr, 64 * kb, 32 * nb, F.lane); continue; } r -= I_G;
        { constexpr int nnb = DM / 32; const int kb = r / nnb, nb = r % nnb; p0_transpose_item(A.in[I_WD], FF, DM, Wdn_t, 32 * nb, nullptr, scr, 64 * kb, 32 * nb, F.lane); }
    }
    bf16* XB = (bf16*)(F.ws + WS_XB); float* rs0 = (float*)(F.ws + WS_RS0);
    for (int m = gw; m < MTOT; m += NGW) {
        GAS unsigned long long* o8 = (GAS unsigned long long*)(XB + (size_t)m * DM) + F.lane;
        if (m >= MVALID) {
#pragma unroll
            for (int j = 0; j < 4; ++j) o8[64 * j] = 0ull;
            if (F.lane == 0) rs0[m] = 0.f;
            continue;
        }
        const float* xrow = m < MP ? A.in[I_XP] + (size_t)m * DM : A.in[I_XS] + (size_t)(m - MP) * DM;
        const GAS f32x4* xr = (const GAS f32x4*)xrow + F.lane;
        f32x4 v[4]; float s = 0.f;
#pragma unroll
        for (int j = 0; j < 4; ++j) { v[j] = xr[64 * j]; s += (v[j].x * v[j].x + v[j].y * v[j].y) + (v[j].z * v[j].z + v[j].w * v[j].w); }
        const float rs = rsqrtf(wave_sum(s) * (1.f / DM) + 1e-6f);
#pragma unroll
        for (int j = 0; j < 4; ++j) o8[64 * j] = (unsigned long long)pk2(v[j].x, v[j].y) | ((unsigned long long)pk2(v[j].z, v[j].w) << 32);
        if (F.lane == 0) rs0[m] = rs;
    }
}

__device__ __forceinline__ float lam_value(const Frame& F, const Args& A) {
    const int l = F.lane;
    const float a = wave_sum(A.in[I_LQ1][l] * A.in[I_LK1][l]), b = wave_sum(A.in[I_LQ2][l] * A.in[I_LK2][l]);
    return __expf(a) - __expf(b) + 0.2f;
}
__device__ __forceinline__ float* rk_arr(const Frame& F, int i) { return (float*)(F.ws + WS_RK + (size_t)i * RK_STRIDE); }

__device__ __forceinline__ void rwkv_prep_unit(Frame& F, const Args& A, int unit) {
    LAS float* mbuf = (LAS float*)(F.lds + RING_OFF);
    LAS float* lin = mbuf + 8 * RSW;
    const bf16* PC = (const bf16*)(F.ws + WS_PC);
    const int r0 = unit * 8, tid = F.tid;
    const float* mu = A.in[I_MU];
    for (int c = tid; c < RSW; c += 512) {
        const float muc = mu[c];
#pragma unroll
        for (int t = 0; t < 8; ++t) {
            const int row = r0 + t; float p = bf2f(PC[(size_t)row * RSW + c]), prev;
            if (row >= MP) prev = A.in[I_SSH][(size_t)(row - MP) * RSW + c];
            else if ((row & (SEQ - 1)) == 0) prev = 0.f;
            else prev = bf2f(PC[(size_t)(row - 1) * RSW + c]);
            const float m = p + (prev - p) * muc;
            mbuf[t * RSW + c] = m;
            if (c >= 1536) { const int i = c - 1536; float v = m; if (i < 64) v = tanhf(m); else if (i >= 128) v = sigmoidf_(m); lin[i * 8 + t] = v; }
        }
    }
    __syncthreads();
    const int ch = tid, head = ch >> 6;
    float wl[8], al[8], gg[8];
    { const float w0 = A.in[I_W0][ch], a0 = A.in[I_A0][ch];
#pragma unroll
      for (int t = 0; t < 8; ++t) { wl[t] = w0; al[t] = a0; gg[t] = 0.f; } }
    const float* w2 = A.in[I_W2]; const float* a2 = A.in[I_A2]; const float* g2 = A.in[I_G2];
#pragma unroll 4
    for (int i = 0; i < 64; ++i) {
        const float w = w2[i * 512 + ch], a = a2[i * 512 + ch];
        const f32x4 t0 = *(const LAS f32x4*)(lin + i * 8), t1 = *(const LAS f32x4*)(lin + i * 8 + 4), x0 = *(const LAS f32x4*)(lin + (64 + i) * 8), x1 = *(const LAS f32x4*)(lin + (64 + i) * 8 + 4);
#pragma unroll
        for (int t = 0; t < 4; ++t) { wl[t] += t0[t] * w; wl[4 + t] += t1[t] * w; al[t] += x0[t] * a; al[4 + t] += x1[t] * a; }
    }
#pragma unroll 4
    for (int i = 0; i < 128; ++i) {
        const float g = g2[i * 512 + ch];
        const f32x4 s0 = *(const LAS f32x4*)(lin + (128 + i) * 8), s1 = *(const LAS f32x4*)(lin + (128 + i) * 8 + 4);
#pragma unroll
        for (int t = 0; t < 4; ++t) { gg[t] += s0[t] * g; gg[4 + t] += s1[t] * g; }
    }
    const float kkc = A.in[I_KK][ch], kac = A.in[I_KA][ch], rkc = A.in[I_RK][ch];
    float* aR = rk_arr(F, 0); float* aW = rk_arr(F, 1); float* aK = rk_arr(F, 2); float* aV = rk_arr(F, 3); float* aA = rk_arr(F, 4); float* aB = rk_arr(F, 5); float* aG = rk_arr(F, 6);
    float* BON = (float*)(F.ws + WS_BON);
#pragma unroll
    for (int t = 0; t < 8; ++t) {
        const int row = r0 + t; const size_t o = (size_t)row * 512 + ch;
        const float r = mbuf[t * RSW + ch], k = mbuf[t * RSW + 512 + ch], v = mbuf[t * RSW + 1024 + ch];
        const float x = -wl[t], sp = fmaxf(x, 0.f) + log1pf(__expf(-fabsf(x)));
        const float e = __expf(-sp - 0.5f), w = __expf(-e);
        const float a = sigmoidf_(al[t]);
        const float kkv = k * kkc, ss = wave_sum(kkv * kkv), kk = kkv * rsqrtf(fmaxf(ss, 1e-24f));
        const float kp = k * (1.f + (a - 1.f) * kac);
        const float bon = wave_sum(r * kp * rkc);
        aR[o] = r; aW[o] = w; aK[o] = kp; aV[o] = v; aA[o] = -kk; aB[o] = kk * a; aG[o] = gg[t];
        if (F.lane == 0) BON[row * 8 + head] = bon;
    }
    __syncthreads();
}

__device__ __forceinline__ float dpp_xor1(float v) { return __builtin_bit_cast(float, __builtin_amdgcn_update_dpp(0, __builtin_bit_cast(int, v), 0xB1, 0xF, 0xF, true)); }
__device__ __forceinline__ float dpp_xor2(float v) { return __builtin_bit_cast(float, __builtin_amdgcn_update_dpp(0, __builtin_bit_cast(int, v), 0x4E, 0xF, 0xF, true)); }
__device__ __forceinline__ float dpp_hmir(float v) { return __builtin_bit_cast(float, __builtin_amdgcn_update_dpp(0, __builtin_bit_cast(int, v), 0x141, 0xF, 0xF, true)); }
__device__ __forceinline__ float red8(float v) { v += dpp_xor1(v); v += dpp_xor2(v); v += dpp_hmir(v); return v; }
__device__ __forceinline__ void scan_unit(Frame& F, const Args& A, int u) {
    constexpr int TB = 32;
    LAS float* vec = (LAS float*)(F.lds + RING_OFF);
    LAS float* ybuf = vec + 6 * TB * 64;
    const int tid = F.tid, i = tid >> 3, seg = tid & 7;
    int h, row0, T; float* sout; float S[8];
    if (u < 32) { h = u & 7; row0 = (u >> 3) * SEQ; T = SEQ; sout = F.out + O_WP + ((size_t)u * 64 + i) * 64 + 8 * seg;
#pragma unroll
        for (int c = 0; c < 8; ++c) S[c] = 0.f; }
    else { const int su = u - 32; h = su & 7; row0 = MP + (su >> 3); T = 1; sout = F.out + O_WS + ((size_t)su * 64 + i) * 64 + 8 * seg;
        const float* s0 = A.in[I_SWKV] + ((size_t)su * 64 + i) * 64 + 8 * seg;
        const f32x4 a = *(const f32x4*)s0, b = *(const f32x4*)(s0 + 4);
#pragma unroll
        for (int c = 0; c < 4; ++c) { S[c] = a[c]; S[4 + c] = b[c]; } }
    const float* BON = (const float*)(F.ws + WS_BON); const float* aG = rk_arr(F, 6); bf16* RW = (bf16*)(F.ws + WS_RW);
    for (int t0 = 0; t0 < T; t0 += TB) {
        const int nb = (T - t0) < TB ? (T - t0) : TB;
        for (int e = tid; e < 6 * TB * 16; e += 512) { const int a = e / (TB * 16), rem = e % (TB * 16), t = rem >> 4, q = rem & 15;
            if (t < nb) *(LAS f32x4*)(vec + (a * TB + t) * 64 + 4 * q) = *(const f32x4*)(rk_arr(F, a) + (size_t)(row0 + t0 + t) * 512 + h * 64 + 4 * q); }
        __syncthreads();
        for (int t = 0; t < nb; ++t) {
            const LAS float* vR = vec + (0 * TB + t) * 64 + 8 * seg; const LAS float* vW = vec + (1 * TB + t) * 64 + 8 * seg; const LAS float* vK = vec + (2 * TB + t) * 64 + 8 * seg;
            const LAS float* vA = vec + (4 * TB + t) * 64 + 8 * seg; const LAS float* vB = vec + (5 * TB + t) * 64 + 8 * seg;
            const float vi = vec[(3 * TB + t) * 64 + i];
            const f32x4 a0 = *(const LAS f32x4*)vA, a1 = *(const LAS f32x4*)(vA + 4);
            float sa = 0.f;
#pragma unroll
            for (int c = 0; c < 4; ++c) { sa += S[c] * a0[c]; sa += S[4 + c] * a1[c]; }
            sa = red8(sa);
            const f32x4 w0 = *(const LAS f32x4*)vW, w1 = *(const LAS f32x4*)(vW + 4), b0 = *(const LAS f32x4*)vB, b1 = *(const LAS f32x4*)(vB + 4), k0 = *(const LAS f32x4*)vK, k1 = *(const LAS f32x4*)(vK + 4);
            const f32x4 r0 = *(const LAS f32x4*)vR, r1 = *(const LAS f32x4*)(vR + 4);
            float y = 0.f;
#pragma unroll
            for (int c = 0; c < 4; ++c) {
                S[c] = S[c] * w0[c] + sa * b0[c] + vi * k0[c]; S[4 + c] = S[4 + c] * w1[c] + sa * b1[c] + vi * k1[c];
                y += S[c] * r0[c]; y += S[4 + c] * r1[c];
            }
            y = red8(y);
            if (seg == 0) ybuf[t * 64 + i] = y;
        }
        __syncthreads();
        { const int t = tid >> 4, q = tid & 15;
          if (t < nb) {
            const int row = row0 + t0 + t;
            const f32x4 yv = *(const LAS f32x4*)(ybuf + t * 64 + 4 * q);
            float s = (yv[0] + yv[1]) + (yv[2] + yv[3]);
            s += __shfl_xor(s, 1); s += __shfl_xor(s, 2); s += __shfl_xor(s, 4); s += __shfl_xor(s, 8);
            const float mean = s * (1.f / 64.f); const f32x4 d = yv - mean;
            float s2 = (d[0] * d[0] + d[1] * d[1]) + (d[2] * d[2] + d[3] * d[3]);
            s2 += __shfl_xor(s2, 1); s2 += __shfl_xor(s2, 2); s2 += __shfl_xor(s2, 4); s2 += __shfl_xor(s2, 8);
            const float rstd = rsqrtf(s2 * (1.f / 64.f) + 64e-5f), bon = BON[row * 8 + h];
            const int cbase = h * 64 + 4 * q;
            const f32x4 gw = *(const f32x4*)(A.in[I_GNW] + cbase), gb = *(const f32x4*)(A.in[I_GNB] + cbase), gv = *(const f32x4*)(aG + (size_t)row * 512 + cbase);
            const f32x4 vv = *(const LAS f32x4*)(vec + (3 * TB + t) * 64 + 4 * q);
            const f32x4 o = (d * rstd * gw + gb + bon * vv) * gv;
            v2u w; w.x = pk2(o[0], o[1]); w.y = pk2(o[2], o[3]);
            *(v2u*)(RW + (size_t)row * 512 + cbase) = w;
          }
        }
        __syncthreads();
    }
    *(f32x4*)sout = (f32x4){S[0], S[1], S[2], S[3]}; *(f32x4*)(sout + 4) = (f32x4){S[4], S[5], S[6], S[7]};
}

constexpr int DP_STRIDE = 260;
__device__ __forceinline__ float half_sum32(float v) { v += __shfl_xor(v, 1); v += __shfl_xor(v, 2); v += __shfl_xor(v, 4); v += __shfl_xor(v, 8); v += __shfl_xor(v, 16); return v; }
__device__ __forceinline__ void decode_unit(Frame& F, const Args& A, int unit) {
    const int seq = unit >> 5, h = (unit >> 3) & 3, g = unit & 7, lane = F.lane, w = F.wave;
    const bf16* QB = (const bf16*)(F.ws + WS_QB);
    const unsigned qw = *(const unsigned*)(QB + (size_t)(MP + seq) * 512 + h * 128 + 2 * lane);
    const float q0 = bflo(qw), q1 = bfhi(qw);
    const float slope = exp2f(-2.f * (float)(h + 1)) * 1.4426950408889634f;
    const int pi = g * 8 + w, page = ((const int*)A.in[I_PT])[seq * NPAGES + pi];
    const float* kp = A.in[I_CK] + ((size_t)page * PAGE * 4 + h) * 128 + 2 * lane;
    const float* vp = A.in[I_CV] + ((size_t)page * PAGE * 4 + h) * 128 + 2 * lane;
    float m0 = -INFINITY, l0 = 0.f, m1 = -INFINITY, l1 = 0.f; f32x2 o0 = {0.f, 0.f}, o1 = {0.f, 0.f};
    for (int p0 = 0; p0 < PAGE; p0 += 8) {
        f32x2 kv[8], vv[8];
#pragma unroll
        for (int j = 0; j < 8; ++j) { kv[j] = *(const f32x2*)(kp + (size_t)(p0 + j) * 512); vv[j] = *(const f32x2*)(vp + (size_t)(p0 + j) * 512); }
        float s0[8], s1[8], mx0 = m0, mx1 = m1;
#pragma unroll
        for (int j = 0; j < 8; ++j) {
            float s = half_sum32(kv[j].x * q0 + kv[j].y * q1) + slope * (float)(pi * PAGE + p0 + j - PAST);
            const float o = __shfl_xor(s, 32);
            s0[j] = lane < 32 ? s : o; s1[j] = lane < 32 ? o : s;
            mx0 = fmaxf(mx0, s0[j]); mx1 = fmaxf(mx1, s1[j]);
        }
        const float a0 = exp2f(m0 - mx0), a1 = exp2f(m1 - mx1);
        l0 *= a0; l1 *= a1; o0 *= a0; o1 *= a1; m0 = mx0; m1 = mx1;
#pragma unroll
        for (int j = 0; j < 8; ++j) { const float e0 = exp2f(s0[j] - m0), e1 = exp2f(s1[j] - m1); l0 += e0; l1 += e1; o0 += e0 * vv[j]; o1 += e1 * vv[j]; }
    }
    LAS float* red = (LAS float*)(F.lds + RING_OFF);
    __syncthreads();
    if (lane == 0) { red[w * DP_STRIDE + 0] = m0; red[w * DP_STRIDE + 1] = l0; red[w * DP_STRIDE + 2] = m1; red[w * DP_STRIDE + 3] = l1; }
    red[w * DP_STRIDE + 4 + 2 * lane] = o0.x; red[w * DP_STRIDE + 5 + 2 * lane] = o0.y; red[w * DP_STRIDE + 132 + 2 * lane] = o1.x; red[w * DP_STRIDE + 133 + 2 * lane] = o1.y;
    __syncthreads();
    if (w == 0) {
        float M0 = -INFINITY, M1 = -INFINITY;
#pragma unroll
        for (int j = 0; j < 8; ++j) { M0 = fmaxf(M0, red[j * DP_STRIDE + 0]); M1 = fmaxf(M1, red[j * DP_STRIDE + 2]); }
        float L0 = 0.f, L1 = 0.f; f32x2 a = {0.f, 0.f}, b = {0.f, 0.f};
#pragma unroll
        for (int j = 0; j < 8; ++j) { const float f0 = exp2f(red[j * DP_STRIDE + 0] - M0), f1 = exp2f(red[j * DP_STRIDE + 2] - M1);
            L0 += f0 * red[j * DP_STRIDE + 1]; L1 += f1 * red[j * DP_STRIDE + 3];
            a.x += f0 * red[j * DP_STRIDE + 4 + 2 * lane]; a.y += f0 * red[j * DP_STRIDE + 5 + 2 * lane]; b.x += f1 * red[j * DP_STRIDE + 132 + 2 * lane]; b.y += f1 * red[j * DP_STRIDE + 133 + 2 * lane]; }
        float* dp = (float*)(F.ws + WS_DP) + (size_t)unit * DP_STRIDE;
        if (lane == 0) { dp[0] = M0; dp[1] = L0; dp[2] = M1; dp[3] = L1; }
        dp[4 + 2 * lane] = a.x; dp[5 + 2 * lane] = a.y; dp[132 + 2 * lane] = b.x; dp[133 + 2 * lane] = b.y;
    }
    __syncthreads();
}
__device__ __forceinline__ void decode_combine(Frame& F, const Args& A, int sh, float lam) {
    const int seq = sh >> 2, h = sh & 3, lane = F.lane; const size_t ro = (size_t)(MP + seq) * 512 + h * 128 + 2 * lane;
    const unsigned qw = *(const unsigned*)((const bf16*)(F.ws + WS_QB) + ro), kw = *(const unsigned*)((const bf16*)(F.ws + WS_KB) + ro), vw = *(const unsigned*)((const bf16*)(F.ws + WS_VB) + ro);
    const float s = half_sum32(bflo(qw) * bflo(kw) + bfhi(qw) * bfhi(kw)), so = __shfl_xor(s, 32);
    const float sn0 = lane < 32 ? s : so, sn1 = lane < 32 ? so : s;
    const float* dp = (const float*)(F.ws + WS_DP) + (size_t)(sh * 8) * DP_STRIDE;
    float M0 = sn0, M1 = sn1;
#pragma unroll
    for (int j = 0; j < 8; ++j) { M0 = fmaxf(M0, dp[j * DP_STRIDE + 0]); M1 = fmaxf(M1, dp[j * DP_STRIDE + 2]); }
    const float e0 = exp2f(sn0 - M0), e1 = exp2f(sn1 - M1);
    float L0 = e0, L1 = e1; f32x2 a = {e0 * bflo(vw), e0 * bfhi(vw)}, b = {e1 * bflo(vw), e1 * bfhi(vw)};
#pragma unroll
    for (int j = 0; j < 8; ++j) { const float f0 = exp2f(dp[j * DP_STRIDE + 0] - M0), f1 = exp2f(dp[j * DP_STRIDE + 2] - M1);
        L0 += f0 * dp[j * DP_STRIDE + 1]; L1 += f1 * dp[j * DP_STRIDE + 3];
        a.x += f0 * dp[j * DP_STRIDE + 4 + 2 * lane]; a.y += f0 * dp[j * DP_STRIDE + 5 + 2 * lane]; b.x += f1 * dp[j * DP_STRIDE + 132 + 2 * lane]; b.y += f1 * dp[j * DP_STRIDE + 133 + 2 * lane]; }
    const float i0 = 1.f / L0, i1 = 1.f / L1;
    const float ox = a.x * i0 - lam * b.x * i1, oy = a.y * i0 - lam * b.y * i1;
    const float rn = rsqrtf(wave_sum(ox * ox + oy * oy) * (1.f / 128.f) + 1e-6f) * 0.8f;
    const float* aog = A.in[I_AOG];
    *(unsigned*)((bf16*)(F.ws + WS_ON) + ro) = pk2(ox * rn * aog[2 * lane], oy * rn * aog[2 * lane + 1]);
}

__device__ __forceinline__ void attn_naive_row(Frame& F, const Args& A, int row, int h, float lam) {
    const int lane = F.lane, t = row & (SEQ - 1), rb = row - t;
    const bf16* QB = (const bf16*)(F.ws + WS_QB); const bf16* KB = (const bf16*)(F.ws + WS_KB); const bf16* VB = (const bf16*)(F.ws + WS_VB);
    const float slope = exp2f(-2.f * (float)(h + 1)) * 1.4426950408889634f;
    float res[2][2];
    for (int c = 0; c < 2; ++c) {
        float q[64];
#pragma unroll
        for (int d = 0; d < 64; d += 2) { const unsigned w = *(const unsigned*)(QB + (size_t)row * 512 + h * 128 + c * 64 + d); q[d] = bflo(w); q[d + 1] = bfhi(w); }
        float m = -INFINITY, l = 0.f, o[128];
#pragma unroll
        for (int d = 0; d < 128; ++d) o[d] = 0.f;
        for (int j = lane; j <= t; j += 64) {
            const bf16* kr = KB + (size_t)(rb + j) * 512 + h * 128 + c * 64; const bf16* vr = VB + (size_t)(rb + j) * 512 + h * 128;
            float s = 0.f;
#pragma unroll
            for (int d = 0; d < 64; d += 8) { const v4u w = *(const v4u*)(kr + d);
                s += q[d] * bflo(w.x) + q[d + 1] * bfhi(w.x) + q[d + 2] * bflo(w.y) + q[d + 3] * bfhi(w.y) + q[d + 4] * bflo(w.z) + q[d + 5] * bfhi(w.z) + q[d + 6] * bflo(w.w) + q[d + 7] * bfhi(w.w); }
            s += slope * (float)(j - t);
            const float mn = fmaxf(m, s), al = exp2f(m - mn), e = exp2f(s - mn);
            l = l * al + e; m = mn;
#pragma unroll
            for (int d = 0; d < 128; d += 8) { const v4u w = *(const v4u*)(vr + d);
                o[d] = o[d] * al + e * bflo(w.x); o[d + 1] = o[d + 1] * al + e * bfhi(w.x); o[d + 2] = o[d + 2] * al + e * bflo(w.y); o[d + 3] = o[d + 3] * al + e * bfhi(w.y);
                o[d + 4] = o[d + 4] * al + e * bflo(w.z); o[d + 5] = o[d + 5] * al + e * bfhi(w.z); o[d + 6] = o[d + 6] * al + e * bflo(w.w); o[d + 7] = o[d + 7] * al + e * bfhi(w.w); }
        }
        float M = m;
#pragma unroll
        for (int x = 1; x < 64; x <<= 1) M = fmaxf(M, __shfl_xor(M, x));
        const float sc = exp2f(m - M);
        const float L = wave_sum(l * sc);
        float r0 = 0.f, r1 = 0.f;
#pragma unroll
        for (int d = 0; d < 128; ++d) { const float tot = wave_sum(o[d] * sc); if ((d & 63) == lane) { if (d < 64) r0 = tot; else r1 = tot; } }
        res[c][0] = r0 / L; res[c][1] = r1 / L;
    }
    const float ox = res[0][0] - lam * res[1][0], oy = res[0][1] - lam * res[1][1];
    const float rn = rsqrtf(wave_sum(ox * ox + oy * oy) * (1.f / 128.f) + 1e-6f) * 0.8f;
    const float* aog = A.in[I_AOG]; bf16* ON = (bf16*)(F.ws + WS_ON) + (size_t)row * 512 + h * 128;
    ON[lane] = (bf16)(pk2(ox * rn * aog[lane], 0.f) & 0xffffu); ON[64 + lane] = (bf16)(pk2(oy * rn * aog[64 + lane], 0.f) & 0xffffu);
}

__device__ __forceinline__ int crow16(int r, int hi) { return (r & 3) + 8 * (r >> 2) + 4 * hi; }

typedef short v4i16_t __attribute__((ext_vector_type(4)));
__device__ __forceinline__ s16x4 vtr(const LAS unsigned char* p) { return __builtin_bit_cast(s16x4, __builtin_amdgcn_ds_read_tr16_b64_v4i16((LAS v4i16_t*)p)); }
__device__ __forceinline__ unsigned bfbits(float f) { return __builtin_bit_cast(unsigned, f) >> 16; }
__device__ __forceinline__ void attn_unit(Frame& F, const Args& A, int b, int h, int qb, float lam) {
    LAS unsigned char* Kt = F.lds + RING_OFF; LAS unsigned char* Vt = Kt + 16384;
    LAS float* wsf = (LAS float*)(Kt + 32768) + F.wave * 64;
    LAS float* xch = (LAS float*)(Kt + 32768 + 2048);
    const bf16* QB = (const bf16*)(F.ws + WS_QB); const bf16* KB = (const bf16*)(F.ws + WS_KB); const bf16* VB = (const bf16*)(F.ws + WS_VB);
    const int tid = F.tid, lane = F.lane, w = F.wave, c = w >> 2, wq = w & 3, r32 = lane & 31, hi = lane >> 5;
    const int rowbase = b * SEQ, q0 = 128 * qb + 32 * wq, NT = 2 * (qb + 1);
    bf16x8 qr[4];
    { const bf16* Qp = QB + (size_t)(rowbase + q0 + r32) * 512 + (2 * h + c) * 64 + 8 * hi;
#pragma unroll
      for (int d0 = 0; d0 < 4; ++d0) qr[d0] = *(const bf16x8*)(Qp + 16 * d0); }
    const float sl = exp2f(-2.f * (float)(h + 1)) * 1.4426950408889634f;
    const unsigned c1 = __builtin_bit_cast(unsigned, sl) & 0xffff0000u; const float r1 = sl - __builtin_bit_cast(float, c1);
    const unsigned c2 = __builtin_bit_cast(unsigned, r1) & 0xffff0000u; const float r2 = r1 - __builtin_bit_cast(float, c2);
    const unsigned c3 = __builtin_bit_cast(unsigned, r2) & 0xffff0000u;
    const unsigned b1 = c1 >> 16, b2 = c2 >> 16, b3 = c3 >> 16, lo_mask = hi ? 0u : 0xffffffffu;
    const v4u qextu = {(b1 | (b2 << 16)) & lo_mask, (b3 | (b1 << 16)) & lo_mask, (b2 | (b3 << 16)) & lo_mask, 0u};
    const bf16x8 qext = __builtin_bit_cast(bf16x8, qextu);
    const unsigned J0 = bfbits((float)r32), J1 = bfbits((float)(32 + r32));
    const bf16* kg0 = KB + (size_t)(rowbase + (tid & 63)) * 512 + h * 128 + (tid >> 6) * 8;
    const bf16* vg0 = VB + (size_t)(rowbase + (tid >> 4)) * 512 + h * 128 + (tid & 15) * 8;
    const int kl0 = (tid >> 6) * 1024 + (tid & 63) * 16, kl1 = kl0 + 8192;
    const int vch = tid & 15, vkv = tid >> 4;
    const int vl0 = (vch >> 2) * 4096 + (vkv >> 3) * 512 + (vkv & 7) * 64 + (vch & 3) * 16, vl1 = vl0 + 4 * 512;
    v4u sk0, sk1, sv0, sv1;
    sk0 = *(const v4u*)kg0; sk1 = *(const v4u*)(kg0 + 64); sv0 = *(const v4u*)vg0; sv1 = *(const v4u*)(vg0 + (size_t)32 * 512);
    f32x16 o[4];
#pragma unroll
    for (int i = 0; i < 4; ++i) o[i] = (f32x16){};
    float m = -INFINITY, l = 0.f;
    const LAS unsigned char* kfp = Kt + (c * 8 + hi) * 1024 + r32 * 16;
    const LAS unsigned char* vfp = Vt + ((lane >> 4) & 1) * 32 + (lane & 3) * 8 + (4 * hi + ((lane & 15) >> 2)) * 64;
    for (int t = 0; t < NT; ++t) {
        __syncthreads();
        *(LAS v4u*)(Kt + kl0) = sk0; *(LAS v4u*)(Kt + kl1) = sk1; *(LAS v4u*)(Vt + vl0) = sv0; *(LAS v4u*)(Vt + vl1) = sv1;
        __syncthreads();
        if (t + 1 < NT) { const size_t go = (size_t)(t + 1) * 64 * 512;
            sk0 = *(const v4u*)(kg0 + go); sk1 = *(const v4u*)(kg0 + go + 64); sv0 = *(const v4u*)(vg0 + go); sv1 = *(const v4u*)(vg0 + go + (size_t)32 * 512); }
        if (64 * t > q0 + 31) continue;
        const unsigned Tb = bfbits((float)(64 * t - 128 * qb));
        f32x16 p[2];
#pragma unroll
        for (int half = 0; half < 2; ++half) {
            f32x16 acc = (f32x16){};
#pragma unroll
            for (int d0 = 0; d0 < 4; ++d0) { const bf16x8 kf = *(const LAS bf16x8*)(kfp + d0 * 2048 + half * 512); acc = __builtin_amdgcn_mfma_f32_32x32x16_bf16(kf, qr[d0], acc, 0, 0, 0); }
            const unsigned Jb = half ? J1 : J0;
            const v4u ke = {(Tb | (Tb << 16)) & lo_mask, (Tb | (Jb << 16)) & lo_mask, (Jb | (Jb << 16)) & lo_mask, 0u};
            p[half] = __builtin_amdgcn_mfma_f32_32x32x16_bf16(__builtin_bit_cast(bf16x8, ke), qext, acc, 0, 0, 0);
        }
        if (64 * t + 63 > q0) {
            const int qpos = q0 + r32;
#pragma unroll
            for (int half = 0; half < 2; ++half)
#pragma unroll
                for (int r = 0; r < 16; ++r) { const int kv = 64 * t + 32 * half + crow16(r, hi); if (kv > qpos) p[half][r] = -INFINITY; }
        }
        float mx = p[0][0];
#pragma unroll
        for (int r = 1; r < 16; ++r) mx = fmaxf(mx, p[0][r]);
#pragma unroll
        for (int r = 0; r < 16; ++r) mx = fmaxf(mx, p[1][r]);
        mx = fmaxf(mx, __shfl_xor(mx, 32));
        const float mn = fmaxf(m, mx), alpha = __builtin_amdgcn_exp2f(m - mn);
        m = mn;
        float ls = 0.f;
#pragma unroll
        for (int half = 0; half < 2; ++half)
#pragma unroll
            for (int r = 0; r < 16; ++r) { const float e = __builtin_amdgcn_exp2f(p[half][r] - mn); p[half][r] = e; ls += e; }
        ls += __shfl_xor(ls, 32);
        l = l * alpha + ls;
        if (__any(alpha != 1.f)) {
            if (hi == 0) wsf[r32] = alpha;
            LDS_WAIT();
#pragma unroll
            for (int r = 0; r < 16; ++r) { const float f = wsf[crow16(r, hi)];
#pragma unroll
                for (int blk = 0; blk < 4; ++blk) o[blk][r] *= f; }
        }
        bf16x8 pa[4];
#pragma unroll
        for (int s = 0; s < 4; ++s) { const int hf = s >> 1, rb = 8 * (s & 1);
            const v4u u = {pk2(p[hf][rb], p[hf][rb + 1]), pk2(p[hf][rb + 2], p[hf][rb + 3]), pk2(p[hf][rb + 4], p[hf][rb + 5]), pk2(p[hf][rb + 6], p[hf][rb + 7])};
            pa[s] = __builtin_bit_cast(bf16x8, u); }
#pragma unroll
        for (int blk = 0; blk < 4; ++blk)
#pragma unroll
            for (int s = 0; s < 4; ++s) {
                const s16x4 lo = vtr(vfp + blk * 4096 + s * 1024), hh = vtr(vfp + blk * 4096 + s * 1024 + 512);
                const bf16x8 vf = {lo[0], lo[1], lo[2], lo[3], hh[0], hh[1], hh[2], hh[3]};
                o[blk] = __builtin_amdgcn_mfma_f32_32x32x16_bf16(pa[s], vf, o[blk], 0, 0, 0);
            }
    }
    if (hi == 0) wsf[r32] = 1.f / l;
    LDS_WAIT();
#pragma unroll
    for (int r = 0; r < 16; ++r) { const float f = wsf[crow16(r, hi)];
#pragma unroll
        for (int blk = 0; blk < 4; ++blk) o[blk][r] *= f; }
    LAS float* xw = xch + wq * 4096;
    if (c == 1) {
#pragma unroll
        for (int blk = 0; blk < 4; ++blk)
#pragma unroll
            for (int r = 0; r < 16; ++r) xw[(blk * 16 + r) * 64 + lane] = o[blk][r];
    }
    __syncthreads();
    if (c == 0) {
        const float* aog = A.in[I_AOG]; bf16* ON = (bf16*)(F.ws + WS_ON);
        float g[4];
#pragma unroll
        for (int blk = 0; blk < 4; ++blk) g[blk] = aog[32 * blk + r32] * 0.8f;
#pragma unroll
        for (int r = 0; r < 16; ++r) {
            float v[4], ss = 0.f;
#pragma unroll
            for (int blk = 0; blk < 4; ++blk) { v[blk] = o[blk][r] - lam * xw[(blk * 16 + r) * 64 + lane]; ss += v[blk] * v[blk]; }
            ss += __shfl_xor(ss, 1); ss += __shfl_xor(ss, 2); ss += __shfl_xor(ss, 4); ss += __shfl_xor(ss, 8); ss += __shfl_xor(ss, 16);
            const float rn = rsqrtf(ss * (1.f / 128.f) + 1e-6f);
            bf16* op = ON + (size_t)(rowbase + q0 + crow16(r, hi)) * 512 + h * 128 + r32;
#pragma unroll
            for (int blk = 0; blk < 4; ++blk) op[32 * blk] = (bf16)(pk2(v[blk] * rn * g[blk], 0.f) & 0xffffu);
        }
    }
    __syncthreads();
}

__device__ __forceinline__ void skinny_tile(Frame& F, LAS float* red, const bf16* A, int lda, const bf16* Bt, int K, int n0) {
    const int lane = F.lane, r = lane & 31, hi = lane >> 5, w = F.wave, kw = K / 8;
    const bf16* ap = A + (size_t)r * lda + w * kw + 8 * hi; const bf16* bp = Bt + (size_t)(n0 + r) * K + w * kw + 8 * hi;
    f32x16 acc = {};
    for (int k = 0; k < kw; k += 16) { const bf16x8 a = *(const bf16x8*)(ap + k), b = *(const bf16x8*)(bp + k); acc = __builtin_amdgcn_mfma_f32_32x32x16_bf16(a, b, acc, 0, 0, 0); }
    __syncthreads();
#pragma unroll
    for (int i = 0; i < 16; ++i) red[w * 1024 + i * 64 + lane] = acc[i];
    __syncthreads();
    for (int e = F.tid; e < 1024; e += 512) { float s = 0.f;
#pragma unroll
        for (int j = 0; j < 8; ++j) s += red[j * 1024 + e];
        red[8 * 1024 + e] = s; }
    __syncthreads();
}

#ifndef MK_N_LAUNCHES
#define MK_N_LAUNCHES 1
#endif
#ifndef MK_NAIVE_ATTN
#define MK_NAIVE_ATTN 0
#endif
constexpr int N_PHASES = 8;
__global__ void __launch_bounds__(NWAVES * 64, 2) mk_fwd(Args args) {
    extern __shared__ __attribute__((aligned(16))) unsigned char lds[];
    Frame F;
    F.lds = (LAS unsigned char*)lds;
    F.MISC = (volatile LAS unsigned*)(F.lds + MISC_OFF);
    F.tid = threadIdx.x; F.lane = F.tid & 63; F.wave = __builtin_amdgcn_readfirstlane(F.tid >> 6);
    F.G = gridDim.x; { const int bx = blockIdx.x; F.vcu = (F.G % 8 == 0) ? (bx % 8) * (F.G / 8) + bx / 8 : bx; }
    F.ws = args.ws; F.out = args.out; F.ctl = (gu32*)(args.ws + WS_CTL);
    const Args& A = args;
    for (int u = F.tid; u < (LDS_BYTES - LDSCTL_OFF) / 4; u += NWAVES * 64) ((LAS unsigned*)(F.lds + LDSCTL_OFF))[u] = 0u;
    __syncthreads();
    XcdBarrier bar; bar.bar = (unsigned*)(F.ctl + CW_BAR); bar.x = 0; bar.st = nullptr;
    if (MK_N_LAUNCHES == 1) bar = xcd_barrier_post((unsigned*)(F.ctl + CW_BAR), F.MISC + 8);
#define GRID_BAR() do { if (MK_N_LAUNCHES == 1) xcd_barrier(bar); } while (0)
    const int lo = args.ph_lo, hi = args.ph_hi;
#ifndef MK_DBG_STOP
#define MK_DBG_STOP 99
#endif
#define IN(k) (lo <= (k) && (k) < hi && (k) <= MK_DBG_STOP)
#define BOTH(k) (IN(k) && IN((k) + 1))
    bf16* XB = (bf16*)(F.ws + WS_XB); float* rs0 = (float*)(F.ws + WS_RS0);
    bf16* QB = (bf16*)(F.ws + WS_QB); bf16* KB = (bf16*)(F.ws + WS_KB); bf16* VB = (bf16*)(F.ws + WS_VB); bf16* PC = (bf16*)(F.ws + WS_PC); bf16* GT = (bf16*)(F.ws + WS_GT);
    bf16* ON = (bf16*)(F.ws + WS_ON); bf16* RW = (bf16*)(F.ws + WS_RW); bf16* MG = (bf16*)(F.ws + WS_MG); bf16* X1B = (bf16*)(F.ws + WS_X1B); bf16* HB = (bf16*)(F.ws + WS_HB);
    float* ssq = (float*)(F.ctl + CW_SSQ);
    const int bx = (int)blockIdx.x;

    if (IN(0)) { for (int i = bx * 512 + F.tid; i < MTOT; i += F.G * 512) ssq[i] = 0.f;
        p0_prologue(F, A); if (BOTH(0)) GRID_BAR(); }
    if (IN(1)) {
        pg8::Gemm g{XB, (const bf16*)(F.ws + WS_WIN), nullptr, nullptr, MTOT, INW, DM}; pg8::StaticOrder S; S.init(MTOT, INW, F.G, bx);
        pg8::EpiProj E{rs0, A.in[I_QG], A.in[I_KG], QB, KB, VB, PC, GT, F.out};
        pg8::gemm_phase<pg8::EpiProj, pg8::StaticOrder, true, true>(F.lds + RING_OFF, g, S, E);
        if (BOTH(1)) GRID_BAR();
    }
    if (IN(2)) {
        for (int u = bx; u < 1024; u += F.G) decode_unit(F, A, u);
        for (int u = bx; u < MVALID / 8; u += F.G) rwkv_prep_unit(F, A, u);
        if (BOTH(2)) GRID_BAR();
    }
    if (IN(3)) {
        if (bx < 32) scan_unit(F, A, bx);
        else {
            const int nb = F.G - 32, b2 = bx - 32;
            for (int u = 32 + b2; u < 32 + 256; u += nb) scan_unit(F, A, u);
            const float lam = lam_value(F, A);
            const int gw = b2 * NWAVES + F.wave, NGW = nb * NWAVES;
            for (int it = gw; it < 128; it += NGW) decode_combine(F, A, it, lam);
#if !MK_NAIVE_ATTN
            for (int u = b2; u < 512; u += nb) attn_unit(F, A, (u & 15) >> 2, u & 3, 31 - (u >> 4), lam);
#endif
        }
        if (BOTH(3)) GRID_BAR();
    }
#if MK_DBG_STOP < 7
    if (lo <= 7 && 7 < hi) {
        const size_t gt = (size_t)bx * 512 + F.tid, GT_ = (size_t)F.G * 512, NY = O_KP - O_YP;
        for (size_t i = gt; i < NY; i += GT_) {
            float v = 0.f;
#if MK_DBG_STOP == 4
            if (i < (size_t)MVALID * 1024) v = bf2f(MG[i]);
#endif
#if MK_DBG_STOP == 1
            if (i < (size_t)8000 * 2048) v = bf2f(GT[i]);
#endif
#if MK_DBG_STOP == 3
            if (i < (size_t)8000 * 2048) v = bf2f(GT[i]);
#endif
            F.out[O_YP + i] = v;
        }
    }
#endif
    if (IN(4)) {
        if (bx < 32) {
            LAS float* red = (LAS float*)(F.lds + RING_OFF); const int n0 = 32 * bx; float t1[2];
            skinny_tile(F, red, ON + (size_t)MP * 512, 512, (const bf16*)(F.ws + WS_WPA), 512, n0);
            t1[0] = red[8192 + F.tid]; t1[1] = red[8192 + 512 + F.tid];
            skinny_tile(F, red, RW + (size_t)MP * 512, 512, (const bf16*)(F.ws + WS_WPB), 512, n0);
#pragma unroll
            for (int i = 0; i < 2; ++i) { const int e = F.tid + 512 * i, reg = e >> 6, ln = e & 63, row = crow16(reg, ln >> 5), col = n0 + (ln & 31);
                const float g1 = bf2f(GT[(size_t)(MP + row) * 2048 + col]), g2 = bf2f(GT[(size_t)(MP + row) * 2048 + 1024 + col]);
                MG[(size_t)(MP + row) * 1024 + col] = (bf16)(pk2(g1 * t1[i] + g2 * red[8192 + e], 0.f) & 0xffffu); }
            __syncthreads();
        }
        pg8::Gemm g{ON, (const bf16*)(F.ws + WS_WPA), RW, (const bf16*)(F.ws + WS_WPB), MP, DM, 512}; pg8::PairOrder S; S.base.init(MP, DM, F.G, bx);
        pg8::EpiMerge E{GT, (float*)(F.ws + WS_TMP), MG};
        pg8::gemm_phase<pg8::EpiMerge, pg8::PairOrder, true, true>(F.lds + RING_OFF, g, S, E);
        if (BOTH(4)) GRID_BAR();
    }
    if (IN(5)) {
        if (bx < 32) {
            LAS float* red = (LAS float*)(F.lds + RING_OFF); const int n0 = 32 * bx;
            skinny_tile(F, red, MG + (size_t)MP * 1024, 1024, (const bf16*)(F.ws + WS_WOUT), 1024, n0);
#pragma unroll
            for (int i = 0; i < 2; ++i) { const int e = F.tid + 512 * i, reg = e >> 6, ln = e & 63, row = crow16(reg, ln >> 5), col = n0 + (ln & 31);
                const float v = A.in[I_XS][(size_t)row * 1024 + col] + red[8192 + e];
                F.out[O_YS + (size_t)row * 1024 + col] = v; X1B[(size_t)(MP + row) * 1024 + col] = (bf16)(pk2(v, 0.f) & 0xffffu);
                float ss = v * v; ss += __shfl_xor(ss, 1); ss += __shfl_xor(ss, 2); ss += __shfl_xor(ss, 4); ss += __shfl_xor(ss, 8); ss += __shfl_xor(ss, 16);
                if ((ln & 31) == 0) atomicAdd(ssq + MP + row, ss); }
            __syncthreads();
        }
        pg8::Gemm g{MG, (const bf16*)(F.ws + WS_WOUT), nullptr, nullptr, MP, DM, DM}; pg8::StaticOrder S; S.init(MP, DM, F.G, bx);
        pg8::EpiOut E{A.in[I_XP], F.out + O_YP, X1B, ssq};
        pg8::gemm_phase<pg8::EpiOut, pg8::StaticOrder, false, true>(F.lds + RING_OFF, g, S, E);
        if (BOTH(5)) GRID_BAR();
    }
    if (IN(6)) {
        pg8::Gemm g{X1B, (const bf16*)(F.ws + WS_WGU), nullptr, nullptr, MTOT, NGU, DM}; pg8::StaticOrder S; S.init(MTOT, NGU, F.G, bx);
        pg8::EpiGateUp E{ssq, HB};
        pg8::gemm_phase<pg8::EpiGateUp, pg8::StaticOrder, true, true>(F.lds + RING_OFF, g, S, E);
        if (BOTH(6)) GRID_BAR();
    }
    if (IN(7)) {
        if (bx < 32) {
            LAS float* red = (LAS float*)(F.lds + RING_OFF); const int n0 = 32 * bx;
            skinny_tile(F, red, HB + (size_t)MP * FF, FF, (const bf16*)(F.ws + WS_WDN), FF, n0);
#pragma unroll
            for (int i = 0; i < 2; ++i) { const int e = F.tid + 512 * i, reg = e >> 6, ln = e & 63, row = crow16(reg, ln >> 5), col = n0 + (ln & 31);
                F.out[O_YS + (size_t)row * 1024 + col] += red[8192 + e]; }
            __syncthreads();
        }
        pg8::Gemm g{HB, (const bf16*)(F.ws + WS_WDN), nullptr, nullptr, MP, DM, FF}; pg8::StaticOrder S; S.init(MP, DM, F.G, bx);
        pg8::EpiDown E{F.out + O_YP};
        pg8::gemm_phase<pg8::EpiDown, pg8::StaticOrder, false, true>(F.lds + RING_OFF, g, S, E);
    }
#undef IN
#undef BOTH
}

#if MK_NAIVE_ATTN
__global__ void __launch_bounds__(512, 2) attn_naive_kernel(Args args) {
    Frame F; F.tid = threadIdx.x; F.lane = F.tid & 63; F.wave = __builtin_amdgcn_readfirstlane(F.tid >> 6); F.G = gridDim.x; F.ws = args.ws; F.out = args.out;
    const Args& A = args;
    const float lam = lam_value(F, A);
    const int gw = (int)blockIdx.x * NWAVES + F.wave, NGW = F.G * NWAVES;
    for (int it = gw; it < MP * 4; it += NGW) attn_naive_row(F, A, it >> 2, it & 3, lam);
}
#endif
extern "C" void kernel_launch(void* const* d_in, const int* in_sizes, int n_in, void* d_out, int out_size, void* d_ws, size_t ws_size, hipStream_t stream) {
    static int grid = 0;
    if (grid == 0) {
        if (n_in != 34 || out_size != (int)O_END || ws_size < WS_END) { fprintf(stderr, "kernel_launch: unexpected shapes: n_in %d out %d ws %zu\n", n_in, out_size, ws_size); grid = -1; return; }
        int dev = 0, cus = 0, per_cu = 0;
        if (hipGetDevice(&dev) != hipSuccess || hipDeviceGetAttribute(&cus, hipDeviceAttributeMultiprocessorCount, dev) != hipSuccess) { grid = -1; return; }
        if (hipFuncSetAttribute((const void*)mk_fwd, hipFuncAttributeMaxDynamicSharedMemorySize, LDS_BYTES) != hipSuccess) { fprintf(stderr, "kernel_launch: hipFuncSetAttribute failed\n"); grid = -1; return; }
        if (hipOccupancyMaxActiveBlocksPerMultiprocessor(&per_cu, (const void*)mk_fwd, NWAVES * 64, LDS_BYTES) != hipSuccess || per_cu < 1) fprintf(stderr, "kernel_launch: occupancy query says %d\n", per_cu);
        (void)hipGetLastError();
        grid = cus;
    }
    if (grid < 0) return;
    if (hipMemsetAsync((char*)d_ws + WS_CTL, 0, CTL_ZERO_BYTES, stream) != hipSuccess) return;
    Args a{};
    for (int i = 0; i < 34; ++i) a.in[i] = (const float*)d_in[i];
    a.out = (float*)d_out; a.ws = (unsigned char*)d_ws;
    const int NL = MK_N_LAUNCHES;
    for (int li = 0; li < NL; ++li) {
        a.ph_lo = (NL == 1) ? 0 : li; a.ph_hi = (NL == 1) ? N_PHASES : li + 1; a.li = li; a.pad = 0;
        hipLaunchKernelGGL(mk_fwd, dim3(grid), dim3(NWAVES * 64), LDS_BYTES, stream, a);
        if (hipPeekAtLastError() != hipSuccess) { fprintf(stderr, "kernel_launch: launch %d failed\n", li); break; }
#if MK_NAIVE_ATTN
        if (NL != 1 && li == 3) hipLaunchKernelGGL(attn_naive_kernel, dim3(1024), dim3(512), 0, stream, a);
#endif
    }
}
```

```cpp
#include <hip/hip_runtime.h>
#include <cstdio>
#include <cstdint>

constexpr int MP = 16384, MS = 32, MVALID = MP + MS, MTOT = 16640;
constexpr int DM = 1024, INW = 5376, FF = 2816, NGU = 2 * FF, SEQ = 4096, NBATCH = 4, RSW = 1792;
constexpr int NPAGES = 64, PAGE = 128, PAST = 8192;
constexpr size_t O_YP = 0, O_YS = 16777216, O_KP = O_YS + 32768, O_VP = O_KP + 8388608, O_WP = O_VP + 8388608, O_SP = O_WP + 131072,
                 O_KS = O_SP + 7168, O_VS = O_KS + 16384, O_WS = O_VS + 16384, O_SS = O_WS + 1048576, O_END = O_SS + 57344;
constexpr float QK_C2 = 0.125f * 1.4426950408889634f;
namespace pg8 {
#define PG8_LAS __attribute__((address_space(3)))
typedef unsigned short bf16_t;
typedef short bf16x8 __attribute__((ext_vector_type(8)));
typedef float f32x4 __attribute__((ext_vector_type(4)));
typedef unsigned u32x4 __attribute__((ext_vector_type(4)));
constexpr int BM = 256, BK = 64, HALF = 128, HTB = HALF * BK * 2  , STAGE_BYTES = 8 * HTB, NXCD = 8, WGM = 8;

__host__ __device__ __forceinline__ int lds_byte(int r, int c) { const int st = (r >> 4) * 2 + (c >> 5), rr = r & 15, cc = c & 31, ob = rr * 64 + cc * 2; return st * 1024 + (ob ^ (((ob >> 9) & 1) << 5)); }
__host__ __device__ __forceinline__ void stage_rc(int b, int& R, int& C) { const int st = b / 1024, sb = b % 1024, swz = sb ^ (((sb >> 9) & 1) << 5); R = (st >> 1) * 16 + swz / 64; C = (st & 1) * 32 + (swz % 64) / 2; }
__host__ __device__ __forceinline__ int perm32(int rho) { const int n = rho >> 4, i = rho & 15; return 8 * (i >> 2) + 4 * n + (i & 3); }

struct Unit { int pm, pn, z; };
struct Gemm { const bf16_t* A; const bf16_t* Bt; const bf16_t* A2; const bf16_t* Bt2; int M, N, K; };

struct StaticOrder {
    int nM, nN, nwg, G, c;
    __host__ __device__ void init(int M, int N, int G_, int c_) { nM = M / BM; nN = N / BM; nwg = nM * nN; G = G_; c = c_; }
    __host__ __device__ bool next(int i, Unit& u) const {
        const long L = (long)i * G + c; if (L >= nwg) return false;
        int wgid = (int)L; { const int q = nwg / NXCD, r = nwg % NXCD, xcd = wgid % NXCD, off = wgid / NXCD; wgid = (xcd < r ? xcd * (q + 1) : r * (q + 1) + (xcd - r) * q) + off; }
        const int nig = WGM * nN, gid = wgid / nig, fm = gid * WGM, gsz = (nM - fm) < WGM ? (nM - fm) : WGM;
        u.pm = fm + ((wgid % nig) % gsz); u.pn = (wgid % nig) / gsz; u.z = 0; return true;
    }
    __device__ __forceinline__ void a_ready(const Unit&) const {}
    __device__ __forceinline__ void done(const Unit&) const {}
};

typedef float f32x2_cv __attribute__((ext_vector_type(2))); typedef __bf16 bf16x2_cv __attribute__((ext_vector_type(2)));
__device__ __forceinline__ unsigned cvt_pk_bf16(float lo, float hi) { const f32x2_cv v = {lo, hi}; const bf16x2_cv b = __builtin_convertvector(v, bf16x2_cv); return __builtin_bit_cast(unsigned, b); }
typedef float f32x2 __attribute__((ext_vector_type(2)));
__device__ __forceinline__ void st_bf16x8(bf16_t* p, const f32x4 a, const f32x4 b) {
    u32x4 w; w.x = cvt_pk_bf16(a[0], a[1]); w.y = cvt_pk_bf16(a[2], a[3]); w.z = cvt_pk_bf16(b[0], b[1]); w.w = cvt_pk_bf16(b[2], b[3]); *(u32x4*)p = w;
}
__device__ __forceinline__ float sigmoidf_(float x) { return __builtin_amdgcn_rcpf(1.f + __expf(-x)); }

struct EpiProj {
    static constexpr bool PERM = true, AFTER_DRAIN = false, KEEP_ACC = false;
    const float* rs0; const float* qg; const float* kg;
    bf16_t *QB, *KB, *VB, *PC, *GT; float* out;
    __device__ __forceinline__ void operator()(const f32x4 (&acc)[2][2][4][2], const Unit& u, int wr, int wc, int fr, int fq) const {
        const int pn = u.pn, rb = u.pm * BM + wr * 64 + fr, c8 = 64 * wc + 8 * fq;
        if (pn < 4) {
            const bool isq = pn < 2; const float* gain = isq ? qg : kg;
            f32x4 gv[2][2];
#pragma unroll
            for (int bj = 0; bj < 2; ++bj)
#pragma unroll
                for (int n = 0; n < 2; ++n) gv[bj][n] = *(const f32x4*)(gain + 32 * bj + 8 * fq + 4 * n);
            const int colg = 256 * (pn & 1) + c8;
#pragma unroll
            for (int ai = 0; ai < 2; ++ai)
#pragma unroll
                for (int m = 0; m < 4; ++m) {
                    const int row = rb + ai * HALF + m * 16; const bool ok = row < MVALID; const float rs = rs0[ok ? row : 0];
                    float ss = 0.f;
#pragma unroll
                    for (int bj = 0; bj < 2; ++bj)
#pragma unroll
                        for (int n = 0; n < 2; ++n) { const f32x4 x = acc[ai][bj][m][n] * rs; ss += (x[0] * x[0] + x[1] * x[1]) + (x[2] * x[2] + x[3] * x[3]); }
                    ss += __shfl_xor(ss, 16); ss += __shfl_xor(ss, 32);
                    const float rn = rsqrtf(ss * (1.f / 64.f) + 1e-6f) * rs;
#pragma unroll
                    for (int bj = 0; bj < 2; ++bj) {
                        const f32x4 v0 = acc[ai][bj][m][0] * rn * gv[bj][0], v1 = acc[ai][bj][m][1] * rn * gv[bj][1];
                        const size_t o = (size_t)row * 512 + colg + 32 * bj;
                        if (ok) {
                            if (isq) st_bf16x8(QB + o, v0 * QK_C2, v1 * QK_C2);
                            else { st_bf16x8(KB + o, v0, v1);
                                float* f = row < MP ? out + O_KP + o : out + O_KS + (size_t)(row - MP) * 512 + colg + 32 * bj;
                                *(f32x4*)f = v0; *(f32x4*)(f + 4) = v1; }
                        }
                    }
                }
        } else {
#pragma unroll
            for (int ai = 0; ai < 2; ++ai)
#pragma unroll
                for (int m = 0; m < 4; ++m) {
                    const int row = rb + ai * HALF + m * 16; const bool ok = row < MVALID; const float rs = rs0[ok ? row : 0];
                    if (!ok) continue;
#pragma unroll
                    for (int bj = 0; bj < 2; ++bj) {
                        f32x4 v0 = acc[ai][bj][m][0] * rs, v1 = acc[ai][bj][m][1] * rs;
                        if (pn < 6) {
                            const size_t c = (size_t)(256 * (pn - 4) + c8 + 32 * bj), o = (size_t)row * 512 + c;
                            st_bf16x8(VB + o, v0, v1);
                            float* f = row < MP ? out + O_VP + o : out + O_VS + (size_t)(row - MP) * 512 + c;
                            *(f32x4*)f = v0; *(f32x4*)(f + 4) = v1;
                        } else if (pn < 13) {
                            const size_t c = (size_t)(256 * (pn - 6) + c8 + 32 * bj);
                            st_bf16x8(PC + (size_t)row * RSW + c, v0, v1);
                            if (row >= MP) { float* f = out + O_SS + (size_t)(row - MP) * RSW + c; *(f32x4*)f = v0; *(f32x4*)(f + 4) = v1; }
                            else if ((row & (SEQ - 1)) == SEQ - 1) { float* f = out + O_SP + (size_t)(row >> 12) * RSW + c; *(f32x4*)f = v0; *(f32x4*)(f + 4) = v1; }
                        } else {
                            const size_t c = (size_t)(256 * (pn - 13) + c8 + 32 * bj);
#ifndef MK_DBG_NOSIG
#pragma unroll
                            for (int j = 0; j < 4; ++j) { v0[j] = sigmoidf_(v0[j]); v1[j] = sigmoidf_(v1[j]); }
#endif
                            st_bf16x8(GT + (size_t)row * 2048 + c, v0, v1);
                        }
                    }
                }
        }
    }
};

struct EpiMerge {
    static constexpr bool PERM = true, AFTER_DRAIN = false, KEEP_ACC = true;
    const bf16_t* GT; float* tmp; bf16_t* MG;
    __device__ __forceinline__ void operator()(const f32x4 (&acc_)[2][2][4][2], const Unit& u, int wr, int wc, int fr, int fq) const {
        f32x4 (&acc)[2][2][4][2] = const_cast<f32x4 (&)[2][2][4][2]>(acc_);
        const int rb = u.pm * BM + wr * 64 + fr, cb = u.pn * BM + wc * 32 + 8 * fq;
#pragma unroll
        for (int ai = 0; ai < 2; ++ai)
#pragma unroll
            for (int m = 0; m < 4; ++m) {
                const int row = rb + ai * HALF + m * 16;
#pragma unroll
                for (int bj = 0; bj < 2; ++bj) {
                    const int col = cb + bj * HALF;
                    const u32x4 gw = *(const u32x4*)(GT + (size_t)row * 2048 + 1024 + col);
                    f32x4 g0, g1;
                    g0[0] = __builtin_bit_cast(float, gw.x << 16); g0[1] = __builtin_bit_cast(float, gw.x & 0xffff0000u); g0[2] = __builtin_bit_cast(float, gw.y << 16); g0[3] = __builtin_bit_cast(float, gw.y & 0xffff0000u);
                    g1[0] = __builtin_bit_cast(float, gw.z << 16); g1[1] = __builtin_bit_cast(float, gw.z & 0xffff0000u); g1[2] = __builtin_bit_cast(float, gw.w << 16); g1[3] = __builtin_bit_cast(float, gw.w & 0xffff0000u);
                    if (!u.z) {
                        const u32x4 hw = *(const u32x4*)(GT + (size_t)row * 2048 + col);
                        f32x4 h0, h1;
                        h0[0] = __builtin_bit_cast(float, hw.x << 16); h0[1] = __builtin_bit_cast(float, hw.x & 0xffff0000u); h0[2] = __builtin_bit_cast(float, hw.y << 16); h0[3] = __builtin_bit_cast(float, hw.y & 0xffff0000u);
                        h1[0] = __builtin_bit_cast(float, hw.z << 16); h1[1] = __builtin_bit_cast(float, hw.z & 0xffff0000u); h1[2] = __builtin_bit_cast(float, hw.w << 16); h1[3] = __builtin_bit_cast(float, hw.w & 0xffff0000u);
#pragma unroll
                        for (int e = 0; e < 4; ++e) { acc[ai][bj][m][0][e] *= h0[e] / fmaxf(g0[e], 1e-30f); acc[ai][bj][m][1][e] *= h1[e] / fmaxf(g1[e], 1e-30f); }
                    } else {
                        const f32x4 v0 = acc[ai][bj][m][0] * g0, v1 = acc[ai][bj][m][1] * g1;
                        st_bf16x8(MG + (size_t)row * 1024 + col, v0, v1);
                    }
                }
            }
    }
};
struct EpiOut {
    static constexpr bool PERM = true, AFTER_DRAIN = false, KEEP_ACC = false;
    const bf16_t* xb; bf16_t* X1B; float* ssq;
    __device__ __forceinline__ void operator()(const f32x4 (&acc)[2][2][4][2], const Unit& u, int wr, int wc, int fr, int fq) const {
        const int rb = u.pm * BM + wr * 64 + fr, cb = u.pn * BM + wc * 32 + 8 * fq;
#pragma unroll
        for (int ai = 0; ai < 2; ++ai)
#pragma unroll
            for (int m = 0; m < 4; ++m) {
                const int row = rb + ai * HALF + m * 16; float ss = 0.f;
#pragma unroll
                for (int bj = 0; bj < 2; ++bj) {
                    const size_t o = (size_t)row * 1024 + cb + bj * HALF;
                    const u32x4 xw = *(const u32x4*)(xb + o); f32x4 v0 = acc[ai][bj][m][0], v1 = acc[ai][bj][m][1];
                    v0[0] += __builtin_bit_cast(float, xw.x << 16); v0[1] += __builtin_bit_cast(float, xw.x & 0xffff0000u); v0[2] += __builtin_bit_cast(float, xw.y << 16); v0[3] += __builtin_bit_cast(float, xw.y & 0xffff0000u);
                    v1[0] += __builtin_bit_cast(float, xw.z << 16); v1[1] += __builtin_bit_cast(float, xw.z & 0xffff0000u); v1[2] += __builtin_bit_cast(float, xw.w << 16); v1[3] += __builtin_bit_cast(float, xw.w & 0xffff0000u);
                    st_bf16x8(X1B + o, v0, v1);
                    ss += (v0[0] * v0[0] + v0[1] * v0[1]) + (v0[2] * v0[2] + v0[3] * v0[3]) + (v1[0] * v1[0] + v1[1] * v1[1]) + (v1[2] * v1[2] + v1[3] * v1[3]);
                }
                ss += __shfl_xor(ss, 16); ss += __shfl_xor(ss, 32);
                if (fq == 0) atomicAdd(ssq + row, ss);
            }
    }
};
struct EpiGateUp {
    static constexpr bool PERM = true, AFTER_DRAIN = false, KEEP_ACC = false;
    const float* ssq; bf16_t* HB;
    __device__ __forceinline__ void operator()(const f32x4 (&acc)[2][2][4][2], const Unit& u, int wr, int wc, int fr, int fq) const {
        const int rb = u.pm * BM + wr * 64 + fr, cb = u.pn * HALF + wc * 32 + 8 * fq;
#pragma unroll
        for (int ai = 0; ai < 2; ++ai)
#pragma unroll
            for (int m = 0; m < 4; ++m) {
                const int row = rb + ai * HALF + m * 16; if (row >= MVALID) continue;
                const float rs = rsqrtf(ssq[row] * (1.f / 1024.f) + 1e-6f);
                f32x4 h[2];
#pragma unroll
                for (int n = 0; n < 2; ++n)
#pragma unroll
                    for (int j = 0; j < 4; ++j) { const float g = acc[ai][0][m][n][j] * rs, uu = acc[ai][1][m][n][j] * rs; h[n][j] = g * sigmoidf_(g) * uu; }
                st_bf16x8(HB + (size_t)row * FF + cb, h[0], h[1]);
            }
    }
};
struct EpiDown {
    static constexpr bool PERM = true, AFTER_DRAIN = false, KEEP_ACC = false;
    float* y; const bf16_t* X1B;
    __device__ __forceinline__ void operator()(const f32x4 (&acc)[2][2][4][2], const Unit& u, int wr, int wc, int fr, int fq) const {
        const int rb = u.pm * BM + wr * 64 + fr, cb = u.pn * BM + wc * 32 + 8 * fq;
#pragma unroll
        for (int ai = 0; ai < 2; ++ai)
#pragma unroll
            for (int m = 0; m < 4; ++m) {
                const int row = rb + ai * HALF + m * 16;
#pragma unroll
                for (int bj = 0; bj < 2; ++bj) {
                    float* p = y + (size_t)row * 1024 + cb + bj * HALF; const u32x4 xw = *(const u32x4*)(X1B + (size_t)row * 1024 + cb + bj * HALF);
                    f32x4 v0 = acc[ai][bj][m][0], v1 = acc[ai][bj][m][1];
                    v0[0] += __builtin_bit_cast(float, xw.x << 16); v0[1] += __builtin_bit_cast(float, xw.x & 0xffff0000u); v0[2] += __builtin_bit_cast(float, xw.y << 16); v0[3] += __builtin_bit_cast(float, xw.y & 0xffff0000u);
                    v1[0] += __builtin_bit_cast(float, xw.z << 16); v1[1] += __builtin_bit_cast(float, xw.z & 0xffff0000u); v1[2] += __builtin_bit_cast(float, xw.w << 16); v1[3] += __builtin_bit_cast(float, xw.w & 0xffff0000u);
                    *(f32x4*)p = v0; *(f32x4*)(p + 4) = v1;
                }
            }
    }
};
struct PairOrder {
    StaticOrder base;
    __device__ __forceinline__ bool next(int i, Unit& u) const { if (!base.next(i >> 1, u)) return false; u.z = i & 1; return true; }
    __device__ __forceinline__ void a_ready(const Unit&) const {}
    __device__ __forceinline__ void done(const Unit&) const {}
};

template <class Epi, class Sched, bool ALIGN_EPI = false, bool SP2 = false>
__device__ __forceinline__ void gemm_phase(PG8_LAS unsigned char* lds, const Gemm g, const Sched& S, const Epi& E) {
    const int tid = threadIdx.x, wid = __builtin_amdgcn_readfirstlane(tid >> 6), lane = tid & 63, wr = wid >> 2, wc = wid & 3, fr = lane & 15, fq = lane >> 4;
    const int K = g.K, nt = K / BK;
    unsigned voffA[2], voffB[2];
#pragma unroll
    for (int i = 0; i < 2; ++i) { int R, C; stage_rc(tid * 16 + i * 8192, R, C); const int Rb = Epi::PERM ? ((R & ~31) + perm32(R & 31)) : R;
        voffA[i] = (unsigned)(R * K + C) * 2u; voffB[i] = (unsigned)(Rb * K + C) * 2u; }
    const size_t kstep = (size_t)(BK * 2);
    const size_t hstep = (size_t)HALF * K * 2;
    const size_t tstep = 2 * hstep;
    const unsigned ldsw = (unsigned)wid * 1024u;
    const int aoff = lds_byte(wr * 64 + fr, fq * 8), boff = lds_byte(wc * 32 + fr, fq * 8);
#define PG8_SA(b, h) (((b) * 2 + (h)) * HTB)
#define PG8_SB(b, h) ((4 + (b) * 2 + (h)) * HTB)
#define PG8_STAGE(bufoff, gbase, voff) do { _Pragma("unroll") for (int _i = 0; _i < 2; ++_i) \
        __builtin_amdgcn_global_load_lds((const unsigned*)((const char*)(gbase) + (voff)[_i]), (PG8_LAS unsigned*)(lds + (bufoff) + ldsw + _i * 8192), 16, 0, 0); } while (0)
#define PG8_LDA(dst, b, h) do { _Pragma("unroll") for (int m = 0; m < 4; ++m) _Pragma("unroll") for (int k = 0; k < 2; ++k) dst[m][k] = *(const PG8_LAS bf16x8*)(lds + PG8_SA(b, h) + aoff + m * 2048 + k * 1024); } while (0)
#define PG8_LDB(dst, b, h) do { _Pragma("unroll") for (int n = 0; n < 2; ++n) _Pragma("unroll") for (int k = 0; k < 2; ++k) dst[n][k] = *(const PG8_LAS bf16x8*)(lds + PG8_SB(b, h) + boff + n * 2048 + k * 1024); } while (0)
#define PG8_MMA(ai, bj, At, Bt) do { __builtin_amdgcn_s_setprio(1); _Pragma("unroll") for (int m = 0; m < 4; ++m) _Pragma("unroll") for (int n = 0; n < 2; ++n) _Pragma("unroll") for (int k = 0; k < 2; ++k) \
        acc[ai][bj][m][n] = __builtin_amdgcn_mfma_f32_16x16x32_bf16(Bt[n][k], At[m][k], acc[ai][bj][m][n], 0, 0, 0); __builtin_amdgcn_s_setprio(0); } while (0)
#define PG8_WAIT_V(n) asm volatile("s_waitcnt vmcnt(" #n ")" ::: "memory")
#define PG8_WAIT_L(n) asm volatile("s_waitcnt lgkmcnt(" #n ")" ::: "memory")
#define PG8_BAR __builtin_amdgcn_s_barrier()
#define PG8_SCHED __builtin_amdgcn_sched_barrier(0)
    Unit cur, nxt; int ui = 0;
    if (!S.next(0, cur)) return;
    f32x4 acc[2][2][4][2];
#pragma unroll
    for (int a = 0; a < 2; ++a)
#pragma unroll
        for (int b = 0; b < 2; ++b)
#pragma unroll
            for (int m = 0; m < 4; ++m)
#pragma unroll
                for (int n = 0; n < 2; ++n) acc[a][b][m][n] = (f32x4){0.f, 0.f, 0.f, 0.f};
    bf16x8 At[4][2], B0[2][2], B1[2][2];
    const char* cA = (const char*)(cur.z ? g.A2 : g.A) + (size_t)cur.pm * tstep; const char* cB = (const char*)(cur.z ? g.Bt2 : g.Bt) + (size_t)cur.pn * tstep;
    S.a_ready(cur);
    if constexpr (SP2) {
        PG8_STAGE(PG8_SB(0, 0), cB, voffB); PG8_STAGE(PG8_SB(0, 1), cB + hstep, voffB); PG8_STAGE(PG8_SA(0, 0), cA, voffA); PG8_STAGE(PG8_SA(0, 1), cA + hstep, voffA);
        if (wr == 1) PG8_BAR;
        PG8_WAIT_V(2); PG8_BAR;
        PG8_STAGE(PG8_SB(1, 0), cB + kstep, voffB); PG8_STAGE(PG8_SA(1, 0), cA + kstep, voffA); PG8_STAGE(PG8_SB(1, 1), cB + hstep + kstep, voffB);
        PG8_WAIT_V(6); PG8_BAR;
    } else {
        PG8_STAGE(PG8_SB(0, 0), cB, voffB); PG8_STAGE(PG8_SA(0, 0), cA, voffA); PG8_STAGE(PG8_SB(0, 1), cB + hstep, voffB); PG8_STAGE(PG8_SA(0, 1), cA + hstep, voffA);
        if (wr == 1) PG8_BAR;
        PG8_WAIT_V(4); PG8_BAR;
        PG8_STAGE(PG8_SB(1, 0), cB + kstep, voffB); PG8_STAGE(PG8_SA(1, 0), cA + kstep, voffA); PG8_STAGE(PG8_SB(1, 1), cB + hstep + kstep, voffB);
        PG8_WAIT_V(6); PG8_BAR;
    }
    for (;;) {
        const bool has_next = S.next(ui + 1, nxt);
        const char* nA = has_next ? (const char*)(nxt.z ? g.A2 : g.A) + (size_t)nxt.pm * tstep : cA; const char* nB = has_next ? (const char*)(nxt.z ? g.Bt2 : g.Bt) + (size_t)nxt.pn * tstep : cB;
        for (int t = 0; t < nt; t += 2) {
            const bool last = (t == nt - 2);
            const char* a1 = cA + (size_t)(t + 1) * kstep;
            const char* a2 = last ? nA : cA + (size_t)(t + 2) * kstep; const char* b2 = last ? nB : cB + (size_t)(t + 2) * kstep;
            const char* a3 = a2 + kstep; const char* b3 = b2 + kstep;
            if (last && has_next) S.a_ready(nxt);
            if constexpr (SP2) {
            PG8_LDB(B0, 0, 0); PG8_LDB(B1, 0, 1); PG8_SCHED; PG8_LDA(At, 0, 0); PG8_STAGE(PG8_SA(1, 1), a1 + hstep, voffA);
            PG8_WAIT_V(8); PG8_WAIT_L(0); PG8_BAR; PG8_MMA(0, 0, At, B0); PG8_MMA(0, 1, At, B1); PG8_BAR; PG8_SCHED;
            PG8_LDA(At, 0, 1); PG8_STAGE(PG8_SB(0, 0), b2, voffB); PG8_STAGE(PG8_SB(0, 1), b2 + hstep, voffB); PG8_STAGE(PG8_SA(0, 0), a2, voffA);
            PG8_WAIT_V(8); PG8_WAIT_L(0); PG8_BAR; PG8_MMA(1, 0, At, B0); PG8_MMA(1, 1, At, B1); PG8_BAR; PG8_SCHED;
            PG8_LDB(B0, 1, 0); PG8_LDB(B1, 1, 1); PG8_SCHED; PG8_LDA(At, 1, 0); PG8_STAGE(PG8_SA(0, 1), a2 + hstep, voffA);
            PG8_WAIT_V(8); PG8_WAIT_L(0); PG8_BAR; PG8_MMA(0, 0, At, B0); PG8_MMA(0, 1, At, B1); PG8_BAR; PG8_SCHED;
            PG8_LDA(At, 1, 1); PG8_STAGE(PG8_SB(1, 0), b3, voffB); PG8_STAGE(PG8_SB(1, 1), b3 + hstep, voffB); PG8_STAGE(PG8_SA(1, 0), a3, voffA);
            PG8_WAIT_V(8); PG8_WAIT_L(0); PG8_BAR; PG8_MMA(1, 0, At, B0); PG8_MMA(1, 1, At, B1); PG8_BAR; PG8_SCHED;
            } else {
            PG8_LDB(B0, 0, 0); PG8_SCHED; PG8_LDA(At, 0, 0); PG8_STAGE(PG8_SA(1, 1), a1 + hstep, voffA);
            PG8_WAIT_L(8); PG8_BAR; PG8_WAIT_L(0); PG8_MMA(0, 0, At, B0); PG8_BAR; PG8_SCHED;
            PG8_LDB(B1, 0, 1); PG8_STAGE(PG8_SB(0, 0), b2, voffB);
            PG8_BAR; PG8_WAIT_L(0); PG8_MMA(0, 1, At, B1); PG8_BAR;
            PG8_LDA(At, 0, 1); PG8_STAGE(PG8_SA(0, 0), a2, voffA);
            PG8_BAR; PG8_WAIT_L(0); PG8_MMA(1, 0, At, B0); PG8_BAR; PG8_SCHED;
            PG8_STAGE(PG8_SB(0, 1), b2 + hstep, voffB);
            PG8_WAIT_V(6); PG8_BAR; PG8_MMA(1, 1, At, B1); PG8_BAR;
            PG8_LDB(B0, 1, 0); PG8_SCHED; PG8_LDA(At, 1, 0); PG8_STAGE(PG8_SA(0, 1), a2 + hstep, voffA);
            PG8_WAIT_L(8); PG8_BAR; PG8_WAIT_L(0); PG8_MMA(0, 0, At, B0); PG8_BAR; PG8_SCHED;
            PG8_LDB(B1, 1, 1); PG8_STAGE(PG8_SB(1, 0), b3, voffB);
            PG8_BAR; PG8_WAIT_L(0); PG8_MMA(0, 1, At, B1); PG8_BAR;
            PG8_LDA(At, 1, 1); PG8_STAGE(PG8_SA(1, 0), a3, voffA);
            PG8_BAR; PG8_WAIT_L(0); PG8_MMA(1, 0, At, B0); PG8_BAR; PG8_SCHED;
            PG8_STAGE(PG8_SB(1, 1), b3 + hstep, voffB);
            PG8_WAIT_V(6); PG8_BAR; PG8_MMA(1, 1, At, B1); PG8_BAR;
            }
        }
        if constexpr (ALIGN_EPI) { if (wr == 0) PG8_BAR; }
        if constexpr (!Epi::AFTER_DRAIN) { E(acc, cur, wr, wc, fr, fq); S.done(cur); }
        if (!has_next) break;
        if (!(Epi::KEEP_ACC && cur.z == 0)) {
#pragma unroll
        for (int a = 0; a < 2; ++a)
#pragma unroll
            for (int b = 0; b < 2; ++b)
#pragma unroll
                for (int m = 0; m < 4; ++m)
#pragma unroll
                    for (int n = 0; n < 2; ++n) acc[a][b][m][n] = (f32x4){0.f, 0.f, 0.f, 0.f};
        }
        cur = nxt; cA = nA; cB = nB; ++ui;
        if constexpr (ALIGN_EPI) { if (wr == 1) PG8_BAR; }
    }
    PG8_WAIT_V(0);
    if constexpr (!ALIGN_EPI) { if (wr == 0) PG8_BAR; }
    PG8_BAR;
    if constexpr (Epi::AFTER_DRAIN) { E.fused(acc, cur, wr, wc, fr, fq, lds, wid, lane); S.done(cur); }
#undef PG8_SA
#undef PG8_SB
#undef PG8_STAGE
#undef PG8_LDA
#undef PG8_LDB
#undef PG8_MMA
#undef PG8_WAIT_V
#undef PG8_WAIT_L
#undef PG8_BAR
#undef PG8_SCHED
}
}

constexpr size_t MiB = 1u << 20;
constexpr size_t WS_CTL = 0, CTL_ZERO_BYTES = 1 * MiB;
constexpr size_t WS_WIN = 2 * MiB, WS_WPA = 13 * MiB, WS_WPB = 14 * MiB, WS_WOUT = 15 * MiB, WS_WGU = 17 * MiB, WS_WDN = 28 * MiB;
constexpr size_t WS_LORA = 28 * MiB + (size_t)DM * FF * 2;
static_assert(WS_LORA + 262144 <= 34 * MiB, "lora map");
constexpr size_t WS_XB = 34 * MiB, WS_RS0 = 67 * MiB, WS_QB = 68 * MiB, WS_KB = 85 * MiB, WS_VB = 102 * MiB, WS_PC = 119 * MiB, WS_GT = 176 * MiB;
constexpr size_t WS_ON = 241 * MiB, WS_RW = 258 * MiB, WS_MG = 275 * MiB, WS_TMP = 308 * MiB, WS_X1B = 373 * MiB, WS_HB = 406 * MiB;
constexpr size_t WS_RK = 496 * MiB, RK_STRIDE = 33 * MiB;
constexpr size_t WS_BON = 728 * MiB, WS_DP = 729 * MiB;
constexpr size_t WS_BON3 = 736 * MiB, WS_Y0 = 740 * MiB, WS_CC = 773 * MiB, WS_PSI = 806 * MiB, WS_PHI = 810 * MiB, WS_SST = 814 * MiB, WS_DP2 = 818 * MiB;
constexpr size_t WS_SC = 830 * MiB, WS_RH = 912 * MiB, WS_GP = 928 * MiB, WS_XC = 944 * MiB, WS_YL = 960 * MiB, WS_SL = 992 * MiB, WS_GC = 1024 * MiB, WS_HT = 1025 * MiB, WS_END = 1026 * MiB;
static_assert(WS_WIN + (size_t)INW * DM * 2 <= WS_WPA && WS_WGU + (size_t)NGU * DM * 2 <= WS_WDN && WS_WDN + (size_t)DM * FF * 2 <= WS_XB, "weights map");
static_assert(WS_XB + (size_t)MTOT * DM * 2 <= WS_RS0 && WS_QB + (size_t)MTOT * 512 * 2 <= WS_KB && WS_PC + (size_t)MTOT * RSW * 2 <= WS_GT && WS_GT + (size_t)MTOT * 2048 * 2 <= WS_ON, "act map 1");
static_assert(WS_MG + (size_t)MTOT * DM * 2 <= WS_TMP && WS_TMP + (size_t)MTOT * DM * 4 <= WS_X1B && WS_X1B + (size_t)MTOT * DM * 2 <= WS_HB && WS_HB + (size_t)MTOT * FF * 2 <= WS_RK, "act map 2");
static_assert((size_t)MTOT * 512 * 4 <= RK_STRIDE && WS_RK + 7 * RK_STRIDE <= WS_BON, "rwkv map");
constexpr int CW_TMO = 0, CW_CODE = 1;
constexpr int CW_BAR = 4096;
constexpr int CW_SSQ = 32768;
constexpr int CW_QUEUE = 2048;
constexpr int CW_QDEC = 2112;
constexpr int CW_DCNT = 65536;
static_assert((CW_DCNT + 128 * 64) * 4 <= (int)CTL_ZERO_BYTES, "CTL map");

constexpr int RING_OFF = 0, RING_BYTES = 139264;
constexpr int LDSCTL_OFF = RING_BYTES, MISC_OFF = LDSCTL_OFF + 320;
constexpr int LDS_BYTES = 155648;
constexpr int NWAVES = 8;

#define GAS __attribute__((address_space(1)))
#define LAS __attribute__((address_space(3)))
typedef unsigned short bf16;
typedef unsigned v4u __attribute__((ext_vector_type(4)));
typedef unsigned v2u __attribute__((ext_vector_type(2)));
typedef float f32x4 __attribute__((ext_vector_type(4)));
typedef float f32x2 __attribute__((ext_vector_type(2)));
typedef float f32x16 __attribute__((ext_vector_type(16)));
typedef short bf16x8 __attribute__((ext_vector_type(8)));
typedef short s16x4 __attribute__((ext_vector_type(4)));
typedef GAS unsigned gu32;
#define RLX_AGENT __ATOMIC_RELAXED, __HIP_MEMORY_SCOPE_AGENT
#define LDS_WAIT() asm volatile("s_waitcnt lgkmcnt(0)" ::: "memory")
#define VM_WAIT() asm volatile("s_waitcnt vmcnt(0)" ::: "memory")
__device__ __forceinline__ unsigned pk2(float lo, float hi) { return pg8::cvt_pk_bf16(lo, hi); }
using pg8::sigmoidf_;
__device__ __forceinline__ float bf2f(unsigned short b) { return __builtin_bit_cast(float, (unsigned)b << 16); }
__device__ __forceinline__ float bflo(unsigned w) { return __builtin_bit_cast(float, w << 16); }
__device__ __forceinline__ float bfhi(unsigned w) { return __builtin_bit_cast(float, w & 0xffff0000u); }

#define XB_TMO      128
#define XB_XCNT(j)  (256  + 64 * (j))
#define XB_XSUB(j)  (1280 + 64 * (j))
#define XB_XGEN(j)  (2304 + 64 * (j))
#define XB_TOP      3328
#define XB_TOPGEN   3392
#define XCD_BAR_WORDS 3456
#define XB_SPIN_CAP (1u << 18)

__device__ __forceinline__ unsigned xb_ld(unsigned* p)              { return __hip_atomic_load(p, __ATOMIC_RELAXED, __HIP_MEMORY_SCOPE_AGENT); }
__device__ __forceinline__ unsigned xb_add(unsigned* p, unsigned v) { return __hip_atomic_fetch_add(p, v, __ATOMIC_RELAXED, __HIP_MEMORY_SCOPE_AGENT); }
__device__ __forceinline__ unsigned xb_xcc_id() { return (unsigned)__builtin_amdgcn_s_getreg((3 << 11) | 20) & 0xFu; }
#define XB_SPIN(cond, bar) do { unsigned _sp = 0; while (cond) { __builtin_amdgcn_s_sleep(1); \
    if ((++_sp & 255u) == 0u) { if (xb_ld(&(bar)[XB_TMO])) break; if (_sp > XB_SPIN_CAP) { atomicAdd(&(bar)[XB_TMO], 1u); break; } } } } while (0)

struct XcdBarrier {
    unsigned* bar; unsigned x;
    volatile LAS unsigned* st;
};

__device__ __forceinline__ XcdBarrier xcd_barrier_post(unsigned* bar, volatile LAS unsigned* st) {
    XcdBarrier b; b.bar = bar; b.x = xb_xcc_id(); b.st = st;
    if (threadIdx.x == 0) (void)xb_add(&bar[XB_XCNT(b.x)], 1u);
    return b;
}
__device__ __forceinline__ void xcd_barrier_complete(unsigned* bar, unsigned x, unsigned& nloc, unsigned& nx) {
    const unsigned G = gridDim.x * gridDim.y * gridDim.z;
    unsigned sum, cnt, mine, sp = 0u;
    for (;;) {
        sum = 0u; cnt = 0u; mine = 0u;
#pragma unroll
        for (unsigned j = 0; j < 16; ++j) { const unsigned c = xb_ld(&bar[XB_XCNT(j)]); sum += c; cnt += (c > 0u) ? 1u : 0u; mine = (j == x) ? c : mine; }
        if (sum == G) break;
        __builtin_amdgcn_s_sleep(1);
        if ((++sp & 255u) == 0u) { if (xb_ld(&bar[XB_TMO])) break; if (sp > XB_SPIN_CAP) { atomicAdd(&bar[XB_TMO], 1u); break; } }
    }
    nloc = mine > 0u ? mine : 1u; nx = cnt > 0u ? cnt : 1u;
}

__device__ __forceinline__ void xcd_barrier(const XcdBarrier& b) {
    asm volatile("s_waitcnt vmcnt(0)" ::: "memory");
    __syncthreads();
    if (threadIdx.x == 0) {
        unsigned* bar = b.bar;
        __builtin_amdgcn_s_waitcnt(0);
        unsigned nloc = b.st[0], nx = b.st[1];
        if (nloc == 0u) { xcd_barrier_complete(bar, b.x, nloc, nx); b.st[0] = nloc; b.st[1] = nx; }
        const unsigned old = xb_add(&bar[XB_XSUB(b.x)], 1u);
        const unsigned gen = old / nloc;
        if (old + 1u == (gen + 1u) * nloc) {
            __builtin_amdgcn_fence(__ATOMIC_RELEASE, "agent");
            asm volatile("s_waitcnt vmcnt(0)" ::: "memory");
            const unsigned og = xb_add(&bar[XB_TOP], 1u);
            const unsigned tg = og / nx;
            if (og + 1u == (tg + 1u) * nx) xb_add(&bar[XB_TOPGEN], 1u);
            else XB_SPIN(xb_ld(&bar[XB_TOPGEN]) == tg, bar);
            __builtin_amdgcn_fence(__ATOMIC_ACQUIRE, "agent");
            xb_add(&bar[XB_XGEN(b.x)], 1u);
            asm volatile("s_waitcnt vmcnt(0)" ::: "memory");
        } else {
            XB_SPIN(xb_ld(&bar[XB_XGEN(b.x)]) == gen, bar);
            __builtin_amdgcn_fence(__ATOMIC_ACQUIRE, "agent");
            asm volatile("s_waitcnt vmcnt(0)" ::: "memory");
        }
    }
    __syncthreads();
}

struct Args { const float* in[34]; float* out; unsigned char* ws; int ph_lo, ph_hi, li, pad; };
struct Frame {
    LAS unsigned char* lds;
    volatile LAS unsigned* MISC;
    gu32* ctl;
    int tid, lane, wave, vcu, G;
    unsigned char* ws; float* out;
#ifdef MK_SUB
    unsigned long long pa, pb;
#endif
};
#ifdef MK_SUB
#define SUBM(k) do { if (MK_SUB == (k)) F.pa = __builtin_amdgcn_s_memrealtime(); if (MK_SUB + 1 == (k)) F.pb = __builtin_amdgcn_s_memrealtime(); } while (0)
#else
#define SUBM(k) do { } while (0)
#endif
enum { I_XP = 0, I_XS, I_CK, I_CV, I_PT, I_SWKV, I_SSH, I_NMIX, I_WIN, I_QG, I_KG, I_LQ1, I_LK1, I_LQ2, I_LK2, I_AOG, I_WPA, I_MU, I_W0, I_W2, I_A0, I_A2, I_G2,
       I_KK, I_KA, I_RK, I_GNW, I_GNB, I_WPB, I_WOUT, I_NFFN, I_WG, I_WU, I_WD };

__device__ __forceinline__ float wave_sum(float v) {
#pragma unroll
    for (int o = 1; o < 64; o <<= 1) v += __shfl_xor(v, o);
    return v;
}

__device__ __forceinline__ float dpp_rmir(float v) { return __builtin_bit_cast(float, __builtin_amdgcn_update_dpp(0, __builtin_bit_cast(int, v), 0x140, 0xF, 0xF, true)); }
__device__ __forceinline__ float sum32(float v) {
    v += __builtin_bit_cast(float, __builtin_amdgcn_update_dpp(0, __builtin_bit_cast(int, v), 0xB1, 0xF, 0xF, true));
    v += __builtin_bit_cast(float, __builtin_amdgcn_update_dpp(0, __builtin_bit_cast(int, v), 0x4E, 0xF, 0xF, true));
    v += __builtin_bit_cast(float, __builtin_amdgcn_update_dpp(0, __builtin_bit_cast(int, v), 0x141, 0xF, 0xF, true));
    v += dpp_rmir(v);
    v += __shfl_xor(v, 16);
    return v;
}
__device__ __forceinline__ void p0_transpose_item(const float* W, int K, int N, bf16* WT, int drow0, const float* kgain, LAS float* scr, int k0, int n0, int lane) {
    float v[32];
    const float* wp = W + (size_t)(k0 + (lane >> 5)) * N + n0 + (lane & 31);
#pragma unroll
    for (int i = 0; i < 32; ++i) v[i] = wp[(size_t)(2 * i) * N];
    const int c = lane & 7;
    f32x4 g0 = {1.f, 1.f, 1.f, 1.f}, g1 = g0;
    if (kgain) { g0 = *(const f32x4*)(kgain + k0 + 8 * c); g1 = *(const f32x4*)(kgain + k0 + 8 * c + 4); }
#pragma unroll
    for (int i = 0; i < 32; ++i) scr[(2 * i + (lane >> 5)) * 33 + (lane & 31)] = v[i];
    LDS_WAIT(); asm volatile("" ::: "memory");
#pragma unroll
    for (int j = 0; j < 4; ++j) { const int n = (lane >> 3) + 8 * j; const LAS float* s = scr + (8 * c) * 33 + n;
        v4u o; o.x = pk2(s[0 * 33] * g0[0], s[1 * 33] * g0[1]); o.y = pk2(s[2 * 33] * g0[2], s[3 * 33] * g0[3]); o.z = pk2(s[4 * 33] * g1[0], s[5 * 33] * g1[1]); o.w = pk2(s[6 * 33] * g1[2], s[7 * 33] * g1[3]);
        *(GAS v4u*)(WT + (size_t)(drow0 + n) * K + k0 + 8 * c) = o; }
    LDS_WAIT(); asm volatile("" ::: "memory");
}
template <int PART> __device__ __forceinline__ void p0_prologue(Frame& F, const Args& A, int gw, int NGW) {
    LAS float* scr = (LAS float*)(F.lds + RING_OFF + F.wave * 16384);
    bf16* Win_t = (bf16*)(F.ws + WS_WIN); bf16* Wpa_t = (bf16*)(F.ws + WS_WPA); bf16* Wpb_t = (bf16*)(F.ws + WS_WPB); bf16* Wout_t = (bf16*)(F.ws + WS_WOUT);
    bf16* Wgu_t = (bf16*)(F.ws + WS_WGU); bf16* Wdn_t = (bf16*)(F.ws + WS_WDN);
    constexpr int I_IN = (DM / 64) * (INW / 32), I_PA = (512 / 64) * (DM / 32), I_OUT = (DM / 64) * (DM / 32), I_G = (DM / 64) * (FF / 32), I_D = (FF / 64) * (DM / 32);
    constexpr int I_L = 16, NITEMS = I_IN + 2 * I_PA + I_OUT + 2 * I_G + I_D + 4 * I_L;
    constexpr int NP0 = I_IN + 4 * I_L, NP1 = NITEMS - NP0;
    for (int ix = gw; ix < (PART == 0 ? NP0 : NP1); ix += NGW) {
        int r = PART == 0 ? (ix < I_IN ? ix : ix - I_IN + (NITEMS - 4 * I_L)) : ix + I_IN;
        if (r < I_IN) { constexpr int nnb = INW / 32; const int kb = r / nnb, nb = r % nnb, pn = nb >> 3, q = nb & 7;
            p0_transpose_item(A.in[I_WIN], DM, INW, Win_t, 256 * pn + 32 * (4 * (q & 1) + (q >> 1)), A.in[I_NMIX], scr, 64 * kb, 32 * nb, F.lane); continue; } r -= I_IN;
        if (r < I_PA) { constexpr int nnb = DM / 32; const int kb = r / nnb, nb = r % nnb; p0_transpose_item(A.in[I_WPA], 512, DM, Wpa_t, 32 * nb, nullptr, scr, 64 * kb, 32 * nb, F.lane); continue; } r -= I_PA;
        if (r < I_PA) { constexpr int nnb = DM / 32; const int kb = r / nnb, nb = r % nnb; p0_transpose_item(A.in[I_WPB], 512, DM, Wpb_t, 32 * nb, nullptr, scr, 64 * kb, 32 * nb, F.lane); continue; } r -= I_PA;
        if (r < I_OUT) { constexpr int nnb = DM / 32; const int kb = r / nnb, nb = r % nnb; p0_transpose_item(A.in[I_WOUT], DM, DM, Wout_t, 32 * nb, nullptr, scr, 64 * kb, 32 * nb, F.lane); continue; } r -= I_OUT;
        if (r < I_G) { constexpr int nnb = FF / 32; const int kb = r / nnb, nb = r % nnb;
            p0_transpose_item(A.in[I_WG], DM, FF, Wgu_t, 256 * (nb >> 2) + 32 * (nb & 3), A.in[I_NFFN], scr, 64 * kb, 32 * nb, F.lane); continue; } r -= I_G;
        if (r < I_G) { constexpr int nnb = FF / 32; const int kb = r / nnb, nb = r % nnb;
            p0_transpose_item(A.in[I_WU], DM, FF, Wgu_t, 256 * (nb >> 2) + 128 + 32 * (nb & 3), A.in[I_NFFN], scr, 64 * kb, 32 * nb, F.lane); continue; } r -= I_G;
        if (r < I_D) { constexpr int nnb = DM / 32; const int kb = r / nnb, nb = r % nnb; p0_transpose_item(A.in[I_WD], FF, DM, Wdn_t, 32 * nb, nullptr, scr, 64 * kb, 32 * nb, F.lane); continue; } r -= I_D;
        { bf16* W2T = (bf16*)(F.ws + WS_LORA); bf16* A2T = W2T + 512 * 64; bf16* G2T = A2T + 512 * 64;
          if (r < I_L) p0_transpose_item(A.in[I_W2], 64, 512, W2T, 32 * r, nullptr, scr, 0, 32 * r, F.lane);
          else if (r < 2 * I_L) p0_transpose_item(A.in[I_A2], 64, 512, A2T, 32 * (r - I_L), nullptr, scr, 0, 32 * (r - I_L), F.lane);
          else { const int q = r - 2 * I_L; p0_transpose_item(A.in[I_G2], 128, 512, G2T, 32 * (q & 15), nullptr, scr, 64 * (q >> 4), 32 * (q & 15), F.lane); } }
    }
    if (PART != 0) return;
    bf16* XB = (bf16*)(F.ws + WS_XB); float* rs0 = (float*)(F.ws + WS_RS0);
    for (int m0 = gw; m0 < MTOT; m0 += 4 * NGW) {
        f32x4 v[4][4];
#pragma unroll
        for (int q = 0; q < 4; ++q) { const int m = m0 + q * NGW;
            if (m < MVALID) { const float* xrow = m < MP ? A.in[I_XP] + (size_t)m * DM : A.in[I_XS] + (size_t)(m - MP) * DM; const GAS f32x4* xr = (const GAS f32x4*)xrow + F.lane;
#pragma unroll
                for (int j = 0; j < 4; ++j) v[q][j] = xr[64 * j]; }
            else {
#pragma unroll
                for (int j = 0; j < 4; ++j) v[q][j] = (f32x4){0.f, 0.f, 0.f, 0.f}; } }
#pragma unroll
        for (int q = 0; q < 4; ++q) { const int m = m0 + q * NGW; if (m >= MTOT) continue;
            GAS unsigned long long* o8 = (GAS unsigned long long*)(XB + (size_t)m * DM) + F.lane; float s = 0.f;
#pragma unroll
            for (int j = 0; j < 4; ++j) { s += (v[q][j].x * v[q][j].x + v[q][j].y * v[q][j].y) + (v[q][j].z * v[q][j].z + v[q][j].w * v[q][j].w);
                o8[64 * j] = (unsigned long long)pk2(v[q][j].x, v[q][j].y) | ((unsigned long long)pk2(v[q][j].z, v[q][j].w) << 32); }
            s = sum32(s); { const auto rr = __builtin_amdgcn_permlane32_swap(__float_as_uint(s), __float_as_uint(s), false, false); s = __uint_as_float(rr[0]) + __uint_as_float(rr[1]); }
            if (F.lane == 0) rs0[m] = m < MVALID ? rsqrtf(s * (1.f / DM) + 1e-6f) : 0.f; }
    }
}

__device__ __forceinline__ int crow16(int r, int hi) { return (r & 3) + 8 * (r >> 2) + 4 * hi; }
__device__ __forceinline__ float lam_value(const Frame& F, const Args& A) {
    const int l = F.lane;
    const float a = wave_sum(A.in[I_LQ1][l] * A.in[I_LK1][l]), b = wave_sum(A.in[I_LQ2][l] * A.in[I_LK2][l]);
    return __expf(a) - __expf(b) + 0.2f;
}
__device__ __forceinline__ f32x4 ld_bf4(const bf16* p) { const v2u w = *(const v2u*)p; return (f32x4){bflo(w.x), bfhi(w.x), bflo(w.y), bfhi(w.y)}; }
__device__ __forceinline__ unsigned* rk_pair(const Frame& F, int i) { return (unsigned*)(F.ws + WS_RK + (size_t)i * RK_STRIDE); }
__device__ __forceinline__ bf16* rk_bf(const Frame& F, int i) { return (bf16*)(F.ws + WS_RK + (size_t)i * RK_STRIDE); }
__device__ __forceinline__ float* rk_arr(const Frame& F, int i) { return (float*)(F.ws + WS_RK + (size_t)i * RK_STRIDE); }

#define CRC(r) (((r) & 3) + 8 * ((r) >> 2))
constexpr int LIN_LD = 264, MS_LD = 1544;
__device__ __forceinline__ float tanh_fast(float x) { return 1.f - 2.f * __builtin_amdgcn_rcpf(1.f + __expf(2.f * x)); }
__device__ __forceinline__ void rwkv_prep_unit(Frame& F, const Args& A, int unit) {
    LAS bf16* msl = (LAS bf16*)(F.lds + RING_OFF);
    LAS bf16* lin = msl + 32 * MS_LD;
    const bf16* PC = (const bf16*)(F.ws + WS_PC);
    int r32_ = F.lane & 31, hi_ = F.lane >> 5; asm volatile("" : "+v"(r32_), "+v"(hi_));
    const int r0 = unit * 32, tid = F.tid, lane = F.lane, w = F.wave, r32 = r32_, hi = hi_;
    const float* mu = A.in[I_MU]; const float* ssh = A.in[I_SSH];
#pragma unroll 7
    for (int k = 0; k < 14; ++k) {
        const int p = tid + 512 * k, t = p / 224, c8 = p - 224 * t, row = r0 + t;
        const v4u cw = *(const v4u*)(PC + (size_t)row * RSW + 8 * c8);
        float cur[8] = {bflo(cw.x), bfhi(cw.x), bflo(cw.y), bfhi(cw.y), bflo(cw.z), bfhi(cw.z), bflo(cw.w), bfhi(cw.w)}, prv[8];
        if (row >= MP) { const f32x4 a = *(const f32x4*)(ssh + (size_t)(row - MP) * RSW + 8 * c8), b = *(const f32x4*)(ssh + (size_t)(row - MP) * RSW + 8 * c8 + 4);
#pragma unroll
            for (int j = 0; j < 4; ++j) { prv[j] = a[j]; prv[4 + j] = b[j]; } }
        else if ((row & (SEQ - 1)) == 0) {
#pragma unroll
            for (int j = 0; j < 8; ++j) prv[j] = 0.f; }
        else { const v4u pw = *(const v4u*)(PC + (size_t)(row - 1) * RSW + 8 * c8);
            prv[0] = bflo(pw.x); prv[1] = bfhi(pw.x); prv[2] = bflo(pw.y); prv[3] = bfhi(pw.y); prv[4] = bflo(pw.z); prv[5] = bfhi(pw.z); prv[6] = bflo(pw.w); prv[7] = bfhi(pw.w); }
        const f32x4 m0 = *(const f32x4*)(mu + 8 * c8), m1 = *(const f32x4*)(mu + 8 * c8 + 4);
        float m[8];
#pragma unroll
        for (int j = 0; j < 4; ++j) { m[j] = cur[j] + (prv[j] - cur[j]) * m0[j]; m[4 + j] = cur[4 + j] + (prv[4 + j] - cur[4 + j]) * m1[j]; }
        if (c8 >= 192) { const int ci = 8 * (c8 - 192);
#pragma unroll
            for (int j = 0; j < 8; ++j) { if (ci < 64) m[j] = tanh_fast(m[j]); else if (ci >= 128) m[j] = sigmoidf_(m[j]); }
            *(LAS v4u*)(lin + t * LIN_LD + ci) = (v4u){pk2(m[0], m[1]), pk2(m[2], m[3]), pk2(m[4], m[5]), pk2(m[6], m[7])}; }
        else *(LAS v4u*)(msl + t * MS_LD + 8 * c8) = (v4u){pk2(m[0], m[1]), pk2(m[2], m[3]), pk2(m[4], m[5]), pk2(m[6], m[7])};
    }
    __syncthreads();
    f32x16 wl[2], al[2], gg[2];
    const bf16* W2T = (const bf16*)(F.ws + WS_LORA); const bf16* A2T = W2T + 512 * 64; const bf16* G2T = A2T + 512 * 64;
#pragma unroll
    for (int ct = 0; ct < 2; ++ct) {
        const int ch = 64 * w + 2 * r32 + ct;
        f32x16 a0 = (f32x16){}, a1 = (f32x16){}, a2 = (f32x16){};
#pragma unroll
        for (int ks = 0; ks < 4; ++ks) {
            const bf16x8 x0 = *(const LAS bf16x8*)(lin + r32 * LIN_LD + 16 * ks + 8 * hi), x1 = *(const LAS bf16x8*)(lin + r32 * LIN_LD + 64 + 16 * ks + 8 * hi);
            const bf16x8 b0 = *(const bf16x8*)(W2T + (size_t)ch * 64 + 16 * ks + 8 * hi), b1 = *(const bf16x8*)(A2T + (size_t)ch * 64 + 16 * ks + 8 * hi);
            a0 = __builtin_amdgcn_mfma_f32_32x32x16_bf16(x0, b0, a0, 0, 0, 0); a1 = __builtin_amdgcn_mfma_f32_32x32x16_bf16(x1, b1, a1, 0, 0, 0);
        }
#pragma unroll
        for (int ks = 0; ks < 8; ++ks) {
            const bf16x8 x2 = *(const LAS bf16x8*)(lin + r32 * LIN_LD + 128 + 16 * ks + 8 * hi);
            const bf16x8 b2 = *(const bf16x8*)(G2T + (size_t)ch * 128 + 16 * ks + 8 * hi);
            a2 = __builtin_amdgcn_mfma_f32_32x32x16_bf16(x2, b2, a2, 0, 0, 0);
        }
        wl[ct] = a0; al[ct] = a1; gg[ct] = a2;
    }
    bf16* aR = rk_bf(F, 0); float* aW = rk_arr(F, 1); bf16* aK = rk_bf(F, 2); bf16* aV = rk_bf(F, 3); bf16* aA = rk_bf(F, 4); bf16* aB = rk_bf(F, 5); bf16* aG = rk_bf(F, 6);
    float* BON = (float*)(F.ws + WS_BON3);
    float w0c[2], a0c[2], kkc[2], kac[2], rkc[2];
#pragma unroll
    for (int ct = 0; ct < 2; ++ct) { const int ch = 64 * w + 2 * r32 + ct; w0c[ct] = A.in[I_W0][ch]; a0c[ct] = A.in[I_A0][ch]; kkc[ct] = A.in[I_KK][ch]; kac[ct] = A.in[I_KA][ch]; rkc[ct] = A.in[I_RK][ch]; }
    if (unit < MP / 32) {
        float lwv[2][16], pin[2][16], off[2];
        int r32o = r32; asm volatile("" : "+v"(r32o));
#pragma unroll
        for (int ct = 0; ct < 2; ++ct)
#pragma unroll
            for (int r = 0; r < 16; ++r) { const float x = -(w0c[ct] + wl[ct][r]), sp = fmaxf(x, 0.f) + __logf(1.f + __expf(-fabsf(x))); lwv[ct][r] = -__expf(-sp - 0.5f); }
#pragma unroll
        for (int ct = 0; ct < 2; ++ct) { float run = 0.f;
#pragma unroll
            for (int q = 0; q < 4; ++q) { const float c0 = lwv[ct][4 * q], c1 = c0 + lwv[ct][4 * q + 1], c2 = c1 + lwv[ct][4 * q + 2], c3 = c2 + lwv[ct][4 * q + 3];
                const float oth = __shfl_xor(c3, 32), base = run + (hi ? oth : 0.f);
                pin[ct][4 * q] = base + c0; pin[ct][4 * q + 1] = base + c1; pin[ct][4 * q + 2] = base + c2; pin[ct][4 * q + 3] = base + c3; run += c3 + oth; }
            off[ct] = (unit & 1) ? 0.f : run;
            if (hi == 0) ((float*)(F.ws + WS_HT))[(size_t)unit * 512 + 64 * w + 2 * r32o + ct] = __expf(run); }
        bf16* scb = (bf16*)(F.ws + WS_SC) + ((size_t)(((unit >> 7) * 8 + w) * 64 + ((unit >> 1) & 63)) * 5 * 64 + 32 * (unit & 1) + 4 * hi) * 64 + 2 * r32o;
#pragma unroll
        for (int r = 0; r < 16; ++r) {
            const int t = crow16(r, hi), row = r0 + t;
            float rr[2], kv[2], vv[2], kkv[2], av[2], wv[2];
            float ss = 0.f;
#pragma unroll
            for (int ct = 0; ct < 2; ++ct) { const int ch = 64 * w + 2 * r32 + ct;
                rr[ct] = bf2f(msl[t * MS_LD + ch]); kv[ct] = bf2f(msl[t * MS_LD + 512 + ch]); vv[ct] = bf2f(msl[t * MS_LD + 1024 + ch]);
                wv[ct] = __expf(lwv[ct][r]);
                av[ct] = sigmoidf_(a0c[ct] + al[ct][r]);
                kkv[ct] = kv[ct] * kkc[ct]; ss += kkv[ct] * kkv[ct];
            }
            ss = sum32(ss);
            const float rn = rsqrtf(fmaxf(ss, 1e-24f));
            float bon = 0.f, br = 0.f, kr = 0.f, kk[2], kp[2];
#pragma unroll
            for (int ct = 0; ct < 2; ++ct) { kk[ct] = kkv[ct] * rn; kp[ct] = kv[ct] * (1.f + (av[ct] - 1.f) * kac[ct]);
                bon += rr[ct] * kp[ct] * rkc[ct]; br += kk[ct] * av[ct] * rr[ct]; kr += kp[ct] * rr[ct]; }
            bon = sum32(bon); br = sum32(br); kr = sum32(kr);
            { float Fm[2], Fi[2];
#pragma unroll
              for (int ct = 0; ct < 2; ++ct) { Fm[ct] = __expf(pin[ct][r] - lwv[ct][r] - off[ct]); Fi[ct] = __expf(off[ct] - pin[ct][r]); }
              unsigned* sp_ = (unsigned*)(scb + CRC(r) * 64);
              sp_[0 * 2048] = pk2(-kk[0] * Fm[0], -kk[1] * Fm[1]);
              sp_[1 * 2048] = pk2(kk[0] * av[0] * Fi[0], kk[1] * av[1] * Fi[1]);
              sp_[2 * 2048] = pk2(kp[0] * Fi[0], kp[1] * Fi[1]);
              sp_[3 * 2048] = pk2(wv[0] * rr[0] * Fm[0], wv[1] * rr[1] * Fm[1]);
              sp_[4 * 2048] = pk2(vv[0], vv[1]);
              *(v2u*)(rk_pair(F, 2) + (size_t)row * 512 + 64 * w + 2 * r32o) = (v2u){pk2(vv[0], gg[0][r]), pk2(vv[1], gg[1][r])}; }
            if (r32 == 0) *(f32x4*)(BON + (size_t)(row * 8 + w) * 4) = (f32x4){bon, br, kr, 0.f};
        }
    } else {
#pragma unroll 4
    for (int r = 0; r < 16; ++r) {
        const int t = crow16(r, hi), row = r0 + t;
        float rr[2], kv[2], vv[2], kkv[2], av[2], wv[2];
        float ss = 0.f;
#pragma unroll
        for (int ct = 0; ct < 2; ++ct) { const int ch = 64 * w + 2 * r32 + ct;
            rr[ct] = bf2f(msl[t * MS_LD + ch]); kv[ct] = bf2f(msl[t * MS_LD + 512 + ch]); vv[ct] = bf2f(msl[t * MS_LD + 1024 + ch]);
            const float x = -(w0c[ct] + wl[ct][r]), sp = fmaxf(x, 0.f) + __logf(1.f + __expf(-fabsf(x)));
            const float e = __expf(-sp - 0.5f); wv[ct] = __expf(-e);
            av[ct] = sigmoidf_(a0c[ct] + al[ct][r]);
            kkv[ct] = kv[ct] * kkc[ct]; ss += kkv[ct] * kkv[ct];
        }
        ss = sum32(ss);
        const float rn = rsqrtf(fmaxf(ss, 1e-24f));
        float bon = 0.f, br = 0.f, kr = 0.f, kk[2], kp[2];
#pragma unroll
        for (int ct = 0; ct < 2; ++ct) { kk[ct] = kkv[ct] * rn; kp[ct] = kv[ct] * (1.f + (av[ct] - 1.f) * kac[ct]);
            bon += rr[ct] * kp[ct] * rkc[ct]; br += kk[ct] * av[ct] * rr[ct]; kr += kp[ct] * rr[ct]; }
        bon = sum32(bon); br = sum32(br); kr = sum32(kr);
#pragma unroll
        for (int ct = 0; ct < 2; ++ct) { const size_t o = (size_t)row * 512 + 64 * w + 2 * r32 + ct;
            aW[o] = wv[ct]; rk_pair(F, 0)[o] = pk2(wv[ct] * rr[ct], kp[ct]); rk_pair(F, 2)[o] = pk2(vv[ct], gg[ct][r]); rk_pair(F, 4)[o] = pk2(-kk[ct], kk[ct] * av[ct]); }
        if (r32 == 0) *(f32x4*)(BON + (size_t)(row * 8 + w) * 4) = (f32x4){bon, br, kr, 0.f};
    }
    }
    __syncthreads();
}

constexpr int NSEG = 8, SEGT = SEQ / NSEG;
__device__ __forceinline__ float dpp_xor1(float v) { return __builtin_bit_cast(float, __builtin_amdgcn_update_dpp(0, __builtin_bit_cast(int, v), 0xB1, 0xF, 0xF, true)); }
__device__ __forceinline__ float dpp_xor2(float v) { return __builtin_bit_cast(float, __builtin_amdgcn_update_dpp(0, __builtin_bit_cast(int, v), 0x4E, 0xF, 0xF, true)); }
__device__ __forceinline__ float dpp_hmir(float v) { return __builtin_bit_cast(float, __builtin_amdgcn_update_dpp(0, __builtin_bit_cast(int, v), 0x141, 0xF, 0xF, true)); }
__device__ __forceinline__ float red8(float v) { v += dpp_xor1(v); v += dpp_xor2(v); v += dpp_hmir(v); return v; }
__device__ __forceinline__ void gn_store(Frame& F, const Args& A, int row, int h, int q, f32x4 yv, f32x4 vv) {
    const float* BON = (const float*)(F.ws + WS_BON3); const bf16* aG = rk_bf(F, 6); bf16* RW = (bf16*)(F.ws + WS_RW);
    float s = (yv[0] + yv[1]) + (yv[2] + yv[3]);
    s += __shfl_xor(s, 1); s += __shfl_xor(s, 2); s += __shfl_xor(s, 4); s += __shfl_xor(s, 8);
    const float mean = s * (1.f / 64.f); const f32x4 d = yv - mean;
    float s2 = (d[0] * d[0] + d[1] * d[1]) + (d[2] * d[2] + d[3] * d[3]);
    s2 += __shfl_xor(s2, 1); s2 += __shfl_xor(s2, 2); s2 += __shfl_xor(s2, 4); s2 += __shfl_xor(s2, 8);
    const float rstd = rsqrtf(s2 * (1.f / 64.f) + 64e-5f), bon = BON[(row * 8 + h) * 4];
    const int cbase = h * 64 + 4 * q;
    const f32x4 gw = *(const f32x4*)(A.in[I_GNW] + cbase), gb = *(const f32x4*)(A.in[I_GNB] + cbase), gv = [&]{ const v4u pg = *(const v4u*)(rk_pair(F, 2) + (size_t)row * 512 + cbase); return (f32x4){bfhi(pg.x), bfhi(pg.y), bfhi(pg.z), bfhi(pg.w)}; }();
    const f32x4 o = (d * rstd * gw + gb + bon * vv) * gv;
    v2u w; w.x = pk2(o[0], o[1]); w.y = pk2(o[2], o[3]);
    *(v2u*)(RW + (size_t)row * 512 + cbase) = w;
}
struct ScanIn { f32x4 a0, a1, r0, r1, w0, w1, b0, b1, k0, k1; float vi, br, kr; };
__device__ __forceinline__ void scan_seg_unit(Frame& F, const Args& A, int u) {
    constexpr int TB = 32, VB = 6 * TB * 64 + 2 * TB;
    LAS float* vecs = (LAS float*)(F.lds + RING_OFF);
    LAS float* ybuf = vecs + 2 * VB;
    LAS float* cbuf = ybuf + TB * 64;
    const int tid = F.tid, i = tid >> 3, seg8 = tid & 7;
    const bool prompt = u < 256;
    int h, row0, T; bool useF; f32x2 S[4], Fm[4];
    if (prompt) { h = (u >> 3) & 7; row0 = (u >> 6) * SEQ + (u & 7) * SEGT; T = SEGT; useF = (u & 7) != 0;
#pragma unroll
        for (int c = 0; c < 4; ++c) { S[c] = (f32x2){0.f, 0.f}; Fm[c] = (f32x2){(8 * seg8 + 2 * c == i) ? 1.f : 0.f, (8 * seg8 + 2 * c + 1 == i) ? 1.f : 0.f}; } }
    else { const int su = u - 256; h = su & 7; row0 = MP + (su >> 3); T = 1; useF = false;
        const float* s0 = A.in[I_SWKV] + ((size_t)su * 64 + i) * 64 + 8 * seg8;
        const f32x4 a = *(const f32x4*)s0, b = *(const f32x4*)(s0 + 4);
        S[0] = (f32x2){a[0], a[1]}; S[1] = (f32x2){a[2], a[3]}; S[2] = (f32x2){b[0], b[1]}; S[3] = (f32x2){b[2], b[3]};
#pragma unroll
        for (int c = 0; c < 4; ++c) Fm[c] = (f32x2){0.f, 0.f}; }
    const float* BON = (const float*)(F.ws + WS_BON3);
    float* Y0 = (float*)(F.ws + WS_Y0); float* CC = (float*)(F.ws + WS_CC);
    f32x4 sg[6]; float sgs = 0.f;
    const int st = tid >> 4, sq = tid & 15;
#define SCAN_STAGE_LOAD(t0_) do { const int nb_ = (T - (t0_)) < TB ? (T - (t0_)) : TB; if (st < nb_) { const size_t go_ = (size_t)(row0 + (t0_) + st) * 512 + h * 64 + 4 * sq; \
        sg[1] = *(const f32x4*)(rk_arr(F, 1) + go_); const v4u p0_ = *(const v4u*)(rk_pair(F, 0) + go_), p2_ = *(const v4u*)(rk_pair(F, 2) + go_), p4_ = *(const v4u*)(rk_pair(F, 4) + go_); \
        sg[0] = (f32x4){bflo(p0_.x), bflo(p0_.y), bflo(p0_.z), bflo(p0_.w)}; sg[2] = (f32x4){bfhi(p0_.x), bfhi(p0_.y), bfhi(p0_.z), bfhi(p0_.w)}; sg[3] = (f32x4){bflo(p2_.x), bflo(p2_.y), bflo(p2_.z), bflo(p2_.w)}; \
        sg[4] = (f32x4){bflo(p4_.x), bflo(p4_.y), bflo(p4_.z), bflo(p4_.w)}; sg[5] = (f32x4){bfhi(p4_.x), bfhi(p4_.y), bfhi(p4_.z), bfhi(p4_.w)}; } \
        if (tid < 2 * TB && (tid >> 1) < nb_) sgs = BON[((row0 + (t0_) + (tid >> 1)) * 8 + h) * 4 + 1 + (tid & 1)]; } while (0)
#define SCAN_STAGE_STORE(buf_) do { LAS float* vb_ = vecs + (buf_) * VB; _Pragma("unroll") for (int a_ = 0; a_ < 6; ++a_) *(LAS f32x4*)(vb_ + (a_ * TB + st) * 64 + 4 * sq) = sg[a_]; \
        if (tid < 2 * TB) vb_[6 * TB * 64 + tid] = sgs; } while (0)
    SCAN_STAGE_LOAD(0); SCAN_STAGE_STORE(0);
    __syncthreads();
    int buf = 0;
    for (int t0 = 0; t0 < T; t0 += TB, buf ^= 1) {
        const int nb = (T - t0) < TB ? (T - t0) : TB;
        const bool more = t0 + TB < T;
        if (more) SCAN_STAGE_LOAD(t0 + TB);
        const LAS float* vec = vecs + buf * VB; const LAS float* scl = vec + 6 * TB * 64;
#define SCAN_LOADIN(X, t_) do { const LAS float* p_ = vec + (t_) * 64 + 8 * seg8; \
        X.r0 = *(const LAS f32x4*)(p_); X.r1 = *(const LAS f32x4*)(p_ + 4); X.w0 = *(const LAS f32x4*)(p_ + TB * 64); X.w1 = *(const LAS f32x4*)(p_ + TB * 64 + 4); \
        X.k0 = *(const LAS f32x4*)(p_ + 2 * TB * 64); X.k1 = *(const LAS f32x4*)(p_ + 2 * TB * 64 + 4); X.a0 = *(const LAS f32x4*)(p_ + 4 * TB * 64); X.a1 = *(const LAS f32x4*)(p_ + 4 * TB * 64 + 4); \
        X.b0 = *(const LAS f32x4*)(p_ + 5 * TB * 64); X.b1 = *(const LAS f32x4*)(p_ + 5 * TB * 64 + 4); X.vi = vec[(3 * TB + (t_)) * 64 + i]; X.br = scl[2 * (t_)]; X.kr = scl[2 * (t_) + 1]; } while (0)
#define LO2(v) ((f32x2){(v)[0], (v)[1]})
#define HI2(v) ((f32x2){(v)[2], (v)[3]})
#define SCAN_STEP(X, Y, t_) do { \
        const f32x2 a_[4] = {LO2(X.a0), HI2(X.a0), LO2(X.a1), HI2(X.a1)}, r_[4] = {LO2(X.r0), HI2(X.r0), LO2(X.r1), HI2(X.r1)}; \
        const f32x2 w_[4] = {LO2(X.w0), HI2(X.w0), LO2(X.w1), HI2(X.w1)}, b_[4] = {LO2(X.b0), HI2(X.b0), LO2(X.b1), HI2(X.b1)}, k_[4] = {LO2(X.k0), HI2(X.k0), LO2(X.k1), HI2(X.k1)}; \
        const float br_ = X.br, kr_ = X.kr, vi_ = X.vi; \
        f32x2 d1 = S[0] * a_[0], d2 = S[0] * r_[0], f1 = Fm[0] * a_[0], f2 = Fm[0] * r_[0]; \
        _Pragma("unroll") for (int c = 1; c < 4; ++c) { d1 += S[c] * a_[c]; d2 += S[c] * r_[c]; f1 += Fm[c] * a_[c]; f2 += Fm[c] * r_[c]; } \
        f32x2 tS[4], tF[4]; _Pragma("unroll") for (int c = 0; c < 4; ++c) { tS[c] = S[c] * w_[c] + vi_ * k_[c]; tF[c] = Fm[c] * w_[c]; } \
        { int tn_ = (t_) + 1;     \
          asm volatile("" : "+v"(tn_) : "v"(d1), "v"(d2), "v"(f1), "v"(f2), "v"(tS[0]), "v"(tS[1]), "v"(tS[2]), "v"(tS[3]), "v"(tF[0]), "v"(tF[1]), "v"(tF[2]), "v"(tF[3])); \
          if ((t_) + 1 < nb) SCAN_LOADIN(Y, tn_); } \
        float q0 = d1.x + d1.y, q1 = d2.x + d2.y, q2 = f1.x + f1.y, q3 = f2.x + f2.y; \
        q0 += dpp_xor1(q0); q1 += dpp_xor1(q1); q2 += dpp_xor1(q2); q3 += dpp_xor1(q3); \
        q0 += dpp_xor2(q0); q1 += dpp_xor2(q1); q2 += dpp_xor2(q2); q3 += dpp_xor2(q3); \
        q0 += dpp_hmir(q0); q1 += dpp_hmir(q1); q2 += dpp_hmir(q2); q3 += dpp_hmir(q3); \
        _Pragma("unroll") for (int c = 0; c < 4; ++c) { S[c] = tS[c] + q0 * b_[c]; Fm[c] = tF[c] + q2 * b_[c]; } \
        if (seg8 == 0) { ybuf[(t_) * 64 + i] = q1 + q0 * br_ + vi_ * kr_; cbuf[(t_) * 64 + i] = q3 + q2 * br_; } } while (0)
        ScanIn IA, IB;
        SCAN_LOADIN(IA, 0);
        for (int t = 0; t < nb; t += 2) {
            SCAN_STEP(IA, IB, t);
            if (t + 1 < nb) SCAN_STEP(IB, IA, t + 1);
        }
        if (more) SCAN_STAGE_STORE(buf ^ 1);
        __syncthreads();
        { const int t = tid >> 4, q = tid & 15;
          if (t < nb) { const int row = row0 + t0 + t;
            const f32x4 yv = *(const LAS f32x4*)(ybuf + t * 64 + 4 * q);
            if (prompt) { *(f32x4*)(Y0 + (size_t)row * 512 + h * 64 + 4 * q) = yv; if (useF) *(f32x4*)(CC + (size_t)row * 512 + h * 64 + 4 * q) = *(const LAS f32x4*)(cbuf + t * 64 + 4 * q); }
            else gn_store(F, A, row, h, q, yv, *(const LAS f32x4*)(vec + (3 * TB + t) * 64 + 4 * q)); } }
        __syncthreads();
    }
#undef SCAN_STAGE_LOAD
#undef SCAN_STAGE_STORE
#undef SCAN_LOADIN
#undef SCAN_STEP
#undef LO2
#undef HI2
    const f32x4 s0v = {S[0].x, S[0].y, S[1].x, S[1].y}, s1v = {S[2].x, S[2].y, S[3].x, S[3].y};
    if (prompt) { float* ps = (float*)(F.ws + WS_PSI) + ((size_t)u * 64 + i) * 64 + 8 * seg8; *(f32x4*)ps = s0v; *(f32x4*)(ps + 4) = s1v;
        if (useF) { float* ph = (float*)(F.ws + WS_PHI) + ((size_t)u * 64 + i) * 64 + 8 * seg8; *(f32x4*)ph = (f32x4){Fm[0].x, Fm[0].y, Fm[1].x, Fm[1].y}; *(f32x4*)(ph + 4) = (f32x4){Fm[2].x, Fm[2].y, Fm[3].x, Fm[3].y}; } }
    else { float* so = F.out + O_WS + ((size_t)(u - 256) * 64 + i) * 64 + 8 * seg8; *(f32x4*)so = s0v; *(f32x4*)(so + 4) = s1v; }
    __syncthreads();
}
__device__ __forceinline__ void carry_unit(Frame& F, const Args& A, int bh) {
    LAS float* X = (LAS float*)(F.lds + RING_OFF);
    LAS float* P = X + 4096;
    const int tid = F.tid, i = tid >> 3, seg8 = tid & 7;
    float* SST = (float*)(F.ws + WS_SST); const float* PSI = (const float*)(F.ws + WS_PSI); const float* PHI = (const float*)(F.ws + WS_PHI);
    float cur[8];
#pragma unroll
    for (int c = 0; c < 8; ++c) cur[c] = 0.f;
    for (int k = 0; k < NSEG; ++k) {
        const size_t uo = ((size_t)(bh * NSEG + k) * 64 + i) * 64 + 8 * seg8;
        *(f32x4*)(SST + uo) = (f32x4){cur[0], cur[1], cur[2], cur[3]}; *(f32x4*)(SST + uo + 4) = (f32x4){cur[4], cur[5], cur[6], cur[7]};
        const f32x4 p0 = *(const f32x4*)(PSI + uo), p1 = *(const f32x4*)(PSI + uo + 4);
        float nx[8] = {p0[0], p0[1], p0[2], p0[3], p1[0], p1[1], p1[2], p1[3]};
        if (k > 0) {
            __syncthreads();
            *(LAS f32x4*)(X + i * 64 + 8 * seg8) = (f32x4){cur[0], cur[1], cur[2], cur[3]}; *(LAS f32x4*)(X + i * 64 + 8 * seg8 + 4) = (f32x4){cur[4], cur[5], cur[6], cur[7]};
            *(LAS f32x4*)(P + i * 64 + 8 * seg8) = *(const f32x4*)(PHI + uo); *(LAS f32x4*)(P + i * 64 + 8 * seg8 + 4) = *(const f32x4*)(PHI + uo + 4);
            __syncthreads();
#pragma unroll 4
            for (int l = 0; l < 64; ++l) { const float x = X[i * 64 + l]; const f32x4 q0 = *(const LAS f32x4*)(P + l * 64 + 8 * seg8), q1 = *(const LAS f32x4*)(P + l * 64 + 8 * seg8 + 4);
#pragma unroll
                for (int c = 0; c < 4; ++c) { nx[c] += x * q0[c]; nx[4 + c] += x * q1[c]; } }
        }
#pragma unroll
        for (int c = 0; c < 8; ++c) cur[c] = nx[c];
    }
    float* so = F.out + O_WP + ((size_t)bh * 64 + i) * 64 + 8 * seg8; *(f32x4*)so = (f32x4){cur[0], cur[1], cur[2], cur[3]}; *(f32x4*)(so + 4) = (f32x4){cur[4], cur[5], cur[6], cur[7]};
    __syncthreads();
}
__device__ __forceinline__ void corr_unit(Frame& F, const Args& A, int u) {
    const int lane = F.lane, w = F.wave, r32 = lane & 31, hi = lane >> 5, seg = u & 7, bh = u >> 3, h = bh & 7, rowseg = (bh >> 3) * SEQ + seg * SEGT;
    const float* SST = (const float*)(F.ws + WS_SST) + (size_t)u * 4096; const float* CC = (const float*)(F.ws + WS_CC); const float* Y0 = (const float*)(F.ws + WS_Y0);
    const float* BON = (const float*)(F.ws + WS_BON3); const bf16* aG = rk_bf(F, 6); const bf16* aV = rk_bf(F, 3); bf16* RW = (bf16*)(F.ws + WS_RW);
    bf16x8 sb[2][4];
    if (seg > 0) {
#pragma unroll
        for (int ct = 0; ct < 2; ++ct)
#pragma unroll
            for (int ks = 0; ks < 4; ++ks) { const float* p = SST + (size_t)(32 * ct + r32) * 64 + 16 * ks + 8 * hi; const f32x4 x = *(const f32x4*)p, y = *(const f32x4*)(p + 4);
                const v4u t = {pk2(x[0], x[1]), pk2(x[2], x[3]), pk2(y[0], y[1]), pk2(y[2], y[3])}; sb[ct][ks] = __builtin_bit_cast(bf16x8, t); }
    }
    float gw[2], gb[2];
#pragma unroll
    for (int ct = 0; ct < 2; ++ct) { gw[ct] = A.in[I_GNW][h * 64 + 32 * ct + r32]; gb[ct] = A.in[I_GNB][h * 64 + 32 * ct + r32]; }
    for (int blk = w; blk < SEGT / 32; blk += NWAVES) {
        const int row0 = rowseg + 32 * blk;
        f32x16 d[2]; d[0] = (f32x16){}; d[1] = (f32x16){};
        float yv0[16], yv1[16], bnv[16]; unsigned vgv0[16], vgv1[16];
#pragma unroll
        for (int r = 0; r < 16; ++r) { const int row = row0 + crow16(r, hi); const size_t o = (size_t)row * 512 + h * 64 + r32;
            yv0[r] = Y0[o]; yv1[r] = Y0[o + 32]; vgv0[r] = rk_pair(F, 2)[o]; vgv1[r] = rk_pair(F, 2)[o + 32]; bnv[r] = BON[(row * 8 + h) * 4]; }
        if (seg > 0) {
#pragma unroll
            for (int ks = 0; ks < 4; ++ks) { const float* p = CC + (size_t)(row0 + r32) * 512 + h * 64 + 16 * ks + 8 * hi; const f32x4 x = *(const f32x4*)p, y = *(const f32x4*)(p + 4);
                const v4u t = {pk2(x[0], x[1]), pk2(x[2], x[3]), pk2(y[0], y[1]), pk2(y[2], y[3])}; const bf16x8 cf = __builtin_bit_cast(bf16x8, t);
                d[0] = __builtin_amdgcn_mfma_f32_32x32x16_bf16(cf, sb[0][ks], d[0], 0, 0, 0); d[1] = __builtin_amdgcn_mfma_f32_32x32x16_bf16(cf, sb[1][ks], d[1], 0, 0, 0); }
        }
#pragma unroll
        for (int r = 0; r < 16; ++r) {
            const int row = row0 + crow16(r, hi); const size_t o = (size_t)row * 512 + h * 64 + r32;
            const float y0 = yv0[r] + d[0][r], y1 = yv1[r] + d[1][r];
            const float mean = sum32(y0 + y1) * (1.f / 64.f), e0 = y0 - mean, e1 = y1 - mean;
            const float rstd = rsqrtf(sum32(e0 * e0 + e1 * e1) * (1.f / 64.f) + 64e-5f), bon = bnv[r];
            const unsigned vg0 = vgv0[r], vg1 = vgv1[r];
            const float o0 = (e0 * rstd * gw[0] + gb[0] + bon * bflo(vg0)) * bfhi(vg0), o1 = (e1 * rstd * gw[1] + gb[1] + bon * bflo(vg1)) * bfhi(vg1);
            RW[o] = (bf16)(pk2(o0, 0.f) & 0xffffu); RW[o + 32] = (bf16)(pk2(o1, 0.f) & 0xffffu);
        }
    }
}

typedef short v4i16_t __attribute__((ext_vector_type(4)));
__device__ __forceinline__ s16x4 vtr(const LAS unsigned char* p) { return __builtin_bit_cast(s16x4, __builtin_amdgcn_ds_read_tr16_b64_v4i16((LAS v4i16_t*)p)); }
constexpr int IMG_LD = 136;
constexpr int IMG_BYTES = 64 * IMG_LD;
typedef bf16x8 Frag[2][4];
__device__ __forceinline__ void mm64(const Frag& Af, const Frag& Bf, f32x16 (&D)[2][2]) {
#pragma unroll
    for (int rt = 0; rt < 2; ++rt)
#pragma unroll
        for (int ct = 0; ct < 2; ++ct)
#pragma unroll
            for (int ks = 0; ks < 4; ++ks) D[rt][ct] = __builtin_amdgcn_mfma_f32_32x32x16_bf16(Af[rt][ks], Bf[ct][ks], D[rt][ct], 0, 0, 0);
}
__device__ __forceinline__ void acc_zero(f32x16 (&D)[2][2]) {
#pragma unroll
    for (int a = 0; a < 2; ++a)
#pragma unroll
        for (int b = 0; b < 2; ++b) D[a][b] = (f32x16){};
}
__device__ __forceinline__ void acc_frag(const f32x16 (&X)[2][2], Frag& Fr) {
#pragma unroll
    for (int rt = 0; rt < 2; ++rt)
#pragma unroll
        for (int ct = 0; ct < 2; ++ct)
#pragma unroll
            for (int hf = 0; hf < 2; ++hf) { const int rb = 8 * hf;
                const v4u u = {pk2(X[rt][ct][rb], X[rt][ct][rb + 1]), pk2(X[rt][ct][rb + 2], X[rt][ct][rb + 3]), pk2(X[rt][ct][rb + 4], X[rt][ct][rb + 5]), pk2(X[rt][ct][rb + 6], X[rt][ct][rb + 7])};
                Fr[ct][2 * rt + hf] = __builtin_bit_cast(bf16x8, u); }
}
__device__ __forceinline__ void rowfrag(const LAS unsigned char* img, int lane, Frag& Fr) {
    const int r32 = lane & 31, hi = lane >> 5;
#pragma unroll
    for (int tl = 0; tl < 2; ++tl)
#pragma unroll
        for (int ks = 0; ks < 4; ++ks) Fr[tl][ks] = *(const LAS bf16x8*)(img + (32 * tl + r32) * IMG_LD + (16 * ks + 8 * hi) * 2);
}
__device__ __forceinline__ void rowfrag_perm(const LAS unsigned char* img, int lane, Frag& Fr) {
    const int r32 = lane & 31, hi = lane >> 5;
#pragma unroll
    for (int tl = 0; tl < 2; ++tl)
#pragma unroll
        for (int ks = 0; ks < 4; ++ks) { const LAS unsigned char* p = img + (32 * tl + r32) * IMG_LD + (16 * ks + 4 * hi) * 2;
            const v2u a = *(const LAS v2u*)p, b = *(const LAS v2u*)(p + 16); const v4u u = {a.x, a.y, b.x, b.y}; Fr[tl][ks] = __builtin_bit_cast(bf16x8, u); }
}
__device__ __forceinline__ void colfrag_tr(const LAS unsigned char* img, int lane, Frag& Fr) {
    const int hi = lane >> 5, qq = (lane & 15) >> 2, p4 = lane & 3, cg = (lane >> 4) & 1;
    const LAS unsigned char* base = img + (4 * hi + qq) * IMG_LD + (16 * cg + 4 * p4) * 2;
#pragma unroll
    for (int tl = 0; tl < 2; ++tl)
#pragma unroll
        for (int ks = 0; ks < 4; ++ks) { const LAS unsigned char* p = base + (16 * ks) * IMG_LD + (32 * tl) * 2;
            const s16x4 lo = vtr(p), hh = vtr(p + 8 * IMG_LD); Fr[tl][ks] = (bf16x8){lo[0], lo[1], lo[2], lo[3], hh[0], hh[1], hh[2], hh[3]}; }
}
__device__ __forceinline__ void img_load(const bf16* g, LAS unsigned char* slot, int lane) {
    asm volatile("" ::: "memory");
    const unsigned char* gb = (const unsigned char*)g + (unsigned)(lane * 16);
    LAS unsigned char* sl_ = slot + (lane >> 3) * IMG_LD + (lane & 7) * 16;
#pragma unroll
    for (int hb = 0; hb < 2; ++hb) { v4u t[4];
#pragma unroll
        for (int k = 0; k < 4; ++k) t[k] = *(const v4u*)(gb + 1024 * (4 * hb + k));
#pragma unroll
        for (int k = 0; k < 4; ++k) *(LAS v4u*)(sl_ + (8 * (4 * hb + k)) * IMG_LD) = t[k];
        asm volatile("" ::: "memory"); }
}
__device__ __forceinline__ void acc_to_img(const f32x16 (&X)[2][2], LAS unsigned char* slot, int lane) {
    const int r32 = lane & 31, hi = lane >> 5; LAS unsigned char* lb = slot + (4 * hi) * IMG_LD + r32 * 2;
#pragma unroll
    for (int rt = 0; rt < 2; ++rt)
#pragma unroll
        for (int ct = 0; ct < 2; ++ct)
        { asm volatile("" ::: "memory");
#pragma unroll
            for (int r = 0; r < 16; ++r) *(LAS bf16*)(lb + (32 * rt + CRC(r)) * IMG_LD + (32 * ct) * 2) = (bf16)(pk2(X[rt][ct][r], 0.f) & 0xffffu); }
}
__device__ __forceinline__ void acc_to_gbf(const f32x16 (&X)[2][2], bf16* g, int lane) {
    const int r32 = lane & 31, hi = lane >> 5; bf16* gl = g + (4 * hi) * 64 + r32;
#pragma unroll
    for (int rt = 0; rt < 2; ++rt)
#pragma unroll
        for (int ct = 0; ct < 2; ++ct)
        { asm volatile("" ::: "memory");
#pragma unroll
            for (int r = 0; r < 16; ++r) gl[(32 * rt + CRC(r)) * 64 + 32 * ct] = (bf16)(pk2(X[rt][ct][r], 0.f) & 0xffffu); }
}
__device__ __forceinline__ void acc_to_gf32(const f32x16 (&X)[2][2], float* g, int lane) {
    const int r32 = lane & 31, hi = lane >> 5; float* gl = g + (4 * hi) * 64 + r32;
#pragma unroll
    for (int rt = 0; rt < 2; ++rt)
#pragma unroll
        for (int ct = 0; ct < 2; ++ct)
        { asm volatile("" ::: "memory");
#pragma unroll
            for (int r = 0; r < 16; ++r) gl[(32 * rt + CRC(r)) * 64 + 32 * ct] = X[rt][ct][r]; }
}
template <bool STRICT> __device__ __forceinline__ void mask_upper(f32x16 (&X)[2][2], int lane) {
    const int r32 = lane & 31, hi = lane >> 5, dl = 4 * hi - r32;
#pragma unroll
    for (int rt = 0; rt < 2; ++rt)
#pragma unroll
        for (int ct = 0; ct < 2; ++ct)
#pragma unroll
            for (int r = 0; r < 16; ++r) { const int dlt = dl + (32 * rt + CRC(r) - 32 * ct); const bool keep = STRICT ? (dlt < 0) : (dlt <= 0); if (!keep) X[rt][ct][r] = 0.f; }
}
template <int RT> __device__ __forceinline__ void mm_rt(const Frag& Af, const Frag& Bf, f32x16 (&D)[2]) {
#pragma unroll
    for (int ct = 0; ct < 2; ++ct)
#pragma unroll
        for (int ks = 0; ks < 4; ++ks) D[ct] = __builtin_amdgcn_mfma_f32_32x32x16_bf16(Af[RT][ks], Bf[ct][ks], D[ct], 0, 0, 0);
}
template <int RT> __device__ __forceinline__ void frag_rt(const f32x16 (&D)[2], Frag& Fr) {
#pragma unroll
    for (int ct = 0; ct < 2; ++ct)
#pragma unroll
        for (int hf = 0; hf < 2; ++hf) { const int rb = 8 * hf;
            const v4u u = {pk2(D[ct][rb], D[ct][rb + 1]), pk2(D[ct][rb + 2], D[ct][rb + 3]), pk2(D[ct][rb + 4], D[ct][rb + 5]), pk2(D[ct][rb + 6], D[ct][rb + 7])};
            Fr[ct][2 * RT + hf] = __builtin_bit_cast(bf16x8, u); }
}
template <int RT, bool STRICT> __device__ __forceinline__ void mask_rt(f32x16 (&D)[2], int lane) {
    const int dl = 4 * (lane >> 5) - (lane & 31);
#pragma unroll
    for (int ct = 0; ct < 2; ++ct)
#pragma unroll
        for (int r = 0; r < 16; ++r) { const int dlt = dl + (32 * RT + CRC(r) - 32 * ct); const bool keep = STRICT ? (dlt < 0) : (dlt <= 0); if (!keep) D[ct][r] = 0.f; }
}
template <int RT> __device__ __forceinline__ void st_f32_rt(const f32x16 (&D)[2], float* g, int lane) { float* gl = g + (4 * (lane >> 5)) * 64 + (lane & 31);
#pragma unroll
    for (int ct = 0; ct < 2; ++ct) { asm volatile("" ::: "memory");
#pragma unroll
        for (int r = 0; r < 16; ++r) gl[(32 * RT + CRC(r)) * 64 + 32 * ct] = D[ct][r]; } }
template <int RT> __device__ __forceinline__ void st_bf_rt(const f32x16 (&D)[2], bf16* g, int lane) { bf16* gl = g + (4 * (lane >> 5)) * 64 + (lane & 31);
#pragma unroll
    for (int ct = 0; ct < 2; ++ct) { asm volatile("" ::: "memory");
#pragma unroll
        for (int r = 0; r < 16; ++r) gl[(32 * RT + CRC(r)) * 64 + 32 * ct] = (bf16)(pk2(D[ct][r], 0.f) & 0xffffu); } }
template <int RT> __device__ __forceinline__ void ld_f32_rt(f32x16 (&D)[2], const float* g, int lane) { const float* gl = g + (4 * (lane >> 5)) * 64 + (lane & 31);
#pragma unroll
    for (int ct = 0; ct < 2; ++ct) { asm volatile("" ::: "memory");
#pragma unroll
        for (int r = 0; r < 16; ++r) D[ct][r] = gl[(32 * RT + CRC(r)) * 64 + 32 * ct]; } }
template <int RT> __device__ __forceinline__ void scale_rt(f32x16 (&D)[2], const float* gcl  ) {
#pragma unroll
    for (int ct = 0; ct < 2; ++ct)
#pragma unroll
        for (int r = 0; r < 16; ++r) D[ct][r] *= gcl[32 * RT + CRC(r)]; }
__device__ __forceinline__ void zero2(f32x16 (&D)[2]) { D[0] = (f32x16){}; D[1] = (f32x16){}; }
__device__ __forceinline__ void tfrag(const f32x16& T, bf16x8& f0, bf16x8& f1) {
    const v4u u0 = {pk2(T[0], T[1]), pk2(T[2], T[3]), pk2(T[4], T[5]), pk2(T[6], T[7])}, u1 = {pk2(T[8], T[9]), pk2(T[10], T[11]), pk2(T[12], T[13]), pk2(T[14], T[15])};
    f0 = __builtin_bit_cast(bf16x8, u0); f1 = __builtin_bit_cast(bf16x8, u1);
}
__device__ __forceinline__ void tmm(const bf16x8 (&a)[2], const bf16x8 (&b)[2], f32x16& d) {
    d = __builtin_amdgcn_mfma_f32_32x32x16_bf16(a[0], b[0], d, 0, 0, 0); d = __builtin_amdgcn_mfma_f32_32x32x16_bf16(a[1], b[1], d, 0, 0, 0);
}
__device__ __forceinline__ void tprod(const Frag& A_, int ra, const Frag& B_, int rb, f32x16& d) {
#pragma unroll
    for (int ks = 0; ks < 4; ++ks) d = __builtin_amdgcn_mfma_f32_32x32x16_bf16(A_[ra][ks], B_[rb][ks], d, 0, 0, 0);
}
template <bool WANT_ZT> __device__ __forceinline__ void diag_inv(f32x16& Q, f32x16& QT, f32x16& Z, f32x16& ZT, int lane) {
    const int dl = 4 * (lane >> 5) - (lane & 31);
#pragma unroll
    for (int r = 0; r < 16; ++r) { const int d = dl + CRC(r); Q[r] = d < 0 ? Q[r] : 0.f; QT[r] = d > 0 ? QT[r] : 0.f; const float id = d == 0 ? 1.f : 0.f; Z[r] = Q[r] + id; ZT[r] = QT[r] + id; }
#pragma unroll 1
    for (int lvl = 0; lvl < 4; ++lvl) {
        bf16x8 fq[2], fqt[2], fz[2];
        tfrag(Q, fq[0], fq[1]); tfrag(QT, fqt[0], fqt[1]);
        Q = (f32x16){}; QT = (f32x16){}; tmm(fqt, fq, Q); tmm(fq, fqt, QT);
        tfrag(Q, fq[0], fq[1]); tfrag(QT, fqt[0], fqt[1]);
        tfrag(Z, fz[0], fz[1]); tmm(fqt, fz, Z);
        if (WANT_ZT) { tfrag(ZT, fz[0], fz[1]); tmm(fq, fz, ZT); }
    }
}
constexpr int NCHK = SEQ / 64;
__device__ __forceinline__ void chunk_prescale(Frame& F, int hc) {
    const int lane = F.lane, bh = hc >> 6, c = hc & 63, h = bh & 7, row0 = (bh >> 3) * SEQ + c * 64;
    bf16* sc = (bf16*)(F.ws + WS_SC) + (size_t)hc * 5 * 4096 + lane;
    const size_t o0 = (size_t)row0 * 512 + h * 64 + lane;
    const float* aW = rk_arr(F, 1) + o0; const unsigned* pRK = rk_pair(F, 0) + o0; const unsigned* pVG = rk_pair(F, 2) + o0; const unsigned* pAB = rk_pair(F, 4) + o0;
    float lc = 0.f;
    float wA[16], wB[16]; unsigned rkA[16], rkB[16], vgA[16], vgB[16], abA[16], abB[16];
#define PS_LOAD(S, tb) do { _Pragma("unroll") for (int i = 0; i < 16; ++i) { const int t = 16 * (tb) + i; w##S[i] = aW[t * 512]; rk##S[i] = pRK[t * 512]; vg##S[i] = pVG[t * 512]; ab##S[i] = pAB[t * 512]; } } while (0)
#define PS_COMP(S, tb) do { _Pragma("unroll") for (int i = 0; i < 16; ++i) { const int t = 16 * (tb) + i; \
        const float em = __expf(lc); lc += __logf(w##S[i]); const float ei = __expf(-lc); \
        sc[0 * 4096 + t * 64] = (bf16)(pk2(bflo(ab##S[i]) * em, 0.f) & 0xffffu); \
        sc[1 * 4096 + t * 64] = (bf16)(pk2(bfhi(ab##S[i]) * ei, 0.f) & 0xffffu); \
        sc[2 * 4096 + t * 64] = (bf16)(pk2(bfhi(rk##S[i]) * ei, 0.f) & 0xffffu); \
        sc[3 * 4096 + t * 64] = (bf16)(pk2(bflo(rk##S[i]) * em, 0.f) & 0xffffu); \
        sc[4 * 4096 + t * 64] = (bf16)(vg##S[i] & 0xffffu); } } while (0)
    PS_LOAD(A, 0); PS_LOAD(B, 1);
    PS_COMP(A, 0); asm volatile("" ::: "memory"); PS_LOAD(A, 2);
    PS_COMP(B, 1); asm volatile("" ::: "memory"); PS_LOAD(B, 3);
    PS_COMP(A, 2); PS_COMP(B, 3);
#undef PS_LOAD
#undef PS_COMP
    ((float*)(F.ws + WS_GC))[(size_t)hc * 64 + lane] = __expf(lc);
}
__device__ __forceinline__ void chunk_unit(Frame& F, int hc) {
    const int lane = F.lane, r32 = lane & 31, hi = lane >> 5;
    LAS unsigned char* s0 = F.lds + RING_OFF + F.wave * (2 * IMG_BYTES); LAS unsigned char* s1 = s0 + IMG_BYTES; const LAS unsigned char* s1l = s1 + (4 * hi) * IMG_LD + r32 * 2;
    SUBM(0);
    const float* rho = (const float*)(F.ws + WS_HT) + (size_t)(((hc >> 9) * 64 + (hc & 63)) * 2) * 512 + ((hc >> 6) & 7) * 64; const float* sig = rho + 512;
    ((float*)(F.ws + WS_GC))[(size_t)hc * 64 + lane] = rho[lane] * sig[lane];
    SUBM(1);
    const bf16* sc = (const bf16*)(F.ws + WS_SC) + (size_t)hc * 5 * 4096;
    const bf16* gAb = sc; const bf16* gBb = sc + 4096; const bf16* gKb = sc + 2 * 4096; const bf16* gRb = sc + 3 * 4096; const bf16* gV = sc + 4 * 4096;
    Frag fa, fb, zf, uf, af;
    {
        f32x16 Q, QT, Z, ZT; bf16x8 zt11[2], z22[2], t0[2], t1[2];
        img_load(gAb, s0, lane); img_load(gBb, s1, lane);
        rowfrag(s1, lane, fa); rowfrag(s0, lane, fb);
        Q = (f32x16){}; QT = (f32x16){}; tprod(fa, 0, fb, 0, Q); tprod(fb, 0, fa, 0, QT); diag_inv<true>(Q, QT, Z, ZT, lane);
        tfrag(Z, zf[0][0], zf[0][1]); tfrag(ZT, zt11[0], zt11[1]);
        Q = (f32x16){}; QT = (f32x16){}; tprod(fa, 1, fb, 1, Q); tprod(fb, 1, fa, 1, QT); diag_inv<false>(Q, QT, Z, ZT, lane);
        tfrag(Z, z22[0], z22[1]); zf[1][2] = z22[0]; zf[1][3] = z22[1];
        QT = (f32x16){}; tprod(fb, 1, fa, 0, QT);
        tfrag(QT, t0[0], t0[1]); Q = (f32x16){}; tmm(t0, z22, Q);
        tfrag(Q, t1[0], t1[1]); Z = (f32x16){}; tmm(zt11, t1, Z);
        tfrag(Z, zf[1][0], zf[1][1]);
        zf[0][2] = (bf16x8){}; zf[0][3] = (bf16x8){};
    }
    SUBM(2);
    f32x16 D[2];
    img_load(gKb, s1, lane);
    rowfrag(s1, lane, fa); rowfrag(s0, lane, fb);
    zero2(D); mm_rt<0>(fa, fb, D); mask_rt<0, true>(D, lane); frag_rt<0>(D, uf);
    zero2(D); mm_rt<1>(fa, fb, D); mask_rt<1, true>(D, lane); frag_rt<1>(D, uf);
    img_load(gV, s1, lane); colfrag_tr(s1, lane, fb);
    zero2(D); mm_rt<0>(uf, fb, D); frag_rt<0>(D, fa);
    zero2(D); mm_rt<1>(uf, fb, D); frag_rt<1>(D, fa);
    zero2(D); mm_rt<0>(zf, fa, D); frag_rt<0>(D, uf);
    zero2(D); mm_rt<1>(zf, fa, D); frag_rt<1>(D, uf);
    colfrag_tr(s0, lane, fa);
    zero2(D); mm_rt<0>(zf, fa, D); frag_rt<0>(D, af);
    zero2(D); mm_rt<1>(zf, fa, D); frag_rt<1>(D, af);
    SUBM(3);
    const float* gcg = sig + 4 * hi; const float* rhg = rho + 4 * hi;
    img_load(gKb, s0, lane); colfrag_tr(s0, lane, zf);
    img_load(gBb, s0, lane); colfrag_tr(s0, lane, fa);
    { unsigned char* slfb = F.ws + WS_SL + (size_t)hc * 8192 + lane * 8; unsigned char* gpfb = F.ws + WS_GP + (size_t)hc * 8192 + lane * 16;
      zero2(D); mm_rt<0>(zf, fb, D); mm_rt<0>(fa, uf, D); scale_rt<0>(D, gcg);
#pragma unroll
      for (int ct = 0; ct < 2; ++ct)
#pragma unroll
          for (int q = 0; q < 4; ++q) *(v2u*)(slfb + ((ct * 2 + 0) * 4 + q) * 512) = (v2u){pk2(D[ct][4 * q], D[ct][4 * q + 1]), pk2(D[ct][4 * q + 2], D[ct][4 * q + 3])};
      zero2(D); mm_rt<1>(zf, fb, D); mm_rt<1>(fa, uf, D); scale_rt<1>(D, gcg);
#pragma unroll
      for (int ct = 0; ct < 2; ++ct)
#pragma unroll
          for (int q = 0; q < 4; ++q) *(v2u*)(slfb + ((ct * 2 + 1) * 4 + q) * 512) = (v2u){pk2(D[ct][4 * q], D[ct][4 * q + 1]), pk2(D[ct][4 * q + 2], D[ct][4 * q + 3])};
      const float gc0 = sig[r32], gc1 = sig[32 + r32];
      zero2(D); mm_rt<0>(af, fa, D); D[0] *= gc0; D[1] *= gc1; scale_rt<0>(D, rhg); frag_rt<0>(D, zf);
      zero2(D); mm_rt<1>(af, fa, D); D[0] *= gc0; D[1] *= gc1; scale_rt<1>(D, rhg); frag_rt<1>(D, zf);
#pragma unroll
      for (int tl = 0; tl < 2; ++tl)
#pragma unroll
          for (int ks = 0; ks < 4; ++ks) *(bf16x8*)(gpfb + (tl * 4 + ks) * 1024) = zf[tl][ks]; }
    SUBM(4);
    img_load(gRb, s1, lane);
    rowfrag(s0, lane, fa); rowfrag(s1, lane, fb);
    zero2(D); mm_rt<0>(fa, fb, D); mask_rt<0, false>(D, lane); frag_rt<0>(D, zf);
    zero2(D); mm_rt<1>(fa, fb, D); mask_rt<1, false>(D, lane); frag_rt<1>(D, zf);
    { const LAS unsigned char* s1t = s1 + r32 * IMG_LD + hi * 8;
      unsigned char* rhfb = F.ws + WS_RH + (size_t)hc * 8192 + lane * 16;
#pragma unroll
      for (int ct = 0; ct < 2; ++ct)
#pragma unroll
          for (int q = 0; q < 4; ++q) { const v2u w_ = *(const LAS v2u*)(s1t + (32 * ct) * IMG_LD + (8 * q) * 2);
              D[ct][4 * q] = bflo(w_.x); D[ct][4 * q + 1] = bfhi(w_.x); D[ct][4 * q + 2] = bflo(w_.y); D[ct][4 * q + 3] = bfhi(w_.y); }
      mm_rt<0>(af, zf, D); scale_rt<0>(D, rhg); frag_rt<0>(D, fa);
#pragma unroll
      for (int ct = 0; ct < 2; ++ct)
#pragma unroll
          for (int q = 0; q < 4; ++q) { const v2u w_ = *(const LAS v2u*)(s1t + (32 * ct) * IMG_LD + (32 + 8 * q) * 2);
              D[ct][4 * q] = bflo(w_.x); D[ct][4 * q + 1] = bfhi(w_.x); D[ct][4 * q + 2] = bflo(w_.y); D[ct][4 * q + 3] = bfhi(w_.y); }
      mm_rt<1>(af, zf, D); scale_rt<1>(D, rhg); frag_rt<1>(D, fa);
#pragma unroll
      for (int tl = 0; tl < 2; ++tl)
#pragma unroll
          for (int ks = 0; ks < 4; ++ks) *(bf16x8*)(rhfb + (tl * 4 + ks) * 1024) = fa[tl][ks]; }
    SUBM(5);
    img_load(gKb, s0, lane);
    rowfrag(s0, lane, fa); rowfrag(s1, lane, fb);
    zero2(D); mm_rt<0>(fa, fb, D); mask_rt<0, false>(D, lane); frag_rt<0>(D, af);
    zero2(D); mm_rt<1>(fa, fb, D); mask_rt<1, false>(D, lane); frag_rt<1>(D, af);
    img_load(gV, s1, lane); colfrag_tr(s1, lane, fb);
    { unsigned char* ylfb = F.ws + WS_YL + (size_t)hc * 16384 + lane * 16;
      zero2(D); mm_rt<0>(zf, uf, D); mm_rt<0>(af, fb, D);
#pragma unroll
      for (int ct = 0; ct < 2; ++ct)
#pragma unroll
          for (int q = 0; q < 4; ++q) *(f32x4*)(ylfb + ((0 * 2 + ct) * 4 + q) * 1024) = (f32x4){D[ct][4 * q], D[ct][4 * q + 1], D[ct][4 * q + 2], D[ct][4 * q + 3]};
      zero2(D); mm_rt<1>(zf, uf, D); mm_rt<1>(af, fb, D);
#pragma unroll
      for (int ct = 0; ct < 2; ++ct)
#pragma unroll
          for (int q = 0; q < 4; ++q) *(f32x4*)(ylfb + ((1 * 2 + ct) * 4 + q) * 1024) = (f32x4){D[ct][4 * q], D[ct][4 * q + 1], D[ct][4 * q + 2], D[ct][4 * q + 3]}; }
    SUBM(6);
}
__device__ __forceinline__ void chain_unit(Frame& F, int gwv) {
    const int lane = F.lane, r32 = lane & 31, hi = lane >> 5, bh = gwv >> 1, ct = gwv & 1;
    const unsigned char* gpf = F.ws + WS_GP + (size_t)bh * NCHK * 8192 + lane * 16;
    const unsigned char* slf = F.ws + WS_SL + (size_t)bh * NCHK * 8192 + ct * 4096 + lane * 8;
    const float* gcl = (const float*)(F.ws + WS_GC) + (size_t)bh * NCHK * 64 + lane;
    unsigned char* xcf = F.ws + WS_XC + (size_t)bh * NCHK * 8192 + ct * 4096 + lane * 16;
    f32x16 X[2]; X[0] = (f32x16){}; X[1] = (f32x16){};
    v4u gA[8], gB[8], gC[8]; v2u sA[8], sB[8], sC[8]; float mA, mB, mC; const int hb = 16 * hi;
#define CH_LOAD(S) do { _Pragma("unroll") for (int k = 0; k < 8; ++k) { g##S[k] = *(const v4u*)(gpf + k * 1024); s##S[k] = *(const v2u*)(slf + k * 512); } m##S = *gcl; gpf += 8192; slf += 8192; gcl += 64; } while (0)
#define CH_STEP(S) do { bf16x8 xh[4]; \
        _Pragma("unroll") for (int rt = 0; rt < 2; ++rt) _Pragma("unroll") for (int hf = 0; hf < 2; ++hf) { const int rb = 8 * hf; \
            const v4u u = {pk2(X[rt][rb], X[rt][rb + 1]), pk2(X[rt][rb + 2], X[rt][rb + 3]), pk2(X[rt][rb + 4], X[rt][rb + 5]), pk2(X[rt][rb + 6], X[rt][rb + 7])}; \
            xh[2 * rt + hf] = __builtin_bit_cast(bf16x8, u); } \
        _Pragma("unroll") for (int ks = 0; ks < 4; ++ks) *(bf16x8*)(xcf + ks * 1024) = xh[ks]; \
        xcf += 8192; \
        _Pragma("unroll") for (int rt = 0; rt < 2; ++rt) _Pragma("unroll") for (int q = 0; q < 4; ++q) _Pragma("unroll") for (int e = 0; e < 4; ++e) { \
            const float gm_ = __builtin_bit_cast(float, __builtin_amdgcn_ds_bpermute(4 * (32 * rt + 8 * q + e) + hb, __builtin_bit_cast(int, m##S)));     \
            const unsigned sw_ = (e < 2) ? s##S[rt * 4 + q].x : s##S[rt * 4 + q].y; \
            X[rt][4 * q + e] = gm_ * X[rt][4 * q + e] + ((e & 1) ? bfhi(sw_) : bflo(sw_)); } \
        _Pragma("unroll") for (int rt = 0; rt < 2; ++rt) _Pragma("unroll") for (int ks = 0; ks < 4; ++ks) \
            X[rt] = __builtin_amdgcn_mfma_f32_32x32x16_bf16(__builtin_bit_cast(bf16x8, g##S[rt * 4 + ks]), xh[ks], X[rt], 0, 0, 0); } while (0)
    static_assert(NCHK % 3 == 1, "chain_unit: 21 x 3 steps + 1");
    CH_LOAD(A); CH_LOAD(B);
#pragma unroll 1
    for (int c = 0; c < NCHK - 1; c += 3) {
        CH_LOAD(C); CH_STEP(A);
        CH_LOAD(A); CH_STEP(B);
        if (c + 4 < NCHK) CH_LOAD(B);
        CH_STEP(C);
    }
    CH_STEP(A);
#undef CH_LOAD
#undef CH_STEP
    float* so = F.out + O_WP + (size_t)bh * 4096 + (32 * ct + r32) * 64 + 4 * hi;
#pragma unroll
    for (int rt = 0; rt < 2; ++rt)
#pragma unroll
        for (int r = 0; r < 16; ++r) so[32 * rt + CRC(r)] = X[rt][r];
}
__device__ __forceinline__ void ypass_unit(Frame& F, const Args& A, int hc) {
    const int lane = F.lane, r32 = lane & 31, hi = lane >> 5, bh = hc >> 6, c = hc & 63, h = bh & 7, row0 = (bh >> 3) * SEQ + c * 64;
    Frag fa, fb;
    { const unsigned char* xcf = F.ws + WS_XC + (size_t)hc * 8192 + lane * 16;
#pragma unroll
      for (int ct = 0; ct < 2; ++ct)
#pragma unroll
          for (int ks = 0; ks < 4; ++ks) fb[ct][ks] = *(const bf16x8*)(xcf + (ct * 4 + ks) * 1024); }
    { const unsigned char* rhf = F.ws + WS_RH + (size_t)hc * 8192 + lane * 16;
#pragma unroll
      for (int tl = 0; tl < 2; ++tl)
#pragma unroll
          for (int ks = 0; ks < 4; ++ks) fa[tl][ks] = *(const bf16x8*)(rhf + (tl * 4 + ks) * 1024); }
    f32x16 Y[2][2];
    { const unsigned char* ylf = F.ws + WS_YL + (size_t)hc * 16384 + lane * 16;
#pragma unroll
      for (int rt = 0; rt < 2; ++rt)
#pragma unroll
          for (int ct = 0; ct < 2; ++ct)
#pragma unroll
              for (int q = 0; q < 4; ++q) { const f32x4 v_ = *(const f32x4*)(ylf + ((rt * 2 + ct) * 4 + q) * 1024);
                  Y[rt][ct][4 * q] = v_[0]; Y[rt][ct][4 * q + 1] = v_[1]; Y[rt][ct][4 * q + 2] = v_[2]; Y[rt][ct][4 * q + 3] = v_[3]; } }
    const float* BON = (const float*)(F.ws + WS_BON3) + (size_t)(row0 + 4 * hi) * 32 + h * 4; bf16* RW = (bf16*)(F.ws + WS_RW) + (size_t)(row0 + 4 * hi) * 512 + h * 64 + r32;
    const unsigned* VG = rk_pair(F, 2) + (size_t)(row0 + 4 * hi) * 512 + h * 64 + r32;
    unsigned vg0[2][16], vg1[2][16]; float bon[2][16];
#pragma unroll
    for (int rt = 0; rt < 2; ++rt)
#pragma unroll
        for (int r = 0; r < 16; ++r) { vg0[rt][r] = VG[(32 * rt + CRC(r)) * 512]; vg1[rt][r] = VG[(32 * rt + CRC(r)) * 512 + 32]; bon[rt][r] = BON[(32 * rt + CRC(r)) * 32]; }
    float gw[2], gb[2];
#pragma unroll
    for (int ct = 0; ct < 2; ++ct) { gw[ct] = A.in[I_GNW][h * 64 + 32 * ct + r32]; gb[ct] = A.in[I_GNB][h * 64 + 32 * ct + r32]; }
    mm64(fa, fb, Y);
#pragma unroll
    for (int rt = 0; rt < 2; ++rt)
#pragma unroll
        for (int r = 0; r < 16; ++r) {
            const float y0 = Y[rt][0][r], y1 = Y[rt][1][r];
            const float mean = sum32(y0 + y1) * (1.f / 64.f), e0 = y0 - mean, e1 = y1 - mean;
            const float rstd = rsqrtf(sum32(e0 * e0 + e1 * e1) * (1.f / 64.f) + 64e-5f);
            const unsigned a0 = vg0[rt][r], a1 = vg1[rt][r];
            const float o0 = (e0 * rstd * gw[0] + gb[0] + bon[rt][r] * bflo(a0)) * bfhi(a0), o1 = (e1 * rstd * gw[1] + gb[1] + bon[rt][r] * bflo(a1)) * bfhi(a1);
            RW[(32 * rt + CRC(r)) * 512] = (bf16)(pk2(o0, 0.f) & 0xffffu); RW[(32 * rt + CRC(r)) * 512 + 32] = (bf16)(pk2(o1, 0.f) & 0xffffu);
        }
}

constexpr int DP_STRIDE = 260;
__device__ __forceinline__ float half_sum32(float v) { v += __shfl_xor(v, 1); v += __shfl_xor(v, 2); v += __shfl_xor(v, 4); v += __shfl_xor(v, 8); v += __shfl_xor(v, 16); return v; }
__device__ __forceinline__ float sum16(float v) {
    v += __builtin_bit_cast(float, __builtin_amdgcn_update_dpp(0, __builtin_bit_cast(int, v), 0xB1, 0xF, 0xF, true));
    v += __builtin_bit_cast(float, __builtin_amdgcn_update_dpp(0, __builtin_bit_cast(int, v), 0x4E, 0xF, 0xF, true));
    v += __builtin_bit_cast(float, __builtin_amdgcn_update_dpp(0, __builtin_bit_cast(int, v), 0x141, 0xF, 0xF, true));
    v += dpp_rmir(v);
    return v;
}
__device__ __forceinline__ void glds16(const void* gsrc, unsigned lds_dst) { unsigned keep;
    asm volatile("s_mov_b32 %0, m0\n\ts_mov_b32 m0, %2\n\ts_nop 0\n\tglobal_load_lds_dwordx4 %1, off\n\ts_mov_b32 m0, %0" : "=&s"(keep) : "v"(gsrc), "s"(lds_dst) : "memory"); }
struct LdsRows { const LAS unsigned char* b; __device__ __forceinline__ f32x4 operator[](int j) const { return *(const LAS f32x4*)(b + j * 1024); } };
__device__ __forceinline__ void decode_unit(Frame& F, const Args& A, int unit) {
    const int seq = unit >> 5, h = F.wave & 3, lane = F.lane, w = F.wave, d4 = lane & 31, tk = lane >> 5;
    const bf16* QB = (const bf16*)(F.ws + WS_QB);
    const v2u qw = *(const v2u*)(QB + (size_t)(MP + seq) * 512 + h * 128 + 4 * d4);
    const f32x4 q4 = {bflo(qw.x), bfhi(qw.x), bflo(qw.y), bfhi(qw.y)};
    const float slope = exp2f(-2.f * (float)(h + 1)) * 1.4426950408889634f;
    const int pi = (unit & 31) * 2 + (w >> 2), page = ((const int*)A.in[I_PT])[seq * NPAGES + pi];
    const float* kp = A.in[I_CK] + ((size_t)page * PAGE * 4 + h) * 128 + (size_t)tk * 512 + 4 * d4;
    const float* vp = A.in[I_CV] + ((size_t)page * PAGE * 4 + h) * 128 + (size_t)tk * 512 + 4 * d4;
    float m0 = -INFINITY, l0 = 0.f, m1 = -INFINITY, l1 = 0.f; f32x4 o0 = {0.f, 0.f, 0.f, 0.f}, o1 = o0;
    const bool c0 = d4 < 16;
    constexpr int DNB = 8;
    f32x4 kA[DNB], vA[DNB], kB[DNB], vB[DNB];
#define DEC_LOAD(KX, VX, p_) do { _Pragma("unroll") for (int j = 0; j < DNB; ++j) { KX[j] = __builtin_nontemporal_load((const f32x4*)(kp + (size_t)((p_) + j) * 1024)); VX[j] = __builtin_nontemporal_load((const f32x4*)(vp + (size_t)((p_) + j) * 1024)); } } while (0)
#define DEC_COMP(KX, VX, p_) do { float s0[DNB], s1[DNB], mx0 = m0, mx1 = m1; \
        _Pragma("unroll") for (int j = 0; j < DNB; ++j) { const f32x4 kq = KX[j] * q4; \
            const float s = sum16((kq[0] + kq[1]) + (kq[2] + kq[3])) + slope * (float)(pi * PAGE + 2 * ((p_) + j) + tk - PAST), so = __shfl_xor(s, 16); \
            s0[j] = c0 ? s : so; s1[j] = c0 ? so : s; mx0 = fmaxf(mx0, s0[j]); mx1 = fmaxf(mx1, s1[j]); } \
        const float a0 = __builtin_amdgcn_exp2f(m0 - mx0), a1 = __builtin_amdgcn_exp2f(m1 - mx1); \
        l0 *= a0; l1 *= a1; o0 *= a0; o1 *= a1; m0 = mx0; m1 = mx1; \
        _Pragma("unroll") for (int j = 0; j < DNB; ++j) { const float e0 = __builtin_amdgcn_exp2f(s0[j] - m0), e1 = __builtin_amdgcn_exp2f(s1[j] - m1); l0 += e0; l1 += e1; o0 += e0 * VX[j]; o1 += e1 * VX[j]; } } while (0)
    DEC_LOAD(kA, vA, 0);
    for (int p0 = 0; p0 < PAGE / 2; p0 += 2 * DNB) {
        DEC_LOAD(kB, vB, p0 + DNB);
        DEC_COMP(kA, vA, p0);
        if (p0 + 2 * DNB < PAGE / 2) DEC_LOAD(kA, vA, p0 + 2 * DNB);
        DEC_COMP(kB, vB, p0 + DNB);
    }
#undef DEC_LOAD
#undef DEC_COMP
#define SWP(x) __uint_as_float(__builtin_amdgcn_permlane32_swap(__float_as_uint(x), __float_as_uint(x), false, false)[tk ? 0 : 1])
    { const float mb0 = SWP(m0), lb0 = SWP(l0), mb1 = SWP(m1), lb1 = SWP(l1);
      const float M0 = fmaxf(m0, mb0), M1 = fmaxf(m1, mb1);
      const float fa0 = __builtin_amdgcn_exp2f(m0 - M0), fb0 = __builtin_amdgcn_exp2f(mb0 - M0), fa1 = __builtin_amdgcn_exp2f(m1 - M1), fb1 = __builtin_amdgcn_exp2f(mb1 - M1);
      f32x4 r0, r1;
#pragma unroll
      for (int j = 0; j < 4; ++j) { const float ob0 = SWP(o0[j]), ob1 = SWP(o1[j]); r0[j] = o0[j] * fa0 + ob0 * fb0; r1[j] = o1[j] * fa1 + ob1 * fb1; }
      float* dp = (float*)(F.ws + WS_DP2) + (size_t)((seq * 4 + h) * NPAGES + pi) * DP_STRIDE;
      if (lane == 0) *(f32x4*)dp = (f32x4){M0, l0 * fa0 + lb0 * fb0, M1, l1 * fa1 + lb1 * fb1};
      if (tk == 0) { *(f32x4*)(dp + 4 + 4 * d4) = r0; *(f32x4*)(dp + 132 + 4 * d4) = r1; } }
#undef SWP
}
__device__ __forceinline__ void decode_combine(Frame& F, const Args& A, int sh, float lam) {
    const int seq = sh >> 2, h = sh & 3, lane = F.lane, w = F.wave; const size_t ro = (size_t)(MP + seq) * 512 + h * 128 + 2 * lane;
    const float* dp = (const float*)(F.ws + WS_DP2) + (size_t)(sh * NPAGES) * DP_STRIDE;
    const float* dpo = dp + 4 + 2 * lane + (size_t)(8 * w) * DP_STRIDE;
    const unsigned qw = *(const unsigned*)((const bf16*)(F.ws + WS_QB) + ro), kw = *(const unsigned*)((const bf16*)(F.ws + WS_KB) + ro), vw = *(const unsigned*)((const bf16*)(F.ws + WS_VB) + ro);
    const f32x4 ml = *(const f32x4*)(dp + (size_t)lane * DP_STRIDE);
    f32x2 o0[8], o1[8];
#pragma unroll
    for (int i = 0; i < 8; ++i) { o0[i] = *(const f32x2*)(dpo + (size_t)i * DP_STRIDE); o1[i] = *(const f32x2*)(dpo + (size_t)i * DP_STRIDE + 128); }
    const float s = half_sum32(bflo(qw) * bflo(kw) + bfhi(qw) * bfhi(kw)), so = __shfl_xor(s, 32);
    const float sn0 = lane < 32 ? s : so, sn1 = lane < 32 ? so : s;
    float mx0 = ml[0], mx1 = ml[2];
#pragma unroll
    for (int o = 1; o < 64; o <<= 1) { mx0 = fmaxf(mx0, __shfl_xor(mx0, o)); mx1 = fmaxf(mx1, __shfl_xor(mx1, o)); }
    const float M0 = fmaxf(mx0, sn0), M1 = fmaxf(mx1, sn1);
    const float e0 = exp2f(sn0 - M0), e1 = exp2f(sn1 - M1), f0 = exp2f(ml[0] - M0), f1 = exp2f(ml[2] - M1);
    const float L0 = e0 + wave_sum(f0 * ml[1]), L1 = e1 + wave_sum(f1 * ml[3]);
    f32x2 a = {0.f, 0.f}, b = {0.f, 0.f};
#pragma unroll
    for (int i = 0; i < 8; ++i) {
        const float g0 = __builtin_bit_cast(float, __builtin_amdgcn_readlane(__builtin_bit_cast(int, f0), 8 * w + i)), g1 = __builtin_bit_cast(float, __builtin_amdgcn_readlane(__builtin_bit_cast(int, f1), 8 * w + i));
        a.x += g0 * o0[i].x; a.y += g0 * o0[i].y; b.x += g1 * o1[i].x; b.y += g1 * o1[i].y; }
    LAS f32x4* red = (LAS f32x4*)(F.lds + RING_OFF);
    red[w * 64 + lane] = (f32x4){a.x, a.y, b.x, b.y};
    __syncthreads();
    if (w != 0) return;
    a = (f32x2){e0 * bflo(vw), e0 * bfhi(vw)}; b = (f32x2){e1 * bflo(vw), e1 * bfhi(vw)};
#pragma unroll
    for (int i = 0; i < 8; ++i) { const f32x4 t = red[i * 64 + lane]; a.x += t[0]; a.y += t[1]; b.x += t[2]; b.y += t[3]; }
    const float i0 = 1.f / L0, i1 = 1.f / L1;
    const float ox = a.x * i0 - lam * b.x * i1, oy = a.y * i0 - lam * b.y * i1;
    const float rn = rsqrtf(wave_sum(ox * ox + oy * oy) * (1.f / 128.f) + 1e-6f) * 0.8f;
    const float* aog = A.in[I_AOG];
    *(unsigned*)((bf16*)(F.ws + WS_ON) + ro) = pk2(ox * rn * aog[2 * lane], oy * rn * aog[2 * lane + 1]);
}

__device__ __forceinline__ void attn_naive_row(Frame& F, const Args& A, int row, int h, float lam) {
    const int lane = F.lane, t = row & (SEQ - 1), rb = row - t;
    const bf16* QB = (const bf16*)(F.ws + WS_QB); const bf16* KB = (const bf16*)(F.ws + WS_KB); const bf16* VB = (const bf16*)(F.ws + WS_VB);
    const float slope = exp2f(-2.f * (float)(h + 1)) * 1.4426950408889634f;
    float res[2][2];
    for (int c = 0; c < 2; ++c) {
        float q[64];
#pragma unroll
        for (int d = 0; d < 64; d += 2) { const unsigned w = *(const unsigned*)(QB + (size_t)row * 512 + h * 128 + c * 64 + d); q[d] = bflo(w); q[d + 1] = bfhi(w); }
        float m = -INFINITY, l = 0.f, o[128];
#pragma unroll
        for (int d = 0; d < 128; ++d) o[d] = 0.f;
        for (int j = lane; j <= t; j += 64) {
            const bf16* kr = KB + (size_t)(rb + j) * 512 + h * 128 + c * 64; const bf16* vr = VB + (size_t)(rb + j) * 512 + h * 128;
            float s = 0.f;
#pragma unroll
            for (int d = 0; d < 64; d += 8) { const v4u w = *(const v4u*)(kr + d);
                s += q[d] * bflo(w.x) + q[d + 1] * bfhi(w.x) + q[d + 2] * bflo(w.y) + q[d + 3] * bfhi(w.y) + q[d + 4] * bflo(w.z) + q[d + 5] * bfhi(w.z) + q[d + 6] * bflo(w.w) + q[d + 7] * bfhi(w.w); }
            s += slope * (float)(j - t);
            const float mn = fmaxf(m, s), al = exp2f(m - mn), e = exp2f(s - mn);
            l = l * al + e; m = mn;
#pragma unroll
            for (int d = 0; d < 128; d += 8) { const v4u w = *(const v4u*)(vr + d);
                o[d] = o[d] * al + e * bflo(w.x); o[d + 1] = o[d + 1] * al + e * bfhi(w.x); o[d + 2] = o[d + 2] * al + e * bflo(w.y); o[d + 3] = o[d + 3] * al + e * bfhi(w.y);
                o[d + 4] = o[d + 4] * al + e * bflo(w.z); o[d + 5] = o[d + 5] * al + e * bfhi(w.z); o[d + 6] = o[d + 6] * al + e * bflo(w.w); o[d + 7] = o[d + 7] * al + e * bfhi(w.w); }
        }
        float M = m;
#pragma unroll
        for (int x = 1; x < 64; x <<= 1) M = fmaxf(M, __shfl_xor(M, x));
        const float sc = exp2f(m - M);
        const float L = wave_sum(l * sc);
        float r0 = 0.f, r1 = 0.f;
#pragma unroll
        for (int d = 0; d < 128; ++d) { const float tot = wave_sum(o[d] * sc); if ((d & 63) == lane) { if (d < 64) r0 = tot; else r1 = tot; } }
        res[c][0] = r0 / L; res[c][1] = r1 / L;
    }
    const float ox = res[0][0] - lam * res[1][0], oy = res[0][1] - lam * res[1][1];
    const float rn = rsqrtf(wave_sum(ox * ox + oy * oy) * (1.f / 128.f) + 1e-6f) * 0.8f;
    const float* aog = A.in[I_AOG]; bf16* ON = (bf16*)(F.ws + WS_ON) + (size_t)row * 512 + h * 128;
    ON[lane] = (bf16)(pk2(ox * rn * aog[lane], 0.f) & 0xffffu); ON[64 + lane] = (bf16)(pk2(oy * rn * aog[64 + lane], 0.f) & 0xffffu);
}


__device__ __forceinline__ unsigned bfbits(float f) { return __builtin_bit_cast(unsigned, f) >> 16; }
__device__ __forceinline__ void attn_unit(Frame& F, const Args& A, int b, int h, int qb, float lam) {
    LAS unsigned char* Kt = F.lds + RING_OFF;
    LAS float* wsf = (LAS float*)(Kt + 98304) + F.wave * 64;
    LAS float* xch = (LAS float*)Kt;
    const bf16* QB = (const bf16*)(F.ws + WS_QB); const bf16* KB = (const bf16*)(F.ws + WS_KB); const bf16* VB = (const bf16*)(F.ws + WS_VB);
    const int tid = F.tid, lane = F.lane, w = F.wave, c = w >> 2, wq = w & 3, r32 = lane & 31, hi = lane >> 5;
    const int rowbase = b * SEQ, q0 = 128 * qb + 32 * wq, NT = 2 * (qb + 1);
    bf16x8 qr[4];
    { const bf16* Qp = QB + (size_t)(rowbase + q0 + r32) * 512 + (2 * h + c) * 64 + 8 * hi;
#pragma unroll
      for (int d0 = 0; d0 < 4; ++d0) qr[d0] = *(const bf16x8*)(Qp + 16 * d0); }
    asm volatile("" : "+v"(qr[0]), "+v"(qr[1]), "+v"(qr[2]), "+v"(qr[3]));
    const float sl = exp2f(-2.f * (float)(h + 1)) * 1.4426950408889634f;
    const unsigned c1 = __builtin_bit_cast(unsigned, sl) & 0xffff0000u; const float r1 = sl - __builtin_bit_cast(float, c1);
    const unsigned c2 = __builtin_bit_cast(unsigned, r1) & 0xffff0000u; const float r2 = r1 - __builtin_bit_cast(float, c2);
    const unsigned c3 = __builtin_bit_cast(unsigned, r2) & 0xffff0000u;
    const unsigned b1 = c1 >> 16, b2 = c2 >> 16, b3 = c3 >> 16, lo_mask = hi ? 0u : 0xffffffffu;
    const v4u qextu = {(b1 | (b2 << 16)) & lo_mask, (b3 | (b1 << 16)) & lo_mask, (b2 | (b3 << 16)) & lo_mask, 0u};
    const bf16x8 qext = __builtin_bit_cast(bf16x8, qextu);
    const unsigned J0 = bfbits((float)r32), J1 = bfbits((float)(32 + r32));
    const unsigned lds0 = (unsigned)(uintptr_t)(F.lds + RING_OFF);
    const bf16* kg0 = KB + (size_t)(rowbase + lane) * 512 + h * 128 + (2 * w) * 8;
    const bf16* vg0 = VB + (size_t)(rowbase + 32 * (w & 1) + (lane >> 2)) * 512 + h * 128 + (w >> 1) * 32 + (lane & 3) * 8;
    const unsigned kd0 = lds0 + (2 * w) * 1024, vd0 = lds0 + 16384 + (w >> 1) * 4096 + (2 * (w & 1)) * 1024;
#define ATT_DMA(t_, boff_) do { const size_t go_ = (size_t)(t_) * 64 * 512; const unsigned bo_ = (unsigned)(boff_); \
        glds16(kg0 + go_, (unsigned)__builtin_amdgcn_readfirstlane(kd0 + bo_)); glds16(kg0 + go_ + 8, (unsigned)__builtin_amdgcn_readfirstlane(kd0 + bo_ + 1024)); \
        glds16(vg0 + go_, (unsigned)__builtin_amdgcn_readfirstlane(vd0 + bo_)); glds16(vg0 + go_ + (size_t)16 * 512, (unsigned)__builtin_amdgcn_readfirstlane(vd0 + bo_ + 1024)); } while (0)
    ATT_DMA(NT - 1, 0);
    f32x16 o[4];
#pragma unroll
    for (int i = 0; i < 4; ++i) o[i] = (f32x16){};
    float m = -INFINITY, l = 0.f;
    bf16x8 pa[4];
    asm volatile("s_waitcnt vmcnt(0) lgkmcnt(0)\n\ts_barrier" ::: "memory");
#define ATT_QKSM(t, bo) do { \
        const LAS unsigned char* kfp = Kt + (bo) + (c * 8 + hi) * 1024 + r32 * 16; \
        const unsigned Tb = bfbits((float)(64 * (t) - 128 * qb)); \
        f32x16 p[2]; bf16x8 kfr[2][4]; \
        _Pragma("unroll") for (int half = 0; half < 2; ++half) _Pragma("unroll") for (int d0 = 0; d0 < 4; ++d0) kfr[half][d0] = *(const LAS bf16x8*)(kfp + d0 * 2048 + half * 512); \
        __builtin_amdgcn_sched_barrier(0); \
        _Pragma("unroll") for (int half = 0; half < 2; ++half) { f32x16 acc = (f32x16){}; \
            _Pragma("unroll") for (int d0 = 0; d0 < 4; ++d0) acc = __builtin_amdgcn_mfma_f32_32x32x16_bf16(kfr[half][d0], qr[d0], acc, 0, 0, 0); \
            const unsigned Jb = half ? J1 : J0; \
            const v4u ke = {(Tb | (Tb << 16)) & lo_mask, (Tb | (Jb << 16)) & lo_mask, (Jb | (Jb << 16)) & lo_mask, 0u}; \
            p[half] = __builtin_amdgcn_mfma_f32_32x32x16_bf16(__builtin_bit_cast(bf16x8, ke), qext, acc, 0, 0, 0); } \
        if (64 * (t) + 63 > q0) { const int qpos = q0 + r32; \
            _Pragma("unroll") for (int half = 0; half < 2; ++half) _Pragma("unroll") for (int r = 0; r < 16; ++r) { const int kv = 64 * (t) + 32 * half + crow16(r, hi); if (kv > qpos) p[half][r] = -INFINITY; } } \
        float mx = p[0][0]; \
        _Pragma("unroll") for (int r = 1; r < 16; ++r) mx = fmaxf(mx, p[0][r]); \
        _Pragma("unroll") for (int r = 0; r < 16; ++r) mx = fmaxf(mx, p[1][r]); \
        { const auto rr = __builtin_amdgcn_permlane32_swap(__float_as_uint(mx), __float_as_uint(mx), false, false); mx = fmaxf(__uint_as_float(rr[0]), __uint_as_float(rr[1])); } \
        const float mn = fmaxf(m, mx), alpha = __builtin_amdgcn_exp2f(m - mn); m = mn; \
        float ls = 0.f; \
        _Pragma("unroll") for (int half = 0; half < 2; ++half) _Pragma("unroll") for (int r = 0; r < 16; ++r) { const float e = __builtin_amdgcn_exp2f(p[half][r] - mn); p[half][r] = e; ls += e; } \
        { const auto rr = __builtin_amdgcn_permlane32_swap(__float_as_uint(ls), __float_as_uint(ls), false, false); ls = __uint_as_float(rr[0]) + __uint_as_float(rr[1]); } \
        l = l * alpha + ls; \
        if (__any(alpha != 1.f)) { if (hi == 0) wsf[r32] = alpha; LDS_WAIT(); \
            _Pragma("unroll") for (int r = 0; r < 16; ++r) { const float f = wsf[crow16(r, hi)]; _Pragma("unroll") for (int blk = 0; blk < 4; ++blk) o[blk][r] *= f; } } \
        _Pragma("unroll") for (int s = 0; s < 4; ++s) { const int hf = s >> 1, rb = 8 * (s & 1); \
            const v4u u = {pk2(p[hf][rb], p[hf][rb + 1]), pk2(p[hf][rb + 2], p[hf][rb + 3]), pk2(p[hf][rb + 4], p[hf][rb + 5]), pk2(p[hf][rb + 6], p[hf][rb + 7])}; \
            pa[s] = __builtin_bit_cast(bf16x8, u); } } while (0)
#define ATT_PV(bo) do { \
        const LAS unsigned char* vfp = Kt + (bo) + 16384 + ((lane >> 4) & 1) * 32 + (lane & 3) * 8 + (4 * hi + ((lane & 15) >> 2)) * 64; \
        s16x4 vlo[2][4], vhi[2][4]; \
        _Pragma("unroll") for (int s = 0; s < 4; ++s) { vlo[0][s] = vtr(vfp + s * 1024); vhi[0][s] = vtr(vfp + s * 1024 + 512); } \
        _Pragma("unroll") for (int blk = 0; blk < 4; ++blk) { \
            if (blk < 3) { _Pragma("unroll") for (int s = 0; s < 4; ++s) { vlo[(blk + 1) & 1][s] = vtr(vfp + (blk + 1) * 4096 + s * 1024); vhi[(blk + 1) & 1][s] = vtr(vfp + (blk + 1) * 4096 + s * 1024 + 512); } } \
            __builtin_amdgcn_sched_barrier(0); \
            _Pragma("unroll") for (int s = 0; s < 4; ++s) { const s16x4 lo = vlo[blk & 1][s], hh = vhi[blk & 1][s]; \
                const bf16x8 vf = {lo[0], lo[1], lo[2], lo[3], hh[0], hh[1], hh[2], hh[3]}; \
                o[blk] = __builtin_amdgcn_mfma_f32_32x32x16_bf16(pa[s], vf, o[blk], 0, 0, 0); } \
            __builtin_amdgcn_sched_barrier(0); } } while (0)
    bool pend = false; int pbo = 0, bo = 0;
    for (int it = 0; it <= NT; ++it) {
        const int t = NT - 1 - it, bn = (bo == 65536) ? 0 : bo + 32768;
        if (it + 1 < NT) ATT_DMA(t - 1, bn);
        const bool act = it < NT && 64 * t <= q0 + 31;
        if (c == 1 && pend) ATT_PV(pbo);
        if (act) ATT_QKSM(t, bo);
        if (c == 0 && act) ATT_PV(bo);
        if (c == 1) { pend = act; pbo = bo; }
        asm volatile("s_waitcnt vmcnt(0) lgkmcnt(0)\n\ts_barrier" ::: "memory");
        bo = bn;
    }
#undef ATT_QKSM
#undef ATT_PV
#undef ATT_DMA
    if (hi == 0) wsf[r32] = 1.f / l;
    LDS_WAIT();
#pragma unroll
    for (int r = 0; r < 16; ++r) { const float f = wsf[crow16(r, hi)];
#pragma unroll
        for (int blk = 0; blk < 4; ++blk) o[blk][r] *= f; }
    LAS float* xw = xch + wq * 4096;
    if (c == 1) {
#pragma unroll
        for (int blk = 0; blk < 4; ++blk)
#pragma unroll
            for (int r = 0; r < 16; ++r) xw[(blk * 16 + r) * 64 + lane] = o[blk][r];
    }
    __syncthreads();
    if (c == 0) {
        const float* aog = A.in[I_AOG]; bf16* ON = (bf16*)(F.ws + WS_ON);
        float g[4];
#pragma unroll
        for (int blk = 0; blk < 4; ++blk) g[blk] = aog[32 * blk + r32] * 0.8f;
#pragma unroll
        for (int r = 0; r < 16; ++r) {
            float v[4], ss = 0.f;
#pragma unroll
            for (int blk = 0; blk < 4; ++blk) { v[blk] = o[blk][r] - lam * xw[(blk * 16 + r) * 64 + lane]; ss += v[blk] * v[blk]; }
            ss += __shfl_xor(ss, 1); ss += __shfl_xor(ss, 2); ss += __shfl_xor(ss, 4); ss += __shfl_xor(ss, 8); ss += __shfl_xor(ss, 16);
            const float rn = rsqrtf(ss * (1.f / 128.f) + 1e-6f);
            bf16* op = ON + (size_t)(rowbase + q0 + crow16(r, hi)) * 512 + h * 128 + r32;
#pragma unroll
            for (int blk = 0; blk < 4; ++blk) op[32 * blk] = (bf16)(pk2(v[blk] * rn * g[blk], 0.f) & 0xffffu);
        }
    }
    __syncthreads();
}

template <int NB = 8> __device__ __forceinline__ void skinny_tile(Frame& F, LAS float* red, const bf16* A, int lda, const bf16* Bt, int K, int n0) {
    const int lane = F.lane, r = lane & 31, hi = lane >> 5, w = F.wave, kw = K / 8;
    const bf16* ap = A + (size_t)r * lda + w * kw + 8 * hi; const bf16* bp = Bt + (size_t)(n0 + r) * K + w * kw + 8 * hi;
    f32x16 acc = {};
    const int nst = kw / 16;
    for (int s0 = 0; s0 < nst; s0 += NB) {
        bf16x8 av[NB], bv[NB];
#pragma unroll
        for (int j = 0; j < NB; ++j) { const int k = (s0 + j < nst ? s0 + j : nst - 1) * 16; av[j] = *(const bf16x8*)(ap + k); bv[j] = *(const bf16x8*)(bp + k); }
#pragma unroll
        for (int j = 0; j < NB; ++j) if (s0 + j < nst) acc = __builtin_amdgcn_mfma_f32_32x32x16_bf16(av[j], bv[j], acc, 0, 0, 0);
    }
    __syncthreads();
#pragma unroll
    for (int i = 0; i < 16; ++i) red[w * 1024 + i * 64 + lane] = acc[i];
    __syncthreads();
    for (int e = F.tid; e < 1024; e += 512) { float s = 0.f;
#pragma unroll
        for (int j = 0; j < 8; ++j) s += red[j * 1024 + e];
        red[8 * 1024 + e] = s; }
    __syncthreads();
}

__device__ __forceinline__ void skinny_pair512(Frame& F, LAS float* red, const bf16* A1, const bf16* B1t, const bf16* A2, const bf16* B2t, int n0) {
    const int lane = F.lane, r = lane & 31, hi = lane >> 5, w = F.wave;
    const size_t ao = (size_t)r * 512 + w * 64 + 8 * hi, bo = (size_t)(n0 + r) * 512 + w * 64 + 8 * hi;
    bf16x8 a1[4], b1[4], a2[4], b2[4];
#pragma unroll
    for (int j = 0; j < 4; ++j) { a1[j] = *(const bf16x8*)(A1 + ao + 16 * j); b1[j] = *(const bf16x8*)(B1t + bo + 16 * j); a2[j] = *(const bf16x8*)(A2 + ao + 16 * j); b2[j] = *(const bf16x8*)(B2t + bo + 16 * j); }
    f32x16 c1 = {}, c2 = {};
#pragma unroll
    for (int j = 0; j < 4; ++j) { c1 = __builtin_amdgcn_mfma_f32_32x32x16_bf16(a1[j], b1[j], c1, 0, 0, 0); c2 = __builtin_amdgcn_mfma_f32_32x32x16_bf16(a2[j], b2[j], c2, 0, 0, 0); }
    __syncthreads();
#pragma unroll
    for (int i = 0; i < 16; ++i) { red[w * 1024 + i * 64 + lane] = c1[i]; red[9216 + w * 1024 + i * 64 + lane] = c2[i]; }
    __syncthreads();
    for (int e = F.tid; e < 1024; e += 512) { float s1 = 0.f, s2 = 0.f;
#pragma unroll
        for (int j = 0; j < 8; ++j) { s1 += red[j * 1024 + e]; s2 += red[9216 + j * 1024 + e]; }
        red[8192 + e] = s1; red[17408 + e] = s2; }
    __syncthreads();
}

#ifndef MK_N_LAUNCHES
#define MK_N_LAUNCHES 1
#endif
#ifndef MK_NAIVE_ATTN
#define MK_NAIVE_ATTN 0
#endif
constexpr int N_PHASES = 10;
__global__ void __launch_bounds__(NWAVES * 64, 2) mk_fwd(Args args) {
    extern __shared__ __attribute__((aligned(16))) unsigned char lds[];
    Frame F;
#ifdef MK_SUB
    F.pa = 0ull; F.pb = 0ull;
#endif
    F.lds = (LAS unsigned char*)lds;
    F.MISC = (volatile LAS unsigned*)(F.lds + MISC_OFF);
    F.tid = threadIdx.x; F.lane = F.tid & 63; F.wave = __builtin_amdgcn_readfirstlane(F.tid >> 6);
    F.G = gridDim.x; { const int bx = blockIdx.x; F.vcu = (F.G % 8 == 0) ? (bx % 8) * (F.G / 8) + bx / 8 : bx; }
    F.ws = args.ws; F.out = args.out; F.ctl = (gu32*)(args.ws + WS_CTL);
    const Args& A = args;
    for (int u = F.tid; u < (LDS_BYTES - LDSCTL_OFF) / 4; u += NWAVES * 64) ((LAS unsigned*)(F.lds + LDSCTL_OFF))[u] = 0u;
    __syncthreads();
    XcdBarrier bar; bar.bar = (unsigned*)(F.ctl + CW_BAR); bar.x = 0; bar.st = nullptr;
    if (MK_N_LAUNCHES == 1) bar = xcd_barrier_post((unsigned*)(F.ctl + CW_BAR), F.MISC + 8);
#define GRID_BAR() do { if (MK_N_LAUNCHES == 1) xcd_barrier(bar); } while (0)
    const int lo = args.ph_lo, hi = args.ph_hi;
#ifndef MK_PROF
#define MK_PROF -1
#endif
#ifndef MK_PROF_SCALE
#define MK_PROF_SCALE 1e-5f
#endif
    unsigned long long prof_a = 0ull, prof_b = 0ull;
#define PH_BEGIN(k) do { if (MK_PROF == (k)) prof_a = __builtin_amdgcn_s_memrealtime(); } while (0)
#define PH_END(k) do { if (MK_PROF == (k)) prof_b = __builtin_amdgcn_s_memrealtime(); } while (0)
#ifndef MK_DBG_STOP
#define MK_DBG_STOP 99
#endif
#define IN(k) (lo <= (k) && (k) < hi && (k) <= MK_DBG_STOP)
#define BOTH(k) (IN(k) && IN((k) + 1))
    bf16* XB = (bf16*)(F.ws + WS_XB); float* rs0 = (float*)(F.ws + WS_RS0);
    bf16* QB = (bf16*)(F.ws + WS_QB); bf16* KB = (bf16*)(F.ws + WS_KB); bf16* VB = (bf16*)(F.ws + WS_VB); bf16* PC = (bf16*)(F.ws + WS_PC); bf16* GT = (bf16*)(F.ws + WS_GT);
    bf16* ON = (bf16*)(F.ws + WS_ON); bf16* RW = (bf16*)(F.ws + WS_RW); bf16* MG = (bf16*)(F.ws + WS_MG); bf16* X1B = (bf16*)(F.ws + WS_X1B); bf16* HB = (bf16*)(F.ws + WS_HB);
    float* ssq = (float*)(F.ctl + CW_SSQ);
    const int bx = (int)blockIdx.x;

    PH_BEGIN(0);
    if (IN(0)) { for (int i = bx * 512 + F.tid; i < MTOT; i += F.G * 512) ssq[i] = 0.f;
        p0_prologue<0>(F, A, F.vcu * NWAVES + F.wave, F.G * NWAVES); if (BOTH(0)) GRID_BAR(); PH_END(0); }
    PH_BEGIN(1);
    if (IN(1)) {
        pg8::Gemm g{XB, (const bf16*)(F.ws + WS_WIN), nullptr, nullptr, MTOT, INW, DM}; pg8::StaticOrder S; S.init(MTOT, INW, F.G, bx);
        pg8::EpiProj E{rs0, A.in[I_QG], A.in[I_KG], QB, KB, VB, PC, GT, F.out};
        pg8::gemm_phase<pg8::EpiProj, pg8::StaticOrder, true, true>(F.lds + RING_OFF, g, S, E);
        { const int nlong = ((MTOT / 256 + (MTOT % 256 != 0)) * (INW / 256)) % F.G;
          if (nlong == 0) p0_prologue<1>(F, A, bx * NWAVES + F.wave, F.G * NWAVES);
          else if (bx >= nlong) p0_prologue<1>(F, A, (bx - nlong) * NWAVES + F.wave, (F.G - nlong) * NWAVES);
          __syncthreads(); }
        if (BOTH(1)) GRID_BAR(); PH_END(1);
    }
    PH_BEGIN(2);
    if (IN(2)) {
        SUBM(30);
        {
            const int grp = (bx + 2 * F.G >= MP / 32) ? bx % 3 : -1;
            int u = bx;
#pragma unroll 1
            for (int st = 0; ; ++st) {
                if (st == grp) {
                    LAS unsigned* qslot = (LAS unsigned*)(F.lds + LDSCTL_OFF);
                    if (F.tid == 0) qslot[0] = __hip_atomic_fetch_add((unsigned*)(F.ctl + CW_QDEC), 1u, __ATOMIC_RELAXED, __HIP_MEMORY_SCOPE_AGENT);
                    __syncthreads();
                    const unsigned k = qslot[0];
                    __syncthreads();
                    if (k < 1024u) decode_unit(F, A, (int)k);
                    __syncthreads();
                } else if (u < MP / 32) { rwkv_prep_unit(F, A, u); u += F.G; }
                else break;
            }
        }
        SUBM(31);
        SUBM(32);
        if (BOTH(2)) GRID_BAR(); PH_END(2);
    }
    PH_BEGIN(3);
    if (IN(3)) {
        SUBM(10);
        SUBM(11);
        for (int hc = bx * NWAVES + F.wave; hc < 32 * NCHK; hc += F.G * NWAVES) chunk_unit(F, hc);
        __syncthreads();
        if (BOTH(3)) GRID_BAR(); PH_END(3);
    }
    PH_BEGIN(4);
    if (IN(4)) {
        { int ln_ = F.lane, td_ = F.tid; asm volatile("" : "+v"(ln_), "+v"(td_)); F.lane = ln_; F.tid = td_; }
        SUBM(50);
        if (bx < 8) { chain_unit(F, bx * NWAVES + F.wave); __syncthreads(); }
        SUBM(51);
        const float lam = lam_value(F, A);
        LAS unsigned* qslot = (LAS unsigned*)(F.lds + LDSCTL_OFF);
        const unsigned dtail = __hip_atomic_load((unsigned*)(F.ctl + CW_QDEC), __ATOMIC_RELAXED, __HIP_MEMORY_SCOPE_AGENT) < 1024u ? __hip_atomic_load((unsigned*)(F.ctl + CW_QDEC), __ATOMIC_RELAXED, __HIP_MEMORY_SCOPE_AGENT) : 1024u;
        for (;;) {
            { int ln_ = F.lane, td_ = F.tid; asm volatile("" : "+v"(ln_), "+v"(td_)); F.lane = ln_; F.tid = td_; }
            if (F.tid == 0) qslot[0] = __hip_atomic_fetch_add((unsigned*)(F.ctl + CW_QUEUE), 1u, __ATOMIC_RELAXED, __HIP_MEMORY_SCOPE_AGENT);
            __syncthreads();
            const unsigned k = qslot[0];
            __syncthreads();
            if (k >= 1537u) break;
            if (k == 0u) { rwkv_prep_unit(F, A, MP / 32); continue; }
            const unsigned tr = (k - 1u) / 3u, r = (k - 1u) - 3u * tr;
#ifdef MK_SUB
            const unsigned long long t0_ = __builtin_amdgcn_s_memrealtime();
#endif
            if (r == 0u) attn_unit(F, A, (int)(tr & 15u) >> 2, (int)(tr & 3u), 31 - (int)(tr >> 4), lam);
            else { const unsigned d = dtail + 2u * tr + r - 1u; if (d < 1024u) decode_unit(F, A, (int)d); }
#ifdef MK_SUB
            if ((MK_SUB == 40 && r == 0u) || (MK_SUB == 41 && r != 0u)) F.pb += __builtin_amdgcn_s_memrealtime() - t0_;
#endif
        }
        if (BOTH(4)) GRID_BAR(); PH_END(4);
    }
    PH_BEGIN(5);
    if (IN(5)) {
        SUBM(20);
        { const float lam = lam_value(F, A);
          for (int it = bx; it < 128; it += F.G) { decode_combine(F, A, it, lam); if (it + F.G < 128) __syncthreads(); } }
        __syncthreads();
        for (int u = 256 + bx; u < 512; u += F.G) scan_seg_unit(F, A, u);
        SUBM(21);
        for (int hc = bx * NWAVES + F.wave; hc < 32 * NCHK; hc += F.G * NWAVES) ypass_unit(F, A, hc);
        SUBM(22);
        __syncthreads();
        if (BOTH(5)) GRID_BAR(); PH_END(5);
    }
    PH_BEGIN(6);
    if (IN(6)) {
        if (bx < 32) {
            LAS float* red = (LAS float*)(F.lds + RING_OFF); const int n0 = 32 * bx;
            skinny_pair512(F, red, ON + (size_t)MP * 512, (const bf16*)(F.ws + WS_WPA), RW + (size_t)MP * 512, (const bf16*)(F.ws + WS_WPB), n0);
#pragma unroll
            for (int i = 0; i < 2; ++i) { const int e = F.tid + 512 * i, reg = e >> 6, ln = e & 63, row = crow16(reg, ln >> 5), col = n0 + (ln & 31);
                const float g1 = bf2f(GT[(size_t)(MP + row) * 2048 + col]), g2 = bf2f(GT[(size_t)(MP + row) * 2048 + 1024 + col]);
                MG[(size_t)(MP + row) * 1024 + col] = (bf16)(pk2(g1 * red[8192 + e] + g2 * red[17408 + e], 0.f) & 0xffffu); }
            __syncthreads();
        }
        pg8::Gemm g{ON, (const bf16*)(F.ws + WS_WPA), RW, (const bf16*)(F.ws + WS_WPB), MP, DM, 512}; pg8::PairOrder S; S.base.init(MP, DM, F.G, bx);
        pg8::EpiMerge E{GT, (float*)(F.ws + WS_TMP), MG};
        pg8::gemm_phase<pg8::EpiMerge, pg8::PairOrder, true, true>(F.lds + RING_OFF, g, S, E);
        if (BOTH(6)) GRID_BAR(); PH_END(6);
    }
    PH_BEGIN(7);
    if (IN(7)) {
        if (bx < 32) {
            LAS float* red = (LAS float*)(F.lds + RING_OFF); const int n0 = 32 * bx;
            skinny_tile(F, red, MG + (size_t)MP * 1024, 1024, (const bf16*)(F.ws + WS_WOUT), 1024, n0);
#pragma unroll
            for (int i = 0; i < 2; ++i) { const int e = F.tid + 512 * i, reg = e >> 6, ln = e & 63, row = crow16(reg, ln >> 5), col = n0 + (ln & 31);
                const float v = A.in[I_XS][(size_t)row * 1024 + col] + red[8192 + e];
                F.out[O_YS + (size_t)row * 1024 + col] = v; X1B[(size_t)(MP + row) * 1024 + col] = (bf16)(pk2(v, 0.f) & 0xffffu);
                float ss = v * v; ss += __shfl_xor(ss, 1); ss += __shfl_xor(ss, 2); ss += __shfl_xor(ss, 4); ss += __shfl_xor(ss, 8); ss += __shfl_xor(ss, 16);
                if ((ln & 31) == 0) atomicAdd(ssq + MP + row, ss); }
            __syncthreads();
        }
        pg8::Gemm g{MG, (const bf16*)(F.ws + WS_WOUT), nullptr, nullptr, MP, DM, DM}; pg8::StaticOrder S; S.init(MP, DM, F.G, bx);
        pg8::EpiOut E{XB, X1B, ssq};
        pg8::gemm_phase<pg8::EpiOut, pg8::StaticOrder, false, true>(F.lds + RING_OFF, g, S, E);
        if (BOTH(7)) GRID_BAR(); PH_END(7);
    }
    PH_BEGIN(8);
    if (IN(8)) {
        pg8::Gemm g{X1B, (const bf16*)(F.ws + WS_WGU), nullptr, nullptr, MTOT, NGU, DM}; pg8::StaticOrder S; S.init(MTOT, NGU, F.G, bx);
        pg8::EpiGateUp E{ssq, HB};
        pg8::gemm_phase<pg8::EpiGateUp, pg8::StaticOrder, true, true>(F.lds + RING_OFF, g, S, E);
        if (BOTH(8)) GRID_BAR(); PH_END(8);
    }
    PH_BEGIN(9);
    if (IN(9)) {
        if (bx < 32) {
            LAS float* red = (LAS float*)(F.lds + RING_OFF); const int n0 = 32 * bx;
            skinny_tile<11>(F, red, HB + (size_t)MP * FF, FF, (const bf16*)(F.ws + WS_WDN), FF, n0);
#pragma unroll
            for (int i = 0; i < 2; ++i) { const int e = F.tid + 512 * i, reg = e >> 6, ln = e & 63, row = crow16(reg, ln >> 5), col = n0 + (ln & 31);
                float yv = F.out[O_YS + (size_t)row * 1024 + col] + red[8192 + e];
#ifdef MK_SUB
                prof_a = F.pa; prof_b = F.pb;
#endif
                if (MK_PROF >= 0 && MK_PROF != 9) yv *= 1.f + sqrtf((float)(prof_b - prof_a) * 0.01f * MK_PROF_SCALE);
                F.out[O_YS + (size_t)row * 1024 + col] = yv; }
            __syncthreads();
        }
        pg8::Gemm g{HB, (const bf16*)(F.ws + WS_WDN), nullptr, nullptr, MP, DM, FF}; pg8::StaticOrder S; S.init(MP, DM, F.G, bx);
        pg8::EpiDown E{F.out + O_YP, X1B};
        pg8::gemm_phase<pg8::EpiDown, pg8::StaticOrder, false, true>(F.lds + RING_OFF, g, S, E);
        if (MK_PROF == 9 && MK_N_LAUNCHES == 1) {
            xcd_barrier(bar); prof_b = __builtin_amdgcn_s_memrealtime();
            const float sc = 1.f + sqrtf((float)(prof_b - prof_a) * 0.01f * 1e-5f);
            for (int e = bx * 512 + F.tid; e < 32 * 1024; e += F.G * 512) F.out[O_YS + e] *= sc;
        }
    }
#undef IN
#undef BOTH
}

#if MK_NAIVE_ATTN
__global__ void __launch_bounds__(512, 2) attn_naive_kernel(Args args) {
    Frame F; F.tid = threadIdx.x; F.lane = F.tid & 63; F.wave = __builtin_amdgcn_readfirstlane(F.tid >> 6); F.G = gridDim.x; F.ws = args.ws; F.out = args.out;
    const Args& A = args;
    const float lam = lam_value(F, A);
    const int gw = (int)blockIdx.x * NWAVES + F.wave, NGW = F.G * NWAVES;
    for (int it = gw; it < MP * 4; it += NGW) attn_naive_row(F, A, it >> 2, it & 3, lam);
}
#endif
extern "C" void kernel_launch(void* const* d_in, const int* in_sizes, int n_in, void* d_out, int out_size, void* d_ws, size_t ws_size, hipStream_t stream) {
    static int grid = 0;
    if (grid == 0) {
        if (n_in != 34 || out_size != (int)O_END || ws_size < WS_END) { fprintf(stderr, "kernel_launch: unexpected shapes: n_in %d out %d ws %zu\n", n_in, out_size, ws_size); grid = -1; return; }
        int dev = 0, cus = 0, per_cu = 0;
        if (hipGetDevice(&dev) != hipSuccess || hipDeviceGetAttribute(&cus, hipDeviceAttributeMultiprocessorCount, dev) != hipSuccess) { grid = -1; return; }
        if (hipFuncSetAttribute((const void*)mk_fwd, hipFuncAttributeMaxDynamicSharedMemorySize, LDS_BYTES) != hipSuccess) { fprintf(stderr, "kernel_launch: hipFuncSetAttribute failed\n"); grid = -1; return; }
        if (hipOccupancyMaxActiveBlocksPerMultiprocessor(&per_cu, (const void*)mk_fwd, NWAVES * 64, LDS_BYTES) != hipSuccess || per_cu < 1) fprintf(stderr, "kernel_launch: occupancy query says %d\n", per_cu);
        (void)hipGetLastError();
        grid = cus;
    }
    if (grid < 0) return;
    if (hipMemsetAsync((char*)d_ws + WS_CTL, 0, CTL_ZERO_BYTES, stream) != hipSuccess) return;
    Args a{};
    for (int i = 0; i < 34; ++i) a.in[i] = (const float*)d_in[i];
    a.out = (float*)d_out; a.ws = (unsigned char*)d_ws;
    const int NL = MK_N_LAUNCHES;
    for (int li = 0; li < NL; ++li) {
        a.ph_lo = (NL == 1) ? 0 : li; a.ph_hi = (NL == 1) ? N_PHASES : li + 1; a.li = li; a.pad = 0;
        hipLaunchKernelGGL(mk_fwd, dim3(grid), dim3(NWAVES * 64), LDS_BYTES, stream, a);
        if (hipPeekAtLastError() != hipSuccess) { fprintf(stderr, "kernel_launch: launch %d failed\n", li); break; }
#if MK_NAIVE_ATTN
        if (NL != 1 && li == 3) hipLaunchKernelGGL(attn_naive_kernel, dim3(1024), dim3(512), 0, stream, a);
#endif
    }
}
```

```cpp
#include <hip/hip_runtime.h>
#include <cstdio>
#include <cstdint>

constexpr int MP = 16384, MS = 32, MVALID = MP + MS, MTOT = 16640;
constexpr int DM = 1024, INW = 5376, FF = 2816, NGU = 2 * FF, SEQ = 4096, NBATCH = 4, RSW = 1792;
constexpr int NPAGES = 64, PAGE = 128, PAST = 8192;
constexpr size_t O_YP = 0, O_YS = 16777216, O_KP = O_YS + 32768, O_VP = O_KP + 8388608, O_WP = O_VP + 8388608, O_SP = O_WP + 131072,
                 O_KS = O_SP + 7168, O_VS = O_KS + 16384, O_WS = O_VS + 16384, O_SS = O_WS + 1048576, O_END = O_SS + 57344;
constexpr float QK_C2 = 0.125f * 1.4426950408889634f;
namespace pg8 {
#define PG8_LAS __attribute__((address_space(3)))
typedef unsigned short bf16_t;
typedef short bf16x8 __attribute__((ext_vector_type(8)));
typedef float f32x4 __attribute__((ext_vector_type(4)));
typedef unsigned u32x4 __attribute__((ext_vector_type(4)));
constexpr int BM = 256, BK = 64, HALF = 128, HTB = HALF * BK * 2  , STAGE_BYTES = 8 * HTB, NXCD = 8, WGM = 8;

__host__ __device__ __forceinline__ int lds_byte(int r, int c) { const int st = (r >> 4) * 2 + (c >> 5), rr = r & 15, cc = c & 31, ob = rr * 64 + cc * 2; return st * 1024 + (ob ^ (((ob >> 9) & 1) << 5)); }
__host__ __device__ __forceinline__ void stage_rc(int b, int& R, int& C) { const int st = b / 1024, sb = b % 1024, swz = sb ^ (((sb >> 9) & 1) << 5); R = (st >> 1) * 16 + swz / 64; C = (st & 1) * 32 + (swz % 64) / 2; }
__host__ __device__ __forceinline__ int perm32(int rho) { const int n = rho >> 4, i = rho & 15; return 8 * (i >> 2) + 4 * n + (i & 3); }

struct Unit { int pm, pn, z; };
struct Gemm { const bf16_t* A; const bf16_t* Bt; const bf16_t* A2; const bf16_t* Bt2; int M, N, K; };

struct StaticOrder {
    int nM, nN, nwg, G, c;
    __host__ __device__ void init(int M, int N, int G_, int c_) { nM = M / BM; nN = N / BM; nwg = nM * nN; G = G_; c = c_; }
    __host__ __device__ bool next(int i, Unit& u) const {
        const long L = (long)i * G + c; if (L >= nwg) return false;
        int wgid = (int)L; { const int q = nwg / NXCD, r = nwg % NXCD, xcd = wgid % NXCD, off = wgid / NXCD; wgid = (xcd < r ? xcd * (q + 1) : r * (q + 1) + (xcd - r) * q) + off; }
        const int nig = WGM * nN, gid = wgid / nig, fm = gid * WGM, gsz = (nM - fm) < WGM ? (nM - fm) : WGM;
        u.pm = fm + ((wgid % nig) % gsz); u.pn = (wgid % nig) / gsz; u.z = 0; return true;
    }
    __device__ __forceinline__ void a_ready(const Unit&) const {}
    __device__ __forceinline__ void done(const Unit&) const {}
};

typedef float f32x2_cv __attribute__((ext_vector_type(2))); typedef __bf16 bf16x2_cv __attribute__((ext_vector_type(2)));
__device__ __forceinline__ unsigned cvt_pk_bf16(float lo, float hi) { const f32x2_cv v = {lo, hi}; const bf16x2_cv b = __builtin_convertvector(v, bf16x2_cv); return __builtin_bit_cast(unsigned, b); }
typedef float f32x2 __attribute__((ext_vector_type(2)));
__device__ __forceinline__ void st_bf16x8(bf16_t* p, const f32x4 a, const f32x4 b) {
    u32x4 w; w.x = cvt_pk_bf16(a[0], a[1]); w.y = cvt_pk_bf16(a[2], a[3]); w.z = cvt_pk_bf16(b[0], b[1]); w.w = cvt_pk_bf16(b[2], b[3]); *(u32x4*)p = w;
}
__device__ __forceinline__ float sigmoidf_(float x) { return __builtin_amdgcn_rcpf(1.f + __expf(-x)); }

struct EpiProj {
    static constexpr bool PERM = true, AFTER_DRAIN = false, KEEP_ACC = false;
    const float* rs0; const float* qg; const float* kg;
    bf16_t *QB, *KB, *VB, *PC, *GT; float* out;
    __device__ __forceinline__ void operator()(const f32x4 (&acc)[2][2][4][2], const Unit& u, int wr, int wc, int fr, int fq) const {
        const int pn = u.pn, rb = u.pm * BM + wr * 64 + fr, c8 = 64 * wc + 8 * fq;
        if (pn < 4) {
            const bool isq = pn < 2; const float* gain = isq ? qg : kg;
            f32x4 gv[2][2];
#pragma unroll
            for (int bj = 0; bj < 2; ++bj)
#pragma unroll
                for (int n = 0; n < 2; ++n) gv[bj][n] = *(const f32x4*)(gain + 32 * bj + 8 * fq + 4 * n);
            const int colg = 256 * (pn & 1) + c8;
#pragma unroll
            for (int ai = 0; ai < 2; ++ai)
#pragma unroll
                for (int m = 0; m < 4; ++m) {
                    const int row = rb + ai * HALF + m * 16; const bool ok = row < MVALID; const float rs = rs0[ok ? row : 0];
                    float ss = 0.f;
#pragma unroll
                    for (int bj = 0; bj < 2; ++bj)
#pragma unroll
                        for (int n = 0; n < 2; ++n) { const f32x4 x = acc[ai][bj][m][n] * rs; ss += (x[0] * x[0] + x[1] * x[1]) + (x[2] * x[2] + x[3] * x[3]); }
                    ss += __shfl_xor(ss, 16); ss += __shfl_xor(ss, 32);
                    const float rn = rsqrtf(ss * (1.f / 64.f) + 1e-6f) * rs;
#pragma unroll
                    for (int bj = 0; bj < 2; ++bj) {
                        const f32x4 v0 = acc[ai][bj][m][0] * rn * gv[bj][0], v1 = acc[ai][bj][m][1] * rn * gv[bj][1];
                        const size_t o = (size_t)row * 512 + colg + 32 * bj;
                        if (ok) {
                            if (isq) st_bf16x8(QB + o, v0 * QK_C2, v1 * QK_C2);
                            else { st_bf16x8(KB + o, v0, v1);
                                float* f = row < MP ? out + O_KP + o : out + O_KS + (size_t)(row - MP) * 512 + colg + 32 * bj;
                                *(f32x4*)f = v0; *(f32x4*)(f + 4) = v1; }
                        }
                    }
                }
        } else {
#pragma unroll
            for (int ai = 0; ai < 2; ++ai)
#pragma unroll
                for (int m = 0; m < 4; ++m) {
                    const int row = rb + ai * HALF + m * 16; const bool ok = row < MVALID; const float rs = rs0[ok ? row : 0];
                    if (!ok) continue;
#pragma unroll
                    for (int bj = 0; bj < 2; ++bj) {
                        f32x4 v0 = acc[ai][bj][m][0] * rs, v1 = acc[ai][bj][m][1] * rs;
                        if (pn < 6) {
                            const size_t c = (size_t)(256 * (pn - 4) + c8 + 32 * bj), o = (size_t)row * 512 + c;
                            st_bf16x8(VB + o, v0, v1);
                            float* f = row < MP ? out + O_VP + o : out + O_VS + (size_t)(row - MP) * 512 + c;
                            *(f32x4*)f = v0; *(f32x4*)(f + 4) = v1;
                        } else if (pn < 13) {
                            const size_t c = (size_t)(256 * (pn - 6) + c8 + 32 * bj);
                            st_bf16x8(PC + (size_t)row * RSW + c, v0, v1);
                            if (row >= MP) { float* f = out + O_SS + (size_t)(row - MP) * RSW + c; *(f32x4*)f = v0; *(f32x4*)(f + 4) = v1; }
                            else if ((row & (SEQ - 1)) == SEQ - 1) { float* f = out + O_SP + (size_t)(row >> 12) * RSW + c; *(f32x4*)f = v0; *(f32x4*)(f + 4) = v1; }
                        } else {
                            const size_t c = (size_t)(256 * (pn - 13) + c8 + 32 * bj);
#ifndef MK_DBG_NOSIG
#pragma unroll
                            for (int j = 0; j < 4; ++j) { v0[j] = sigmoidf_(v0[j]); v1[j] = sigmoidf_(v1[j]); }
#endif
                            st_bf16x8(GT + (size_t)row * 2048 + c, v0, v1);
                        }
                    }
                }
        }
    }
};

struct EpiMerge {
    static constexpr bool PERM = true, AFTER_DRAIN = false, KEEP_ACC = true;
    const bf16_t* GT; float* tmp; bf16_t* MG;
    __device__ __forceinline__ void operator()(const f32x4 (&acc_)[2][2][4][2], const Unit& u, int wr, int wc, int fr, int fq) const {
        f32x4 (&acc)[2][2][4][2] = const_cast<f32x4 (&)[2][2][4][2]>(acc_);
        const int rb = u.pm * BM + wr * 64 + fr, cb = u.pn * BM + wc * 32 + 8 * fq;
#pragma unroll
        for (int ai = 0; ai < 2; ++ai)
#pragma unroll
            for (int m = 0; m < 4; ++m) {
                const int row = rb + ai * HALF + m * 16;
#pragma unroll
                for (int bj = 0; bj < 2; ++bj) {
                    const int col = cb + bj * HALF;
                    const u32x4 gw = *(const u32x4*)(GT + (size_t)row * 2048 + 1024 + col);
                    f32x4 g0, g1;
                    g0[0] = __builtin_bit_cast(float, gw.x << 16); g0[1] = __builtin_bit_cast(float, gw.x & 0xffff0000u); g0[2] = __builtin_bit_cast(float, gw.y << 16); g0[3] = __builtin_bit_cast(float, gw.y & 0xffff0000u);
                    g1[0] = __builtin_bit_cast(float, gw.z << 16); g1[1] = __builtin_bit_cast(float, gw.z & 0xffff0000u); g1[2] = __builtin_bit_cast(float, gw.w << 16); g1[3] = __builtin_bit_cast(float, gw.w & 0xffff0000u);
                    if (!u.z) {
                        const u32x4 hw = *(const u32x4*)(GT + (size_t)row * 2048 + col);
                        f32x4 h0, h1;
                        h0[0] = __builtin_bit_cast(float, hw.x << 16); h0[1] = __builtin_bit_cast(float, hw.x & 0xffff0000u); h0[2] = __builtin_bit_cast(float, hw.y << 16); h0[3] = __builtin_bit_cast(float, hw.y & 0xffff0000u);
                        h1[0] = __builtin_bit_cast(float, hw.z << 16); h1[1] = __builtin_bit_cast(float, hw.z & 0xffff0000u); h1[2] = __builtin_bit_cast(float, hw.w << 16); h1[3] = __builtin_bit_cast(float, hw.w & 0xffff0000u);
#pragma unroll
                        for (int e = 0; e < 4; ++e) { acc[ai][bj][m][0][e] *= h0[e] / fmaxf(g0[e], 1e-30f); acc[ai][bj][m][1][e] *= h1[e] / fmaxf(g1[e], 1e-30f); }
                    } else {
                        const f32x4 v0 = acc[ai][bj][m][0] * g0, v1 = acc[ai][bj][m][1] * g1;
                        st_bf16x8(MG + (size_t)row * 1024 + col, v0, v1);
                    }
                }
            }
    }
};
struct EpiOut {
    static constexpr bool PERM = true, AFTER_DRAIN = false, KEEP_ACC = false;
    const bf16_t* xb; bf16_t* X1B; float* ssq;
    __device__ __forceinline__ void operator()(const f32x4 (&acc)[2][2][4][2], const Unit& u, int wr, int wc, int fr, int fq) const {
        const int rb = u.pm * BM + wr * 64 + fr, cb = u.pn * BM + wc * 32 + 8 * fq;
#pragma unroll
        for (int ai = 0; ai < 2; ++ai)
#pragma unroll
            for (int m = 0; m < 4; ++m) {
                const int row = rb + ai * HALF + m * 16; float ss = 0.f;
#pragma unroll
                for (int bj = 0; bj < 2; ++bj) {
                    const size_t o = (size_t)row * 1024 + cb + bj * HALF;
                    const u32x4 xw = *(const u32x4*)(xb + o); f32x4 v0 = acc[ai][bj][m][0], v1 = acc[ai][bj][m][1];
                    v0[0] += __builtin_bit_cast(float, xw.x << 16); v0[1] += __builtin_bit_cast(float, xw.x & 0xffff0000u); v0[2] += __builtin_bit_cast(float, xw.y << 16); v0[3] += __builtin_bit_cast(float, xw.y & 0xffff0000u);
                    v1[0] += __builtin_bit_cast(float, xw.z << 16); v1[1] += __builtin_bit_cast(float, xw.z & 0xffff0000u); v1[2] += __builtin_bit_cast(float, xw.w << 16); v1[3] += __builtin_bit_cast(float, xw.w & 0xffff0000u);
                    st_bf16x8(X1B + o, v0, v1);
                    ss += (v0[0] * v0[0] + v0[1] * v0[1]) + (v0[2] * v0[2] + v0[3] * v0[3]) + (v1[0] * v1[0] + v1[1] * v1[1]) + (v1[2] * v1[2] + v1[3] * v1[3]);
                }
                ss += __shfl_xor(ss, 16); ss += __shfl_xor(ss, 32);
                if (fq == 0) atomicAdd(ssq + row, ss);
            }
    }
};
struct EpiGateUp {
    static constexpr bool PERM = true, AFTER_DRAIN = false, KEEP_ACC = false;
    const float* ssq; bf16_t* HB;
    __device__ __forceinline__ void operator()(const f32x4 (&acc)[2][2][4][2], const Unit& u, int wr, int wc, int fr, int fq) const {
        const int rb = u.pm * BM + wr * 64 + fr, cb = u.pn * HALF + wc * 32 + 8 * fq;
#pragma unroll
        for (int ai = 0; ai < 2; ++ai)
#pragma unroll
            for (int m = 0; m < 4; ++m) {
                const int row = rb + ai * HALF + m * 16; if (row >= MVALID) continue;
                const float rs = rsqrtf(ssq[row] * (1.f / 1024.f) + 1e-6f);
                f32x4 h[2];
#pragma unroll
                for (int n = 0; n < 2; ++n)
#pragma unroll
                    for (int j = 0; j < 4; ++j) { const float g = acc[ai][0][m][n][j] * rs, uu = acc[ai][1][m][n][j] * rs; h[n][j] = g * sigmoidf_(g) * uu; }
                st_bf16x8(HB + (size_t)row * FF + cb, h[0], h[1]);
            }
    }
};
struct EpiDown {
    static constexpr bool PERM = true, AFTER_DRAIN = false, KEEP_ACC = false;
    float* y; const bf16_t* X1B;
    __device__ __forceinline__ void operator()(const f32x4 (&acc)[2][2][4][2], const Unit& u, int wr, int wc, int fr, int fq) const {
        const int rb = u.pm * BM + wr * 64 + fr, cb = u.pn * BM + wc * 32 + 8 * fq;
#pragma unroll
        for (int ai = 0; ai < 2; ++ai)
#pragma unroll
            for (int m = 0; m < 4; ++m) {
                const int row = rb + ai * HALF + m * 16;
#pragma unroll
                for (int bj = 0; bj < 2; ++bj) {
                    float* p = y + (size_t)row * 1024 + cb + bj * HALF; const u32x4 xw = *(const u32x4*)(X1B + (size_t)row * 1024 + cb + bj * HALF);
                    f32x4 v0 = acc[ai][bj][m][0], v1 = acc[ai][bj][m][1];
                    v0[0] += __builtin_bit_cast(float, xw.x << 16); v0[1] += __builtin_bit_cast(float, xw.x & 0xffff0000u); v0[2] += __builtin_bit_cast(float, xw.y << 16); v0[3] += __builtin_bit_cast(float, xw.y & 0xffff0000u);
                    v1[0] += __builtin_bit_cast(float, xw.z << 16); v1[1] += __builtin_bit_cast(float, xw.z & 0xffff0000u); v1[2] += __builtin_bit_cast(float, xw.w << 16); v1[3] += __builtin_bit_cast(float, xw.w & 0xffff0000u);
                    *(f32x4*)p = v0; *(f32x4*)(p + 4) = v1;
                }
            }
    }
};
struct PairOrder {
    StaticOrder base;
    __device__ __forceinline__ bool next(int i, Unit& u) const { if (!base.next(i >> 1, u)) return false; u.z = i & 1; return true; }
    __device__ __forceinline__ void a_ready(const Unit&) const {}
    __device__ __forceinline__ void done(const Unit&) const {}
};

template <class Epi, class Sched, bool ALIGN_EPI = false, bool SP2 = false>
__device__ __forceinline__ void gemm_phase(PG8_LAS unsigned char* lds, const Gemm g, const Sched& S, const Epi& E) {
    const int tid = threadIdx.x, wid = __builtin_amdgcn_readfirstlane(tid >> 6), lane = tid & 63, wr = wid >> 2, wc = wid & 3, fr = lane & 15, fq = lane >> 4;
    const int K = g.K, nt = K / BK;
    unsigned voffA[2], voffB[2];
#pragma unroll
    for (int i = 0; i < 2; ++i) { int R, C; stage_rc(tid * 16 + i * 8192, R, C); const int Rb = Epi::PERM ? ((R & ~31) + perm32(R & 31)) : R;
        voffA[i] = (unsigned)(R * K + C) * 2u; voffB[i] = (unsigned)(Rb * K + C) * 2u; }
    const size_t kstep = (size_t)(BK * 2);
    const size_t hstep = (size_t)HALF * K * 2;
    const size_t tstep = 2 * hstep;
    const unsigned ldsw = (unsigned)wid * 1024u;
    const int aoff = lds_byte(wr * 64 + fr, fq * 8), boff = lds_byte(wc * 32 + fr, fq * 8);
#define PG8_SA(b, h) (((b) * 2 + (h)) * HTB)
#define PG8_SB(b, h) ((4 + (b) * 2 + (h)) * HTB)
#define PG8_STAGE(bufoff, gbase, voff) do { _Pragma("unroll") for (int _i = 0; _i < 2; ++_i) \
        __builtin_amdgcn_global_load_lds((const unsigned*)((const char*)(gbase) + (voff)[_i]), (PG8_LAS unsigned*)(lds + (bufoff) + ldsw + _i * 8192), 16, 0, 0); } while (0)
#define PG8_LDA(dst, b, h) do { _Pragma("unroll") for (int m = 0; m < 4; ++m) _Pragma("unroll") for (int k = 0; k < 2; ++k) dst[m][k] = *(const PG8_LAS bf16x8*)(lds + PG8_SA(b, h) + aoff + m * 2048 + k * 1024); } while (0)
#define PG8_LDB(dst, b, h) do { _Pragma("unroll") for (int n = 0; n < 2; ++n) _Pragma("unroll") for (int k = 0; k < 2; ++k) dst[n][k] = *(const PG8_LAS bf16x8*)(lds + PG8_SB(b, h) + boff + n * 2048 + k * 1024); } while (0)
#define PG8_MMA(ai, bj, At, Bt) do { __builtin_amdgcn_s_setprio(1); _Pragma("unroll") for (int m = 0; m < 4; ++m) _Pragma("unroll") for (int n = 0; n < 2; ++n) _Pragma("unroll") for (int k = 0; k < 2; ++k) \
        acc[ai][bj][m][n] = __builtin_amdgcn_mfma_f32_16x16x32_bf16(Bt[n][k], At[m][k], acc[ai][bj][m][n], 0, 0, 0); __builtin_amdgcn_s_setprio(0); } while (0)
#define PG8_WAIT_V(n) asm volatile("s_waitcnt vmcnt(" #n ")" ::: "memory")
#define PG8_WAIT_L(n) asm volatile("s_waitcnt lgkmcnt(" #n ")" ::: "memory")
#define PG8_BAR __builtin_amdgcn_s_barrier()
#define PG8_SCHED __builtin_amdgcn_sched_barrier(0)
    Unit cur, nxt; int ui = 0;
    if (!S.next(0, cur)) return;
    f32x4 acc[2][2][4][2];
#pragma unroll
    for (int a = 0; a < 2; ++a)
#pragma unroll
        for (int b = 0; b < 2; ++b)
#pragma unroll
            for (int m = 0; m < 4; ++m)
#pragma unroll
                for (int n = 0; n < 2; ++n) acc[a][b][m][n] = (f32x4){0.f, 0.f, 0.f, 0.f};
    bf16x8 At[4][2], B0[2][2], B1[2][2];
    const char* cA = (const char*)(cur.z ? g.A2 : g.A) + (size_t)cur.pm * tstep; const char* cB = (const char*)(cur.z ? g.Bt2 : g.Bt) + (size_t)cur.pn * tstep;
    S.a_ready(cur);
    if constexpr (SP2) {
        PG8_STAGE(PG8_SB(0, 0), cB, voffB); PG8_STAGE(PG8_SB(0, 1), cB + hstep, voffB); PG8_STAGE(PG8_SA(0, 0), cA, voffA); PG8_STAGE(PG8_SA(0, 1), cA + hstep, voffA);
        if (wr == 1) PG8_BAR;
        PG8_WAIT_V(2); PG8_BAR;
        PG8_STAGE(PG8_SB(1, 0), cB + kstep, voffB); PG8_STAGE(PG8_SA(1, 0), cA + kstep, voffA); PG8_STAGE(PG8_SB(1, 1), cB + hstep + kstep, voffB);
        PG8_WAIT_V(6); PG8_BAR;
    } else {
        PG8_STAGE(PG8_SB(0, 0), cB, voffB); PG8_STAGE(PG8_SA(0, 0), cA, voffA); PG8_STAGE(PG8_SB(0, 1), cB + hstep, voffB); PG8_STAGE(PG8_SA(0, 1), cA + hstep, voffA);
        if (wr == 1) PG8_BAR;
        PG8_WAIT_V(4); PG8_BAR;
        PG8_STAGE(PG8_SB(1, 0), cB + kstep, voffB); PG8_STAGE(PG8_SA(1, 0), cA + kstep, voffA); PG8_STAGE(PG8_SB(1, 1), cB + hstep + kstep, voffB);
        PG8_WAIT_V(6); PG8_BAR;
    }
    for (;;) {
        const bool has_next = S.next(ui + 1, nxt);
        const char* nA = has_next ? (const char*)(nxt.z ? g.A2 : g.A) + (size_t)nxt.pm * tstep : cA; const char* nB = has_next ? (const char*)(nxt.z ? g.Bt2 : g.Bt) + (size_t)nxt.pn * tstep : cB;
        for (int t = 0; t < nt; t += 2) {
            const bool last = (t == nt - 2);
            const char* a1 = cA + (size_t)(t + 1) * kstep;
            const char* a2 = last ? nA : cA + (size_t)(t + 2) * kstep; const char* b2 = last ? nB : cB + (size_t)(t + 2) * kstep;
            const char* a3 = a2 + kstep; const char* b3 = b2 + kstep;
            if (last && has_next) S.a_ready(nxt);
            if constexpr (SP2) {
            PG8_LDB(B0, 0, 0); PG8_LDB(B1, 0, 1); PG8_SCHED; PG8_LDA(At, 0, 0); PG8_STAGE(PG8_SA(1, 1), a1 + hstep, voffA);
            PG8_WAIT_V(8); PG8_WAIT_L(0); PG8_BAR; PG8_MMA(0, 0, At, B0); PG8_MMA(0, 1, At, B1); PG8_BAR; PG8_SCHED;
            PG8_LDA(At, 0, 1); PG8_STAGE(PG8_SB(0, 0), b2, voffB); PG8_STAGE(PG8_SB(0, 1), b2 + hstep, voffB); PG8_STAGE(PG8_SA(0, 0), a2, voffA);
            PG8_WAIT_V(8); PG8_WAIT_L(0); PG8_BAR; PG8_MMA(1, 0, At, B0); PG8_MMA(1, 1, At, B1); PG8_BAR; PG8_SCHED;
            PG8_LDB(B0, 1, 0); PG8_LDB(B1, 1, 1); PG8_SCHED; PG8_LDA(At, 1, 0); PG8_STAGE(PG8_SA(0, 1), a2 + hstep, voffA);
            PG8_WAIT_V(8); PG8_WAIT_L(0); PG8_BAR; PG8_MMA(0, 0, At, B0); PG8_MMA(0, 1, At, B1); PG8_BAR; PG8_SCHED;
            PG8_LDA(At, 1, 1); PG8_STAGE(PG8_SB(1, 0), b3, voffB); PG8_STAGE(PG8_SB(1, 1), b3 + hstep, voffB); PG8_STAGE(PG8_SA(1, 0), a3, voffA);
            PG8_WAIT_V(8); PG8_WAIT_L(0); PG8_BAR; PG8_MMA(1, 0, At, B0); PG8_MMA(1, 1, At, B1); PG8_BAR; PG8_SCHED;
            } else {
            PG8_LDB(B0, 0, 0); PG8_SCHED; PG8_LDA(At, 0, 0); PG8_STAGE(PG8_SA(1, 1), a1 + hstep, voffA);
            PG8_WAIT_L(8); PG8_BAR; PG8_WAIT_L(0); PG8_MMA(0, 0, At, B0); PG8_BAR; PG8_SCHED;
            PG8_LDB(B1, 0, 1); PG8_STAGE(PG8_SB(0, 0), b2, voffB);
            PG8_BAR; PG8_WAIT_L(0); PG8_MMA(0, 1, At, B1); PG8_BAR;
            PG8_LDA(At, 0, 1); PG8_STAGE(PG8_SA(0, 0), a2, voffA);
            PG8_BAR; PG8_WAIT_L(0); PG8_MMA(1, 0, At, B0); PG8_BAR; PG8_SCHED;
            PG8_STAGE(PG8_SB(0, 1), b2 + hstep, voffB);
            PG8_WAIT_V(6); PG8_BAR; PG8_MMA(1, 1, At, B1); PG8_BAR;
            PG8_LDB(B0, 1, 0); PG8_SCHED; PG8_LDA(At, 1, 0); PG8_STAGE(PG8_SA(0, 1), a2 + hstep, voffA);
            PG8_WAIT_L(8); PG8_BAR; PG8_WAIT_L(0); PG8_MMA(0, 0, At, B0); PG8_BAR; PG8_SCHED;
            PG8_LDB(B1, 1, 1); PG8_STAGE(PG8_SB(1, 0), b3, voffB);
            PG8_BAR; PG8_WAIT_L(0); PG8_MMA(0, 1, At, B1); PG8_BAR;
            PG8_LDA(At, 1, 1); PG8_STAGE(PG8_SA(1, 0), a3, voffA);
            PG8_BAR; PG8_WAIT_L(0); PG8_MMA(1, 0, At, B0); PG8_BAR; PG8_SCHED;
            PG8_STAGE(PG8_SB(1, 1), b3 + hstep, voffB);
            PG8_WAIT_V(6); PG8_BAR; PG8_MMA(1, 1, At, B1); PG8_BAR;
            }
        }
        if constexpr (ALIGN_EPI) { if (wr == 0) PG8_BAR; }
        if constexpr (!Epi::AFTER_DRAIN) { E(acc, cur, wr, wc, fr, fq); S.done(cur); }
        if (!has_next) break;
        if (!(Epi::KEEP_ACC && cur.z == 0)) {
#pragma unroll
        for (int a = 0; a < 2; ++a)
#pragma unroll
            for (int b = 0; b < 2; ++b)
#pragma unroll
                for (int m = 0; m < 4; ++m)
#pragma unroll
                    for (int n = 0; n < 2; ++n) acc[a][b][m][n] = (f32x4){0.f, 0.f, 0.f, 0.f};
        }
        cur = nxt; cA = nA; cB = nB; ++ui;
        if constexpr (ALIGN_EPI) { if (wr == 1) PG8_BAR; }
    }
    PG8_WAIT_V(0);
    if constexpr (!ALIGN_EPI) { if (wr == 0) PG8_BAR; }
    PG8_BAR;
    if constexpr (Epi::AFTER_DRAIN) { E.fused(acc, cur, wr, wc, fr, fq, lds, wid, lane); S.done(cur); }
#undef PG8_SA
#undef PG8_SB
#undef PG8_STAGE
#undef PG8_LDA
#undef PG8_LDB
#undef PG8_MMA
#undef PG8_WAIT_V
#undef PG8_WAIT_L
#undef PG8_BAR
#undef PG8_SCHED
}
}

constexpr size_t MiB = 1u << 20;
constexpr size_t WS_CTL = 0, CTL_ZERO_BYTES = 1 * MiB;
constexpr size_t WS_WIN = 2 * MiB, WS_WPA = 13 * MiB, WS_WPB = 14 * MiB, WS_WOUT = 15 * MiB, WS_WGU = 17 * MiB, WS_WDN = 28 * MiB;
constexpr size_t WS_LORA = 28 * MiB + (size_t)DM * FF * 2;
static_assert(WS_LORA + 262144 <= 34 * MiB, "lora map");
constexpr size_t WS_XB = 34 * MiB, WS_RS0 = 67 * MiB, WS_QB = 68 * MiB, WS_KB = 85 * MiB, WS_VB = 102 * MiB, WS_PC = 119 * MiB, WS_GT = 176 * MiB;
constexpr size_t WS_ON = 241 * MiB, WS_RW = 258 * MiB, WS_MG = 275 * MiB, WS_TMP = 308 * MiB, WS_X1B = 373 * MiB, WS_HB = 406 * MiB;
constexpr size_t WS_RK = 496 * MiB, RK_STRIDE = 33 * MiB;
constexpr size_t WS_BON = 728 * MiB, WS_DP = 729 * MiB;
constexpr size_t WS_BON3 = 736 * MiB, WS_Y0 = 740 * MiB, WS_CC = 773 * MiB, WS_PSI = 806 * MiB, WS_PHI = 810 * MiB, WS_SST = 814 * MiB, WS_DP2 = 818 * MiB;
constexpr size_t WS_SC = 830 * MiB, WS_RH = 912 * MiB, WS_GP = 928 * MiB, WS_XC = 944 * MiB, WS_YL = 960 * MiB, WS_SL = 992 * MiB, WS_GC = 1024 * MiB, WS_HT = 1025 * MiB, WS_END = 1026 * MiB;
static_assert(WS_WIN + (size_t)INW * DM * 2 <= WS_WPA && WS_WGU + (size_t)NGU * DM * 2 <= WS_WDN && WS_WDN + (size_t)DM * FF * 2 <= WS_XB, "weights map");
static_assert(WS_XB + (size_t)MTOT * DM * 2 <= WS_RS0 && WS_QB + (size_t)MTOT * 512 * 2 <= WS_KB && WS_PC + (size_t)MTOT * RSW * 2 <= WS_GT && WS_GT + (size_t)MTOT * 2048 * 2 <= WS_ON, "act map 1");
static_assert(WS_MG + (size_t)MTOT * DM * 2 <= WS_TMP && WS_TMP + (size_t)MTOT * DM * 4 <= WS_X1B && WS_X1B + (size_t)MTOT * DM * 2 <= WS_HB && WS_HB + (size_t)MTOT * FF * 2 <= WS_RK, "act map 2");
static_assert((size_t)MTOT * 512 * 4 <= RK_STRIDE && WS_RK + 7 * RK_STRIDE <= WS_BON, "rwkv map");
constexpr int CW_TMO = 0, CW_CODE = 1;
constexpr int CW_BAR = 4096;
constexpr int CW_SSQ = 32768;
constexpr int CW_QUEUE = 2048;
constexpr int CW_QDEC = 2112;
constexpr int CW_DCNT = 65536;
static_assert((CW_DCNT + 128 * 64) * 4 <= (int)CTL_ZERO_BYTES, "CTL map");

constexpr int RING_OFF = 0, RING_BYTES = 139264;
constexpr int LDSCTL_OFF = RING_BYTES, MISC_OFF = LDSCTL_OFF + 320;
constexpr int LDS_BYTES = 155648;
constexpr int NWAVES = 8;

#define GAS __attribute__((address_space(1)))
#define LAS __attribute__((address_space(3)))
typedef unsigned short bf16;
typedef unsigned v4u __attribute__((ext_vector_type(4)));
typedef unsigned v2u __attribute__((ext_vector_type(2)));
typedef float f32x4 __attribute__((ext_vector_type(4)));
typedef float f32x2 __attribute__((ext_vector_type(2)));
typedef float f32x16 __attribute__((ext_vector_type(16)));
typedef short bf16x8 __attribute__((ext_vector_type(8)));
typedef short s16x4 __attribute__((ext_vector_type(4)));
typedef GAS unsigned gu32;
#define RLX_AGENT __ATOMIC_RELAXED, __HIP_MEMORY_SCOPE_AGENT
#define LDS_WAIT() asm volatile("s_waitcnt lgkmcnt(0)" ::: "memory")
#define VM_WAIT() asm volatile("s_waitcnt vmcnt(0)" ::: "memory")
__device__ __forceinline__ unsigned pk2(float lo, float hi) { return pg8::cvt_pk_bf16(lo, hi); }
using pg8::sigmoidf_;
__device__ __forceinline__ float bf2f(unsigned short b) { return __builtin_bit_cast(float, (unsigned)b << 16); }
__device__ __forceinline__ float bflo(unsigned w) { return __builtin_bit_cast(float, w << 16); }
__device__ __forceinline__ float bfhi(unsigned w) { return __builtin_bit_cast(float, w & 0xffff0000u); }

#define XB_TMO      128
#define XB_XCNT(j)  (256  + 64 * (j))
#define XB_XSUB(j)  (1280 + 64 * (j))
#define XB_XGEN(j)  (2304 + 64 * (j))
#define XB_TOP      3328
#define XB_TOPGEN   3392
#define XCD_BAR_WORDS 3456
#define XB_SPIN_CAP (1u << 18)

__device__ __forceinline__ unsigned xb_ld(unsigned* p)              { return __hip_atomic_load(p, __ATOMIC_RELAXED, __HIP_MEMORY_SCOPE_AGENT); }
__device__ __forceinline__ unsigned xb_add(unsigned* p, unsigned v) { return __hip_atomic_fetch_add(p, v, __ATOMIC_RELAXED, __HIP_MEMORY_SCOPE_AGENT); }
__device__ __forceinline__ unsigned xb_xcc_id() { return (unsigned)__builtin_amdgcn_s_getreg((3 << 11) | 20) & 0xFu; }
#define XB_SPIN(cond, bar) do { unsigned _sp = 0; while (cond) { __builtin_amdgcn_s_sleep(1); \
    if ((++_sp & 255u) == 0u) { if (xb_ld(&(bar)[XB_TMO])) break; if (_sp > XB_SPIN_CAP) { atomicAdd(&(bar)[XB_TMO], 1u); break; } } } } while (0)

struct XcdBarrier {
    unsigned* bar; unsigned x;
    volatile LAS unsigned* st;
};

__device__ __forceinline__ XcdBarrier xcd_barrier_post(unsigned* bar, volatile LAS unsigned* st) {
    XcdBarrier b; b.bar = bar; b.x = xb_xcc_id(); b.st = st;
    if (threadIdx.x == 0) (void)xb_add(&bar[XB_XCNT(b.x)], 1u);
    return b;
}
__device__ __forceinline__ void xcd_barrier_complete(unsigned* bar, unsigned x, unsigned& nloc, unsigned& nx) {
    const unsigned G = gridDim.x * gridDim.y * gridDim.z;
    unsigned sum, cnt, mine, sp = 0u;
    for (;;) {
        sum = 0u; cnt = 0u; mine = 0u;
#pragma unroll
        for (unsigned j = 0; j < 16; ++j) { const unsigned c = xb_ld(&bar[XB_XCNT(j)]); sum += c; cnt += (c > 0u) ? 1u : 0u; mine = (j == x) ? c : mine; }
        if (sum == G) break;
        __builtin_amdgcn_s_sleep(1);
        if ((++sp & 255u) == 0u) { if (xb_ld(&bar[XB_TMO])) break; if (sp > XB_SPIN_CAP) { atomicAdd(&bar[XB_TMO], 1u); break; } }
    }
    nloc = mine > 0u ? mine : 1u; nx = cnt > 0u ? cnt : 1u;
}

__device__ __forceinline__ void xcd_barrier(const XcdBarrier& b) {
    asm volatile("s_waitcnt vmcnt(0)" ::: "memory");
    __syncthreads();
    if (threadIdx.x == 0) {
        unsigned* bar = b.bar;
        __builtin_amdgcn_s_waitcnt(0);
        unsigned nloc = b.st[0], nx = b.st[1];
        if (nloc == 0u) { xcd_barrier_complete(bar, b.x, nloc, nx); b.st[0] = nloc; b.st[1] = nx; }
        const unsigned old = xb_add(&bar[XB_XSUB(b.x)], 1u);
        const unsigned gen = old / nloc;
        if (old + 1u == (gen + 1u) * nloc) {
            __builtin_amdgcn_fence(__ATOMIC_RELEASE, "agent");
            asm volatile("s_waitcnt vmcnt(0)" ::: "memory");
            const unsigned og = xb_add(&bar[XB_TOP], 1u);
            const unsigned tg = og / nx;
            if (og + 1u == (tg + 1u) * nx) xb_add(&bar[XB_TOPGEN], 1u);
            else XB_SPIN(xb_ld(&bar[XB_TOPGEN]) == tg, bar);
            __builtin_amdgcn_fence(__ATOMIC_ACQUIRE, "agent");
            xb_add(&bar[XB_XGEN(b.x)], 1u);
            asm volatile("s_waitcnt vmcnt(0)" ::: "memory");
        } else {
            XB_SPIN(xb_ld(&bar[XB_XGEN(b.x)]) == gen, bar);
            __builtin_amdgcn_fence(__ATOMIC_ACQUIRE, "agent");
            asm volatile("s_waitcnt vmcnt(0)" ::: "memory");
        }
    }
    __syncthreads();
}

struct Args { const float* in[34]; float* out; unsigned char* ws; int ph_lo, ph_hi, li, pad; };
struct Frame {
    LAS unsigned char* lds;
    volatile LAS unsigned* MISC;
    gu32* ctl;
    int tid, lane, wave, vcu, G;
    unsigned char* ws; float* out;
#ifdef MK_SUB
    unsigned long long pa, pb;
#endif
};
#ifdef MK_SUB
#define SUBM(k) do { if (MK_SUB == (k)) F.pa = __builtin_amdgcn_s_memrealtime(); if (MK_SUB + 1 == (k)) F.pb = __builtin_amdgcn_s_memrealtime(); } while (0)
#else
#define SUBM(k) do { } while (0)
#endif
enum { I_XP = 0, I_XS, I_CK, I_CV, I_PT, I_SWKV, I_SSH, I_NMIX, I_WIN, I_QG, I_KG, I_LQ1, I_LK1, I_LQ2, I_LK2, I_AOG, I_WPA, I_MU, I_W0, I_W2, I_A0, I_A2, I_G2,
       I_KK, I_KA, I_RK, I_GNW, I_GNB, I_WPB, I_WOUT, I_NFFN, I_WG, I_WU, I_WD };

__device__ __forceinline__ float wave_sum(float v) {
#pragma unroll
    for (int o = 1; o < 64; o <<= 1) v += __shfl_xor(v, o);
    return v;
}

__device__ __forceinline__ float dpp_rmir(float v) { return __builtin_bit_cast(float, __builtin_amdgcn_update_dpp(0, __builtin_bit_cast(int, v), 0x140, 0xF, 0xF, true)); }
__device__ __forceinline__ float sum32(float v) {
    v += __builtin_bit_cast(float, __builtin_amdgcn_update_dpp(0, __builtin_bit_cast(int, v), 0xB1, 0xF, 0xF, true));
    v += __builtin_bit_cast(float, __builtin_amdgcn_update_dpp(0, __builtin_bit_cast(int, v), 0x4E, 0xF, 0xF, true));
    v += __builtin_bit_cast(float, __builtin_amdgcn_update_dpp(0, __builtin_bit_cast(int, v), 0x141, 0xF, 0xF, true));
    v += dpp_rmir(v);
    v += __shfl_xor(v, 16);
    return v;
}
__device__ __forceinline__ void p0_transpose_item(const float* W, int K, int N, bf16* WT, int drow0, const float* kgain, LAS float* scr, int k0, int n0, int lane) {
    float v[32];
    const float* wp = W + (size_t)(k0 + (lane >> 5)) * N + n0 + (lane & 31);
#pragma unroll
    for (int i = 0; i < 32; ++i) v[i] = wp[(size_t)(2 * i) * N];
    const int c = lane & 7;
    f32x4 g0 = {1.f, 1.f, 1.f, 1.f}, g1 = g0;
    if (kgain) { g0 = *(const f32x4*)(kgain + k0 + 8 * c); g1 = *(const f32x4*)(kgain + k0 + 8 * c + 4); }
#pragma unroll
    for (int i = 0; i < 32; ++i) scr[(2 * i + (lane >> 5)) * 33 + (lane & 31)] = v[i];
    LDS_WAIT(); asm volatile("" ::: "memory");
#pragma unroll
    for (int j = 0; j < 4; ++j) { const int n = (lane >> 3) + 8 * j; const LAS float* s = scr + (8 * c) * 33 + n;
        v4u o; o.x = pk2(s[0 * 33] * g0[0], s[1 * 33] * g0[1]); o.y = pk2(s[2 * 33] * g0[2], s[3 * 33] * g0[3]); o.z = pk2(s[4 * 33] * g1[0], s[5 * 33] * g1[1]); o.w = pk2(s[6 * 33] * g1[2], s[7 * 33] * g1[3]);
        *(GAS v4u*)(WT + (size_t)(drow0 + n) * K + k0 + 8 * c) = o; }
    LDS_WAIT(); asm volatile("" ::: "memory");
}
template <int PART> __device__ __forceinline__ void p0_prologue(Frame& F, const Args& A, int gw, int NGW) {
    LAS float* scr = (LAS float*)(F.lds + RING_OFF + F.wave * 16384);
    bf16* Win_t = (bf16*)(F.ws + WS_WIN); bf16* Wpa_t = (bf16*)(F.ws + WS_WPA); bf16* Wpb_t = (bf16*)(F.ws + WS_WPB); bf16* Wout_t = (bf16*)(F.ws + WS_WOUT);
    bf16* Wgu_t = (bf16*)(F.ws + WS_WGU); bf16* Wdn_t = (bf16*)(F.ws + WS_WDN);
    constexpr int I_IN = (DM / 64) * (INW / 32), I_PA = (512 / 64) * (DM / 32), I_OUT = (DM / 64) * (DM / 32), I_G = (DM / 64) * (FF / 32), I_D = (FF / 64) * (DM / 32);
    constexpr int I_L = 16, NITEMS = I_IN + 2 * I_PA + I_OUT + 2 * I_G + I_D + 4 * I_L;
    constexpr int NP0 = I_IN + 4 * I_L, NP1 = NITEMS - NP0;
    for (int ix = gw; ix < (PART == 0 ? NP0 : NP1); ix += NGW) {
        int r = PART == 0 ? (ix < I_IN ? ix : ix - I_IN + (NITEMS - 4 * I_L)) : ix + I_IN;
        if (r < I_IN) { constexpr int nnb = INW / 32; const int kb = r / nnb, nb = r % nnb, pn = nb >> 3, q = nb & 7;
            p0_transpose_item(A.in[I_WIN], DM, INW, Win_t, 256 * pn + 32 * (4 * (q & 1) + (q >> 1)), A.in[I_NMIX], scr, 64 * kb, 32 * nb, F.lane); continue; } r -= I_IN;
        if (r < I_PA) { constexpr int nnb = DM / 32; const int kb = r / nnb, nb = r % nnb; p0_transpose_item(A.in[I_WPA], 512, DM, Wpa_t, 32 * nb, nullptr, scr, 64 * kb, 32 * nb, F.lane); continue; } r -= I_PA;
        if (r < I_PA) { constexpr int nnb = DM / 32; const int kb = r / nnb, nb = r % nnb; p0_transpose_item(A.in[I_WPB], 512, DM, Wpb_t, 32 * nb, nullptr, scr, 64 * kb, 32 * nb, F.lane); continue; } r -= I_PA;
        if (r < I_OUT) { constexpr int nnb = DM / 32; const int kb = r / nnb, nb = r % nnb; p0_transpose_item(A.in[I_WOUT], DM, DM, Wout_t, 32 * nb, nullptr, scr, 64 * kb, 32 * nb, F.lane); continue; } r -= I_OUT;
        if (r < I_G) { constexpr int nnb = FF / 32; const int kb = r / nnb, nb = r % nnb;
            p0_transpose_item(A.in[I_WG], DM, FF, Wgu_t, 256 * (nb >> 2) + 32 * (nb & 3), A.in[I_NFFN], scr, 64 * kb, 32 * nb, F.lane); continue; } r -= I_G;
        if (r < I_G) { constexpr int nnb = FF / 32; const int kb = r / nnb, nb = r % nnb;
            p0_transpose_item(A.in[I_WU], DM, FF, Wgu_t, 256 * (nb >> 2) + 128 + 32 * (nb & 3), A.in[I_NFFN], scr, 64 * kb, 32 * nb, F.lane); continue; } r -= I_G;
        if (r < I_D) { constexpr int nnb = DM / 32; const int kb = r / nnb, nb = r % nnb; p0_transpose_item(A.in[I_WD], FF, DM, Wdn_t, 32 * nb, nullptr, scr, 64 * kb, 32 * nb, F.lane); continue; } r -= I_D;
        { bf16* W2T = (bf16*)(F.ws + WS_LORA); bf16* A2T = W2T + 512 * 64; bf16* G2T = A2T + 512 * 64;
          if (r < I_L) p0_transpose_item(A.in[I_W2], 64, 512, W2T, 32 * r, nullptr, scr, 0, 32 * r, F.lane);
          else if (r < 2 * I_L) p0_transpose_item(A.in[I_A2], 64, 512, A2T, 32 * (r - I_L), nullptr, scr, 0, 32 * (r - I_L), F.lane);
          else { const int q = r - 2 * I_L; p0_transpose_item(A.in[I_G2], 128, 512, G2T, 32 * (q & 15), nullptr, scr, 64 * (q >> 4), 32 * (q & 15), F.lane); } }
    }
    if (PART != 0) return;
    bf16* XB = (bf16*)(F.ws + WS_XB); float* rs0 = (float*)(F.ws + WS_RS0);
    for (int m0 = gw; m0 < MTOT; m0 += 4 * NGW) {
        f32x4 v[4][4];
#pragma unroll
        for (int q = 0; q < 4; ++q) { const int m = m0 + q * NGW;
            if (m < MVALID) { const float* xrow = m < MP ? A.in[I_XP] + (size_t)m * DM : A.in[I_XS] + (size_t)(m - MP) * DM; const GAS f32x4* xr = (const GAS f32x4*)xrow + F.lane;
#pragma unroll
                for (int j = 0; j < 4; ++j) v[q][j] = xr[64 * j]; }
            else {
#pragma unroll
                for (int j = 0; j < 4; ++j) v[q][j] = (f32x4){0.f, 0.f, 0.f, 0.f}; } }
#pragma unroll
        for (int q = 0; q < 4; ++q) { const int m = m0 + q * NGW; if (m >= MTOT) continue;
            GAS unsigned long long* o8 = (GAS unsigned long long*)(XB + (size_t)m * DM) + F.lane; float s = 0.f;
#pragma unroll
            for (int j = 0; j < 4; ++j) { s += (v[q][j].x * v[q][j].x + v[q][j].y * v[q][j].y) + (v[q][j].z * v[q][j].z + v[q][j].w * v[q][j].w);
                o8[64 * j] = (unsigned long long)pk2(v[q][j].x, v[q][j].y) | ((unsigned long long)pk2(v[q][j].z, v[q][j].w) << 32); }
            s = sum32(s); { const auto rr = __builtin_amdgcn_permlane32_swap(__float_as_uint(s), __float_as_uint(s), false, false); s = __uint_as_float(rr[0]) + __uint_as_float(rr[1]); }
            if (F.lane == 0) rs0[m] = m < MVALID ? rsqrtf(s * (1.f / DM) + 1e-6f) : 0.f; }
    }
}

__device__ __forceinline__ int crow16(int r, int hi) { return (r & 3) + 8 * (r >> 2) + 4 * hi; }
__device__ __forceinline__ float lam_value(const Frame& F, const Args& A) {
    const int l = F.lane;
    const float a = wave_sum(A.in[I_LQ1][l] * A.in[I_LK1][l]), b = wave_sum(A.in[I_LQ2][l] * A.in[I_LK2][l]);
    return __expf(a) - __expf(b) + 0.2f;
}
__device__ __forceinline__ f32x4 ld_bf4(const bf16* p) { const v2u w = *(const v2u*)p; return (f32x4){bflo(w.x), bfhi(w.x), bflo(w.y), bfhi(w.y)}; }
__device__ __forceinline__ unsigned* rk_pair(const Frame& F, int i) { return (unsigned*)(F.ws + WS_RK + (size_t)i * RK_STRIDE); }
__device__ __forceinline__ bf16* rk_bf(const Frame& F, int i) { return (bf16*)(F.ws + WS_RK + (size_t)i * RK_STRIDE); }
__device__ __forceinline__ float* rk_arr(const Frame& F, int i) { return (float*)(F.ws + WS_RK + (size_t)i * RK_STRIDE); }

#define CRC(r) (((r) & 3) + 8 * ((r) >> 2))
constexpr int LIN_LD = 264, MS_LD = 1544;
__device__ __forceinline__ float tanh_fast(float x) { return 1.f - 2.f * __builtin_amdgcn_rcpf(1.f + __expf(2.f * x)); }
__device__ __forceinline__ void rwkv_prep_unit(Frame& F, const Args& A, int unit) {
    LAS bf16* msl = (LAS bf16*)(F.lds + RING_OFF);
    LAS bf16* lin = msl + 32 * MS_LD;
    const bf16* PC = (const bf16*)(F.ws + WS_PC);
    int r32_ = F.lane & 31, hi_ = F.lane >> 5; asm volatile("" : "+v"(r32_), "+v"(hi_));
    const int r0 = unit * 32, tid = F.tid, lane = F.lane, w = F.wave, r32 = r32_, hi = hi_;
    const float* mu = A.in[I_MU]; const float* ssh = A.in[I_SSH];
#pragma unroll 7
    for (int k = 0; k < 14; ++k) {
        const int p = tid + 512 * k, t = p / 224, c8 = p - 224 * t, row = r0 + t;
        const v4u cw = *(const v4u*)(PC + (size_t)row * RSW + 8 * c8);
        float cur[8] = {bflo(cw.x), bfhi(cw.x), bflo(cw.y), bfhi(cw.y), bflo(cw.z), bfhi(cw.z), bflo(cw.w), bfhi(cw.w)}, prv[8];
        if (row >= MP) { const f32x4 a = *(const f32x4*)(ssh + (size_t)(row - MP) * RSW + 8 * c8), b = *(const f32x4*)(ssh + (size_t)(row - MP) * RSW + 8 * c8 + 4);
#pragma unroll
            for (int j = 0; j < 4; ++j) { prv[j] = a[j]; prv[4 + j] = b[j]; } }
        else if ((row & (SEQ - 1)) == 0) {
#pragma unroll
            for (int j = 0; j < 8; ++j) prv[j] = 0.f; }
        else { const v4u pw = *(const v4u*)(PC + (size_t)(row - 1) * RSW + 8 * c8);
            prv[0] = bflo(pw.x); prv[1] = bfhi(pw.x); prv[2] = bflo(pw.y); prv[3] = bfhi(pw.y); prv[4] = bflo(pw.z); prv[5] = bfhi(pw.z); prv[6] = bflo(pw.w); prv[7] = bfhi(pw.w); }
        const f32x4 m0 = *(const f32x4*)(mu + 8 * c8), m1 = *(const f32x4*)(mu + 8 * c8 + 4);
        float m[8];
#pragma unroll
        for (int j = 0; j < 4; ++j) { m[j] = cur[j] + (prv[j] - cur[j]) * m0[j]; m[4 + j] = cur[4 + j] + (prv[4 + j] - cur[4 + j]) * m1[j]; }
        if (c8 >= 192) { const int ci = 8 * (c8 - 192);
#pragma unroll
            for (int j = 0; j < 8; ++j) { if (ci < 64) m[j] = tanh_fast(m[j]); else if (ci >= 128) m[j] = sigmoidf_(m[j]); }
            *(LAS v4u*)(lin + t * LIN_LD + ci) = (v4u){pk2(m[0], m[1]), pk2(m[2], m[3]), pk2(m[4], m[5]), pk2(m[6], m[7])}; }
        else *(LAS v4u*)(msl + t * MS_LD + 8 * c8) = (v4u){pk2(m[0], m[1]), pk2(m[2], m[3]), pk2(m[4], m[5]), pk2(m[6], m[7])};
    }
    __syncthreads();
    f32x16 wl[2], al[2], gg[2];
    const bf16* W2T = (const bf16*)(F.ws + WS_LORA); const bf16* A2T = W2T + 512 * 64; const bf16* G2T = A2T + 512 * 64;
#pragma unroll
    for (int ct = 0; ct < 2; ++ct) {
        const int ch = 64 * w + 2 * r32 + ct;
        f32x16 a0 = (f32x16){}, a1 = (f32x16){}, a2 = (f32x16){};
#pragma unroll
        for (int ks = 0; ks < 4; ++ks) {
            const bf16x8 x0 = *(const LAS bf16x8*)(lin + r32 * LIN_LD + 16 * ks + 8 * hi), x1 = *(const LAS bf16x8*)(lin + r32 * LIN_LD + 64 + 16 * ks + 8 * hi);
            const bf16x8 b0 = *(const bf16x8*)(W2T + (size_t)ch * 64 + 16 * ks + 8 * hi), b1 = *(const bf16x8*)(A2T + (size_t)ch * 64 + 16 * ks + 8 * hi);
            a0 = __builtin_amdgcn_mfma_f32_32x32x16_bf16(x0, b0, a0, 0, 0, 0); a1 = __builtin_amdgcn_mfma_f32_32x32x16_bf16(x1, b1, a1, 0, 0, 0);
        }
#pragma unroll
        for (int ks = 0; ks < 8; ++ks) {
            const bf16x8 x2 = *(const LAS bf16x8*)(lin + r32 * LIN_LD + 128 + 16 * ks + 8 * hi);
            const bf16x8 b2 = *(const bf16x8*)(G2T + (size_t)ch * 128 + 16 * ks + 8 * hi);
            a2 = __builtin_amdgcn_mfma_f32_32x32x16_bf16(x2, b2, a2, 0, 0, 0);
        }
        wl[ct] = a0; al[ct] = a1; gg[ct] = a2;
    }
    bf16* aR = rk_bf(F, 0); float* aW = rk_arr(F, 1); bf16* aK = rk_bf(F, 2); bf16* aV = rk_bf(F, 3); bf16* aA = rk_bf(F, 4); bf16* aB = rk_bf(F, 5); bf16* aG = rk_bf(F, 6);
    float* BON = (float*)(F.ws + WS_BON3);
    float w0c[2], a0c[2], kkc[2], kac[2], rkc[2];
#pragma unroll
    for (int ct = 0; ct < 2; ++ct) { const int ch = 64 * w + 2 * r32 + ct; w0c[ct] = A.in[I_W0][ch]; a0c[ct] = A.in[I_A0][ch]; kkc[ct] = A.in[I_KK][ch]; kac[ct] = A.in[I_KA][ch]; rkc[ct] = A.in[I_RK][ch]; }
    if (unit < MP / 32) {
        float lwv[2][16], pin[2][16], off[2];
        int r32o = r32; asm volatile("" : "+v"(r32o));
#pragma unroll
        for (int ct = 0; ct < 2; ++ct)
#pragma unroll
            for (int r = 0; r < 16; ++r) { const float x = -(w0c[ct] + wl[ct][r]), sp = fmaxf(x, 0.f) + __logf(1.f + __expf(-fabsf(x))); lwv[ct][r] = -__expf(-sp - 0.5f); }
#pragma unroll
        for (int ct = 0; ct < 2; ++ct) { float run = 0.f;
#pragma unroll
            for (int q = 0; q < 4; ++q) { const float c0 = lwv[ct][4 * q], c1 = c0 + lwv[ct][4 * q + 1], c2 = c1 + lwv[ct][4 * q + 2], c3 = c2 + lwv[ct][4 * q + 3];
                const float oth = __shfl_xor(c3, 32), base = run + (hi ? oth : 0.f);
                pin[ct][4 * q] = base + c0; pin[ct][4 * q + 1] = base + c1; pin[ct][4 * q + 2] = base + c2; pin[ct][4 * q + 3] = base + c3; run += c3 + oth; }
            off[ct] = (unit & 1) ? 0.f : run;
            if (hi == 0) ((float*)(F.ws + WS_HT))[(size_t)unit * 512 + 64 * w + 2 * r32o + ct] = __expf(run); }
        bf16* scb = (bf16*)(F.ws + WS_SC) + ((size_t)(((unit >> 7) * 8 + w) * 64 + ((unit >> 1) & 63)) * 5 * 64 + 32 * (unit & 1) + 4 * hi) * 64 + 2 * r32o;
#pragma unroll
        for (int r = 0; r < 16; ++r) {
            const int t = crow16(r, hi), row = r0 + t;
            float rr[2], kv[2], vv[2], kkv[2], av[2], wv[2];
            float ss = 0.f;
#pragma unroll
            for (int ct = 0; ct < 2; ++ct) { const int ch = 64 * w + 2 * r32 + ct;
                rr[ct] = bf2f(msl[t * MS_LD + ch]); kv[ct] = bf2f(msl[t * MS_LD + 512 + ch]); vv[ct] = bf2f(msl[t * MS_LD + 1024 + ch]);
                wv[ct] = __expf(lwv[ct][r]);
                av[ct] = sigmoidf_(a0c[ct] + al[ct][r]);
                kkv[ct] = kv[ct] * kkc[ct]; ss += kkv[ct] * kkv[ct];
            }
            ss = sum32(ss);
            const float rn = rsqrtf(fmaxf(ss, 1e-24f));
            float bon = 0.f, br = 0.f, kr = 0.f, kk[2], kp[2];
#pragma unroll
            for (int ct = 0; ct < 2; ++ct) { kk[ct] = kkv[ct] * rn; kp[ct] = kv[ct] * (1.f + (av[ct] - 1.f) * kac[ct]);
                bon += rr[ct] * kp[ct] * rkc[ct]; br += kk[ct] * av[ct] * rr[ct]; kr += kp[ct] * rr[ct]; }
            bon = sum32(bon); br = sum32(br); kr = sum32(kr);
            { float Fm[2], Fi[2];
#pragma unroll
              for (int ct = 0; ct < 2; ++ct) { Fm[ct] = __expf(pin[ct][r] - lwv[ct][r] - off[ct]); Fi[ct] = __expf(off[ct] - pin[ct][r]); }
              unsigned* sp_ = (unsigned*)(scb + CRC(r) * 64);
              sp_[0 * 2048] = pk2(-kk[0] * Fm[0], -kk[1] * Fm[1]);
              sp_[1 * 2048] = pk2(kk[0] * av[0] * Fi[0], kk[1] * av[1] * Fi[1]);
              sp_[2 * 2048] = pk2(kp[0] * Fi[0], kp[1] * Fi[1]);
              sp_[3 * 2048] = pk2(wv[0] * rr[0] * Fm[0], wv[1] * rr[1] * Fm[1]);
              sp_[4 * 2048] = pk2(vv[0], vv[1]);
              *(v2u*)(rk_pair(F, 2) + (size_t)row * 512 + 64 * w + 2 * r32o) = (v2u){pk2(vv[0], gg[0][r]), pk2(vv[1], gg[1][r])}; }
            if (r32 == 0) *(f32x4*)(BON + (size_t)(row * 8 + w) * 4) = (f32x4){bon, br, kr, 0.f};
        }
    } else {
#pragma unroll 4
    for (int r = 0; r < 16; ++r) {
        const int t = crow16(r, hi), row = r0 + t;
        float rr[2], kv[2], vv[2], kkv[2], av[2], wv[2];
        float ss = 0.f;
#pragma unroll
        for (int ct = 0; ct < 2; ++ct) { const int ch = 64 * w + 2 * r32 + ct;
            rr[ct] = bf2f(msl[t * MS_LD + ch]); kv[ct] = bf2f(msl[t * MS_LD + 512 + ch]); vv[ct] = bf2f(msl[t * MS_LD + 1024 + ch]);
            const float x = -(w0c[ct] + wl[ct][r]), sp = fmaxf(x, 0.f) + __logf(1.f + __expf(-fabsf(x)));
            const float e = __expf(-sp - 0.5f); wv[ct] = __expf(-e);
            av[ct] = sigmoidf_(a0c[ct] + al[ct][r]);
            kkv[ct] = kv[ct] * kkc[ct]; ss += kkv[ct] * kkv[ct];
        }
        ss = sum32(ss);
        const float rn = rsqrtf(fmaxf(ss, 1e-24f));
        float bon = 0.f, br = 0.f, kr = 0.f, kk[2], kp[2];
#pragma unroll
        for (int ct = 0; ct < 2; ++ct) { kk[ct] = kkv[ct] * rn; kp[ct] = kv[ct] * (1.f + (av[ct] - 1.f) * kac[ct]);
            bon += rr[ct] * kp[ct] * rkc[ct]; br += kk[ct] * av[ct] * rr[ct]; kr += kp[ct] * rr[ct]; }
        bon = sum32(bon); br = sum32(br); kr = sum32(kr);
#pragma unroll
        for (int ct = 0; ct < 2; ++ct) { const size_t o = (size_t)row * 512 + 64 * w + 2 * r32 + ct;
            aW[o] = wv[ct]; rk_pair(F, 0)[o] = pk2(wv[ct] * rr[ct], kp[ct]); rk_pair(F, 2)[o] = pk2(vv[ct], gg[ct][r]); rk_pair(F, 4)[o] = pk2(-kk[ct], kk[ct] * av[ct]); }
        if (r32 == 0) *(f32x4*)(BON + (size_t)(row * 8 + w) * 4) = (f32x4){bon, br, kr, 0.f};
    }
    }
    __syncthreads();
}

constexpr int NSEG = 8, SEGT = SEQ / NSEG;
__device__ __forceinline__ float dpp_xor1(float v) { return __builtin_bit_cast(float, __builtin_amdgcn_update_dpp(0, __builtin_bit_cast(int, v), 0xB1, 0xF, 0xF, true)); }
__device__ __forceinline__ float dpp_xor2(float v) { return __builtin_bit_cast(float, __builtin_amdgcn_update_dpp(0, __builtin_bit_cast(int, v), 0x4E, 0xF, 0xF, true)); }
__device__ __forceinline__ float dpp_hmir(float v) { return __builtin_bit_cast(float, __builtin_amdgcn_update_dpp(0, __builtin_bit_cast(int, v), 0x141, 0xF, 0xF, true)); }
__device__ __forceinline__ float red8(float v) { v += dpp_xor1(v); v += dpp_xor2(v); v += dpp_hmir(v); return v; }
__device__ __forceinline__ void gn_store(Frame& F, const Args& A, int row, int h, int q, f32x4 yv, f32x4 vv) {
    const float* BON = (const float*)(F.ws + WS_BON3); const bf16* aG = rk_bf(F, 6); bf16* RW = (bf16*)(F.ws + WS_RW);
    float s = (yv[0] + yv[1]) + (yv[2] + yv[3]);
    s += __shfl_xor(s, 1); s += __shfl_xor(s, 2); s += __shfl_xor(s, 4); s += __shfl_xor(s, 8);
    const float mean = s * (1.f / 64.f); const f32x4 d = yv - mean;
    float s2 = (d[0] * d[0] + d[1] * d[1]) + (d[2] * d[2] + d[3] * d[3]);
    s2 += __shfl_xor(s2, 1); s2 += __shfl_xor(s2, 2); s2 += __shfl_xor(s2, 4); s2 += __shfl_xor(s2, 8);
    const float rstd = rsqrtf(s2 * (1.f / 64.f) + 64e-5f), bon = BON[(row * 8 + h) * 4];
    const int cbase = h * 64 + 4 * q;
    const f32x4 gw = *(const f32x4*)(A.in[I_GNW] + cbase), gb = *(const f32x4*)(A.in[I_GNB] + cbase), gv = [&]{ const v4u pg = *(const v4u*)(rk_pair(F, 2) + (size_t)row * 512 + cbase); return (f32x4){bfhi(pg.x), bfhi(pg.y), bfhi(pg.z), bfhi(pg.w)}; }();
    const f32x4 o = (d * rstd * gw + gb + bon * vv) * gv;
    v2u w; w.x = pk2(o[0], o[1]); w.y = pk2(o[2], o[3]);
    *(v2u*)(RW + (size_t)row * 512 + cbase) = w;
}
struct ScanIn { f32x4 a0, a1, r0, r1, w0, w1, b0, b1, k0, k1; float vi, br, kr; };
__device__ __forceinline__ void scan_seg_unit(Frame& F, const Args& A, int u) {
    constexpr int TB = 32, VB = 6 * TB * 64 + 2 * TB;
    LAS float* vecs = (LAS float*)(F.lds + RING_OFF);
    LAS float* ybuf = vecs + 2 * VB;
    LAS float* cbuf = ybuf + TB * 64;
    const int tid = F.tid, i = tid >> 3, seg8 = tid & 7;
    const bool prompt = u < 256;
    int h, row0, T; bool useF; f32x2 S[4], Fm[4];
    if (prompt) { h = (u >> 3) & 7; row0 = (u >> 6) * SEQ + (u & 7) * SEGT; T = SEGT; useF = (u & 7) != 0;
#pragma unroll
        for (int c = 0; c < 4; ++c) { S[c] = (f32x2){0.f, 0.f}; Fm[c] = (f32x2){(8 * seg8 + 2 * c == i) ? 1.f : 0.f, (8 * seg8 + 2 * c + 1 == i) ? 1.f : 0.f}; } }
    else { const int su = u - 256; h = su & 7; row0 = MP + (su >> 3); T = 1; useF = false;
        const float* s0 = A.in[I_SWKV] + ((size_t)su * 64 + i) * 64 + 8 * seg8;
        const f32x4 a = *(const f32x4*)s0, b = *(const f32x4*)(s0 + 4);
        S[0] = (f32x2){a[0], a[1]}; S[1] = (f32x2){a[2], a[3]}; S[2] = (f32x2){b[0], b[1]}; S[3] = (f32x2){b[2], b[3]};
#pragma unroll
        for (int c = 0; c < 4; ++c) Fm[c] = (f32x2){0.f, 0.f}; }
    const float* BON = (const float*)(F.ws + WS_BON3);
    float* Y0 = (float*)(F.ws + WS_Y0); float* CC = (float*)(F.ws + WS_CC);
    f32x4 sg[6]; float sgs = 0.f;
    const int st = tid >> 4, sq = tid & 15;
#define SCAN_STAGE_LOAD(t0_) do { const int nb_ = (T - (t0_)) < TB ? (T - (t0_)) : TB; if (st < nb_) { const size_t go_ = (size_t)(row0 + (t0_) + st) * 512 + h * 64 + 4 * sq; \
        sg[1] = *(const f32x4*)(rk_arr(F, 1) + go_); const v4u p0_ = *(const v4u*)(rk_pair(F, 0) + go_), p2_ = *(const v4u*)(rk_pair(F, 2) + go_), p4_ = *(const v4u*)(rk_pair(F, 4) + go_); \
        sg[0] = (f32x4){bflo(p0_.x), bflo(p0_.y), bflo(p0_.z), bflo(p0_.w)}; sg[2] = (f32x4){bfhi(p0_.x), bfhi(p0_.y), bfhi(p0_.z), bfhi(p0_.w)}; sg[3] = (f32x4){bflo(p2_.x), bflo(p2_.y), bflo(p2_.z), bflo(p2_.w)}; \
        sg[4] = (f32x4){bflo(p4_.x), bflo(p4_.y), bflo(p4_.z), bflo(p4_.w)}; sg[5] = (f32x4){bfhi(p4_.x), bfhi(p4_.y), bfhi(p4_.z), bfhi(p4_.w)}; } \
        if (tid < 2 * TB && (tid >> 1) < nb_) sgs = BON[((row0 + (t0_) + (tid >> 1)) * 8 + h) * 4 + 1 + (tid & 1)]; } while (0)
#define SCAN_STAGE_STORE(buf_) do { LAS float* vb_ = vecs + (buf_) * VB; _Pragma("unroll") for (int a_ = 0; a_ < 6; ++a_) *(LAS f32x4*)(vb_ + (a_ * TB + st) * 64 + 4 * sq) = sg[a_]; \
        if (tid < 2 * TB) vb_[6 * TB * 64 + tid] = sgs; } while (0)
    SCAN_STAGE_LOAD(0); SCAN_STAGE_STORE(0);
    __syncthreads();
    int buf = 0;
    for (int t0 = 0; t0 < T; t0 += TB, buf ^= 1) {
        const int nb = (T - t0) < TB ? (T - t0) : TB;
        const bool more = t0 + TB < T;
        if (more) SCAN_STAGE_LOAD(t0 + TB);
        const LAS float* vec = vecs + buf * VB; const LAS float* scl = vec + 6 * TB * 64;
#define SCAN_LOADIN(X, t_) do { const LAS float* p_ = vec + (t_) * 64 + 8 * seg8; \
        X.r0 = *(const LAS f32x4*)(p_); X.r1 = *(const LAS f32x4*)(p_ + 4); X.w0 = *(const LAS f32x4*)(p_ + TB * 64); X.w1 = *(const LAS f32x4*)(p_ + TB * 64 + 4); \
        X.k0 = *(const LAS f32x4*)(p_ + 2 * TB * 64); X.k1 = *(const LAS f32x4*)(p_ + 2 * TB * 64 + 4); X.a0 = *(const LAS f32x4*)(p_ + 4 * TB * 64); X.a1 = *(const LAS f32x4*)(p_ + 4 * TB * 64 + 4); \
        X.b0 = *(const LAS f32x4*)(p_ + 5 * TB * 64); X.b1 = *(const LAS f32x4*)(p_ + 5 * TB * 64 + 4); X.vi = vec[(3 * TB + (t_)) * 64 + i]; X.br = scl[2 * (t_)]; X.kr = scl[2 * (t_) + 1]; } while (0)
#define LO2(v) ((f32x2){(v)[0], (v)[1]})
#define HI2(v) ((f32x2){(v)[2], (v)[3]})
#define SCAN_STEP(X, Y, t_) do { \
        const f32x2 a_[4] = {LO2(X.a0), HI2(X.a0), LO2(X.a1), HI2(X.a1)}, r_[4] = {LO2(X.r0), HI2(X.r0), LO2(X.r1), HI2(X.r1)}; \
        const f32x2 w_[4] = {LO2(X.w0), HI2(X.w0), LO2(X.w1), HI2(X.w1)}, b_[4] = {LO2(X.b0), HI2(X.b0), LO2(X.b1), HI2(X.b1)}, k_[4] = {LO2(X.k0), HI2(X.k0), LO2(X.k1), HI2(X.k1)}; \
        const float br_ = X.br, kr_ = X.kr, vi_ = X.vi; \
        f32x2 d1 = S[0] * a_[0], d2 = S[0] * r_[0], f1 = Fm[0] * a_[0], f2 = Fm[0] * r_[0]; \
        _Pragma("unroll") for (int c = 1; c < 4; ++c) { d1 += S[c] * a_[c]; d2 += S[c] * r_[c]; f1 += Fm[c] * a_[c]; f2 += Fm[c] * r_[c]; } \
        f32x2 tS[4], tF[4]; _Pragma("unroll") for (int c = 0; c < 4; ++c) { tS[c] = S[c] * w_[c] + vi_ * k_[c]; tF[c] = Fm[c] * w_[c]; } \
        { int tn_ = (t_) + 1;     \
          asm volatile("" : "+v"(tn_) : "v"(d1), "v"(d2), "v"(f1), "v"(f2), "v"(tS[0]), "v"(tS[1]), "v"(tS[2]), "v"(tS[3]), "v"(tF[0]), "v"(tF[1]), "v"(tF[2]), "v"(tF[3])); \
          if ((t_) + 1 < nb) SCAN_LOADIN(Y, tn_); } \
        float q0 = d1.x + d1.y, q1 = d2.x + d2.y, q2 = f1.x + f1.y, q3 = f2.x + f2.y; \
        q0 += dpp_xor1(q0); q1 += dpp_xor1(q1); q2 += dpp_xor1(q2); q3 += dpp_xor1(q3); \
        q0 += dpp_xor2(q0); q1 += dpp_xor2(q1); q2 += dpp_xor2(q2); q3 += dpp_xor2(q3); \
        q0 += dpp_hmir(q0); q1 += dpp_hmir(q1); q2 += dpp_hmir(q2); q3 += dpp_hmir(q3); \
        _Pragma("unroll") for (int c = 0; c < 4; ++c) { S[c] = tS[c] + q0 * b_[c]; Fm[c] = tF[c] + q2 * b_[c]; } \
        if (seg8 == 0) { ybuf[(t_) * 64 + i] = q1 + q0 * br_ + vi_ * kr_; cbuf[(t_) * 64 + i] = q3 + q2 * br_; } } while (0)
        ScanIn IA, IB;
        SCAN_LOADIN(IA, 0);
        for (int t = 0; t < nb; t += 2) {
            SCAN_STEP(IA, IB, t);
            if (t + 1 < nb) SCAN_STEP(IB, IA, t + 1);
        }
        if (more) SCAN_STAGE_STORE(buf ^ 1);
        __syncthreads();
        { const int t = tid >> 4, q = tid & 15;
          if (t < nb) { const int row = row0 + t0 + t;
            const f32x4 yv = *(const LAS f32x4*)(ybuf + t * 64 + 4 * q);
            if (prompt) { *(f32x4*)(Y0 + (size_t)row * 512 + h * 64 + 4 * q) = yv; if (useF) *(f32x4*)(CC + (size_t)row * 512 + h * 64 + 4 * q) = *(const LAS f32x4*)(cbuf + t * 64 + 4 * q); }
            else gn_store(F, A, row, h, q, yv, *(const LAS f32x4*)(vec + (3 * TB + t) * 64 + 4 * q)); } }
        __syncthreads();
    }
#undef SCAN_STAGE_LOAD
#undef SCAN_STAGE_STORE
#undef SCAN_LOADIN
#undef SCAN_STEP
#undef LO2
#undef HI2
    const f32x4 s0v = {S[0].x, S[0].y, S[1].x, S[1].y}, s1v = {S[2].x, S[2].y, S[3].x, S[3].y};
    if (prompt) { float* ps = (float*)(F.ws + WS_PSI) + ((size_t)u * 64 + i) * 64 + 8 * seg8; *(f32x4*)ps = s0v; *(f32x4*)(ps + 4) = s1v;
        if (useF) { float* ph = (float*)(F.ws + WS_PHI) + ((size_t)u * 64 + i) * 64 + 8 * seg8; *(f32x4*)ph = (f32x4){Fm[0].x, Fm[0].y, Fm[1].x, Fm[1].y}; *(f32x4*)(ph + 4) = (f32x4){Fm[2].x, Fm[2].y, Fm[3].x, Fm[3].y}; } }
    else { float* so = F.out + O_WS + ((size_t)(u - 256) * 64 + i) * 64 + 8 * seg8; *(f32x4*)so = s0v; *(f32x4*)(so + 4) = s1v; }
    __syncthreads();
}
__device__ __forceinline__ void carry_unit(Frame& F, const Args& A, int bh) {
    LAS float* X = (LAS float*)(F.lds + RING_OFF);
    LAS float* P = X + 4096;
    const int tid = F.tid, i = tid >> 3, seg8 = tid & 7;
    float* SST = (float*)(F.ws + WS_SST); const float* PSI = (const float*)(F.ws + WS_PSI); const float* PHI = (const float*)(F.ws + WS_PHI);
    float cur[8];
#pragma unroll
    for (int c = 0; c < 8; ++c) cur[c] = 0.f;
    for (int k = 0; k < NSEG; ++k) {
        const size_t uo = ((size_t)(bh * NSEG + k) * 64 + i) * 64 + 8 * seg8;
        *(f32x4*)(SST + uo) = (f32x4){cur[0], cur[1], cur[2], cur[3]}; *(f32x4*)(SST + uo + 4) = (f32x4){cur[4], cur[5], cur[6], cur[7]};
        const f32x4 p0 = *(const f32x4*)(PSI + uo), p1 = *(const f32x4*)(PSI + uo + 4);
        float nx[8] = {p0[0], p0[1], p0[2], p0[3], p1[0], p1[1], p1[2], p1[3]};
        if (k > 0) {
            __syncthreads();
            *(LAS f32x4*)(X + i * 64 + 8 * seg8) = (f32x4){cur[0], cur[1], cur[2], cur[3]}; *(LAS f32x4*)(X + i * 64 + 8 * seg8 + 4) = (f32x4){cur[4], cur[5], cur[6], cur[7]};
            *(LAS f32x4*)(P + i * 64 + 8 * seg8) = *(const f32x4*)(PHI + uo); *(LAS f32x4*)(P + i * 64 + 8 * seg8 + 4) = *(const f32x4*)(PHI + uo + 4);
            __syncthreads();
#pragma unroll 4
            for (int l = 0; l < 64; ++l) { const float x = X[i * 64 + l]; const f32x4 q0 = *(const LAS f32x4*)(P + l * 64 + 8 * seg8), q1 = *(const LAS f32x4*)(P + l * 64 + 8 * seg8 + 4);
#pragma unroll
                for (int c = 0; c < 4; ++c) { nx[c] += x * q0[c]; nx[4 + c] += x * q1[c]; } }
        }
#pragma unroll
        for (int c = 0; c < 8; ++c) cur[c] = nx[c];
    }
    float* so = F.out + O_WP + ((size_t)bh * 64 + i) * 64 + 8 * seg8; *(f32x4*)so = (f32x4){cur[0], cur[1], cur[2], cur[3]}; *(f32x4*)(so + 4) = (f32x4){cur[4], cur[5], cur[6], cur[7]};
    __syncthreads();
}
__device__ __forceinline__ void corr_unit(Frame& F, const Args& A, int u) {
    const int lane = F.lane, w = F.wave, r32 = lane & 31, hi = lane >> 5, seg = u & 7, bh = u >> 3, h = bh & 7, rowseg = (bh >> 3) * SEQ + seg * SEGT;
    const float* SST = (const float*)(F.ws + WS_SST) + (size_t)u * 4096; const float* CC = (const float*)(F.ws + WS_CC); const float* Y0 = (const float*)(F.ws + WS_Y0);
    const float* BON = (const float*)(F.ws + WS_BON3); const bf16* aG = rk_bf(F, 6); const bf16* aV = rk_bf(F, 3); bf16* RW = (bf16*)(F.ws + WS_RW);
    bf16x8 sb[2][4];
    if (seg > 0) {
#pragma unroll
        for (int ct = 0; ct < 2; ++ct)
#pragma unroll
            for (int ks = 0; ks < 4; ++ks) { const float* p = SST + (size_t)(32 * ct + r32) * 64 + 16 * ks + 8 * hi; const f32x4 x = *(const f32x4*)p, y = *(const f32x4*)(p + 4);
                const v4u t = {pk2(x[0], x[1]), pk2(x[2], x[3]), pk2(y[0], y[1]), pk2(y[2], y[3])}; sb[ct][ks] = __builtin_bit_cast(bf16x8, t); }
    }
    float gw[2], gb[2];
#pragma unroll
    for (int ct = 0; ct < 2; ++ct) { gw[ct] = A.in[I_GNW][h * 64 + 32 * ct + r32]; gb[ct] = A.in[I_GNB][h * 64 + 32 * ct + r32]; }
    for (int blk = w; blk < SEGT / 32; blk += NWAVES) {
        const int row0 = rowseg + 32 * blk;
        f32x16 d[2]; d[0] = (f32x16){}; d[1] = (f32x16){};
        float yv0[16], yv1[16], bnv[16]; unsigned vgv0[16], vgv1[16];
#pragma unroll
        for (int r = 0; r < 16; ++r) { const int row = row0 + crow16(r, hi); const size_t o = (size_t)row * 512 + h * 64 + r32;
            yv0[r] = Y0[o]; yv1[r] = Y0[o + 32]; vgv0[r] = rk_pair(F, 2)[o]; vgv1[r] = rk_pair(F, 2)[o + 32]; bnv[r] = BON[(row * 8 + h) * 4]; }
        if (seg > 0) {
#pragma unroll
            for (int ks = 0; ks < 4; ++ks) { const float* p = CC + (size_t)(row0 + r32) * 512 + h * 64 + 16 * ks + 8 * hi; const f32x4 x = *(const f32x4*)p, y = *(const f32x4*)(p + 4);
                const v4u t = {pk2(x[0], x[1]), pk2(x[2], x[3]), pk2(y[0], y[1]), pk2(y[2], y[3])}; const bf16x8 cf = __builtin_bit_cast(bf16x8, t);
                d[0] = __builtin_amdgcn_mfma_f32_32x32x16_bf16(cf, sb[0][ks], d[0], 0, 0, 0); d[1] = __builtin_amdgcn_mfma_f32_32x32x16_bf16(cf, sb[1][ks], d[1], 0, 0, 0); }
        }
#pragma unroll
        for (int r = 0; r < 16; ++r) {
            const int row = row0 + crow16(r, hi); const size_t o = (size_t)row * 512 + h * 64 + r32;
            const float y0 = yv0[r] + d[0][r], y1 = yv1[r] + d[1][r];
            const float mean = sum32(y0 + y1) * (1.f / 64.f), e0 = y0 - mean, e1 = y1 - mean;
            const float rstd = rsqrtf(sum32(e0 * e0 + e1 * e1) * (1.f / 64.f) + 64e-5f), bon = bnv[r];
            const unsigned vg0 = vgv0[r], vg1 = vgv1[r];
            const float o0 = (e0 * rstd * gw[0] + gb[0] + bon * bflo(vg0)) * bfhi(vg0), o1 = (e1 * rstd * gw[1] + gb[1] + bon * bflo(vg1)) * bfhi(vg1);
            RW[o] = (bf16)(pk2(o0, 0.f) & 0xffffu); RW[o + 32] = (bf16)(pk2(o1, 0.f) & 0xffffu);
        }
    }
}

typedef short v4i16_t __attribute__((ext_vector_type(4)));
__device__ __forceinline__ s16x4 vtr(const LAS unsigned char* p) { return __builtin_bit_cast(s16x4, __builtin_amdgcn_ds_read_tr16_b64_v4i16((LAS v4i16_t*)p)); }
constexpr int IMG_LD = 136;
constexpr int IMG_BYTES = 64 * IMG_LD;
typedef bf16x8 Frag[2][4];
__device__ __forceinline__ void mm64(const Frag& Af, const Frag& Bf, f32x16 (&D)[2][2]) {
#pragma unroll
    for (int rt = 0; rt < 2; ++rt)
#pragma unroll
        for (int ct = 0; ct < 2; ++ct)
#pragma unroll
            for (int ks = 0; ks < 4; ++ks) D[rt][ct] = __builtin_amdgcn_mfma_f32_32x32x16_bf16(Af[rt][ks], Bf[ct][ks], D[rt][ct], 0, 0, 0);
}
__device__ __forceinline__ void acc_zero(f32x16 (&D)[2][2]) {
#pragma unroll
    for (int a = 0; a < 2; ++a)
#pragma unroll
        for (int b = 0; b < 2; ++b) D[a][b] = (f32x16){};
}
__device__ __forceinline__ void acc_frag(const f32x16 (&X)[2][2], Frag& Fr) {
#pragma unroll
    for (int rt = 0; rt < 2; ++rt)
#pragma unroll
        for (int ct = 0; ct < 2; ++ct)
#pragma unroll
            for (int hf = 0; hf < 2; ++hf) { const int rb = 8 * hf;
                const v4u u = {pk2(X[rt][ct][rb], X[rt][ct][rb + 1]), pk2(X[rt][ct][rb + 2], X[rt][ct][rb + 3]), pk2(X[rt][ct][rb + 4], X[rt][ct][rb + 5]), pk2(X[rt][ct][rb + 6], X[rt][ct][rb + 7])};
                Fr[ct][2 * rt + hf] = __builtin_bit_cast(bf16x8, u); }
}
__device__ __forceinline__ void rowfrag(const LAS unsigned char* img, int lane, Frag& Fr) {
    const int r32 = lane & 31, hi = lane >> 5;
#pragma unroll
    for (int tl = 0; tl < 2; ++tl)
#pragma unroll
        for (int ks = 0; ks < 4; ++ks) Fr[tl][ks] = *(const LAS bf16x8*)(img + (32 * tl + r32) * IMG_LD + (16 * ks + 8 * hi) * 2);
}
__device__ __forceinline__ void rowfrag_perm(const LAS unsigned char* img, int lane, Frag& Fr) {
    const int r32 = lane & 31, hi = lane >> 5;
#pragma unroll
    for (int tl = 0; tl < 2; ++tl)
#pragma unroll
        for (int ks = 0; ks < 4; ++ks) { const LAS unsigned char* p = img + (32 * tl + r32) * IMG_LD + (16 * ks + 4 * hi) * 2;
            const v2u a = *(const LAS v2u*)p, b = *(const LAS v2u*)(p + 16); const v4u u = {a.x, a.y, b.x, b.y}; Fr[tl][ks] = __builtin_bit_cast(bf16x8, u); }
}
__device__ __forceinline__ void colfrag_tr(const LAS unsigned char* img, int lane, Frag& Fr) {
    const int hi = lane >> 5, qq = (lane & 15) >> 2, p4 = lane & 3, cg = (lane >> 4) & 1;
    const LAS unsigned char* base = img + (4 * hi + qq) * IMG_LD + (16 * cg + 4 * p4) * 2;
#pragma unroll
    for (int tl = 0; tl < 2; ++tl)
#pragma unroll
        for (int ks = 0; ks < 4; ++ks) { const LAS unsigned char* p = base + (16 * ks) * IMG_LD + (32 * tl) * 2;
            const s16x4 lo = vtr(p), hh = vtr(p + 8 * IMG_LD); Fr[tl][ks] = (bf16x8){lo[0], lo[1], lo[2], lo[3], hh[0], hh[1], hh[2], hh[3]}; }
}
__device__ __forceinline__ void img_load(const bf16* g, LAS unsigned char* slot, int lane) {
    asm volatile("" ::: "memory");
    const unsigned char* gb = (const unsigned char*)g + (unsigned)(lane * 16);
    LAS unsigned char* sl_ = slot + (lane >> 3) * IMG_LD + (lane & 7) * 16;
#pragma unroll
    for (int hb = 0; hb < 2; ++hb) { v4u t[4];
#pragma unroll
        for (int k = 0; k < 4; ++k) t[k] = *(const v4u*)(gb + 1024 * (4 * hb + k));
#pragma unroll
        for (int k = 0; k < 4; ++k) *(LAS v4u*)(sl_ + (8 * (4 * hb + k)) * IMG_LD) = t[k];
        asm volatile("" ::: "memory"); }
}
__device__ __forceinline__ void acc_to_img(const f32x16 (&X)[2][2], LAS unsigned char* slot, int lane) {
    const int r32 = lane & 31, hi = lane >> 5; LAS unsigned char* lb = slot + (4 * hi) * IMG_LD + r32 * 2;
#pragma unroll
    for (int rt = 0; rt < 2; ++rt)
#pragma unroll
        for (int ct = 0; ct < 2; ++ct)
        { asm volatile("" ::: "memory");
#pragma unroll
            for (int r = 0; r < 16; ++r) *(LAS bf16*)(lb + (32 * rt + CRC(r)) * IMG_LD + (32 * ct) * 2) = (bf16)(pk2(X[rt][ct][r], 0.f) & 0xffffu); }
}
__device__ __forceinline__ void acc_to_gbf(const f32x16 (&X)[2][2], bf16* g, int lane) {
    const int r32 = lane & 31, hi = lane >> 5; bf16* gl = g + (4 * hi) * 64 + r32;
#pragma unroll
    for (int rt = 0; rt < 2; ++rt)
#pragma unroll
        for (int ct = 0; ct < 2; ++ct)
        { asm volatile("" ::: "memory");
#pragma unroll
            for (int r = 0; r < 16; ++r) gl[(32 * rt + CRC(r)) * 64 + 32 * ct] = (bf16)(pk2(X[rt][ct][r], 0.f) & 0xffffu); }
}
__device__ __forceinline__ void acc_to_gf32(const f32x16 (&X)[2][2], float* g, int lane) {
    const int r32 = lane & 31, hi = lane >> 5; float* gl = g + (4 * hi) * 64 + r32;
#pragma unroll
    for (int rt = 0; rt < 2; ++rt)
#pragma unroll
        for (int ct = 0; ct < 2; ++ct)
        { asm volatile("" ::: "memory");
#pragma unroll
            for (int r = 0; r < 16; ++r) gl[(32 * rt + CRC(r)) * 64 + 32 * ct] = X[rt][ct][r]; }
}
template <bool STRICT> __device__ __forceinline__ void mask_upper(f32x16 (&X)[2][2], int lane) {
    const int r32 = lane & 31, hi = lane >> 5, dl = 4 * hi - r32;
#pragma unroll
    for (int rt = 0; rt < 2; ++rt)
#pragma unroll
        for (int ct = 0; ct < 2; ++ct)
#pragma unroll
            for (int r = 0; r < 16; ++r) { const int dlt = dl + (32 * rt + CRC(r) - 32 * ct); const bool keep = STRICT ? (dlt < 0) : (dlt <= 0); if (!keep) X[rt][ct][r] = 0.f; }
}
template <int RT> __device__ __forceinline__ void mm_rt(const Frag& Af, const Frag& Bf, f32x16 (&D)[2]) {
#pragma unroll
    for (int ct = 0; ct < 2; ++ct)
#pragma unroll
        for (int ks = 0; ks < 4; ++ks) D[ct] = __builtin_amdgcn_mfma_f32_32x32x16_bf16(Af[RT][ks], Bf[ct][ks], D[ct], 0, 0, 0);
}
template <int RT> __device__ __forceinline__ void frag_rt(const f32x16 (&D)[2], Frag& Fr) {
#pragma unroll
    for (int ct = 0; ct < 2; ++ct)
#pragma unroll
        for (int hf = 0; hf < 2; ++hf) { const int rb = 8 * hf;
            const v4u u = {pk2(D[ct][rb], D[ct][rb + 1]), pk2(D[ct][rb + 2], D[ct][rb + 3]), pk2(D[ct][rb + 4], D[ct][rb + 5]), pk2(D[ct][rb + 6], D[ct][rb + 7])};
            Fr[ct][2 * RT + hf] = __builtin_bit_cast(bf16x8, u); }
}
template <int RT, bool STRICT> __device__ __forceinline__ void mask_rt(f32x16 (&D)[2], int lane) {
    const int dl = 4 * (lane >> 5) - (lane & 31);
#pragma unroll
    for (int ct = 0; ct < 2; ++ct)
#pragma unroll
        for (int r = 0; r < 16; ++r) { const int dlt = dl + (32 * RT + CRC(r) - 32 * ct); const bool keep = STRICT ? (dlt < 0) : (dlt <= 0); if (!keep) D[ct][r] = 0.f; }
}
template <int RT> __device__ __forceinline__ void st_f32_rt(const f32x16 (&D)[2], float* g, int lane) { float* gl = g + (4 * (lane >> 5)) * 64 + (lane & 31);
#pragma unroll
    for (int ct = 0; ct < 2; ++ct) { asm volatile("" ::: "memory");
#pragma unroll
        for (int r = 0; r < 16; ++r) gl[(32 * RT + CRC(r)) * 64 + 32 * ct] = D[ct][r]; } }
template <int RT> __device__ __forceinline__ void st_bf_rt(const f32x16 (&D)[2], bf16* g, int lane) { bf16* gl = g + (4 * (lane >> 5)) * 64 + (lane & 31);
#pragma unroll
    for (int ct = 0; ct < 2; ++ct) { asm volatile("" ::: "memory");
#pragma unroll
        for (int r = 0; r < 16; ++r) gl[(32 * RT + CRC(r)) * 64 + 32 * ct] = (bf16)(pk2(D[ct][r], 0.f) & 0xffffu); } }
template <int RT> __device__ __forceinline__ void ld_f32_rt(f32x16 (&D)[2], const float* g, int lane) { const float* gl = g + (4 * (lane >> 5)) * 64 + (lane & 31);
#pragma unroll
    for (int ct = 0; ct < 2; ++ct) { asm volatile("" ::: "memory");
#pragma unroll
        for (int r = 0; r < 16; ++r) D[ct][r] = gl[(32 * RT + CRC(r)) * 64 + 32 * ct]; } }
template <int RT> __device__ __forceinline__ void scale_rt(f32x16 (&D)[2], const float* gcl  ) {
#pragma unroll
    for (int ct = 0; ct < 2; ++ct)
#pragma unroll
        for (int r = 0; r < 16; ++r) D[ct][r] *= gcl[32 * RT + CRC(r)]; }
__device__ __forceinline__ void zero2(f32x16 (&D)[2]) { D[0] = (f32x16){}; D[1] = (f32x16){}; }
__device__ __forceinline__ void tfrag(const f32x16& T, bf16x8& f0, bf16x8& f1) {
    const v4u u0 = {pk2(T[0], T[1]), pk2(T[2], T[3]), pk2(T[4], T[5]), pk2(T[6], T[7])}, u1 = {pk2(T[8], T[9]), pk2(T[10], T[11]), pk2(T[12], T[13]), pk2(T[14], T[15])};
    f0 = __builtin_bit_cast(bf16x8, u0); f1 = __builtin_bit_cast(bf16x8, u1);
}
__device__ __forceinline__ void tmm(const bf16x8 (&a)[2], const bf16x8 (&b)[2], f32x16& d) {
    d = __builtin_amdgcn_mfma_f32_32x32x16_bf16(a[0], b[0], d, 0, 0, 0); d = __builtin_amdgcn_mfma_f32_32x32x16_bf16(a[1], b[1], d, 0, 0, 0);
}
__device__ __forceinline__ void tprod(const Frag& A_, int ra, const Frag& B_, int rb, f32x16& d) {
#pragma unroll
    for (int ks = 0; ks < 4; ++ks) d = __builtin_amdgcn_mfma_f32_32x32x16_bf16(A_[ra][ks], B_[rb][ks], d, 0, 0, 0);
}
template <bool WANT_ZT> __device__ __forceinline__ void diag_inv(f32x16& Q, f32x16& QT, f32x16& Z, f32x16& ZT, int lane) {
    const int dl = 4 * (lane >> 5) - (lane & 31);
#pragma unroll
    for (int r = 0; r < 16; ++r) { const int d = dl + CRC(r); Q[r] = d < 0 ? Q[r] : 0.f; QT[r] = d > 0 ? QT[r] : 0.f; const float id = d == 0 ? 1.f : 0.f; Z[r] = Q[r] + id; ZT[r] = QT[r] + id; }
#pragma unroll 1
    for (int lvl = 0; lvl < 4; ++lvl) {
        bf16x8 fq[2], fqt[2], fz[2];
        tfrag(Q, fq[0], fq[1]); tfrag(QT, fqt[0], fqt[1]);
        Q = (f32x16){}; QT = (f32x16){}; tmm(fqt, fq, Q); tmm(fq, fqt, QT);
        tfrag(Q, fq[0], fq[1]); tfrag(QT, fqt[0], fqt[1]);
        tfrag(Z, fz[0], fz[1]); tmm(fqt, fz, Z);
        if (WANT_ZT) { tfrag(ZT, fz[0], fz[1]); tmm(fq, fz, ZT); }
    }
}
constexpr int NCHK = SEQ / 64;
__device__ __forceinline__ void chunk_prescale(Frame& F, int hc) {
    const int lane = F.lane, bh = hc >> 6, c = hc & 63, h = bh & 7, row0 = (bh >> 3) * SEQ + c * 64;
    bf16* sc = (bf16*)(F.ws + WS_SC) + (size_t)hc * 5 * 4096 + lane;
    const size_t o0 = (size_t)row0 * 512 + h * 64 + lane;
    const float* aW = rk_arr(F, 1) + o0; const unsigned* pRK = rk_pair(F, 0) + o0; const unsigned* pVG = rk_pair(F, 2) + o0; const unsigned* pAB = rk_pair(F, 4) + o0;
    float lc = 0.f;
    float wA[16], wB[16]; unsigned rkA[16], rkB[16], vgA[16], vgB[16], abA[16], abB[16];
#define PS_LOAD(S, tb) do { _Pragma("unroll") for (int i = 0; i < 16; ++i) { const int t = 16 * (tb) + i; w##S[i] = aW[t * 512]; rk##S[i] = pRK[t * 512]; vg##S[i] = pVG[t * 512]; ab##S[i] = pAB[t * 512]; } } while (0)
#define PS_COMP(S, tb) do { _Pragma("unroll") for (int i = 0; i < 16; ++i) { const int t = 16 * (tb) + i; \
        const float em = __expf(lc); lc += __logf(w##S[i]); const float ei = __expf(-lc); \
        sc[0 * 4096 + t * 64] = (bf16)(pk2(bflo(ab##S[i]) * em, 0.f) & 0xffffu); \
        sc[1 * 4096 + t * 64] = (bf16)(pk2(bfhi(ab##S[i]) * ei, 0.f) & 0xffffu); \
        sc[2 * 4096 + t * 64] = (bf16)(pk2(bfhi(rk##S[i]) * ei, 0.f) & 0xffffu); \
        sc[3 * 4096 + t * 64] = (bf16)(pk2(bflo(rk##S[i]) * em, 0.f) & 0xffffu); \
        sc[4 * 4096 + t * 64] = (bf16)(vg##S[i] & 0xffffu); } } while (0)
    PS_LOAD(A, 0); PS_LOAD(B, 1);
    PS_COMP(A, 0); asm volatile("" ::: "memory"); PS_LOAD(A, 2);
    PS_COMP(B, 1); asm volatile("" ::: "memory"); PS_LOAD(B, 3);
    PS_COMP(A, 2); PS_COMP(B, 3);
#undef PS_LOAD
#undef PS_COMP
    ((float*)(F.ws + WS_GC))[(size_t)hc * 64 + lane] = __expf(lc);
}
__device__ __forceinline__ void chunk_unit(Frame& F, int hc) {
    const int lane = F.lane, r32 = lane & 31, hi = lane >> 5;
    LAS unsigned char* s0 = F.lds + RING_OFF + F.wave * (2 * IMG_BYTES); LAS unsigned char* s1 = s0 + IMG_BYTES; const LAS unsigned char* s1l = s1 + (4 * hi) * IMG_LD + r32 * 2;
    SUBM(0);
    const float* rho = (const float*)(F.ws + WS_HT) + (size_t)(((hc >> 9) * 64 + (hc & 63)) * 2) * 512 + ((hc >> 6) & 7) * 64; const float* sig = rho + 512;
    ((float*)(F.ws + WS_GC))[(size_t)hc * 64 + lane] = rho[lane] * sig[lane];
    SUBM(1);
    const bf16* sc = (const bf16*)(F.ws + WS_SC) + (size_t)hc * 5 * 4096;
    const bf16* gAb = sc; const bf16* gBb = sc + 4096; const bf16* gKb = sc + 2 * 4096; const bf16* gRb = sc + 3 * 4096; const bf16* gV = sc + 4 * 4096;
    Frag fa, fb, zf, uf, af;
    {
        f32x16 Q, QT, Z, ZT; bf16x8 zt11[2], z22[2], t0[2], t1[2];
        img_load(gAb, s0, lane); img_load(gBb, s1, lane);
        rowfrag(s1, lane, fa); rowfrag(s0, lane, fb);
        Q = (f32x16){}; QT = (f32x16){}; tprod(fa, 0, fb, 0, Q); tprod(fb, 0, fa, 0, QT); diag_inv<true>(Q, QT, Z, ZT, lane);
        tfrag(Z, zf[0][0], zf[0][1]); tfrag(ZT, zt11[0], zt11[1]);
        Q = (f32x16){}; QT = (f32x16){}; tprod(fa, 1, fb, 1, Q); tprod(fb, 1, fa, 1, QT); diag_inv<false>(Q, QT, Z, ZT, lane);
        tfrag(Z, z22[0], z22[1]); zf[1][2] = z22[0]; zf[1][3] = z22[1];
        QT = (f32x16){}; tprod(fb, 1, fa, 0, QT);
        tfrag(QT, t0[0], t0[1]); Q = (f32x16){}; tmm(t0, z22, Q);
        tfrag(Q, t1[0], t1[1]); Z = (f32x16){}; tmm(zt11, t1, Z);
        tfrag(Z, zf[1][0], zf[1][1]);
        zf[0][2] = (bf16x8){}; zf[0][3] = (bf16x8){};
    }
    SUBM(2);
    f32x16 D[2];
    img_load(gKb, s1, lane);
    rowfrag(s1, lane, fa); rowfrag(s0, lane, fb);
    zero2(D); mm_rt<0>(fa, fb, D); mask_rt<0, true>(D, lane); frag_rt<0>(D, uf);
    zero2(D); mm_rt<1>(fa, fb, D); mask_rt<1, true>(D, lane); frag_rt<1>(D, uf);
    img_load(gV, s1, lane); colfrag_tr(s1, lane, fb);
    zero2(D); mm_rt<0>(uf, fb, D); frag_rt<0>(D, fa);
    zero2(D); mm_rt<1>(uf, fb, D); frag_rt<1>(D, fa);
    zero2(D); mm_rt<0>(zf, fa, D); frag_rt<0>(D, uf);
    zero2(D); mm_rt<1>(zf, fa, D); frag_rt<1>(D, uf);
    colfrag_tr(s0, lane, fa);
    zero2(D); mm_rt<0>(zf, fa, D); frag_rt<0>(D, af);
    zero2(D); mm_rt<1>(zf, fa, D); frag_rt<1>(D, af);
    SUBM(3);
    const float* gcg = sig + 4 * hi; const float* rhg = rho + 4 * hi;
    img_load(gKb, s0, lane); colfrag_tr(s0, lane, zf);
    img_load(gBb, s0, lane); colfrag_tr(s0, lane, fa);
    { unsigned char* slfb = F.ws + WS_SL + (size_t)hc * 8192 + lane * 8; unsigned char* gpfb = F.ws + WS_GP + (size_t)hc * 8192 + lane * 16;
      zero2(D); mm_rt<0>(zf, fb, D); mm_rt<0>(fa, uf, D); scale_rt<0>(D, gcg);
#pragma unroll
      for (int ct = 0; ct < 2; ++ct)
#pragma unroll
          for (int q = 0; q < 4; ++q) *(v2u*)(slfb + ((ct * 2 + 0) * 4 + q) * 512) = (v2u){pk2(D[ct][4 * q], D[ct][4 * q + 1]), pk2(D[ct][4 * q + 2], D[ct][4 * q + 3])};
      zero2(D); mm_rt<1>(zf, fb, D); mm_rt<1>(fa, uf, D); scale_rt<1>(D, gcg);
#pragma unroll
      for (int ct = 0; ct < 2; ++ct)
#pragma unroll
          for (int q = 0; q < 4; ++q) *(v2u*)(slfb + ((ct * 2 + 1) * 4 + q) * 512) = (v2u){pk2(D[ct][4 * q], D[ct][4 * q + 1]), pk2(D[ct][4 * q + 2], D[ct][4 * q + 3])};
      const float gc0 = sig[r32], gc1 = sig[32 + r32];
      zero2(D); mm_rt<0>(af, fa, D); D[0] *= gc0; D[1] *= gc1; scale_rt<0>(D, rhg); frag_rt<0>(D, zf);
      zero2(D); mm_rt<1>(af, fa, D); D[0] *= gc0; D[1] *= gc1; scale_rt<1>(D, rhg); frag_rt<1>(D, zf);
#pragma unroll
      for (int tl = 0; tl < 2; ++tl)
#pragma unroll
          for (int ks = 0; ks < 4; ++ks) *(bf16x8*)(gpfb + (tl * 4 + ks) * 1024) = zf[tl][ks]; }
    SUBM(4);
    img_load(gRb, s1, lane);
    rowfrag(s0, lane, fa); rowfrag(s1, lane, fb);
    zero2(D); mm_rt<0>(fa, fb, D); mask_rt<0, false>(D, lane); frag_rt<0>(D, zf);
    zero2(D); mm_rt<1>(fa, fb, D); mask_rt<1, false>(D, lane); frag_rt<1>(D, zf);
    { const LAS unsigned char* s1t = s1 + r32 * IMG_LD + hi * 8;
      unsigned char* rhfb = F.ws + WS_RH + (size_t)hc * 8192 + lane * 16;
#pragma unroll
      for (int ct = 0; ct < 2; ++ct)
#pragma unroll
          for (int q = 0; q < 4; ++q) { const v2u w_ = *(const LAS v2u*)(s1t + (32 * ct) * IMG_LD + (8 * q) * 2);
              D[ct][4 * q] = bflo(w_.x); D[ct][4 * q + 1] = bfhi(w_.x); D[ct][4 * q + 2] = bflo(w_.y); D[ct][4 * q + 3] = bfhi(w_.y); }
      mm_rt<0>(af, zf, D); scale_rt<0>(D, rhg); frag_rt<0>(D, fa);
#pragma unroll
      for (int ct = 0; ct < 2; ++ct)
#pragma unroll
          for (int q = 0; q < 4; ++q) { const v2u w_ = *(const LAS v2u*)(s1t + (32 * ct) * IMG_LD + (32 + 8 * q) * 2);
              D[ct][4 * q] = bflo(w_.x); D[ct][4 * q + 1] = bfhi(w_.x); D[ct][4 * q + 2] = bflo(w_.y); D[ct][4 * q + 3] = bfhi(w_.y); }
      mm_rt<1>(af, zf, D); scale_rt<1>(D, rhg); frag_rt<1>(D, fa);
#pragma unroll
      for (int tl = 0; tl < 2; ++tl)
#pragma unroll
          for (int ks = 0; ks < 4; ++ks) *(bf16x8*)(rhfb + (tl * 4 + ks) * 1024) = fa[tl][ks]; }
    SUBM(5);
    img_load(gKb, s0, lane);
    rowfrag(s0, lane, fa); rowfrag(s1, lane, fb);
    zero2(D); mm_rt<0>(fa, fb, D); mask_rt<0, false>(D, lane); frag_rt<0>(D, af);
    zero2(D); mm_rt<1>(fa, fb, D); mask_rt<1, false>(D, lane); frag_rt<1>(D, af);
    img_load(gV, s1, lane); colfrag_tr(s1, lane, fb);
    { unsigned char* ylfb = F.ws + WS_YL + (size_t)hc * 16384 + lane * 16;
      zero2(D); mm_rt<0>(zf, uf, D); mm_rt<0>(af, fb, D);
#pragma unroll
      for (int ct = 0; ct < 2; ++ct)
#pragma unroll
          for (int q = 0; q < 4; ++q) *(f32x4*)(ylfb + ((0 * 2 + ct) * 4 + q) * 1024) = (f32x4){D[ct][4 * q], D[ct][4 * q + 1], D[ct][4 * q + 2], D[ct][4 * q + 3]};
      zero2(D); mm_rt<1>(zf, uf, D); mm_rt<1>(af, fb, D);
#pragma unroll
      for (int ct = 0; ct < 2; ++ct)
#pragma unroll
          for (int q = 0; q < 4; ++q) *(f32x4*)(ylfb + ((1 * 2 + ct) * 4 + q) * 1024) = (f32x4){D[ct][4 * q], D[ct][4 * q + 1], D[ct][4 * q + 2], D[ct][4 * q + 3]}; }
    SUBM(6);
}
__device__ __forceinline__ void chain_unit(Frame& F, int gwv) {
    const int lane = F.lane, r32 = lane & 31, hi = lane >> 5, bh = gwv >> 1, ct = gwv & 1;
    const unsigned char* gpf = F.ws + WS_GP + (size_t)bh * NCHK * 8192 + lane * 16;
    const unsigned char* slf = F.ws + WS_SL + (size_t)bh * NCHK * 8192 + ct * 4096 + lane * 8;
    const float* gcl = (const float*)(F.ws + WS_GC) + (size_t)bh * NCHK * 64 + lane;
    unsigned char* xcf = F.ws + WS_XC + (size_t)bh * NCHK * 8192 + ct * 4096 + lane * 16;
    f32x16 X[2]; X[0] = (f32x16){}; X[1] = (f32x16){};
    v4u gA[8], gB[8], gC[8]; v2u sA[8], sB[8], sC[8]; float mA, mB, mC; const int hb = 16 * hi;
#define CH_LOAD(S) do { _Pragma("unroll") for (int k = 0; k < 8; ++k) { g##S[k] = *(const v4u*)(gpf + k * 1024); s##S[k] = *(const v2u*)(slf + k * 512); } m##S = *gcl; gpf += 8192; slf += 8192; gcl += 64; } while (0)
#define CH_STEP(S) do { bf16x8 xh[4]; \
        _Pragma("unroll") for (int rt = 0; rt < 2; ++rt) _Pragma("unroll") for (int hf = 0; hf < 2; ++hf) { const int rb = 8 * hf; \
            const v4u u = {pk2(X[rt][rb], X[rt][rb + 1]), pk2(X[rt][rb + 2], X[rt][rb + 3]), pk2(X[rt][rb + 4], X[rt][rb + 5]), pk2(X[rt][rb + 6], X[rt][rb + 7])}; \
            xh[2 * rt + hf] = __builtin_bit_cast(bf16x8, u); } \
        _Pragma("unroll") for (int ks = 0; ks < 4; ++ks) *(bf16x8*)(xcf + ks * 1024) = xh[ks]; \
        xcf += 8192; \
        _Pragma("unroll") for (int rt = 0; rt < 2; ++rt) _Pragma("unroll") for (int q = 0; q < 4; ++q) _Pragma("unroll") for (int e = 0; e < 4; ++e) { \
            const float gm_ = __builtin_bit_cast(float, __builtin_amdgcn_ds_bpermute(4 * (32 * rt + 8 * q + e) + hb, __builtin_bit_cast(int, m##S)));     \
            const unsigned sw_ = (e < 2) ? s##S[rt * 4 + q].x : s##S[rt * 4 + q].y; \
            X[rt][4 * q + e] = gm_ * X[rt][4 * q + e] + ((e & 1) ? bfhi(sw_) : bflo(sw_)); } \
        _Pragma("unroll") for (int rt = 0; rt < 2; ++rt) _Pragma("unroll") for (int ks = 0; ks < 4; ++ks) \
            X[rt] = __builtin_amdgcn_mfma_f32_32x32x16_bf16(__builtin_bit_cast(bf16x8, g##S[rt * 4 + ks]), xh[ks], X[rt], 0, 0, 0); } while (0)
    static_assert(NCHK % 3 == 1, "chain_unit: 21 x 3 steps + 1");
    CH_LOAD(A); CH_LOAD(B);
#pragma unroll 1
    for (int c = 0; c < NCHK - 1; c += 3) {
        CH_LOAD(C); CH_STEP(A);
        CH_LOAD(A); CH_STEP(B);
        if (c + 4 < NCHK) CH_LOAD(B);
        CH_STEP(C);
    }
    CH_STEP(A);
#undef CH_LOAD
#undef CH_STEP
    float* so = F.out + O_WP + (size_t)bh * 4096 + (32 * ct + r32) * 64 + 4 * hi;
#pragma unroll
    for (int rt = 0; rt < 2; ++rt)
#pragma unroll
        for (int r = 0; r < 16; ++r) so[32 * rt + CRC(r)] = X[rt][r];
}
__device__ __forceinline__ void ypass_unit(Frame& F, const Args& A, int hc) {
    const int lane = F.lane, r32 = lane & 31, hi = lane >> 5, bh = hc >> 6, c = hc & 63, h = bh & 7, row0 = (bh >> 3) * SEQ + c * 64;
    Frag fa, fb;
    { const unsigned char* xcf = F.ws + WS_XC + (size_t)hc * 8192 + lane * 16;
#pragma unroll
      for (int ct = 0; ct < 2; ++ct)
#pragma unroll
          for (int ks = 0; ks < 4; ++ks) fb[ct][ks] = *(const bf16x8*)(xcf + (ct * 4 + ks) * 1024); }
    { const unsigned char* rhf = F.ws + WS_RH + (size_t)hc * 8192 + lane * 16;
#pragma unroll
      for (int tl = 0; tl < 2; ++tl)
#pragma unroll
          for (int ks = 0; ks < 4; ++ks) fa[tl][ks] = *(const bf16x8*)(rhf + (tl * 4 + ks) * 1024); }
    f32x16 Y[2][2];
    { const unsigned char* ylf = F.ws + WS_YL + (size_t)hc * 16384 + lane * 16;
#pragma unroll
      for (int rt = 0; rt < 2; ++rt)
#pragma unroll
          for (int ct = 0; ct < 2; ++ct)
#pragma unroll
              for (int q = 0; q < 4; ++q) { const f32x4 v_ = *(const f32x4*)(ylf + ((rt * 2 + ct) * 4 + q) * 1024);
                  Y[rt][ct][4 * q] = v_[0]; Y[rt][ct][4 * q + 1] = v_[1]; Y[rt][ct][4 * q + 2] = v_[2]; Y[rt][ct][4 * q + 3] = v_[3]; } }
    const float* BON = (const float*)(F.ws + WS_BON3) + (size_t)(row0 + 4 * hi) * 32 + h * 4; bf16* RW = (bf16*)(F.ws + WS_RW) + (size_t)(row0 + 4 * hi) * 512 + h * 64 + r32;
    const unsigned* VG = rk_pair(F, 2) + (size_t)(row0 + 4 * hi) * 512 + h * 64 + r32;
    unsigned vg0[2][16], vg1[2][16]; float bon[2][16];
#pragma unroll
    for (int rt = 0; rt < 2; ++rt)
#pragma unroll
        for (int r = 0; r < 16; ++r) { vg0[rt][r] = VG[(32 * rt + CRC(r)) * 512]; vg1[rt][r] = VG[(32 * rt + CRC(r)) * 512 + 32]; bon[rt][r] = BON[(32 * rt + CRC(r)) * 32]; }
    float gw[2], gb[2];
#pragma unroll
    for (int ct = 0; ct < 2; ++ct) { gw[ct] = A.in[I_GNW][h * 64 + 32 * ct + r32]; gb[ct] = A.in[I_GNB][h * 64 + 32 * ct + r32]; }
    mm64(fa, fb, Y);
#pragma unroll
    for (int rt = 0; rt < 2; ++rt)
#pragma unroll
        for (int r = 0; r < 16; ++r) {
            const float y0 = Y[rt][0][r], y1 = Y[rt][1][r];
            const float mean = sum32(y0 + y1) * (1.f / 64.f), e0 = y0 - mean, e1 = y1 - mean;
            const float rstd = rsqrtf(sum32(e0 * e0 + e1 * e1) * (1.f / 64.f) + 64e-5f);
            const unsigned a0 = vg0[rt][r], a1 = vg1[rt][r];
            const float o0 = (e0 * rstd * gw[0] + gb[0] + bon[rt][r] * bflo(a0)) * bfhi(a0), o1 = (e1 * rstd * gw[1] + gb[1] + bon[rt][r] * bflo(a1)) * bfhi(a1);
            RW[(32 * rt + CRC(r)) * 512] = (bf16)(pk2(o0, 0.f) & 0xffffu); RW[(32 * rt + CRC(r)) * 512 + 32] = (bf16)(pk2(o1, 0.f) & 0xffffu);
        }
}

constexpr int DP_STRIDE = 260;
__device__ __forceinline__ float half_sum32(float v) { v += __shfl_xor(v, 1); v += __shfl_xor(v, 2); v += __shfl_xor(v, 4); v += __shfl_xor(v, 8); v += __shfl_xor(v, 16); return v; }
__device__ __forceinline__ float sum16(float v) {
    v += __builtin_bit_cast(float, __builtin_amdgcn_update_dpp(0, __builtin_bit_cast(int, v), 0xB1, 0xF, 0xF, true));
    v += __builtin_bit_cast(float, __builtin_amdgcn_update_dpp(0, __builtin_bit_cast(int, v), 0x4E, 0xF, 0xF, true));
    v += __builtin_bit_cast(float, __builtin_amdgcn_update_dpp(0, __builtin_bit_cast(int, v), 0x141, 0xF, 0xF, true));
    v += dpp_rmir(v);
    return v;
}
__device__ __forceinline__ void glds16(const void* gsrc, unsigned lds_dst) { unsigned keep;
    asm volatile("s_mov_b32 %0, m0\n\ts_mov_b32 m0, %2\n\ts_nop 0\n\tglobal_load_lds_dwordx4 %1, off\n\ts_mov_b32 m0, %0" : "=&s"(keep) : "v"(gsrc), "s"(lds_dst) : "memory"); }
struct LdsRows { const LAS unsigned char* b; __device__ __forceinline__ f32x4 operator[](int j) const { return *(const LAS f32x4*)(b + j * 1024); } };
__device__ __forceinline__ void decode_unit(Frame& F, const Args& A, int unit) {
    const int seq = unit >> 5, h = F.wave & 3, lane = F.lane, w = F.wave, d4 = lane & 31, tk = lane >> 5;
    const bf16* QB = (const bf16*)(F.ws + WS_QB);
    const v2u qw = *(const v2u*)(QB + (size_t)(MP + seq) * 512 + h * 128 + 4 * d4);
    const f32x4 q4 = {bflo(qw.x), bfhi(qw.x), bflo(qw.y), bfhi(qw.y)};
    const float slope = exp2f(-2.f * (float)(h + 1)) * 1.4426950408889634f;
    const int pi = (unit & 31) * 2 + (w >> 2), page = ((const int*)A.in[I_PT])[seq * NPAGES + pi];
    const float* kp = A.in[I_CK] + ((size_t)page * PAGE * 4 + h) * 128 + (size_t)tk * 512 + 4 * d4;
    const float* vp = A.in[I_CV] + ((size_t)page * PAGE * 4 + h) * 128 + (size_t)tk * 512 + 4 * d4;
    float m0 = -INFINITY, l0 = 0.f, m1 = -INFINITY, l1 = 0.f; f32x4 o0 = {0.f, 0.f, 0.f, 0.f}, o1 = o0;
    const bool c0 = d4 < 16;
    constexpr int DNB = 8;
    f32x4 kA[DNB], vA[DNB], kB[DNB], vB[DNB];
#define DEC_LOAD(KX, VX, p_) do { _Pragma("unroll") for (int j = 0; j < DNB; ++j) { KX[j] = __builtin_nontemporal_load((const f32x4*)(kp + (size_t)((p_) + j) * 1024)); VX[j] = __builtin_nontemporal_load((const f32x4*)(vp + (size_t)((p_) + j) * 1024)); } } while (0)
#define DEC_COMP(KX, VX, p_) do { float s0[DNB], s1[DNB], mx0 = m0, mx1 = m1; \
        _Pragma("unroll") for (int j = 0; j < DNB; ++j) { const f32x4 kq = KX[j] * q4; \
            const float s = sum16((kq[0] + kq[1]) + (kq[2] + kq[3])) + slope * (float)(pi * PAGE + 2 * ((p_) + j) + tk - PAST), so = __shfl_xor(s, 16); \
            s0[j] = c0 ? s : so; s1[j] = c0 ? so : s; mx0 = fmaxf(mx0, s0[j]); mx1 = fmaxf(mx1, s1[j]); } \
        const float a0 = __builtin_amdgcn_exp2f(m0 - mx0), a1 = __builtin_amdgcn_exp2f(m1 - mx1); \
        l0 *= a0; l1 *= a1; o0 *= a0; o1 *= a1; m0 = mx0; m1 = mx1; \
        _Pragma("unroll") for (int j = 0; j < DNB; ++j) { const float e0 = __builtin_amdgcn_exp2f(s0[j] - m0), e1 = __builtin_amdgcn_exp2f(s1[j] - m1); l0 += e0; l1 += e1; o0 += e0 * VX[j]; o1 += e1 * VX[j]; } } while (0)
    DEC_LOAD(kA, vA, 0);
    for (int p0 = 0; p0 < PAGE / 2; p0 += 2 * DNB) {
        DEC_LOAD(kB, vB, p0 + DNB);
        DEC_COMP(kA, vA, p0);
        if (p0 + 2 * DNB < PAGE / 2) DEC_LOAD(kA, vA, p0 + 2 * DNB);
        DEC_COMP(kB, vB, p0 + DNB);
    }
#undef DEC_LOAD
#undef DEC_COMP
#define SWP(x) __uint_as_float(__builtin_amdgcn_permlane32_swap(__float_as_uint(x), __float_as_uint(x), false, false)[tk ? 0 : 1])
    { const float mb0 = SWP(m0), lb0 = SWP(l0), mb1 = SWP(m1), lb1 = SWP(l1);
      const float M0 = fmaxf(m0, mb0), M1 = fmaxf(m1, mb1);
      const float fa0 = __builtin_amdgcn_exp2f(m0 - M0), fb0 = __builtin_amdgcn_exp2f(mb0 - M0), fa1 = __builtin_amdgcn_exp2f(m1 - M1), fb1 = __builtin_amdgcn_exp2f(mb1 - M1);
      f32x4 r0, r1;
#pragma unroll
      for (int j = 0; j < 4; ++j) { const float ob0 = SWP(o0[j]), ob1 = SWP(o1[j]); r0[j] = o0[j] * fa0 + ob0 * fb0; r1[j] = o1[j] * fa1 + ob1 * fb1; }
      float* dp = (float*)(F.ws + WS_DP2) + (size_t)((seq * 4 + h) * NPAGES + pi) * DP_STRIDE;
      if (lane == 0) *(f32x4*)dp = (f32x4){M0, l0 * fa0 + lb0 * fb0, M1, l1 * fa1 + lb1 * fb1};
      if (tk == 0) { *(f32x4*)(dp + 4 + 4 * d4) = r0; *(f32x4*)(dp + 132 + 4 * d4) = r1; } }
#undef SWP
}
__device__ __forceinline__ void decode_combine(Frame& F, const Args& A, int sh, float lam) {
    const int seq = sh >> 2, h = sh & 3, lane = F.lane, w = F.wave; const size_t ro = (size_t)(MP + seq) * 512 + h * 128 + 2 * lane;
    const float* dp = (const float*)(F.ws + WS_DP2) + (size_t)(sh * NPAGES) * DP_STRIDE;
    const float* dpo = dp + 4 + 2 * lane + (size_t)(8 * w) * DP_STRIDE;
    const unsigned qw = *(const unsigned*)((const bf16*)(F.ws + WS_QB) + ro), kw = *(const unsigned*)((const bf16*)(F.ws + WS_KB) + ro), vw = *(const unsigned*)((const bf16*)(F.ws + WS_VB) + ro);
    const f32x4 ml = *(const f32x4*)(dp + (size_t)lane * DP_STRIDE);
    f32x2 o0[8], o1[8];
#pragma unroll
    for (int i = 0; i < 8; ++i) { o0[i] = *(const f32x2*)(dpo + (size_t)i * DP_STRIDE); o1[i] = *(const f32x2*)(dpo + (size_t)i * DP_STRIDE + 128); }
    const float s = half_sum32(bflo(qw) * bflo(kw) + bfhi(qw) * bfhi(kw)), so = __shfl_xor(s, 32);
    const float sn0 = lane < 32 ? s : so, sn1 = lane < 32 ? so : s;
    float mx0 = ml[0], mx1 = ml[2];
#pragma unroll
    for (int o = 1; o < 64; o <<= 1) { mx0 = fmaxf(mx0, __shfl_xor(mx0, o)); mx1 = fmaxf(mx1, __shfl_xor(mx1, o)); }
    const float M0 = fmaxf(mx0, sn0), M1 = fmaxf(mx1, sn1);
    const float e0 = exp2f(sn0 - M0), e1 = exp2f(sn1 - M1), f0 = exp2f(ml[0] - M0), f1 = exp2f(ml[2] - M1);
    const float L0 = e0 + wave_sum(f0 * ml[1]), L1 = e1 + wave_sum(f1 * ml[3]);
    f32x2 a = {0.f, 0.f}, b = {0.f, 0.f};
#pragma unroll
    for (int i = 0; i < 8; ++i) {
        const float g0 = __builtin_bit_cast(float, __builtin_amdgcn_readlane(__builtin_bit_cast(int, f0), 8 * w + i)), g1 = __builtin_bit_cast(float, __builtin_amdgcn_readlane(__builtin_bit_cast(int, f1), 8 * w + i));
        a.x += g0 * o0[i].x; a.y += g0 * o0[i].y; b.x += g1 * o1[i].x; b.y += g1 * o1[i].y; }
    LAS f32x4* red = (LAS f32x4*)(F.lds + RING_OFF);
    red[w * 64 + lane] = (f32x4){a.x, a.y, b.x, b.y};
    __syncthreads();
    if (w != 0) return;
    a = (f32x2){e0 * bflo(vw), e0 * bfhi(vw)}; b = (f32x2){e1 * bflo(vw), e1 * bfhi(vw)};
#pragma unroll
    for (int i = 0; i < 8; ++i) { const f32x4 t = red[i * 64 + lane]; a.x += t[0]; a.y += t[1]; b.x += t[2]; b.y += t[3]; }
    const float i0 = 1.f / L0, i1 = 1.f / L1;
    const float ox = a.x * i0 - lam * b.x * i1, oy = a.y * i0 - lam * b.y * i1;
    const float rn = rsqrtf(wave_sum(ox * ox + oy * oy) * (1.f / 128.f) + 1e-6f) * 0.8f;
    const float* aog = A.in[I_AOG];
    *(unsigned*)((bf16*)(F.ws + WS_ON) + ro) = pk2(ox * rn * aog[2 * lane], oy * rn * aog[2 * lane + 1]);
}

__device__ __forceinline__ void attn_naive_row(Frame& F, const Args& A, int row, int h, float lam) {
    const int lane = F.lane, t = row & (SEQ - 1), rb = row - t;
    const bf16* QB = (const bf16*)(F.ws + WS_QB); const bf16* KB = (const bf16*)(F.ws + WS_KB); const bf16* VB = (const bf16*)(F.ws + WS_VB);
    const float slope = exp2f(-2.f * (float)(h + 1)) * 1.4426950408889634f;
    float res[2][2];
    for (int c = 0; c < 2; ++c) {
        float q[64];
#pragma unroll
        for (int d = 0; d < 64; d += 2) { const unsigned w = *(const unsigned*)(QB + (size_t)row * 512 + h * 128 + c * 64 + d); q[d] = bflo(w); q[d + 1] = bfhi(w); }
        float m = -INFINITY, l = 0.f, o[128];
#pragma unroll
        for (int d = 0; d < 128; ++d) o[d] = 0.f;
        for (int j = lane; j <= t; j += 64) {
            const bf16* kr = KB + (size_t)(rb + j) * 512 + h * 128 + c * 64; const bf16* vr = VB + (size_t)(rb + j) * 512 + h * 128;
            float s = 0.f;
#pragma unroll
            for (int d = 0; d < 64; d += 8) { const v4u w = *(const v4u*)(kr + d);
                s += q[d] * bflo(w.x) + q[d + 1] * bfhi(w.x) + q[d + 2] * bflo(w.y) + q[d + 3] * bfhi(w.y) + q[d + 4] * bflo(w.z) + q[d + 5] * bfhi(w.z) + q[d + 6] * bflo(w.w) + q[d + 7] * bfhi(w.w); }
            s += slope * (float)(j - t);
            const float mn = fmaxf(m, s), al = exp2f(m - mn), e = exp2f(s - mn);
            l = l * al + e; m = mn;
#pragma unroll
            for (int d = 0; d < 128; d += 8) { const v4u w = *(const v4u*)(vr + d);
                o[d] = o[d] * al + e * bflo(w.x); o[d + 1] = o[d + 1] * al + e * bfhi(w.x); o[d + 2] = o[d + 2] * al + e * bflo(w.y); o[d + 3] = o[d + 3] * al + e * bfhi(w.y);
                o[d + 4] = o[d + 4] * al + e * bflo(w.z); o[d + 5] = o[d + 5] * al + e * bfhi(w.z); o[d + 6] = o[d + 6] * al + e * bflo(w.w); o[d + 7] = o[d + 7] * al + e * bfhi(w.w); }
        }
        float M = m;
#pragma unroll
        for (int x = 1; x < 64; x <<= 1) M = fmaxf(M, __shfl_xor(M, x));
        const float sc = exp2f(m - M);
        const float L = wave_sum(l * sc);
        float r0 = 0.f, r1 = 0.f;
#pragma unroll
        for (int d = 0; d < 128; ++d) { const float tot = wave_sum(o[d] * sc); if ((d & 63) == lane) { if (d < 64) r0 = tot; else r1 = tot; } }
        res[c][0] = r0 / L; res[c][1] = r1 / L;
    }
    const float ox = res[0][0] - lam * res[1][0], oy = res[0][1] - lam * res[1][1];
    const float rn = rsqrtf(wave_sum(ox * ox + oy * oy) * (1.f / 128.f) + 1e-6f) * 0.8f;
    const float* aog = A.in[I_AOG]; bf16* ON = (bf16*)(F.ws + WS_ON) + (size_t)row * 512 + h * 128;
    ON[lane] = (bf16)(pk2(ox * rn * aog[lane], 0.f) & 0xffffu); ON[64 + lane] = (bf16)(pk2(oy * rn * aog[64 + lane], 0.f) & 0xffffu);
}


__device__ __forceinline__ unsigned bfbits(float f) { return __builtin_bit_cast(unsigned, f) >> 16; }
__device__ __forceinline__ void attn_unit(Frame& F, const Args& A, int b, int h, int qb, float lam) {
    LAS unsigned char* Kt = F.lds + RING_OFF;
    LAS float* wsf = (LAS float*)(Kt + 98304) + F.wave * 64;
    LAS float* xch = (LAS float*)Kt;
    const bf16* QB = (const bf16*)(F.ws + WS_QB); const bf16* KB = (const bf16*)(F.ws + WS_KB); const bf16* VB = (const bf16*)(F.ws + WS_VB);
    const int tid = F.tid, lane = F.lane, w = F.wave, c = w >> 2, wq = w & 3, r32 = lane & 31, hi = lane >> 5;
    const int rowbase = b * SEQ, q0 = 128 * qb + 32 * wq, NT = 2 * (qb + 1);
    bf16x8 qr[4];
    { const bf16* Qp = QB + (size_t)(rowbase + q0 + r32) * 512 + (2 * h + c) * 64 + 8 * hi;
#pragma unroll
      for (int d0 = 0; d0 < 4; ++d0) qr[d0] = *(const bf16x8*)(Qp + 16 * d0); }
    asm volatile("" : "+v"(qr[0]), "+v"(qr[1]), "+v"(qr[2]), "+v"(qr[3]));
    const float sl = exp2f(-2.f * (float)(h + 1)) * 1.4426950408889634f;
    const unsigned c1 = __builtin_bit_cast(unsigned, sl) & 0xffff0000u; const float r1 = sl - __builtin_bit_cast(float, c1);
    const unsigned c2 = __builtin_bit_cast(unsigned, r1) & 0xffff0000u; const float r2 = r1 - __builtin_bit_cast(float, c2);
    const unsigned c3 = __builtin_bit_cast(unsigned, r2) & 0xffff0000u;
    const unsigned b1 = c1 >> 16, b2 = c2 >> 16, b3 = c3 >> 16, lo_mask = hi ? 0u : 0xffffffffu;
    const v4u qextu = {(b1 | (b2 << 16)) & lo_mask, (b3 | (b1 << 16)) & lo_mask, (b2 | (b3 << 16)) & lo_mask, 0u};
    const bf16x8 qext = __builtin_bit_cast(bf16x8, qextu);
    const unsigned J0 = bfbits((float)r32), J1 = bfbits((float)(32 + r32));
    const unsigned lds0 = (unsigned)(uintptr_t)(F.lds + RING_OFF);
    const bf16* kg0 = KB + (size_t)(rowbase + lane) * 512 + h * 128 + (2 * w) * 8;
    const bf16* vg0 = VB + (size_t)(rowbase + 32 * (w & 1) + (lane >> 2)) * 512 + h * 128 + (w >> 1) * 32 + (lane & 3) * 8;
    const unsigned kd0 = lds0 + (2 * w) * 1024, vd0 = lds0 + 16384 + (w >> 1) * 4096 + (2 * (w & 1)) * 1024;
#define ATT_DMA(t_, boff_) do { const size_t go_ = (size_t)(t_) * 64 * 512; const unsigned bo_ = (unsigned)(boff_); \
        glds16(kg0 + go_, (unsigned)__builtin_amdgcn_readfirstlane(kd0 + bo_)); glds16(kg0 + go_ + 8, (unsigned)__builtin_amdgcn_readfirstlane(kd0 + bo_ + 1024)); \
        glds16(vg0 + go_, (unsigned)__builtin_amdgcn_readfirstlane(vd0 + bo_)); glds16(vg0 + go_ + (size_t)16 * 512, (unsigned)__builtin_amdgcn_readfirstlane(vd0 + bo_ + 1024)); } while (0)
    ATT_DMA(NT - 1, 0);
    f32x16 o[4];
#pragma unroll
    for (int i = 0; i < 4; ++i) o[i] = (f32x16){};
    float m = -INFINITY, l = 0.f;
    bf16x8 pa[4];
    asm volatile("s_waitcnt vmcnt(0) lgkmcnt(0)\n\ts_barrier" ::: "memory");
#define ATT_QKSM(t, bo) do { \
        const LAS unsigned char* kfp = Kt + (bo) + (c * 8 + hi) * 1024 + r32 * 16; \
        const unsigned Tb = bfbits((float)(64 * (t) - 128 * qb)); \
        f32x16 p[2]; bf16x8 kfr[2][4]; \
        _Pragma("unroll") for (int half = 0; half < 2; ++half) _Pragma("unroll") for (int d0 = 0; d0 < 4; ++d0) kfr[half][d0] = *(const LAS bf16x8*)(kfp + d0 * 2048 + half * 512); \
        __builtin_amdgcn_sched_barrier(0); \
        _Pragma("unroll") for (int half = 0; half < 2; ++half) { f32x16 acc = (f32x16){}; \
            _Pragma("unroll") for (int d0 = 0; d0 < 4; ++d0) acc = __builtin_amdgcn_mfma_f32_32x32x16_bf16(kfr[half][d0], qr[d0], acc, 0, 0, 0); \
            const unsigned Jb = half ? J1 : J0; \
            const v4u ke = {(Tb | (Tb << 16)) & lo_mask, (Tb | (Jb << 16)) & lo_mask, (Jb | (Jb << 16)) & lo_mask, 0u}; \
            p[half] = __builtin_amdgcn_mfma_f32_32x32x16_bf16(__builtin_bit_cast(bf16x8, ke), qext, acc, 0, 0, 0); } \
        if (64 * (t) + 63 > q0) { const int qpos = q0 + r32; \
            _Pragma("unroll") for (int half = 0; half < 2; ++half) _Pragma("unroll") for (int r = 0; r < 16; ++r) { const int kv = 64 * (t) + 32 * half + crow16(r, hi); if (kv > qpos) p[half][r] = -INFINITY; } } \
        float mx = p[0][0]; \
        _Pragma("unroll") for (int r = 1; r < 16; ++r) mx = fmaxf(mx, p[0][r]); \
        _Pragma("unroll") for (int r = 0; r < 16; ++r) mx = fmaxf(mx, p[1][r]); \
        { const auto rr = __builtin_amdgcn_permlane32_swap(__float_as_uint(mx), __float_as_uint(mx), false, false); mx = fmaxf(__uint_as_float(rr[0]), __uint_as_float(rr[1])); } \
        const float mn = fmaxf(m, mx), alpha = __builtin_amdgcn_exp2f(m - mn); m = mn; \
        float ls = 0.f; \
        _Pragma("unroll") for (int half = 0; half < 2; ++half) _Pragma("unroll") for (int r = 0; r < 16; ++r) { const float e = __builtin_amdgcn_exp2f(p[half][r] - mn); p[half][r] = e; ls += e; } \
        { const auto rr = __builtin_amdgcn_permlane32_swap(__float_as_uint(ls), __float_as_uint(ls), false, false); ls = __uint_as_float(rr[0]) + __uint_as_float(rr[1]); } \
        l = l * alpha + ls; \
        if (__any(alpha != 1.f)) { if (hi == 0) wsf[r32] = alpha; LDS_WAIT(); \
            _Pragma("unroll") for (int r = 0; r < 16; ++r) { const float f = wsf[crow16(r, hi)]; _Pragma("unroll") for (int blk = 0; blk < 4; ++blk) o[blk][r] *= f; } } \
        _Pragma("unroll") for (int s = 0; s < 4; ++s) { const int hf = s >> 1, rb = 8 * (s & 1); \
            const v4u u = {pk2(p[hf][rb], p[hf][rb + 1]), pk2(p[hf][rb + 2], p[hf][rb + 3]), pk2(p[hf][rb + 4], p[hf][rb + 5]), pk2(p[hf][rb + 6], p[hf][rb + 7])}; \
            pa[s] = __builtin_bit_cast(bf16x8, u); } } while (0)
#define ATT_PV(bo) do { \
        const LAS unsigned char* vfp = Kt + (bo) + 16384 + ((lane >> 4) & 1) * 32 + (lane & 3) * 8 + (4 * hi + ((lane & 15) >> 2)) * 64; \
        s16x4 vlo[2][4], vhi[2][4]; \
        _Pragma("unroll") for (int s = 0; s < 4; ++s) { vlo[0][s] = vtr(vfp + s * 1024); vhi[0][s] = vtr(vfp + s * 1024 + 512); } \
        _Pragma("unroll") for (int blk = 0; blk < 4; ++blk) { \
            if (blk < 3) { _Pragma("unroll") for (int s = 0; s < 4; ++s) { vlo[(blk + 1) & 1][s] = vtr(vfp + (blk + 1) * 4096 + s * 1024); vhi[(blk + 1) & 1][s] = vtr(vfp + (blk + 1) * 4096 + s * 1024 + 512); } } \
            __builtin_amdgcn_sched_barrier(0); \
            _Pragma("unroll") for (int s = 0; s < 4; ++s) { const s16x4 lo = vlo[blk & 1][s], hh = vhi[blk & 1][s]; \
                const bf16x8 vf = {lo[0], lo[1], lo[2], lo[3], hh[0], hh[1], hh[2], hh[3]}; \
                o[blk] = __builtin_amdgcn_mfma_f32_32x32x16_bf16(pa[s], vf, o[blk], 0, 0, 0); } \
            __builtin_amdgcn_sched_barrier(0); } } while (0)
    bool pend = false; int pbo = 0, bo = 0;
    for (int it = 0; it <= NT; ++it) {
        const int t = NT - 1 - it, bn = (bo == 65536) ? 0 : bo + 32768;
        if (it + 1 < NT) ATT_DMA(t - 1, bn);
        const bool act = it < NT && 64 * t <= q0 + 31;
        if (c == 1 && pend) ATT_PV(pbo);
        if (act) ATT_QKSM(t, bo);
        if (c == 0 && act) ATT_PV(bo);
        if (c == 1) { pend = act; pbo = bo; }
        asm volatile("s_waitcnt vmcnt(0) lgkmcnt(0)\n\ts_barrier" ::: "memory");
        bo = bn;
    }
#undef ATT_QKSM
#undef ATT_PV
#undef ATT_DMA
    if (hi == 0) wsf[r32] = 1.f / l;
    LDS_WAIT();
#pragma unroll
    for (int r = 0; r < 16; ++r) { const float f = wsf[crow16(r, hi)];
#pragma unroll
        for (int blk = 0; blk < 4; ++blk) o[blk][r] *= f; }
    LAS float* xw = xch + wq * 4096;
    if (c == 1) {
#pragma unroll
        for (int blk = 0; blk < 4; ++blk)
#pragma unroll
            for (int r = 0; r < 16; ++r) xw[(blk * 16 + r) * 64 + lane] = o[blk][r];
    }
    __syncthreads();
    if (c == 0) {
        const float* aog = A.in[I_AOG]; bf16* ON = (bf16*)(F.ws + WS_ON);
        float g[4];
#pragma unroll
        for (int blk = 0; blk < 4; ++blk) g[blk] = aog[32 * blk + r32] * 0.8f;
#pragma unroll
        for (int r = 0; r < 16; ++r) {
            float v[4], ss = 0.f;
#pragma unroll
            for (int blk = 0; blk < 4; ++blk) { v[blk] = o[blk][r] - lam * xw[(blk * 16 + r) * 64 + lane]; ss += v[blk] * v[blk]; }
            ss += __shfl_xor(ss, 1); ss += __shfl_xor(ss, 2); ss += __shfl_xor(ss, 4); ss += __shfl_xor(ss, 8); ss += __shfl_xor(ss, 16);
            const float rn = rsqrtf(ss * (1.f / 128.f) + 1e-6f);
            bf16* op = ON + (size_t)(rowbase + q0 + crow16(r, hi)) * 512 + h * 128 + r32;
#pragma unroll
            for (int blk = 0; blk < 4; ++blk) op[32 * blk] = (bf16)(pk2(v[blk] * rn * g[blk], 0.f) & 0xffffu);
        }
    }
    __syncthreads();
}

__device__ __forceinline__ void skinny_tile(Frame& F, LAS float* red, const bf16* A, int lda, const bf16* Bt, int K, int n0) {
    const int lane = F.lane, r = lane & 31, hi = lane >> 5, w = F.wave, kw = K / 8;
    const bf16* ap = A + (size_t)r * lda + w * kw + 8 * hi; const bf16* bp = Bt + (size_t)(n0 + r) * K + w * kw + 8 * hi;
    f32x16 acc = {};
    const int nst = kw / 16;
    for (int s0 = 0; s0 < nst; s0 += 8) {
        bf16x8 av[8], bv[8];
#pragma unroll
        for (int j = 0; j < 8; ++j) { const int k = (s0 + j < nst ? s0 + j : nst - 1) * 16; av[j] = *(const bf16x8*)(ap + k); bv[j] = *(const bf16x8*)(bp + k); }
#pragma unroll
        for (int j = 0; j < 8; ++j) if (s0 + j < nst) acc = __builtin_amdgcn_mfma_f32_32x32x16_bf16(av[j], bv[j], acc, 0, 0, 0);
    }
    __syncthreads();
#pragma unroll
    for (int i = 0; i < 16; ++i) red[w * 1024 + i * 64 + lane] = acc[i];
    __syncthreads();
    for (int e = F.tid; e < 1024; e += 512) { float s = 0.f;
#pragma unroll
        for (int j = 0; j < 8; ++j) s += red[j * 1024 + e];
        red[8 * 1024 + e] = s; }
    __syncthreads();
}

#ifndef MK_N_LAUNCHES
#define MK_N_LAUNCHES 1
#endif
#ifndef MK_NAIVE_ATTN
#define MK_NAIVE_ATTN 0
#endif
constexpr int N_PHASES = 10;
__global__ void __launch_bounds__(NWAVES * 64, 2) mk_fwd(Args args) {
    extern __shared__ __attribute__((aligned(16))) unsigned char lds[];
    Frame F;
#ifdef MK_SUB
    F.pa = 0ull; F.pb = 0ull;
#endif
    F.lds = (LAS unsigned char*)lds;
    F.MISC = (volatile LAS unsigned*)(F.lds + MISC_OFF);
    F.tid = threadIdx.x; F.lane = F.tid & 63; F.wave = __builtin_amdgcn_readfirstlane(F.tid >> 6);
    F.G = gridDim.x; { const int bx = blockIdx.x; F.vcu = (F.G % 8 == 0) ? (bx % 8) * (F.G / 8) + bx / 8 : bx; }
    F.ws = args.ws; F.out = args.out; F.ctl = (gu32*)(args.ws + WS_CTL);
    const Args& A = args;
    for (int u = F.tid; u < (LDS_BYTES - LDSCTL_OFF) / 4; u += NWAVES * 64) ((LAS unsigned*)(F.lds + LDSCTL_OFF))[u] = 0u;
    __syncthreads();
    XcdBarrier bar; bar.bar = (unsigned*)(F.ctl + CW_BAR); bar.x = 0; bar.st = nullptr;
    if (MK_N_LAUNCHES == 1) bar = xcd_barrier_post((unsigned*)(F.ctl + CW_BAR), F.MISC + 8);
#define GRID_BAR() do { if (MK_N_LAUNCHES == 1) xcd_barrier(bar); } while (0)
    const int lo = args.ph_lo, hi = args.ph_hi;
#ifndef MK_PROF
#define MK_PROF -1
#endif
#ifndef MK_PROF_SCALE
#define MK_PROF_SCALE 1e-5f
#endif
    unsigned long long prof_a = 0ull, prof_b = 0ull;
#define PH_BEGIN(k) do { if (MK_PROF == (k)) prof_a = __builtin_amdgcn_s_memrealtime(); } while (0)
#define PH_END(k) do { if (MK_PROF == (k)) prof_b = __builtin_amdgcn_s_memrealtime(); } while (0)
#ifndef MK_DBG_STOP
#define MK_DBG_STOP 99
#endif
#define IN(k) (lo <= (k) && (k) < hi && (k) <= MK_DBG_STOP)
#define BOTH(k) (IN(k) && IN((k) + 1))
    bf16* XB = (bf16*)(F.ws + WS_XB); float* rs0 = (float*)(F.ws + WS_RS0);
    bf16* QB = (bf16*)(F.ws + WS_QB); bf16* KB = (bf16*)(F.ws + WS_KB); bf16* VB = (bf16*)(F.ws + WS_VB); bf16* PC = (bf16*)(F.ws + WS_PC); bf16* GT = (bf16*)(F.ws + WS_GT);
    bf16* ON = (bf16*)(F.ws + WS_ON); bf16* RW = (bf16*)(F.ws + WS_RW); bf16* MG = (bf16*)(F.ws + WS_MG); bf16* X1B = (bf16*)(F.ws + WS_X1B); bf16* HB = (bf16*)(F.ws + WS_HB);
    float* ssq = (float*)(F.ctl + CW_SSQ);
    const int bx = (int)blockIdx.x;

    PH_BEGIN(0);
    if (IN(0)) { for (int i = bx * 512 + F.tid; i < MTOT; i += F.G * 512) ssq[i] = 0.f;
        p0_prologue<0>(F, A, F.vcu * NWAVES + F.wave, F.G * NWAVES); if (BOTH(0)) GRID_BAR(); PH_END(0); }
    PH_BEGIN(1);
    if (IN(1)) {
        pg8::Gemm g{XB, (const bf16*)(F.ws + WS_WIN), nullptr, nullptr, MTOT, INW, DM}; pg8::StaticOrder S; S.init(MTOT, INW, F.G, bx);
        pg8::EpiProj E{rs0, A.in[I_QG], A.in[I_KG], QB, KB, VB, PC, GT, F.out};
        pg8::gemm_phase<pg8::EpiProj, pg8::StaticOrder, true, true>(F.lds + RING_OFF, g, S, E);
        { const int nlong = ((MTOT / 256 + (MTOT % 256 != 0)) * (INW / 256)) % F.G;
          if (nlong == 0) p0_prologue<1>(F, A, bx * NWAVES + F.wave, F.G * NWAVES);
          else if (bx >= nlong) p0_prologue<1>(F, A, (bx - nlong) * NWAVES + F.wave, (F.G - nlong) * NWAVES);
          __syncthreads(); }
        if (BOTH(1)) GRID_BAR(); PH_END(1);
    }
    PH_BEGIN(2);
    if (IN(2)) {
        SUBM(30);
        {
            const int grp = (bx + 2 * F.G >= MP / 32) ? bx % 3 : -1;
            int u = bx;
#pragma unroll 1
            for (int st = 0; ; ++st) {
                if (st == grp) {
                    LAS unsigned* qslot = (LAS unsigned*)(F.lds + LDSCTL_OFF);
                    if (F.tid == 0) qslot[0] = __hip_atomic_fetch_add((unsigned*)(F.ctl + CW_QDEC), 1u, __ATOMIC_RELAXED, __HIP_MEMORY_SCOPE_AGENT);
                    __syncthreads();
                    const unsigned k = qslot[0];
                    __syncthreads();
                    if (k < 1024u) decode_unit(F, A, (int)k);
                    __syncthreads();
                } else if (u < MP / 32) { rwkv_prep_unit(F, A, u); u += F.G; }
                else break;
            }
        }
        SUBM(31);
        SUBM(32);
        if (BOTH(2)) GRID_BAR(); PH_END(2);
    }
    PH_BEGIN(3);
    if (IN(3)) {
        SUBM(10);
        SUBM(11);
        for (int hc = bx * NWAVES + F.wave; hc < 32 * NCHK; hc += F.G * NWAVES) chunk_unit(F, hc);
        __syncthreads();
        if (BOTH(3)) GRID_BAR(); PH_END(3);
    }
    PH_BEGIN(4);
    if (IN(4)) {
        { int ln_ = F.lane, td_ = F.tid; asm volatile("" : "+v"(ln_), "+v"(td_)); F.lane = ln_; F.tid = td_; }
        SUBM(50);
        if (bx < 8) { chain_unit(F, bx * NWAVES + F.wave); __syncthreads(); }
        SUBM(51);
        const float lam = lam_value(F, A);
        LAS unsigned* qslot = (LAS unsigned*)(F.lds + LDSCTL_OFF);
        const unsigned dtail = __hip_atomic_load((unsigned*)(F.ctl + CW_QDEC), __ATOMIC_RELAXED, __HIP_MEMORY_SCOPE_AGENT) < 1024u ? __hip_atomic_load((unsigned*)(F.ctl + CW_QDEC), __ATOMIC_RELAXED, __HIP_MEMORY_SCOPE_AGENT) : 1024u;
        for (;;) {
            { int ln_ = F.lane, td_ = F.tid; asm volatile("" : "+v"(ln_), "+v"(td_)); F.lane = ln_; F.tid = td_; }
            if (F.tid == 0) qslot[0] = __hip_atomic_fetch_add((unsigned*)(F.ctl + CW_QUEUE), 1u, __ATOMIC_RELAXED, __HIP_MEMORY_SCOPE_AGENT);
            __syncthreads();
            const unsigned k = qslot[0];
            __syncthreads();
            if (k >= 1025u) break;
            if (k == 0u) { rwkv_prep_unit(F, A, MP / 32); continue; }
            const unsigned tr = (k - 1u) >> 1, r = (k - 1u) & 1u;
#ifdef MK_SUB
            const unsigned long long t0_ = __builtin_amdgcn_s_memrealtime();
#endif
            if (r == 0u) attn_unit(F, A, (int)(tr & 15u) >> 2, (int)(tr & 3u), 31 - (int)(tr >> 4), lam);
            else { const unsigned d = dtail + 2u * tr; if (d < 1024u) decode_unit(F, A, (int)d); if (d + 1u < 1024u) { __syncthreads(); decode_unit(F, A, (int)(d + 1u)); } }
#ifdef MK_SUB
            if ((MK_SUB == 40 && r == 0u) || (MK_SUB == 41 && r != 0u)) F.pb += __builtin_amdgcn_s_memrealtime() - t0_;
#endif
        }
        if (BOTH(4)) GRID_BAR(); PH_END(4);
    }
    PH_BEGIN(5);
    if (IN(5)) {
        SUBM(20);
        { const float lam = lam_value(F, A);
          for (int it = bx; it < 128; it += F.G) { decode_combine(F, A, it, lam); if (it + F.G < 128) __syncthreads(); } }
        __syncthreads();
        for (int u = 256 + bx; u < 512; u += F.G) scan_seg_unit(F, A, u);
        SUBM(21);
        for (int hc = bx * NWAVES + F.wave; hc < 32 * NCHK; hc += F.G * NWAVES) ypass_unit(F, A, hc);
        SUBM(22);
        __syncthreads();
        if (BOTH(5)) GRID_BAR(); PH_END(5);
    }
    PH_BEGIN(6);
    if (IN(6)) {
        if (bx < 32) {
            LAS float* red = (LAS float*)(F.lds + RING_OFF); const int n0 = 32 * bx; float t1[2];
            skinny_tile(F, red, ON + (size_t)MP * 512, 512, (const bf16*)(F.ws + WS_WPA), 512, n0);
            t1[0] = red[8192 + F.tid]; t1[1] = red[8192 + 512 + F.tid];
            skinny_tile(F, red, RW + (size_t)MP * 512, 512, (const bf16*)(F.ws + WS_WPB), 512, n0);
#pragma unroll
            for (int i = 0; i < 2; ++i) { const int e = F.tid + 512 * i, reg = e >> 6, ln = e & 63, row = crow16(reg, ln >> 5), col = n0 + (ln & 31);
                const float g1 = bf2f(GT[(size_t)(MP + row) * 2048 + col]), g2 = bf2f(GT[(size_t)(MP + row) * 2048 + 1024 + col]);
                MG[(size_t)(MP + row) * 1024 + col] = (bf16)(pk2(g1 * t1[i] + g2 * red[8192 + e], 0.f) & 0xffffu); }
            __syncthreads();
        }
        pg8::Gemm g{ON, (const bf16*)(F.ws + WS_WPA), RW, (const bf16*)(F.ws + WS_WPB), MP, DM, 512}; pg8::PairOrder S; S.base.init(MP, DM, F.G, bx);
        pg8::EpiMerge E{GT, (float*)(F.ws + WS_TMP), MG};
        pg8::gemm_phase<pg8::EpiMerge, pg8::PairOrder, true, true>(F.lds + RING_OFF, g, S, E);
        if (BOTH(6)) GRID_BAR(); PH_END(6);
    }
    PH_BEGIN(7);
    if (IN(7)) {
        if (bx < 32) {
            LAS float* red = (LAS float*)(F.lds + RING_OFF); const int n0 = 32 * bx;
            skinny_tile(F, red, MG + (size_t)MP * 1024, 1024, (const bf16*)(F.ws + WS_WOUT), 1024, n0);
#pragma unroll
            for (int i = 0; i < 2; ++i) { const int e = F.tid + 512 * i, reg = e >> 6, ln = e & 63, row = crow16(reg, ln >> 5), col = n0 + (ln & 31);
                const float v = A.in[I_XS][(size_t)row * 1024 + col] + red[8192 + e];
                F.out[O_YS + (size_t)row * 1024 + col] = v; X1B[(size_t)(MP + row) * 1024 + col] = (bf16)(pk2(v, 0.f) & 0xffffu);
                float ss = v * v; ss += __shfl_xor(ss, 1); ss += __shfl_xor(ss, 2); ss += __shfl_xor(ss, 4); ss += __shfl_xor(ss, 8); ss += __shfl_xor(ss, 16);
                if ((ln & 31) == 0) atomicAdd(ssq + MP + row, ss); }
            __syncthreads();
        }
        pg8::Gemm g{MG, (const bf16*)(F.ws + WS_WOUT), nullptr, nullptr, MP, DM, DM}; pg8::StaticOrder S; S.init(MP, DM, F.G, bx);
        pg8::EpiOut E{XB, X1B, ssq};
        pg8::gemm_phase<pg8::EpiOut, pg8::StaticOrder, false, true>(F.lds + RING_OFF, g, S, E);
        if (BOTH(7)) GRID_BAR(); PH_END(7);
    }
    PH_BEGIN(8);
    if (IN(8)) {
        pg8::Gemm g{X1B, (const bf16*)(F.ws + WS_WGU), nullptr, nullptr, MTOT, NGU, DM}; pg8::StaticOrder S; S.init(MTOT, NGU, F.G, bx);
        pg8::EpiGateUp E{ssq, HB};
        pg8::gemm_phase<pg8::EpiGateUp, pg8::StaticOrder, true, true>(F.lds + RING_OFF, g, S, E);
        if (BOTH(8)) GRID_BAR(); PH_END(8);
    }
    PH_BEGIN(9);
    if (IN(9)) {
        if (bx < 32) {
            LAS float* red = (LAS float*)(F.lds + RING_OFF); const int n0 = 32 * bx;
            skinny_tile(F, red, HB + (size_t)MP * FF, FF, (const bf16*)(F.ws + WS_WDN), FF, n0);
#pragma unroll
            for (int i = 0; i < 2; ++i) { const int e = F.tid + 512 * i, reg = e >> 6, ln = e & 63, row = crow16(reg, ln >> 5), col = n0 + (ln & 31);
                float yv = F.out[O_YS + (size_t)row * 1024 + col] + red[8192 + e];
#ifdef MK_SUB
                prof_a = F.pa; prof_b = F.pb;
#endif
                if (MK_PROF >= 0 && MK_PROF != 9) yv *= 1.f + sqrtf((float)(prof_b - prof_a) * 0.01f * MK_PROF_SCALE);
                F.out[O_YS + (size_t)row * 1024 + col] = yv; }
            __syncthreads();
        }
        pg8::Gemm g{HB, (const bf16*)(F.ws + WS_WDN), nullptr, nullptr, MP, DM, FF}; pg8::StaticOrder S; S.init(MP, DM, F.G, bx);
        pg8::EpiDown E{F.out + O_YP, X1B};
        pg8::gemm_phase<pg8::EpiDown, pg8::StaticOrder, false, true>(F.lds + RING_OFF, g, S, E);
        if (MK_PROF == 9 && MK_N_LAUNCHES == 1) {
            xcd_barrier(bar); prof_b = __builtin_amdgcn_s_memrealtime();
            const float sc = 1.f + sqrtf((float)(prof_b - prof_a) * 0.01f * 1e-5f);
            for (int e = bx * 512 + F.tid; e < 32 * 1024; e += F.G * 512) F.out[O_YS + e] *= sc;
        }
    }
#undef IN
#undef BOTH
}

#if MK_NAIVE_ATTN
__global__ void __launch_bounds__(512, 2) attn_naive_kernel(Args args) {
    Frame F; F.tid = threadIdx.x; F.lane = F.tid & 63; F.wave = __builtin_amdgcn_readfirstlane(F.tid >> 6); F.G = gridDim.x; F.ws = args.ws; F.out = args.out;
    const Args& A = args;
    const float lam = lam_value(F, A);
    const int gw = (int)blockIdx.x * NWAVES + F.wave, NGW = F.G * NWAVES;
    for (int it = gw; it < MP * 4; it += NGW) attn_naive_row(F, A, it >> 2, it & 3, lam);
}
#endif
extern "C" void kernel_launch(void* const* d_in, const int* in_sizes, int n_in, void* d_out, int out_size, void* d_ws, size_t ws_size, hipStream_t stream) {
    static int grid = 0;
    if (grid == 0) {
        if (n_in != 34 || out_size != (int)O_END || ws_size < WS_END) { fprintf(stderr, "kernel_launch: unexpected shapes: n_in %d out %d ws %zu\n", n_in, out_size, ws_size); grid = -1; return; }
        int dev = 0, cus = 0, per_cu = 0;
        if (hipGetDevice(&dev) != hipSuccess || hipDeviceGetAttribute(&cus, hipDeviceAttributeMultiprocessorCount, dev) != hipSuccess) { grid = -1; return; }
        if (hipFuncSetAttribute((const void*)mk_fwd, hipFuncAttributeMaxDynamicSharedMemorySize, LDS_BYTES) != hipSuccess) { fprintf(stderr, "kernel_launch: hipFuncSetAttribute failed\n"); grid = -1; return; }
        if (hipOccupancyMaxActiveBlocksPerMultiprocessor(&per_cu, (const void*)mk_fwd, NWAVES * 64, LDS_BYTES) != hipSuccess || per_cu < 1) fprintf(stderr, "kernel_launch: occupancy query says %d\n", per_cu);
        (void)hipGetLastError();
        grid = cus;
    }
    if (grid < 0) return;
    if (hipMemsetAsync((char*)d_ws + WS_CTL, 0, CTL_ZERO_BYTES, stream) != hipSuccess) return;
    Args a{};
    for (int i = 0; i < 34; ++i) a.in[i] = (const float*)d_in[i];
    a.out = (float*)d_out; a.ws = (unsigned char*)d_ws;
    const int NL = MK_N_LAUNCHES;
    for (int li = 0; li < NL; ++li) {
        a.ph_lo = (NL == 1) ? 0 : li; a.ph_hi = (NL == 1) ? N_PHASES : li + 1; a.li = li; a.pad = 0;
        hipLaunchKernelGGL(mk_fwd, dim3(grid), dim3(NWAVES * 64), LDS_BYTES, stream, a);
        if (hipPeekAtLastError() != hipSuccess) { fprintf(stderr, "kernel_launch: launch %d failed\n", li); break; }
#if MK_NAIVE_ATTN
        if (NL != 1 && li == 3) hipLaunchKernelGGL(attn_naive_kernel, dim3(1024), dim3(512), 0, stream, a);
#endif
    }
}
```

```cpp
#include <hip/hip_runtime.h>
#include <cstdio>
#include <cstdint>

constexpr int MP = 16384, MS = 32, MVALID = MP + MS, MTOT = 16640;
constexpr int DM = 1024, INW = 5376, FF = 2816, NGU = 2 * FF, SEQ = 4096, NBATCH = 4, RSW = 1792;
constexpr int NPAGES = 64, PAGE = 128, PAST = 8192;
constexpr size_t O_YP = 0, O_YS = 16777216, O_KP = O_YS + 32768, O_VP = O_KP + 8388608, O_WP = O_VP + 8388608, O_SP = O_WP + 131072,
                 O_KS = O_SP + 7168, O_VS = O_KS + 16384, O_WS = O_VS + 16384, O_SS = O_WS + 1048576, O_END = O_SS + 57344;
constexpr float QK_C2 = 0.125f * 1.4426950408889634f;
namespace pg8 {
#define PG8_LAS __attribute__((address_space(3)))
typedef unsigned short bf16_t;
typedef short bf16x8 __attribute__((ext_vector_type(8)));
typedef float f32x4 __attribute__((ext_vector_type(4)));
typedef unsigned u32x4 __attribute__((ext_vector_type(4)));
constexpr int BM = 256, BK = 64, HALF = 128, HTB = HALF * BK * 2  , STAGE_BYTES = 8 * HTB, NXCD = 8, WGM = 8;

__host__ __device__ __forceinline__ int lds_byte(int r, int c) { const int st = (r >> 4) * 2 + (c >> 5), rr = r & 15, cc = c & 31, ob = rr * 64 + cc * 2; return st * 1024 + (ob ^ (((ob >> 9) & 1) << 5)); }
__host__ __device__ __forceinline__ void stage_rc(int b, int& R, int& C) { const int st = b / 1024, sb = b % 1024, swz = sb ^ (((sb >> 9) & 1) << 5); R = (st >> 1) * 16 + swz / 64; C = (st & 1) * 32 + (swz % 64) / 2; }
__host__ __device__ __forceinline__ int perm32(int rho) { const int n = rho >> 4, i = rho & 15; return 8 * (i >> 2) + 4 * n + (i & 3); }

struct Unit { int pm, pn, z; };
struct Gemm { const bf16_t* A; const bf16_t* Bt; const bf16_t* A2; const bf16_t* Bt2; int M, N, K; };

struct StaticOrder {
    int nM, nN, nwg, G, c;
    __host__ __device__ void init(int M, int N, int G_, int c_) { nM = M / BM; nN = N / BM; nwg = nM * nN; G = G_; c = c_; }
    __host__ __device__ bool next(int i, Unit& u) const {
        const long L = (long)i * G + c; if (L >= nwg) return false;
        int wgid = (int)L; { const int q = nwg / NXCD, r = nwg % NXCD, xcd = wgid % NXCD, off = wgid / NXCD; wgid = (xcd < r ? xcd * (q + 1) : r * (q + 1) + (xcd - r) * q) + off; }
        const int nig = WGM * nN, gid = wgid / nig, fm = gid * WGM, gsz = (nM - fm) < WGM ? (nM - fm) : WGM;
        u.pm = fm + ((wgid % nig) % gsz); u.pn = (wgid % nig) / gsz; u.z = 0; return true;
    }
    __device__ __forceinline__ void a_ready(const Unit&) const {}
    __device__ __forceinline__ void done(const Unit&) const {}
};

typedef float f32x2_cv __attribute__((ext_vector_type(2))); typedef __bf16 bf16x2_cv __attribute__((ext_vector_type(2)));
__device__ __forceinline__ unsigned cvt_pk_bf16(float lo, float hi) { const f32x2_cv v = {lo, hi}; const bf16x2_cv b = __builtin_convertvector(v, bf16x2_cv); return __builtin_bit_cast(unsigned, b); }
typedef float f32x2 __attribute__((ext_vector_type(2)));
__device__ __forceinline__ void st_bf16x8(bf16_t* p, const f32x4 a, const f32x4 b) {
    u32x4 w; w.x = cvt_pk_bf16(a[0], a[1]); w.y = cvt_pk_bf16(a[2], a[3]); w.z = cvt_pk_bf16(b[0], b[1]); w.w = cvt_pk_bf16(b[2], b[3]); *(u32x4*)p = w;
}
__device__ __forceinline__ float sigmoidf_(float x) { return __builtin_amdgcn_rcpf(1.f + __expf(-x)); }

struct EpiProj {
    static constexpr bool PERM = true, AFTER_DRAIN = false, KEEP_ACC = false;
    const float* rs0; const float* qg; const float* kg;
    bf16_t *QB, *KB, *VB, *PC, *GT; float* out;
    __device__ __forceinline__ void operator()(const f32x4 (&acc)[2][2][4][2], const Unit& u, int wr, int wc, int fr, int fq) const {
        const int pn = u.pn, rb = u.pm * BM + wr * 64 + fr, c8 = 64 * wc + 8 * fq;
        if (pn < 4) {
            const bool isq = pn < 2; const float* gain = isq ? qg : kg;
            f32x4 gv[2][2];
#pragma unroll
            for (int bj = 0; bj < 2; ++bj)
#pragma unroll
                for (int n = 0; n < 2; ++n) gv[bj][n] = *(const f32x4*)(gain + 32 * bj + 8 * fq + 4 * n);
            const int colg = 256 * (pn & 1) + c8;
#pragma unroll
            for (int ai = 0; ai < 2; ++ai)
#pragma unroll
                for (int m = 0; m < 4; ++m) {
                    const int row = rb + ai * HALF + m * 16; const bool ok = row < MVALID; const float rs = rs0[ok ? row : 0];
                    float ss = 0.f;
#pragma unroll
                    for (int bj = 0; bj < 2; ++bj)
#pragma unroll
                        for (int n = 0; n < 2; ++n) { const f32x4 x = acc[ai][bj][m][n] * rs; ss += (x[0] * x[0] + x[1] * x[1]) + (x[2] * x[2] + x[3] * x[3]); }
                    ss += __shfl_xor(ss, 16); ss += __shfl_xor(ss, 32);
                    const float rn = rsqrtf(ss * (1.f / 64.f) + 1e-6f) * rs;
#pragma unroll
                    for (int bj = 0; bj < 2; ++bj) {
                        const f32x4 v0 = acc[ai][bj][m][0] * rn * gv[bj][0], v1 = acc[ai][bj][m][1] * rn * gv[bj][1];
                        const size_t o = (size_t)row * 512 + colg + 32 * bj;
                        if (ok) {
                            if (isq) st_bf16x8(QB + o, v0 * QK_C2, v1 * QK_C2);
                            else { st_bf16x8(KB + o, v0, v1);
                                float* f = row < MP ? out + O_KP + o : out + O_KS + (size_t)(row - MP) * 512 + colg + 32 * bj;
                                *(f32x4*)f = v0; *(f32x4*)(f + 4) = v1; }
                        }
                    }
                }
        } else {
#pragma unroll
            for (int ai = 0; ai < 2; ++ai)
#pragma unroll
                for (int m = 0; m < 4; ++m) {
                    const int row = rb + ai * HALF + m * 16; const bool ok = row < MVALID; const float rs = rs0[ok ? row : 0];
                    if (!ok) continue;
#pragma unroll
                    for (int bj = 0; bj < 2; ++bj) {
                        f32x4 v0 = acc[ai][bj][m][0] * rs, v1 = acc[ai][bj][m][1] * rs;
                        if (pn < 6) {
                            const size_t c = (size_t)(256 * (pn - 4) + c8 + 32 * bj), o = (size_t)row * 512 + c;
                            st_bf16x8(VB + o, v0, v1);
                            float* f = row < MP ? out + O_VP + o : out + O_VS + (size_t)(row - MP) * 512 + c;
                            *(f32x4*)f = v0; *(f32x4*)(f + 4) = v1;
                        } else if (pn < 13) {
                            const size_t c = (size_t)(256 * (pn - 6) + c8 + 32 * bj);
                            st_bf16x8(PC + (size_t)row * RSW + c, v0, v1);
                            if (row >= MP) { float* f = out + O_SS + (size_t)(row - MP) * RSW + c; *(f32x4*)f = v0; *(f32x4*)(f + 4) = v1; }
                            else if ((row & (SEQ - 1)) == SEQ - 1) { float* f = out + O_SP + (size_t)(row >> 12) * RSW + c; *(f32x4*)f = v0; *(f32x4*)(f + 4) = v1; }
                        } else {
                            const size_t c = (size_t)(256 * (pn - 13) + c8 + 32 * bj);
#ifndef MK_DBG_NOSIG
#pragma unroll
                            for (int j = 0; j < 4; ++j) { v0[j] = sigmoidf_(v0[j]); v1[j] = sigmoidf_(v1[j]); }
#endif
                            st_bf16x8(GT + (size_t)row * 2048 + c, v0, v1);
                        }
                    }
                }
        }
    }
};

struct EpiMerge {
    static constexpr bool PERM = true, AFTER_DRAIN = false, KEEP_ACC = true;
    const bf16_t* GT; float* tmp; bf16_t* MG;
    __device__ __forceinline__ void operator()(const f32x4 (&acc_)[2][2][4][2], const Unit& u, int wr, int wc, int fr, int fq) const {
        f32x4 (&acc)[2][2][4][2] = const_cast<f32x4 (&)[2][2][4][2]>(acc_);
        const int rb = u.pm * BM + wr * 64 + fr, cb = u.pn * BM + wc * 32 + 8 * fq;
#pragma unroll
        for (int ai = 0; ai < 2; ++ai)
#pragma unroll
            for (int m = 0; m < 4; ++m) {
                const int row = rb + ai * HALF + m * 16;
#pragma unroll
                for (int bj = 0; bj < 2; ++bj) {
                    const int col = cb + bj * HALF;
                    const u32x4 gw = *(const u32x4*)(GT + (size_t)row * 2048 + 1024 + col);
                    f32x4 g0, g1;
                    g0[0] = __builtin_bit_cast(float, gw.x << 16); g0[1] = __builtin_bit_cast(float, gw.x & 0xffff0000u); g0[2] = __builtin_bit_cast(float, gw.y << 16); g0[3] = __builtin_bit_cast(float, gw.y & 0xffff0000u);
                    g1[0] = __builtin_bit_cast(float, gw.z << 16); g1[1] = __builtin_bit_cast(float, gw.z & 0xffff0000u); g1[2] = __builtin_bit_cast(float, gw.w << 16); g1[3] = __builtin_bit_cast(float, gw.w & 0xffff0000u);
                    if (!u.z) {
                        const u32x4 hw = *(const u32x4*)(GT + (size_t)row * 2048 + col);
                        f32x4 h0, h1;
                        h0[0] = __builtin_bit_cast(float, hw.x << 16); h0[1] = __builtin_bit_cast(float, hw.x & 0xffff0000u); h0[2] = __builtin_bit_cast(float, hw.y << 16); h0[3] = __builtin_bit_cast(float, hw.y & 0xffff0000u);
                        h1[0] = __builtin_bit_cast(float, hw.z << 16); h1[1] = __builtin_bit_cast(float, hw.z & 0xffff0000u); h1[2] = __builtin_bit_cast(float, hw.w << 16); h1[3] = __builtin_bit_cast(float, hw.w & 0xffff0000u);
#pragma unroll
                        for (int e = 0; e < 4; ++e) { acc[ai][bj][m][0][e] *= h0[e] / fmaxf(g0[e], 1e-30f); acc[ai][bj][m][1][e] *= h1[e] / fmaxf(g1[e], 1e-30f); }
                    } else {
                        const f32x4 v0 = acc[ai][bj][m][0] * g0, v1 = acc[ai][bj][m][1] * g1;
                        st_bf16x8(MG + (size_t)row * 1024 + col, v0, v1);
                    }
                }
            }
    }
};
struct EpiOut {
    static constexpr bool PERM = true, AFTER_DRAIN = false, KEEP_ACC = false;
    const bf16_t* xb; bf16_t* X1B; float* ssq;
    __device__ __forceinline__ void operator()(const f32x4 (&acc)[2][2][4][2], const Unit& u, int wr, int wc, int fr, int fq) const {
        const int rb = u.pm * BM + wr * 64 + fr, cb = u.pn * BM + wc * 32 + 8 * fq;
#pragma unroll
        for (int ai = 0; ai < 2; ++ai)
#pragma unroll
            for (int m = 0; m < 4; ++m) {
                const int row = rb + ai * HALF + m * 16; float ss = 0.f;
#pragma unroll
                for (int bj = 0; bj < 2; ++bj) {
                    const size_t o = (size_t)row * 1024 + cb + bj * HALF;
                    const u32x4 xw = *(const u32x4*)(xb + o); f32x4 v0 = acc[ai][bj][m][0], v1 = acc[ai][bj][m][1];
                    v0[0] += __builtin_bit_cast(float, xw.x << 16); v0[1] += __builtin_bit_cast(float, xw.x & 0xffff0000u); v0[2] += __builtin_bit_cast(float, xw.y << 16); v0[3] += __builtin_bit_cast(float, xw.y & 0xffff0000u);
                    v1[0] += __builtin_bit_cast(float, xw.z << 16); v1[1] += __builtin_bit_cast(float, xw.z & 0xffff0000u); v1[2] += __builtin_bit_cast(float, xw.w << 16); v1[3] += __builtin_bit_cast(float, xw.w & 0xffff0000u);
                    st_bf16x8(X1B + o, v0, v1);
                    ss += (v0[0] * v0[0] + v0[1] * v0[1]) + (v0[2] * v0[2] + v0[3] * v0[3]) + (v1[0] * v1[0] + v1[1] * v1[1]) + (v1[2] * v1[2] + v1[3] * v1[3]);
                }
                ss += __shfl_xor(ss, 16); ss += __shfl_xor(ss, 32);
                if (fq == 0) atomicAdd(ssq + row, ss);
            }
    }
};
struct EpiGateUp {
    static constexpr bool PERM = true, AFTER_DRAIN = false, KEEP_ACC = false;
    const float* ssq; bf16_t* HB;
    __device__ __forceinline__ void operator()(const f32x4 (&acc)[2][2][4][2], const Unit& u, int wr, int wc, int fr, int fq) const {
        const int rb = u.pm * BM + wr * 64 + fr, cb = u.pn * HALF + wc * 32 + 8 * fq;
#pragma unroll
        for (int ai = 0; ai < 2; ++ai)
#pragma unroll
            for (int m = 0; m < 4; ++m) {
                const int row = rb + ai * HALF + m * 16; if (row >= MVALID) continue;
                const float rs = rsqrtf(ssq[row] * (1.f / 1024.f) + 1e-6f);
                f32x4 h[2];
#pragma unroll
                for (int n = 0; n < 2; ++n)
#pragma unroll
                    for (int j = 0; j < 4; ++j) { const float g = acc[ai][0][m][n][j] * rs, uu = acc[ai][1][m][n][j] * rs; h[n][j] = g * sigmoidf_(g) * uu; }
                st_bf16x8(HB + (size_t)row * FF + cb, h[0], h[1]);
            }
    }
};
struct EpiDown {
    static constexpr bool PERM = true, AFTER_DRAIN = false, KEEP_ACC = false;
    float* y; const bf16_t* X1B;
    __device__ __forceinline__ void operator()(const f32x4 (&acc)[2][2][4][2], const Unit& u, int wr, int wc, int fr, int fq) const {
        const int rb = u.pm * BM + wr * 64 + fr, cb = u.pn * BM + wc * 32 + 8 * fq;
#pragma unroll
        for (int ai = 0; ai < 2; ++ai)
#pragma unroll
            for (int m = 0; m < 4; ++m) {
                const int row = rb + ai * HALF + m * 16;
#pragma unroll
                for (int bj = 0; bj < 2; ++bj) {
                    float* p = y + (size_t)row * 1024 + cb + bj * HALF; const u32x4 xw = *(const u32x4*)(X1B + (size_t)row * 1024 + cb + bj * HALF);
                    f32x4 v0 = acc[ai][bj][m][0], v1 = acc[ai][bj][m][1];
                    v0[0] += __builtin_bit_cast(float, xw.x << 16); v0[1] += __builtin_bit_cast(float, xw.x & 0xffff0000u); v0[2] += __builtin_bit_cast(float, xw.y << 16); v0[3] += __builtin_bit_cast(float, xw.y & 0xffff0000u);
                    v1[0] += __builtin_bit_cast(float, xw.z << 16); v1[1] += __builtin_bit_cast(float, xw.z & 0xffff0000u); v1[2] += __builtin_bit_cast(float, xw.w << 16); v1[3] += __builtin_bit_cast(float, xw.w & 0xffff0000u);
                    *(f32x4*)p = v0; *(f32x4*)(p + 4) = v1;
                }
            }
    }
};
struct PairOrder {
    StaticOrder base;
    __device__ __forceinline__ bool next(int i, Unit& u) const { if (!base.next(i >> 1, u)) return false; u.z = i & 1; return true; }
    __device__ __forceinline__ void a_ready(const Unit&) const {}
    __device__ __forceinline__ void done(const Unit&) const {}
};

template <class Epi, class Sched, bool ALIGN_EPI = false, bool SP2 = false>
__device__ __forceinline__ void gemm_phase(PG8_LAS unsigned char* lds, const Gemm g, const Sched& S, const Epi& E) {
    const int tid = threadIdx.x, wid = __builtin_amdgcn_readfirstlane(tid >> 6), lane = tid & 63, wr = wid >> 2, wc = wid & 3, fr = lane & 15, fq = lane >> 4;
    const int K = g.K, nt = K / BK;
    unsigned voffA[2], voffB[2];
#pragma unroll
    for (int i = 0; i < 2; ++i) { int R, C; stage_rc(tid * 16 + i * 8192, R, C); const int Rb = Epi::PERM ? ((R & ~31) + perm32(R & 31)) : R;
        voffA[i] = (unsigned)(R * K + C) * 2u; voffB[i] = (unsigned)(Rb * K + C) * 2u; }
    const size_t kstep = (size_t)(BK * 2);
    const size_t hstep = (size_t)HALF * K * 2;
    const size_t tstep = 2 * hstep;
    const unsigned ldsw = (unsigned)wid * 1024u;
    const int aoff = lds_byte(wr * 64 + fr, fq * 8), boff = lds_byte(wc * 32 + fr, fq * 8);
#define PG8_SA(b, h) (((b) * 2 + (h)) * HTB)
#define PG8_SB(b, h) ((4 + (b) * 2 + (h)) * HTB)
#define PG8_STAGE(bufoff, gbase, voff) do { _Pragma("unroll") for (int _i = 0; _i < 2; ++_i) \
        __builtin_amdgcn_global_load_lds((const unsigned*)((const char*)(gbase) + (voff)[_i]), (PG8_LAS unsigned*)(lds + (bufoff) + ldsw + _i * 8192), 16, 0, 0); } while (0)
#define PG8_LDA(dst, b, h) do { _Pragma("unroll") for (int m = 0; m < 4; ++m) _Pragma("unroll") for (int k = 0; k < 2; ++k) dst[m][k] = *(const PG8_LAS bf16x8*)(lds + PG8_SA(b, h) + aoff + m * 2048 + k * 1024); } while (0)
#define PG8_LDB(dst, b, h) do { _Pragma("unroll") for (int n = 0; n < 2; ++n) _Pragma("unroll") for (int k = 0; k < 2; ++k) dst[n][k] = *(const PG8_LAS bf16x8*)(lds + PG8_SB(b, h) + boff + n * 2048 + k * 1024); } while (0)
#define PG8_MMA(ai, bj, At, Bt) do { __builtin_amdgcn_s_setprio(1); _Pragma("unroll") for (int m = 0; m < 4; ++m) _Pragma("unroll") for (int n = 0; n < 2; ++n) _Pragma("unroll") for (int k = 0; k < 2; ++k) \
        acc[ai][bj][m][n] = __builtin_amdgcn_mfma_f32_16x16x32_bf16(Bt[n][k], At[m][k], acc[ai][bj][m][n], 0, 0, 0); __builtin_amdgcn_s_setprio(0); } while (0)
#define PG8_WAIT_V(n) asm volatile("s_waitcnt vmcnt(" #n ")" ::: "memory")
#define PG8_WAIT_L(n) asm volatile("s_waitcnt lgkmcnt(" #n ")" ::: "memory")
#define PG8_BAR __builtin_amdgcn_s_barrier()
#define PG8_SCHED __builtin_amdgcn_sched_barrier(0)
    Unit cur, nxt; int ui = 0;
    if (!S.next(0, cur)) return;
    f32x4 acc[2][2][4][2];
#pragma unroll
    for (int a = 0; a < 2; ++a)
#pragma unroll
        for (int b = 0; b < 2; ++b)
#pragma unroll
            for (int m = 0; m < 4; ++m)
#pragma unroll
                for (int n = 0; n < 2; ++n) acc[a][b][m][n] = (f32x4){0.f, 0.f, 0.f, 0.f};
    bf16x8 At[4][2], B0[2][2], B1[2][2];
    const char* cA = (const char*)(cur.z ? g.A2 : g.A) + (size_t)cur.pm * tstep; const char* cB = (const char*)(cur.z ? g.Bt2 : g.Bt) + (size_t)cur.pn * tstep;
    S.a_ready(cur);
    if constexpr (SP2) {
        PG8_STAGE(PG8_SB(0, 0), cB, voffB); PG8_STAGE(PG8_SB(0, 1), cB + hstep, voffB); PG8_STAGE(PG8_SA(0, 0), cA, voffA); PG8_STAGE(PG8_SA(0, 1), cA + hstep, voffA);
        if (wr == 1) PG8_BAR;
        PG8_WAIT_V(2); PG8_BAR;
        PG8_STAGE(PG8_SB(1, 0), cB + kstep, voffB); PG8_STAGE(PG8_SA(1, 0), cA + kstep, voffA); PG8_STAGE(PG8_SB(1, 1), cB + hstep + kstep, voffB);
        PG8_WAIT_V(6); PG8_BAR;
    } else {
        PG8_STAGE(PG8_SB(0, 0), cB, voffB); PG8_STAGE(PG8_SA(0, 0), cA, voffA); PG8_STAGE(PG8_SB(0, 1), cB + hstep, voffB); PG8_STAGE(PG8_SA(0, 1), cA + hstep, voffA);
        if (wr == 1) PG8_BAR;
        PG8_WAIT_V(4); PG8_BAR;
        PG8_STAGE(PG8_SB(1, 0), cB + kstep, voffB); PG8_STAGE(PG8_SA(1, 0), cA + kstep, voffA); PG8_STAGE(PG8_SB(1, 1), cB + hstep + kstep, voffB);
        PG8_WAIT_V(6); PG8_BAR;
    }
    for (;;) {
        const bool has_next = S.next(ui + 1, nxt);
        const char* nA = has_next ? (const char*)(nxt.z ? g.A2 : g.A) + (size_t)nxt.pm * tstep : cA; const char* nB = has_next ? (const char*)(nxt.z ? g.Bt2 : g.Bt) + (size_t)nxt.pn * tstep : cB;
        for (int t = 0; t < nt; t += 2) {
            const bool last = (t == nt - 2);
            const char* a1 = cA + (size_t)(t + 1) * kstep;
            const char* a2 = last ? nA : cA + (size_t)(t + 2) * kstep; const char* b2 = last ? nB : cB + (size_t)(t + 2) * kstep;
            const char* a3 = a2 + kstep; const char* b3 = b2 + kstep;
            if (last && has_next) S.a_ready(nxt);
            if constexpr (SP2) {
            PG8_LDB(B0, 0, 0); PG8_LDB(B1, 0, 1); PG8_SCHED; PG8_LDA(At, 0, 0); PG8_STAGE(PG8_SA(1, 1), a1 + hstep, voffA);
            PG8_WAIT_V(8); PG8_WAIT_L(0); PG8_BAR; PG8_MMA(0, 0, At, B0); PG8_MMA(0, 1, At, B1); PG8_BAR; PG8_SCHED;
            PG8_LDA(At, 0, 1); PG8_STAGE(PG8_SB(0, 0), b2, voffB); PG8_STAGE(PG8_SB(0, 1), b2 + hstep, voffB); PG8_STAGE(PG8_SA(0, 0), a2, voffA);
            PG8_WAIT_V(8); PG8_WAIT_L(0); PG8_BAR; PG8_MMA(1, 0, At, B0); PG8_MMA(1, 1, At, B1); PG8_BAR; PG8_SCHED;
            PG8_LDB(B0, 1, 0); PG8_LDB(B1, 1, 1); PG8_SCHED; PG8_LDA(At, 1, 0); PG8_STAGE(PG8_SA(0, 1), a2 + hstep, voffA);
            PG8_WAIT_V(8); PG8_WAIT_L(0); PG8_BAR; PG8_MMA(0, 0, At, B0); PG8_MMA(0, 1, At, B1); PG8_BAR; PG8_SCHED;
            PG8_LDA(At, 1, 1); PG8_STAGE(PG8_SB(1, 0), b3, voffB); PG8_STAGE(PG8_SB(1, 1), b3 + hstep, voffB); PG8_STAGE(PG8_SA(1, 0), a3, voffA);
            PG8_WAIT_V(8); PG8_WAIT_L(0); PG8_BAR; PG8_MMA(1, 0, At, B0); PG8_MMA(1, 1, At, B1); PG8_BAR; PG8_SCHED;
            } else {
            PG8_LDB(B0, 0, 0); PG8_SCHED; PG8_LDA(At, 0, 0); PG8_STAGE(PG8_SA(1, 1), a1 + hstep, voffA);
            PG8_WAIT_L(8); PG8_BAR; PG8_WAIT_L(0); PG8_MMA(0, 0, At, B0); PG8_BAR; PG8_SCHED;
            PG8_LDB(B1, 0, 1); PG8_STAGE(PG8_SB(0, 0), b2, voffB);
            PG8_BAR; PG8_WAIT_L(0); PG8_MMA(0, 1, At, B1); PG8_BAR;
            PG8_LDA(At, 0, 1); PG8_STAGE(PG8_SA(0, 0), a2, voffA);
            PG8_BAR; PG8_WAIT_L(0); PG8_MMA(1, 0, At, B0); PG8_BAR; PG8_SCHED;
            PG8_STAGE(PG8_SB(0, 1), b2 + hstep, voffB);
            PG8_WAIT_V(6); PG8_BAR; PG8_MMA(1, 1, At, B1); PG8_BAR;
            PG8_LDB(B0, 1, 0); PG8_SCHED; PG8_LDA(At, 1, 0); PG8_STAGE(PG8_SA(0, 1), a2 + hstep, voffA);
            PG8_WAIT_L(8); PG8_BAR; PG8_WAIT_L(0); PG8_MMA(0, 0, At, B0); PG8_BAR; PG8_SCHED;
            PG8_LDB(B1, 1, 1); PG8_STAGE(PG8_SB(1, 0), b3, voffB);
            PG8_BAR; PG8_WAIT_L(0); PG8_MMA(0, 1, At, B1); PG8_BAR;
            PG8_LDA(At, 1, 1); PG8_STAGE(PG8_SA(1, 0), a3, voffA);
            PG8_BAR; PG8_WAIT_L(0); PG8_MMA(1, 0, At, B0); PG8_BAR; PG8_SCHED;
            PG8_STAGE(PG8_SB(1, 1), b3 + hstep, voffB);
            PG8_WAIT_V(6); PG8_BAR; PG8_MMA(1, 1, At, B1); PG8_BAR;
            }
        }
        if constexpr (ALIGN_EPI) { if (wr == 0) PG8_BAR; }
        if constexpr (!Epi::AFTER_DRAIN) { E(acc, cur, wr, wc, fr, fq); S.done(cur); }
        if (!has_next) break;
        if (!(Epi::KEEP_ACC && cur.z == 0)) {
#pragma unroll
        for (int a = 0; a < 2; ++a)
#pragma unroll
            for (int b = 0; b < 2; ++b)
#pragma unroll
                for (int m = 0; m < 4; ++m)
#pragma unroll
                    for (int n = 0; n < 2; ++n) acc[a][b][m][n] = (f32x4){0.f, 0.f, 0.f, 0.f};
        }
        cur = nxt; cA = nA; cB = nB; ++ui;
        if constexpr (ALIGN_EPI) { if (wr == 1) PG8_BAR; }
    }
    PG8_WAIT_V(0);
    if constexpr (!ALIGN_EPI) { if (wr == 0) PG8_BAR; }
    PG8_BAR;
    if constexpr (Epi::AFTER_DRAIN) { E.fused(acc, cur, wr, wc, fr, fq, lds, wid, lane); S.done(cur); }
#undef PG8_SA
#undef PG8_SB
#undef PG8_STAGE
#undef PG8_LDA
#undef PG8_LDB
#undef PG8_MMA
#undef PG8_WAIT_V
#undef PG8_WAIT_L
#undef PG8_BAR
#undef PG8_SCHED
}
}

constexpr size_t MiB = 1u << 20;
constexpr size_t WS_CTL = 0, CTL_ZERO_BYTES = 1 * MiB;
constexpr size_t WS_WIN = 2 * MiB, WS_WPA = 13 * MiB, WS_WPB = 14 * MiB, WS_WOUT = 15 * MiB, WS_WGU = 17 * MiB, WS_WDN = 28 * MiB;
constexpr size_t WS_LORA = 28 * MiB + (size_t)DM * FF * 2;
static_assert(WS_LORA + 262144 <= 34 * MiB, "lora map");
constexpr size_t WS_XB = 34 * MiB, WS_RS0 = 67 * MiB, WS_QB = 68 * MiB, WS_KB = 85 * MiB, WS_VB = 102 * MiB, WS_PC = 119 * MiB, WS_GT = 176 * MiB;
constexpr size_t WS_ON = 241 * MiB, WS_RW = 258 * MiB, WS_MG = 275 * MiB, WS_TMP = 308 * MiB, WS_X1B = 373 * MiB, WS_HB = 406 * MiB;
constexpr size_t WS_RK = 496 * MiB, RK_STRIDE = 33 * MiB;
constexpr size_t WS_BON = 728 * MiB, WS_DP = 729 * MiB;
constexpr size_t WS_BON3 = 736 * MiB, WS_Y0 = 740 * MiB, WS_CC = 773 * MiB, WS_PSI = 806 * MiB, WS_PHI = 810 * MiB, WS_SST = 814 * MiB, WS_DP2 = 818 * MiB;
constexpr size_t WS_SC = 830 * MiB, WS_RH = 912 * MiB, WS_GP = 928 * MiB, WS_XC = 944 * MiB, WS_YL = 960 * MiB, WS_SL = 992 * MiB, WS_GC = 1024 * MiB, WS_HT = 1025 * MiB, WS_END = 1026 * MiB;
static_assert(WS_WIN + (size_t)INW * DM * 2 <= WS_WPA && WS_WGU + (size_t)NGU * DM * 2 <= WS_WDN && WS_WDN + (size_t)DM * FF * 2 <= WS_XB, "weights map");
static_assert(WS_XB + (size_t)MTOT * DM * 2 <= WS_RS0 && WS_QB + (size_t)MTOT * 512 * 2 <= WS_KB && WS_PC + (size_t)MTOT * RSW * 2 <= WS_GT && WS_GT + (size_t)MTOT * 2048 * 2 <= WS_ON, "act map 1");
static_assert(WS_MG + (size_t)MTOT * DM * 2 <= WS_TMP && WS_TMP + (size_t)MTOT * DM * 4 <= WS_X1B && WS_X1B + (size_t)MTOT * DM * 2 <= WS_HB && WS_HB + (size_t)MTOT * FF * 2 <= WS_RK, "act map 2");
static_assert((size_t)MTOT * 512 * 4 <= RK_STRIDE && WS_RK + 7 * RK_STRIDE <= WS_BON, "rwkv map");
constexpr int CW_TMO = 0, CW_CODE = 1;
constexpr int CW_BAR = 4096;
constexpr int CW_SSQ = 32768;
constexpr int CW_QUEUE = 2048;
constexpr int CW_QDEC = 2112;
constexpr int CW_DCNT = 65536;
static_assert((CW_DCNT + 128 * 64) * 4 <= (int)CTL_ZERO_BYTES, "CTL map");

constexpr int RING_OFF = 0, RING_BYTES = 139264;
constexpr int LDSCTL_OFF = RING_BYTES, MISC_OFF = LDSCTL_OFF + 320;
constexpr int LDS_BYTES = 155648;
constexpr int NWAVES = 8;

#define GAS __attribute__((address_space(1)))
#define LAS __attribute__((address_space(3)))
typedef unsigned short bf16;
typedef unsigned v4u __attribute__((ext_vector_type(4)));
typedef unsigned v2u __attribute__((ext_vector_type(2)));
typedef float f32x4 __attribute__((ext_vector_type(4)));
typedef float f32x2 __attribute__((ext_vector_type(2)));
typedef float f32x16 __attribute__((ext_vector_type(16)));
typedef short bf16x8 __attribute__((ext_vector_type(8)));
typedef short s16x4 __attribute__((ext_vector_type(4)));
typedef GAS unsigned gu32;
#define RLX_AGENT __ATOMIC_RELAXED, __HIP_MEMORY_SCOPE_AGENT
#define LDS_WAIT() asm volatile("s_waitcnt lgkmcnt(0)" ::: "memory")
#define VM_WAIT() asm volatile("s_waitcnt vmcnt(0)" ::: "memory")
__device__ __forceinline__ unsigned pk2(float lo, float hi) { return pg8::cvt_pk_bf16(lo, hi); }
using pg8::sigmoidf_;
__device__ __forceinline__ float bf2f(unsigned short b) { return __builtin_bit_cast(float, (unsigned)b << 16); }
__device__ __forceinline__ float bflo(unsigned w) { return __builtin_bit_cast(float, w << 16); }
__device__ __forceinline__ float bfhi(unsigned w) { return __builtin_bit_cast(float, w & 0xffff0000u); }

#define XB_TMO      128
#define XB_XCNT(j)  (256  + 64 * (j))
#define XB_XSUB(j)  (1280 + 64 * (j))
#define XB_XGEN(j)  (2304 + 64 * (j))
#define XB_TOP      3328
#define XB_TOPGEN   3392
#define XCD_BAR_WORDS 3456
#define XB_SPIN_CAP (1u << 18)

__device__ __forceinline__ unsigned xb_ld(unsigned* p)              { return __hip_atomic_load(p, __ATOMIC_RELAXED, __HIP_MEMORY_SCOPE_AGENT); }
__device__ __forceinline__ unsigned xb_add(unsigned* p, unsigned v) { return __hip_atomic_fetch_add(p, v, __ATOMIC_RELAXED, __HIP_MEMORY_SCOPE_AGENT); }
__device__ __forceinline__ unsigned xb_xcc_id() { return (unsigned)__builtin_amdgcn_s_getreg((3 << 11) | 20) & 0xFu; }
#define XB_SPIN(cond, bar) do { unsigned _sp = 0; while (cond) { __builtin_amdgcn_s_sleep(1); \
    if ((++_sp & 255u) == 0u) { if (xb_ld(&(bar)[XB_TMO])) break; if (_sp > XB_SPIN_CAP) { atomicAdd(&(bar)[XB_TMO], 1u); break; } } } } while (0)

struct XcdBarrier {
    unsigned* bar; unsigned x;
    volatile LAS unsigned* st;
};

__device__ __forceinline__ XcdBarrier xcd_barrier_post(unsigned* bar, volatile LAS unsigned* st) {
    XcdBarrier b; b.bar = bar; b.x = xb_xcc_id(); b.st = st;
    if (threadIdx.x == 0) (void)xb_add(&bar[XB_XCNT(b.x)], 1u);
    return b;
}
__device__ __forceinline__ void xcd_barrier_complete(unsigned* bar, unsigned x, unsigned& nloc, unsigned& nx) {
    const unsigned G = gridDim.x * gridDim.y * gridDim.z;
    unsigned sum, cnt, mine, sp = 0u;
    for (;;) {
        sum = 0u; cnt = 0u; mine = 0u;
#pragma unroll
        for (unsigned j = 0; j < 16; ++j) { const unsigned c = xb_ld(&bar[XB_XCNT(j)]); sum += c; cnt += (c > 0u) ? 1u : 0u; mine = (j == x) ? c : mine; }
        if (sum == G) break;
        __builtin_amdgcn_s_sleep(1);
        if ((++sp & 255u) == 0u) { if (xb_ld(&bar[XB_TMO])) break; if (sp > XB_SPIN_CAP) { atomicAdd(&bar[XB_TMO], 1u); break; } }
    }
    nloc = mine > 0u ? mine : 1u; nx = cnt > 0u ? cnt : 1u;
}

__device__ __forceinline__ void xcd_barrier(const XcdBarrier& b) {
    asm volatile("s_waitcnt vmcnt(0)" ::: "memory");
    __syncthreads();
    if (threadIdx.x == 0) {
        unsigned* bar = b.bar;
        __builtin_amdgcn_s_waitcnt(0);
        unsigned nloc = b.st[0], nx = b.st[1];
        if (nloc == 0u) { xcd_barrier_complete(bar, b.x, nloc, nx); b.st[0] = nloc; b.st[1] = nx; }
        const unsigned old = xb_add(&bar[XB_XSUB(b.x)], 1u);
        const unsigned gen = old / nloc;
        if (old + 1u == (gen + 1u) * nloc) {
            __builtin_amdgcn_fence(__ATOMIC_RELEASE, "agent");
            asm volatile("s_waitcnt vmcnt(0)" ::: "memory");
            const unsigned og = xb_add(&bar[XB_TOP], 1u);
            const unsigned tg = og / nx;
            if (og + 1u == (tg + 1u) * nx) xb_add(&bar[XB_TOPGEN], 1u);
            else XB_SPIN(xb_ld(&bar[XB_TOPGEN]) == tg, bar);
            __builtin_amdgcn_fence(__ATOMIC_ACQUIRE, "agent");
            xb_add(&bar[XB_XGEN(b.x)], 1u);
            asm volatile("s_waitcnt vmcnt(0)" ::: "memory");
        } else {
            XB_SPIN(xb_ld(&bar[XB_XGEN(b.x)]) == gen, bar);
            __builtin_amdgcn_fence(__ATOMIC_ACQUIRE, "agent");
            asm volatile("s_waitcnt vmcnt(0)" ::: "memory");
        }
    }
    __syncthreads();
}

struct Args { const float* in[34]; float* out; unsigned char* ws; int ph_lo, ph_hi, li, pad; };
struct Frame {
    LAS unsigned char* lds;
    volatile LAS unsigned* MISC;
    gu32* ctl;
    int tid, lane, wave, vcu, G;
    unsigned char* ws; float* out;
#ifdef MK_SUB
    unsigned long long pa, pb;
#endif
};
#ifdef MK_SUB
#define SUBM(k) do { if (MK_SUB == (k)) F.pa = __builtin_amdgcn_s_memrealtime(); if (MK_SUB + 1 == (k)) F.pb = __builtin_amdgcn_s_memrealtime(); } while (0)
#else
#define SUBM(k) do { } while (0)
#endif
enum { I_XP = 0, I_XS, I_CK, I_CV, I_PT, I_SWKV, I_SSH, I_NMIX, I_WIN, I_QG, I_KG, I_LQ1, I_LK1, I_LQ2, I_LK2, I_AOG, I_WPA, I_MU, I_W0, I_W2, I_A0, I_A2, I_G2,
       I_KK, I_KA, I_RK, I_GNW, I_GNB, I_WPB, I_WOUT, I_NFFN, I_WG, I_WU, I_WD };

__device__ __forceinline__ float wave_sum(float v) {
#pragma unroll
    for (int o = 1; o < 64; o <<= 1) v += __shfl_xor(v, o);
    return v;
}

__device__ __forceinline__ float dpp_rmir(float v) { return __builtin_bit_cast(float, __builtin_amdgcn_update_dpp(0, __builtin_bit_cast(int, v), 0x140, 0xF, 0xF, true)); }
__device__ __forceinline__ float sum32(float v) {
    v += __builtin_bit_cast(float, __builtin_amdgcn_update_dpp(0, __builtin_bit_cast(int, v), 0xB1, 0xF, 0xF, true));
    v += __builtin_bit_cast(float, __builtin_amdgcn_update_dpp(0, __builtin_bit_cast(int, v), 0x4E, 0xF, 0xF, true));
    v += __builtin_bit_cast(float, __builtin_amdgcn_update_dpp(0, __builtin_bit_cast(int, v), 0x141, 0xF, 0xF, true));
    v += dpp_rmir(v);
    v += __shfl_xor(v, 16);
    return v;
}
__device__ __forceinline__ void p0_transpose_item(const float* W, int K, int N, bf16* WT, int drow0, const float* kgain, LAS float* scr, int k0, int n0, int lane) {
    float v[32];
    const float* wp = W + (size_t)(k0 + (lane >> 5)) * N + n0 + (lane & 31);
#pragma unroll
    for (int i = 0; i < 32; ++i) v[i] = wp[(size_t)(2 * i) * N];
    const int c = lane & 7;
    f32x4 g0 = {1.f, 1.f, 1.f, 1.f}, g1 = g0;
    if (kgain) { g0 = *(const f32x4*)(kgain + k0 + 8 * c); g1 = *(const f32x4*)(kgain + k0 + 8 * c + 4); }
#pragma unroll
    for (int i = 0; i < 32; ++i) scr[(2 * i + (lane >> 5)) * 33 + (lane & 31)] = v[i];
    LDS_WAIT(); asm volatile("" ::: "memory");
#pragma unroll
    for (int j = 0; j < 4; ++j) { const int n = (lane >> 3) + 8 * j; const LAS float* s = scr + (8 * c) * 33 + n;
        v4u o; o.x = pk2(s[0 * 33] * g0[0], s[1 * 33] * g0[1]); o.y = pk2(s[2 * 33] * g0[2], s[3 * 33] * g0[3]); o.z = pk2(s[4 * 33] * g1[0], s[5 * 33] * g1[1]); o.w = pk2(s[6 * 33] * g1[2], s[7 * 33] * g1[3]);
        *(GAS v4u*)(WT + (size_t)(drow0 + n) * K + k0 + 8 * c) = o; }
    LDS_WAIT(); asm volatile("" ::: "memory");
}
template <int PART> __device__ __forceinline__ void p0_prologue(Frame& F, const Args& A, int gw, int NGW) {
    LAS float* scr = (LAS float*)(F.lds + RING_OFF + F.wave * 16384);
    bf16* Win_t = (bf16*)(F.ws + WS_WIN); bf16* Wpa_t = (bf16*)(F.ws + WS_WPA); bf16* Wpb_t = (bf16*)(F.ws + WS_WPB); bf16* Wout_t = (bf16*)(F.ws + WS_WOUT);
    bf16* Wgu_t = (bf16*)(F.ws + WS_WGU); bf16* Wdn_t = (bf16*)(F.ws + WS_WDN);
    constexpr int I_IN = (DM / 64) * (INW / 32), I_PA = (512 / 64) * (DM / 32), I_OUT = (DM / 64) * (DM / 32), I_G = (DM / 64) * (FF / 32), I_D = (FF / 64) * (DM / 32);
    constexpr int I_L = 16, NITEMS = I_IN + 2 * I_PA + I_OUT + 2 * I_G + I_D + 4 * I_L;
    constexpr int NP0 = I_IN + 4 * I_L, NP1 = NITEMS - NP0;
    for (int ix = gw; ix < (PART == 0 ? NP0 : NP1); ix += NGW) {
        int r = PART == 0 ? (ix < I_IN ? ix : ix - I_IN + (NITEMS - 4 * I_L)) : ix + I_IN;
        if (r < I_IN) { constexpr int nnb = INW / 32; const int kb = r / nnb, nb = r % nnb, pn = nb >> 3, q = nb & 7;
            p0_transpose_item(A.in[I_WIN], DM, INW, Win_t, 256 * pn + 32 * (4 * (q & 1) + (q >> 1)), A.in[I_NMIX], scr, 64 * kb, 32 * nb, F.lane); continue; } r -= I_IN;
        if (r < I_PA) { constexpr int nnb = DM / 32; const int kb = r / nnb, nb = r % nnb; p0_transpose_item(A.in[I_WPA], 512, DM, Wpa_t, 32 * nb, nullptr, scr, 64 * kb, 32 * nb, F.lane); continue; } r -= I_PA;
        if (r < I_PA) { constexpr int nnb = DM / 32; const int kb = r / nnb, nb = r % nnb; p0_transpose_item(A.in[I_WPB], 512, DM, Wpb_t, 32 * nb, nullptr, scr, 64 * kb, 32 * nb, F.lane); continue; } r -= I_PA;
        if (r < I_OUT) { constexpr int nnb = DM / 32; const int kb = r / nnb, nb = r % nnb; p0_transpose_item(A.in[I_WOUT], DM, DM, Wout_t, 32 * nb, nullptr, scr, 64 * kb, 32 * nb, F.lane); continue; } r -= I_OUT;
        if (r < I_G) { constexpr int nnb = FF / 32; const int kb = r / nnb, nb = r % nnb;
            p0_transpose_item(A.in[I_WG], DM, FF, Wgu_t, 256 * (nb >> 2) + 32 * (nb & 3), A.in[I_NFFN], scr, 64 * kb, 32 * nb, F.lane); continue; } r -= I_G;
        if (r < I_G) { constexpr int nnb = FF / 32; const int kb = r / nnb, nb = r % nnb;
            p0_transpose_item(A.in[I_WU], DM, FF, Wgu_t, 256 * (nb >> 2) + 128 + 32 * (nb & 3), A.in[I_NFFN], scr, 64 * kb, 32 * nb, F.lane); continue; } r -= I_G;
        if (r < I_D) { constexpr int nnb = DM / 32; const int kb = r / nnb, nb = r % nnb; p0_transpose_item(A.in[I_WD], FF, DM, Wdn_t, 32 * nb, nullptr, scr, 64 * kb, 32 * nb, F.lane); continue; } r -= I_D;
        { bf16* W2T = (bf16*)(F.ws + WS_LORA); bf16* A2T = W2T + 512 * 64; bf16* G2T = A2T + 512 * 64;
          if (r < I_L) p0_transpose_item(A.in[I_W2], 64, 512, W2T, 32 * r, nullptr, scr, 0, 32 * r, F.lane);
          else if (r < 2 * I_L) p0_transpose_item(A.in[I_A2], 64, 512, A2T, 32 * (r - I_L), nullptr, scr, 0, 32 * (r - I_L), F.lane);
          else { const int q = r - 2 * I_L; p0_transpose_item(A.in[I_G2], 128, 512, G2T, 32 * (q & 15), nullptr, scr, 64 * (q >> 4), 32 * (q & 15), F.lane); } }
    }
    if (PART != 0) return;
    bf16* XB = (bf16*)(F.ws + WS_XB); float* rs0 = (float*)(F.ws + WS_RS0);
    for (int m0 = gw; m0 < MTOT; m0 += 4 * NGW) {
        f32x4 v[4][4];
#pragma unroll
        for (int q = 0; q < 4; ++q) { const int m = m0 + q * NGW;
            if (m < MVALID) { const float* xrow = m < MP ? A.in[I_XP] + (size_t)m * DM : A.in[I_XS] + (size_t)(m - MP) * DM; const GAS f32x4* xr = (const GAS f32x4*)xrow + F.lane;
#pragma unroll
                for (int j = 0; j < 4; ++j) v[q][j] = xr[64 * j]; }
            else {
#pragma unroll
                for (int j = 0; j < 4; ++j) v[q][j] = (f32x4){0.f, 0.f, 0.f, 0.f}; } }
#pragma unroll
        for (int q = 0; q < 4; ++q) { const int m = m0 + q * NGW; if (m >= MTOT) continue;
            GAS unsigned long long* o8 = (GAS unsigned long long*)(XB + (size_t)m * DM) + F.lane; float s = 0.f;
#pragma unroll
            for (int j = 0; j < 4; ++j) { s += (v[q][j].x * v[q][j].x + v[q][j].y * v[q][j].y) + (v[q][j].z * v[q][j].z + v[q][j].w * v[q][j].w);
                o8[64 * j] = (unsigned long long)pk2(v[q][j].x, v[q][j].y) | ((unsigned long long)pk2(v[q][j].z, v[q][j].w) << 32); }
            s = sum32(s); { const auto rr = __builtin_amdgcn_permlane32_swap(__float_as_uint(s), __float_as_uint(s), false, false); s = __uint_as_float(rr[0]) + __uint_as_float(rr[1]); }
            if (F.lane == 0) rs0[m] = m < MVALID ? rsqrtf(s * (1.f / DM) + 1e-6f) : 0.f; }
    }
}

__device__ __forceinline__ int crow16(int r, int hi) { return (r & 3) + 8 * (r >> 2) + 4 * hi; }
__device__ __forceinline__ float lam_value(const Frame& F, const Args& A) {
    const int l = F.lane;
    const float a = wave_sum(A.in[I_LQ1][l] * A.in[I_LK1][l]), b = wave_sum(A.in[I_LQ2][l] * A.in[I_LK2][l]);
    return __expf(a) - __expf(b) + 0.2f;
}
__device__ __forceinline__ f32x4 ld_bf4(const bf16* p) { const v2u w = *(const v2u*)p; return (f32x4){bflo(w.x), bfhi(w.x), bflo(w.y), bfhi(w.y)}; }
__device__ __forceinline__ unsigned* rk_pair(const Frame& F, int i) { return (unsigned*)(F.ws + WS_RK + (size_t)i * RK_STRIDE); }
__device__ __forceinline__ bf16* rk_bf(const Frame& F, int i) { return (bf16*)(F.ws + WS_RK + (size_t)i * RK_STRIDE); }
__device__ __forceinline__ float* rk_arr(const Frame& F, int i) { return (float*)(F.ws + WS_RK + (size_t)i * RK_STRIDE); }

#define CRC(r) (((r) & 3) + 8 * ((r) >> 2))
constexpr int LIN_LD = 264, MS_LD = 1544;
__device__ __forceinline__ float tanh_fast(float x) { return 1.f - 2.f * __builtin_amdgcn_rcpf(1.f + __expf(2.f * x)); }
__device__ __forceinline__ void rwkv_prep_unit(Frame& F, const Args& A, int unit) {
    LAS bf16* msl = (LAS bf16*)(F.lds + RING_OFF);
    LAS bf16* lin = msl + 32 * MS_LD;
    const bf16* PC = (const bf16*)(F.ws + WS_PC);
    int r32_ = F.lane & 31, hi_ = F.lane >> 5; asm volatile("" : "+v"(r32_), "+v"(hi_));
    const int r0 = unit * 32, tid = F.tid, lane = F.lane, w = F.wave, r32 = r32_, hi = hi_;
    const float* mu = A.in[I_MU]; const float* ssh = A.in[I_SSH];
    const bool samp = unit >= MP / 32;
#pragma unroll 7
    for (int k = 0; k < 14; ++k) {
        const int p = tid + 512 * k, t = p / 224, c8 = p - 224 * t, row = r0 + t;
        const v4u cw = *(const v4u*)(PC + (size_t)row * RSW + 8 * c8);
        float cur[8] = {bflo(cw.x), bfhi(cw.x), bflo(cw.y), bfhi(cw.y), bflo(cw.z), bfhi(cw.z), bflo(cw.w), bfhi(cw.w)}, prv[8];
        if (samp) { const f32x4 a = *(const f32x4*)(ssh + (size_t)(row - MP) * RSW + 8 * c8), b = *(const f32x4*)(ssh + (size_t)(row - MP) * RSW + 8 * c8 + 4);
#pragma unroll
            for (int j = 0; j < 4; ++j) { prv[j] = a[j]; prv[4 + j] = b[j]; } }
        else { const bool first = (row & (SEQ - 1)) == 0;
            const v4u pw = *(const v4u*)(PC + (size_t)(first ? row : row - 1) * RSW + 8 * c8);
            prv[0] = bflo(pw.x); prv[1] = bfhi(pw.x); prv[2] = bflo(pw.y); prv[3] = bfhi(pw.y); prv[4] = bflo(pw.z); prv[5] = bfhi(pw.z); prv[6] = bflo(pw.w); prv[7] = bfhi(pw.w);
#pragma unroll
            for (int j = 0; j < 8; ++j) prv[j] = first ? 0.f : prv[j]; }
        const f32x4 m0 = *(const f32x4*)(mu + 8 * c8), m1 = *(const f32x4*)(mu + 8 * c8 + 4);
        float m[8];
#pragma unroll
        for (int j = 0; j < 4; ++j) { m[j] = cur[j] + (prv[j] - cur[j]) * m0[j]; m[4 + j] = cur[4 + j] + (prv[4 + j] - cur[4 + j]) * m1[j]; }
        if (c8 >= 192) { const int ci = 8 * (c8 - 192);
#pragma unroll
            for (int j = 0; j < 8; ++j) { if (ci < 64) m[j] = tanh_fast(m[j]); else if (ci >= 128) m[j] = sigmoidf_(m[j]); }
            *(LAS v4u*)(lin + t * LIN_LD + ci) = (v4u){pk2(m[0], m[1]), pk2(m[2], m[3]), pk2(m[4], m[5]), pk2(m[6], m[7])}; }
        else *(LAS v4u*)(msl + t * MS_LD + 8 * c8) = (v4u){pk2(m[0], m[1]), pk2(m[2], m[3]), pk2(m[4], m[5]), pk2(m[6], m[7])};
    }
    __syncthreads();
    f32x16 wl[2], al[2], gg[2];
    const bf16* W2T = (const bf16*)(F.ws + WS_LORA); const bf16* A2T = W2T + 512 * 64; const bf16* G2T = A2T + 512 * 64;
#pragma unroll
    for (int ct = 0; ct < 2; ++ct) {
        const int ch = 64 * w + 2 * r32 + ct;
        f32x16 a0 = (f32x16){}, a1 = (f32x16){}, a2 = (f32x16){};
#pragma unroll
        for (int ks = 0; ks < 4; ++ks) {
            const bf16x8 x0 = *(const LAS bf16x8*)(lin + r32 * LIN_LD + 16 * ks + 8 * hi), x1 = *(const LAS bf16x8*)(lin + r32 * LIN_LD + 64 + 16 * ks + 8 * hi);
            const bf16x8 b0 = *(const bf16x8*)(W2T + (size_t)ch * 64 + 16 * ks + 8 * hi), b1 = *(const bf16x8*)(A2T + (size_t)ch * 64 + 16 * ks + 8 * hi);
            a0 = __builtin_amdgcn_mfma_f32_32x32x16_bf16(x0, b0, a0, 0, 0, 0); a1 = __builtin_amdgcn_mfma_f32_32x32x16_bf16(x1, b1, a1, 0, 0, 0);
        }
#pragma unroll
        for (int ks = 0; ks < 8; ++ks) {
            const bf16x8 x2 = *(const LAS bf16x8*)(lin + r32 * LIN_LD + 128 + 16 * ks + 8 * hi);
            const bf16x8 b2 = *(const bf16x8*)(G2T + (size_t)ch * 128 + 16 * ks + 8 * hi);
            a2 = __builtin_amdgcn_mfma_f32_32x32x16_bf16(x2, b2, a2, 0, 0, 0);
        }
        wl[ct] = a0; al[ct] = a1; gg[ct] = a2;
    }
    bf16* aR = rk_bf(F, 0); float* aW = rk_arr(F, 1); bf16* aK = rk_bf(F, 2); bf16* aV = rk_bf(F, 3); bf16* aA = rk_bf(F, 4); bf16* aB = rk_bf(F, 5); bf16* aG = rk_bf(F, 6);
    float* BON = (float*)(F.ws + WS_BON3);
    float w0c[2], a0c[2], kkc[2], kac[2], rkc[2];
#pragma unroll
    for (int ct = 0; ct < 2; ++ct) { const int ch = 64 * w + 2 * r32 + ct; w0c[ct] = A.in[I_W0][ch]; a0c[ct] = A.in[I_A0][ch]; kkc[ct] = A.in[I_KK][ch]; kac[ct] = A.in[I_KA][ch]; rkc[ct] = A.in[I_RK][ch]; }
    if (unit < MP / 32) {
        float lwv[2][16], pin[2][16], off[2];
        int r32o = r32; asm volatile("" : "+v"(r32o));
#pragma unroll
        for (int ct = 0; ct < 2; ++ct)
#pragma unroll
            for (int r = 0; r < 16; ++r) { const float x = -(w0c[ct] + wl[ct][r]), sp = fmaxf(x, 0.f) + __logf(1.f + __expf(-fabsf(x))); lwv[ct][r] = -__expf(-sp - 0.5f); }
#pragma unroll
        for (int ct = 0; ct < 2; ++ct) { float run = 0.f;
#pragma unroll
            for (int q = 0; q < 4; ++q) { const float c0 = lwv[ct][4 * q], c1 = c0 + lwv[ct][4 * q + 1], c2 = c1 + lwv[ct][4 * q + 2], c3 = c2 + lwv[ct][4 * q + 3];
                const float oth = __shfl_xor(c3, 32), base = run + (hi ? oth : 0.f);
                pin[ct][4 * q] = base + c0; pin[ct][4 * q + 1] = base + c1; pin[ct][4 * q + 2] = base + c2; pin[ct][4 * q + 3] = base + c3; run += c3 + oth; }
            off[ct] = (unit & 1) ? 0.f : run;
            if (hi == 0) ((float*)(F.ws + WS_HT))[(size_t)unit * 512 + 64 * w + 2 * r32o + ct] = __expf(run); }
        bf16* scb = (bf16*)(F.ws + WS_SC) + ((size_t)(((unit >> 7) * 8 + w) * 64 + ((unit >> 1) & 63)) * 5 * 64 + 32 * (unit & 1) + 4 * hi) * 64 + 2 * r32o;
#pragma unroll
        for (int r = 0; r < 16; ++r) {
            const int t = crow16(r, hi), row = r0 + t;
            float rr[2], kv[2], vv[2], kkv[2], av[2], wv[2];
            float ss = 0.f;
#pragma unroll
            for (int ct = 0; ct < 2; ++ct) { const int ch = 64 * w + 2 * r32 + ct;
                rr[ct] = bf2f(msl[t * MS_LD + ch]); kv[ct] = bf2f(msl[t * MS_LD + 512 + ch]); vv[ct] = bf2f(msl[t * MS_LD + 1024 + ch]);
                wv[ct] = __expf(lwv[ct][r]);
                av[ct] = sigmoidf_(a0c[ct] + al[ct][r]);
                kkv[ct] = kv[ct] * kkc[ct]; ss += kkv[ct] * kkv[ct];
            }
            ss = sum32(ss);
            const float rn = rsqrtf(fmaxf(ss, 1e-24f));
            float bon = 0.f, br = 0.f, kr = 0.f, kk[2], kp[2];
#pragma unroll
            for (int ct = 0; ct < 2; ++ct) { kk[ct] = kkv[ct] * rn; kp[ct] = kv[ct] * (1.f + (av[ct] - 1.f) * kac[ct]);
                bon += rr[ct] * kp[ct] * rkc[ct]; br += kk[ct] * av[ct] * rr[ct]; kr += kp[ct] * rr[ct]; }
            bon = sum32(bon); br = sum32(br); kr = sum32(kr);
            { float Fm[2], Fi[2];
#pragma unroll
              for (int ct = 0; ct < 2; ++ct) { Fm[ct] = __expf(pin[ct][r] - lwv[ct][r] - off[ct]); Fi[ct] = __expf(off[ct] - pin[ct][r]); }
              unsigned* sp_ = (unsigned*)(scb + CRC(r) * 64);
              sp_[0 * 2048] = pk2(-kk[0] * Fm[0], -kk[1] * Fm[1]);
              sp_[1 * 2048] = pk2(kk[0] * av[0] * Fi[0], kk[1] * av[1] * Fi[1]);
              sp_[2 * 2048] = pk2(kp[0] * Fi[0], kp[1] * Fi[1]);
              sp_[3 * 2048] = pk2(wv[0] * rr[0] * Fm[0], wv[1] * rr[1] * Fm[1]);
              sp_[4 * 2048] = pk2(vv[0], vv[1]);
              *(v2u*)(rk_pair(F, 2) + (size_t)row * 512 + 64 * w + 2 * r32o) = (v2u){pk2(vv[0], gg[0][r]), pk2(vv[1], gg[1][r])}; }
            if (r32 == 0) *(f32x4*)(BON + (size_t)(row * 8 + w) * 4) = (f32x4){bon, br, kr, 0.f};
        }
    } else {
#pragma unroll 4
    for (int r = 0; r < 16; ++r) {
        const int t = crow16(r, hi), row = r0 + t;
        float rr[2], kv[2], vv[2], kkv[2], av[2], wv[2];
        float ss = 0.f;
#pragma unroll
        for (int ct = 0; ct < 2; ++ct) { const int ch = 64 * w + 2 * r32 + ct;
            rr[ct] = bf2f(msl[t * MS_LD + ch]); kv[ct] = bf2f(msl[t * MS_LD + 512 + ch]); vv[ct] = bf2f(msl[t * MS_LD + 1024 + ch]);
            const float x = -(w0c[ct] + wl[ct][r]), sp = fmaxf(x, 0.f) + __logf(1.f + __expf(-fabsf(x)));
            const float e = __expf(-sp - 0.5f); wv[ct] = __expf(-e);
            av[ct] = sigmoidf_(a0c[ct] + al[ct][r]);
            kkv[ct] = kv[ct] * kkc[ct]; ss += kkv[ct] * kkv[ct];
        }
        ss = sum32(ss);
        const float rn = rsqrtf(fmaxf(ss, 1e-24f));
        float bon = 0.f, br = 0.f, kr = 0.f, kk[2], kp[2];
#pragma unroll
        for (int ct = 0; ct < 2; ++ct) { kk[ct] = kkv[ct] * rn; kp[ct] = kv[ct] * (1.f + (av[ct] - 1.f) * kac[ct]);
            bon += rr[ct] * kp[ct] * rkc[ct]; br += kk[ct] * av[ct] * rr[ct]; kr += kp[ct] * rr[ct]; }
        bon = sum32(bon); br = sum32(br); kr = sum32(kr);
#pragma unroll
        for (int ct = 0; ct < 2; ++ct) { const size_t o = (size_t)row * 512 + 64 * w + 2 * r32 + ct;
            aW[o] = wv[ct]; rk_pair(F, 0)[o] = pk2(wv[ct] * rr[ct], kp[ct]); rk_pair(F, 2)[o] = pk2(vv[ct], gg[ct][r]); rk_pair(F, 4)[o] = pk2(-kk[ct], kk[ct] * av[ct]); }
        if (r32 == 0) *(f32x4*)(BON + (size_t)(row * 8 + w) * 4) = (f32x4){bon, br, kr, 0.f};
    }
    }
    __syncthreads();
}

constexpr int NSEG = 8, SEGT = SEQ / NSEG;
__device__ __forceinline__ float dpp_xor1(float v) { return __builtin_bit_cast(float, __builtin_amdgcn_update_dpp(0, __builtin_bit_cast(int, v), 0xB1, 0xF, 0xF, true)); }
__device__ __forceinline__ float dpp_xor2(float v) { return __builtin_bit_cast(float, __builtin_amdgcn_update_dpp(0, __builtin_bit_cast(int, v), 0x4E, 0xF, 0xF, true)); }
__device__ __forceinline__ float dpp_hmir(float v) { return __builtin_bit_cast(float, __builtin_amdgcn_update_dpp(0, __builtin_bit_cast(int, v), 0x141, 0xF, 0xF, true)); }
__device__ __forceinline__ float red8(float v) { v += dpp_xor1(v); v += dpp_xor2(v); v += dpp_hmir(v); return v; }
__device__ __forceinline__ void gn_store(Frame& F, const Args& A, int row, int h, int q, f32x4 yv, f32x4 vv) {
    const float* BON = (const float*)(F.ws + WS_BON3); const bf16* aG = rk_bf(F, 6); bf16* RW = (bf16*)(F.ws + WS_RW);
    float s = (yv[0] + yv[1]) + (yv[2] + yv[3]);
    s += __shfl_xor(s, 1); s += __shfl_xor(s, 2); s += __shfl_xor(s, 4); s += __shfl_xor(s, 8);
    const float mean = s * (1.f / 64.f); const f32x4 d = yv - mean;
    float s2 = (d[0] * d[0] + d[1] * d[1]) + (d[2] * d[2] + d[3] * d[3]);
    s2 += __shfl_xor(s2, 1); s2 += __shfl_xor(s2, 2); s2 += __shfl_xor(s2, 4); s2 += __shfl_xor(s2, 8);
    const float rstd = rsqrtf(s2 * (1.f / 64.f) + 64e-5f), bon = BON[(row * 8 + h) * 4];
    const int cbase = h * 64 + 4 * q;
    const f32x4 gw = *(const f32x4*)(A.in[I_GNW] + cbase), gb = *(const f32x4*)(A.in[I_GNB] + cbase), gv = [&]{ const v4u pg = *(const v4u*)(rk_pair(F, 2) + (size_t)row * 512 + cbase); return (f32x4){bfhi(pg.x), bfhi(pg.y), bfhi(pg.z), bfhi(pg.w)}; }();
    const f32x4 o = (d * rstd * gw + gb + bon * vv) * gv;
    v2u w; w.x = pk2(o[0], o[1]); w.y = pk2(o[2], o[3]);
    *(v2u*)(RW + (size_t)row * 512 + cbase) = w;
}
struct ScanIn { f32x4 a0, a1, r0, r1, w0, w1, b0, b1, k0, k1; float vi, br, kr; };
__device__ __forceinline__ void scan_seg_unit(Frame& F, const Args& A, int u) {
    constexpr int TB = 32, VB = 6 * TB * 64 + 2 * TB;
    LAS float* vecs = (LAS float*)(F.lds + RING_OFF);
    LAS float* ybuf = vecs + 2 * VB;
    LAS float* cbuf = ybuf + TB * 64;
    const int tid = F.tid, i = tid >> 3, seg8 = tid & 7;
    const bool prompt = u < 256;
    int h, row0, T; bool useF; f32x2 S[4], Fm[4];
    if (prompt) { h = (u >> 3) & 7; row0 = (u >> 6) * SEQ + (u & 7) * SEGT; T = SEGT; useF = (u & 7) != 0;
#pragma unroll
        for (int c = 0; c < 4; ++c) { S[c] = (f32x2){0.f, 0.f}; Fm[c] = (f32x2){(8 * seg8 + 2 * c == i) ? 1.f : 0.f, (8 * seg8 + 2 * c + 1 == i) ? 1.f : 0.f}; } }
    else { const int su = u - 256; h = su & 7; row0 = MP + (su >> 3); T = 1; useF = false;
        const float* s0 = A.in[I_SWKV] + ((size_t)su * 64 + i) * 64 + 8 * seg8;
        const f32x4 a = *(const f32x4*)s0, b = *(const f32x4*)(s0 + 4);
        S[0] = (f32x2){a[0], a[1]}; S[1] = (f32x2){a[2], a[3]}; S[2] = (f32x2){b[0], b[1]}; S[3] = (f32x2){b[2], b[3]};
#pragma unroll
        for (int c = 0; c < 4; ++c) Fm[c] = (f32x2){0.f, 0.f}; }
    const float* BON = (const float*)(F.ws + WS_BON3);
    float* Y0 = (float*)(F.ws + WS_Y0); float* CC = (float*)(F.ws + WS_CC);
    f32x4 sg[6]; float sgs = 0.f;
    const int st = tid >> 4, sq = tid & 15;
#define SCAN_STAGE_LOAD(t0_) do { const int nb_ = (T - (t0_)) < TB ? (T - (t0_)) : TB; if (st < nb_) { const size_t go_ = (size_t)(row0 + (t0_) + st) * 512 + h * 64 + 4 * sq; \
        sg[1] = *(const f32x4*)(rk_arr(F, 1) + go_); const v4u p0_ = *(const v4u*)(rk_pair(F, 0) + go_), p2_ = *(const v4u*)(rk_pair(F, 2) + go_), p4_ = *(const v4u*)(rk_pair(F, 4) + go_); \
        sg[0] = (f32x4){bflo(p0_.x), bflo(p0_.y), bflo(p0_.z), bflo(p0_.w)}; sg[2] = (f32x4){bfhi(p0_.x), bfhi(p0_.y), bfhi(p0_.z), bfhi(p0_.w)}; sg[3] = (f32x4){bflo(p2_.x), bflo(p2_.y), bflo(p2_.z), bflo(p2_.w)}; \
        sg[4] = (f32x4){bflo(p4_.x), bflo(p4_.y), bflo(p4_.z), bflo(p4_.w)}; sg[5] = (f32x4){bfhi(p4_.x), bfhi(p4_.y), bfhi(p4_.z), bfhi(p4_.w)}; } \
        if (tid < 2 * TB && (tid >> 1) < nb_) sgs = BON[((row0 + (t0_) + (tid >> 1)) * 8 + h) * 4 + 1 + (tid & 1)]; } while (0)
#define SCAN_STAGE_STORE(buf_) do { LAS float* vb_ = vecs + (buf_) * VB; _Pragma("unroll") for (int a_ = 0; a_ < 6; ++a_) *(LAS f32x4*)(vb_ + (a_ * TB + st) * 64 + 4 * sq) = sg[a_]; \
        if (tid < 2 * TB) vb_[6 * TB * 64 + tid] = sgs; } while (0)
    SCAN_STAGE_LOAD(0); SCAN_STAGE_STORE(0);
    __syncthreads();
    int buf = 0;
    for (int t0 = 0; t0 < T; t0 += TB, buf ^= 1) {
        const int nb = (T - t0) < TB ? (T - t0) : TB;
        const bool more = t0 + TB < T;
        if (more) SCAN_STAGE_LOAD(t0 + TB);
        const LAS float* vec = vecs + buf * VB; const LAS float* scl = vec + 6 * TB * 64;
#define SCAN_LOADIN(X, t_) do { const LAS float* p_ = vec + (t_) * 64 + 8 * seg8; \
        X.r0 = *(const LAS f32x4*)(p_); X.r1 = *(const LAS f32x4*)(p_ + 4); X.w0 = *(const LAS f32x4*)(p_ + TB * 64); X.w1 = *(const LAS f32x4*)(p_ + TB * 64 + 4); \
        X.k0 = *(const LAS f32x4*)(p_ + 2 * TB * 64); X.k1 = *(const LAS f32x4*)(p_ + 2 * TB * 64 + 4); X.a0 = *(const LAS f32x4*)(p_ + 4 * TB * 64); X.a1 = *(const LAS f32x4*)(p_ + 4 * TB * 64 + 4); \
        X.b0 = *(const LAS f32x4*)(p_ + 5 * TB * 64); X.b1 = *(const LAS f32x4*)(p_ + 5 * TB * 64 + 4); X.vi = vec[(3 * TB + (t_)) * 64 + i]; X.br = scl[2 * (t_)]; X.kr = scl[2 * (t_) + 1]; } while (0)
#define LO2(v) ((f32x2){(v)[0], (v)[1]})
#define HI2(v) ((f32x2){(v)[2], (v)[3]})
#define SCAN_STEP(X, Y, t_) do { \
        const f32x2 a_[4] = {LO2(X.a0), HI2(X.a0), LO2(X.a1), HI2(X.a1)}, r_[4] = {LO2(X.r0), HI2(X.r0), LO2(X.r1), HI2(X.r1)}; \
        const f32x2 w_[4] = {LO2(X.w0), HI2(X.w0), LO2(X.w1), HI2(X.w1)}, b_[4] = {LO2(X.b0), HI2(X.b0), LO2(X.b1), HI2(X.b1)}, k_[4] = {LO2(X.k0), HI2(X.k0), LO2(X.k1), HI2(X.k1)}; \
        const float br_ = X.br, kr_ = X.kr, vi_ = X.vi; \
        f32x2 d1 = S[0] * a_[0], d2 = S[0] * r_[0], f1 = Fm[0] * a_[0], f2 = Fm[0] * r_[0]; \
        _Pragma("unroll") for (int c = 1; c < 4; ++c) { d1 += S[c] * a_[c]; d2 += S[c] * r_[c]; f1 += Fm[c] * a_[c]; f2 += Fm[c] * r_[c]; } \
        f32x2 tS[4], tF[4]; _Pragma("unroll") for (int c = 0; c < 4; ++c) { tS[c] = S[c] * w_[c] + vi_ * k_[c]; tF[c] = Fm[c] * w_[c]; } \
        { int tn_ = (t_) + 1;     \
          asm volatile("" : "+v"(tn_) : "v"(d1), "v"(d2), "v"(f1), "v"(f2), "v"(tS[0]), "v"(tS[1]), "v"(tS[2]), "v"(tS[3]), "v"(tF[0]), "v"(tF[1]), "v"(tF[2]), "v"(tF[3])); \
          if ((t_) + 1 < nb) SCAN_LOADIN(Y, tn_); } \
        float q0 = d1.x + d1.y, q1 = d2.x + d2.y, q2 = f1.x + f1.y, q3 = f2.x + f2.y; \
        q0 += dpp_xor1(q0); q1 += dpp_xor1(q1); q2 += dpp_xor1(q2); q3 += dpp_xor1(q3); \
        q0 += dpp_xor2(q0); q1 += dpp_xor2(q1); q2 += dpp_xor2(q2); q3 += dpp_xor2(q3); \
        q0 += dpp_hmir(q0); q1 += dpp_hmir(q1); q2 += dpp_hmir(q2); q3 += dpp_hmir(q3); \
        _Pragma("unroll") for (int c = 0; c < 4; ++c) { S[c] = tS[c] + q0 * b_[c]; Fm[c] = tF[c] + q2 * b_[c]; } \
        if (seg8 == 0) { ybuf[(t_) * 64 + i] = q1 + q0 * br_ + vi_ * kr_; cbuf[(t_) * 64 + i] = q3 + q2 * br_; } } while (0)
        ScanIn IA, IB;
        SCAN_LOADIN(IA, 0);
        for (int t = 0; t < nb; t += 2) {
            SCAN_STEP(IA, IB, t);
            if (t + 1 < nb) SCAN_STEP(IB, IA, t + 1);
        }
        if (more) SCAN_STAGE_STORE(buf ^ 1);
        __syncthreads();
        { const int t = tid >> 4, q = tid & 15;
          if (t < nb) { const int row = row0 + t0 + t;
            const f32x4 yv = *(const LAS f32x4*)(ybuf + t * 64 + 4 * q);
            if (prompt) { *(f32x4*)(Y0 + (size_t)row * 512 + h * 64 + 4 * q) = yv; if (useF) *(f32x4*)(CC + (size_t)row * 512 + h * 64 + 4 * q) = *(const LAS f32x4*)(cbuf + t * 64 + 4 * q); }
            else gn_store(F, A, row, h, q, yv, *(const LAS f32x4*)(vec + (3 * TB + t) * 64 + 4 * q)); } }
        __syncthreads();
    }
#undef SCAN_STAGE_LOAD
#undef SCAN_STAGE_STORE
#undef SCAN_LOADIN
#undef SCAN_STEP
#undef LO2
#undef HI2
    const f32x4 s0v = {S[0].x, S[0].y, S[1].x, S[1].y}, s1v = {S[2].x, S[2].y, S[3].x, S[3].y};
    if (prompt) { float* ps = (float*)(F.ws + WS_PSI) + ((size_t)u * 64 + i) * 64 + 8 * seg8; *(f32x4*)ps = s0v; *(f32x4*)(ps + 4) = s1v;
        if (useF) { float* ph = (float*)(F.ws + WS_PHI) + ((size_t)u * 64 + i) * 64 + 8 * seg8; *(f32x4*)ph = (f32x4){Fm[0].x, Fm[0].y, Fm[1].x, Fm[1].y}; *(f32x4*)(ph + 4) = (f32x4){Fm[2].x, Fm[2].y, Fm[3].x, Fm[3].y}; } }
    else { float* so = F.out + O_WS + ((size_t)(u - 256) * 64 + i) * 64 + 8 * seg8; *(f32x4*)so = s0v; *(f32x4*)(so + 4) = s1v; }
    __syncthreads();
}
__device__ __forceinline__ void carry_unit(Frame& F, const Args& A, int bh) {
    LAS float* X = (LAS float*)(F.lds + RING_OFF);
    LAS float* P = X + 4096;
    const int tid = F.tid, i = tid >> 3, seg8 = tid & 7;
    float* SST = (float*)(F.ws + WS_SST); const float* PSI = (const float*)(F.ws + WS_PSI); const float* PHI = (const float*)(F.ws + WS_PHI);
    float cur[8];
#pragma unroll
    for (int c = 0; c < 8; ++c) cur[c] = 0.f;
    for (int k = 0; k < NSEG; ++k) {
        const size_t uo = ((size_t)(bh * NSEG + k) * 64 + i) * 64 + 8 * seg8;
        *(f32x4*)(SST + uo) = (f32x4){cur[0], cur[1], cur[2], cur[3]}; *(f32x4*)(SST + uo + 4) = (f32x4){cur[4], cur[5], cur[6], cur[7]};
        const f32x4 p0 = *(const f32x4*)(PSI + uo), p1 = *(const f32x4*)(PSI + uo + 4);
        float nx[8] = {p0[0], p0[1], p0[2], p0[3], p1[0], p1[1], p1[2], p1[3]};
        if (k > 0) {
            __syncthreads();
            *(LAS f32x4*)(X + i * 64 + 8 * seg8) = (f32x4){cur[0], cur[1], cur[2], cur[3]}; *(LAS f32x4*)(X + i * 64 + 8 * seg8 + 4) = (f32x4){cur[4], cur[5], cur[6], cur[7]};
            *(LAS f32x4*)(P + i * 64 + 8 * seg8) = *(const f32x4*)(PHI + uo); *(LAS f32x4*)(P + i * 64 + 8 * seg8 + 4) = *(const f32x4*)(PHI + uo + 4);
            __syncthreads();
#pragma unroll 4
            for (int l = 0; l < 64; ++l) { const float x = X[i * 64 + l]; const f32x4 q0 = *(const LAS f32x4*)(P + l * 64 + 8 * seg8), q1 = *(const LAS f32x4*)(P + l * 64 + 8 * seg8 + 4);
#pragma unroll
                for (int c = 0; c < 4; ++c) { nx[c] += x * q0[c]; nx[4 + c] += x * q1[c]; } }
        }
#pragma unroll
        for (int c = 0; c < 8; ++c) cur[c] = nx[c];
    }
    float* so = F.out + O_WP + ((size_t)bh * 64 + i) * 64 + 8 * seg8; *(f32x4*)so = (f32x4){cur[0], cur[1], cur[2], cur[3]}; *(f32x4*)(so + 4) = (f32x4){cur[4], cur[5], cur[6], cur[7]};
    __syncthreads();
}
__device__ __forceinline__ void corr_unit(Frame& F, const Args& A, int u) {
    const int lane = F.lane, w = F.wave, r32 = lane & 31, hi = lane >> 5, seg = u & 7, bh = u >> 3, h = bh & 7, rowseg = (bh >> 3) * SEQ + seg * SEGT;
    const float* SST = (const float*)(F.ws + WS_SST) + (size_t)u * 4096; const float* CC = (const float*)(F.ws + WS_CC); const float* Y0 = (const float*)(F.ws + WS_Y0);
    const float* BON = (const float*)(F.ws + WS_BON3); const bf16* aG = rk_bf(F, 6); const bf16* aV = rk_bf(F, 3); bf16* RW = (bf16*)(F.ws + WS_RW);
    bf16x8 sb[2][4];
    if (seg > 0) {
#pragma unroll
        for (int ct = 0; ct < 2; ++ct)
#pragma unroll
            for (int ks = 0; ks < 4; ++ks) { const float* p = SST + (size_t)(32 * ct + r32) * 64 + 16 * ks + 8 * hi; const f32x4 x = *(const f32x4*)p, y = *(const f32x4*)(p + 4);
                const v4u t = {pk2(x[0], x[1]), pk2(x[2], x[3]), pk2(y[0], y[1]), pk2(y[2], y[3])}; sb[ct][ks] = __builtin_bit_cast(bf16x8, t); }
    }
    float gw[2], gb[2];
#pragma unroll
    for (int ct = 0; ct < 2; ++ct) { gw[ct] = A.in[I_GNW][h * 64 + 32 * ct + r32]; gb[ct] = A.in[I_GNB][h * 64 + 32 * ct + r32]; }
    for (int blk = w; blk < SEGT / 32; blk += NWAVES) {
        const int row0 = rowseg + 32 * blk;
        f32x16 d[2]; d[0] = (f32x16){}; d[1] = (f32x16){};
        float yv0[16], yv1[16], bnv[16]; unsigned vgv0[16], vgv1[16];
#pragma unroll
        for (int r = 0; r < 16; ++r) { const int row = row0 + crow16(r, hi); const size_t o = (size_t)row * 512 + h * 64 + r32;
            yv0[r] = Y0[o]; yv1[r] = Y0[o + 32]; vgv0[r] = rk_pair(F, 2)[o]; vgv1[r] = rk_pair(F, 2)[o + 32]; bnv[r] = BON[(row * 8 + h) * 4]; }
        if (seg > 0) {
#pragma unroll
            for (int ks = 0; ks < 4; ++ks) { const float* p = CC + (size_t)(row0 + r32) * 512 + h * 64 + 16 * ks + 8 * hi; const f32x4 x = *(const f32x4*)p, y = *(const f32x4*)(p + 4);
                const v4u t = {pk2(x[0], x[1]), pk2(x[2], x[3]), pk2(y[0], y[1]), pk2(y[2], y[3])}; const bf16x8 cf = __builtin_bit_cast(bf16x8, t);
                d[0] = __builtin_amdgcn_mfma_f32_32x32x16_bf16(cf, sb[0][ks], d[0], 0, 0, 0); d[1] = __builtin_amdgcn_mfma_f32_32x32x16_bf16(cf, sb[1][ks], d[1], 0, 0, 0); }
        }
#pragma unroll
        for (int r = 0; r < 16; ++r) {
            const int row = row0 + crow16(r, hi); const size_t o = (size_t)row * 512 + h * 64 + r32;
            const float y0 = yv0[r] + d[0][r], y1 = yv1[r] + d[1][r];
            const float mean = sum32(y0 + y1) * (1.f / 64.f), e0 = y0 - mean, e1 = y1 - mean;
            const float rstd = rsqrtf(sum32(e0 * e0 + e1 * e1) * (1.f / 64.f) + 64e-5f), bon = bnv[r];
            const unsigned vg0 = vgv0[r], vg1 = vgv1[r];
            const float o0 = (e0 * rstd * gw[0] + gb[0] + bon * bflo(vg0)) * bfhi(vg0), o1 = (e1 * rstd * gw[1] + gb[1] + bon * bflo(vg1)) * bfhi(vg1);
            RW[o] = (bf16)(pk2(o0, 0.f) & 0xffffu); RW[o + 32] = (bf16)(pk2(o1, 0.f) & 0xffffu);
        }
    }
}

typedef short v4i16_t __attribute__((ext_vector_type(4)));
__device__ __forceinline__ s16x4 vtr(const LAS unsigned char* p) { return __builtin_bit_cast(s16x4, __builtin_amdgcn_ds_read_tr16_b64_v4i16((LAS v4i16_t*)p)); }
constexpr int IMG_LD = 136;
constexpr int IMG_BYTES = 64 * IMG_LD;
typedef bf16x8 Frag[2][4];
__device__ __forceinline__ void mm64(const Frag& Af, const Frag& Bf, f32x16 (&D)[2][2]) {
#pragma unroll
    for (int rt = 0; rt < 2; ++rt)
#pragma unroll
        for (int ct = 0; ct < 2; ++ct)
#pragma unroll
            for (int ks = 0; ks < 4; ++ks) D[rt][ct] = __builtin_amdgcn_mfma_f32_32x32x16_bf16(Af[rt][ks], Bf[ct][ks], D[rt][ct], 0, 0, 0);
}
__device__ __forceinline__ void acc_zero(f32x16 (&D)[2][2]) {
#pragma unroll
    for (int a = 0; a < 2; ++a)
#pragma unroll
        for (int b = 0; b < 2; ++b) D[a][b] = (f32x16){};
}
__device__ __forceinline__ void acc_frag(const f32x16 (&X)[2][2], Frag& Fr) {
#pragma unroll
    for (int rt = 0; rt < 2; ++rt)
#pragma unroll
        for (int ct = 0; ct < 2; ++ct)
#pragma unroll
            for (int hf = 0; hf < 2; ++hf) { const int rb = 8 * hf;
                const v4u u = {pk2(X[rt][ct][rb], X[rt][ct][rb + 1]), pk2(X[rt][ct][rb + 2], X[rt][ct][rb + 3]), pk2(X[rt][ct][rb + 4], X[rt][ct][rb + 5]), pk2(X[rt][ct][rb + 6], X[rt][ct][rb + 7])};
                Fr[ct][2 * rt + hf] = __builtin_bit_cast(bf16x8, u); }
}
__device__ __forceinline__ void rowfrag(const LAS unsigned char* img, int lane, Frag& Fr) {
    const int r32 = lane & 31, hi = lane >> 5;
#pragma unroll
    for (int tl = 0; tl < 2; ++tl)
#pragma unroll
        for (int ks = 0; ks < 4; ++ks) Fr[tl][ks] = *(const LAS bf16x8*)(img + (32 * tl + r32) * IMG_LD + (16 * ks + 8 * hi) * 2);
}
__device__ __forceinline__ void rowfrag_perm(const LAS unsigned char* img, int lane, Frag& Fr) {
    const int r32 = lane & 31, hi = lane >> 5;
#pragma unroll
    for (int tl = 0; tl < 2; ++tl)
#pragma unroll
        for (int ks = 0; ks < 4; ++ks) { const LAS unsigned char* p = img + (32 * tl + r32) * IMG_LD + (16 * ks + 4 * hi) * 2;
            const v2u a = *(const LAS v2u*)p, b = *(const LAS v2u*)(p + 16); const v4u u = {a.x, a.y, b.x, b.y}; Fr[tl][ks] = __builtin_bit_cast(bf16x8, u); }
}
__device__ __forceinline__ void colfrag_tr(const LAS unsigned char* img, int lane, Frag& Fr) {
    const int hi = lane >> 5, qq = (lane & 15) >> 2, p4 = lane & 3, cg = (lane >> 4) & 1;
    const LAS unsigned char* base = img + (4 * hi + qq) * IMG_LD + (16 * cg + 4 * p4) * 2;
#pragma unroll
    for (int tl = 0; tl < 2; ++tl)
#pragma unroll
        for (int ks = 0; ks < 4; ++ks) { const LAS unsigned char* p = base + (16 * ks) * IMG_LD + (32 * tl) * 2;
            const s16x4 lo = vtr(p), hh = vtr(p + 8 * IMG_LD); Fr[tl][ks] = (bf16x8){lo[0], lo[1], lo[2], lo[3], hh[0], hh[1], hh[2], hh[3]}; }
}
__device__ __forceinline__ void img_load(const bf16* g, LAS unsigned char* slot, int lane) {
    asm volatile("" ::: "memory");
    const unsigned char* gb = (const unsigned char*)g + (unsigned)(lane * 16);
    LAS unsigned char* sl_ = slot + (lane >> 3) * IMG_LD + (lane & 7) * 16;
#pragma unroll
    for (int hb = 0; hb < 2; ++hb) { v4u t[4];
#pragma unroll
        for (int k = 0; k < 4; ++k) t[k] = *(const v4u*)(gb + 1024 * (4 * hb + k));
#pragma unroll
        for (int k = 0; k < 4; ++k) *(LAS v4u*)(sl_ + (8 * (4 * hb + k)) * IMG_LD) = t[k];
        asm volatile("" ::: "memory"); }
}
__device__ __forceinline__ void acc_to_img(const f32x16 (&X)[2][2], LAS unsigned char* slot, int lane) {
    const int r32 = lane & 31, hi = lane >> 5; LAS unsigned char* lb = slot + (4 * hi) * IMG_LD + r32 * 2;
#pragma unroll
    for (int rt = 0; rt < 2; ++rt)
#pragma unroll
        for (int ct = 0; ct < 2; ++ct)
        { asm volatile("" ::: "memory");
#pragma unroll
            for (int r = 0; r < 16; ++r) *(LAS bf16*)(lb + (32 * rt + CRC(r)) * IMG_LD + (32 * ct) * 2) = (bf16)(pk2(X[rt][ct][r], 0.f) & 0xffffu); }
}
__device__ __forceinline__ void acc_to_gbf(const f32x16 (&X)[2][2], bf16* g, int lane) {
    const int r32 = lane & 31, hi = lane >> 5; bf16* gl = g + (4 * hi) * 64 + r32;
#pragma unroll
    for (int rt = 0; rt < 2; ++rt)
#pragma unroll
        for (int ct = 0; ct < 2; ++ct)
        { asm volatile("" ::: "memory");
#pragma unroll
            for (int r = 0; r < 16; ++r) gl[(32 * rt + CRC(r)) * 64 + 32 * ct] = (bf16)(pk2(X[rt][ct][r], 0.f) & 0xffffu); }
}
__device__ __forceinline__ void acc_to_gf32(const f32x16 (&X)[2][2], float* g, int lane) {
    const int r32 = lane & 31, hi = lane >> 5; float* gl = g + (4 * hi) * 64 + r32;
#pragma unroll
    for (int rt = 0; rt < 2; ++rt)
#pragma unroll
        for (int ct = 0; ct < 2; ++ct)
        { asm volatile("" ::: "memory");
#pragma unroll
            for (int r = 0; r < 16; ++r) gl[(32 * rt + CRC(r)) * 64 + 32 * ct] = X[rt][ct][r]; }
}
template <bool STRICT> __device__ __forceinline__ void mask_upper(f32x16 (&X)[2][2], int lane) {
    const int r32 = lane & 31, hi = lane >> 5, dl = 4 * hi - r32;
#pragma unroll
    for (int rt = 0; rt < 2; ++rt)
#pragma unroll
        for (int ct = 0; ct < 2; ++ct)
#pragma unroll
            for (int r = 0; r < 16; ++r) { const int dlt = dl + (32 * rt + CRC(r) - 32 * ct); const bool keep = STRICT ? (dlt < 0) : (dlt <= 0); if (!keep) X[rt][ct][r] = 0.f; }
}
template <int RT> __device__ __forceinline__ void mm_rt(const Frag& Af, const Frag& Bf, f32x16 (&D)[2]) {
#pragma unroll
    for (int ct = 0; ct < 2; ++ct)
#pragma unroll
        for (int ks = 0; ks < 4; ++ks) D[ct] = __builtin_amdgcn_mfma_f32_32x32x16_bf16(Af[RT][ks], Bf[ct][ks], D[ct], 0, 0, 0);
}
template <int RT> __device__ __forceinline__ void frag_rt(const f32x16 (&D)[2], Frag& Fr) {
#pragma unroll
    for (int ct = 0; ct < 2; ++ct)
#pragma unroll
        for (int hf = 0; hf < 2; ++hf) { const int rb = 8 * hf;
            const v4u u = {pk2(D[ct][rb], D[ct][rb + 1]), pk2(D[ct][rb + 2], D[ct][rb + 3]), pk2(D[ct][rb + 4], D[ct][rb + 5]), pk2(D[ct][rb + 6], D[ct][rb + 7])};
            Fr[ct][2 * RT + hf] = __builtin_bit_cast(bf16x8, u); }
}
template <int RT, bool STRICT> __device__ __forceinline__ void mask_rt(f32x16 (&D)[2], int lane) {
    const int dl = 4 * (lane >> 5) - (lane & 31);
#pragma unroll
    for (int ct = 0; ct < 2; ++ct)
#pragma unroll
        for (int r = 0; r < 16; ++r) { const int dlt = dl + (32 * RT + CRC(r) - 32 * ct); const bool keep = STRICT ? (dlt < 0) : (dlt <= 0); if (!keep) D[ct][r] = 0.f; }
}
template <int RT> __device__ __forceinline__ void st_f32_rt(const f32x16 (&D)[2], float* g, int lane) { float* gl = g + (4 * (lane >> 5)) * 64 + (lane & 31);
#pragma unroll
    for (int ct = 0; ct < 2; ++ct) { asm volatile("" ::: "memory");
#pragma unroll
        for (int r = 0; r < 16; ++r) gl[(32 * RT + CRC(r)) * 64 + 32 * ct] = D[ct][r]; } }
template <int RT> __device__ __forceinline__ void st_bf_rt(const f32x16 (&D)[2], bf16* g, int lane) { bf16* gl = g + (4 * (lane >> 5)) * 64 + (lane & 31);
#pragma unroll
    for (int ct = 0; ct < 2; ++ct) { asm volatile("" ::: "memory");
#pragma unroll
        for (int r = 0; r < 16; ++r) gl[(32 * RT + CRC(r)) * 64 + 32 * ct] = (bf16)(pk2(D[ct][r], 0.f) & 0xffffu); } }
template <int RT> __device__ __forceinline__ void ld_f32_rt(f32x16 (&D)[2], const float* g, int lane) { const float* gl = g + (4 * (lane >> 5)) * 64 + (lane & 31);
#pragma unroll
    for (int ct = 0; ct < 2; ++ct) { asm volatile("" ::: "memory");
#pragma unroll
        for (int r = 0; r < 16; ++r) D[ct][r] = gl[(32 * RT + CRC(r)) * 64 + 32 * ct]; } }
template <int RT> __device__ __forceinline__ void scale_rt(f32x16 (&D)[2], const float* gcl  ) {
#pragma unroll
    for (int ct = 0; ct < 2; ++ct)
#pragma unroll
        for (int r = 0; r < 16; ++r) D[ct][r] *= gcl[32 * RT + CRC(r)]; }
__device__ __forceinline__ void zero2(f32x16 (&D)[2]) { D[0] = (f32x16){}; D[1] = (f32x16){}; }
__device__ __forceinline__ void tfrag(const f32x16& T, bf16x8& f0, bf16x8& f1) {
    const v4u u0 = {pk2(T[0], T[1]), pk2(T[2], T[3]), pk2(T[4], T[5]), pk2(T[6], T[7])}, u1 = {pk2(T[8], T[9]), pk2(T[10], T[11]), pk2(T[12], T[13]), pk2(T[14], T[15])};
    f0 = __builtin_bit_cast(bf16x8, u0); f1 = __builtin_bit_cast(bf16x8, u1);
}
__device__ __forceinline__ void tmm(const bf16x8 (&a)[2], const bf16x8 (&b)[2], f32x16& d) {
    d = __builtin_amdgcn_mfma_f32_32x32x16_bf16(a[0], b[0], d, 0, 0, 0); d = __builtin_amdgcn_mfma_f32_32x32x16_bf16(a[1], b[1], d, 0, 0, 0);
}
__device__ __forceinline__ void tprod(const Frag& A_, int ra, const Frag& B_, int rb, f32x16& d) {
#pragma unroll
    for (int ks = 0; ks < 4; ++ks) d = __builtin_amdgcn_mfma_f32_32x32x16_bf16(A_[ra][ks], B_[rb][ks], d, 0, 0, 0);
}
template <bool WANT_ZT> __device__ __forceinline__ void diag_inv(f32x16& Q, f32x16& QT, f32x16& Z, f32x16& ZT, int lane) {
    const int dl = 4 * (lane >> 5) - (lane & 31);
#pragma unroll
    for (int r = 0; r < 16; ++r) { const int d = dl + CRC(r); Q[r] = d < 0 ? Q[r] : 0.f; QT[r] = d > 0 ? QT[r] : 0.f; const float id = d == 0 ? 1.f : 0.f; Z[r] = Q[r] + id; ZT[r] = QT[r] + id; }
#pragma unroll 1
    for (int lvl = 0; lvl < 4; ++lvl) {
        bf16x8 fq[2], fqt[2], fz[2];
        tfrag(Q, fq[0], fq[1]); tfrag(QT, fqt[0], fqt[1]);
        Q = (f32x16){}; QT = (f32x16){}; tmm(fqt, fq, Q); tmm(fq, fqt, QT);
        tfrag(Q, fq[0], fq[1]); tfrag(QT, fqt[0], fqt[1]);
        tfrag(Z, fz[0], fz[1]); tmm(fqt, fz, Z);
        if (WANT_ZT) { tfrag(ZT, fz[0], fz[1]); tmm(fq, fz, ZT); }
    }
}
constexpr int NCHK = SEQ / 64;
__device__ __forceinline__ void chunk_prescale(Frame& F, int hc) {
    const int lane = F.lane, bh = hc >> 6, c = hc & 63, h = bh & 7, row0 = (bh >> 3) * SEQ + c * 64;
    bf16* sc = (bf16*)(F.ws + WS_SC) + (size_t)hc * 5 * 4096 + lane;
    const size_t o0 = (size_t)row0 * 512 + h * 64 + lane;
    const float* aW = rk_arr(F, 1) + o0; const unsigned* pRK = rk_pair(F, 0) + o0; const unsigned* pVG = rk_pair(F, 2) + o0; const unsigned* pAB = rk_pair(F, 4) + o0;
    float lc = 0.f;
    float wA[16], wB[16]; unsigned rkA[16], rkB[16], vgA[16], vgB[16], abA[16], abB[16];
#define PS_LOAD(S, tb) do { _Pragma("unroll") for (int i = 0; i < 16; ++i) { const int t = 16 * (tb) + i; w##S[i] = aW[t * 512]; rk##S[i] = pRK[t * 512]; vg##S[i] = pVG[t * 512]; ab##S[i] = pAB[t * 512]; } } while (0)
#define PS_COMP(S, tb) do { _Pragma("unroll") for (int i = 0; i < 16; ++i) { const int t = 16 * (tb) + i; \
        const float em = __expf(lc); lc += __logf(w##S[i]); const float ei = __expf(-lc); \
        sc[0 * 4096 + t * 64] = (bf16)(pk2(bflo(ab##S[i]) * em, 0.f) & 0xffffu); \
        sc[1 * 4096 + t * 64] = (bf16)(pk2(bfhi(ab##S[i]) * ei, 0.f) & 0xffffu); \
        sc[2 * 4096 + t * 64] = (bf16)(pk2(bfhi(rk##S[i]) * ei, 0.f) & 0xffffu); \
        sc[3 * 4096 + t * 64] = (bf16)(pk2(bflo(rk##S[i]) * em, 0.f) & 0xffffu); \
        sc[4 * 4096 + t * 64] = (bf16)(vg##S[i] & 0xffffu); } } while (0)
    PS_LOAD(A, 0); PS_LOAD(B, 1);
    PS_COMP(A, 0); asm volatile("" ::: "memory"); PS_LOAD(A, 2);
    PS_COMP(B, 1); asm volatile("" ::: "memory"); PS_LOAD(B, 3);
    PS_COMP(A, 2); PS_COMP(B, 3);
#undef PS_LOAD
#undef PS_COMP
    ((float*)(F.ws + WS_GC))[(size_t)hc * 64 + lane] = __expf(lc);
}
__device__ __forceinline__ void chunk_unit(Frame& F, int hc) {
    const int lane = F.lane, r32 = lane & 31, hi = lane >> 5;
    LAS unsigned char* s0 = F.lds + RING_OFF + F.wave * (2 * IMG_BYTES); LAS unsigned char* s1 = s0 + IMG_BYTES; const LAS unsigned char* s1l = s1 + (4 * hi) * IMG_LD + r32 * 2;
    SUBM(0);
    const float* rho = (const float*)(F.ws + WS_HT) + (size_t)(((hc >> 9) * 64 + (hc & 63)) * 2) * 512 + ((hc >> 6) & 7) * 64; const float* sig = rho + 512;
    ((float*)(F.ws + WS_GC))[(size_t)hc * 64 + lane] = rho[lane] * sig[lane];
    SUBM(1);
    const bf16* sc = (const bf16*)(F.ws + WS_SC) + (size_t)hc * 5 * 4096;
    const bf16* gAb = sc; const bf16* gBb = sc + 4096; const bf16* gKb = sc + 2 * 4096; const bf16* gRb = sc + 3 * 4096; const bf16* gV = sc + 4 * 4096;
    Frag fa, fb, zf, uf, af;
    {
        f32x16 Q, QT, Z, ZT; bf16x8 zt11[2], z22[2], t0[2], t1[2];
        img_load(gAb, s0, lane); img_load(gBb, s1, lane);
        rowfrag(s1, lane, fa); rowfrag(s0, lane, fb);
        Q = (f32x16){}; QT = (f32x16){}; tprod(fa, 0, fb, 0, Q); tprod(fb, 0, fa, 0, QT); diag_inv<true>(Q, QT, Z, ZT, lane);
        tfrag(Z, zf[0][0], zf[0][1]); tfrag(ZT, zt11[0], zt11[1]);
        Q = (f32x16){}; QT = (f32x16){}; tprod(fa, 1, fb, 1, Q); tprod(fb, 1, fa, 1, QT); diag_inv<false>(Q, QT, Z, ZT, lane);
        tfrag(Z, z22[0], z22[1]); zf[1][2] = z22[0]; zf[1][3] = z22[1];
        QT = (f32x16){}; tprod(fb, 1, fa, 0, QT);
        tfrag(QT, t0[0], t0[1]); Q = (f32x16){}; tmm(t0, z22, Q);
        tfrag(Q, t1[0], t1[1]); Z = (f32x16){}; tmm(zt11, t1, Z);
        tfrag(Z, zf[1][0], zf[1][1]);
        zf[0][2] = (bf16x8){}; zf[0][3] = (bf16x8){};
    }
    SUBM(2);
    f32x16 D[2];
    img_load(gKb, s1, lane);
    rowfrag(s1, lane, fa); rowfrag(s0, lane, fb);
    zero2(D); mm_rt<0>(fa, fb, D); mask_rt<0, true>(D, lane); frag_rt<0>(D, uf);
    zero2(D); mm_rt<1>(fa, fb, D); mask_rt<1, true>(D, lane); frag_rt<1>(D, uf);
    img_load(gV, s1, lane); colfrag_tr(s1, lane, fb);
    zero2(D); mm_rt<0>(uf, fb, D); frag_rt<0>(D, fa);
    zero2(D); mm_rt<1>(uf, fb, D); frag_rt<1>(D, fa);
    zero2(D); mm_rt<0>(zf, fa, D); frag_rt<0>(D, uf);
    zero2(D); mm_rt<1>(zf, fa, D); frag_rt<1>(D, uf);
    colfrag_tr(s0, lane, fa);
    zero2(D); mm_rt<0>(zf, fa, D); frag_rt<0>(D, af);
    zero2(D); mm_rt<1>(zf, fa, D); frag_rt<1>(D, af);
    SUBM(3);
    const float* gcg = sig + 4 * hi; const float* rhg = rho + 4 * hi;
    img_load(gKb, s0, lane); colfrag_tr(s0, lane, zf);
    img_load(gBb, s0, lane); colfrag_tr(s0, lane, fa);
    { unsigned char* slfb = F.ws + WS_SL + (size_t)hc * 8192 + lane * 8; unsigned char* gpfb = F.ws + WS_GP + (size_t)hc * 8192 + lane * 16;
      zero2(D); mm_rt<0>(zf, fb, D); mm_rt<0>(fa, uf, D); scale_rt<0>(D, gcg);
#pragma unroll
      for (int ct = 0; ct < 2; ++ct)
#pragma unroll
          for (int q = 0; q < 4; ++q) *(v2u*)(slfb + ((ct * 2 + 0) * 4 + q) * 512) = (v2u){pk2(D[ct][4 * q], D[ct][4 * q + 1]), pk2(D[ct][4 * q + 2], D[ct][4 * q + 3])};
      zero2(D); mm_rt<1>(zf, fb, D); mm_rt<1>(fa, uf, D); scale_rt<1>(D, gcg);
#pragma unroll
      for (int ct = 0; ct < 2; ++ct)
#pragma unroll
          for (int q = 0; q < 4; ++q) *(v2u*)(slfb + ((ct * 2 + 1) * 4 + q) * 512) = (v2u){pk2(D[ct][4 * q], D[ct][4 * q + 1]), pk2(D[ct][4 * q + 2], D[ct][4 * q + 3])};
      const float gc0 = sig[r32], gc1 = sig[32 + r32];
      zero2(D); mm_rt<0>(af, fa, D); D[0] *= gc0; D[1] *= gc1; scale_rt<0>(D, rhg); frag_rt<0>(D, zf);
      zero2(D); mm_rt<1>(af, fa, D); D[0] *= gc0; D[1] *= gc1; scale_rt<1>(D, rhg); frag_rt<1>(D, zf);
#pragma unroll
      for (int tl = 0; tl < 2; ++tl)
#pragma unroll
          for (int ks = 0; ks < 4; ++ks) *(bf16x8*)(gpfb + (tl * 4 + ks) * 1024) = zf[tl][ks]; }
    SUBM(4);
    img_load(gRb, s1, lane);
    rowfrag(s0, lane, fa); rowfrag(s1, lane, fb);
    zero2(D); mm_rt<0>(fa, fb, D); mask_rt<0, false>(D, lane); frag_rt<0>(D, zf);
    zero2(D); mm_rt<1>(fa, fb, D); mask_rt<1, false>(D, lane); frag_rt<1>(D, zf);
    { const LAS unsigned char* s1t = s1 + r32 * IMG_LD + hi * 8;
      unsigned char* rhfb = F.ws + WS_RH + (size_t)hc * 8192 + lane * 16;
#pragma unroll
      for (int ct = 0; ct < 2; ++ct)
#pragma unroll
          for (int q = 0; q < 4; ++q) { const v2u w_ = *(const LAS v2u*)(s1t + (32 * ct) * IMG_LD + (8 * q) * 2);
              D[ct][4 * q] = bflo(w_.x); D[ct][4 * q + 1] = bfhi(w_.x); D[ct][4 * q + 2] = bflo(w_.y); D[ct][4 * q + 3] = bfhi(w_.y); }
      mm_rt<0>(af, zf, D); scale_rt<0>(D, rhg); frag_rt<0>(D, fa);
#pragma unroll
      for (int ct = 0; ct < 2; ++ct)
#pragma unroll
          for (int q = 0; q < 4; ++q) { const v2u w_ = *(const LAS v2u*)(s1t + (32 * ct) * IMG_LD + (32 + 8 * q) * 2);
              D[ct][4 * q] = bflo(w_.x); D[ct][4 * q + 1] = bfhi(w_.x); D[ct][4 * q + 2] = bflo(w_.y); D[ct][4 * q + 3] = bfhi(w_.y); }
      mm_rt<1>(af, zf, D); scale_rt<1>(D, rhg); frag_rt<1>(D, fa);
#pragma unroll
      for (int tl = 0; tl < 2; ++tl)
#pragma unroll
          for (int ks = 0; ks < 4; ++ks) *(bf16x8*)(rhfb + (tl * 4 + ks) * 1024) = fa[tl][ks]; }
    SUBM(5);
    img_load(gKb, s0, lane);
    rowfrag(s0, lane, fa); rowfrag(s1, lane, fb);
    zero2(D); mm_rt<0>(fa, fb, D); mask_rt<0, false>(D, lane); frag_rt<0>(D, af);
    zero2(D); mm_rt<1>(fa, fb, D); mask_rt<1, false>(D, lane); frag_rt<1>(D, af);
    img_load(gV, s1, lane); colfrag_tr(s1, lane, fb);
    { unsigned char* ylfb = F.ws + WS_YL + (size_t)hc * 16384 + lane * 16;
      zero2(D); mm_rt<0>(zf, uf, D); mm_rt<0>(af, fb, D);
#pragma unroll
      for (int ct = 0; ct < 2; ++ct)
#pragma unroll
          for (int q = 0; q < 4; ++q) *(f32x4*)(ylfb + ((0 * 2 + ct) * 4 + q) * 1024) = (f32x4){D[ct][4 * q], D[ct][4 * q + 1], D[ct][4 * q + 2], D[ct][4 * q + 3]};
      zero2(D); mm_rt<1>(zf, uf, D); mm_rt<1>(af, fb, D);
#pragma unroll
      for (int ct = 0; ct < 2; ++ct)
#pragma unroll
          for (int q = 0; q < 4; ++q) *(f32x4*)(ylfb + ((1 * 2 + ct) * 4 + q) * 1024) = (f32x4){D[ct][4 * q], D[ct][4 * q + 1], D[ct][4 * q + 2], D[ct][4 * q + 3]}; }
    SUBM(6);
}
__device__ __forceinline__ void chain_unit(Frame& F, int gwv) {
    const int lane = F.lane, r32 = lane & 31, hi = lane >> 5, bh = gwv >> 1, ct = gwv & 1;
    const unsigned char* gpf = F.ws + WS_GP + (size_t)bh * NCHK * 8192 + lane * 16;
    const unsigned char* slf = F.ws + WS_SL + (size_t)bh * NCHK * 8192 + ct * 4096 + lane * 8;
    const float* gcl = (const float*)(F.ws + WS_GC) + (size_t)bh * NCHK * 64 + lane;
    unsigned char* xcf = F.ws + WS_XC + (size_t)bh * NCHK * 8192 + ct * 4096 + lane * 16;
    f32x16 X[2]; X[0] = (f32x16){}; X[1] = (f32x16){};
    v4u gA[8], gB[8], gC[8]; v2u sA[8], sB[8], sC[8]; float mA, mB, mC; const int hb = 16 * hi;
#define CH_LOAD(S) do { _Pragma("unroll") for (int k = 0; k < 8; ++k) { g##S[k] = *(const v4u*)(gpf + k * 1024); s##S[k] = *(const v2u*)(slf + k * 512); } m##S = *gcl; gpf += 8192; slf += 8192; gcl += 64; } while (0)
#define CH_STEP(S) do { bf16x8 xh[4]; \
        _Pragma("unroll") for (int rt = 0; rt < 2; ++rt) _Pragma("unroll") for (int hf = 0; hf < 2; ++hf) { const int rb = 8 * hf; \
            const v4u u = {pk2(X[rt][rb], X[rt][rb + 1]), pk2(X[rt][rb + 2], X[rt][rb + 3]), pk2(X[rt][rb + 4], X[rt][rb + 5]), pk2(X[rt][rb + 6], X[rt][rb + 7])}; \
            xh[2 * rt + hf] = __builtin_bit_cast(bf16x8, u); } \
        _Pragma("unroll") for (int ks = 0; ks < 4; ++ks) *(bf16x8*)(xcf + ks * 1024) = xh[ks]; \
        xcf += 8192; \
        _Pragma("unroll") for (int rt = 0; rt < 2; ++rt) _Pragma("unroll") for (int q = 0; q < 4; ++q) _Pragma("unroll") for (int e = 0; e < 4; ++e) { \
            const float gm_ = __builtin_bit_cast(float, __builtin_amdgcn_ds_bpermute(4 * (32 * rt + 8 * q + e) + hb, __builtin_bit_cast(int, m##S)));     \
            const unsigned sw_ = (e < 2) ? s##S[rt * 4 + q].x : s##S[rt * 4 + q].y; \
            X[rt][4 * q + e] = gm_ * X[rt][4 * q + e] + ((e & 1) ? bfhi(sw_) : bflo(sw_)); } \
        _Pragma("unroll") for (int rt = 0; rt < 2; ++rt) _Pragma("unroll") for (int ks = 0; ks < 4; ++ks) \
            X[rt] = __builtin_amdgcn_mfma_f32_32x32x16_bf16(__builtin_bit_cast(bf16x8, g##S[rt * 4 + ks]), xh[ks], X[rt], 0, 0, 0); } while (0)
    static_assert(NCHK % 3 == 1, "chain_unit: 21 x 3 steps + 1");
    CH_LOAD(A); CH_LOAD(B);
#pragma unroll 1
    for (int c = 0; c < NCHK - 1; c += 3) {
        CH_LOAD(C); CH_STEP(A);
        CH_LOAD(A); CH_STEP(B);
        if (c + 4 < NCHK) CH_LOAD(B);
        CH_STEP(C);
    }
    CH_STEP(A);
#undef CH_LOAD
#undef CH_STEP
    float* so = F.out + O_WP + (size_t)bh * 4096 + (32 * ct + r32) * 64 + 4 * hi;
#pragma unroll
    for (int rt = 0; rt < 2; ++rt)
#pragma unroll
        for (int r = 0; r < 16; ++r) so[32 * rt + CRC(r)] = X[rt][r];
}
__device__ __forceinline__ void ypass_unit(Frame& F, const Args& A, int hc) {
    const int lane = F.lane, r32 = lane & 31, hi = lane >> 5, bh = hc >> 6, c = hc & 63, h = bh & 7, row0 = (bh >> 3) * SEQ + c * 64;
    Frag fa, fb;
    { const unsigned char* xcf = F.ws + WS_XC + (size_t)hc * 8192 + lane * 16;
#pragma unroll
      for (int ct = 0; ct < 2; ++ct)
#pragma unroll
          for (int ks = 0; ks < 4; ++ks) fb[ct][ks] = *(const bf16x8*)(xcf + (ct * 4 + ks) * 1024); }
    { const unsigned char* rhf = F.ws + WS_RH + (size_t)hc * 8192 + lane * 16;
#pragma unroll
      for (int tl = 0; tl < 2; ++tl)
#pragma unroll
          for (int ks = 0; ks < 4; ++ks) fa[tl][ks] = *(const bf16x8*)(rhf + (tl * 4 + ks) * 1024); }
    f32x16 Y[2][2];
    { const unsigned char* ylf = F.ws + WS_YL + (size_t)hc * 16384 + lane * 16;
#pragma unroll
      for (int rt = 0; rt < 2; ++rt)
#pragma unroll
          for (int ct = 0; ct < 2; ++ct)
#pragma unroll
              for (int q = 0; q < 4; ++q) { const f32x4 v_ = *(const f32x4*)(ylf + ((rt * 2 + ct) * 4 + q) * 1024);
                  Y[rt][ct][4 * q] = v_[0]; Y[rt][ct][4 * q + 1] = v_[1]; Y[rt][ct][4 * q + 2] = v_[2]; Y[rt][ct][4 * q + 3] = v_[3]; } }
    const float* BON = (const float*)(F.ws + WS_BON3) + (size_t)(row0 + 4 * hi) * 32 + h * 4; bf16* RW = (bf16*)(F.ws + WS_RW) + (size_t)(row0 + 4 * hi) * 512 + h * 64 + r32;
    const unsigned* VG = rk_pair(F, 2) + (size_t)(row0 + 4 * hi) * 512 + h * 64 + r32;
    unsigned vg0[2][16], vg1[2][16]; float bon[2][16];
#pragma unroll
    for (int rt = 0; rt < 2; ++rt)
#pragma unroll
        for (int r = 0; r < 16; ++r) { vg0[rt][r] = VG[(32 * rt + CRC(r)) * 512]; vg1[rt][r] = VG[(32 * rt + CRC(r)) * 512 + 32]; bon[rt][r] = BON[(32 * rt + CRC(r)) * 32]; }
    float gw[2], gb[2];
#pragma unroll
    for (int ct = 0; ct < 2; ++ct) { gw[ct] = A.in[I_GNW][h * 64 + 32 * ct + r32]; gb[ct] = A.in[I_GNB][h * 64 + 32 * ct + r32]; }
    mm64(fa, fb, Y);
#pragma unroll
    for (int rt = 0; rt < 2; ++rt)
#pragma unroll
        for (int r = 0; r < 16; ++r) {
            const float y0 = Y[rt][0][r], y1 = Y[rt][1][r];
            const float mean = sum32(y0 + y1) * (1.f / 64.f), e0 = y0 - mean, e1 = y1 - mean;
            const float rstd = rsqrtf(sum32(e0 * e0 + e1 * e1) * (1.f / 64.f) + 64e-5f);
            const unsigned a0 = vg0[rt][r], a1 = vg1[rt][r];
            const float o0 = (e0 * rstd * gw[0] + gb[0] + bon[rt][r] * bflo(a0)) * bfhi(a0), o1 = (e1 * rstd * gw[1] + gb[1] + bon[rt][r] * bflo(a1)) * bfhi(a1);
            RW[(32 * rt + CRC(r)) * 512] = (bf16)(pk2(o0, 0.f) & 0xffffu); RW[(32 * rt + CRC(r)) * 512 + 32] = (bf16)(pk2(o1, 0.f) & 0xffffu);
        }
}

constexpr int DP_STRIDE = 260;
__device__ __forceinline__ float half_sum32(float v) { v += __shfl_xor(v, 1); v += __shfl_xor(v, 2); v += __shfl_xor(v, 4); v += __shfl_xor(v, 8); v += __shfl_xor(v, 16); return v; }
__device__ __forceinline__ float sum16(float v) {
    v += __builtin_bit_cast(float, __builtin_amdgcn_update_dpp(0, __builtin_bit_cast(int, v), 0xB1, 0xF, 0xF, true));
    v += __builtin_bit_cast(float, __builtin_amdgcn_update_dpp(0, __builtin_bit_cast(int, v), 0x4E, 0xF, 0xF, true));
    v += __builtin_bit_cast(float, __builtin_amdgcn_update_dpp(0, __builtin_bit_cast(int, v), 0x141, 0xF, 0xF, true));
    v += dpp_rmir(v);
    return v;
}
__device__ __forceinline__ void glds16(const void* gsrc, unsigned lds_dst) { unsigned keep;
    asm volatile("s_mov_b32 %0, m0\n\ts_mov_b32 m0, %2\n\ts_nop 0\n\tglobal_load_lds_dwordx4 %1, off\n\ts_mov_b32 m0, %0" : "=&s"(keep) : "v"(gsrc), "s"(lds_dst) : "memory"); }
struct LdsRows { const LAS unsigned char* b; __device__ __forceinline__ f32x4 operator[](int j) const { return *(const LAS f32x4*)(b + j * 1024); } };
__device__ __forceinline__ void decode_unit(Frame& F, const Args& A, int unit) {
    const int seq = unit >> 5, h = F.wave & 3, lane = F.lane, w = F.wave, d4 = lane & 31, tk = lane >> 5;
    const bf16* QB = (const bf16*)(F.ws + WS_QB);
    const v2u qw = *(const v2u*)(QB + (size_t)(MP + seq) * 512 + h * 128 + 4 * d4);
    const f32x4 q4 = {bflo(qw.x), bfhi(qw.x), bflo(qw.y), bfhi(qw.y)};
    const float slope = exp2f(-2.f * (float)(h + 1)) * 1.4426950408889634f;
    const int pi = (unit & 31) * 2 + (w >> 2), page = ((const int*)A.in[I_PT])[seq * NPAGES + pi];
    const float* kp = A.in[I_CK] + ((size_t)page * PAGE * 4 + h) * 128 + (size_t)tk * 512 + 4 * d4;
    const float* vp = A.in[I_CV] + ((size_t)page * PAGE * 4 + h) * 128 + (size_t)tk * 512 + 4 * d4;
    float m0 = -INFINITY, l0 = 0.f, m1 = -INFINITY, l1 = 0.f; f32x4 o0 = {0.f, 0.f, 0.f, 0.f}, o1 = o0;
    const bool c0 = d4 < 16;
    constexpr int DNB = 8;
    f32x4 kA[DNB], vA[DNB], kB[DNB], vB[DNB];
#define DEC_LOAD(KX, VX, p_) do { _Pragma("unroll") for (int j = 0; j < DNB; ++j) { KX[j] = __builtin_nontemporal_load((const f32x4*)(kp + (size_t)((p_) + j) * 1024)); VX[j] = __builtin_nontemporal_load((const f32x4*)(vp + (size_t)((p_) + j) * 1024)); } } while (0)
#define DEC_COMP(KX, VX, p_) do { float s0[DNB], s1[DNB], mx0 = m0, mx1 = m1; \
        _Pragma("unroll") for (int j = 0; j < DNB; ++j) { const f32x4 kq = KX[j] * q4; \
            const float s = sum16((kq[0] + kq[1]) + (kq[2] + kq[3])) + slope * (float)(pi * PAGE + 2 * ((p_) + j) + tk - PAST), so = __shfl_xor(s, 16); \
            s0[j] = c0 ? s : so; s1[j] = c0 ? so : s; mx0 = fmaxf(mx0, s0[j]); mx1 = fmaxf(mx1, s1[j]); } \
        const float a0 = __builtin_amdgcn_exp2f(m0 - mx0), a1 = __builtin_amdgcn_exp2f(m1 - mx1); \
        l0 *= a0; l1 *= a1; o0 *= a0; o1 *= a1; m0 = mx0; m1 = mx1; \
        _Pragma("unroll") for (int j = 0; j < DNB; ++j) { const float e0 = __builtin_amdgcn_exp2f(s0[j] - m0), e1 = __builtin_amdgcn_exp2f(s1[j] - m1); l0 += e0; l1 += e1; o0 += e0 * VX[j]; o1 += e1 * VX[j]; } } while (0)
    DEC_LOAD(kA, vA, 0);
    for (int p0 = 0; p0 < PAGE / 2; p0 += 2 * DNB) {
        DEC_LOAD(kB, vB, p0 + DNB);
        DEC_COMP(kA, vA, p0);
        if (p0 + 2 * DNB < PAGE / 2) DEC_LOAD(kA, vA, p0 + 2 * DNB);
        DEC_COMP(kB, vB, p0 + DNB);
    }
#undef DEC_LOAD
#undef DEC_COMP
#define SWP(x) __uint_as_float(__builtin_amdgcn_permlane32_swap(__float_as_uint(x), __float_as_uint(x), false, false)[tk ? 0 : 1])
    { const float mb0 = SWP(m0), lb0 = SWP(l0), mb1 = SWP(m1), lb1 = SWP(l1);
      const float M0 = fmaxf(m0, mb0), M1 = fmaxf(m1, mb1);
      const float fa0 = __builtin_amdgcn_exp2f(m0 - M0), fb0 = __builtin_amdgcn_exp2f(mb0 - M0), fa1 = __builtin_amdgcn_exp2f(m1 - M1), fb1 = __builtin_amdgcn_exp2f(mb1 - M1);
      f32x4 r0, r1;
#pragma unroll
      for (int j = 0; j < 4; ++j) { const float ob0 = SWP(o0[j]), ob1 = SWP(o1[j]); r0[j] = o0[j] * fa0 + ob0 * fb0; r1[j] = o1[j] * fa1 + ob1 * fb1; }
      float* dp = (float*)(F.ws + WS_DP2) + (size_t)((seq * 4 + h) * NPAGES + pi) * DP_STRIDE;
      if (lane == 0) *(f32x4*)dp = (f32x4){M0, l0 * fa0 + lb0 * fb0, M1, l1 * fa1 + lb1 * fb1};
      if (tk == 0) { *(f32x4*)(dp + 4 + 4 * d4) = r0; *(f32x4*)(dp + 132 + 4 * d4) = r1; } }
#undef SWP
}
__device__ __forceinline__ void decode_combine(Frame& F, const Args& A, int sh, float lam) {
    const int seq = sh >> 2, h = sh & 3, lane = F.lane, w = F.wave; const size_t ro = (size_t)(MP + seq) * 512 + h * 128 + 2 * lane;
    const float* dp = (const float*)(F.ws + WS_DP2) + (size_t)(sh * NPAGES) * DP_STRIDE;
    const float* dpo = dp + 4 + 2 * lane + (size_t)(8 * w) * DP_STRIDE;
    const unsigned qw = *(const unsigned*)((const bf16*)(F.ws + WS_QB) + ro), kw = *(const unsigned*)((const bf16*)(F.ws + WS_KB) + ro), vw = *(const unsigned*)((const bf16*)(F.ws + WS_VB) + ro);
    const f32x4 ml = *(const f32x4*)(dp + (size_t)lane * DP_STRIDE);
    f32x2 o0[8], o1[8];
#pragma unroll
    for (int i = 0; i < 8; ++i) { o0[i] = *(const f32x2*)(dpo + (size_t)i * DP_STRIDE); o1[i] = *(const f32x2*)(dpo + (size_t)i * DP_STRIDE + 128); }
    const float s = half_sum32(bflo(qw) * bflo(kw) + bfhi(qw) * bfhi(kw)), so = __shfl_xor(s, 32);
    const float sn0 = lane < 32 ? s : so, sn1 = lane < 32 ? so : s;
    float mx0 = ml[0], mx1 = ml[2];
#pragma unroll
    for (int o = 1; o < 64; o <<= 1) { mx0 = fmaxf(mx0, __shfl_xor(mx0, o)); mx1 = fmaxf(mx1, __shfl_xor(mx1, o)); }
    const float M0 = fmaxf(mx0, sn0), M1 = fmaxf(mx1, sn1);
    const float e0 = exp2f(sn0 - M0), e1 = exp2f(sn1 - M1), f0 = exp2f(ml[0] - M0), f1 = exp2f(ml[2] - M1);
    const float L0 = e0 + wave_sum(f0 * ml[1]), L1 = e1 + wave_sum(f1 * ml[3]);
    f32x2 a = {0.f, 0.f}, b = {0.f, 0.f};
#pragma unroll
    for (int i = 0; i < 8; ++i) {
        const float g0 = __builtin_bit_cast(float, __builtin_amdgcn_readlane(__builtin_bit_cast(int, f0), 8 * w + i)), g1 = __builtin_bit_cast(float, __builtin_amdgcn_readlane(__builtin_bit_cast(int, f1), 8 * w + i));
        a.x += g0 * o0[i].x; a.y += g0 * o0[i].y; b.x += g1 * o1[i].x; b.y += g1 * o1[i].y; }
    LAS f32x4* red = (LAS f32x4*)(F.lds + RING_OFF);
    red[w * 64 + lane] = (f32x4){a.x, a.y, b.x, b.y};
    __syncthreads();
    if (w != 0) return;
    a = (f32x2){e0 * bflo(vw), e0 * bfhi(vw)}; b = (f32x2){e1 * bflo(vw), e1 * bfhi(vw)};
#pragma unroll
    for (int i = 0; i < 8; ++i) { const f32x4 t = red[i * 64 + lane]; a.x += t[0]; a.y += t[1]; b.x += t[2]; b.y += t[3]; }
    const float i0 = 1.f / L0, i1 = 1.f / L1;
    const float ox = a.x * i0 - lam * b.x * i1, oy = a.y * i0 - lam * b.y * i1;
    const float rn = rsqrtf(wave_sum(ox * ox + oy * oy) * (1.f / 128.f) + 1e-6f) * 0.8f;
    const float* aog = A.in[I_AOG];
    *(unsigned*)((bf16*)(F.ws + WS_ON) + ro) = pk2(ox * rn * aog[2 * lane], oy * rn * aog[2 * lane + 1]);
}

__device__ __forceinline__ void attn_naive_row(Frame& F, const Args& A, int row, int h, float lam) {
    const int lane = F.lane, t = row & (SEQ - 1), rb = row - t;
    const bf16* QB = (const bf16*)(F.ws + WS_QB); const bf16* KB = (const bf16*)(F.ws + WS_KB); const bf16* VB = (const bf16*)(F.ws + WS_VB);
    const float slope = exp2f(-2.f * (float)(h + 1)) * 1.4426950408889634f;
    float res[2][2];
    for (int c = 0; c < 2; ++c) {
        float q[64];
#pragma unroll
        for (int d = 0; d < 64; d += 2) { const unsigned w = *(const unsigned*)(QB + (size_t)row * 512 + h * 128 + c * 64 + d); q[d] = bflo(w); q[d + 1] = bfhi(w); }
        float m = -INFINITY, l = 0.f, o[128];
#pragma unroll
        for (int d = 0; d < 128; ++d) o[d] = 0.f;
        for (int j = lane; j <= t; j += 64) {
            const bf16* kr = KB + (size_t)(rb + j) * 512 + h * 128 + c * 64; const bf16* vr = VB + (size_t)(rb + j) * 512 + h * 128;
            float s = 0.f;
#pragma unroll
            for (int d = 0; d < 64; d += 8) { const v4u w = *(const v4u*)(kr + d);
                s += q[d] * bflo(w.x) + q[d + 1] * bfhi(w.x) + q[d + 2] * bflo(w.y) + q[d + 3] * bfhi(w.y) + q[d + 4] * bflo(w.z) + q[d + 5] * bfhi(w.z) + q[d + 6] * bflo(w.w) + q[d + 7] * bfhi(w.w); }
            s += slope * (float)(j - t);
            const float mn = fmaxf(m, s), al = exp2f(m - mn), e = exp2f(s - mn);
            l = l * al + e; m = mn;
#pragma unroll
            for (int d = 0; d < 128; d += 8) { const v4u w = *(const v4u*)(vr + d);
                o[d] = o[d] * al + e * bflo(w.x); o[d + 1] = o[d + 1] * al + e * bfhi(w.x); o[d + 2] = o[d + 2] * al + e * bflo(w.y); o[d + 3] = o[d + 3] * al + e * bfhi(w.y);
                o[d + 4] = o[d + 4] * al + e * bflo(w.z); o[d + 5] = o[d + 5] * al + e * bfhi(w.z); o[d + 6] = o[d + 6] * al + e * bflo(w.w); o[d + 7] = o[d + 7] * al + e * bfhi(w.w); }
        }
        float M = m;
#pragma unroll
        for (int x = 1; x < 64; x <<= 1) M = fmaxf(M, __shfl_xor(M, x));
        const float sc = exp2f(m - M);
        const float L = wave_sum(l * sc);
        float r0 = 0.f, r1 = 0.f;
#pragma unroll
        for (int d = 0; d < 128; ++d) { const float tot = wave_sum(o[d] * sc); if ((d & 63) == lane) { if (d < 64) r0 = tot; else r1 = tot; } }
        res[c][0] = r0 / L; res[c][1] = r1 / L;
    }
    const float ox = res[0][0] - lam * res[1][0], oy = res[0][1] - lam * res[1][1];
    const float rn = rsqrtf(wave_sum(ox * ox + oy * oy) * (1.f / 128.f) + 1e-6f) * 0.8f;
    const float* aog = A.in[I_AOG]; bf16* ON = (bf16*)(F.ws + WS_ON) + (size_t)row * 512 + h * 128;
    ON[lane] = (bf16)(pk2(ox * rn * aog[lane], 0.f) & 0xffffu); ON[64 + lane] = (bf16)(pk2(oy * rn * aog[64 + lane], 0.f) & 0xffffu);
}


__device__ __forceinline__ unsigned bfbits(float f) { return __builtin_bit_cast(unsigned, f) >> 16; }
__device__ __forceinline__ void attn_unit(Frame& F, const Args& A, int b, int h, int qb, float lam) {
    LAS unsigned char* Kt = F.lds + RING_OFF;
    LAS float* wsf = (LAS float*)(Kt + 98304) + F.wave * 64;
    LAS float* xch = (LAS float*)Kt;
    const bf16* QB = (const bf16*)(F.ws + WS_QB); const bf16* KB = (const bf16*)(F.ws + WS_KB); const bf16* VB = (const bf16*)(F.ws + WS_VB);
    const int tid = F.tid, lane = F.lane, w = F.wave, c = w >> 2, wq = w & 3, r32 = lane & 31, hi = lane >> 5;
    const int rowbase = b * SEQ, q0 = 128 * qb + 32 * wq, NT = 2 * (qb + 1);
    bf16x8 qr[4];
    { const bf16* Qp = QB + (size_t)(rowbase + q0 + r32) * 512 + (2 * h + c) * 64 + 8 * hi;
#pragma unroll
      for (int d0 = 0; d0 < 4; ++d0) qr[d0] = *(const bf16x8*)(Qp + 16 * d0); }
    asm volatile("" : "+v"(qr[0]), "+v"(qr[1]), "+v"(qr[2]), "+v"(qr[3]));
    const float sl = exp2f(-2.f * (float)(h + 1)) * 1.4426950408889634f;
    const unsigned c1 = __builtin_bit_cast(unsigned, sl) & 0xffff0000u; const float r1 = sl - __builtin_bit_cast(float, c1);
    const unsigned c2 = __builtin_bit_cast(unsigned, r1) & 0xffff0000u; const float r2 = r1 - __builtin_bit_cast(float, c2);
    const unsigned c3 = __builtin_bit_cast(unsigned, r2) & 0xffff0000u;
    const unsigned b1 = c1 >> 16, b2 = c2 >> 16, b3 = c3 >> 16, lo_mask = hi ? 0u : 0xffffffffu;
    const v4u qextu = {(b1 | (b2 << 16)) & lo_mask, (b3 | (b1 << 16)) & lo_mask, (b2 | (b3 << 16)) & lo_mask, 0u};
    const bf16x8 qext = __builtin_bit_cast(bf16x8, qextu);
    const unsigned J0 = bfbits((float)r32), J1 = bfbits((float)(32 + r32));
    const unsigned lds0 = (unsigned)(uintptr_t)(F.lds + RING_OFF);
    const bf16* kg0 = KB + (size_t)(rowbase + lane) * 512 + h * 128 + (2 * w) * 8;
    const bf16* vg0 = VB + (size_t)(rowbase + 32 * (w & 1) + (lane >> 2)) * 512 + h * 128 + (w >> 1) * 32 + (lane & 3) * 8;
    const unsigned kd0 = lds0 + (2 * w) * 1024, vd0 = lds0 + 16384 + (w >> 1) * 4096 + (2 * (w & 1)) * 1024;
#define ATT_DMA(t_, boff_) do { const size_t go_ = (size_t)(t_) * 64 * 512; const unsigned bo_ = (unsigned)(boff_); \
        glds16(kg0 + go_, (unsigned)__builtin_amdgcn_readfirstlane(kd0 + bo_)); glds16(kg0 + go_ + 8, (unsigned)__builtin_amdgcn_readfirstlane(kd0 + bo_ + 1024)); \
        glds16(vg0 + go_, (unsigned)__builtin_amdgcn_readfirstlane(vd0 + bo_)); glds16(vg0 + go_ + (size_t)16 * 512, (unsigned)__builtin_amdgcn_readfirstlane(vd0 + bo_ + 1024)); } while (0)
    ATT_DMA(NT - 1, 0);
    f32x16 o[4];
#pragma unroll
    for (int i = 0; i < 4; ++i) o[i] = (f32x16){};
    float m = -INFINITY, l = 0.f;
    bf16x8 pa[4];
    asm volatile("s_waitcnt vmcnt(0) lgkmcnt(0)\n\ts_barrier" ::: "memory");
#define ATT_QKSM(t, bo) do { \
        const LAS unsigned char* kfp = Kt + (bo) + (c * 8 + hi) * 1024 + r32 * 16; \
        const unsigned Tb = bfbits((float)(64 * (t) - 128 * qb)); \
        f32x16 p[2]; bf16x8 kfr[2][4]; \
        _Pragma("unroll") for (int half = 0; half < 2; ++half) _Pragma("unroll") for (int d0 = 0; d0 < 4; ++d0) kfr[half][d0] = *(const LAS bf16x8*)(kfp + d0 * 2048 + half * 512); \
        __builtin_amdgcn_sched_barrier(0); \
        _Pragma("unroll") for (int half = 0; half < 2; ++half) { f32x16 acc = (f32x16){}; \
            _Pragma("unroll") for (int d0 = 0; d0 < 4; ++d0) acc = __builtin_amdgcn_mfma_f32_32x32x16_bf16(kfr[half][d0], qr[d0], acc, 0, 0, 0); \
            const unsigned Jb = half ? J1 : J0; \
            const v4u ke = {(Tb | (Tb << 16)) & lo_mask, (Tb | (Jb << 16)) & lo_mask, (Jb | (Jb << 16)) & lo_mask, 0u}; \
            p[half] = __builtin_amdgcn_mfma_f32_32x32x16_bf16(__builtin_bit_cast(bf16x8, ke), qext, acc, 0, 0, 0); } \
        if (64 * (t) + 63 > q0) { const int qpos = q0 + r32; \
            _Pragma("unroll") for (int half = 0; half < 2; ++half) _Pragma("unroll") for (int r = 0; r < 16; ++r) { const int kv = 64 * (t) + 32 * half + crow16(r, hi); if (kv > qpos) p[half][r] = -INFINITY; } } \
        float mx = p[0][0]; \
        _Pragma("unroll") for (int r = 1; r < 16; ++r) mx = fmaxf(mx, p[0][r]); \
        _Pragma("unroll") for (int r = 0; r < 16; ++r) mx = fmaxf(mx, p[1][r]); \
        { const auto rr = __builtin_amdgcn_permlane32_swap(__float_as_uint(mx), __float_as_uint(mx), false, false); mx = fmaxf(__uint_as_float(rr[0]), __uint_as_float(rr[1])); } \
        const float mn = fmaxf(m, mx), alpha = __builtin_amdgcn_exp2f(m - mn); m = mn; \
        float ls = 0.f; \
        _Pragma("unroll") for (int half = 0; half < 2; ++half) _Pragma("unroll") for (int r = 0; r < 16; ++r) { const float e = __builtin_amdgcn_exp2f(p[half][r] - mn); p[half][r] = e; ls += e; } \
        { const auto rr = __builtin_amdgcn_permlane32_swap(__float_as_uint(ls), __float_as_uint(ls), false, false); ls = __uint_as_float(rr[0]) + __uint_as_float(rr[1]); } \
        l = l * alpha + ls; \
        if (__any(alpha != 1.f)) { if (hi == 0) wsf[r32] = alpha; LDS_WAIT(); \
            _Pragma("unroll") for (int r = 0; r < 16; ++r) { const float f = wsf[crow16(r, hi)]; _Pragma("unroll") for (int blk = 0; blk < 4; ++blk) o[blk][r] *= f; } } \
        _Pragma("unroll") for (int s = 0; s < 4; ++s) { const int hf = s >> 1, rb = 8 * (s & 1); \
            const v4u u = {pk2(p[hf][rb], p[hf][rb + 1]), pk2(p[hf][rb + 2], p[hf][rb + 3]), pk2(p[hf][rb + 4], p[hf][rb + 5]), pk2(p[hf][rb + 6], p[hf][rb + 7])}; \
            pa[s] = __builtin_bit_cast(bf16x8, u); } } while (0)
#define ATT_PV(bo) do { \
        const LAS unsigned char* vfp = Kt + (bo) + 16384 + ((lane >> 4) & 1) * 32 + (lane & 3) * 8 + (4 * hi + ((lane & 15) >> 2)) * 64; \
        s16x4 vlo[2][4], vhi[2][4]; \
        _Pragma("unroll") for (int s = 0; s < 4; ++s) { vlo[0][s] = vtr(vfp + s * 1024); vhi[0][s] = vtr(vfp + s * 1024 + 512); } \
        _Pragma("unroll") for (int blk = 0; blk < 4; ++blk) { \
            if (blk < 3) { _Pragma("unroll") for (int s = 0; s < 4; ++s) { vlo[(blk + 1) & 1][s] = vtr(vfp + (blk + 1) * 4096 + s * 1024); vhi[(blk + 1) & 1][s] = vtr(vfp + (blk + 1) * 4096 + s * 1024 + 512); } } \
            __builtin_amdgcn_sched_barrier(0); \
            _Pragma("unroll") for (int s = 0; s < 4; ++s) { const s16x4 lo = vlo[blk & 1][s], hh = vhi[blk & 1][s]; \
                const bf16x8 vf = {lo[0], lo[1], lo[2], lo[3], hh[0], hh[1], hh[2], hh[3]}; \
                o[blk] = __builtin_amdgcn_mfma_f32_32x32x16_bf16(pa[s], vf, o[blk], 0, 0, 0); } \
            __builtin_amdgcn_sched_barrier(0); } } while (0)
    bool pend = false; int pbo = 0, bo = 0;
    for (int it = 0; it <= NT; ++it) {
        const int t = NT - 1 - it, bn = (bo == 65536) ? 0 : bo + 32768;
        if (it + 1 < NT) ATT_DMA(t - 1, bn);
        const bool act = it < NT && 64 * t <= q0 + 31;
        if (c == 1 && pend) ATT_PV(pbo);
        if (act) ATT_QKSM(t, bo);
        if (c == 0 && act) ATT_PV(bo);
        if (c == 1) { pend = act; pbo = bo; }
        asm volatile("s_waitcnt vmcnt(0) lgkmcnt(0)\n\ts_barrier" ::: "memory");
        bo = bn;
    }
#undef ATT_QKSM
#undef ATT_PV
#undef ATT_DMA
    if (hi == 0) wsf[r32] = 1.f / l;
    LDS_WAIT();
#pragma unroll
    for (int r = 0; r < 16; ++r) { const float f = wsf[crow16(r, hi)];
#pragma unroll
        for (int blk = 0; blk < 4; ++blk) o[blk][r] *= f; }
    LAS float* xw = xch + wq * 4096;
    if (c == 1) {
#pragma unroll
        for (int blk = 0; blk < 4; ++blk)
#pragma unroll
            for (int r = 0; r < 16; ++r) xw[(blk * 16 + r) * 64 + lane] = o[blk][r];
    }
    __syncthreads();
    if (c == 0) {
        const float* aog = A.in[I_AOG]; bf16* ON = (bf16*)(F.ws + WS_ON);
        float g[4];
#pragma unroll
        for (int blk = 0; blk < 4; ++blk) g[blk] = aog[32 * blk + r32] * 0.8f;
#pragma unroll
        for (int r = 0; r < 16; ++r) {
            float v[4], ss = 0.f;
#pragma unroll
            for (int blk = 0; blk < 4; ++blk) { v[blk] = o[blk][r] - lam * xw[(blk * 16 + r) * 64 + lane]; ss += v[blk] * v[blk]; }
            ss += __shfl_xor(ss, 1); ss += __shfl_xor(ss, 2); ss += __shfl_xor(ss, 4); ss += __shfl_xor(ss, 8); ss += __shfl_xor(ss, 16);
            const float rn = rsqrtf(ss * (1.f / 128.f) + 1e-6f);
            bf16* op = ON + (size_t)(rowbase + q0 + crow16(r, hi)) * 512 + h * 128 + r32;
#pragma unroll
            for (int blk = 0; blk < 4; ++blk) op[32 * blk] = (bf16)(pk2(v[blk] * rn * g[blk], 0.f) & 0xffffu);
        }
    }
    __syncthreads();
}

__device__ __forceinline__ void skinny_tile(Frame& F, LAS float* red, const bf16* A, int lda, const bf16* Bt, int K, int n0) {
    const int lane = F.lane, r = lane & 31, hi = lane >> 5, w = F.wave, kw = K / 8;
    const bf16* ap = A + (size_t)r * lda + w * kw + 8 * hi; const bf16* bp = Bt + (size_t)(n0 + r) * K + w * kw + 8 * hi;
    f32x16 acc = {};
    const int nst = kw / 16;
    for (int s0 = 0; s0 < nst; s0 += 8) {
        bf16x8 av[8], bv[8];
#pragma unroll
        for (int j = 0; j < 8; ++j) { const int k = (s0 + j < nst ? s0 + j : nst - 1) * 16; av[j] = *(const bf16x8*)(ap + k); bv[j] = *(const bf16x8*)(bp + k); }
#pragma unroll
        for (int j = 0; j < 8; ++j) if (s0 + j < nst) acc = __builtin_amdgcn_mfma_f32_32x32x16_bf16(av[j], bv[j], acc, 0, 0, 0);
    }
    __syncthreads();
#pragma unroll
    for (int i = 0; i < 16; ++i) red[w * 1024 + i * 64 + lane] = acc[i];
    __syncthreads();
    for (int e = F.tid; e < 1024; e += 512) { float s = 0.f;
#pragma unroll
        for (int j = 0; j < 8; ++j) s += red[j * 1024 + e];
        red[8 * 1024 + e] = s; }
    __syncthreads();
}

#ifndef MK_N_LAUNCHES
#define MK_N_LAUNCHES 1
#endif
#ifndef MK_NAIVE_ATTN
#define MK_NAIVE_ATTN 0
#endif
constexpr int N_PHASES = 10;
__global__ void __launch_bounds__(NWAVES * 64, 2) mk_fwd(Args args) {
    extern __shared__ __attribute__((aligned(16))) unsigned char lds[];
    Frame F;
#ifdef MK_SUB
    F.pa = 0ull; F.pb = 0ull;
#endif
    F.lds = (LAS unsigned char*)lds;
    F.MISC = (volatile LAS unsigned*)(F.lds + MISC_OFF);
    F.tid = threadIdx.x; F.lane = F.tid & 63; F.wave = __builtin_amdgcn_readfirstlane(F.tid >> 6);
    F.G = gridDim.x; { const int bx = blockIdx.x; F.vcu = (F.G % 8 == 0) ? (bx % 8) * (F.G / 8) + bx / 8 : bx; }
    F.ws = args.ws; F.out = args.out; F.ctl = (gu32*)(args.ws + WS_CTL);
    const Args& A = args;
    for (int u = F.tid; u < (LDS_BYTES - LDSCTL_OFF) / 4; u += NWAVES * 64) ((LAS unsigned*)(F.lds + LDSCTL_OFF))[u] = 0u;
    __syncthreads();
    XcdBarrier bar; bar.bar = (unsigned*)(F.ctl + CW_BAR); bar.x = 0; bar.st = nullptr;
    if (MK_N_LAUNCHES == 1) bar = xcd_barrier_post((unsigned*)(F.ctl + CW_BAR), F.MISC + 8);
#define GRID_BAR() do { if (MK_N_LAUNCHES == 1) xcd_barrier(bar); } while (0)
    const int lo = args.ph_lo, hi = args.ph_hi;
#ifndef MK_PROF
#define MK_PROF -1
#endif
#ifndef MK_PROF_SCALE
#define MK_PROF_SCALE 1e-5f
#endif
    unsigned long long prof_a = 0ull, prof_b = 0ull;
#define PH_BEGIN(k) do { if (MK_PROF == (k)) prof_a = __builtin_amdgcn_s_memrealtime(); } while (0)
#define PH_END(k) do { if (MK_PROF == (k)) prof_b = __builtin_amdgcn_s_memrealtime(); } while (0)
#ifndef MK_DBG_STOP
#define MK_DBG_STOP 99
#endif
#define IN(k) (lo <= (k) && (k) < hi && (k) <= MK_DBG_STOP)
#define BOTH(k) (IN(k) && IN((k) + 1))
    bf16* XB = (bf16*)(F.ws + WS_XB); float* rs0 = (float*)(F.ws + WS_RS0);
    bf16* QB = (bf16*)(F.ws + WS_QB); bf16* KB = (bf16*)(F.ws + WS_KB); bf16* VB = (bf16*)(F.ws + WS_VB); bf16* PC = (bf16*)(F.ws + WS_PC); bf16* GT = (bf16*)(F.ws + WS_GT);
    bf16* ON = (bf16*)(F.ws + WS_ON); bf16* RW = (bf16*)(F.ws + WS_RW); bf16* MG = (bf16*)(F.ws + WS_MG); bf16* X1B = (bf16*)(F.ws + WS_X1B); bf16* HB = (bf16*)(F.ws + WS_HB);
    float* ssq = (float*)(F.ctl + CW_SSQ);
    const int bx = (int)blockIdx.x;

    PH_BEGIN(0);
    if (IN(0)) { for (int i = bx * 512 + F.tid; i < MTOT; i += F.G * 512) ssq[i] = 0.f;
        p0_prologue<0>(F, A, F.vcu * NWAVES + F.wave, F.G * NWAVES); if (BOTH(0)) GRID_BAR(); PH_END(0); }
    PH_BEGIN(1);
    if (IN(1)) {
        pg8::Gemm g{XB, (const bf16*)(F.ws + WS_WIN), nullptr, nullptr, MTOT, INW, DM}; pg8::StaticOrder S; S.init(MTOT, INW, F.G, bx);
        pg8::EpiProj E{rs0, A.in[I_QG], A.in[I_KG], QB, KB, VB, PC, GT, F.out};
        pg8::gemm_phase<pg8::EpiProj, pg8::StaticOrder, true, true>(F.lds + RING_OFF, g, S, E);
        { const int nlong = ((MTOT / 256 + (MTOT % 256 != 0)) * (INW / 256)) % F.G;
          if (nlong == 0) p0_prologue<1>(F, A, bx * NWAVES + F.wave, F.G * NWAVES);
          else if (bx >= nlong) p0_prologue<1>(F, A, (bx - nlong) * NWAVES + F.wave, (F.G - nlong) * NWAVES);
          __syncthreads(); }
        if (BOTH(1)) GRID_BAR(); PH_END(1);
    }
    PH_BEGIN(2);
    if (IN(2)) {
        SUBM(30);
        {
            const int grp = (bx + 2 * F.G >= MP / 32) ? bx % 3 : -1;
            int u = bx;
#pragma unroll 1
            for (int st = 0; ; ++st) {
                if (st == grp) {
                    LAS unsigned* qslot = (LAS unsigned*)(F.lds + LDSCTL_OFF);
                    if (F.tid == 0) qslot[0] = __hip_atomic_fetch_add((unsigned*)(F.ctl + CW_QDEC), 1u, __ATOMIC_RELAXED, __HIP_MEMORY_SCOPE_AGENT);
                    __syncthreads();
                    const unsigned k = qslot[0];
                    __syncthreads();
                    if (k < 1024u) decode_unit(F, A, (int)k);
                    __syncthreads();
                } else if (u < MP / 32) { rwkv_prep_unit(F, A, u); u += F.G; }
                else break;
            }
        }
        SUBM(31);
        SUBM(32);
        if (BOTH(2)) GRID_BAR(); PH_END(2);
    }
    PH_BEGIN(3);
    if (IN(3)) {
        SUBM(10);
        SUBM(11);
        for (int hc = bx * NWAVES + F.wave; hc < 32 * NCHK; hc += F.G * NWAVES) chunk_unit(F, hc);
        __syncthreads();
        if (BOTH(3)) GRID_BAR(); PH_END(3);
    }
    PH_BEGIN(4);
    if (IN(4)) {
        { int ln_ = F.lane, td_ = F.tid; asm volatile("" : "+v"(ln_), "+v"(td_)); F.lane = ln_; F.tid = td_; }
        SUBM(50);
        if (bx < 8) { chain_unit(F, bx * NWAVES + F.wave); __syncthreads(); }
        SUBM(51);
        const float lam = lam_value(F, A);
        LAS unsigned* qslot = (LAS unsigned*)(F.lds + LDSCTL_OFF);
        const unsigned dtail = __hip_atomic_load((unsigned*)(F.ctl + CW_QDEC), __ATOMIC_RELAXED, __HIP_MEMORY_SCOPE_AGENT) < 1024u ? __hip_atomic_load((unsigned*)(F.ctl + CW_QDEC), __ATOMIC_RELAXED, __HIP_MEMORY_SCOPE_AGENT) : 1024u;
        for (;;) {
            { int ln_ = F.lane, td_ = F.tid; asm volatile("" : "+v"(ln_), "+v"(td_)); F.lane = ln_; F.tid = td_; }
            if (F.tid == 0) qslot[0] = __hip_atomic_fetch_add((unsigned*)(F.ctl + CW_QUEUE), 1u, __ATOMIC_RELAXED, __HIP_MEMORY_SCOPE_AGENT);
            __syncthreads();
            const unsigned k = qslot[0];
            __syncthreads();
            if (k >= 1537u) break;
            if (k == 0u) { rwkv_prep_unit(F, A, MP / 32); continue; }
            const unsigned tr = (k - 1u) / 3u, r = (k - 1u) - 3u * tr;
#ifdef MK_SUB
            const unsigned long long t0_ = __builtin_amdgcn_s_memrealtime();
#endif
            if (r == 0u) attn_unit(F, A, (int)(tr & 15u) >> 2, (int)(tr & 3u), 31 - (int)(tr >> 4), lam);
            else { const unsigned d = dtail + 2u * tr + r - 1u; if (d < 1024u) decode_unit(F, A, (int)d); }
#ifdef MK_SUB
            if ((MK_SUB == 40 && r == 0u) || (MK_SUB == 41 && r != 0u)) F.pb += __builtin_amdgcn_s_memrealtime() - t0_;
#endif
        }
        if (BOTH(4)) GRID_BAR(); PH_END(4);
    }
    PH_BEGIN(5);
    if (IN(5)) {
        SUBM(20);
        { const float lam = lam_value(F, A);
          for (int it = bx; it < 128; it += F.G) { decode_combine(F, A, it, lam); if (it + F.G < 128) __syncthreads(); } }
        __syncthreads();
        for (int u = 256 + bx; u < 512; u += F.G) scan_seg_unit(F, A, u);
        SUBM(21);
        for (int hc = bx * NWAVES + F.wave; hc < 32 * NCHK; hc += F.G * NWAVES) ypass_unit(F, A, hc);
        SUBM(22);
        __syncthreads();
        if (BOTH(5)) GRID_BAR(); PH_END(5);
    }
    PH_BEGIN(6);
    if (IN(6)) {
        if (bx < 32) {
            LAS float* red = (LAS float*)(F.lds + RING_OFF); const int n0 = 32 * bx; float t1[2];
            skinny_tile(F, red, ON + (size_t)MP * 512, 512, (const bf16*)(F.ws + WS_WPA), 512, n0);
            t1[0] = red[8192 + F.tid]; t1[1] = red[8192 + 512 + F.tid];
            skinny_tile(F, red, RW + (size_t)MP * 512, 512, (const bf16*)(F.ws + WS_WPB), 512, n0);
#pragma unroll
            for (int i = 0; i < 2; ++i) { const int e = F.tid + 512 * i, reg = e >> 6, ln = e & 63, row = crow16(reg, ln >> 5), col = n0 + (ln & 31);
                const float g1 = bf2f(GT[(size_t)(MP + row) * 2048 + col]), g2 = bf2f(GT[(size_t)(MP + row) * 2048 + 1024 + col]);
                MG[(size_t)(MP + row) * 1024 + col] = (bf16)(pk2(g1 * t1[i] + g2 * red[8192 + e], 0.f) & 0xffffu); }
            __syncthreads();
        }
        pg8::Gemm g{ON, (const bf16*)(F.ws + WS_WPA), RW, (const bf16*)(F.ws + WS_WPB), MP, DM, 512}; pg8::PairOrder S; S.base.init(MP, DM, F.G, bx);
        pg8::EpiMerge E{GT, (float*)(F.ws + WS_TMP), MG};
        pg8::gemm_phase<pg8::EpiMerge, pg8::PairOrder, true, true>(F.lds + RING_OFF, g, S, E);
        if (BOTH(6)) GRID_BAR(); PH_END(6);
    }
    PH_BEGIN(7);
    if (IN(7)) {
        if (bx < 32) {
            LAS float* red = (LAS float*)(F.lds + RING_OFF); const int n0 = 32 * bx;
            skinny_tile(F, red, MG + (size_t)MP * 1024, 1024, (const bf16*)(F.ws + WS_WOUT), 1024, n0);
#pragma unroll
            for (int i = 0; i < 2; ++i) { const int e = F.tid + 512 * i, reg = e >> 6, ln = e & 63, row = crow16(reg, ln >> 5), col = n0 + (ln & 31);
                const float v = A.in[I_XS][(size_t)row * 1024 + col] + red[8192 + e];
                F.out[O_YS + (size_t)row * 1024 + col] = v; X1B[(size_t)(MP + row) * 1024 + col] = (bf16)(pk2(v, 0.f) & 0xffffu);
                float ss = v * v; ss += __shfl_xor(ss, 1); ss += __shfl_xor(ss, 2); ss += __shfl_xor(ss, 4); ss += __shfl_xor(ss, 8); ss += __shfl_xor(ss, 16);
                if ((ln & 31) == 0) atomicAdd(ssq + MP + row, ss); }
            __syncthreads();
        }
        pg8::Gemm g{MG, (const bf16*)(F.ws + WS_WOUT), nullptr, nullptr, MP, DM, DM}; pg8::StaticOrder S; S.init(MP, DM, F.G, bx);
        pg8::EpiOut E{XB, X1B, ssq};
        pg8::gemm_phase<pg8::EpiOut, pg8::StaticOrder, false, true>(F.lds + RING_OFF, g, S, E);
        if (BOTH(7)) GRID_BAR(); PH_END(7);
    }
    PH_BEGIN(8);
    if (IN(8)) {
        pg8::Gemm g{X1B, (const bf16*)(F.ws + WS_WGU), nullptr, nullptr, MTOT, NGU, DM}; pg8::StaticOrder S; S.init(MTOT, NGU, F.G, bx);
        pg8::EpiGateUp E{ssq, HB};
        pg8::gemm_phase<pg8::EpiGateUp, pg8::StaticOrder, true, true>(F.lds + RING_OFF, g, S, E);
        if (BOTH(8)) GRID_BAR(); PH_END(8);
    }
    PH_BEGIN(9);
    if (IN(9)) {
        if (bx < 32) {
            LAS float* red = (LAS float*)(F.lds + RING_OFF); const int n0 = 32 * bx;
            skinny_tile(F, red, HB + (size_t)MP * FF, FF, (const bf16*)(F.ws + WS_WDN), FF, n0);
#pragma unroll
            for (int i = 0; i < 2; ++i) { const int e = F.tid + 512 * i, reg = e >> 6, ln = e & 63, row = crow16(reg, ln >> 5), col = n0 + (ln & 31);
                float yv = F.out[O_YS + (size_t)row * 1024 + col] + red[8192 + e];
#ifdef MK_SUB
                prof_a = F.pa; prof_b = F.pb;
#endif
                if (MK_PROF >= 0 && MK_PROF != 9) yv *= 1.f + sqrtf((float)(prof_b - prof_a) * 0.01f * MK_PROF_SCALE);
                F.out[O_YS + (size_t)row * 1024 + col] = yv; }
            __syncthreads();
        }
        pg8::Gemm g{HB, (const bf16*)(F.ws + WS_WDN), nullptr, nullptr, MP, DM, FF}; pg8::StaticOrder S; S.init(MP, DM, F.G, bx);
        pg8::EpiDown E{F.out + O_YP, X1B};
        pg8::gemm_phase<pg8::EpiDown, pg8::StaticOrder, false, true>(F.lds + RING_OFF, g, S, E);
        if (MK_PROF == 9 && MK_N_LAUNCHES == 1) {
            xcd_barrier(bar); prof_b = __builtin_amdgcn_s_memrealtime();
            const float sc = 1.f + sqrtf((float)(prof_b - prof_a) * 0.01f * 1e-5f);
            for (int e = bx * 512 + F.tid; e < 32 * 1024; e += F.G * 512) F.out[O_YS + e] *= sc;
        }
    }
#undef IN
#undef BOTH
}

#if MK_NAIVE_ATTN
__global__ void __launch_bounds__(512, 2) attn_naive_kernel(Args args) {
    Frame F; F.tid = threadIdx.x; F.lane = F.tid & 63; F.wave = __builtin_amdgcn_readfirstlane(F.tid >> 6); F.G = gridDim.x; F.ws = args.ws; F.out = args.out;
    const Args& A = args;
    const float lam = lam_value(F, A);
    const int gw = (int)blockIdx.x * NWAVES + F.wave, NGW = F.G * NWAVES;
    for (int it = gw; it < MP * 4; it += NGW) attn_naive_row(F, A, it >> 2, it & 3, lam);
}
#endif
extern "C" void kernel_launch(void* const* d_in, const int* in_sizes, int n_in, void* d_out, int out_size, void* d_ws, size_t ws_size, hipStream_t stream) {
    static int grid = 0;
    if (grid == 0) {
        if (n_in != 34 || out_size != (int)O_END || ws_size < WS_END) { fprintf(stderr, "kernel_launch: unexpected shapes: n_in %d out %d ws %zu\n", n_in, out_size, ws_size); grid = -1; return; }
        int dev = 0, cus = 0, per_cu = 0;
        if (hipGetDevice(&dev) != hipSuccess || hipDeviceGetAttribute(&cus, hipDeviceAttributeMultiprocessorCount, dev) != hipSuccess) { grid = -1; return; }
        if (hipFuncSetAttribute((const void*)mk_fwd, hipFuncAttributeMaxDynamicSharedMemorySize, LDS_BYTES) != hipSuccess) { fprintf(stderr, "kernel_launch: hipFuncSetAttribute failed\n"); grid = -1; return; }
        if (hipOccupancyMaxActiveBlocksPerMultiprocessor(&per_cu, (const void*)mk_fwd, NWAVES * 64, LDS_BYTES) != hipSuccess || per_cu < 1) fprintf(stderr, "kernel_launch: occupancy query says %d\n", per_cu);
        (void)hipGetLastError();
        grid = cus;
    }
    if (grid < 0) return;
    if (hipMemsetAsync((char*)d_ws + WS_CTL, 0, CTL_ZERO_BYTES, stream) != hipSuccess) return;
    Args a{};
    for (int i = 0; i < 34; ++i) a.in[i] = (const float*)d_in[i];
    a.out = (float*)d_out; a.ws = (unsigned char*)d_ws;
    const int NL = MK_N_LAUNCHES;
    for (int li = 0; li < NL; ++li) {
        a.ph_lo = (NL == 1) ? 0 : li; a.ph_hi = (NL == 1) ? N_PHASES : li + 1; a.li = li; a.pad = 0;
        hipLaunchKernelGGL(mk_fwd, dim3(grid), dim3(NWAVES * 64), LDS_BYTES, stream, a);
        if (hipPeekAtLastError() != hipSuccess) { fprintf(stderr, "kernel_launch: launch %d failed\n", li); break; }
#if MK_NAIVE_ATTN
        if (NL != 1 && li == 3) hipLaunchKernelGGL(attn_naive_kernel, dim3(1024), dim3(512), 0, stream, a);
#endif
    }
}
```

```cpp
#include <hip/hip_runtime.h>
#include <cstdio>
#include <cstdint>

constexpr int MP = 16384, MS = 32, MVALID = MP + MS, MTOT = 16640;
constexpr int DM = 1024, INW = 5376, FF = 2816, NGU = 2 * FF, SEQ = 4096, NBATCH = 4, RSW = 1792;
constexpr int NPAGES = 64, PAGE = 128, PAST = 8192;
constexpr size_t O_YP = 0, O_YS = 16777216, O_KP = O_YS + 32768, O_VP = O_KP + 8388608, O_WP = O_VP + 8388608, O_SP = O_WP + 131072,
                 O_KS = O_SP + 7168, O_VS = O_KS + 16384, O_WS = O_VS + 16384, O_SS = O_WS + 1048576, O_END = O_SS + 57344;
constexpr float QK_C2 = 0.125f * 1.4426950408889634f;
namespace pg8 {
#define PG8_LAS __attribute__((address_space(3)))
typedef unsigned short bf16_t;
typedef short bf16x8 __attribute__((ext_vector_type(8)));
typedef float f32x4 __attribute__((ext_vector_type(4)));
typedef unsigned u32x4 __attribute__((ext_vector_type(4)));
constexpr int BM = 256, BK = 64, HALF = 128, HTB = HALF * BK * 2  , STAGE_BYTES = 8 * HTB, NXCD = 8, WGM = 8;

__host__ __device__ __forceinline__ int lds_byte(int r, int c) { const int st = (r >> 4) * 2 + (c >> 5), rr = r & 15, cc = c & 31, ob = rr * 64 + cc * 2; return st * 1024 + (ob ^ (((ob >> 9) & 1) << 5)); }
__host__ __device__ __forceinline__ void stage_rc(int b, int& R, int& C) { const int st = b / 1024, sb = b % 1024, swz = sb ^ (((sb >> 9) & 1) << 5); R = (st >> 1) * 16 + swz / 64; C = (st & 1) * 32 + (swz % 64) / 2; }
__host__ __device__ __forceinline__ int perm32(int rho) { const int n = rho >> 4, i = rho & 15; return 8 * (i >> 2) + 4 * n + (i & 3); }

struct Unit { int pm, pn, z; };
struct Gemm { const bf16_t* A; const bf16_t* Bt; const bf16_t* A2; const bf16_t* Bt2; int M, N, K; };

struct StaticOrder {
    int nM, nN, nwg, G, c;
    __host__ __device__ void init(int M, int N, int G_, int c_) { nM = M / BM; nN = N / BM; nwg = nM * nN; G = G_; c = c_; }
    __host__ __device__ bool next(int i, Unit& u) const {
        const long L = (long)i * G + c; if (L >= nwg) return false;
        int wgid = (int)L; { const int q = nwg / NXCD, r = nwg % NXCD, xcd = wgid % NXCD, off = wgid / NXCD; wgid = (xcd < r ? xcd * (q + 1) : r * (q + 1) + (xcd - r) * q) + off; }
        const int nig = WGM * nN, gid = wgid / nig, fm = gid * WGM, gsz = (nM - fm) < WGM ? (nM - fm) : WGM;
        u.pm = fm + ((wgid % nig) % gsz); u.pn = (wgid % nig) / gsz; u.z = 0; return true;
    }
    __device__ __forceinline__ void a_ready(const Unit&) const {}
    __device__ __forceinline__ void done(const Unit&) const {}
};

typedef float f32x2_cv __attribute__((ext_vector_type(2))); typedef __bf16 bf16x2_cv __attribute__((ext_vector_type(2)));
__device__ __forceinline__ unsigned cvt_pk_bf16(float lo, float hi) { const f32x2_cv v = {lo, hi}; const bf16x2_cv b = __builtin_convertvector(v, bf16x2_cv); return __builtin_bit_cast(unsigned, b); }
typedef float f32x2 __attribute__((ext_vector_type(2)));
__device__ __forceinline__ void st_bf16x8(bf16_t* p, const f32x4 a, const f32x4 b) {
    u32x4 w; w.x = cvt_pk_bf16(a[0], a[1]); w.y = cvt_pk_bf16(a[2], a[3]); w.z = cvt_pk_bf16(b[0], b[1]); w.w = cvt_pk_bf16(b[2], b[3]); *(u32x4*)p = w;
}
__device__ __forceinline__ float sigmoidf_(float x) { return __builtin_amdgcn_rcpf(1.f + __expf(-x)); }

struct EpiProj {
    static constexpr bool PERM = true, AFTER_DRAIN = false, KEEP_ACC = false;
    const float* rs0; const float* qg; const float* kg;
    bf16_t *QB, *KB, *VB, *PC, *GT; float* out;
    __device__ __forceinline__ void operator()(const f32x4 (&acc)[2][2][4][2], const Unit& u, int wr, int wc, int fr, int fq) const {
        const int pn = u.pn, rb = u.pm * BM + wr * 64 + fr, c8 = 64 * wc + 8 * fq;
        if (pn < 4) {
            const bool isq = pn < 2; const float* gain = isq ? qg : kg;
            f32x4 gv[2][2];
#pragma unroll
            for (int bj = 0; bj < 2; ++bj)
#pragma unroll
                for (int n = 0; n < 2; ++n) gv[bj][n] = *(const f32x4*)(gain + 32 * bj + 8 * fq + 4 * n);
            const int colg = 256 * (pn & 1) + c8;
#pragma unroll
            for (int ai = 0; ai < 2; ++ai)
#pragma unroll
                for (int m = 0; m < 4; ++m) {
                    const int row = rb + ai * HALF + m * 16; const bool ok = row < MVALID; const float rs = rs0[ok ? row : 0];
                    float ss = 0.f;
#pragma unroll
                    for (int bj = 0; bj < 2; ++bj)
#pragma unroll
                        for (int n = 0; n < 2; ++n) { const f32x4 x = acc[ai][bj][m][n] * rs; ss += (x[0] * x[0] + x[1] * x[1]) + (x[2] * x[2] + x[3] * x[3]); }
                    ss += __shfl_xor(ss, 16); ss += __shfl_xor(ss, 32);
                    const float rn = rsqrtf(ss * (1.f / 64.f) + 1e-6f) * rs;
#pragma unroll
                    for (int bj = 0; bj < 2; ++bj) {
                        const f32x4 v0 = acc[ai][bj][m][0] * rn * gv[bj][0], v1 = acc[ai][bj][m][1] * rn * gv[bj][1];
                        const size_t o = (size_t)row * 512 + colg + 32 * bj;
                        if (ok) {
                            if (isq) st_bf16x8(QB + o, v0 * QK_C2, v1 * QK_C2);
                            else { st_bf16x8(KB + o, v0, v1);
                                float* f = row < MP ? out + O_KP + o : out + O_KS + (size_t)(row - MP) * 512 + colg + 32 * bj;
                                *(f32x4*)f = v0; *(f32x4*)(f + 4) = v1; }
                        }
                    }
                }
        } else {
#pragma unroll
            for (int ai = 0; ai < 2; ++ai)
#pragma unroll
                for (int m = 0; m < 4; ++m) {
                    const int row = rb + ai * HALF + m * 16; const bool ok = row < MVALID; const float rs = rs0[ok ? row : 0];
                    if (!ok) continue;
#pragma unroll
                    for (int bj = 0; bj < 2; ++bj) {
                        f32x4 v0 = acc[ai][bj][m][0] * rs, v1 = acc[ai][bj][m][1] * rs;
                        if (pn < 6) {
                            const size_t c = (size_t)(256 * (pn - 4) + c8 + 32 * bj), o = (size_t)row * 512 + c;
                            st_bf16x8(VB + o, v0, v1);
                            float* f = row < MP ? out + O_VP + o : out + O_VS + (size_t)(row - MP) * 512 + c;
                            *(f32x4*)f = v0; *(f32x4*)(f + 4) = v1;
                        } else if (pn < 13) {
                            const size_t c = (size_t)(256 * (pn - 6) + c8 + 32 * bj);
                            st_bf16x8(PC + (size_t)row * RSW + c, v0, v1);
                            if (row >= MP) { float* f = out + O_SS + (size_t)(row - MP) * RSW + c; *(f32x4*)f = v0; *(f32x4*)(f + 4) = v1; }
                            else if ((row & (SEQ - 1)) == SEQ - 1) { float* f = out + O_SP + (size_t)(row >> 12) * RSW + c; *(f32x4*)f = v0; *(f32x4*)(f + 4) = v1; }
                        } else {
                            const size_t c = (size_t)(256 * (pn - 13) + c8 + 32 * bj);
#ifndef MK_DBG_NOSIG
#pragma unroll
                            for (int j = 0; j < 4; ++j) { v0[j] = sigmoidf_(v0[j]); v1[j] = sigmoidf_(v1[j]); }
#endif
                            st_bf16x8(GT + (size_t)row * 2048 + c, v0, v1);
                        }
                    }
                }
        }
    }
};

struct EpiMerge {
    static constexpr bool PERM = true, AFTER_DRAIN = false, KEEP_ACC = true;
    const bf16_t* GT; float* tmp; bf16_t* MG;
    __device__ __forceinline__ void operator()(const f32x4 (&acc_)[2][2][4][2], const Unit& u, int wr, int wc, int fr, int fq) const {
        f32x4 (&acc)[2][2][4][2] = const_cast<f32x4 (&)[2][2][4][2]>(acc_);
        const int rb = u.pm * BM + wr * 64 + fr, cb = u.pn * BM + wc * 32 + 8 * fq;
#pragma unroll
        for (int ai = 0; ai < 2; ++ai)
#pragma unroll
            for (int m = 0; m < 4; ++m) {
                const int row = rb + ai * HALF + m * 16;
#pragma unroll
                for (int bj = 0; bj < 2; ++bj) {
                    const int col = cb + bj * HALF;
                    const u32x4 gw = *(const u32x4*)(GT + (size_t)row * 2048 + 1024 + col);
                    f32x4 g0, g1;
                    g0[0] = __builtin_bit_cast(float, gw.x << 16); g0[1] = __builtin_bit_cast(float, gw.x & 0xffff0000u); g0[2] = __builtin_bit_cast(float, gw.y << 16); g0[3] = __builtin_bit_cast(float, gw.y & 0xffff0000u);
                    g1[0] = __builtin_bit_cast(float, gw.z << 16); g1[1] = __builtin_bit_cast(float, gw.z & 0xffff0000u); g1[2] = __builtin_bit_cast(float, gw.w << 16); g1[3] = __builtin_bit_cast(float, gw.w & 0xffff0000u);
                    if (!u.z) {
                        const u32x4 hw = *(const u32x4*)(GT + (size_t)row * 2048 + col);
                        f32x4 h0, h1;
                        h0[0] = __builtin_bit_cast(float, hw.x << 16); h0[1] = __builtin_bit_cast(float, hw.x & 0xffff0000u); h0[2] = __builtin_bit_cast(float, hw.y << 16); h0[3] = __builtin_bit_cast(float, hw.y & 0xffff0000u);
                        h1[0] = __builtin_bit_cast(float, hw.z << 16); h1[1] = __builtin_bit_cast(float, hw.z & 0xffff0000u); h1[2] = __builtin_bit_cast(float, hw.w << 16); h1[3] = __builtin_bit_cast(float, hw.w & 0xffff0000u);
#pragma unroll
                        for (int e = 0; e < 4; ++e) { acc[ai][bj][m][0][e] *= h0[e] / fmaxf(g0[e], 1e-30f); acc[ai][bj][m][1][e] *= h1[e] / fmaxf(g1[e], 1e-30f); }
                    } else {
                        const f32x4 v0 = acc[ai][bj][m][0] * g0, v1 = acc[ai][bj][m][1] * g1;
                        st_bf16x8(MG + (size_t)row * 1024 + col, v0, v1);
                    }
                }
            }
    }
};
struct EpiOut {
    static constexpr bool PERM = true, AFTER_DRAIN = false, KEEP_ACC = false;
    const bf16_t* xb; bf16_t* X1B; float* ssq;
    __device__ __forceinline__ void operator()(const f32x4 (&acc)[2][2][4][2], const Unit& u, int wr, int wc, int fr, int fq) const {
        const int rb = u.pm * BM + wr * 64 + fr, cb = u.pn * BM + wc * 32 + 8 * fq;
#pragma unroll
        for (int ai = 0; ai < 2; ++ai)
#pragma unroll
            for (int m = 0; m < 4; ++m) {
                const int row = rb + ai * HALF + m * 16; float ss = 0.f;
#pragma unroll
                for (int bj = 0; bj < 2; ++bj) {
                    const size_t o = (size_t)row * 1024 + cb + bj * HALF;
                    const u32x4 xw = *(const u32x4*)(xb + o); f32x4 v0 = acc[ai][bj][m][0], v1 = acc[ai][bj][m][1];
                    v0[0] += __builtin_bit_cast(float, xw.x << 16); v0[1] += __builtin_bit_cast(float, xw.x & 0xffff0000u); v0[2] += __builtin_bit_cast(float, xw.y << 16); v0[3] += __builtin_bit_cast(float, xw.y & 0xffff0000u);
                    v1[0] += __builtin_bit_cast(float, xw.z << 16); v1[1] += __builtin_bit_cast(float, xw.z & 0xffff0000u); v1[2] += __builtin_bit_cast(float, xw.w << 16); v1[3] += __builtin_bit_cast(float, xw.w & 0xffff0000u);
                    st_bf16x8(X1B + o, v0, v1);
                    ss += (v0[0] * v0[0] + v0[1] * v0[1]) + (v0[2] * v0[2] + v0[3] * v0[3]) + (v1[0] * v1[0] + v1[1] * v1[1]) + (v1[2] * v1[2] + v1[3] * v1[3]);
                }
                ss += __shfl_xor(ss, 16); ss += __shfl_xor(ss, 32);
                if (fq == 0) atomicAdd(ssq + row, ss);
            }
    }
};
struct EpiGateUp {
    static constexpr bool PERM = true, AFTER_DRAIN = false, KEEP_ACC = false;
    const float* ssq; bf16_t* HB;
    __device__ __forceinline__ void operator()(const f32x4 (&acc)[2][2][4][2], const Unit& u, int wr, int wc, int fr, int fq) const {
        const int rb = u.pm * BM + wr * 64 + fr, cb = u.pn * HALF + wc * 32 + 8 * fq;
#pragma unroll
        for (int ai = 0; ai < 2; ++ai)
#pragma unroll
            for (int m = 0; m < 4; ++m) {
                const int row = rb + ai * HALF + m * 16; if (row >= MVALID) continue;
                const float rs = rsqrtf(ssq[row] * (1.f / 1024.f) + 1e-6f);
                f32x4 h[2];
#pragma unroll
                for (int n = 0; n < 2; ++n)
#pragma unroll
                    for (int j = 0; j < 4; ++j) { const float g = acc[ai][0][m][n][j] * rs, uu = acc[ai][1][m][n][j] * rs; h[n][j] = g * sigmoidf_(g) * uu; }
                st_bf16x8(HB + (size_t)row * FF + cb, h[0], h[1]);
            }
    }
};
struct EpiDown {
    static constexpr bool PERM = true, AFTER_DRAIN = false, KEEP_ACC = false;
    float* y; const bf16_t* X1B;
    __device__ __forceinline__ void operator()(const f32x4 (&acc)[2][2][4][2], const Unit& u, int wr, int wc, int fr, int fq) const {
        const int rb = u.pm * BM + wr * 64 + fr, cb = u.pn * BM + wc * 32 + 8 * fq;
#pragma unroll
        for (int ai = 0; ai < 2; ++ai)
#pragma unroll
            for (int m = 0; m < 4; ++m) {
                const int row = rb + ai * HALF + m * 16;
#pragma unroll
                for (int bj = 0; bj < 2; ++bj) {
                    float* p = y + (size_t)row * 1024 + cb + bj * HALF; const u32x4 xw = *(const u32x4*)(X1B + (size_t)row * 1024 + cb + bj * HALF);
                    f32x4 v0 = acc[ai][bj][m][0], v1 = acc[ai][bj][m][1];
                    v0[0] += __builtin_bit_cast(float, xw.x << 16); v0[1] += __builtin_bit_cast(float, xw.x & 0xffff0000u); v0[2] += __builtin_bit_cast(float, xw.y << 16); v0[3] += __builtin_bit_cast(float, xw.y & 0xffff0000u);
                    v1[0] += __builtin_bit_cast(float, xw.z << 16); v1[1] += __builtin_bit_cast(float, xw.z & 0xffff0000u); v1[2] += __builtin_bit_cast(float, xw.w << 16); v1[3] += __builtin_bit_cast(float, xw.w & 0xffff0000u);
                    *(f32x4*)p = v0; *(f32x4*)(p + 4) = v1;
                }
            }
    }
};
struct PairOrder {
    StaticOrder base;
    __device__ __forceinline__ bool next(int i, Unit& u) const { if (!base.next(i >> 1, u)) return false; u.z = i & 1; return true; }
    __device__ __forceinline__ void a_ready(const Unit&) const {}
    __device__ __forceinline__ void done(const Unit&) const {}
};

template <class Epi, class Sched, bool ALIGN_EPI = false, bool SP2 = false>
__device__ __forceinline__ void gemm_phase(PG8_LAS unsigned char* lds, const Gemm g, const Sched& S, const Epi& E) {
    const int tid = threadIdx.x, wid = __builtin_amdgcn_readfirstlane(tid >> 6), lane = tid & 63, wr = wid >> 2, wc = wid & 3, fr = lane & 15, fq = lane >> 4;
    const int K = g.K, nt = K / BK;
    unsigned voffA[2], voffB[2];
#pragma unroll
    for (int i = 0; i < 2; ++i) { int R, C; stage_rc(tid * 16 + i * 8192, R, C); const int Rb = Epi::PERM ? ((R & ~31) + perm32(R & 31)) : R;
        voffA[i] = (unsigned)(R * K + C) * 2u; voffB[i] = (unsigned)(Rb * K + C) * 2u; }
    const size_t kstep = (size_t)(BK * 2);
    const size_t hstep = (size_t)HALF * K * 2;
    const size_t tstep = 2 * hstep;
    const unsigned ldsw = (unsigned)wid * 1024u;
    const int aoff = lds_byte(wr * 64 + fr, fq * 8), boff = lds_byte(wc * 32 + fr, fq * 8);
#define PG8_SA(b, h) (((b) * 2 + (h)) * HTB)
#define PG8_SB(b, h) ((4 + (b) * 2 + (h)) * HTB)
#define PG8_STAGE(bufoff, gbase, voff) do { _Pragma("unroll") for (int _i = 0; _i < 2; ++_i) \
        __builtin_amdgcn_global_load_lds((const unsigned*)((const char*)(gbase) + (voff)[_i]), (PG8_LAS unsigned*)(lds + (bufoff) + ldsw + _i * 8192), 16, 0, 0); } while (0)
#define PG8_LDA(dst, b, h) do { _Pragma("unroll") for (int m = 0; m < 4; ++m) _Pragma("unroll") for (int k = 0; k < 2; ++k) dst[m][k] = *(const PG8_LAS bf16x8*)(lds + PG8_SA(b, h) + aoff + m * 2048 + k * 1024); } while (0)
#define PG8_LDB(dst, b, h) do { _Pragma("unroll") for (int n = 0; n < 2; ++n) _Pragma("unroll") for (int k = 0; k < 2; ++k) dst[n][k] = *(const PG8_LAS bf16x8*)(lds + PG8_SB(b, h) + boff + n * 2048 + k * 1024); } while (0)
#define PG8_MMA(ai, bj, At, Bt) do { __builtin_amdgcn_s_setprio(1); _Pragma("unroll") for (int m = 0; m < 4; ++m) _Pragma("unroll") for (int n = 0; n < 2; ++n) _Pragma("unroll") for (int k = 0; k < 2; ++k) \
        acc[ai][bj][m][n] = __builtin_amdgcn_mfma_f32_16x16x32_bf16(Bt[n][k], At[m][k], acc[ai][bj][m][n], 0, 0, 0); __builtin_amdgcn_s_setprio(0); } while (0)
#define PG8_WAIT_V(n) asm volatile("s_waitcnt vmcnt(" #n ")" ::: "memory")
#define PG8_WAIT_L(n) asm volatile("s_waitcnt lgkmcnt(" #n ")" ::: "memory")
#define PG8_BAR __builtin_amdgcn_s_barrier()
#define PG8_SCHED __builtin_amdgcn_sched_barrier(0)
    Unit cur, nxt; int ui = 0;
    if (!S.next(0, cur)) return;
    f32x4 acc[2][2][4][2];
#pragma unroll
    for (int a = 0; a < 2; ++a)
#pragma unroll
        for (int b = 0; b < 2; ++b)
#pragma unroll
            for (int m = 0; m < 4; ++m)
#pragma unroll
                for (int n = 0; n < 2; ++n) acc[a][b][m][n] = (f32x4){0.f, 0.f, 0.f, 0.f};
    bf16x8 At[4][2], B0[2][2], B1[2][2];
    const char* cA = (const char*)(cur.z ? g.A2 : g.A) + (size_t)cur.pm * tstep; const char* cB = (const char*)(cur.z ? g.Bt2 : g.Bt) + (size_t)cur.pn * tstep;
    S.a_ready(cur);
    if constexpr (SP2) {
        PG8_STAGE(PG8_SB(0, 0), cB, voffB); PG8_STAGE(PG8_SB(0, 1), cB + hstep, voffB); PG8_STAGE(PG8_SA(0, 0), cA, voffA); PG8_STAGE(PG8_SA(0, 1), cA + hstep, voffA);
        if (wr == 1) PG8_BAR;
        PG8_WAIT_V(2); PG8_BAR;
        PG8_STAGE(PG8_SB(1, 0), cB + kstep, voffB); PG8_STAGE(PG8_SA(1, 0), cA + kstep, voffA); PG8_STAGE(PG8_SB(1, 1), cB + hstep + kstep, voffB);
        PG8_WAIT_V(6); PG8_BAR;
    } else {
        PG8_STAGE(PG8_SB(0, 0), cB, voffB); PG8_STAGE(PG8_SA(0, 0), cA, voffA); PG8_STAGE(PG8_SB(0, 1), cB + hstep, voffB); PG8_STAGE(PG8_SA(0, 1), cA + hstep, voffA);
        if (wr == 1) PG8_BAR;
        PG8_WAIT_V(4); PG8_BAR;
        PG8_STAGE(PG8_SB(1, 0), cB + kstep, voffB); PG8_STAGE(PG8_SA(1, 0), cA + kstep, voffA); PG8_STAGE(PG8_SB(1, 1), cB + hstep + kstep, voffB);
        PG8_WAIT_V(6); PG8_BAR;
    }
    for (;;) {
        const bool has_next = S.next(ui + 1, nxt);
        const char* nA = has_next ? (const char*)(nxt.z ? g.A2 : g.A) + (size_t)nxt.pm * tstep : cA; const char* nB = has_next ? (const char*)(nxt.z ? g.Bt2 : g.Bt) + (size_t)nxt.pn * tstep : cB;
        for (int t = 0; t < nt; t += 2) {
            const bool last = (t == nt - 2);
            const char* a1 = cA + (size_t)(t + 1) * kstep;
            const char* a2 = last ? nA : cA + (size_t)(t + 2) * kstep; const char* b2 = last ? nB : cB + (size_t)(t + 2) * kstep;
            const char* a3 = a2 + kstep; const char* b3 = b2 + kstep;
            if (last && has_next) S.a_ready(nxt);
            if constexpr (SP2) {
            PG8_LDB(B0, 0, 0); PG8_LDB(B1, 0, 1); PG8_SCHED; PG8_LDA(At, 0, 0); PG8_STAGE(PG8_SA(1, 1), a1 + hstep, voffA);
            PG8_WAIT_V(8); PG8_WAIT_L(0); PG8_BAR; PG8_MMA(0, 0, At, B0); PG8_MMA(0, 1, At, B1); PG8_BAR; PG8_SCHED;
            PG8_LDA(At, 0, 1); PG8_STAGE(PG8_SB(0, 0), b2, voffB); PG8_STAGE(PG8_SB(0, 1), b2 + hstep, voffB); PG8_STAGE(PG8_SA(0, 0), a2, voffA);
            PG8_WAIT_V(8); PG8_WAIT_L(0); PG8_BAR; PG8_MMA(1, 0, At, B0); PG8_MMA(1, 1, At, B1); PG8_BAR; PG8_SCHED;
            PG8_LDB(B0, 1, 0); PG8_LDB(B1, 1, 1); PG8_SCHED; PG8_LDA(At, 1, 0); PG8_STAGE(PG8_SA(0, 1), a2 + hstep, voffA);
            PG8_WAIT_V(8); PG8_WAIT_L(0); PG8_BAR; PG8_MMA(0, 0, At, B0); PG8_MMA(0, 1, At, B1); PG8_BAR; PG8_SCHED;
            PG8_LDA(At, 1, 1); PG8_STAGE(PG8_SB(1, 0), b3, voffB); PG8_STAGE(PG8_SB(1, 1), b3 + hstep, voffB); PG8_STAGE(PG8_SA(1, 0), a3, voffA);
            PG8_WAIT_V(8); PG8_WAIT_L(0); PG8_BAR; PG8_MMA(1, 0, At, B0); PG8_MMA(1, 1, At, B1); PG8_BAR; PG8_SCHED;
            } else {
            PG8_LDB(B0, 0, 0); PG8_SCHED; PG8_LDA(At, 0, 0); PG8_STAGE(PG8_SA(1, 1), a1 + hstep, voffA);
            PG8_WAIT_L(8); PG8_BAR; PG8_WAIT_L(0); PG8_MMA(0, 0, At, B0); PG8_BAR; PG8_SCHED;
            PG8_LDB(B1, 0, 1); PG8_STAGE(PG8_SB(0, 0), b2, voffB);
            PG8_BAR; PG8_WAIT_L(0); PG8_MMA(0, 1, At, B1); PG8_BAR;
            PG8_LDA(At, 0, 1); PG8_STAGE(PG8_SA(0, 0), a2, voffA);
            PG8_BAR; PG8_WAIT_L(0); PG8_MMA(1, 0, At, B0); PG8_BAR; PG8_SCHED;
            PG8_STAGE(PG8_SB(0, 1), b2 + hstep, voffB);
            PG8_WAIT_V(6); PG8_BAR; PG8_MMA(1, 1, At, B1); PG8_BAR;
            PG8_LDB(B0, 1, 0); PG8_SCHED; PG8_LDA(At, 1, 0); PG8_STAGE(PG8_SA(0, 1), a2 + hstep, voffA);
            PG8_WAIT_L(8); PG8_BAR; PG8_WAIT_L(0); PG8_MMA(0, 0, At, B0); PG8_BAR; PG8_SCHED;
            PG8_LDB(B1, 1, 1); PG8_STAGE(PG8_SB(1, 0), b3, voffB);
            PG8_BAR; PG8_WAIT_L(0); PG8_MMA(0, 1, At, B1); PG8_BAR;
            PG8_LDA(At, 1, 1); PG8_STAGE(PG8_SA(1, 0), a3, voffA);
            PG8_BAR; PG8_WAIT_L(0); PG8_MMA(1, 0, At, B0); PG8_BAR; PG8_SCHED;
            PG8_STAGE(PG8_SB(1, 1), b3 + hstep, voffB);
            PG8_WAIT_V(6); PG8_BAR; PG8_MMA(1, 1, At, B1); PG8_BAR;
            }
        }
        if constexpr (ALIGN_EPI) { if (wr == 0) PG8_BAR; }
        if constexpr (!Epi::AFTER_DRAIN) { E(acc, cur, wr, wc, fr, fq); S.done(cur); }
        if (!has_next) break;
        if (!(Epi::KEEP_ACC && cur.z == 0)) {
#pragma unroll
        for (int a = 0; a < 2; ++a)
#pragma unroll
            for (int b = 0; b < 2; ++b)
#pragma unroll
                for (int m = 0; m < 4; ++m)
#pragma unroll
                    for (int n = 0; n < 2; ++n) acc[a][b][m][n] = (f32x4){0.f, 0.f, 0.f, 0.f};
        }
        cur = nxt; cA = nA; cB = nB; ++ui;
        if constexpr (ALIGN_EPI) { if (wr == 1) PG8_BAR; }
    }
    PG8_WAIT_V(0);
    if constexpr (!ALIGN_EPI) { if (wr == 0) PG8_BAR; }
    PG8_BAR;
    if constexpr (Epi::AFTER_DRAIN) { E.fused(acc, cur, wr, wc, fr, fq, lds, wid, lane); S.done(cur); }
#undef PG8_SA
#undef PG8_SB
#undef PG8_STAGE
#undef PG8_LDA
#undef PG8_LDB
#undef PG8_MMA
#undef PG8_WAIT_V
#undef PG8_WAIT_L
#undef PG8_BAR
#undef PG8_SCHED
}
}

constexpr size_t MiB = 1u << 20;
constexpr size_t WS_CTL = 0, CTL_ZERO_BYTES = 1 * MiB;
constexpr size_t WS_WIN = 2 * MiB, WS_WPA = 13 * MiB, WS_WPB = 14 * MiB, WS_WOUT = 15 * MiB, WS_WGU = 17 * MiB, WS_WDN = 28 * MiB;
constexpr size_t WS_LORA = 28 * MiB + (size_t)DM * FF * 2;
static_assert(WS_LORA + 262144 <= 34 * MiB, "lora map");
constexpr size_t WS_XB = 34 * MiB, WS_RS0 = 67 * MiB, WS_QB = 68 * MiB, WS_KB = 85 * MiB, WS_VB = 102 * MiB, WS_PC = 119 * MiB, WS_GT = 176 * MiB;
constexpr size_t WS_ON = 241 * MiB, WS_RW = 258 * MiB, WS_MG = 275 * MiB, WS_TMP = 308 * MiB, WS_X1B = 373 * MiB, WS_HB = 406 * MiB;
constexpr size_t WS_RK = 496 * MiB, RK_STRIDE = 33 * MiB;
constexpr size_t WS_BON = 728 * MiB, WS_DP = 729 * MiB;
constexpr size_t WS_BON3 = 736 * MiB, WS_Y0 = 740 * MiB, WS_CC = 773 * MiB, WS_PSI = 806 * MiB, WS_PHI = 810 * MiB, WS_SST = 814 * MiB, WS_DP2 = 818 * MiB;
constexpr size_t WS_SC = 830 * MiB, WS_RH = 912 * MiB, WS_GP = 928 * MiB, WS_XC = 944 * MiB, WS_YL = 960 * MiB, WS_SL = 992 * MiB, WS_GC = 1024 * MiB, WS_HT = 1025 * MiB, WS_END = 1026 * MiB;
static_assert(WS_WIN + (size_t)INW * DM * 2 <= WS_WPA && WS_WGU + (size_t)NGU * DM * 2 <= WS_WDN && WS_WDN + (size_t)DM * FF * 2 <= WS_XB, "weights map");
static_assert(WS_XB + (size_t)MTOT * DM * 2 <= WS_RS0 && WS_QB + (size_t)MTOT * 512 * 2 <= WS_KB && WS_PC + (size_t)MTOT * RSW * 2 <= WS_GT && WS_GT + (size_t)MTOT * 2048 * 2 <= WS_ON, "act map 1");
static_assert(WS_MG + (size_t)MTOT * DM * 2 <= WS_TMP && WS_TMP + (size_t)MTOT * DM * 4 <= WS_X1B && WS_X1B + (size_t)MTOT * DM * 2 <= WS_HB && WS_HB + (size_t)MTOT * FF * 2 <= WS_RK, "act map 2");
static_assert((size_t)MTOT * 512 * 4 <= RK_STRIDE && WS_RK + 7 * RK_STRIDE <= WS_BON, "rwkv map");
constexpr int CW_TMO = 0, CW_CODE = 1;
constexpr int CW_BAR = 4096;
constexpr int CW_SSQ = 32768;
constexpr int CW_QUEUE = 2048;
constexpr int CW_QDEC = 2112;
constexpr int CW_DCNT = 65536;
static_assert((CW_DCNT + 128 * 64) * 4 <= (int)CTL_ZERO_BYTES, "CTL map");

constexpr int RING_OFF = 0, RING_BYTES = 139264;
constexpr int LDSCTL_OFF = RING_BYTES, MISC_OFF = LDSCTL_OFF + 320;
constexpr int LDS_BYTES = 155648;
constexpr int NWAVES = 8;

#define GAS __attribute__((address_space(1)))
#define LAS __attribute__((address_space(3)))
typedef unsigned short bf16;
typedef unsigned v4u __attribute__((ext_vector_type(4)));
typedef unsigned v2u __attribute__((ext_vector_type(2)));
typedef float f32x4 __attribute__((ext_vector_type(4)));
typedef float f32x2 __attribute__((ext_vector_type(2)));
typedef float f32x16 __attribute__((ext_vector_type(16)));
typedef short bf16x8 __attribute__((ext_vector_type(8)));
typedef short s16x4 __attribute__((ext_vector_type(4)));
typedef GAS unsigned gu32;
#define RLX_AGENT __ATOMIC_RELAXED, __HIP_MEMORY_SCOPE_AGENT
#define LDS_WAIT() asm volatile("s_waitcnt lgkmcnt(0)" ::: "memory")
#define VM_WAIT() asm volatile("s_waitcnt vmcnt(0)" ::: "memory")
__device__ __forceinline__ unsigned pk2(float lo, float hi) { return pg8::cvt_pk_bf16(lo, hi); }
using pg8::sigmoidf_;
__device__ __forceinline__ float bf2f(unsigned short b) { return __builtin_bit_cast(float, (unsigned)b << 16); }
__device__ __forceinline__ float bflo(unsigned w) { return __builtin_bit_cast(float, w << 16); }
__device__ __forceinline__ float bfhi(unsigned w) { return __builtin_bit_cast(float, w & 0xffff0000u); }

#define XB_TMO      128
#define XB_XCNT(j)  (256  + 64 * (j))
#define XB_XSUB(j)  (1280 + 64 * (j))
#define XB_XGEN(j)  (2304 + 64 * (j))
#define XB_TOP      3328
#define XB_TOPGEN   3392
#define XCD_BAR_WORDS 3456
#define XB_SPIN_CAP (1u << 18)

__device__ __forceinline__ unsigned xb_ld(unsigned* p)              { return __hip_atomic_load(p, __ATOMIC_RELAXED, __HIP_MEMORY_SCOPE_AGENT); }
__device__ __forceinline__ unsigned xb_add(unsigned* p, unsigned v) { return __hip_atomic_fetch_add(p, v, __ATOMIC_RELAXED, __HIP_MEMORY_SCOPE_AGENT); }
__device__ __forceinline__ unsigned xb_xcc_id() { return (unsigned)__builtin_amdgcn_s_getreg((3 << 11) | 20) & 0xFu; }
#define XB_SPIN(cond, bar) do { unsigned _sp = 0; while (cond) { __builtin_amdgcn_s_sleep(1); \
    if ((++_sp & 255u) == 0u) { if (xb_ld(&(bar)[XB_TMO])) break; if (_sp > XB_SPIN_CAP) { atomicAdd(&(bar)[XB_TMO], 1u); break; } } } } while (0)

struct XcdBarrier {
    unsigned* bar; unsigned x;
    volatile LAS unsigned* st;
};

__device__ __forceinline__ XcdBarrier xcd_barrier_post(unsigned* bar, volatile LAS unsigned* st) {
    XcdBarrier b; b.bar = bar; b.x = xb_xcc_id(); b.st = st;
    if (threadIdx.x == 0) (void)xb_add(&bar[XB_XCNT(b.x)], 1u);
    return b;
}
__device__ __forceinline__ void xcd_barrier_complete(unsigned* bar, unsigned x, unsigned& nloc, unsigned& nx) {
    const unsigned G = gridDim.x * gridDim.y * gridDim.z;
    unsigned sum, cnt, mine, sp = 0u;
    for (;;) {
        sum = 0u; cnt = 0u; mine = 0u;
#pragma unroll
        for (unsigned j = 0; j < 16; ++j) { const unsigned c = xb_ld(&bar[XB_XCNT(j)]); sum += c; cnt += (c > 0u) ? 1u : 0u; mine = (j == x) ? c : mine; }
        if (sum == G) break;
        __builtin_amdgcn_s_sleep(1);
        if ((++sp & 255u) == 0u) { if (xb_ld(&bar[XB_TMO])) break; if (sp > XB_SPIN_CAP) { atomicAdd(&bar[XB_TMO], 1u); break; } }
    }
    nloc = mine > 0u ? mine : 1u; nx = cnt > 0u ? cnt : 1u;
}

__device__ __forceinline__ void xcd_barrier(const XcdBarrier& b) {
    asm volatile("s_waitcnt vmcnt(0)" ::: "memory");
    __syncthreads();
    if (threadIdx.x == 0) {
        unsigned* bar = b.bar;
        __builtin_amdgcn_s_waitcnt(0);
        unsigned nloc = b.st[0], nx = b.st[1];
        if (nloc == 0u) { xcd_barrier_complete(bar, b.x, nloc, nx); b.st[0] = nloc; b.st[1] = nx; }
        const unsigned old = xb_add(&bar[XB_XSUB(b.x)], 1u);
        const unsigned gen = old / nloc;
        if (old + 1u == (gen + 1u) * nloc) {
            __builtin_amdgcn_fence(__ATOMIC_RELEASE, "agent");
            asm volatile("s_waitcnt vmcnt(0)" ::: "memory");
            const unsigned og = xb_add(&bar[XB_TOP], 1u);
            const unsigned tg = og / nx;
            if (og + 1u == (tg + 1u) * nx) xb_add(&bar[XB_TOPGEN], 1u);
            else XB_SPIN(xb_ld(&bar[XB_TOPGEN]) == tg, bar);
            __builtin_amdgcn_fence(__ATOMIC_ACQUIRE, "agent");
            xb_add(&bar[XB_XGEN(b.x)], 1u);
            asm volatile("s_waitcnt vmcnt(0)" ::: "memory");
        } else {
            XB_SPIN(xb_ld(&bar[XB_XGEN(b.x)]) == gen, bar);
            __builtin_amdgcn_fence(__ATOMIC_ACQUIRE, "agent");
            asm volatile("s_waitcnt vmcnt(0)" ::: "memory");
        }
    }
    __syncthreads();
}

struct Args { const float* in[34]; float* out; unsigned char* ws; int ph_lo, ph_hi, li, pad; };
struct Frame {
    LAS unsigned char* lds;
    volatile LAS unsigned* MISC;
    gu32* ctl;
    int tid, lane, wave, vcu, G;
    unsigned char* ws; float* out;
#ifdef MK_SUB
    unsigned long long pa, pb;
#endif
};
#ifdef MK_SUB
#define SUBM(k) do { if (MK_SUB == (k)) F.pa = __builtin_amdgcn_s_memrealtime(); if (MK_SUB + 1 == (k)) F.pb = __builtin_amdgcn_s_memrealtime(); } while (0)
#else
#define SUBM(k) do { } while (0)
#endif
enum { I_XP = 0, I_XS, I_CK, I_CV, I_PT, I_SWKV, I_SSH, I_NMIX, I_WIN, I_QG, I_KG, I_LQ1, I_LK1, I_LQ2, I_LK2, I_AOG, I_WPA, I_MU, I_W0, I_W2, I_A0, I_A2, I_G2,
       I_KK, I_KA, I_RK, I_GNW, I_GNB, I_WPB, I_WOUT, I_NFFN, I_WG, I_WU, I_WD };

__device__ __forceinline__ float wave_sum(float v) {
#pragma unroll
    for (int o = 1; o < 64; o <<= 1) v += __shfl_xor(v, o);
    return v;
}

__device__ __forceinline__ float dpp_rmir(float v) { return __builtin_bit_cast(float, __builtin_amdgcn_update_dpp(0, __builtin_bit_cast(int, v), 0x140, 0xF, 0xF, true)); }
__device__ __forceinline__ float sum32(float v) {
    v += __builtin_bit_cast(float, __builtin_amdgcn_update_dpp(0, __builtin_bit_cast(int, v), 0xB1, 0xF, 0xF, true));
    v += __builtin_bit_cast(float, __builtin_amdgcn_update_dpp(0, __builtin_bit_cast(int, v), 0x4E, 0xF, 0xF, true));
    v += __builtin_bit_cast(float, __builtin_amdgcn_update_dpp(0, __builtin_bit_cast(int, v), 0x141, 0xF, 0xF, true));
    v += dpp_rmir(v);
    v += __shfl_xor(v, 16);
    return v;
}
__device__ __forceinline__ void p0_transpose_item(const float* W, int K, int N, bf16* WT, int drow0, const float* kgain, LAS float* scr, int k0, int n0, int lane) {
    float v[32];
    const float* wp = W + (size_t)(k0 + (lane >> 5)) * N + n0 + (lane & 31);
#pragma unroll
    for (int i = 0; i < 32; ++i) v[i] = wp[(size_t)(2 * i) * N];
    const int c = lane & 7;
    f32x4 g0 = {1.f, 1.f, 1.f, 1.f}, g1 = g0;
    if (kgain) { g0 = *(const f32x4*)(kgain + k0 + 8 * c); g1 = *(const f32x4*)(kgain + k0 + 8 * c + 4); }
#pragma unroll
    for (int i = 0; i < 32; ++i) scr[(2 * i + (lane >> 5)) * 33 + (lane & 31)] = v[i];
    LDS_WAIT(); asm volatile("" ::: "memory");
#pragma unroll
    for (int j = 0; j < 4; ++j) { const int n = (lane >> 3) + 8 * j; const LAS float* s = scr + (8 * c) * 33 + n;
        v4u o; o.x = pk2(s[0 * 33] * g0[0], s[1 * 33] * g0[1]); o.y = pk2(s[2 * 33] * g0[2], s[3 * 33] * g0[3]); o.z = pk2(s[4 * 33] * g1[0], s[5 * 33] * g1[1]); o.w = pk2(s[6 * 33] * g1[2], s[7 * 33] * g1[3]);
        *(GAS v4u*)(WT + (size_t)(drow0 + n) * K + k0 + 8 * c) = o; }
    LDS_WAIT(); asm volatile("" ::: "memory");
}
template <int PART> __device__ __forceinline__ void p0_prologue(Frame& F, const Args& A, int gw, int NGW) {
    LAS float* scr = (LAS float*)(F.lds + RING_OFF + F.wave * 16384);
    bf16* Win_t = (bf16*)(F.ws + WS_WIN); bf16* Wpa_t = (bf16*)(F.ws + WS_WPA); bf16* Wpb_t = (bf16*)(F.ws + WS_WPB); bf16* Wout_t = (bf16*)(F.ws + WS_WOUT);
    bf16* Wgu_t = (bf16*)(F.ws + WS_WGU); bf16* Wdn_t = (bf16*)(F.ws + WS_WDN);
    constexpr int I_IN = (DM / 64) * (INW / 32), I_PA = (512 / 64) * (DM / 32), I_OUT = (DM / 64) * (DM / 32), I_G = (DM / 64) * (FF / 32), I_D = (FF / 64) * (DM / 32);
    constexpr int I_L = 16, NITEMS = I_IN + 2 * I_PA + I_OUT + 2 * I_G + I_D + 4 * I_L;
    constexpr int NP0 = I_IN + 4 * I_L, NP1 = NITEMS - NP0;
    for (int ix = gw; ix < (PART == 0 ? NP0 : NP1); ix += NGW) {
        int r = PART == 0 ? (ix < I_IN ? ix : ix - I_IN + (NITEMS - 4 * I_L)) : ix + I_IN;
        if (r < I_IN) { constexpr int nnb = INW / 32; const int kb = r / nnb, nb = r % nnb, pn = nb >> 3, q = nb & 7;
            p0_transpose_item(A.in[I_WIN], DM, INW, Win_t, 256 * pn + 32 * (4 * (q & 1) + (q >> 1)), A.in[I_NMIX], scr, 64 * kb, 32 * nb, F.lane); continue; } r -= I_IN;
        if (r < I_PA) { constexpr int nnb = DM / 32; const int kb = r / nnb, nb = r % nnb; p0_transpose_item(A.in[I_WPA], 512, DM, Wpa_t, 32 * nb, nullptr, scr, 64 * kb, 32 * nb, F.lane); continue; } r -= I_PA;
        if (r < I_PA) { constexpr int nnb = DM / 32; const int kb = r / nnb, nb = r % nnb; p0_transpose_item(A.in[I_WPB], 512, DM, Wpb_t, 32 * nb, nullptr, scr, 64 * kb, 32 * nb, F.lane); continue; } r -= I_PA;
        if (r < I_OUT) { constexpr int nnb = DM / 32; const int kb = r / nnb, nb = r % nnb; p0_transpose_item(A.in[I_WOUT], DM, DM, Wout_t, 32 * nb, nullptr, scr, 64 * kb, 32 * nb, F.lane); continue; } r -= I_OUT;
        if (r < I_G) { constexpr int nnb = FF / 32; const int kb = r / nnb, nb = r % nnb;
            p0_transpose_item(A.in[I_WG], DM, FF, Wgu_t, 256 * (nb >> 2) + 32 * (nb & 3), A.in[I_NFFN], scr, 64 * kb, 32 * nb, F.lane); continue; } r -= I_G;
        if (r < I_G) { constexpr int nnb = FF / 32; const int kb = r / nnb, nb = r % nnb;
            p0_transpose_item(A.in[I_WU], DM, FF, Wgu_t, 256 * (nb >> 2) + 128 + 32 * (nb & 3), A.in[I_NFFN], scr, 64 * kb, 32 * nb, F.lane); continue; } r -= I_G;
        if (r < I_D) { constexpr int nnb = DM / 32; const int kb = r / nnb, nb = r % nnb; p0_transpose_item(A.in[I_WD], FF, DM, Wdn_t, 32 * nb, nullptr, scr, 64 * kb, 32 * nb, F.lane); continue; } r -= I_D;
        { bf16* W2T = (bf16*)(F.ws + WS_LORA); bf16* A2T = W2T + 512 * 64; bf16* G2T = A2T + 512 * 64;
          if (r < I_L) p0_transpose_item(A.in[I_W2], 64, 512, W2T, 32 * r, nullptr, scr, 0, 32 * r, F.lane);
          else if (r < 2 * I_L) p0_transpose_item(A.in[I_A2], 64, 512, A2T, 32 * (r - I_L), nullptr, scr, 0, 32 * (r - I_L), F.lane);
          else { const int q = r - 2 * I_L; p0_transpose_item(A.in[I_G2], 128, 512, G2T, 32 * (q & 15), nullptr, scr, 64 * (q >> 4), 32 * (q & 15), F.lane); } }
    }
    if (PART != 0) return;
    bf16* XB = (bf16*)(F.ws + WS_XB); float* rs0 = (float*)(F.ws + WS_RS0);
    for (int m0 = gw; m0 < MTOT; m0 += 8 * NGW) {
        f32x4 v[8][4];
#pragma unroll
        for (int q = 0; q < 8; ++q) { const int m = m0 + q * NGW;
            if (m < MVALID) { const float* xrow = m < MP ? A.in[I_XP] + (size_t)m * DM : A.in[I_XS] + (size_t)(m - MP) * DM; const GAS f32x4* xr = (const GAS f32x4*)xrow + F.lane;
#pragma unroll
                for (int j = 0; j < 4; ++j) v[q][j] = xr[64 * j]; }
            else {
#pragma unroll
                for (int j = 0; j < 4; ++j) v[q][j] = (f32x4){0.f, 0.f, 0.f, 0.f}; } }
#pragma unroll
        for (int q = 0; q < 8; ++q) { const int m = m0 + q * NGW; if (m >= MTOT) continue;
            GAS unsigned long long* o8 = (GAS unsigned long long*)(XB + (size_t)m * DM) + F.lane; float s = 0.f;
#pragma unroll
            for (int j = 0; j < 4; ++j) { s += (v[q][j].x * v[q][j].x + v[q][j].y * v[q][j].y) + (v[q][j].z * v[q][j].z + v[q][j].w * v[q][j].w);
                o8[64 * j] = (unsigned long long)pk2(v[q][j].x, v[q][j].y) | ((unsigned long long)pk2(v[q][j].z, v[q][j].w) << 32); }
            s = sum32(s); { const auto rr = __builtin_amdgcn_permlane32_swap(__float_as_uint(s), __float_as_uint(s), false, false); s = __uint_as_float(rr[0]) + __uint_as_float(rr[1]); }
            if (F.lane == 0) rs0[m] = m < MVALID ? rsqrtf(s * (1.f / DM) + 1e-6f) : 0.f; }
    }
}

__device__ __forceinline__ int crow16(int r, int hi) { return (r & 3) + 8 * (r >> 2) + 4 * hi; }
__device__ __forceinline__ float lam_value(const Frame& F, const Args& A) {
    const int l = F.lane;
    const float a = wave_sum(A.in[I_LQ1][l] * A.in[I_LK1][l]), b = wave_sum(A.in[I_LQ2][l] * A.in[I_LK2][l]);
    return __expf(a) - __expf(b) + 0.2f;
}
__device__ __forceinline__ f32x4 ld_bf4(const bf16* p) { const v2u w = *(const v2u*)p; return (f32x4){bflo(w.x), bfhi(w.x), bflo(w.y), bfhi(w.y)}; }
__device__ __forceinline__ unsigned* rk_pair(const Frame& F, int i) { return (unsigned*)(F.ws + WS_RK + (size_t)i * RK_STRIDE); }
__device__ __forceinline__ bf16* rk_bf(const Frame& F, int i) { return (bf16*)(F.ws + WS_RK + (size_t)i * RK_STRIDE); }
__device__ __forceinline__ float* rk_arr(const Frame& F, int i) { return (float*)(F.ws + WS_RK + (size_t)i * RK_STRIDE); }

#define CRC(r) (((r) & 3) + 8 * ((r) >> 2))
constexpr int LIN_LD = 264, MS_LD = 1544;
__device__ __forceinline__ float tanh_fast(float x) { return 1.f - 2.f * __builtin_amdgcn_rcpf(1.f + __expf(2.f * x)); }
__device__ __forceinline__ void rwkv_prep_unit(Frame& F, const Args& A, int unit) {
    LAS bf16* msl = (LAS bf16*)(F.lds + RING_OFF);
    LAS bf16* lin = msl + 32 * MS_LD;
    const bf16* PC = (const bf16*)(F.ws + WS_PC);
    int r32_ = F.lane & 31, hi_ = F.lane >> 5; asm volatile("" : "+v"(r32_), "+v"(hi_));
    const int r0 = unit * 32, tid = F.tid, lane = F.lane, w = F.wave, r32 = r32_, hi = hi_;
    const float* mu = A.in[I_MU]; const float* ssh = A.in[I_SSH];
    const bool samp = unit >= MP / 32;
#pragma unroll 7
    for (int k = 0; k < 14; ++k) {
        const int p = tid + 512 * k, t = p / 224, c8 = p - 224 * t, row = r0 + t;
        const v4u cw = *(const v4u*)(PC + (size_t)row * RSW + 8 * c8);
        float cur[8] = {bflo(cw.x), bfhi(cw.x), bflo(cw.y), bfhi(cw.y), bflo(cw.z), bfhi(cw.z), bflo(cw.w), bfhi(cw.w)}, prv[8];
        if (samp) { const f32x4 a = *(const f32x4*)(ssh + (size_t)(row - MP) * RSW + 8 * c8), b = *(const f32x4*)(ssh + (size_t)(row - MP) * RSW + 8 * c8 + 4);
#pragma unroll
            for (int j = 0; j < 4; ++j) { prv[j] = a[j]; prv[4 + j] = b[j]; } }
        else { const bool first = (row & (SEQ - 1)) == 0;
            const v4u pw = *(const v4u*)(PC + (size_t)(first ? row : row - 1) * RSW + 8 * c8);
            prv[0] = bflo(pw.x); prv[1] = bfhi(pw.x); prv[2] = bflo(pw.y); prv[3] = bfhi(pw.y); prv[4] = bflo(pw.z); prv[5] = bfhi(pw.z); prv[6] = bflo(pw.w); prv[7] = bfhi(pw.w);
#pragma unroll
            for (int j = 0; j < 8; ++j) prv[j] = first ? 0.f : prv[j]; }
        const f32x4 m0 = *(const f32x4*)(mu + 8 * c8), m1 = *(const f32x4*)(mu + 8 * c8 + 4);
        float m[8];
#pragma unroll
        for (int j = 0; j < 4; ++j) { m[j] = cur[j] + (prv[j] - cur[j]) * m0[j]; m[4 + j] = cur[4 + j] + (prv[4 + j] - cur[4 + j]) * m1[j]; }
        if (c8 >= 192) { const int ci = 8 * (c8 - 192);
#pragma unroll
            for (int j = 0; j < 8; ++j) { if (ci < 64) m[j] = tanh_fast(m[j]); else if (ci >= 128) m[j] = sigmoidf_(m[j]); }
            *(LAS v4u*)(lin + t * LIN_LD + ci) = (v4u){pk2(m[0], m[1]), pk2(m[2], m[3]), pk2(m[4], m[5]), pk2(m[6], m[7])}; }
        else *(LAS v4u*)(msl + t * MS_LD + 8 * c8) = (v4u){pk2(m[0], m[1]), pk2(m[2], m[3]), pk2(m[4], m[5]), pk2(m[6], m[7])};
    }
    __syncthreads();
    f32x16 wl[2], al[2], gg[2];
    const bf16* W2T = (const bf16*)(F.ws + WS_LORA); const bf16* A2T = W2T + 512 * 64; const bf16* G2T = A2T + 512 * 64;
#pragma unroll
    for (int ct = 0; ct < 2; ++ct) {
        const int ch = 64 * w + 2 * r32 + ct;
        f32x16 a0 = (f32x16){}, a1 = (f32x16){}, a2 = (f32x16){};
#pragma unroll
        for (int ks = 0; ks < 4; ++ks) {
            const bf16x8 x0 = *(const LAS bf16x8*)(lin + r32 * LIN_LD + 16 * ks + 8 * hi), x1 = *(const LAS bf16x8*)(lin + r32 * LIN_LD + 64 + 16 * ks + 8 * hi);
            const bf16x8 b0 = *(const bf16x8*)(W2T + (size_t)ch * 64 + 16 * ks + 8 * hi), b1 = *(const bf16x8*)(A2T + (size_t)ch * 64 + 16 * ks + 8 * hi);
            a0 = __builtin_amdgcn_mfma_f32_32x32x16_bf16(x0, b0, a0, 0, 0, 0); a1 = __builtin_amdgcn_mfma_f32_32x32x16_bf16(x1, b1, a1, 0, 0, 0);
        }
#pragma unroll
        for (int ks = 0; ks < 8; ++ks) {
            const bf16x8 x2 = *(const LAS bf16x8*)(lin + r32 * LIN_LD + 128 + 16 * ks + 8 * hi);
            const bf16x8 b2 = *(const bf16x8*)(G2T + (size_t)ch * 128 + 16 * ks + 8 * hi);
            a2 = __builtin_amdgcn_mfma_f32_32x32x16_bf16(x2, b2, a2, 0, 0, 0);
        }
        wl[ct] = a0; al[ct] = a1; gg[ct] = a2;
    }
    bf16* aR = rk_bf(F, 0); float* aW = rk_arr(F, 1); bf16* aK = rk_bf(F, 2); bf16* aV = rk_bf(F, 3); bf16* aA = rk_bf(F, 4); bf16* aB = rk_bf(F, 5); bf16* aG = rk_bf(F, 6);
    float* BON = (float*)(F.ws + WS_BON3);
    float w0c[2], a0c[2], kkc[2], kac[2], rkc[2];
#pragma unroll
    for (int ct = 0; ct < 2; ++ct) { const int ch = 64 * w + 2 * r32 + ct; w0c[ct] = A.in[I_W0][ch]; a0c[ct] = A.in[I_A0][ch]; kkc[ct] = A.in[I_KK][ch]; kac[ct] = A.in[I_KA][ch]; rkc[ct] = A.in[I_RK][ch]; }
    if (unit < MP / 32) {
        float lwv[2][16], pin[2][16], off[2];
        int r32o = r32; asm volatile("" : "+v"(r32o));
#pragma unroll
        for (int ct = 0; ct < 2; ++ct)
#pragma unroll
            for (int r = 0; r < 16; ++r) { const float x = -(w0c[ct] + wl[ct][r]), sp = fmaxf(x, 0.f) + __logf(1.f + __expf(-fabsf(x))); lwv[ct][r] = -__expf(-sp - 0.5f); }
#pragma unroll
        for (int ct = 0; ct < 2; ++ct) { float run = 0.f;
#pragma unroll
            for (int q = 0; q < 4; ++q) { const float c0 = lwv[ct][4 * q], c1 = c0 + lwv[ct][4 * q + 1], c2 = c1 + lwv[ct][4 * q + 2], c3 = c2 + lwv[ct][4 * q + 3];
                const float oth = __shfl_xor(c3, 32), base = run + (hi ? oth : 0.f);
                pin[ct][4 * q] = base + c0; pin[ct][4 * q + 1] = base + c1; pin[ct][4 * q + 2] = base + c2; pin[ct][4 * q + 3] = base + c3; run += c3 + oth; }
            off[ct] = (unit & 1) ? 0.f : run;
            if (hi == 0) ((float*)(F.ws + WS_HT))[(size_t)unit * 512 + 64 * w + 2 * r32o + ct] = __expf(run); }
        bf16* scb = (bf16*)(F.ws + WS_SC) + ((size_t)(((unit >> 7) * 8 + w) * 64 + ((unit >> 1) & 63)) * 5 * 64 + 32 * (unit & 1) + 4 * hi) * 64 + 2 * r32o;
#pragma unroll
        for (int r = 0; r < 16; ++r) {
            const int t = crow16(r, hi), row = r0 + t;
            float rr[2], kv[2], vv[2], kkv[2], av[2], wv[2];
            float ss = 0.f;
#pragma unroll
            for (int ct = 0; ct < 2; ++ct) { const int ch = 64 * w + 2 * r32 + ct;
                rr[ct] = bf2f(msl[t * MS_LD + ch]); kv[ct] = bf2f(msl[t * MS_LD + 512 + ch]); vv[ct] = bf2f(msl[t * MS_LD + 1024 + ch]);
                wv[ct] = __expf(lwv[ct][r]);
                av[ct] = sigmoidf_(a0c[ct] + al[ct][r]);
                kkv[ct] = kv[ct] * kkc[ct]; ss += kkv[ct] * kkv[ct];
            }
            ss = sum32(ss);
            const float rn = rsqrtf(fmaxf(ss, 1e-24f));
            float bon = 0.f, br = 0.f, kr = 0.f, kk[2], kp[2];
#pragma unroll
            for (int ct = 0; ct < 2; ++ct) { kk[ct] = kkv[ct] * rn; kp[ct] = kv[ct] * (1.f + (av[ct] - 1.f) * kac[ct]);
                bon += rr[ct] * kp[ct] * rkc[ct]; br += kk[ct] * av[ct] * rr[ct]; kr += kp[ct] * rr[ct]; }
            bon = sum32(bon); br = sum32(br); kr = sum32(kr);
            { float Fm[2], Fi[2];
#pragma unroll
              for (int ct = 0; ct < 2; ++ct) { Fm[ct] = __expf(pin[ct][r] - lwv[ct][r] - off[ct]); Fi[ct] = __expf(off[ct] - pin[ct][r]); }
              unsigned* sp_ = (unsigned*)(scb + CRC(r) * 64);
              sp_[0 * 2048] = pk2(-kk[0] * Fm[0], -kk[1] * Fm[1]);
              sp_[1 * 2048] = pk2(kk[0] * av[0] * Fi[0], kk[1] * av[1] * Fi[1]);
              sp_[2 * 2048] = pk2(kp[0] * Fi[0], kp[1] * Fi[1]);
              sp_[3 * 2048] = pk2(wv[0] * rr[0] * Fm[0], wv[1] * rr[1] * Fm[1]);
              sp_[4 * 2048] = pk2(vv[0], vv[1]);
              *(v2u*)(rk_pair(F, 2) + (size_t)row * 512 + 64 * w + 2 * r32o) = (v2u){pk2(vv[0], gg[0][r]), pk2(vv[1], gg[1][r])}; }
            if (r32 == 0) *(f32x4*)(BON + (size_t)(row * 8 + w) * 4) = (f32x4){bon, br, kr, 0.f};
        }
    } else {
#pragma unroll 4
    for (int r = 0; r < 16; ++r) {
        const int t = crow16(r, hi), row = r0 + t;
        float rr[2], kv[2], vv[2], kkv[2], av[2], wv[2];
        float ss = 0.f;
#pragma unroll
        for (int ct = 0; ct < 2; ++ct) { const int ch = 64 * w + 2 * r32 + ct;
            rr[ct] = bf2f(msl[t * MS_LD + ch]); kv[ct] = bf2f(msl[t * MS_LD + 512 + ch]); vv[ct] = bf2f(msl[t * MS_LD + 1024 + ch]);
            const float x = -(w0c[ct] + wl[ct][r]), sp = fmaxf(x, 0.f) + __logf(1.f + __expf(-fabsf(x)));
            const float e = __expf(-sp - 0.5f); wv[ct] = __expf(-e);
            av[ct] = sigmoidf_(a0c[ct] + al[ct][r]);
            kkv[ct] = kv[ct] * kkc[ct]; ss += kkv[ct] * kkv[ct];
        }
        ss = sum32(ss);
        const float rn = rsqrtf(fmaxf(ss, 1e-24f));
        float bon = 0.f, br = 0.f, kr = 0.f, kk[2], kp[2];
#pragma unroll
        for (int ct = 0; ct < 2; ++ct) { kk[ct] = kkv[ct] * rn; kp[ct] = kv[ct] * (1.f + (av[ct] - 1.f) * kac[ct]);
            bon += rr[ct] * kp[ct] * rkc[ct]; br += kk[ct] * av[ct] * rr[ct]; kr += kp[ct] * rr[ct]; }
        bon = sum32(bon); br = sum32(br); kr = sum32(kr);
#pragma unroll
        for (int ct = 0; ct < 2; ++ct) { const size_t o = (size_t)row * 512 + 64 * w + 2 * r32 + ct;
            aW[o] = wv[ct]; rk_pair(F, 0)[o] = pk2(wv[ct] * rr[ct], kp[ct]); rk_pair(F, 2)[o] = pk2(vv[ct], gg[ct][r]); rk_pair(F, 4)[o] = pk2(-kk[ct], kk[ct] * av[ct]); }
        if (r32 == 0) *(f32x4*)(BON + (size_t)(row * 8 + w) * 4) = (f32x4){bon, br, kr, 0.f};
    }
    }
    __syncthreads();
}

constexpr int NSEG = 8, SEGT = SEQ / NSEG;
__device__ __forceinline__ float dpp_xor1(float v) { return __builtin_bit_cast(float, __builtin_amdgcn_update_dpp(0, __builtin_bit_cast(int, v), 0xB1, 0xF, 0xF, true)); }
__device__ __forceinline__ float dpp_xor2(float v) { return __builtin_bit_cast(float, __builtin_amdgcn_update_dpp(0, __builtin_bit_cast(int, v), 0x4E, 0xF, 0xF, true)); }
__device__ __forceinline__ float dpp_hmir(float v) { return __builtin_bit_cast(float, __builtin_amdgcn_update_dpp(0, __builtin_bit_cast(int, v), 0x141, 0xF, 0xF, true)); }
__device__ __forceinline__ float red8(float v) { v += dpp_xor1(v); v += dpp_xor2(v); v += dpp_hmir(v); return v; }
__device__ __forceinline__ void gn_store(Frame& F, const Args& A, int row, int h, int q, f32x4 yv, f32x4 vv) {
    const float* BON = (const float*)(F.ws + WS_BON3); const bf16* aG = rk_bf(F, 6); bf16* RW = (bf16*)(F.ws + WS_RW);
    float s = (yv[0] + yv[1]) + (yv[2] + yv[3]);
    s += __shfl_xor(s, 1); s += __shfl_xor(s, 2); s += __shfl_xor(s, 4); s += __shfl_xor(s, 8);
    const float mean = s * (1.f / 64.f); const f32x4 d = yv - mean;
    float s2 = (d[0] * d[0] + d[1] * d[1]) + (d[2] * d[2] + d[3] * d[3]);
    s2 += __shfl_xor(s2, 1); s2 += __shfl_xor(s2, 2); s2 += __shfl_xor(s2, 4); s2 += __shfl_xor(s2, 8);
    const float rstd = rsqrtf(s2 * (1.f / 64.f) + 64e-5f), bon = BON[(row * 8 + h) * 4];
    const int cbase = h * 64 + 4 * q;
    const f32x4 gw = *(const f32x4*)(A.in[I_GNW] + cbase), gb = *(const f32x4*)(A.in[I_GNB] + cbase), gv = [&]{ const v4u pg = *(const v4u*)(rk_pair(F, 2) + (size_t)row * 512 + cbase); return (f32x4){bfhi(pg.x), bfhi(pg.y), bfhi(pg.z), bfhi(pg.w)}; }();
    const f32x4 o = (d * rstd * gw + gb + bon * vv) * gv;
    v2u w; w.x = pk2(o[0], o[1]); w.y = pk2(o[2], o[3]);
    *(v2u*)(RW + (size_t)row * 512 + cbase) = w;
}
struct ScanIn { f32x4 a0, a1, r0, r1, w0, w1, b0, b1, k0, k1; float vi, br, kr; };
__device__ __forceinline__ void scan_seg_unit(Frame& F, const Args& A, int u) {
    constexpr int TB = 32, VB = 6 * TB * 64 + 2 * TB;
    LAS float* vecs = (LAS float*)(F.lds + RING_OFF);
    LAS float* ybuf = vecs + 2 * VB;
    LAS float* cbuf = ybuf + TB * 64;
    const int tid = F.tid, i = tid >> 3, seg8 = tid & 7;
    const bool prompt = u < 256;
    int h, row0, T; bool useF; f32x2 S[4], Fm[4];
    if (prompt) { h = (u >> 3) & 7; row0 = (u >> 6) * SEQ + (u & 7) * SEGT; T = SEGT; useF = (u & 7) != 0;
#pragma unroll
        for (int c = 0; c < 4; ++c) { S[c] = (f32x2){0.f, 0.f}; Fm[c] = (f32x2){(8 * seg8 + 2 * c == i) ? 1.f : 0.f, (8 * seg8 + 2 * c + 1 == i) ? 1.f : 0.f}; } }
    else { const int su = u - 256; h = su & 7; row0 = MP + (su >> 3); T = 1; useF = false;
        const float* s0 = A.in[I_SWKV] + ((size_t)su * 64 + i) * 64 + 8 * seg8;
        const f32x4 a = *(const f32x4*)s0, b = *(const f32x4*)(s0 + 4);
        S[0] = (f32x2){a[0], a[1]}; S[1] = (f32x2){a[2], a[3]}; S[2] = (f32x2){b[0], b[1]}; S[3] = (f32x2){b[2], b[3]};
#pragma unroll
        for (int c = 0; c < 4; ++c) Fm[c] = (f32x2){0.f, 0.f}; }
    const float* BON = (const float*)(F.ws + WS_BON3);
    float* Y0 = (float*)(F.ws + WS_Y0); float* CC = (float*)(F.ws + WS_CC);
    f32x4 sg[6]; float sgs = 0.f;
    const int st = tid >> 4, sq = tid & 15;
#define SCAN_STAGE_LOAD(t0_) do { const int nb_ = (T - (t0_)) < TB ? (T - (t0_)) : TB; if (st < nb_) { const size_t go_ = (size_t)(row0 + (t0_) + st) * 512 + h * 64 + 4 * sq; \
        sg[1] = *(const f32x4*)(rk_arr(F, 1) + go_); const v4u p0_ = *(const v4u*)(rk_pair(F, 0) + go_), p2_ = *(const v4u*)(rk_pair(F, 2) + go_), p4_ = *(const v4u*)(rk_pair(F, 4) + go_); \
        sg[0] = (f32x4){bflo(p0_.x), bflo(p0_.y), bflo(p0_.z), bflo(p0_.w)}; sg[2] = (f32x4){bfhi(p0_.x), bfhi(p0_.y), bfhi(p0_.z), bfhi(p0_.w)}; sg[3] = (f32x4){bflo(p2_.x), bflo(p2_.y), bflo(p2_.z), bflo(p2_.w)}; \
        sg[4] = (f32x4){bflo(p4_.x), bflo(p4_.y), bflo(p4_.z), bflo(p4_.w)}; sg[5] = (f32x4){bfhi(p4_.x), bfhi(p4_.y), bfhi(p4_.z), bfhi(p4_.w)}; } \
        if (tid < 2 * TB && (tid >> 1) < nb_) sgs = BON[((row0 + (t0_) + (tid >> 1)) * 8 + h) * 4 + 1 + (tid & 1)]; } while (0)
#define SCAN_STAGE_STORE(buf_) do { LAS float* vb_ = vecs + (buf_) * VB; _Pragma("unroll") for (int a_ = 0; a_ < 6; ++a_) *(LAS f32x4*)(vb_ + (a_ * TB + st) * 64 + 4 * sq) = sg[a_]; \
        if (tid < 2 * TB) vb_[6 * TB * 64 + tid] = sgs; } while (0)
    SCAN_STAGE_LOAD(0); SCAN_STAGE_STORE(0);
    __syncthreads();
    int buf = 0;
    for (int t0 = 0; t0 < T; t0 += TB, buf ^= 1) {
        const int nb = (T - t0) < TB ? (T - t0) : TB;
        const bool more = t0 + TB < T;
        if (more) SCAN_STAGE_LOAD(t0 + TB);
        const LAS float* vec = vecs + buf * VB; const LAS float* scl = vec + 6 * TB * 64;
#define SCAN_LOADIN(X, t_) do { const LAS float* p_ = vec + (t_) * 64 + 8 * seg8; \
        X.r0 = *(const LAS f32x4*)(p_); X.r1 = *(const LAS f32x4*)(p_ + 4); X.w0 = *(const LAS f32x4*)(p_ + TB * 64); X.w1 = *(const LAS f32x4*)(p_ + TB * 64 + 4); \
        X.k0 = *(const LAS f32x4*)(p_ + 2 * TB * 64); X.k1 = *(const LAS f32x4*)(p_ + 2 * TB * 64 + 4); X.a0 = *(const LAS f32x4*)(p_ + 4 * TB * 64); X.a1 = *(const LAS f32x4*)(p_ + 4 * TB * 64 + 4); \
        X.b0 = *(const LAS f32x4*)(p_ + 5 * TB * 64); X.b1 = *(const LAS f32x4*)(p_ + 5 * TB * 64 + 4); X.vi = vec[(3 * TB + (t_)) * 64 + i]; X.br = scl[2 * (t_)]; X.kr = scl[2 * (t_) + 1]; } while (0)
#define LO2(v) ((f32x2){(v)[0], (v)[1]})
#define HI2(v) ((f32x2){(v)[2], (v)[3]})
#define SCAN_STEP(X, Y, t_) do { \
        const f32x2 a_[4] = {LO2(X.a0), HI2(X.a0), LO2(X.a1), HI2(X.a1)}, r_[4] = {LO2(X.r0), HI2(X.r0), LO2(X.r1), HI2(X.r1)}; \
        const f32x2 w_[4] = {LO2(X.w0), HI2(X.w0), LO2(X.w1), HI2(X.w1)}, b_[4] = {LO2(X.b0), HI2(X.b0), LO2(X.b1), HI2(X.b1)}, k_[4] = {LO2(X.k0), HI2(X.k0), LO2(X.k1), HI2(X.k1)}; \
        const float br_ = X.br, kr_ = X.kr, vi_ = X.vi; \
        f32x2 d1 = S[0] * a_[0], d2 = S[0] * r_[0], f1 = Fm[0] * a_[0], f2 = Fm[0] * r_[0]; \
        _Pragma("unroll") for (int c = 1; c < 4; ++c) { d1 += S[c] * a_[c]; d2 += S[c] * r_[c]; f1 += Fm[c] * a_[c]; f2 += Fm[c] * r_[c]; } \
        f32x2 tS[4], tF[4]; _Pragma("unroll") for (int c = 0; c < 4; ++c) { tS[c] = S[c] * w_[c] + vi_ * k_[c]; tF[c] = Fm[c] * w_[c]; } \
        { int tn_ = (t_) + 1;     \
          asm volatile("" : "+v"(tn_) : "v"(d1), "v"(d2), "v"(f1), "v"(f2), "v"(tS[0]), "v"(tS[1]), "v"(tS[2]), "v"(tS[3]), "v"(tF[0]), "v"(tF[1]), "v"(tF[2]), "v"(tF[3])); \
          if ((t_) + 1 < nb) SCAN_LOADIN(Y, tn_); } \
        float q0 = d1.x + d1.y, q1 = d2.x + d2.y, q2 = f1.x + f1.y, q3 = f2.x + f2.y; \
        q0 += dpp_xor1(q0); q1 += dpp_xor1(q1); q2 += dpp_xor1(q2); q3 += dpp_xor1(q3); \
        q0 += dpp_xor2(q0); q1 += dpp_xor2(q1); q2 += dpp_xor2(q2); q3 += dpp_xor2(q3); \
        q0 += dpp_hmir(q0); q1 += dpp_hmir(q1); q2 += dpp_hmir(q2); q3 += dpp_hmir(q3); \
        _Pragma("unroll") for (int c = 0; c < 4; ++c) { S[c] = tS[c] + q0 * b_[c]; Fm[c] = tF[c] + q2 * b_[c]; } \
        if (seg8 == 0) { ybuf[(t_) * 64 + i] = q1 + q0 * br_ + vi_ * kr_; cbuf[(t_) * 64 + i] = q3 + q2 * br_; } } while (0)
        ScanIn IA, IB;
        SCAN_LOADIN(IA, 0);
        for (int t = 0; t < nb; t += 2) {
            SCAN_STEP(IA, IB, t);
            if (t + 1 < nb) SCAN_STEP(IB, IA, t + 1);
        }
        if (more) SCAN_STAGE_STORE(buf ^ 1);
        __syncthreads();
        { const int t = tid >> 4, q = tid & 15;
          if (t < nb) { const int row = row0 + t0 + t;
            const f32x4 yv = *(const LAS f32x4*)(ybuf + t * 64 + 4 * q);
            if (prompt) { *(f32x4*)(Y0 + (size_t)row * 512 + h * 64 + 4 * q) = yv; if (useF) *(f32x4*)(CC + (size_t)row * 512 + h * 64 + 4 * q) = *(const LAS f32x4*)(cbuf + t * 64 + 4 * q); }
            else gn_store(F, A, row, h, q, yv, *(const LAS f32x4*)(vec + (3 * TB + t) * 64 + 4 * q)); } }
        __syncthreads();
    }
#undef SCAN_STAGE_LOAD
#undef SCAN_STAGE_STORE
#undef SCAN_LOADIN
#undef SCAN_STEP
#undef LO2
#undef HI2
    const f32x4 s0v = {S[0].x, S[0].y, S[1].x, S[1].y}, s1v = {S[2].x, S[2].y, S[3].x, S[3].y};
    if (prompt) { float* ps = (float*)(F.ws + WS_PSI) + ((size_t)u * 64 + i) * 64 + 8 * seg8; *(f32x4*)ps = s0v; *(f32x4*)(ps + 4) = s1v;
        if (useF) { float* ph = (float*)(F.ws + WS_PHI) + ((size_t)u * 64 + i) * 64 + 8 * seg8; *(f32x4*)ph = (f32x4){Fm[0].x, Fm[0].y, Fm[1].x, Fm[1].y}; *(f32x4*)(ph + 4) = (f32x4){Fm[2].x, Fm[2].y, Fm[3].x, Fm[3].y}; } }
    else { float* so = F.out + O_WS + ((size_t)(u - 256) * 64 + i) * 64 + 8 * seg8; *(f32x4*)so = s0v; *(f32x4*)(so + 4) = s1v; }
    __syncthreads();
}
__device__ __forceinline__ void carry_unit(Frame& F, const Args& A, int bh) {
    LAS float* X = (LAS float*)(F.lds + RING_OFF);
    LAS float* P = X + 4096;
    const int tid = F.tid, i = tid >> 3, seg8 = tid & 7;
    float* SST = (float*)(F.ws + WS_SST); const float* PSI = (const float*)(F.ws + WS_PSI); const float* PHI = (const float*)(F.ws + WS_PHI);
    float cur[8];
#pragma unroll
    for (int c = 0; c < 8; ++c) cur[c] = 0.f;
    for (int k = 0; k < NSEG; ++k) {
        const size_t uo = ((size_t)(bh * NSEG + k) * 64 + i) * 64 + 8 * seg8;
        *(f32x4*)(SST + uo) = (f32x4){cur[0], cur[1], cur[2], cur[3]}; *(f32x4*)(SST + uo + 4) = (f32x4){cur[4], cur[5], cur[6], cur[7]};
        const f32x4 p0 = *(const f32x4*)(PSI + uo), p1 = *(const f32x4*)(PSI + uo + 4);
        float nx[8] = {p0[0], p0[1], p0[2], p0[3], p1[0], p1[1], p1[2], p1[3]};
        if (k > 0) {
            __syncthreads();
            *(LAS f32x4*)(X + i * 64 + 8 * seg8) = (f32x4){cur[0], cur[1], cur[2], cur[3]}; *(LAS f32x4*)(X + i * 64 + 8 * seg8 + 4) = (f32x4){cur[4], cur[5], cur[6], cur[7]};
            *(LAS f32x4*)(P + i * 64 + 8 * seg8) = *(const f32x4*)(PHI + uo); *(LAS f32x4*)(P + i * 64 + 8 * seg8 + 4) = *(const f32x4*)(PHI + uo + 4);
            __syncthreads();
#pragma unroll 4
            for (int l = 0; l < 64; ++l) { const float x = X[i * 64 + l]; const f32x4 q0 = *(const LAS f32x4*)(P + l * 64 + 8 * seg8), q1 = *(const LAS f32x4*)(P + l * 64 + 8 * seg8 + 4);
#pragma unroll
                for (int c = 0; c < 4; ++c) { nx[c] += x * q0[c]; nx[4 + c] += x * q1[c]; } }
        }
#pragma unroll
        for (int c = 0; c < 8; ++c) cur[c] = nx[c];
    }
    float* so = F.out + O_WP + ((size_t)bh * 64 + i) * 64 + 8 * seg8; *(f32x4*)so = (f32x4){cur[0], cur[1], cur[2], cur[3]}; *(f32x4*)(so + 4) = (f32x4){cur[4], cur[5], cur[6], cur[7]};
    __syncthreads();
}
__device__ __forceinline__ void corr_unit(Frame& F, const Args& A, int u) {
    const int lane = F.lane, w = F.wave, r32 = lane & 31, hi = lane >> 5, seg = u & 7, bh = u >> 3, h = bh & 7, rowseg = (bh >> 3) * SEQ + seg * SEGT;
    const float* SST = (const float*)(F.ws + WS_SST) + (size_t)u * 4096; const float* CC = (const float*)(F.ws + WS_CC); const float* Y0 = (const float*)(F.ws + WS_Y0);
    const float* BON = (const float*)(F.ws + WS_BON3); const bf16* aG = rk_bf(F, 6); const bf16* aV = rk_bf(F, 3); bf16* RW = (bf16*)(F.ws + WS_RW);
    bf16x8 sb[2][4];
    if (seg > 0) {
#pragma unroll
        for (int ct = 0; ct < 2; ++ct)
#pragma unroll
            for (int ks = 0; ks < 4; ++ks) { const float* p = SST + (size_t)(32 * ct + r32) * 64 + 16 * ks + 8 * hi; const f32x4 x = *(const f32x4*)p, y = *(const f32x4*)(p + 4);
                const v4u t = {pk2(x[0], x[1]), pk2(x[2], x[3]), pk2(y[0], y[1]), pk2(y[2], y[3])}; sb[ct][ks] = __builtin_bit_cast(bf16x8, t); }
    }
    float gw[2], gb[2];
#pragma unroll
    for (int ct = 0; ct < 2; ++ct) { gw[ct] = A.in[I_GNW][h * 64 + 32 * ct + r32]; gb[ct] = A.in[I_GNB][h * 64 + 32 * ct + r32]; }
    for (int blk = w; blk < SEGT / 32; blk += NWAVES) {
        const int row0 = rowseg + 32 * blk;
        f32x16 d[2]; d[0] = (f32x16){}; d[1] = (f32x16){};
        float yv0[16], yv1[16], bnv[16]; unsigned vgv0[16], vgv1[16];
#pragma unroll
        for (int r = 0; r < 16; ++r) { const int row = row0 + crow16(r, hi); const size_t o = (size_t)row * 512 + h * 64 + r32;
            yv0[r] = Y0[o]; yv1[r] = Y0[o + 32]; vgv0[r] = rk_pair(F, 2)[o]; vgv1[r] = rk_pair(F, 2)[o + 32]; bnv[r] = BON[(row * 8 + h) * 4]; }
        if (seg > 0) {
#pragma unroll
            for (int ks = 0; ks < 4; ++ks) { const float* p = CC + (size_t)(row0 + r32) * 512 + h * 64 + 16 * ks + 8 * hi; const f32x4 x = *(const f32x4*)p, y = *(const f32x4*)(p + 4);
                const v4u t = {pk2(x[0], x[1]), pk2(x[2], x[3]), pk2(y[0], y[1]), pk2(y[2], y[3])}; const bf16x8 cf = __builtin_bit_cast(bf16x8, t);
                d[0] = __builtin_amdgcn_mfma_f32_32x32x16_bf16(cf, sb[0][ks], d[0], 0, 0, 0); d[1] = __builtin_amdgcn_mfma_f32_32x32x16_bf16(cf, sb[1][ks], d[1], 0, 0, 0); }
        }
#pragma unroll
        for (int r = 0; r < 16; ++r) {
            const int row = row0 + crow16(r, hi); const size_t o = (size_t)row * 512 + h * 64 + r32;
            const float y0 = yv0[r] + d[0][r], y1 = yv1[r] + d[1][r];
            const float mean = sum32(y0 + y1) * (1.f / 64.f), e0 = y0 - mean, e1 = y1 - mean;
            const float rstd = rsqrtf(sum32(e0 * e0 + e1 * e1) * (1.f / 64.f) + 64e-5f), bon = bnv[r];
            const unsigned vg0 = vgv0[r], vg1 = vgv1[r];
            const float o0 = (e0 * rstd * gw[0] + gb[0] + bon * bflo(vg0)) * bfhi(vg0), o1 = (e1 * rstd * gw[1] + gb[1] + bon * bflo(vg1)) * bfhi(vg1);
            RW[o] = (bf16)(pk2(o0, 0.f) & 0xffffu); RW[o + 32] = (bf16)(pk2(o1, 0.f) & 0xffffu);
        }
    }
}

typedef short v4i16_t __attribute__((ext_vector_type(4)));
__device__ __forceinline__ s16x4 vtr(const LAS unsigned char* p) { return __builtin_bit_cast(s16x4, __builtin_amdgcn_ds_read_tr16_b64_v4i16((LAS v4i16_t*)p)); }
constexpr int IMG_LD = 136;
constexpr int IMG_BYTES = 64 * IMG_LD;
typedef bf16x8 Frag[2][4];
__device__ __forceinline__ void mm64(const Frag& Af, const Frag& Bf, f32x16 (&D)[2][2]) {
#pragma unroll
    for (int rt = 0; rt < 2; ++rt)
#pragma unroll
        for (int ct = 0; ct < 2; ++ct)
#pragma unroll
            for (int ks = 0; ks < 4; ++ks) D[rt][ct] = __builtin_amdgcn_mfma_f32_32x32x16_bf16(Af[rt][ks], Bf[ct][ks], D[rt][ct], 0, 0, 0);
}
__device__ __forceinline__ void acc_zero(f32x16 (&D)[2][2]) {
#pragma unroll
    for (int a = 0; a < 2; ++a)
#pragma unroll
        for (int b = 0; b < 2; ++b) D[a][b] = (f32x16){};
}
__device__ __forceinline__ void acc_frag(const f32x16 (&X)[2][2], Frag& Fr) {
#pragma unroll
    for (int rt = 0; rt < 2; ++rt)
#pragma unroll
        for (int ct = 0; ct < 2; ++ct)
#pragma unroll
            for (int hf = 0; hf < 2; ++hf) { const int rb = 8 * hf;
                const v4u u = {pk2(X[rt][ct][rb], X[rt][ct][rb + 1]), pk2(X[rt][ct][rb + 2], X[rt][ct][rb + 3]), pk2(X[rt][ct][rb + 4], X[rt][ct][rb + 5]), pk2(X[rt][ct][rb + 6], X[rt][ct][rb + 7])};
                Fr[ct][2 * rt + hf] = __builtin_bit_cast(bf16x8, u); }
}
__device__ __forceinline__ void rowfrag(const LAS unsigned char* img, int lane, Frag& Fr) {
    const int r32 = lane & 31, hi = lane >> 5;
#pragma unroll
    for (int tl = 0; tl < 2; ++tl)
#pragma unroll
        for (int ks = 0; ks < 4; ++ks) Fr[tl][ks] = *(const LAS bf16x8*)(img + (32 * tl + r32) * IMG_LD + (16 * ks + 8 * hi) * 2);
}
__device__ __forceinline__ void rowfrag_perm(const LAS unsigned char* img, int lane, Frag& Fr) {
    const int r32 = lane & 31, hi = lane >> 5;
#pragma unroll
    for (int tl = 0; tl < 2; ++tl)
#pragma unroll
        for (int ks = 0; ks < 4; ++ks) { const LAS unsigned char* p = img + (32 * tl + r32) * IMG_LD + (16 * ks + 4 * hi) * 2;
            const v2u a = *(const LAS v2u*)p, b = *(const LAS v2u*)(p + 16); const v4u u = {a.x, a.y, b.x, b.y}; Fr[tl][ks] = __builtin_bit_cast(bf16x8, u); }
}
__device__ __forceinline__ void colfrag_tr(const LAS unsigned char* img, int lane, Frag& Fr) {
    const int hi = lane >> 5, qq = (lane & 15) >> 2, p4 = lane & 3, cg = (lane >> 4) & 1;
    const LAS unsigned char* base = img + (4 * hi + qq) * IMG_LD + (16 * cg + 4 * p4) * 2;
#pragma unroll
    for (int tl = 0; tl < 2; ++tl)
#pragma unroll
        for (int ks = 0; ks < 4; ++ks) { const LAS unsigned char* p = base + (16 * ks) * IMG_LD + (32 * tl) * 2;
            const s16x4 lo = vtr(p), hh = vtr(p + 8 * IMG_LD); Fr[tl][ks] = (bf16x8){lo[0], lo[1], lo[2], lo[3], hh[0], hh[1], hh[2], hh[3]}; }
}
__device__ __forceinline__ void img_load(const bf16* g, LAS unsigned char* slot, int lane) {
    asm volatile("" ::: "memory");
    const unsigned char* gb = (const unsigned char*)g + (unsigned)(lane * 16);
    LAS unsigned char* sl_ = slot + (lane >> 3) * IMG_LD + (lane & 7) * 16;
#pragma unroll
    for (int hb = 0; hb < 2; ++hb) { v4u t[4];
#pragma unroll
        for (int k = 0; k < 4; ++k) t[k] = *(const v4u*)(gb + 1024 * (4 * hb + k));
#pragma unroll
        for (int k = 0; k < 4; ++k) *(LAS v4u*)(sl_ + (8 * (4 * hb + k)) * IMG_LD) = t[k];
        asm volatile("" ::: "memory"); }
}
__device__ __forceinline__ void acc_to_img(const f32x16 (&X)[2][2], LAS unsigned char* slot, int lane) {
    const int r32 = lane & 31, hi = lane >> 5; LAS unsigned char* lb = slot + (4 * hi) * IMG_LD + r32 * 2;
#pragma unroll
    for (int rt = 0; rt < 2; ++rt)
#pragma unroll
        for (int ct = 0; ct < 2; ++ct)
        { asm volatile("" ::: "memory");
#pragma unroll
            for (int r = 0; r < 16; ++r) *(LAS bf16*)(lb + (32 * rt + CRC(r)) * IMG_LD + (32 * ct) * 2) = (bf16)(pk2(X[rt][ct][r], 0.f) & 0xffffu); }
}
__device__ __forceinline__ void acc_to_gbf(const f32x16 (&X)[2][2], bf16* g, int lane) {
    const int r32 = lane & 31, hi = lane >> 5; bf16* gl = g + (4 * hi) * 64 + r32;
#pragma unroll
    for (int rt = 0; rt < 2; ++rt)
#pragma unroll
        for (int ct = 0; ct < 2; ++ct)
        { asm volatile("" ::: "memory");
#pragma unroll
            for (int r = 0; r < 16; ++r) gl[(32 * rt + CRC(r)) * 64 + 32 * ct] = (bf16)(pk2(X[rt][ct][r], 0.f) & 0xffffu); }
}
__device__ __forceinline__ void acc_to_gf32(const f32x16 (&X)[2][2], float* g, int lane) {
    const int r32 = lane & 31, hi = lane >> 5; float* gl = g + (4 * hi) * 64 + r32;
#pragma unroll
    for (int rt = 0; rt < 2; ++rt)
#pragma unroll
        for (int ct = 0; ct < 2; ++ct)
        { asm volatile("" ::: "memory");
#pragma unroll
            for (int r = 0; r < 16; ++r) gl[(32 * rt + CRC(r)) * 64 + 32 * ct] = X[rt][ct][r]; }
}
template <bool STRICT> __device__ __forceinline__ void mask_upper(f32x16 (&X)[2][2], int lane) {
    const int r32 = lane & 31, hi = lane >> 5, dl = 4 * hi - r32;
#pragma unroll
    for (int rt = 0; rt < 2; ++rt)
#pragma unroll
        for (int ct = 0; ct < 2; ++ct)
#pragma unroll
            for (int r = 0; r < 16; ++r) { const int dlt = dl + (32 * rt + CRC(r) - 32 * ct); const bool keep = STRICT ? (dlt < 0) : (dlt <= 0); if (!keep) X[rt][ct][r] = 0.f; }
}
template <int RT> __device__ __forceinline__ void mm_rt(const Frag& Af, const Frag& Bf, f32x16 (&D)[2]) {
#pragma unroll
    for (int ct = 0; ct < 2; ++ct)
#pragma unroll
        for (int ks = 0; ks < 4; ++ks) D[ct] = __builtin_amdgcn_mfma_f32_32x32x16_bf16(Af[RT][ks], Bf[ct][ks], D[ct], 0, 0, 0);
}
template <int RT> __device__ __forceinline__ void frag_rt(const f32x16 (&D)[2], Frag& Fr) {
#pragma unroll
    for (int ct = 0; ct < 2; ++ct)
#pragma unroll
        for (int hf = 0; hf < 2; ++hf) { const int rb = 8 * hf;
            const v4u u = {pk2(D[ct][rb], D[ct][rb + 1]), pk2(D[ct][rb + 2], D[ct][rb + 3]), pk2(D[ct][rb + 4], D[ct][rb + 5]), pk2(D[ct][rb + 6], D[ct][rb + 7])};
            Fr[ct][2 * RT + hf] = __builtin_bit_cast(bf16x8, u); }
}
template <int RT, bool STRICT> __device__ __forceinline__ void mask_rt(f32x16 (&D)[2], int lane) {
    const int dl = 4 * (lane >> 5) - (lane & 31);
#pragma unroll
    for (int ct = 0; ct < 2; ++ct)
#pragma unroll
        for (int r = 0; r < 16; ++r) { const int dlt = dl + (32 * RT + CRC(r) - 32 * ct); const bool keep = STRICT ? (dlt < 0) : (dlt <= 0); if (!keep) D[ct][r] = 0.f; }
}
template <int RT> __device__ __forceinline__ void st_f32_rt(const f32x16 (&D)[2], float* g, int lane) { float* gl = g + (4 * (lane >> 5)) * 64 + (lane & 31);
#pragma unroll
    for (int ct = 0; ct < 2; ++ct) { asm volatile("" ::: "memory");
#pragma unroll
        for (int r = 0; r < 16; ++r) gl[(32 * RT + CRC(r)) * 64 + 32 * ct] = D[ct][r]; } }
template <int RT> __device__ __forceinline__ void st_bf_rt(const f32x16 (&D)[2], bf16* g, int lane) { bf16* gl = g + (4 * (lane >> 5)) * 64 + (lane & 31);
#pragma unroll
    for (int ct = 0; ct < 2; ++ct) { asm volatile("" ::: "memory");
#pragma unroll
        for (int r = 0; r < 16; ++r) gl[(32 * RT + CRC(r)) * 64 + 32 * ct] = (bf16)(pk2(D[ct][r], 0.f) & 0xffffu); } }
template <int RT> __device__ __forceinline__ void ld_f32_rt(f32x16 (&D)[2], const float* g, int lane) { const float* gl = g + (4 * (lane >> 5)) * 64 + (lane & 31);
#pragma unroll
    for (int ct = 0; ct < 2; ++ct) { asm volatile("" ::: "memory");
#pragma unroll
        for (int r = 0; r < 16; ++r) D[ct][r] = gl[(32 * RT + CRC(r)) * 64 + 32 * ct]; } }
template <int RT> __device__ __forceinline__ void scale_rt(f32x16 (&D)[2], const float* gcl  ) {
#pragma unroll
    for (int ct = 0; ct < 2; ++ct)
#pragma unroll
        for (int r = 0; r < 16; ++r) D[ct][r] *= gcl[32 * RT + CRC(r)]; }
__device__ __forceinline__ void zero2(f32x16 (&D)[2]) { D[0] = (f32x16){}; D[1] = (f32x16){}; }
__device__ __forceinline__ void tfrag(const f32x16& T, bf16x8& f0, bf16x8& f1) {
    const v4u u0 = {pk2(T[0], T[1]), pk2(T[2], T[3]), pk2(T[4], T[5]), pk2(T[6], T[7])}, u1 = {pk2(T[8], T[9]), pk2(T[10], T[11]), pk2(T[12], T[13]), pk2(T[14], T[15])};
    f0 = __builtin_bit_cast(bf16x8, u0); f1 = __builtin_bit_cast(bf16x8, u1);
}
__device__ __forceinline__ void tmm(const bf16x8 (&a)[2], const bf16x8 (&b)[2], f32x16& d) {
    d = __builtin_amdgcn_mfma_f32_32x32x16_bf16(a[0], b[0], d, 0, 0, 0); d = __builtin_amdgcn_mfma_f32_32x32x16_bf16(a[1], b[1], d, 0, 0, 0);
}
__device__ __forceinline__ void tprod(const Frag& A_, int ra, const Frag& B_, int rb, f32x16& d) {
#pragma unroll
    for (int ks = 0; ks < 4; ++ks) d = __builtin_amdgcn_mfma_f32_32x32x16_bf16(A_[ra][ks], B_[rb][ks], d, 0, 0, 0);
}
template <bool WANT_ZT> __device__ __forceinline__ void diag_inv(f32x16& Q, f32x16& QT, f32x16& Z, f32x16& ZT, int lane) {
    const int dl = 4 * (lane >> 5) - (lane & 31);
#pragma unroll
    for (int r = 0; r < 16; ++r) { const int d = dl + CRC(r); Q[r] = d < 0 ? Q[r] : 0.f; QT[r] = d > 0 ? QT[r] : 0.f; const float id = d == 0 ? 1.f : 0.f; Z[r] = Q[r] + id; ZT[r] = QT[r] + id; }
#pragma unroll 1
    for (int lvl = 0; lvl < 4; ++lvl) {
        bf16x8 fq[2], fqt[2], fz[2];
        tfrag(Q, fq[0], fq[1]); tfrag(QT, fqt[0], fqt[1]);
        Q = (f32x16){}; QT = (f32x16){}; tmm(fqt, fq, Q); tmm(fq, fqt, QT);
        tfrag(Q, fq[0], fq[1]); tfrag(QT, fqt[0], fqt[1]);
        tfrag(Z, fz[0], fz[1]); tmm(fqt, fz, Z);
        if (WANT_ZT) { tfrag(ZT, fz[0], fz[1]); tmm(fq, fz, ZT); }
    }
}
constexpr int NCHK = SEQ / 64;
__device__ __forceinline__ void chunk_prescale(Frame& F, int hc) {
    const int lane = F.lane, bh = hc >> 6, c = hc & 63, h = bh & 7, row0 = (bh >> 3) * SEQ + c * 64;
    bf16* sc = (bf16*)(F.ws + WS_SC) + (size_t)hc * 5 * 4096 + lane;
    const size_t o0 = (size_t)row0 * 512 + h * 64 + lane;
    const float* aW = rk_arr(F, 1) + o0; const unsigned* pRK = rk_pair(F, 0) + o0; const unsigned* pVG = rk_pair(F, 2) + o0; const unsigned* pAB = rk_pair(F, 4) + o0;
    float lc = 0.f;
    float wA[16], wB[16]; unsigned rkA[16], rkB[16], vgA[16], vgB[16], abA[16], abB[16];
#define PS_LOAD(S, tb) do { _Pragma("unroll") for (int i = 0; i < 16; ++i) { const int t = 16 * (tb) + i; w##S[i] = aW[t * 512]; rk##S[i] = pRK[t * 512]; vg##S[i] = pVG[t * 512]; ab##S[i] = pAB[t * 512]; } } while (0)
#define PS_COMP(S, tb) do { _Pragma("unroll") for (int i = 0; i < 16; ++i) { const int t = 16 * (tb) + i; \
        const float em = __expf(lc); lc += __logf(w##S[i]); const float ei = __expf(-lc); \
        sc[0 * 4096 + t * 64] = (bf16)(pk2(bflo(ab##S[i]) * em, 0.f) & 0xffffu); \
        sc[1 * 4096 + t * 64] = (bf16)(pk2(bfhi(ab##S[i]) * ei, 0.f) & 0xffffu); \
        sc[2 * 4096 + t * 64] = (bf16)(pk2(bfhi(rk##S[i]) * ei, 0.f) & 0xffffu); \
        sc[3 * 4096 + t * 64] = (bf16)(pk2(bflo(rk##S[i]) * em, 0.f) & 0xffffu); \
        sc[4 * 4096 + t * 64] = (bf16)(vg##S[i] & 0xffffu); } } while (0)
    PS_LOAD(A, 0); PS_LOAD(B, 1);
    PS_COMP(A, 0); asm volatile("" ::: "memory"); PS_LOAD(A, 2);
    PS_COMP(B, 1); asm volatile("" ::: "memory"); PS_LOAD(B, 3);
    PS_COMP(A, 2); PS_COMP(B, 3);
#undef PS_LOAD
#undef PS_COMP
    ((float*)(F.ws + WS_GC))[(size_t)hc * 64 + lane] = __expf(lc);
}
__device__ __forceinline__ void chunk_unit(Frame& F, int hc) {
    const int lane = F.lane, r32 = lane & 31, hi = lane >> 5;
    LAS unsigned char* s0 = F.lds + RING_OFF + F.wave * (2 * IMG_BYTES); LAS unsigned char* s1 = s0 + IMG_BYTES; const LAS unsigned char* s1l = s1 + (4 * hi) * IMG_LD + r32 * 2;
    SUBM(0);
    const float* rho = (const float*)(F.ws + WS_HT) + (size_t)(((hc >> 9) * 64 + (hc & 63)) * 2) * 512 + ((hc >> 6) & 7) * 64; const float* sig = rho + 512;
    ((float*)(F.ws + WS_GC))[(size_t)hc * 64 + lane] = rho[lane] * sig[lane];
    SUBM(1);
    const bf16* sc = (const bf16*)(F.ws + WS_SC) + (size_t)hc * 5 * 4096;
    const bf16* gAb = sc; const bf16* gBb = sc + 4096; const bf16* gKb = sc + 2 * 4096; const bf16* gRb = sc + 3 * 4096; const bf16* gV = sc + 4 * 4096;
    Frag fa, fb, zf, uf, af;
    {
        f32x16 Q, QT, Z, ZT; bf16x8 zt11[2], z22[2], t0[2], t1[2];
        img_load(gAb, s0, lane); img_load(gBb, s1, lane);
        rowfrag(s1, lane, fa); rowfrag(s0, lane, fb);
        Q = (f32x16){}; QT = (f32x16){}; tprod(fa, 0, fb, 0, Q); tprod(fb, 0, fa, 0, QT); diag_inv<true>(Q, QT, Z, ZT, lane);
        tfrag(Z, zf[0][0], zf[0][1]); tfrag(ZT, zt11[0], zt11[1]);
        Q = (f32x16){}; QT = (f32x16){}; tprod(fa, 1, fb, 1, Q); tprod(fb, 1, fa, 1, QT); diag_inv<false>(Q, QT, Z, ZT, lane);
        tfrag(Z, z22[0], z22[1]); zf[1][2] = z22[0]; zf[1][3] = z22[1];
        QT = (f32x16){}; tprod(fb, 1, fa, 0, QT);
        tfrag(QT, t0[0], t0[1]); Q = (f32x16){}; tmm(t0, z22, Q);
        tfrag(Q, t1[0], t1[1]); Z = (f32x16){}; tmm(zt11, t1, Z);
        tfrag(Z, zf[1][0], zf[1][1]);
        zf[0][2] = (bf16x8){}; zf[0][3] = (bf16x8){};
    }
    SUBM(2);
    f32x16 D[2];
    img_load(gKb, s1, lane);
    rowfrag(s1, lane, fa); rowfrag(s0, lane, fb);
    zero2(D); mm_rt<0>(fa, fb, D); mask_rt<0, true>(D, lane); frag_rt<0>(D, uf);
    zero2(D); mm_rt<1>(fa, fb, D); mask_rt<1, true>(D, lane); frag_rt<1>(D, uf);
    img_load(gV, s1, lane); colfrag_tr(s1, lane, fb);
    zero2(D); mm_rt<0>(uf, fb, D); frag_rt<0>(D, fa);
    zero2(D); mm_rt<1>(uf, fb, D); frag_rt<1>(D, fa);
    zero2(D); mm_rt<0>(zf, fa, D); frag_rt<0>(D, uf);
    zero2(D); mm_rt<1>(zf, fa, D); frag_rt<1>(D, uf);
    colfrag_tr(s0, lane, fa);
    zero2(D); mm_rt<0>(zf, fa, D); frag_rt<0>(D, af);
    zero2(D); mm_rt<1>(zf, fa, D); frag_rt<1>(D, af);
    SUBM(3);
    const float* gcg = sig + 4 * hi; const float* rhg = rho + 4 * hi;
    img_load(gKb, s0, lane); colfrag_tr(s0, lane, zf);
    img_load(gBb, s0, lane); colfrag_tr(s0, lane, fa);
    { unsigned char* slfb = F.ws + WS_SL + (size_t)hc * 8192 + lane * 8; unsigned char* gpfb = F.ws + WS_GP + (size_t)hc * 8192 + lane * 16;
      zero2(D); mm_rt<0>(zf, fb, D); mm_rt<0>(fa, uf, D); scale_rt<0>(D, gcg);
#pragma unroll
      for (int ct = 0; ct < 2; ++ct)
#pragma unroll
          for (int q = 0; q < 4; ++q) *(v2u*)(slfb + ((ct * 2 + 0) * 4 + q) * 512) = (v2u){pk2(D[ct][4 * q], D[ct][4 * q + 1]), pk2(D[ct][4 * q + 2], D[ct][4 * q + 3])};
      zero2(D); mm_rt<1>(zf, fb, D); mm_rt<1>(fa, uf, D); scale_rt<1>(D, gcg);
#pragma unroll
      for (int ct = 0; ct < 2; ++ct)
#pragma unroll
          for (int q = 0; q < 4; ++q) *(v2u*)(slfb + ((ct * 2 + 1) * 4 + q) * 512) = (v2u){pk2(D[ct][4 * q], D[ct][4 * q + 1]), pk2(D[ct][4 * q + 2], D[ct][4 * q + 3])};
      const float gc0 = sig[r32], gc1 = sig[32 + r32];
      zero2(D); mm_rt<0>(af, fa, D); D[0] *= gc0; D[1] *= gc1; scale_rt<0>(D, rhg); frag_rt<0>(D, zf);
      zero2(D); mm_rt<1>(af, fa, D); D[0] *= gc0; D[1] *= gc1; scale_rt<1>(D, rhg); frag_rt<1>(D, zf);
#pragma unroll
      for (int tl = 0; tl < 2; ++tl)
#pragma unroll
          for (int ks = 0; ks < 4; ++ks) *(bf16x8*)(gpfb + (tl * 4 + ks) * 1024) = zf[tl][ks]; }
    SUBM(4);
    img_load(gRb, s1, lane);
    rowfrag(s0, lane, fa); rowfrag(s1, lane, fb);
    zero2(D); mm_rt<0>(fa, fb, D); mask_rt<0, false>(D, lane); frag_rt<0>(D, zf);
    zero2(D); mm_rt<1>(fa, fb, D); mask_rt<1, false>(D, lane); frag_rt<1>(D, zf);
    { const LAS unsigned char* s1t = s1 + r32 * IMG_LD + hi * 8;
      unsigned char* rhfb = F.ws + WS_RH + (size_t)hc * 8192 + lane * 16;
#pragma unroll
      for (int ct = 0; ct < 2; ++ct)
#pragma unroll
          for (int q = 0; q < 4; ++q) { const v2u w_ = *(const LAS v2u*)(s1t + (32 * ct) * IMG_LD + (8 * q) * 2);
              D[ct][4 * q] = bflo(w_.x); D[ct][4 * q + 1] = bfhi(w_.x); D[ct][4 * q + 2] = bflo(w_.y); D[ct][4 * q + 3] = bfhi(w_.y); }
      mm_rt<0>(af, zf, D); scale_rt<0>(D, rhg); frag_rt<0>(D, fa);
#pragma unroll
      for (int ct = 0; ct < 2; ++ct)
#pragma unroll
          for (int q = 0; q < 4; ++q) { const v2u w_ = *(const LAS v2u*)(s1t + (32 * ct) * IMG_LD + (32 + 8 * q) * 2);
              D[ct][4 * q] = bflo(w_.x); D[ct][4 * q + 1] = bfhi(w_.x); D[ct][4 * q + 2] = bflo(w_.y); D[ct][4 * q + 3] = bfhi(w_.y); }
      mm_rt<1>(af, zf, D); scale_rt<1>(D, rhg); frag_rt<1>(D, fa);
#pragma unroll
      for (int tl = 0; tl < 2; ++tl)
#pragma unroll
          for (int ks = 0; ks < 4; ++ks) *(bf16x8*)(rhfb + (tl * 4 + ks) * 1024) = fa[tl][ks]; }
    SUBM(5);
    img_load(gKb, s0, lane);
    rowfrag(s0, lane, fa); rowfrag(s1, lane, fb);
    zero2(D); mm_rt<0>(fa, fb, D); mask_rt<0, false>(D, lane); frag_rt<0>(D, af);
    zero2(D); mm_rt<1>(fa, fb, D); mask_rt<1, false>(D, lane); frag_rt<1>(D, af);
    img_load(gV, s1, lane); colfrag_tr(s1, lane, fb);
    { unsigned char* ylfb = F.ws + WS_YL + (size_t)hc * 16384 + lane * 16;
      zero2(D); mm_rt<0>(zf, uf, D); mm_rt<0>(af, fb, D);
#pragma unroll
      for (int ct = 0; ct < 2; ++ct)
#pragma unroll
          for (int q = 0; q < 4; ++q) *(f32x4*)(ylfb + ((0 * 2 + ct) * 4 + q) * 1024) = (f32x4){D[ct][4 * q], D[ct][4 * q + 1], D[ct][4 * q + 2], D[ct][4 * q + 3]};
      zero2(D); mm_rt<1>(zf, uf, D); mm_rt<1>(af, fb, D);
#pragma unroll
      for (int ct = 0; ct < 2; ++ct)
#pragma unroll
          for (int q = 0; q < 4; ++q) *(f32x4*)(ylfb + ((1 * 2 + ct) * 4 + q) * 1024) = (f32x4){D[ct][4 * q], D[ct][4 * q + 1], D[ct][4 * q + 2], D[ct][4 * q + 3]}; }
    SUBM(6);
}
__device__ __forceinline__ void chain_unit(Frame& F, int gwv) {
    const int lane = F.lane, r32 = lane & 31, hi = lane >> 5, bh = gwv >> 1, ct = gwv & 1;
    const unsigned char* gpf = F.ws + WS_GP + (size_t)bh * NCHK * 8192 + lane * 16;
    const unsigned char* slf = F.ws + WS_SL + (size_t)bh * NCHK * 8192 + ct * 4096 + lane * 8;
    const float* gcl = (const float*)(F.ws + WS_GC) + (size_t)bh * NCHK * 64 + lane;
    unsigned char* xcf = F.ws + WS_XC + (size_t)bh * NCHK * 8192 + ct * 4096 + lane * 16;
    f32x16 X[2]; X[0] = (f32x16){}; X[1] = (f32x16){};
    v4u gA[8], gB[8], gC[8]; v2u sA[8], sB[8], sC[8]; float mA, mB, mC; const int hb = 16 * hi;
#define CH_LOAD(S) do { _Pragma("unroll") for (int k = 0; k < 8; ++k) { g##S[k] = *(const v4u*)(gpf + k * 1024); s##S[k] = *(const v2u*)(slf + k * 512); } m##S = *gcl; gpf += 8192; slf += 8192; gcl += 64; } while (0)
#define CH_STEP(S) do { bf16x8 xh[4]; \
        _Pragma("unroll") for (int rt = 0; rt < 2; ++rt) _Pragma("unroll") for (int hf = 0; hf < 2; ++hf) { const int rb = 8 * hf; \
            const v4u u = {pk2(X[rt][rb], X[rt][rb + 1]), pk2(X[rt][rb + 2], X[rt][rb + 3]), pk2(X[rt][rb + 4], X[rt][rb + 5]), pk2(X[rt][rb + 6], X[rt][rb + 7])}; \
            xh[2 * rt + hf] = __builtin_bit_cast(bf16x8, u); } \
        _Pragma("unroll") for (int ks = 0; ks < 4; ++ks) *(bf16x8*)(xcf + ks * 1024) = xh[ks]; \
        xcf += 8192; \
        _Pragma("unroll") for (int rt = 0; rt < 2; ++rt) _Pragma("unroll") for (int q = 0; q < 4; ++q) _Pragma("unroll") for (int e = 0; e < 4; ++e) { \
            const float gm_ = __builtin_bit_cast(float, __builtin_amdgcn_ds_bpermute(4 * (32 * rt + 8 * q + e) + hb, __builtin_bit_cast(int, m##S)));     \
            const unsigned sw_ = (e < 2) ? s##S[rt * 4 + q].x : s##S[rt * 4 + q].y; \
            X[rt][4 * q + e] = gm_ * X[rt][4 * q + e] + ((e & 1) ? bfhi(sw_) : bflo(sw_)); } \
        _Pragma("unroll") for (int rt = 0; rt < 2; ++rt) _Pragma("unroll") for (int ks = 0; ks < 4; ++ks) \
            X[rt] = __builtin_amdgcn_mfma_f32_32x32x16_bf16(__builtin_bit_cast(bf16x8, g##S[rt * 4 + ks]), xh[ks], X[rt], 0, 0, 0); } while (0)
    static_assert(NCHK % 3 == 1, "chain_unit: 21 x 3 steps + 1");
    CH_LOAD(A); CH_LOAD(B);
#pragma unroll 1
    for (int c = 0; c < NCHK - 1; c += 3) {
        CH_LOAD(C); CH_STEP(A);
        CH_LOAD(A); CH_STEP(B);
        if (c + 4 < NCHK) CH_LOAD(B);
        CH_STEP(C);
    }
    CH_STEP(A);
#undef CH_LOAD
#undef CH_STEP
    float* so = F.out + O_WP + (size_t)bh * 4096 + (32 * ct + r32) * 64 + 4 * hi;
#pragma unroll
    for (int rt = 0; rt < 2; ++rt)
#pragma unroll
        for (int r = 0; r < 16; ++r) so[32 * rt + CRC(r)] = X[rt][r];
}
__device__ __forceinline__ void ypass_unit(Frame& F, const Args& A, int hc) {
    const int lane = F.lane, r32 = lane & 31, hi = lane >> 5, bh = hc >> 6, c = hc & 63, h = bh & 7, row0 = (bh >> 3) * SEQ + c * 64;
    Frag fa, fb;
    { const unsigned char* xcf = F.ws + WS_XC + (size_t)hc * 8192 + lane * 16;
#pragma unroll
      for (int ct = 0; ct < 2; ++ct)
#pragma unroll
          for (int ks = 0; ks < 4; ++ks) fb[ct][ks] = *(const bf16x8*)(xcf + (ct * 4 + ks) * 1024); }
    { const unsigned char* rhf = F.ws + WS_RH + (size_t)hc * 8192 + lane * 16;
#pragma unroll
      for (int tl = 0; tl < 2; ++tl)
#pragma unroll
          for (int ks = 0; ks < 4; ++ks) fa[tl][ks] = *(const bf16x8*)(rhf + (tl * 4 + ks) * 1024); }
    f32x16 Y[2][2];
    { const unsigned char* ylf = F.ws + WS_YL + (size_t)hc * 16384 + lane * 16;
#pragma unroll
      for (int rt = 0; rt < 2; ++rt)
#pragma unroll
          for (int ct = 0; ct < 2; ++ct)
#pragma unroll
              for (int q = 0; q < 4; ++q) { const f32x4 v_ = *(const f32x4*)(ylf + ((rt * 2 + ct) * 4 + q) * 1024);
                  Y[rt][ct][4 * q] = v_[0]; Y[rt][ct][4 * q + 1] = v_[1]; Y[rt][ct][4 * q + 2] = v_[2]; Y[rt][ct][4 * q + 3] = v_[3]; } }
    const float* BON = (const float*)(F.ws + WS_BON3) + (size_t)(row0 + 4 * hi) * 32 + h * 4; bf16* RW = (bf16*)(F.ws + WS_RW) + (size_t)(row0 + 4 * hi) * 512 + h * 64 + r32;
    const unsigned* VG = rk_pair(F, 2) + (size_t)(row0 + 4 * hi) * 512 + h * 64 + r32;
    unsigned vg0[2][16], vg1[2][16]; float bon[2][16];
#pragma unroll
    for (int rt = 0; rt < 2; ++rt)
#pragma unroll
        for (int r = 0; r < 16; ++r) { vg0[rt][r] = VG[(32 * rt + CRC(r)) * 512]; vg1[rt][r] = VG[(32 * rt + CRC(r)) * 512 + 32]; bon[rt][r] = BON[(32 * rt + CRC(r)) * 32]; }
    float gw[2], gb[2];
#pragma unroll
    for (int ct = 0; ct < 2; ++ct) { gw[ct] = A.in[I_GNW][h * 64 + 32 * ct + r32]; gb[ct] = A.in[I_GNB][h * 64 + 32 * ct + r32]; }
    mm64(fa, fb, Y);
#pragma unroll
    for (int rt = 0; rt < 2; ++rt)
#pragma unroll
        for (int r = 0; r < 16; ++r) {
            const float y0 = Y[rt][0][r], y1 = Y[rt][1][r];
            const float mean = sum32(y0 + y1) * (1.f / 64.f), e0 = y0 - mean, e1 = y1 - mean;
            const float rstd = rsqrtf(sum32(e0 * e0 + e1 * e1) * (1.f / 64.f) + 64e-5f);
            const unsigned a0 = vg0[rt][r], a1 = vg1[rt][r];
            const float o0 = (e0 * rstd * gw[0] + gb[0] + bon[rt][r] * bflo(a0)) * bfhi(a0), o1 = (e1 * rstd * gw[1] + gb[1] + bon[rt][r] * bflo(a1)) * bfhi(a1);
            RW[(32 * rt + CRC(r)) * 512] = (bf16)(pk2(o0, 0.f) & 0xffffu); RW[(32 * rt + CRC(r)) * 512 + 32] = (bf16)(pk2(o1, 0.f) & 0xffffu);
        }
}

constexpr int DP_STRIDE = 260;
__device__ __forceinline__ float half_sum32(float v) { v += __shfl_xor(v, 1); v += __shfl_xor(v, 2); v += __shfl_xor(v, 4); v += __shfl_xor(v, 8); v += __shfl_xor(v, 16); return v; }
__device__ __forceinline__ float sum16(float v) {
    v += __builtin_bit_cast(float, __builtin_amdgcn_update_dpp(0, __builtin_bit_cast(int, v), 0xB1, 0xF, 0xF, true));
    v += __builtin_bit_cast(float, __builtin_amdgcn_update_dpp(0, __builtin_bit_cast(int, v), 0x4E, 0xF, 0xF, true));
    v += __builtin_bit_cast(float, __builtin_amdgcn_update_dpp(0, __builtin_bit_cast(int, v), 0x141, 0xF, 0xF, true));
    v += dpp_rmir(v);
    return v;
}
__device__ __forceinline__ void glds16(const void* gsrc, unsigned lds_dst) { unsigned keep;
    asm volatile("s_mov_b32 %0, m0\n\ts_mov_b32 m0, %2\n\ts_nop 0\n\tglobal_load_lds_dwordx4 %1, off\n\ts_mov_b32 m0, %0" : "=&s"(keep) : "v"(gsrc), "s"(lds_dst) : "memory"); }
struct LdsRows { const LAS unsigned char* b; __device__ __forceinline__ f32x4 operator[](int j) const { return *(const LAS f32x4*)(b + j * 1024); } };
__device__ __forceinline__ void decode_unit(Frame& F, const Args& A, int unit) {
    const int seq = unit >> 5, h = F.wave & 3, lane = F.lane, w = F.wave, d4 = lane & 31, tk = lane >> 5;
    const bf16* QB = (const bf16*)(F.ws + WS_QB);
    const v2u qw = *(const v2u*)(QB + (size_t)(MP + seq) * 512 + h * 128 + 4 * d4);
    const f32x4 q4 = {bflo(qw.x), bfhi(qw.x), bflo(qw.y), bfhi(qw.y)};
    const float slope = exp2f(-2.f * (float)(h + 1)) * 1.4426950408889634f;
    const int pi = (unit & 31) * 2 + (w >> 2), page = ((const int*)A.in[I_PT])[seq * NPAGES + pi];
    const float* kp = A.in[I_CK] + ((size_t)page * PAGE * 4 + h) * 128 + (size_t)tk * 512 + 4 * d4;
    const float* vp = A.in[I_CV] + ((size_t)page * PAGE * 4 + h) * 128 + (size_t)tk * 512 + 4 * d4;
    float m0 = -INFINITY, l0 = 0.f, m1 = -INFINITY, l1 = 0.f; f32x4 o0 = {0.f, 0.f, 0.f, 0.f}, o1 = o0;
    const bool c0 = d4 < 16;
    constexpr int DNB = 8;
    f32x4 kA[DNB], vA[DNB], kB[DNB], vB[DNB];
#define DEC_LOAD(KX, VX, p_) do { _Pragma("unroll") for (int j = 0; j < DNB; ++j) { KX[j] = __builtin_nontemporal_load((const f32x4*)(kp + (size_t)((p_) + j) * 1024)); VX[j] = __builtin_nontemporal_load((const f32x4*)(vp + (size_t)((p_) + j) * 1024)); } } while (0)
#define DEC_COMP(KX, VX, p_) do { float s0[DNB], s1[DNB], mx0 = m0, mx1 = m1; \
        _Pragma("unroll") for (int j = 0; j < DNB; ++j) { const f32x4 kq = KX[j] * q4; \
            const float s = sum16((kq[0] + kq[1]) + (kq[2] + kq[3])) + slope * (float)(pi * PAGE + 2 * ((p_) + j) + tk - PAST), so = __shfl_xor(s, 16); \
            s0[j] = c0 ? s : so; s1[j] = c0 ? so : s; mx0 = fmaxf(mx0, s0[j]); mx1 = fmaxf(mx1, s1[j]); } \
        const float a0 = __builtin_amdgcn_exp2f(m0 - mx0), a1 = __builtin_amdgcn_exp2f(m1 - mx1); \
        l0 *= a0; l1 *= a1; o0 *= a0; o1 *= a1; m0 = mx0; m1 = mx1; \
        _Pragma("unroll") for (int j = 0; j < DNB; ++j) { const float e0 = __builtin_amdgcn_exp2f(s0[j] - m0), e1 = __builtin_amdgcn_exp2f(s1[j] - m1); l0 += e0; l1 += e1; o0 += e0 * VX[j]; o1 += e1 * VX[j]; } } while (0)
    DEC_LOAD(kA, vA, 0);
    for (int p0 = 0; p0 < PAGE / 2; p0 += 2 * DNB) {
        DEC_LOAD(kB, vB, p0 + DNB);
        DEC_COMP(kA, vA, p0);
        if (p0 + 2 * DNB < PAGE / 2) DEC_LOAD(kA, vA, p0 + 2 * DNB);
        DEC_COMP(kB, vB, p0 + DNB);
    }
#undef DEC_LOAD
#undef DEC_COMP
#define SWP(x) __uint_as_float(__builtin_amdgcn_permlane32_swap(__float_as_uint(x), __float_as_uint(x), false, false)[tk ? 0 : 1])
    { const float mb0 = SWP(m0), lb0 = SWP(l0), mb1 = SWP(m1), lb1 = SWP(l1);
      const float M0 = fmaxf(m0, mb0), M1 = fmaxf(m1, mb1);
      const float fa0 = __builtin_amdgcn_exp2f(m0 - M0), fb0 = __builtin_amdgcn_exp2f(mb0 - M0), fa1 = __builtin_amdgcn_exp2f(m1 - M1), fb1 = __builtin_amdgcn_exp2f(mb1 - M1);
      f32x4 r0, r1;
#pragma unroll
      for (int j = 0; j < 4; ++j) { const float ob0 = SWP(o0[j]), ob1 = SWP(o1[j]); r0[j] = o0[j] * fa0 + ob0 * fb0; r1[j] = o1[j] * fa1 + ob1 * fb1; }
      float* dp = (float*)(F.ws + WS_DP2) + (size_t)((seq * 4 + h) * NPAGES + pi) * DP_STRIDE;
      if (lane == 0) *(f32x4*)dp = (f32x4){M0, l0 * fa0 + lb0 * fb0, M1, l1 * fa1 + lb1 * fb1};
      if (tk == 0) { *(f32x4*)(dp + 4 + 4 * d4) = r0; *(f32x4*)(dp + 132 + 4 * d4) = r1; } }
#undef SWP
}
__device__ __forceinline__ void decode_combine(Frame& F, const Args& A, int sh, float lam) {
    const int seq = sh >> 2, h = sh & 3, lane = F.lane, w = F.wave; const size_t ro = (size_t)(MP + seq) * 512 + h * 128 + 2 * lane;
    const float* dp = (const float*)(F.ws + WS_DP2) + (size_t)(sh * NPAGES) * DP_STRIDE;
    const float* dpo = dp + 4 + 2 * lane + (size_t)(8 * w) * DP_STRIDE;
    const unsigned qw = *(const unsigned*)((const bf16*)(F.ws + WS_QB) + ro), kw = *(const unsigned*)((const bf16*)(F.ws + WS_KB) + ro), vw = *(const unsigned*)((const bf16*)(F.ws + WS_VB) + ro);
    const f32x4 ml = *(const f32x4*)(dp + (size_t)lane * DP_STRIDE);
    f32x2 o0[8], o1[8];
#pragma unroll
    for (int i = 0; i < 8; ++i) { o0[i] = *(const f32x2*)(dpo + (size_t)i * DP_STRIDE); o1[i] = *(const f32x2*)(dpo + (size_t)i * DP_STRIDE + 128); }
    const float s = half_sum32(bflo(qw) * bflo(kw) + bfhi(qw) * bfhi(kw)), so = __shfl_xor(s, 32);
    const float sn0 = lane < 32 ? s : so, sn1 = lane < 32 ? so : s;
    float mx0 = ml[0], mx1 = ml[2];
#pragma unroll
    for (int o = 1; o < 64; o <<= 1) { mx0 = fmaxf(mx0, __shfl_xor(mx0, o)); mx1 = fmaxf(mx1, __shfl_xor(mx1, o)); }
    const float M0 = fmaxf(mx0, sn0), M1 = fmaxf(mx1, sn1);
    const float e0 = exp2f(sn0 - M0), e1 = exp2f(sn1 - M1), f0 = exp2f(ml[0] - M0), f1 = exp2f(ml[2] - M1);
    const float L0 = e0 + wave_sum(f0 * ml[1]), L1 = e1 + wave_sum(f1 * ml[3]);
    f32x2 a = {0.f, 0.f}, b = {0.f, 0.f};
#pragma unroll
    for (int i = 0; i < 8; ++i) {
        const float g0 = __builtin_bit_cast(float, __builtin_amdgcn_readlane(__builtin_bit_cast(int, f0), 8 * w + i)), g1 = __builtin_bit_cast(float, __builtin_amdgcn_readlane(__builtin_bit_cast(int, f1), 8 * w + i));
        a.x += g0 * o0[i].x; a.y += g0 * o0[i].y; b.x += g1 * o1[i].x; b.y += g1 * o1[i].y; }
    LAS f32x4* red = (LAS f32x4*)(F.lds + RING_OFF);
    red[w * 64 + lane] = (f32x4){a.x, a.y, b.x, b.y};
    __syncthreads();
    if (w != 0) return;
    a = (f32x2){e0 * bflo(vw), e0 * bfhi(vw)}; b = (f32x2){e1 * bflo(vw), e1 * bfhi(vw)};
#pragma unroll
    for (int i = 0; i < 8; ++i) { const f32x4 t = red[i * 64 + lane]; a.x += t[0]; a.y += t[1]; b.x += t[2]; b.y += t[3]; }
    const float i0 = 1.f / L0, i1 = 1.f / L1;
    const float ox = a.x * i0 - lam * b.x * i1, oy = a.y * i0 - lam * b.y * i1;
    const float rn = rsqrtf(wave_sum(ox * ox + oy * oy) * (1.f / 128.f) + 1e-6f) * 0.8f;
    const float* aog = A.in[I_AOG];
    *(unsigned*)((bf16*)(F.ws + WS_ON) + ro) = pk2(ox * rn * aog[2 * lane], oy * rn * aog[2 * lane + 1]);
}

__device__ __forceinline__ void attn_naive_row(Frame& F, const Args& A, int row, int h, float lam) {
    const int lane = F.lane, t = row & (SEQ - 1), rb = row - t;
    const bf16* QB = (const bf16*)(F.ws + WS_QB); const bf16* KB = (const bf16*)(F.ws + WS_KB); const bf16* VB = (const bf16*)(F.ws + WS_VB);
    const float slope = exp2f(-2.f * (float)(h + 1)) * 1.4426950408889634f;
    float res[2][2];
    for (int c = 0; c < 2; ++c) {
        float q[64];
#pragma unroll
        for (int d = 0; d < 64; d += 2) { const unsigned w = *(const unsigned*)(QB + (size_t)row * 512 + h * 128 + c * 64 + d); q[d] = bflo(w); q[d + 1] = bfhi(w); }
        float m = -INFINITY, l = 0.f, o[128];
#pragma unroll
        for (int d = 0; d < 128; ++d) o[d] = 0.f;
        for (int j = lane; j <= t; j += 64) {
            const bf16* kr = KB + (size_t)(rb + j) * 512 + h * 128 + c * 64; const bf16* vr = VB + (size_t)(rb + j) * 512 + h * 128;
            float s = 0.f;
#pragma unroll
            for (int d = 0; d < 64; d += 8) { const v4u w = *(const v4u*)(kr + d);
                s += q[d] * bflo(w.x) + q[d + 1] * bfhi(w.x) + q[d + 2] * bflo(w.y) + q[d + 3] * bfhi(w.y) + q[d + 4] * bflo(w.z) + q[d + 5] * bfhi(w.z) + q[d + 6] * bflo(w.w) + q[d + 7] * bfhi(w.w); }
            s += slope * (float)(j - t);
            const float mn = fmaxf(m, s), al = exp2f(m - mn), e = exp2f(s - mn);
            l = l * al + e; m = mn;
#pragma unroll
            for (int d = 0; d < 128; d += 8) { const v4u w = *(const v4u*)(vr + d);
                o[d] = o[d] * al + e * bflo(w.x); o[d + 1] = o[d + 1] * al + e * bfhi(w.x); o[d + 2] = o[d + 2] * al + e * bflo(w.y); o[d + 3] = o[d + 3] * al + e * bfhi(w.y);
                o[d + 4] = o[d + 4] * al + e * bflo(w.z); o[d + 5] = o[d + 5] * al + e * bfhi(w.z); o[d + 6] = o[d + 6] * al + e * bflo(w.w); o[d + 7] = o[d + 7] * al + e * bfhi(w.w); }
        }
        float M = m;
#pragma unroll
        for (int x = 1; x < 64; x <<= 1) M = fmaxf(M, __shfl_xor(M, x));
        const float sc = exp2f(m - M);
        const float L = wave_sum(l * sc);
        float r0 = 0.f, r1 = 0.f;
#pragma unroll
        for (int d = 0; d < 128; ++d) { const float tot = wave_sum(o[d] * sc); if ((d & 63) == lane) { if (d < 64) r0 = tot; else r1 = tot; } }
        res[c][0] = r0 / L; res[c][1] = r1 / L;
    }
    const float ox = res[0][0] - lam * res[1][0], oy = res[0][1] - lam * res[1][1];
    const float rn = rsqrtf(wave_sum(ox * ox + oy * oy) * (1.f / 128.f) + 1e-6f) * 0.8f;
    const float* aog = A.in[I_AOG]; bf16* ON = (bf16*)(F.ws + WS_ON) + (size_t)row * 512 + h * 128;
    ON[lane] = (bf16)(pk2(ox * rn * aog[lane], 0.f) & 0xffffu); ON[64 + lane] = (bf16)(pk2(oy * rn * aog[64 + lane], 0.f) & 0xffffu);
}


__device__ __forceinline__ unsigned bfbits(float f) { return __builtin_bit_cast(unsigned, f) >> 16; }
__device__ __forceinline__ void attn_unit(Frame& F, const Args& A, int b, int h, int qb, float lam) {
    LAS unsigned char* Kt = F.lds + RING_OFF;
    LAS float* wsf = (LAS float*)(Kt + 98304) + F.wave * 64;
    LAS float* xch = (LAS float*)Kt;
    const bf16* QB = (const bf16*)(F.ws + WS_QB); const bf16* KB = (const bf16*)(F.ws + WS_KB); const bf16* VB = (const bf16*)(F.ws + WS_VB);
    const int tid = F.tid, lane = F.lane, w = F.wave, c = w >> 2, wq = w & 3, r32 = lane & 31, hi = lane >> 5;
    const int rowbase = b * SEQ, q0 = 128 * qb + 32 * wq, NT = 2 * (qb + 1);
    bf16x8 qr[4];
    { const bf16* Qp = QB + (size_t)(rowbase + q0 + r32) * 512 + (2 * h + c) * 64 + 8 * hi;
#pragma unroll
      for (int d0 = 0; d0 < 4; ++d0) qr[d0] = *(const bf16x8*)(Qp + 16 * d0); }
    asm volatile("" : "+v"(qr[0]), "+v"(qr[1]), "+v"(qr[2]), "+v"(qr[3]));
    const float sl = exp2f(-2.f * (float)(h + 1)) * 1.4426950408889634f;
    const unsigned c1 = __builtin_bit_cast(unsigned, sl) & 0xffff0000u; const float r1 = sl - __builtin_bit_cast(float, c1);
    const unsigned c2 = __builtin_bit_cast(unsigned, r1) & 0xffff0000u; const float r2 = r1 - __builtin_bit_cast(float, c2);
    const unsigned c3 = __builtin_bit_cast(unsigned, r2) & 0xffff0000u;
    const unsigned b1 = c1 >> 16, b2 = c2 >> 16, b3 = c3 >> 16, lo_mask = hi ? 0u : 0xffffffffu;
    const v4u qextu = {(b1 | (b2 << 16)) & lo_mask, (b3 | (b1 << 16)) & lo_mask, (b2 | (b3 << 16)) & lo_mask, 0u};
    const bf16x8 qext = __builtin_bit_cast(bf16x8, qextu);
    const unsigned J0 = bfbits((float)r32), J1 = bfbits((float)(32 + r32));
    const unsigned lds0 = (unsigned)(uintptr_t)(F.lds + RING_OFF);
    const bf16* kg0 = KB + (size_t)(rowbase + lane) * 512 + h * 128 + (2 * w) * 8;
    const bf16* vg0 = VB + (size_t)(rowbase + 32 * (w & 1) + (lane >> 2)) * 512 + h * 128 + (w >> 1) * 32 + (lane & 3) * 8;
    const unsigned kd0 = lds0 + (2 * w) * 1024, vd0 = lds0 + 16384 + (w >> 1) * 4096 + (2 * (w & 1)) * 1024;
#define ATT_DMA(t_, boff_) do { const size_t go_ = (size_t)(t_) * 64 * 512; const unsigned bo_ = (unsigned)(boff_); \
        glds16(kg0 + go_, (unsigned)__builtin_amdgcn_readfirstlane(kd0 + bo_)); glds16(kg0 + go_ + 8, (unsigned)__builtin_amdgcn_readfirstlane(kd0 + bo_ + 1024)); \
        glds16(vg0 + go_, (unsigned)__builtin_amdgcn_readfirstlane(vd0 + bo_)); glds16(vg0 + go_ + (size_t)16 * 512, (unsigned)__builtin_amdgcn_readfirstlane(vd0 + bo_ + 1024)); } while (0)
    ATT_DMA(NT - 1, 0);
    f32x16 o[4];
#pragma unroll
    for (int i = 0; i < 4; ++i) o[i] = (f32x16){};
    float m = -INFINITY, l = 0.f;
    bf16x8 pa[4];
    asm volatile("s_waitcnt vmcnt(0) lgkmcnt(0)\n\ts_barrier" ::: "memory");
#define ATT_QKSM(t, bo) do { \
        const LAS unsigned char* kfp = Kt + (bo) + (c * 8 + hi) * 1024 + r32 * 16; \
        const unsigned Tb = bfbits((float)(64 * (t) - 128 * qb)); \
        f32x16 p[2]; bf16x8 kfr[2][4]; \
        _Pragma("unroll") for (int half = 0; half < 2; ++half) _Pragma("unroll") for (int d0 = 0; d0 < 4; ++d0) kfr[half][d0] = *(const LAS bf16x8*)(kfp + d0 * 2048 + half * 512); \
        __builtin_amdgcn_sched_barrier(0); \
        _Pragma("unroll") for (int half = 0; half < 2; ++half) { f32x16 acc = (f32x16){}; \
            _Pragma("unroll") for (int d0 = 0; d0 < 4; ++d0) acc = __builtin_amdgcn_mfma_f32_32x32x16_bf16(kfr[half][d0], qr[d0], acc, 0, 0, 0); \
            const unsigned Jb = half ? J1 : J0; \
            const v4u ke = {(Tb | (Tb << 16)) & lo_mask, (Tb | (Jb << 16)) & lo_mask, (Jb | (Jb << 16)) & lo_mask, 0u}; \
            p[half] = __builtin_amdgcn_mfma_f32_32x32x16_bf16(__builtin_bit_cast(bf16x8, ke), qext, acc, 0, 0, 0); } \
        if (64 * (t) + 63 > q0) { const int qpos = q0 + r32; \
            _Pragma("unroll") for (int half = 0; half < 2; ++half) _Pragma("unroll") for (int r = 0; r < 16; ++r) { const int kv = 64 * (t) + 32 * half + crow16(r, hi); if (kv > qpos) p[half][r] = -INFINITY; } } \
        float mx = p[0][0]; \
        _Pragma("unroll") for (int r = 1; r < 16; ++r) mx = fmaxf(mx, p[0][r]); \
        _Pragma("unroll") for (int r = 0; r < 16; ++r) mx = fmaxf(mx, p[1][r]); \
        { const auto rr = __builtin_amdgcn_permlane32_swap(__float_as_uint(mx), __float_as_uint(mx), false, false); mx = fmaxf(__uint_as_float(rr[0]), __uint_as_float(rr[1])); } \
        const float mn = fmaxf(m, mx), alpha = __builtin_amdgcn_exp2f(m - mn); m = mn; \
        float ls = 0.f; \
        _Pragma("unroll") for (int half = 0; half < 2; ++half) _Pragma("unroll") for (int r = 0; r < 16; ++r) { const float e = __builtin_amdgcn_exp2f(p[half][r] - mn); p[half][r] = e; ls += e; } \
        { const auto rr = __builtin_amdgcn_permlane32_swap(__float_as_uint(ls), __float_as_uint(ls), false, false); ls = __uint_as_float(rr[0]) + __uint_as_float(rr[1]); } \
        l = l * alpha + ls; \
        if (__any(alpha != 1.f)) { if (hi == 0) wsf[r32] = alpha; LDS_WAIT(); \
            _Pragma("unroll") for (int r = 0; r < 16; ++r) { const float f = wsf[crow16(r, hi)]; _Pragma("unroll") for (int blk = 0; blk < 4; ++blk) o[blk][r] *= f; } } \
        _Pragma("unroll") for (int s = 0; s < 4; ++s) { const int hf = s >> 1, rb = 8 * (s & 1); \
            const v4u u = {pk2(p[hf][rb], p[hf][rb + 1]), pk2(p[hf][rb + 2], p[hf][rb + 3]), pk2(p[hf][rb + 4], p[hf][rb + 5]), pk2(p[hf][rb + 6], p[hf][rb + 7])}; \
            pa[s] = __builtin_bit_cast(bf16x8, u); } } while (0)
#define ATT_PV(bo) do { \
        const LAS unsigned char* vfp = Kt + (bo) + 16384 + ((lane >> 4) & 1) * 32 + (lane & 3) * 8 + (4 * hi + ((lane & 15) >> 2)) * 64; \
        s16x4 vlo[2][4], vhi[2][4]; \
        _Pragma("unroll") for (int s = 0; s < 4; ++s) { vlo[0][s] = vtr(vfp + s * 1024); vhi[0][s] = vtr(vfp + s * 1024 + 512); } \
        _Pragma("unroll") for (int blk = 0; blk < 4; ++blk) { \
            if (blk < 3) { _Pragma("unroll") for (int s = 0; s < 4; ++s) { vlo[(blk + 1) & 1][s] = vtr(vfp + (blk + 1) * 4096 + s * 1024); vhi[(blk + 1) & 1][s] = vtr(vfp + (blk + 1) * 4096 + s * 1024 + 512); } } \
            __builtin_amdgcn_sched_barrier(0); \
            _Pragma("unroll") for (int s = 0; s < 4; ++s) { const s16x4 lo = vlo[blk & 1][s], hh = vhi[blk & 1][s]; \
                const bf16x8 vf = {lo[0], lo[1], lo[2], lo[3], hh[0], hh[1], hh[2], hh[3]}; \
                o[blk] = __builtin_amdgcn_mfma_f32_32x32x16_bf16(pa[s], vf, o[blk], 0, 0, 0); } \
            __builtin_amdgcn_sched_barrier(0); } } while (0)
    bool pend = false; int pbo = 0, bo = 0;
    for (int it = 0; it <= NT; ++it) {
        const int t = NT - 1 - it, bn = (bo == 65536) ? 0 : bo + 32768;
        if (it + 1 < NT) ATT_DMA(t - 1, bn);
        const bool act = it < NT && 64 * t <= q0 + 31;
        if (c == 1 && pend) ATT_PV(pbo);
        if (act) ATT_QKSM(t, bo);
        if (c == 0 && act) ATT_PV(bo);
        if (c == 1) { pend = act; pbo = bo; }
        asm volatile("s_waitcnt vmcnt(0) lgkmcnt(0)\n\ts_barrier" ::: "memory");
        bo = bn;
    }
#undef ATT_QKSM
#undef ATT_PV
#undef ATT_DMA
    if (hi == 0) wsf[r32] = 1.f / l;
    LDS_WAIT();
#pragma unroll
    for (int r = 0; r < 16; ++r) { const float f = wsf[crow16(r, hi)];
#pragma unroll
        for (int blk = 0; blk < 4; ++blk) o[blk][r] *= f; }
    LAS float* xw = xch + wq * 4096;
    if (c == 1) {
#pragma unroll
        for (int blk = 0; blk < 4; ++blk)
#pragma unroll
            for (int r = 0; r < 16; ++r) xw[(blk * 16 + r) * 64 + lane] = o[blk][r];
    }
    __syncthreads();
    if (c == 0) {
        const float* aog = A.in[I_AOG]; bf16* ON = (bf16*)(F.ws + WS_ON);
        float g[4];
#pragma unroll
        for (int blk = 0; blk < 4; ++blk) g[blk] = aog[32 * blk + r32] * 0.8f;
#pragma unroll
        for (int r = 0; r < 16; ++r) {
            float v[4], ss = 0.f;
#pragma unroll
            for (int blk = 0; blk < 4; ++blk) { v[blk] = o[blk][r] - lam * xw[(blk * 16 + r) * 64 + lane]; ss += v[blk] * v[blk]; }
            ss += __shfl_xor(ss, 1); ss += __shfl_xor(ss, 2); ss += __shfl_xor(ss, 4); ss += __shfl_xor(ss, 8); ss += __shfl_xor(ss, 16);
            const float rn = rsqrtf(ss * (1.f / 128.f) + 1e-6f);
            bf16* op = ON + (size_t)(rowbase + q0 + crow16(r, hi)) * 512 + h * 128 + r32;
#pragma unroll
            for (int blk = 0; blk < 4; ++blk) op[32 * blk] = (bf16)(pk2(v[blk] * rn * g[blk], 0.f) & 0xffffu);
        }
    }
    __syncthreads();
}

__device__ __forceinline__ void skinny_tile(Frame& F, LAS float* red, const bf16* A, int lda, const bf16* Bt, int K, int n0) {
    const int lane = F.lane, r = lane & 31, hi = lane >> 5, w = F.wave, kw = K / 8;
    const bf16* ap = A + (size_t)r * lda + w * kw + 8 * hi; const bf16* bp = Bt + (size_t)(n0 + r) * K + w * kw + 8 * hi;
    f32x16 acc = {};
    const int nst = kw / 16;
    for (int s0 = 0; s0 < nst; s0 += 8) {
        bf16x8 av[8], bv[8];
#pragma unroll
        for (int j = 0; j < 8; ++j) { const int k = (s0 + j < nst ? s0 + j : nst - 1) * 16; av[j] = *(const bf16x8*)(ap + k); bv[j] = *(const bf16x8*)(bp + k); }
#pragma unroll
        for (int j = 0; j < 8; ++j) if (s0 + j < nst) acc = __builtin_amdgcn_mfma_f32_32x32x16_bf16(av[j], bv[j], acc, 0, 0, 0);
    }
    __syncthreads();
#pragma unroll
    for (int i = 0; i < 16; ++i) red[w * 1024 + i * 64 + lane] = acc[i];
    __syncthreads();
    for (int e = F.tid; e < 1024; e += 512) { float s = 0.f;
#pragma unroll
        for (int j = 0; j < 8; ++j) s += red[j * 1024 + e];
        red[8 * 1024 + e] = s; }
    __syncthreads();
}

#ifndef MK_N_LAUNCHES
#define MK_N_LAUNCHES 1
#endif
#ifndef MK_NAIVE_ATTN
#define MK_NAIVE_ATTN 0
#endif
constexpr int N_PHASES = 10;
__global__ void __launch_bounds__(NWAVES * 64, 2) mk_fwd(Args args) {
    extern __shared__ __attribute__((aligned(16))) unsigned char lds[];
    Frame F;
#ifdef MK_SUB
    F.pa = 0ull; F.pb = 0ull;
#endif
    F.lds = (LAS unsigned char*)lds;
    F.MISC = (volatile LAS unsigned*)(F.lds + MISC_OFF);
    F.tid = threadIdx.x; F.lane = F.tid & 63; F.wave = __builtin_amdgcn_readfirstlane(F.tid >> 6);
    F.G = gridDim.x; { const int bx = blockIdx.x; F.vcu = (F.G % 8 == 0) ? (bx % 8) * (F.G / 8) + bx / 8 : bx; }
    F.ws = args.ws; F.out = args.out; F.ctl = (gu32*)(args.ws + WS_CTL);
    const Args& A = args;
    for (int u = F.tid; u < (LDS_BYTES - LDSCTL_OFF) / 4; u += NWAVES * 64) ((LAS unsigned*)(F.lds + LDSCTL_OFF))[u] = 0u;
    __syncthreads();
    XcdBarrier bar; bar.bar = (unsigned*)(F.ctl + CW_BAR); bar.x = 0; bar.st = nullptr;
    if (MK_N_LAUNCHES == 1) bar = xcd_barrier_post((unsigned*)(F.ctl + CW_BAR), F.MISC + 8);
#define GRID_BAR() do { if (MK_N_LAUNCHES == 1) xcd_barrier(bar); } while (0)
    const int lo = args.ph_lo, hi = args.ph_hi;
#ifndef MK_PROF
#define MK_PROF -1
#endif
#ifndef MK_PROF_SCALE
#define MK_PROF_SCALE 1e-5f
#endif
    unsigned long long prof_a = 0ull, prof_b = 0ull;
#define PH_BEGIN(k) do { if (MK_PROF == (k)) prof_a = __builtin_amdgcn_s_memrealtime(); } while (0)
#define PH_END(k) do { if (MK_PROF == (k)) prof_b = __builtin_amdgcn_s_memrealtime(); } while (0)
#ifndef MK_DBG_STOP
#define MK_DBG_STOP 99
#endif
#define IN(k) (lo <= (k) && (k) < hi && (k) <= MK_DBG_STOP)
#define BOTH(k) (IN(k) && IN((k) + 1))
    bf16* XB = (bf16*)(F.ws + WS_XB); float* rs0 = (float*)(F.ws + WS_RS0);
    bf16* QB = (bf16*)(F.ws + WS_QB); bf16* KB = (bf16*)(F.ws + WS_KB); bf16* VB = (bf16*)(F.ws + WS_VB); bf16* PC = (bf16*)(F.ws + WS_PC); bf16* GT = (bf16*)(F.ws + WS_GT);
    bf16* ON = (bf16*)(F.ws + WS_ON); bf16* RW = (bf16*)(F.ws + WS_RW); bf16* MG = (bf16*)(F.ws + WS_MG); bf16* X1B = (bf16*)(F.ws + WS_X1B); bf16* HB = (bf16*)(F.ws + WS_HB);
    float* ssq = (float*)(F.ctl + CW_SSQ);
    const int bx = (int)blockIdx.x;

    PH_BEGIN(0);
    if (IN(0)) { for (int i = bx * 512 + F.tid; i < MTOT; i += F.G * 512) ssq[i] = 0.f;
        p0_prologue<0>(F, A, F.vcu * NWAVES + F.wave, F.G * NWAVES); if (BOTH(0)) GRID_BAR(); PH_END(0); }
    PH_BEGIN(1);
    if (IN(1)) {
        pg8::Gemm g{XB, (const bf16*)(F.ws + WS_WIN), nullptr, nullptr, MTOT, INW, DM}; pg8::StaticOrder S; S.init(MTOT, INW, F.G, bx);
        pg8::EpiProj E{rs0, A.in[I_QG], A.in[I_KG], QB, KB, VB, PC, GT, F.out};
        pg8::gemm_phase<pg8::EpiProj, pg8::StaticOrder, true, true>(F.lds + RING_OFF, g, S, E);
        { const int nlong = ((MTOT / 256 + (MTOT % 256 != 0)) * (INW / 256)) % F.G;
          if (nlong == 0) p0_prologue<1>(F, A, bx * NWAVES + F.wave, F.G * NWAVES);
          else if (bx >= nlong) p0_prologue<1>(F, A, (bx - nlong) * NWAVES + F.wave, (F.G - nlong) * NWAVES);
          __syncthreads(); }
        if (BOTH(1)) GRID_BAR(); PH_END(1);
    }
    PH_BEGIN(2);
    if (IN(2)) {
        SUBM(30);
        {
            const int grp = (bx + 2 * F.G >= MP / 32) ? bx % 3 : -1;
            int u = bx;
#pragma unroll 1
            for (int st = 0; ; ++st) {
                if (st == grp) {
                    LAS unsigned* qslot = (LAS unsigned*)(F.lds + LDSCTL_OFF);
                    if (F.tid == 0) qslot[0] = __hip_atomic_fetch_add((unsigned*)(F.ctl + CW_QDEC), 1u, __ATOMIC_RELAXED, __HIP_MEMORY_SCOPE_AGENT);
                    __syncthreads();
                    const unsigned k = qslot[0];
                    __syncthreads();
                    if (k < 1024u) decode_unit(F, A, (int)k);
                    __syncthreads();
                } else if (u < MP / 32) { rwkv_prep_unit(F, A, u); u += F.G; }
                else break;
            }
        }
        SUBM(31);
        SUBM(32);
        if (BOTH(2)) GRID_BAR(); PH_END(2);
    }
    PH_BEGIN(3);
    if (IN(3)) {
        SUBM(10);
        SUBM(11);
        for (int hc = bx * NWAVES + F.wave; hc < 32 * NCHK; hc += F.G * NWAVES) chunk_unit(F, hc);
        __syncthreads();
        if (BOTH(3)) GRID_BAR(); PH_END(3);
    }
    PH_BEGIN(4);
    if (IN(4)) {
        { int ln_ = F.lane, td_ = F.tid; asm volatile("" : "+v"(ln_), "+v"(td_)); F.lane = ln_; F.tid = td_; }
        SUBM(50);
        if (bx < 8) { chain_unit(F, bx * NWAVES + F.wave); __syncthreads(); }
        SUBM(51);
        const float lam = lam_value(F, A);
        LAS unsigned* qslot = (LAS unsigned*)(F.lds + LDSCTL_OFF);
        const unsigned dtail = __hip_atomic_load((unsigned*)(F.ctl + CW_QDEC), __ATOMIC_RELAXED, __HIP_MEMORY_SCOPE_AGENT) < 1024u ? __hip_atomic_load((unsigned*)(F.ctl + CW_QDEC), __ATOMIC_RELAXED, __HIP_MEMORY_SCOPE_AGENT) : 1024u;
        for (;;) {
            { int ln_ = F.lane, td_ = F.tid; asm volatile("" : "+v"(ln_), "+v"(td_)); F.lane = ln_; F.tid = td_; }
            if (F.tid == 0) qslot[0] = __hip_atomic_fetch_add((unsigned*)(F.ctl + CW_QUEUE), 1u, __ATOMIC_RELAXED, __HIP_MEMORY_SCOPE_AGENT);
            __syncthreads();
            const unsigned k = qslot[0];
            __syncthreads();
            if (k >= 1025u) break;
            if (k == 0u) { rwkv_prep_unit(F, A, MP / 32); continue; }
            const unsigned tr = (k - 1u) >> 1, r = (k - 1u) & 1u;
#ifdef MK_SUB
            const unsigned long long t0_ = __builtin_amdgcn_s_memrealtime();
#endif
            if (r == 0u) attn_unit(F, A, (int)(tr & 15u) >> 2, (int)(tr & 3u), 31 - (int)(tr >> 4), lam);
            else { const unsigned d = dtail + 2u * tr; if (d < 1024u) decode_unit(F, A, (int)d); if (d + 1u < 1024u) { __syncthreads(); decode_unit(F, A, (int)(d + 1u)); } }
#ifdef MK_SUB
            if ((MK_SUB == 40 && r == 0u) || (MK_SUB == 41 && r != 0u)) F.pb += __builtin_amdgcn_s_memrealtime() - t0_;
#endif
        }
        if (BOTH(4)) GRID_BAR(); PH_END(4);
    }
    PH_BEGIN(5);
    if (IN(5)) {
        SUBM(20);
        { const float lam = lam_value(F, A);
          for (int it = bx; it < 128; it += F.G) { decode_combine(F, A, it, lam); if (it + F.G < 128) __syncthreads(); } }
        __syncthreads();
        for (int u = 256 + bx; u < 512; u += F.G) scan_seg_unit(F, A, u);
        SUBM(21);
        for (int hc = bx * NWAVES + F.wave; hc < 32 * NCHK; hc += F.G * NWAVES) ypass_unit(F, A, hc);
        SUBM(22);
        __syncthreads();
        if (BOTH(5)) GRID_BAR(); PH_END(5);
    }
    PH_BEGIN(6);
    if (IN(6)) {
        if (bx < 32) {
            LAS float* red = (LAS float*)(F.lds + RING_OFF); const int n0 = 32 * bx; float t1[2];
            skinny_tile(F, red, ON + (size_t)MP * 512, 512, (const bf16*)(F.ws + WS_WPA), 512, n0);
            t1[0] = red[8192 + F.tid]; t1[1] = red[8192 + 512 + F.tid];
            skinny_tile(F, red, RW + (size_t)MP * 512, 512, (const bf16*)(F.ws + WS_WPB), 512, n0);
#pragma unroll
            for (int i = 0; i < 2; ++i) { const int e = F.tid + 512 * i, reg = e >> 6, ln = e & 63, row = crow16(reg, ln >> 5), col = n0 + (ln & 31);
                const float g1 = bf2f(GT[(size_t)(MP + row) * 2048 + col]), g2 = bf2f(GT[(size_t)(MP + row) * 2048 + 1024 + col]);
                MG[(size_t)(MP + row) * 1024 + col] = (bf16)(pk2(g1 * t1[i] + g2 * red[8192 + e], 0.f) & 0xffffu); }
            __syncthreads();
        }
        pg8::Gemm g{ON, (const bf16*)(F.ws + WS_WPA), RW, (const bf16*)(F.ws + WS_WPB), MP, DM, 512}; pg8::PairOrder S; S.base.init(MP, DM, F.G, bx);
        pg8::EpiMerge E{GT, (float*)(F.ws + WS_TMP), MG};
        pg8::gemm_phase<pg8::EpiMerge, pg8::PairOrder, true, true>(F.lds + RING_OFF, g, S, E);
        if (BOTH(6)) GRID_BAR(); PH_END(6);
    }
    PH_BEGIN(7);
    if (IN(7)) {
        if (bx < 32) {
            LAS float* red = (LAS float*)(F.lds + RING_OFF); const int n0 = 32 * bx;
            skinny_tile(F, red, MG + (size_t)MP * 1024, 1024, (const bf16*)(F.ws + WS_WOUT), 1024, n0);
#pragma unroll
            for (int i = 0; i < 2; ++i) { const int e = F.tid + 512 * i, reg = e >> 6, ln = e & 63, row = crow16(reg, ln >> 5), col = n0 + (ln & 31);
                const float v = A.in[I_XS][(size_t)row * 1024 + col] + red[8192 + e];
                F.out[O_YS + (size_t)row * 1024 + col] = v; X1B[(size_t)(MP + row) * 1024 + col] = (bf16)(pk2(v, 0.f) & 0xffffu);
                float ss = v * v; ss += __shfl_xor(ss, 1); ss += __shfl_xor(ss, 2); ss += __shfl_xor(ss, 4); ss += __shfl_xor(ss, 8); ss += __shfl_xor(ss, 16);
                if ((ln & 31) == 0) atomicAdd(ssq + MP + row, ss); }
            __syncthreads();
        }
        pg8::Gemm g{MG, (const bf16*)(F.ws + WS_WOUT), nullptr, nullptr, MP, DM, DM}; pg8::StaticOrder S; S.init(MP, DM, F.G, bx);
        pg8::EpiOut E{XB, X1B, ssq};
        pg8::gemm_phase<pg8::EpiOut, pg8::StaticOrder, false, true>(F.lds + RING_OFF, g, S, E);
        if (BOTH(7)) GRID_BAR(); PH_END(7);
    }
    PH_BEGIN(8);
    if (IN(8)) {
        pg8::Gemm g{X1B, (const bf16*)(F.ws + WS_WGU), nullptr, nullptr, MTOT, NGU, DM}; pg8::StaticOrder S; S.init(MTOT, NGU, F.G, bx);
        pg8::EpiGateUp E{ssq, HB};
        pg8::gemm_phase<pg8::EpiGateUp, pg8::StaticOrder, true, true>(F.lds + RING_OFF, g, S, E);
        if (BOTH(8)) GRID_BAR(); PH_END(8);
    }
    PH_BEGIN(9);
    if (IN(9)) {
        if (bx < 32) {
            LAS float* red = (LAS float*)(F.lds + RING_OFF); const int n0 = 32 * bx;
            skinny_tile(F, red, HB + (size_t)MP * FF, FF, (const bf16*)(F.ws + WS_WDN), FF, n0);
#pragma unroll
            for (int i = 0; i < 2; ++i) { const int e = F.tid + 512 * i, reg = e >> 6, ln = e & 63, row = crow16(reg, ln >> 5), col = n0 + (ln & 31);
                float yv = F.out[O_YS + (size_t)row * 1024 + col] + red[8192 + e];
#ifdef MK_SUB
                prof_a = F.pa; prof_b = F.pb;
#endif
                if (MK_PROF >= 0 && MK_PROF != 9) yv *= 1.f + sqrtf((float)(prof_b - prof_a) * 0.01f * MK_PROF_SCALE);
                F.out[O_YS + (size_t)row * 1024 + col] = yv; }
            __syncthreads();
        }
        pg8::Gemm g{HB, (const bf16*)(F.ws + WS_WDN), nullptr, nullptr, MP, DM, FF}; pg8::StaticOrder S; S.init(MP, DM, F.G, bx);
        pg8::EpiDown E{F.out + O_YP, X1B};
        pg8::gemm_phase<pg8::EpiDown, pg8::StaticOrder, false, true>(F.lds + RING_OFF, g, S, E);
        if (MK_PROF == 9 && MK_N_LAUNCHES == 1) {
            xcd_barrier(bar); prof_b = __builtin_amdgcn_s_memrealtime();
            const float sc = 1.f + sqrtf((float)(prof_b - prof_a) * 0.01f * 1e-5f);
            for (int e = bx * 512 + F.tid; e < 32 * 1024; e += F.G * 512) F.out[O_YS + e] *= sc;
        }
    }
#undef IN
#undef BOTH
}

#if MK_NAIVE_ATTN
__global__ void __launch_bounds__(512, 2) attn_naive_kernel(Args args) {
    Frame F; F.tid = threadIdx.x; F.lane = F.tid & 63; F.wave = __builtin_amdgcn_readfirstlane(F.tid >> 6); F.G = gridDim.x; F.ws = args.ws; F.out = args.out;
    const Args& A = args;
    const float lam = lam_value(F, A);
    const int gw = (int)blockIdx.x * NWAVES + F.wave, NGW = F.G * NWAVES;
    for (int it = gw; it < MP * 4; it += NGW) attn_naive_row(F, A, it >> 2, it & 3, lam);
}
#endif
extern "C" void kernel_launch(void* const* d_in, const int* in_sizes, int n_in, void* d_out, int out_size, void* d_ws, size_t ws_size, hipStream_t stream) {
    static int grid = 0;
    if (grid == 0) {
        if (n_in != 34 || out_size != (int)O_END || ws_size < WS_END) { fprintf(stderr, "kernel_launch: unexpected shapes: n_in %d out %d ws %zu\n", n_in, out_size, ws_size); grid = -1; return; }
        int dev = 0, cus = 0, per_cu = 0;
        if (hipGetDevice(&dev) != hipSuccess || hipDeviceGetAttribute(&cus, hipDeviceAttributeMultiprocessorCount, dev) != hipSuccess) { grid = -1; return; }
        if (hipFuncSetAttribute((const void*)mk_fwd, hipFuncAttributeMaxDynamicSharedMemorySize, LDS_BYTES) != hipSuccess) { fprintf(stderr, "kernel_launch: hipFuncSetAttribute failed\n"); grid = -1; return; }
        if (hipOccupancyMaxActiveBlocksPerMultiprocessor(&per_cu, (const void*)mk_fwd, NWAVES * 64, LDS_BYTES) != hipSuccess || per_cu < 1) fprintf(stderr, "kernel_launch: occupancy query says %d\n", per_cu);
        (void)hipGetLastError();
        grid = cus;
    }
    if (grid < 0) return;
    if (hipMemsetAsync((char*)d_ws + WS_CTL, 0, CTL_ZERO_BYTES, stream) != hipSuccess) return;
    Args a{};
    for (int i = 0; i < 34; ++i) a.in[i] = (const float*)d_in[i];
    a.out = (float*)d_out; a.ws = (unsigned char*)d_ws;
    const int NL = MK_N_LAUNCHES;
    for (int li = 0; li < NL; ++li) {
        a.ph_lo = (NL == 1) ? 0 : li; a.ph_hi = (NL == 1) ? N_PHASES : li + 1; a.li = li; a.pad = 0;
        hipLaunchKernelGGL(mk_fwd, dim3(grid), dim3(NWAVES * 64), LDS_BYTES, stream, a);
        if (hipPeekAtLastError() != hipSuccess) { fprintf(stderr, "kernel_launch: launch %d failed\n", li); break; }
#if MK_NAIVE_ATTN
        if (NL != 1 && li == 3) hipLaunchKernelGGL(attn_naive_kernel, dim3(1024), dim3(512), 0, stream, a);
#endif
    }
}
```

```cpp
#include <hip/hip_runtime.h>
#include <cstdio>
#include <cstdint>

constexpr int MP = 16384, MS = 32, MVALID = MP + MS, MTOT = 16640;
constexpr int DM = 1024, INW = 5376, FF = 2816, NGU = 2 * FF, SEQ = 4096, NBATCH = 4, RSW = 1792;
constexpr int NPAGES = 64, PAGE = 128, PAST = 8192;
constexpr size_t O_YP = 0, O_YS = 16777216, O_KP = O_YS + 32768, O_VP = O_KP + 8388608, O_WP = O_VP + 8388608, O_SP = O_WP + 131072,
                 O_KS = O_SP + 7168, O_VS = O_KS + 16384, O_WS = O_VS + 16384, O_SS = O_WS + 1048576, O_END = O_SS + 57344;
constexpr float QK_C2 = 0.125f * 1.4426950408889634f;
namespace pg8 {
#define PG8_LAS __attribute__((address_space(3)))
typedef unsigned short bf16_t;
typedef short bf16x8 __attribute__((ext_vector_type(8)));
typedef float f32x4 __attribute__((ext_vector_type(4)));
typedef unsigned u32x4 __attribute__((ext_vector_type(4)));
constexpr int BM = 256, BK = 64, HALF = 128, HTB = HALF * BK * 2  , STAGE_BYTES = 8 * HTB, NXCD = 8, WGM = 8;

__host__ __device__ __forceinline__ int lds_byte(int r, int c) { const int st = (r >> 4) * 2 + (c >> 5), rr = r & 15, cc = c & 31, ob = rr * 64 + cc * 2; return st * 1024 + (ob ^ (((ob >> 9) & 1) << 5)); }
__host__ __device__ __forceinline__ void stage_rc(int b, int& R, int& C) { const int st = b / 1024, sb = b % 1024, swz = sb ^ (((sb >> 9) & 1) << 5); R = (st >> 1) * 16 + swz / 64; C = (st & 1) * 32 + (swz % 64) / 2; }
__host__ __device__ __forceinline__ int perm32(int rho) { const int n = rho >> 4, i = rho & 15; return 8 * (i >> 2) + 4 * n + (i & 3); }

struct Unit { int pm, pn, z; };
struct Gemm { const bf16_t* A; const bf16_t* Bt; const bf16_t* A2; const bf16_t* Bt2; int M, N, K; };

struct StaticOrder {
    int nM, nN, nwg, G, c;
    __host__ __device__ void init(int M, int N, int G_, int c_) { nM = M / BM; nN = N / BM; nwg = nM * nN; G = G_; c = c_; }
    __host__ __device__ bool next(int i, Unit& u) const {
        const long L = (long)i * G + c; if (L >= nwg) return false;
        int wgid = (int)L; { const int q = nwg / NXCD, r = nwg % NXCD, xcd = wgid % NXCD, off = wgid / NXCD; wgid = (xcd < r ? xcd * (q + 1) : r * (q + 1) + (xcd - r) * q) + off; }
        const int nig = WGM * nN, gid = wgid / nig, fm = gid * WGM, gsz = (nM - fm) < WGM ? (nM - fm) : WGM;
        u.pm = fm + ((wgid % nig) % gsz); u.pn = (wgid % nig) / gsz; u.z = 0; return true;
    }
    __device__ __forceinline__ void a_ready(const Unit&) const {}
    __device__ __forceinline__ void done(const Unit&) const {}
};

typedef float f32x2_cv __attribute__((ext_vector_type(2))); typedef __bf16 bf16x2_cv __attribute__((ext_vector_type(2)));
__device__ __forceinline__ unsigned cvt_pk_bf16(float lo, float hi) { const f32x2_cv v = {lo, hi}; const bf16x2_cv b = __builtin_convertvector(v, bf16x2_cv); return __builtin_bit_cast(unsigned, b); }
typedef float f32x2 __attribute__((ext_vector_type(2)));
__device__ __forceinline__ void st_bf16x8(bf16_t* p, const f32x4 a, const f32x4 b) {
    u32x4 w; w.x = cvt_pk_bf16(a[0], a[1]); w.y = cvt_pk_bf16(a[2], a[3]); w.z = cvt_pk_bf16(b[0], b[1]); w.w = cvt_pk_bf16(b[2], b[3]); *(u32x4*)p = w;
}
__device__ __forceinline__ float sigmoidf_(float x) { return __builtin_amdgcn_rcpf(1.f + __expf(-x)); }

struct EpiProj {
    static constexpr bool PERM = true, AFTER_DRAIN = false, KEEP_ACC = false;
    const float* rs0; const float* qg; const float* kg;
    bf16_t *QB, *KB, *VB, *PC, *GT; float* out;
    __device__ __forceinline__ void operator()(const f32x4 (&acc)[2][2][4][2], const Unit& u, int wr, int wc, int fr, int fq) const {
        const int pn = u.pn, rb = u.pm * BM + wr * 64 + fr, c8 = 64 * wc + 8 * fq;
        if (pn < 4) {
            const bool isq = pn < 2; const float* gain = isq ? qg : kg;
            f32x4 gv[2][2];
#pragma unroll
            for (int bj = 0; bj < 2; ++bj)
#pragma unroll
                for (int n = 0; n < 2; ++n) gv[bj][n] = *(const f32x4*)(gain + 32 * bj + 8 * fq + 4 * n);
            const int colg = 256 * (pn & 1) + c8;
#pragma unroll
            for (int ai = 0; ai < 2; ++ai)
#pragma unroll
                for (int m = 0; m < 4; ++m) {
                    const int row = rb + ai * HALF + m * 16; const bool ok = row < MVALID; const float rs = rs0[ok ? row : 0];
                    float ss = 0.f;
#pragma unroll
                    for (int bj = 0; bj < 2; ++bj)
#pragma unroll
                        for (int n = 0; n < 2; ++n) { const f32x4 x = acc[ai][bj][m][n] * rs; ss += (x[0] * x[0] + x[1] * x[1]) + (x[2] * x[2] + x[3] * x[3]); }
                    ss += __shfl_xor(ss, 16); ss += __shfl_xor(ss, 32);
                    const float rn = rsqrtf(ss * (1.f / 64.f) + 1e-6f) * rs;
#pragma unroll
                    for (int bj = 0; bj < 2; ++bj) {
                        const f32x4 v0 = acc[ai][bj][m][0] * rn * gv[bj][0], v1 = acc[ai][bj][m][1] * rn * gv[bj][1];
                        const size_t o = (size_t)row * 512 + colg + 32 * bj;
                        if (ok) {
                            if (isq) st_bf16x8(QB + o, v0 * QK_C2, v1 * QK_C2);
                            else { st_bf16x8(KB + o, v0, v1);
                                float* f = row < MP ? out + O_KP + o : out + O_KS + (size_t)(row - MP) * 512 + colg + 32 * bj;
                                *(f32x4*)f = v0; *(f32x4*)(f + 4) = v1; }
                        }
                    }
                }
        } else {
#pragma unroll
            for (int ai = 0; ai < 2; ++ai)
#pragma unroll
                for (int m = 0; m < 4; ++m) {
                    const int row = rb + ai * HALF + m * 16; const bool ok = row < MVALID; const float rs = rs0[ok ? row : 0];
                    if (!ok) continue;
#pragma unroll
                    for (int bj = 0; bj < 2; ++bj) {
                        f32x4 v0 = acc[ai][bj][m][0] * rs, v1 = acc[ai][bj][m][1] * rs;
                        if (pn < 6) {
                            const size_t c = (size_t)(256 * (pn - 4) + c8 + 32 * bj), o = (size_t)row * 512 + c;
                            st_bf16x8(VB + o, v0, v1);
                            float* f = row < MP ? out + O_VP + o : out + O_VS + (size_t)(row - MP) * 512 + c;
                            *(f32x4*)f = v0; *(f32x4*)(f + 4) = v1;
                        } else if (pn < 13) {
                            const size_t c = (size_t)(256 * (pn - 6) + c8 + 32 * bj);
                            st_bf16x8(PC + (size_t)row * RSW + c, v0, v1);
                            if (row >= MP) { float* f = out + O_SS + (size_t)(row - MP) * RSW + c; *(f32x4*)f = v0; *(f32x4*)(f + 4) = v1; }
                            else if ((row & (SEQ - 1)) == SEQ - 1) { float* f = out + O_SP + (size_t)(row >> 12) * RSW + c; *(f32x4*)f = v0; *(f32x4*)(f + 4) = v1; }
                        } else {
                            const size_t c = (size_t)(256 * (pn - 13) + c8 + 32 * bj);
#ifndef MK_DBG_NOSIG
#pragma unroll
                            for (int j = 0; j < 4; ++j) { v0[j] = sigmoidf_(v0[j]); v1[j] = sigmoidf_(v1[j]); }
#endif
                            st_bf16x8(GT + (size_t)row * 2048 + c, v0, v1);
                        }
                    }
                }
        }
    }
};

struct EpiMerge {
    static constexpr bool PERM = true, AFTER_DRAIN = false, KEEP_ACC = true;
    const bf16_t* GT; float* tmp; bf16_t* MG;
    __device__ __forceinline__ void operator()(const f32x4 (&acc_)[2][2][4][2], const Unit& u, int wr, int wc, int fr, int fq) const {
        f32x4 (&acc)[2][2][4][2] = const_cast<f32x4 (&)[2][2][4][2]>(acc_);
        const int rb = u.pm * BM + wr * 64 + fr, cb = u.pn * BM + wc * 32 + 8 * fq;
#pragma unroll
        for (int ai = 0; ai < 2; ++ai)
#pragma unroll
            for (int m = 0; m < 4; ++m) {
                const int row = rb + ai * HALF + m * 16;
#pragma unroll
                for (int bj = 0; bj < 2; ++bj) {
                    const int col = cb + bj * HALF;
                    const u32x4 gw = *(const u32x4*)(GT + (size_t)row * 2048 + 1024 + col);
                    f32x4 g0, g1;
                    g0[0] = __builtin_bit_cast(float, gw.x << 16); g0[1] = __builtin_bit_cast(float, gw.x & 0xffff0000u); g0[2] = __builtin_bit_cast(float, gw.y << 16); g0[3] = __builtin_bit_cast(float, gw.y & 0xffff0000u);
                    g1[0] = __builtin_bit_cast(float, gw.z << 16); g1[1] = __builtin_bit_cast(float, gw.z & 0xffff0000u); g1[2] = __builtin_bit_cast(float, gw.w << 16); g1[3] = __builtin_bit_cast(float, gw.w & 0xffff0000u);
                    if (!u.z) {
                        const u32x4 hw = *(const u32x4*)(GT + (size_t)row * 2048 + col);
                        f32x4 h0, h1;
                        h0[0] = __builtin_bit_cast(float, hw.x << 16); h0[1] = __builtin_bit_cast(float, hw.x & 0xffff0000u); h0[2] = __builtin_bit_cast(float, hw.y << 16); h0[3] = __builtin_bit_cast(float, hw.y & 0xffff0000u);
                        h1[0] = __builtin_bit_cast(float, hw.z << 16); h1[1] = __builtin_bit_cast(float, hw.z & 0xffff0000u); h1[2] = __builtin_bit_cast(float, hw.w << 16); h1[3] = __builtin_bit_cast(float, hw.w & 0xffff0000u);
#pragma unroll
                        for (int e = 0; e < 4; ++e) { acc[ai][bj][m][0][e] *= h0[e] / fmaxf(g0[e], 1e-30f); acc[ai][bj][m][1][e] *= h1[e] / fmaxf(g1[e], 1e-30f); }
                    } else {
                        const f32x4 v0 = acc[ai][bj][m][0] * g0, v1 = acc[ai][bj][m][1] * g1;
                        st_bf16x8(MG + (size_t)row * 1024 + col, v0, v1);
                    }
                }
            }
    }
};
struct EpiOut {
    static constexpr bool PERM = true, AFTER_DRAIN = false, KEEP_ACC = false;
    const bf16_t* xb; bf16_t* X1B; float* ssq;
    __device__ __forceinline__ void operator()(const f32x4 (&acc)[2][2][4][2], const Unit& u, int wr, int wc, int fr, int fq) const {
        const int rb = u.pm * BM + wr * 64 + fr, cb = u.pn * BM + wc * 32 + 8 * fq;
#pragma unroll
        for (int ai = 0; ai < 2; ++ai)
#pragma unroll
            for (int m = 0; m < 4; ++m) {
                const int row = rb + ai * HALF + m * 16; float ss = 0.f;
#pragma unroll
                for (int bj = 0; bj < 2; ++bj) {
                    const size_t o = (size_t)row * 1024 + cb + bj * HALF;
                    const u32x4 xw = *(const u32x4*)(xb + o); f32x4 v0 = acc[ai][bj][m][0], v1 = acc[ai][bj][m][1];
                    v0[0] += __builtin_bit_cast(float, xw.x << 16); v0[1] += __builtin_bit_cast(float, xw.x & 0xffff0000u); v0[2] += __builtin_bit_cast(float, xw.y << 16); v0[3] += __builtin_bit_cast(float, xw.y & 0xffff0000u);
                    v1[0] += __builtin_bit_cast(float, xw.z << 16); v1[1] += __builtin_bit_cast(float, xw.z & 0xffff0000u); v1[2] += __builtin_bit_cast(float, xw.w << 16); v1[3] += __builtin_bit_cast(float, xw.w & 0xffff0000u);
                    st_bf16x8(X1B + o, v0, v1);
                    ss += (v0[0] * v0[0] + v0[1] * v0[1]) + (v0[2] * v0[2] + v0[3] * v0[3]) + (v1[0] * v1[0] + v1[1] * v1[1]) + (v1[2] * v1[2] + v1[3] * v1[3]);
                }
                ss += __shfl_xor(ss, 16); ss += __shfl_xor(ss, 32);
                if (fq == 0) atomicAdd(ssq + row, ss);
            }
    }
};
struct EpiGateUp {
    static constexpr bool PERM = true, AFTER_DRAIN = false, KEEP_ACC = false;
    const float* ssq; bf16_t* HB;
    __device__ __forceinline__ void operator()(const f32x4 (&acc)[2][2][4][2], const Unit& u, int wr, int wc, int fr, int fq) const {
        const int rb = u.pm * BM + wr * 64 + fr, cb = u.pn * HALF + wc * 32 + 8 * fq;
#pragma unroll
        for (int ai = 0; ai < 2; ++ai)
#pragma unroll
            for (int m = 0; m < 4; ++m) {
                const int row = rb + ai * HALF + m * 16; if (row >= MVALID) continue;
                const float rs = rsqrtf(ssq[row] * (1.f / 1024.f) + 1e-6f);
                f32x4 h[2];
#pragma unroll
                for (int n = 0; n < 2; ++n)
#pragma unroll
                    for (int j = 0; j < 4; ++j) { const float g = acc[ai][0][m][n][j] * rs, uu = acc[ai][1][m][n][j] * rs; h[n][j] = g * sigmoidf_(g) * uu; }
                st_bf16x8(HB + (size_t)row * FF + cb, h[0], h[1]);
            }
    }
};
struct EpiDown {
    static constexpr bool PERM = true, AFTER_DRAIN = false, KEEP_ACC = false;
    float* y; const bf16_t* X1B;
    __device__ __forceinline__ void operator()(const f32x4 (&acc)[2][2][4][2], const Unit& u, int wr, int wc, int fr, int fq) const {
        const int rb = u.pm * BM + wr * 64 + fr, cb = u.pn * BM + wc * 32 + 8 * fq;
#pragma unroll
        for (int ai = 0; ai < 2; ++ai)
#pragma unroll
            for (int m = 0; m < 4; ++m) {
                const int row = rb + ai * HALF + m * 16;
#pragma unroll
                for (int bj = 0; bj < 2; ++bj) {
                    float* p = y + (size_t)row * 1024 + cb + bj * HALF; const u32x4 xw = *(const u32x4*)(X1B + (size_t)row * 1024 + cb + bj * HALF);
                    f32x4 v0 = acc[ai][bj][m][0], v1 = acc[ai][bj][m][1];
                    v0[0] += __builtin_bit_cast(float, xw.x << 16); v0[1] += __builtin_bit_cast(float, xw.x & 0xffff0000u); v0[2] += __builtin_bit_cast(float, xw.y << 16); v0[3] += __builtin_bit_cast(float, xw.y & 0xffff0000u);
                    v1[0] += __builtin_bit_cast(float, xw.z << 16); v1[1] += __builtin_bit_cast(float, xw.z & 0xffff0000u); v1[2] += __builtin_bit_cast(float, xw.w << 16); v1[3] += __builtin_bit_cast(float, xw.w & 0xffff0000u);
                    *(f32x4*)p = v0; *(f32x4*)(p + 4) = v1;
                }
            }
    }
};
struct PairOrder {
    StaticOrder base;
    __device__ __forceinline__ bool next(int i, Unit& u) const { if (!base.next(i >> 1, u)) return false; u.z = i & 1; return true; }
    __device__ __forceinline__ void a_ready(const Unit&) const {}
    __device__ __forceinline__ void done(const Unit&) const {}
};

template <class Epi, class Sched, bool ALIGN_EPI = false, bool SP2 = false>
__device__ __forceinline__ void gemm_phase(PG8_LAS unsigned char* lds, const Gemm g, const Sched& S, const Epi& E) {
    const int tid = threadIdx.x, wid = __builtin_amdgcn_readfirstlane(tid >> 6), lane = tid & 63, wr = wid >> 2, wc = wid & 3, fr = lane & 15, fq = lane >> 4;
    const int K = g.K, nt = K / BK;
    unsigned voffA[2], voffB[2];
#pragma unroll
    for (int i = 0; i < 2; ++i) { int R, C; stage_rc(tid * 16 + i * 8192, R, C); const int Rb = Epi::PERM ? ((R & ~31) + perm32(R & 31)) : R;
        voffA[i] = (unsigned)(R * K + C) * 2u; voffB[i] = (unsigned)(Rb * K + C) * 2u; }
    const size_t kstep = (size_t)(BK * 2);
    const size_t hstep = (size_t)HALF * K * 2;
    const size_t tstep = 2 * hstep;
    const unsigned ldsw = (unsigned)wid * 1024u;
    const int aoff = lds_byte(wr * 64 + fr, fq * 8), boff = lds_byte(wc * 32 + fr, fq * 8);
#define PG8_SA(b, h) (((b) * 2 + (h)) * HTB)
#define PG8_SB(b, h) ((4 + (b) * 2 + (h)) * HTB)
#define PG8_STAGE(bufoff, gbase, voff) do { _Pragma("unroll") for (int _i = 0; _i < 2; ++_i) \
        __builtin_amdgcn_global_load_lds((const unsigned*)((const char*)(gbase) + (voff)[_i]), (PG8_LAS unsigned*)(lds + (bufoff) + ldsw + _i * 8192), 16, 0, 0); } while (0)
#define PG8_LDA(dst, b, h) do { _Pragma("unroll") for (int m = 0; m < 4; ++m) _Pragma("unroll") for (int k = 0; k < 2; ++k) dst[m][k] = *(const PG8_LAS bf16x8*)(lds + PG8_SA(b, h) + aoff + m * 2048 + k * 1024); } while (0)
#define PG8_LDB(dst, b, h) do { _Pragma("unroll") for (int n = 0; n < 2; ++n) _Pragma("unroll") for (int k = 0; k < 2; ++k) dst[n][k] = *(const PG8_LAS bf16x8*)(lds + PG8_SB(b, h) + boff + n * 2048 + k * 1024); } while (0)
#define PG8_MMA(ai, bj, At, Bt) do { __builtin_amdgcn_s_setprio(1); _Pragma("unroll") for (int m = 0; m < 4; ++m) _Pragma("unroll") for (int n = 0; n < 2; ++n) _Pragma("unroll") for (int k = 0; k < 2; ++k) \
        acc[ai][bj][m][n] = __builtin_amdgcn_mfma_f32_16x16x32_bf16(Bt[n][k], At[m][k], acc[ai][bj][m][n], 0, 0, 0); __builtin_amdgcn_s_setprio(0); } while (0)
#define PG8_WAIT_V(n) asm volatile("s_waitcnt vmcnt(" #n ")" ::: "memory")
#define PG8_WAIT_L(n) asm volatile("s_waitcnt lgkmcnt(" #n ")" ::: "memory")
#define PG8_BAR __builtin_amdgcn_s_barrier()
#define PG8_SCHED __builtin_amdgcn_sched_barrier(0)
    Unit cur, nxt; int ui = 0;
    if (!S.next(0, cur)) return;
    f32x4 acc[2][2][4][2];
#pragma unroll
    for (int a = 0; a < 2; ++a)
#pragma unroll
        for (int b = 0; b < 2; ++b)
#pragma unroll
            for (int m = 0; m < 4; ++m)
#pragma unroll
                for (int n = 0; n < 2; ++n) acc[a][b][m][n] = (f32x4){0.f, 0.f, 0.f, 0.f};
    bf16x8 At[4][2], B0[2][2], B1[2][2];
    const char* cA = (const char*)(cur.z ? g.A2 : g.A) + (size_t)cur.pm * tstep; const char* cB = (const char*)(cur.z ? g.Bt2 : g.Bt) + (size_t)cur.pn * tstep;
    S.a_ready(cur);
    if constexpr (SP2) {
        PG8_STAGE(PG8_SB(0, 0), cB, voffB); PG8_STAGE(PG8_SB(0, 1), cB + hstep, voffB); PG8_STAGE(PG8_SA(0, 0), cA, voffA); PG8_STAGE(PG8_SA(0, 1), cA + hstep, voffA);
        if (wr == 1) PG8_BAR;
        PG8_WAIT_V(2); PG8_BAR;
        PG8_STAGE(PG8_SB(1, 0), cB + kstep, voffB); PG8_STAGE(PG8_SA(1, 0), cA + kstep, voffA); PG8_STAGE(PG8_SB(1, 1), cB + hstep + kstep, voffB);
        PG8_WAIT_V(6); PG8_BAR;
    } else {
        PG8_STAGE(PG8_SB(0, 0), cB, voffB); PG8_STAGE(PG8_SA(0, 0), cA, voffA); PG8_STAGE(PG8_SB(0, 1), cB + hstep, voffB); PG8_STAGE(PG8_SA(0, 1), cA + hstep, voffA);
        if (wr == 1) PG8_BAR;
        PG8_WAIT_V(4); PG8_BAR;
        PG8_STAGE(PG8_SB(1, 0), cB + kstep, voffB); PG8_STAGE(PG8_SA(1, 0), cA + kstep, voffA); PG8_STAGE(PG8_SB(1, 1), cB + hstep + kstep, voffB);
        PG8_WAIT_V(6); PG8_BAR;
    }
    for (;;) {
        const bool has_next = S.next(ui + 1, nxt);
        const char* nA = has_next ? (const char*)(nxt.z ? g.A2 : g.A) + (size_t)nxt.pm * tstep : cA; const char* nB = has_next ? (const char*)(nxt.z ? g.Bt2 : g.Bt) + (size_t)nxt.pn * tstep : cB;
        for (int t = 0; t < nt; t += 2) {
            const bool last = (t == nt - 2);
            const char* a1 = cA + (size_t)(t + 1) * kstep;
            const char* a2 = last ? nA : cA + (size_t)(t + 2) * kstep; const char* b2 = last ? nB : cB + (size_t)(t + 2) * kstep;
            const char* a3 = a2 + kstep; const char* b3 = b2 + kstep;
            if (last && has_next) S.a_ready(nxt);
            if constexpr (SP2) {
            PG8_LDB(B0, 0, 0); PG8_LDB(B1, 0, 1); PG8_SCHED; PG8_LDA(At, 0, 0); PG8_STAGE(PG8_SA(1, 1), a1 + hstep, voffA);
            PG8_WAIT_V(8); PG8_WAIT_L(0); PG8_BAR; PG8_MMA(0, 0, At, B0); PG8_MMA(0, 1, At, B1); PG8_BAR; PG8_SCHED;
            PG8_LDA(At, 0, 1); PG8_STAGE(PG8_SB(0, 0), b2, voffB); PG8_STAGE(PG8_SB(0, 1), b2 + hstep, voffB); PG8_STAGE(PG8_SA(0, 0), a2, voffA);
            PG8_WAIT_V(8); PG8_WAIT_L(0); PG8_BAR; PG8_MMA(1, 0, At, B0); PG8_MMA(1, 1, At, B1); PG8_BAR; PG8_SCHED;
            PG8_LDB(B0, 1, 0); PG8_LDB(B1, 1, 1); PG8_SCHED; PG8_LDA(At, 1, 0); PG8_STAGE(PG8_SA(0, 1), a2 + hstep, voffA);
            PG8_WAIT_V(8); PG8_WAIT_L(0); PG8_BAR; PG8_MMA(0, 0, At, B0); PG8_MMA(0, 1, At, B1); PG8_BAR; PG8_SCHED;
            PG8_LDA(At, 1, 1); PG8_STAGE(PG8_SB(1, 0), b3, voffB); PG8_STAGE(PG8_SB(1, 1), b3 + hstep, voffB); PG8_STAGE(PG8_SA(1, 0), a3, voffA);
            PG8_WAIT_V(8); PG8_WAIT_L(0); PG8_BAR; PG8_MMA(1, 0, At, B0); PG8_MMA(1, 1, At, B1); PG8_BAR; PG8_SCHED;
            } else {
            PG8_LDB(B0, 0, 0); PG8_SCHED; PG8_LDA(At, 0, 0); PG8_STAGE(PG8_SA(1, 1), a1 + hstep, voffA);
            PG8_WAIT_L(8); PG8_BAR; PG8_WAIT_L(0); PG8_MMA(0, 0, At, B0); PG8_BAR; PG8_SCHED;
            PG8_LDB(B1, 0, 1); PG8_STAGE(PG8_SB(0, 0), b2, voffB);
            PG8_BAR; PG8_WAIT_L(0); PG8_MMA(0, 1, At, B1); PG8_BAR;
            PG8_LDA(At, 0, 1); PG8_STAGE(PG8_SA(0, 0), a2, voffA);
            PG8_BAR; PG8_WAIT_L(0); PG8_MMA(1, 0, At, B0); PG8_BAR; PG8_SCHED;
            PG8_STAGE(PG8_SB(0, 1), b2 + hstep, voffB);
            PG8_WAIT_V(6); PG8_BAR; PG8_MMA(1, 1, At, B1); PG8_BAR;
            PG8_LDB(B0, 1, 0); PG8_SCHED; PG8_LDA(At, 1, 0); PG8_STAGE(PG8_SA(0, 1), a2 + hstep, voffA);
            PG8_WAIT_L(8); PG8_BAR; PG8_WAIT_L(0); PG8_MMA(0, 0, At, B0); PG8_BAR; PG8_SCHED;
            PG8_LDB(B1, 1, 1); PG8_STAGE(PG8_SB(1, 0), b3, voffB);
            PG8_BAR; PG8_WAIT_L(0); PG8_MMA(0, 1, At, B1); PG8_BAR;
            PG8_LDA(At, 1, 1); PG8_STAGE(PG8_SA(1, 0), a3, voffA);
            PG8_BAR; PG8_WAIT_L(0); PG8_MMA(1, 0, At, B0); PG8_BAR; PG8_SCHED;
            PG8_STAGE(PG8_SB(1, 1), b3 + hstep, voffB);
            PG8_WAIT_V(6); PG8_BAR; PG8_MMA(1, 1, At, B1); PG8_BAR;
            }
        }
        if constexpr (ALIGN_EPI) { if (wr == 0) PG8_BAR; }
        if constexpr (!Epi::AFTER_DRAIN) { E(acc, cur, wr, wc, fr, fq); S.done(cur); }
        if (!has_next) break;
        if (!(Epi::KEEP_ACC && cur.z == 0)) {
#pragma unroll
        for (int a = 0; a < 2; ++a)
#pragma unroll
            for (int b = 0; b < 2; ++b)
#pragma unroll
                for (int m = 0; m < 4; ++m)
#pragma unroll
                    for (int n = 0; n < 2; ++n) acc[a][b][m][n] = (f32x4){0.f, 0.f, 0.f, 0.f};
        }
        cur = nxt; cA = nA; cB = nB; ++ui;
        if constexpr (ALIGN_EPI) { if (wr == 1) PG8_BAR; }
    }
    PG8_WAIT_V(0);
    if constexpr (!ALIGN_EPI) { if (wr == 0) PG8_BAR; }
    PG8_BAR;
    if constexpr (Epi::AFTER_DRAIN) { E.fused(acc, cur, wr, wc, fr, fq, lds, wid, lane); S.done(cur); }
#undef PG8_SA
#undef PG8_SB
#undef PG8_STAGE
#undef PG8_LDA
#undef PG8_LDB
#undef PG8_MMA
#undef PG8_WAIT_V
#undef PG8_WAIT_L
#undef PG8_BAR
#undef PG8_SCHED
}
}

constexpr size_t MiB = 1u << 20;
constexpr size_t WS_CTL = 0, CTL_ZERO_BYTES = 1 * MiB;
constexpr size_t WS_WIN = 2 * MiB, WS_WPA = 13 * MiB, WS_WPB = 14 * MiB, WS_WOUT = 15 * MiB, WS_WGU = 17 * MiB, WS_WDN = 28 * MiB;
constexpr size_t WS_LORA = 28 * MiB + (size_t)DM * FF * 2;
static_assert(WS_LORA + 262144 <= 34 * MiB, "lora map");
constexpr size_t WS_XB = 34 * MiB, WS_RS0 = 67 * MiB, WS_QB = 68 * MiB, WS_KB = 85 * MiB, WS_VB = 102 * MiB, WS_PC = 119 * MiB, WS_GT = 176 * MiB;
constexpr size_t WS_ON = 241 * MiB, WS_RW = 258 * MiB, WS_MG = 275 * MiB, WS_TMP = 308 * MiB, WS_X1B = 373 * MiB, WS_HB = 406 * MiB;
constexpr size_t WS_RK = 496 * MiB, RK_STRIDE = 33 * MiB;
constexpr size_t WS_BON = 728 * MiB, WS_DP = 729 * MiB;
constexpr size_t WS_BON3 = 736 * MiB, WS_Y0 = 740 * MiB, WS_CC = 773 * MiB, WS_PSI = 806 * MiB, WS_PHI = 810 * MiB, WS_SST = 814 * MiB, WS_DP2 = 818 * MiB;
constexpr size_t WS_SC = 830 * MiB, WS_RH = 912 * MiB, WS_GP = 928 * MiB, WS_XC = 944 * MiB, WS_YL = 960 * MiB, WS_SL = 992 * MiB, WS_GC = 1024 * MiB, WS_HT = 1025 * MiB, WS_END = 1026 * MiB;
static_assert(WS_WIN + (size_t)INW * DM * 2 <= WS_WPA && WS_WGU + (size_t)NGU * DM * 2 <= WS_WDN && WS_WDN + (size_t)DM * FF * 2 <= WS_XB, "weights map");
static_assert(WS_XB + (size_t)MTOT * DM * 2 <= WS_RS0 && WS_QB + (size_t)MTOT * 512 * 2 <= WS_KB && WS_PC + (size_t)MTOT * RSW * 2 <= WS_GT && WS_GT + (size_t)MTOT * 2048 * 2 <= WS_ON, "act map 1");
static_assert(WS_MG + (size_t)MTOT * DM * 2 <= WS_TMP && WS_TMP + (size_t)MTOT * DM * 4 <= WS_X1B && WS_X1B + (size_t)MTOT * DM * 2 <= WS_HB && WS_HB + (size_t)MTOT * FF * 2 <= WS_RK, "act map 2");
static_assert((size_t)MTOT * 512 * 4 <= RK_STRIDE && WS_RK + 7 * RK_STRIDE <= WS_BON, "rwkv map");
constexpr int CW_TMO = 0, CW_CODE = 1;
constexpr int CW_BAR = 4096;
constexpr int CW_SSQ = 32768;
constexpr int CW_QUEUE = 2048;
constexpr int CW_QDEC = 2112;
constexpr int CW_DCNT = 65536;
static_assert((CW_DCNT + 128 * 64) * 4 <= (int)CTL_ZERO_BYTES, "CTL map");

constexpr int RING_OFF = 0, RING_BYTES = 139264;
constexpr int LDSCTL_OFF = RING_BYTES, MISC_OFF = LDSCTL_OFF + 320;
constexpr int LDS_BYTES = 155648;
constexpr int NWAVES = 8;

#define GAS __attribute__((address_space(1)))
#define LAS __attribute__((address_space(3)))
typedef unsigned short bf16;
typedef unsigned v4u __attribute__((ext_vector_type(4)));
typedef unsigned v2u __attribute__((ext_vector_type(2)));
typedef float f32x4 __attribute__((ext_vector_type(4)));
typedef float f32x2 __attribute__((ext_vector_type(2)));
typedef float f32x16 __attribute__((ext_vector_type(16)));
typedef short bf16x8 __attribute__((ext_vector_type(8)));
typedef short s16x4 __attribute__((ext_vector_type(4)));
typedef GAS unsigned gu32;
#define RLX_AGENT __ATOMIC_RELAXED, __HIP_MEMORY_SCOPE_AGENT
#define LDS_WAIT() asm volatile("s_waitcnt lgkmcnt(0)" ::: "memory")
#define VM_WAIT() asm volatile("s_waitcnt vmcnt(0)" ::: "memory")
__device__ __forceinline__ unsigned pk2(float lo, float hi) { return pg8::cvt_pk_bf16(lo, hi); }
using pg8::sigmoidf_;
__device__ __forceinline__ float bf2f(unsigned short b) { return __builtin_bit_cast(float, (unsigned)b << 16); }
__device__ __forceinline__ float bflo(unsigned w) { return __builtin_bit_cast(float, w << 16); }
__device__ __forceinline__ float bfhi(unsigned w) { return __builtin_bit_cast(float, w & 0xffff0000u); }

#define XB_TMO      128
#define XB_XCNT(j)  (256  + 64 * (j))
#define XB_XSUB(j)  (1280 + 64 * (j))
#define XB_XGEN(j)  (2304 + 64 * (j))
#define XB_TOP      3328
#define XB_TOPGEN   3392
#define XCD_BAR_WORDS 3456
#define XB_SPIN_CAP (1u << 18)

__device__ __forceinline__ unsigned xb_ld(unsigned* p)              { return __hip_atomic_load(p, __ATOMIC_RELAXED, __HIP_MEMORY_SCOPE_AGENT); }
__device__ __forceinline__ unsigned xb_add(unsigned* p, unsigned v) { return __hip_atomic_fetch_add(p, v, __ATOMIC_RELAXED, __HIP_MEMORY_SCOPE_AGENT); }
__device__ __forceinline__ unsigned xb_xcc_id() { return (unsigned)__builtin_amdgcn_s_getreg((3 << 11) | 20) & 0xFu; }
#define XB_SPIN(cond, bar) do { unsigned _sp = 0; while (cond) { __builtin_amdgcn_s_sleep(1); \
    if ((++_sp & 255u) == 0u) { if (xb_ld(&(bar)[XB_TMO])) break; if (_sp > XB_SPIN_CAP) { atomicAdd(&(bar)[XB_TMO], 1u); break; } } } } while (0)

struct XcdBarrier {
    unsigned* bar; unsigned x;
    volatile LAS unsigned* st;
};

__device__ __forceinline__ XcdBarrier xcd_barrier_post(unsigned* bar, volatile LAS unsigned* st) {
    XcdBarrier b; b.bar = bar; b.x = xb_xcc_id(); b.st = st;
    if (threadIdx.x == 0) (void)xb_add(&bar[XB_XCNT(b.x)], 1u);
    return b;
}
__device__ __forceinline__ void xcd_barrier_complete(unsigned* bar, unsigned x, unsigned& nloc, unsigned& nx) {
    const unsigned G = gridDim.x * gridDim.y * gridDim.z;
    unsigned sum, cnt, mine, sp = 0u;
    for (;;) {
        sum = 0u; cnt = 0u; mine = 0u;
#pragma unroll
        for (unsigned j = 0; j < 16; ++j) { const unsigned c = xb_ld(&bar[XB_XCNT(j)]); sum += c; cnt += (c > 0u) ? 1u : 0u; mine = (j == x) ? c : mine; }
        if (sum == G) break;
        __builtin_amdgcn_s_sleep(1);
        if ((++sp & 255u) == 0u) { if (xb_ld(&bar[XB_TMO])) break; if (sp > XB_SPIN_CAP) { atomicAdd(&bar[XB_TMO], 1u); break; } }
    }
    nloc = mine > 0u ? mine : 1u; nx = cnt > 0u ? cnt : 1u;
}

__device__ __forceinline__ void xcd_barrier(const XcdBarrier& b) {
    asm volatile("s_waitcnt vmcnt(0)" ::: "memory");
    __syncthreads();
    if (threadIdx.x == 0) {
        unsigned* bar = b.bar;
        __builtin_amdgcn_s_waitcnt(0);
        unsigned nloc = b.st[0], nx = b.st[1];
        if (nloc == 0u) { xcd_barrier_complete(bar, b.x, nloc, nx); b.st[0] = nloc; b.st[1] = nx; }
        const unsigned old = xb_add(&bar[XB_XSUB(b.x)], 1u);
        const unsigned gen = old / nloc;
        if (old + 1u == (gen + 1u) * nloc) {
            __builtin_amdgcn_fence(__ATOMIC_RELEASE, "agent");
            asm volatile("s_waitcnt vmcnt(0)" ::: "memory");
            const unsigned og = xb_add(&bar[XB_TOP], 1u);
            const unsigned tg = og / nx;
            if (og + 1u == (tg + 1u) * nx) xb_add(&bar[XB_TOPGEN], 1u);
            else XB_SPIN(xb_ld(&bar[XB_TOPGEN]) == tg, bar);
            __builtin_amdgcn_fence(__ATOMIC_ACQUIRE, "agent");
            xb_add(&bar[XB_XGEN(b.x)], 1u);
            asm volatile("s_waitcnt vmcnt(0)" ::: "memory");
        } else {
            XB_SPIN(xb_ld(&bar[XB_XGEN(b.x)]) == gen, bar);
            __builtin_amdgcn_fence(__ATOMIC_ACQUIRE, "agent");
            asm volatile("s_waitcnt vmcnt(0)" ::: "memory");
        }
    }
    __syncthreads();
}

struct Args { const float* in[34]; float* out; unsigned char* ws; int ph_lo, ph_hi, li, pad; };
struct Frame {
    LAS unsigned char* lds;
    volatile LAS unsigned* MISC;
    gu32* ctl;
    int tid, lane, wave, vcu, G;
    unsigned char* ws; float* out;
#ifdef MK_SUB
    unsigned long long pa, pb;
#endif
};
#ifdef MK_SUB
#define SUBM(k) do { if (MK_SUB == (k)) F.pa = __builtin_amdgcn_s_memrealtime(); if (MK_SUB + 1 == (k)) F.pb = __builtin_amdgcn_s_memrealtime(); } while (0)
#else
#define SUBM(k) do { } while (0)
#endif
enum { I_XP = 0, I_XS, I_CK, I_CV, I_PT, I_SWKV, I_SSH, I_NMIX, I_WIN, I_QG, I_KG, I_LQ1, I_LK1, I_LQ2, I_LK2, I_AOG, I_WPA, I_MU, I_W0, I_W2, I_A0, I_A2, I_G2,
       I_KK, I_KA, I_RK, I_GNW, I_GNB, I_WPB, I_WOUT, I_NFFN, I_WG, I_WU, I_WD };

__device__ __forceinline__ float wave_sum(float v) {
#pragma unroll
    for (int o = 1; o < 64; o <<= 1) v += __shfl_xor(v, o);
    return v;
}

__device__ __forceinline__ float dpp_rmir(float v) { return __builtin_bit_cast(float, __builtin_amdgcn_update_dpp(0, __builtin_bit_cast(int, v), 0x140, 0xF, 0xF, true)); }
__device__ __forceinline__ float sum32(float v) {
    v += __builtin_bit_cast(float, __builtin_amdgcn_update_dpp(0, __builtin_bit_cast(int, v), 0xB1, 0xF, 0xF, true));
    v += __builtin_bit_cast(float, __builtin_amdgcn_update_dpp(0, __builtin_bit_cast(int, v), 0x4E, 0xF, 0xF, true));
    v += __builtin_bit_cast(float, __builtin_amdgcn_update_dpp(0, __builtin_bit_cast(int, v), 0x141, 0xF, 0xF, true));
    v += dpp_rmir(v);
    v += __shfl_xor(v, 16);
    return v;
}
__device__ __forceinline__ void p0_transpose_item(const float* W, int K, int N, bf16* WT, int drow0, const float* kgain, LAS float* scr, int k0, int n0, int lane) {
    float v[32];
    const float* wp = W + (size_t)(k0 + (lane >> 5)) * N + n0 + (lane & 31);
#pragma unroll
    for (int i = 0; i < 32; ++i) v[i] = wp[(size_t)(2 * i) * N];
    const int c = lane & 7;
    f32x4 g0 = {1.f, 1.f, 1.f, 1.f}, g1 = g0;
    if (kgain) { g0 = *(const f32x4*)(kgain + k0 + 8 * c); g1 = *(const f32x4*)(kgain + k0 + 8 * c + 4); }
#pragma unroll
    for (int i = 0; i < 32; ++i) scr[(2 * i + (lane >> 5)) * 33 + (lane & 31)] = v[i];
    LDS_WAIT(); asm volatile("" ::: "memory");
#pragma unroll
    for (int j = 0; j < 4; ++j) { const int n = (lane >> 3) + 8 * j; const LAS float* s = scr + (8 * c) * 33 + n;
        v4u o; o.x = pk2(s[0 * 33] * g0[0], s[1 * 33] * g0[1]); o.y = pk2(s[2 * 33] * g0[2], s[3 * 33] * g0[3]); o.z = pk2(s[4 * 33] * g1[0], s[5 * 33] * g1[1]); o.w = pk2(s[6 * 33] * g1[2], s[7 * 33] * g1[3]);
        *(GAS v4u*)(WT + (size_t)(drow0 + n) * K + k0 + 8 * c) = o; }
    LDS_WAIT(); asm volatile("" ::: "memory");
}
template <int PART> __device__ __forceinline__ void p0_prologue(Frame& F, const Args& A, int gw, int NGW) {
    LAS float* scr = (LAS float*)(F.lds + RING_OFF + F.wave * 16384);
    bf16* Win_t = (bf16*)(F.ws + WS_WIN); bf16* Wpa_t = (bf16*)(F.ws + WS_WPA); bf16* Wpb_t = (bf16*)(F.ws + WS_WPB); bf16* Wout_t = (bf16*)(F.ws + WS_WOUT);
    bf16* Wgu_t = (bf16*)(F.ws + WS_WGU); bf16* Wdn_t = (bf16*)(F.ws + WS_WDN);
    constexpr int I_IN = (DM / 64) * (INW / 32), I_PA = (512 / 64) * (DM / 32), I_OUT = (DM / 64) * (DM / 32), I_G = (DM / 64) * (FF / 32), I_D = (FF / 64) * (DM / 32);
    constexpr int I_L = 16, NITEMS = I_IN + 2 * I_PA + I_OUT + 2 * I_G + I_D + 4 * I_L;
    constexpr int NP0 = I_IN + 4 * I_L, NP1 = NITEMS - NP0;
    for (int ix = gw; ix < (PART == 0 ? NP0 : NP1); ix += NGW) {
        int r = PART == 0 ? (ix < I_IN ? ix : ix - I_IN + (NITEMS - 4 * I_L)) : ix + I_IN;
        if (r < I_IN) { constexpr int nnb = INW / 32; const int kb = r / nnb, nb = r % nnb, pn = nb >> 3, q = nb & 7;
            p0_transpose_item(A.in[I_WIN], DM, INW, Win_t, 256 * pn + 32 * (4 * (q & 1) + (q >> 1)), A.in[I_NMIX], scr, 64 * kb, 32 * nb, F.lane); continue; } r -= I_IN;
        if (r < I_PA) { constexpr int nnb = DM / 32; const int kb = r / nnb, nb = r % nnb; p0_transpose_item(A.in[I_WPA], 512, DM, Wpa_t, 32 * nb, nullptr, scr, 64 * kb, 32 * nb, F.lane); continue; } r -= I_PA;
        if (r < I_PA) { constexpr int nnb = DM / 32; const int kb = r / nnb, nb = r % nnb; p0_transpose_item(A.in[I_WPB], 512, DM, Wpb_t, 32 * nb, nullptr, scr, 64 * kb, 32 * nb, F.lane); continue; } r -= I_PA;
        if (r < I_OUT) { constexpr int nnb = DM / 32; const int kb = r / nnb, nb = r % nnb; p0_transpose_item(A.in[I_WOUT], DM, DM, Wout_t, 32 * nb, nullptr, scr, 64 * kb, 32 * nb, F.lane); continue; } r -= I_OUT;
        if (r < I_G) { constexpr int nnb = FF / 32; const int kb = r / nnb, nb = r % nnb;
            p0_transpose_item(A.in[I_WG], DM, FF, Wgu_t, 256 * (nb >> 2) + 32 * (nb & 3), A.in[I_NFFN], scr, 64 * kb, 32 * nb, F.lane); continue; } r -= I_G;
        if (r < I_G) { constexpr int nnb = FF / 32; const int kb = r / nnb, nb = r % nnb;
            p0_transpose_item(A.in[I_WU], DM, FF, Wgu_t, 256 * (nb >> 2) + 128 + 32 * (nb & 3), A.in[I_NFFN], scr, 64 * kb, 32 * nb, F.lane); continue; } r -= I_G;
        if (r < I_D) { constexpr int nnb = DM / 32; const int kb = r / nnb, nb = r % nnb; p0_transpose_item(A.in[I_WD], FF, DM, Wdn_t, 32 * nb, nullptr, scr, 64 * kb, 32 * nb, F.lane); continue; } r -= I_D;
        { bf16* W2T = (bf16*)(F.ws + WS_LORA); bf16* A2T = W2T + 512 * 64; bf16* G2T = A2T + 512 * 64;
          if (r < I_L) p0_transpose_item(A.in[I_W2], 64, 512, W2T, 32 * r, nullptr, scr, 0, 32 * r, F.lane);
          else if (r < 2 * I_L) p0_transpose_item(A.in[I_A2], 64, 512, A2T, 32 * (r - I_L), nullptr, scr, 0, 32 * (r - I_L), F.lane);
          else { const int q = r - 2 * I_L; p0_transpose_item(A.in[I_G2], 128, 512, G2T, 32 * (q & 15), nullptr, scr, 64 * (q >> 4), 32 * (q & 15), F.lane); } }
    }
    if (PART != 0) return;
    bf16* XB = (bf16*)(F.ws + WS_XB); float* rs0 = (float*)(F.ws + WS_RS0);
    for (int m0 = gw; m0 < MTOT; m0 += 4 * NGW) {
        f32x4 v[4][4];
#pragma unroll
        for (int q = 0; q < 4; ++q) { const int m = m0 + q * NGW;
            if (m < MVALID) { const float* xrow = m < MP ? A.in[I_XP] + (size_t)m * DM : A.in[I_XS] + (size_t)(m - MP) * DM; const GAS f32x4* xr = (const GAS f32x4*)xrow + F.lane;
#pragma unroll
                for (int j = 0; j < 4; ++j) v[q][j] = xr[64 * j]; }
            else {
#pragma unroll
                for (int j = 0; j < 4; ++j) v[q][j] = (f32x4){0.f, 0.f, 0.f, 0.f}; } }
#pragma unroll
        for (int q = 0; q < 4; ++q) { const int m = m0 + q * NGW; if (m >= MTOT) continue;
            GAS unsigned long long* o8 = (GAS unsigned long long*)(XB + (size_t)m * DM) + F.lane; float s = 0.f;
#pragma unroll
            for (int j = 0; j < 4; ++j) { s += (v[q][j].x * v[q][j].x + v[q][j].y * v[q][j].y) + (v[q][j].z * v[q][j].z + v[q][j].w * v[q][j].w);
                o8[64 * j] = (unsigned long long)pk2(v[q][j].x, v[q][j].y) | ((unsigned long long)pk2(v[q][j].z, v[q][j].w) << 32); }
            s = sum32(s); { const auto rr = __builtin_amdgcn_permlane32_swap(__float_as_uint(s), __float_as_uint(s), false, false); s = __uint_as_float(rr[0]) + __uint_as_float(rr[1]); }
            if (F.lane == 0) rs0[m] = m < MVALID ? rsqrtf(s * (1.f / DM) + 1e-6f) : 0.f; }
    }
}

__device__ __forceinline__ int crow16(int r, int hi) { return (r & 3) + 8 * (r >> 2) + 4 * hi; }
__device__ __forceinline__ float lam_value(const Frame& F, const Args& A) {
    const int l = F.lane;
    const float a = wave_sum(A.in[I_LQ1][l] * A.in[I_LK1][l]), b = wave_sum(A.in[I_LQ2][l] * A.in[I_LK2][l]);
    return __expf(a) - __expf(b) + 0.2f;
}
__device__ __forceinline__ f32x4 ld_bf4(const bf16* p) { const v2u w = *(const v2u*)p; return (f32x4){bflo(w.x), bfhi(w.x), bflo(w.y), bfhi(w.y)}; }
__device__ __forceinline__ unsigned* rk_pair(const Frame& F, int i) { return (unsigned*)(F.ws + WS_RK + (size_t)i * RK_STRIDE); }
__device__ __forceinline__ bf16* rk_bf(const Frame& F, int i) { return (bf16*)(F.ws + WS_RK + (size_t)i * RK_STRIDE); }
__device__ __forceinline__ float* rk_arr(const Frame& F, int i) { return (float*)(F.ws + WS_RK + (size_t)i * RK_STRIDE); }

#define CRC(r) (((r) & 3) + 8 * ((r) >> 2))
constexpr int LIN_LD = 264, MS_LD = 1544;
__device__ __forceinline__ float tanh_fast(float x) { return 1.f - 2.f * __builtin_amdgcn_rcpf(1.f + __expf(2.f * x)); }
__device__ __forceinline__ void rwkv_prep_unit(Frame& F, const Args& A, int unit) {
    LAS bf16* msl = (LAS bf16*)(F.lds + RING_OFF);
    LAS bf16* lin = msl + 32 * MS_LD;
    const bf16* PC = (const bf16*)(F.ws + WS_PC);
    int r32_ = F.lane & 31, hi_ = F.lane >> 5; asm volatile("" : "+v"(r32_), "+v"(hi_));
    const int r0 = unit * 32, tid = F.tid, lane = F.lane, w = F.wave, r32 = r32_, hi = hi_;
    const float* mu = A.in[I_MU]; const float* ssh = A.in[I_SSH];
#pragma unroll 7
    for (int k = 0; k < 14; ++k) {
        const int p = tid + 512 * k, t = p / 224, c8 = p - 224 * t, row = r0 + t;
        const v4u cw = *(const v4u*)(PC + (size_t)row * RSW + 8 * c8);
        float cur[8] = {bflo(cw.x), bfhi(cw.x), bflo(cw.y), bfhi(cw.y), bflo(cw.z), bfhi(cw.z), bflo(cw.w), bfhi(cw.w)}, prv[8];
        if (row >= MP) { const f32x4 a = *(const f32x4*)(ssh + (size_t)(row - MP) * RSW + 8 * c8), b = *(const f32x4*)(ssh + (size_t)(row - MP) * RSW + 8 * c8 + 4);
#pragma unroll
            for (int j = 0; j < 4; ++j) { prv[j] = a[j]; prv[4 + j] = b[j]; } }
        else if ((row & (SEQ - 1)) == 0) {
#pragma unroll
            for (int j = 0; j < 8; ++j) prv[j] = 0.f; }
        else { const v4u pw = *(const v4u*)(PC + (size_t)(row - 1) * RSW + 8 * c8);
            prv[0] = bflo(pw.x); prv[1] = bfhi(pw.x); prv[2] = bflo(pw.y); prv[3] = bfhi(pw.y); prv[4] = bflo(pw.z); prv[5] = bfhi(pw.z); prv[6] = bflo(pw.w); prv[7] = bfhi(pw.w); }
        const f32x4 m0 = *(const f32x4*)(mu + 8 * c8), m1 = *(const f32x4*)(mu + 8 * c8 + 4);
        float m[8];
#pragma unroll
        for (int j = 0; j < 4; ++j) { m[j] = cur[j] + (prv[j] - cur[j]) * m0[j]; m[4 + j] = cur[4 + j] + (prv[4 + j] - cur[4 + j]) * m1[j]; }
        if (c8 >= 192) { const int ci = 8 * (c8 - 192);
#pragma unroll
            for (int j = 0; j < 8; ++j) { if (ci < 64) m[j] = tanh_fast(m[j]); else if (ci >= 128) m[j] = sigmoidf_(m[j]); }
            *(LAS v4u*)(lin + t * LIN_LD + ci) = (v4u){pk2(m[0], m[1]), pk2(m[2], m[3]), pk2(m[4], m[5]), pk2(m[6], m[7])}; }
        else *(LAS v4u*)(msl + t * MS_LD + 8 * c8) = (v4u){pk2(m[0], m[1]), pk2(m[2], m[3]), pk2(m[4], m[5]), pk2(m[6], m[7])};
    }
    __syncthreads();
    f32x16 wl[2], al[2], gg[2];
    const bf16* W2T = (const bf16*)(F.ws + WS_LORA); const bf16* A2T = W2T + 512 * 64; const bf16* G2T = A2T + 512 * 64;
#pragma unroll
    for (int ct = 0; ct < 2; ++ct) {
        const int ch = 64 * w + 2 * r32 + ct;
        f32x16 a0 = (f32x16){}, a1 = (f32x16){}, a2 = (f32x16){};
#pragma unroll
        for (int ks = 0; ks < 4; ++ks) {
            const bf16x8 x0 = *(const LAS bf16x8*)(lin + r32 * LIN_LD + 16 * ks + 8 * hi), x1 = *(const LAS bf16x8*)(lin + r32 * LIN_LD + 64 + 16 * ks + 8 * hi);
            const bf16x8 b0 = *(const bf16x8*)(W2T + (size_t)ch * 64 + 16 * ks + 8 * hi), b1 = *(const bf16x8*)(A2T + (size_t)ch * 64 + 16 * ks + 8 * hi);
            a0 = __builtin_amdgcn_mfma_f32_32x32x16_bf16(x0, b0, a0, 0, 0, 0); a1 = __builtin_amdgcn_mfma_f32_32x32x16_bf16(x1, b1, a1, 0, 0, 0);
        }
#pragma unroll
        for (int ks = 0; ks < 8; ++ks) {
            const bf16x8 x2 = *(const LAS bf16x8*)(lin + r32 * LIN_LD + 128 + 16 * ks + 8 * hi);
            const bf16x8 b2 = *(const bf16x8*)(G2T + (size_t)ch * 128 + 16 * ks + 8 * hi);
            a2 = __builtin_amdgcn_mfma_f32_32x32x16_bf16(x2, b2, a2, 0, 0, 0);
        }
        wl[ct] = a0; al[ct] = a1; gg[ct] = a2;
    }
    bf16* aR = rk_bf(F, 0); float* aW = rk_arr(F, 1); bf16* aK = rk_bf(F, 2); bf16* aV = rk_bf(F, 3); bf16* aA = rk_bf(F, 4); bf16* aB = rk_bf(F, 5); bf16* aG = rk_bf(F, 6);
    float* BON = (float*)(F.ws + WS_BON3);
    float w0c[2], a0c[2], kkc[2], kac[2], rkc[2];
#pragma unroll
    for (int ct = 0; ct < 2; ++ct) { const int ch = 64 * w + 2 * r32 + ct; w0c[ct] = A.in[I_W0][ch]; a0c[ct] = A.in[I_A0][ch]; kkc[ct] = A.in[I_KK][ch]; kac[ct] = A.in[I_KA][ch]; rkc[ct] = A.in[I_RK][ch]; }
    if (unit < MP / 32) {
        float lwv[2][16], pin[2][16], off[2];
        int r32o = r32; asm volatile("" : "+v"(r32o));
#pragma unroll
        for (int ct = 0; ct < 2; ++ct)
#pragma unroll
            for (int r = 0; r < 16; ++r) { const float x = -(w0c[ct] + wl[ct][r]), sp = fmaxf(x, 0.f) + __logf(1.f + __expf(-fabsf(x))); lwv[ct][r] = -__expf(-sp - 0.5f); }
#pragma unroll
        for (int ct = 0; ct < 2; ++ct) { float run = 0.f;
#pragma unroll
            for (int q = 0; q < 4; ++q) { const float c0 = lwv[ct][4 * q], c1 = c0 + lwv[ct][4 * q + 1], c2 = c1 + lwv[ct][4 * q + 2], c3 = c2 + lwv[ct][4 * q + 3];
                const float oth = __shfl_xor(c3, 32), base = run + (hi ? oth : 0.f);
                pin[ct][4 * q] = base + c0; pin[ct][4 * q + 1] = base + c1; pin[ct][4 * q + 2] = base + c2; pin[ct][4 * q + 3] = base + c3; run += c3 + oth; }
            off[ct] = (unit & 1) ? 0.f : run;
            if (hi == 0) ((float*)(F.ws + WS_HT))[(size_t)unit * 512 + 64 * w + 2 * r32o + ct] = __expf(run); }
        bf16* scb = (bf16*)(F.ws + WS_SC) + ((size_t)(((unit >> 7) * 8 + w) * 64 + ((unit >> 1) & 63)) * 5 * 64 + 32 * (unit & 1) + 4 * hi) * 64 + 2 * r32o;
#pragma unroll
        for (int r = 0; r < 16; ++r) {
            const int t = crow16(r, hi), row = r0 + t;
            float rr[2], kv[2], vv[2], kkv[2], av[2], wv[2];
            float ss = 0.f;
#pragma unroll
            for (int ct = 0; ct < 2; ++ct) { const int ch = 64 * w + 2 * r32 + ct;
                rr[ct] = bf2f(msl[t * MS_LD + ch]); kv[ct] = bf2f(msl[t * MS_LD + 512 + ch]); vv[ct] = bf2f(msl[t * MS_LD + 1024 + ch]);
                wv[ct] = __expf(lwv[ct][r]);
                av[ct] = sigmoidf_(a0c[ct] + al[ct][r]);
                kkv[ct] = kv[ct] * kkc[ct]; ss += kkv[ct] * kkv[ct];
            }
            ss = sum32(ss);
            const float rn = rsqrtf(fmaxf(ss, 1e-24f));
            float bon = 0.f, br = 0.f, kr = 0.f, kk[2], kp[2];
#pragma unroll
            for (int ct = 0; ct < 2; ++ct) { kk[ct] = kkv[ct] * rn; kp[ct] = kv[ct] * (1.f + (av[ct] - 1.f) * kac[ct]);
                bon += rr[ct] * kp[ct] * rkc[ct]; br += kk[ct] * av[ct] * rr[ct]; kr += kp[ct] * rr[ct]; }
            bon = sum32(bon); br = sum32(br); kr = sum32(kr);
            { float Fm[2], Fi[2];
#pragma unroll
              for (int ct = 0; ct < 2; ++ct) { Fm[ct] = __expf(pin[ct][r] - lwv[ct][r] - off[ct]); Fi[ct] = __expf(off[ct] - pin[ct][r]); }
              unsigned* sp_ = (unsigned*)(scb + CRC(r) * 64);
              sp_[0 * 2048] = pk2(-kk[0] * Fm[0], -kk[1] * Fm[1]);
              sp_[1 * 2048] = pk2(kk[0] * av[0] * Fi[0], kk[1] * av[1] * Fi[1]);
              sp_[2 * 2048] = pk2(kp[0] * Fi[0], kp[1] * Fi[1]);
              sp_[3 * 2048] = pk2(wv[0] * rr[0] * Fm[0], wv[1] * rr[1] * Fm[1]);
              sp_[4 * 2048] = pk2(vv[0], vv[1]);
              *(v2u*)(rk_pair(F, 2) + (size_t)row * 512 + 64 * w + 2 * r32o) = (v2u){pk2(vv[0], gg[0][r]), pk2(vv[1], gg[1][r])}; }
            if (r32 == 0) *(f32x4*)(BON + (size_t)(row * 8 + w) * 4) = (f32x4){bon, br, kr, 0.f};
        }
    } else {
#pragma unroll 4
    for (int r = 0; r < 16; ++r) {
        const int t = crow16(r, hi), row = r0 + t;
        float rr[2], kv[2], vv[2], kkv[2], av[2], wv[2];
        float ss = 0.f;
#pragma unroll
        for (int ct = 0; ct < 2; ++ct) { const int ch = 64 * w + 2 * r32 + ct;
            rr[ct] = bf2f(msl[t * MS_LD + ch]); kv[ct] = bf2f(msl[t * MS_LD + 512 + ch]); vv[ct] = bf2f(msl[t * MS_LD + 1024 + ch]);
            const float x = -(w0c[ct] + wl[ct][r]), sp = fmaxf(x, 0.f) + __logf(1.f + __expf(-fabsf(x)));
            const float e = __expf(-sp - 0.5f); wv[ct] = __expf(-e);
            av[ct] = sigmoidf_(a0c[ct] + al[ct][r]);
            kkv[ct] = kv[ct] * kkc[ct]; ss += kkv[ct] * kkv[ct];
        }
        ss = sum32(ss);
        const float rn = rsqrtf(fmaxf(ss, 1e-24f));
        float bon = 0.f, br = 0.f, kr = 0.f, kk[2], kp[2];
#pragma unroll
        for (int ct = 0; ct < 2; ++ct) { kk[ct] = kkv[ct] * rn; kp[ct] = kv[ct] * (1.f + (av[ct] - 1.f) * kac[ct]);
            bon += rr[ct] * kp[ct] * rkc[ct]; br += kk[ct] * av[ct] * rr[ct]; kr += kp[ct] * rr[ct]; }
        bon = sum32(bon); br = sum32(br); kr = sum32(kr);
#pragma unroll
        for (int ct = 0; ct < 2; ++ct) { const size_t o = (size_t)row * 512 + 64 * w + 2 * r32 + ct;
            aW[o] = wv[ct]; rk_pair(F, 0)[o] = pk2(wv[ct] * rr[ct], kp[ct]); rk_pair(F, 2)[o] = pk2(vv[ct], gg[ct][r]); rk_pair(F, 4)[o] = pk2(-kk[ct], kk[ct] * av[ct]); }
        if (r32 == 0) *(f32x4*)(BON + (size_t)(row * 8 + w) * 4) = (f32x4){bon, br, kr, 0.f};
    }
    }
    __syncthreads();
}

constexpr int NSEG = 8, SEGT = SEQ / NSEG;
__device__ __forceinline__ float dpp_xor1(float v) { return __builtin_bit_cast(float, __builtin_amdgcn_update_dpp(0, __builtin_bit_cast(int, v), 0xB1, 0xF, 0xF, true)); }
__device__ __forceinline__ float dpp_xor2(float v) { return __builtin_bit_cast(float, __builtin_amdgcn_update_dpp(0, __builtin_bit_cast(int, v), 0x4E, 0xF, 0xF, true)); }
__device__ __forceinline__ float dpp_hmir(float v) { return __builtin_bit_cast(float, __builtin_amdgcn_update_dpp(0, __builtin_bit_cast(int, v), 0x141, 0xF, 0xF, true)); }
__device__ __forceinline__ float red8(float v) { v += dpp_xor1(v); v += dpp_xor2(v); v += dpp_hmir(v); return v; }
__device__ __forceinline__ void gn_store(Frame& F, const Args& A, int row, int h, int q, f32x4 yv, f32x4 vv) {
    const float* BON = (const float*)(F.ws + WS_BON3); const bf16* aG = rk_bf(F, 6); bf16* RW = (bf16*)(F.ws + WS_RW);
    float s = (yv[0] + yv[1]) + (yv[2] + yv[3]);
    s += __shfl_xor(s, 1); s += __shfl_xor(s, 2); s += __shfl_xor(s, 4); s += __shfl_xor(s, 8);
    const float mean = s * (1.f / 64.f); const f32x4 d = yv - mean;
    float s2 = (d[0] * d[0] + d[1] * d[1]) + (d[2] * d[2] + d[3] * d[3]);
    s2 += __shfl_xor(s2, 1); s2 += __shfl_xor(s2, 2); s2 += __shfl_xor(s2, 4); s2 += __shfl_xor(s2, 8);
    const float rstd = rsqrtf(s2 * (1.f / 64.f) + 64e-5f), bon = BON[(row * 8 + h) * 4];
    const int cbase = h * 64 + 4 * q;
    const f32x4 gw = *(const f32x4*)(A.in[I_GNW] + cbase), gb = *(const f32x4*)(A.in[I_GNB] + cbase), gv = [&]{ const v4u pg = *(const v4u*)(rk_pair(F, 2) + (size_t)row * 512 + cbase); return (f32x4){bfhi(pg.x), bfhi(pg.y), bfhi(pg.z), bfhi(pg.w)}; }();
    const f32x4 o = (d * rstd * gw + gb + bon * vv) * gv;
    v2u w; w.x = pk2(o[0], o[1]); w.y = pk2(o[2], o[3]);
    *(v2u*)(RW + (size_t)row * 512 + cbase) = w;
}
struct ScanIn { f32x4 a0, a1, r0, r1, w0, w1, b0, b1, k0, k1; float vi, br, kr; };
__device__ __forceinline__ void scan_seg_unit(Frame& F, const Args& A, int u) {
    constexpr int TB = 32, VB = 6 * TB * 64 + 2 * TB;
    LAS float* vecs = (LAS float*)(F.lds + RING_OFF);
    LAS float* ybuf = vecs + 2 * VB;
    LAS float* cbuf = ybuf + TB * 64;
    const int tid = F.tid, i = tid >> 3, seg8 = tid & 7;
    const bool prompt = u < 256;
    int h, row0, T; bool useF; f32x2 S[4], Fm[4];
    if (prompt) { h = (u >> 3) & 7; row0 = (u >> 6) * SEQ + (u & 7) * SEGT; T = SEGT; useF = (u & 7) != 0;
#pragma unroll
        for (int c = 0; c < 4; ++c) { S[c] = (f32x2){0.f, 0.f}; Fm[c] = (f32x2){(8 * seg8 + 2 * c == i) ? 1.f : 0.f, (8 * seg8 + 2 * c + 1 == i) ? 1.f : 0.f}; } }
    else { const int su = u - 256; h = su & 7; row0 = MP + (su >> 3); T = 1; useF = false;
        const float* s0 = A.in[I_SWKV] + ((size_t)su * 64 + i) * 64 + 8 * seg8;
        const f32x4 a = *(const f32x4*)s0, b = *(const f32x4*)(s0 + 4);
        S[0] = (f32x2){a[0], a[1]}; S[1] = (f32x2){a[2], a[3]}; S[2] = (f32x2){b[0], b[1]}; S[3] = (f32x2){b[2], b[3]};
#pragma unroll
        for (int c = 0; c < 4; ++c) Fm[c] = (f32x2){0.f, 0.f}; }
    const float* BON = (const float*)(F.ws + WS_BON3);
    float* Y0 = (float*)(F.ws + WS_Y0); float* CC = (float*)(F.ws + WS_CC);
    f32x4 sg[6]; float sgs = 0.f;
    const int st = tid >> 4, sq = tid & 15;
#define SCAN_STAGE_LOAD(t0_) do { const int nb_ = (T - (t0_)) < TB ? (T - (t0_)) : TB; if (st < nb_) { const size_t go_ = (size_t)(row0 + (t0_) + st) * 512 + h * 64 + 4 * sq; \
        sg[1] = *(const f32x4*)(rk_arr(F, 1) + go_); const v4u p0_ = *(const v4u*)(rk_pair(F, 0) + go_), p2_ = *(const v4u*)(rk_pair(F, 2) + go_), p4_ = *(const v4u*)(rk_pair(F, 4) + go_); \
        sg[0] = (f32x4){bflo(p0_.x), bflo(p0_.y), bflo(p0_.z), bflo(p0_.w)}; sg[2] = (f32x4){bfhi(p0_.x), bfhi(p0_.y), bfhi(p0_.z), bfhi(p0_.w)}; sg[3] = (f32x4){bflo(p2_.x), bflo(p2_.y), bflo(p2_.z), bflo(p2_.w)}; \
        sg[4] = (f32x4){bflo(p4_.x), bflo(p4_.y), bflo(p4_.z), bflo(p4_.w)}; sg[5] = (f32x4){bfhi(p4_.x), bfhi(p4_.y), bfhi(p4_.z), bfhi(p4_.w)}; } \
        if (tid < 2 * TB && (tid >> 1) < nb_) sgs = BON[((row0 + (t0_) + (tid >> 1)) * 8 + h) * 4 + 1 + (tid & 1)]; } while (0)
#define SCAN_STAGE_STORE(buf_) do { LAS float* vb_ = vecs + (buf_) * VB; _Pragma("unroll") for (int a_ = 0; a_ < 6; ++a_) *(LAS f32x4*)(vb_ + (a_ * TB + st) * 64 + 4 * sq) = sg[a_]; \
        if (tid < 2 * TB) vb_[6 * TB * 64 + tid] = sgs; } while (0)
    SCAN_STAGE_LOAD(0); SCAN_STAGE_STORE(0);
    __syncthreads();
    int buf = 0;
    for (int t0 = 0; t0 < T; t0 += TB, buf ^= 1) {
        const int nb = (T - t0) < TB ? (T - t0) : TB;
        const bool more = t0 + TB < T;
        if (more) SCAN_STAGE_LOAD(t0 + TB);
        const LAS float* vec = vecs + buf * VB; const LAS float* scl = vec + 6 * TB * 64;
#define SCAN_LOADIN(X, t_) do { const LAS float* p_ = vec + (t_) * 64 + 8 * seg8; \
        X.r0 = *(const LAS f32x4*)(p_); X.r1 = *(const LAS f32x4*)(p_ + 4); X.w0 = *(const LAS f32x4*)(p_ + TB * 64); X.w1 = *(const LAS f32x4*)(p_ + TB * 64 + 4); \
        X.k0 = *(const LAS f32x4*)(p_ + 2 * TB * 64); X.k1 = *(const LAS f32x4*)(p_ + 2 * TB * 64 + 4); X.a0 = *(const LAS f32x4*)(p_ + 4 * TB * 64); X.a1 = *(const LAS f32x4*)(p_ + 4 * TB * 64 + 4); \
        X.b0 = *(const LAS f32x4*)(p_ + 5 * TB * 64); X.b1 = *(const LAS f32x4*)(p_ + 5 * TB * 64 + 4); X.vi = vec[(3 * TB + (t_)) * 64 + i]; X.br = scl[2 * (t_)]; X.kr = scl[2 * (t_) + 1]; } while (0)
#define LO2(v) ((f32x2){(v)[0], (v)[1]})
#define HI2(v) ((f32x2){(v)[2], (v)[3]})
#define SCAN_STEP(X, Y, t_) do { \
        const f32x2 a_[4] = {LO2(X.a0), HI2(X.a0), LO2(X.a1), HI2(X.a1)}, r_[4] = {LO2(X.r0), HI2(X.r0), LO2(X.r1), HI2(X.r1)}; \
        const f32x2 w_[4] = {LO2(X.w0), HI2(X.w0), LO2(X.w1), HI2(X.w1)}, b_[4] = {LO2(X.b0), HI2(X.b0), LO2(X.b1), HI2(X.b1)}, k_[4] = {LO2(X.k0), HI2(X.k0), LO2(X.k1), HI2(X.k1)}; \
        const float br_ = X.br, kr_ = X.kr, vi_ = X.vi; \
        f32x2 d1 = S[0] * a_[0], d2 = S[0] * r_[0], f1 = Fm[0] * a_[0], f2 = Fm[0] * r_[0]; \
        _Pragma("unroll") for (int c = 1; c < 4; ++c) { d1 += S[c] * a_[c]; d2 += S[c] * r_[c]; f1 += Fm[c] * a_[c]; f2 += Fm[c] * r_[c]; } \
        f32x2 tS[4], tF[4]; _Pragma("unroll") for (int c = 0; c < 4; ++c) { tS[c] = S[c] * w_[c] + vi_ * k_[c]; tF[c] = Fm[c] * w_[c]; } \
        { int tn_ = (t_) + 1;     \
          asm volatile("" : "+v"(tn_) : "v"(d1), "v"(d2), "v"(f1), "v"(f2), "v"(tS[0]), "v"(tS[1]), "v"(tS[2]), "v"(tS[3]), "v"(tF[0]), "v"(tF[1]), "v"(tF[2]), "v"(tF[3])); \
          if ((t_) + 1 < nb) SCAN_LOADIN(Y, tn_); } \
        float q0 = d1.x + d1.y, q1 = d2.x + d2.y, q2 = f1.x + f1.y, q3 = f2.x + f2.y; \
        q0 += dpp_xor1(q0); q1 += dpp_xor1(q1); q2 += dpp_xor1(q2); q3 += dpp_xor1(q3); \
        q0 += dpp_xor2(q0); q1 += dpp_xor2(q1); q2 += dpp_xor2(q2); q3 += dpp_xor2(q3); \
        q0 += dpp_hmir(q0); q1 += dpp_hmir(q1); q2 += dpp_hmir(q2); q3 += dpp_hmir(q3); \
        _Pragma("unroll") for (int c = 0; c < 4; ++c) { S[c] = tS[c] + q0 * b_[c]; Fm[c] = tF[c] + q2 * b_[c]; } \
        if (seg8 == 0) { ybuf[(t_) * 64 + i] = q1 + q0 * br_ + vi_ * kr_; cbuf[(t_) * 64 + i] = q3 + q2 * br_; } } while (0)
        ScanIn IA, IB;
        SCAN_LOADIN(IA, 0);
        for (int t = 0; t < nb; t += 2) {
            SCAN_STEP(IA, IB, t);
            if (t + 1 < nb) SCAN_STEP(IB, IA, t + 1);
        }
        if (more) SCAN_STAGE_STORE(buf ^ 1);
        __syncthreads();
        { const int t = tid >> 4, q = tid & 15;
          if (t < nb) { const int row = row0 + t0 + t;
            const f32x4 yv = *(const LAS f32x4*)(ybuf + t * 64 + 4 * q);
            if (prompt) { *(f32x4*)(Y0 + (size_t)row * 512 + h * 64 + 4 * q) = yv; if (useF) *(f32x4*)(CC + (size_t)row * 512 + h * 64 + 4 * q) = *(const LAS f32x4*)(cbuf + t * 64 + 4 * q); }
            else gn_store(F, A, row, h, q, yv, *(const LAS f32x4*)(vec + (3 * TB + t) * 64 + 4 * q)); } }
        __syncthreads();
    }
#undef SCAN_STAGE_LOAD
#undef SCAN_STAGE_STORE
#undef SCAN_LOADIN
#undef SCAN_STEP
#undef LO2
#undef HI2
    const f32x4 s0v = {S[0].x, S[0].y, S[1].x, S[1].y}, s1v = {S[2].x, S[2].y, S[3].x, S[3].y};
    if (prompt) { float* ps = (float*)(F.ws + WS_PSI) + ((size_t)u * 64 + i) * 64 + 8 * seg8; *(f32x4*)ps = s0v; *(f32x4*)(ps + 4) = s1v;
        if (useF) { float* ph = (float*)(F.ws + WS_PHI) + ((size_t)u * 64 + i) * 64 + 8 * seg8; *(f32x4*)ph = (f32x4){Fm[0].x, Fm[0].y, Fm[1].x, Fm[1].y}; *(f32x4*)(ph + 4) = (f32x4){Fm[2].x, Fm[2].y, Fm[3].x, Fm[3].y}; } }
    else { float* so = F.out + O_WS + ((size_t)(u - 256) * 64 + i) * 64 + 8 * seg8; *(f32x4*)so = s0v; *(f32x4*)(so + 4) = s1v; }
    __syncthreads();
}
__device__ __forceinline__ void carry_unit(Frame& F, const Args& A, int bh) {
    LAS float* X = (LAS float*)(F.lds + RING_OFF);
    LAS float* P = X + 4096;
    const int tid = F.tid, i = tid >> 3, seg8 = tid & 7;
    float* SST = (float*)(F.ws + WS_SST); const float* PSI = (const float*)(F.ws + WS_PSI); const float* PHI = (const float*)(F.ws + WS_PHI);
    float cur[8];
#pragma unroll
    for (int c = 0; c < 8; ++c) cur[c] = 0.f;
    for (int k = 0; k < NSEG; ++k) {
        const size_t uo = ((size_t)(bh * NSEG + k) * 64 + i) * 64 + 8 * seg8;
        *(f32x4*)(SST + uo) = (f32x4){cur[0], cur[1], cur[2], cur[3]}; *(f32x4*)(SST + uo + 4) = (f32x4){cur[4], cur[5], cur[6], cur[7]};
        const f32x4 p0 = *(const f32x4*)(PSI + uo), p1 = *(const f32x4*)(PSI + uo + 4);
        float nx[8] = {p0[0], p0[1], p0[2], p0[3], p1[0], p1[1], p1[2], p1[3]};
        if (k > 0) {
            __syncthreads();
            *(LAS f32x4*)(X + i * 64 + 8 * seg8) = (f32x4){cur[0], cur[1], cur[2], cur[3]}; *(LAS f32x4*)(X + i * 64 + 8 * seg8 + 4) = (f32x4){cur[4], cur[5], cur[6], cur[7]};
            *(LAS f32x4*)(P + i * 64 + 8 * seg8) = *(const f32x4*)(PHI + uo); *(LAS f32x4*)(P + i * 64 + 8 * seg8 + 4) = *(const f32x4*)(PHI + uo + 4);
            __syncthreads();
#pragma unroll 4
            for (int l = 0; l < 64; ++l) { const float x = X[i * 64 + l]; const f32x4 q0 = *(const LAS f32x4*)(P + l * 64 + 8 * seg8), q1 = *(const LAS f32x4*)(P + l * 64 + 8 * seg8 + 4);
#pragma unroll
                for (int c = 0; c < 4; ++c) { nx[c] += x * q0[c]; nx[4 + c] += x * q1[c]; } }
        }
#pragma unroll
        for (int c = 0; c < 8; ++c) cur[c] = nx[c];
    }
    float* so = F.out + O_WP + ((size_t)bh * 64 + i) * 64 + 8 * seg8; *(f32x4*)so = (f32x4){cur[0], cur[1], cur[2], cur[3]}; *(f32x4*)(so + 4) = (f32x4){cur[4], cur[5], cur[6], cur[7]};
    __syncthreads();
}
__device__ __forceinline__ void corr_unit(Frame& F, const Args& A, int u) {
    const int lane = F.lane, w = F.wave, r32 = lane & 31, hi = lane >> 5, seg = u & 7, bh = u >> 3, h = bh & 7, rowseg = (bh >> 3) * SEQ + seg * SEGT;
    const float* SST = (const float*)(F.ws + WS_SST) + (size_t)u * 4096; const float* CC = (const float*)(F.ws + WS_CC); const float* Y0 = (const float*)(F.ws + WS_Y0);
    const float* BON = (const float*)(F.ws + WS_BON3); const bf16* aG = rk_bf(F, 6); const bf16* aV = rk_bf(F, 3); bf16* RW = (bf16*)(F.ws + WS_RW);
    bf16x8 sb[2][4];
    if (seg > 0) {
#pragma unroll
        for (int ct = 0; ct < 2; ++ct)
#pragma unroll
            for (int ks = 0; ks < 4; ++ks) { const float* p = SST + (size_t)(32 * ct + r32) * 64 + 16 * ks + 8 * hi; const f32x4 x = *(const f32x4*)p, y = *(const f32x4*)(p + 4);
                const v4u t = {pk2(x[0], x[1]), pk2(x[2], x[3]), pk2(y[0], y[1]), pk2(y[2], y[3])}; sb[ct][ks] = __builtin_bit_cast(bf16x8, t); }
    }
    float gw[2], gb[2];
#pragma unroll
    for (int ct = 0; ct < 2; ++ct) { gw[ct] = A.in[I_GNW][h * 64 + 32 * ct + r32]; gb[ct] = A.in[I_GNB][h * 64 + 32 * ct + r32]; }
    for (int blk = w; blk < SEGT / 32; blk += NWAVES) {
        const int row0 = rowseg + 32 * blk;
        f32x16 d[2]; d[0] = (f32x16){}; d[1] = (f32x16){};
        float yv0[16], yv1[16], bnv[16]; unsigned vgv0[16], vgv1[16];
#pragma unroll
        for (int r = 0; r < 16; ++r) { const int row = row0 + crow16(r, hi); const size_t o = (size_t)row * 512 + h * 64 + r32;
            yv0[r] = Y0[o]; yv1[r] = Y0[o + 32]; vgv0[r] = rk_pair(F, 2)[o]; vgv1[r] = rk_pair(F, 2)[o + 32]; bnv[r] = BON[(row * 8 + h) * 4]; }
        if (seg > 0) {
#pragma unroll
            for (int ks = 0; ks < 4; ++ks) { const float* p = CC + (size_t)(row0 + r32) * 512 + h * 64 + 16 * ks + 8 * hi; const f32x4 x = *(const f32x4*)p, y = *(const f32x4*)(p + 4);
                const v4u t = {pk2(x[0], x[1]), pk2(x[2], x[3]), pk2(y[0], y[1]), pk2(y[2], y[3])}; const bf16x8 cf = __builtin_bit_cast(bf16x8, t);
                d[0] = __builtin_amdgcn_mfma_f32_32x32x16_bf16(cf, sb[0][ks], d[0], 0, 0, 0); d[1] = __builtin_amdgcn_mfma_f32_32x32x16_bf16(cf, sb[1][ks], d[1], 0, 0, 0); }
        }
#pragma unroll
        for (int r = 0; r < 16; ++r) {
            const int row = row0 + crow16(r, hi); const size_t o = (size_t)row * 512 + h * 64 + r32;
            const float y0 = yv0[r] + d[0][r], y1 = yv1[r] + d[1][r];
            const float mean = sum32(y0 + y1) * (1.f / 64.f), e0 = y0 - mean, e1 = y1 - mean;
            const float rstd = rsqrtf(sum32(e0 * e0 + e1 * e1) * (1.f / 64.f) + 64e-5f), bon = bnv[r];
            const unsigned vg0 = vgv0[r], vg1 = vgv1[r];
            const float o0 = (e0 * rstd * gw[0] + gb[0] + bon * bflo(vg0)) * bfhi(vg0), o1 = (e1 * rstd * gw[1] + gb[1] + bon * bflo(vg1)) * bfhi(vg1);
            RW[o] = (bf16)(pk2(o0, 0.f) & 0xffffu); RW[o + 32] = (bf16)(pk2(o1, 0.f) & 0xffffu);
        }
    }
}

typedef short v4i16_t __attribute__((ext_vector_type(4)));
__device__ __forceinline__ s16x4 vtr(const LAS unsigned char* p) { return __builtin_bit_cast(s16x4, __builtin_amdgcn_ds_read_tr16_b64_v4i16((LAS v4i16_t*)p)); }
constexpr int IMG_LD = 136;
constexpr int IMG_BYTES = 64 * IMG_LD;
typedef bf16x8 Frag[2][4];
__device__ __forceinline__ void mm64(const Frag& Af, const Frag& Bf, f32x16 (&D)[2][2]) {
#pragma unroll
    for (int rt = 0; rt < 2; ++rt)
#pragma unroll
        for (int ct = 0; ct < 2; ++ct)
#pragma unroll
            for (int ks = 0; ks < 4; ++ks) D[rt][ct] = __builtin_amdgcn_mfma_f32_32x32x16_bf16(Af[rt][ks], Bf[ct][ks], D[rt][ct], 0, 0, 0);
}
__device__ __forceinline__ void acc_zero(f32x16 (&D)[2][2]) {
#pragma unroll
    for (int a = 0; a < 2; ++a)
#pragma unroll
        for (int b = 0; b < 2; ++b) D[a][b] = (f32x16){};
}
__device__ __forceinline__ void acc_frag(const f32x16 (&X)[2][2], Frag& Fr) {
#pragma unroll
    for (int rt = 0; rt < 2; ++rt)
#pragma unroll
        for (int ct = 0; ct < 2; ++ct)
#pragma unroll
            for (int hf = 0; hf < 2; ++hf) { const int rb = 8 * hf;
                const v4u u = {pk2(X[rt][ct][rb], X[rt][ct][rb + 1]), pk2(X[rt][ct][rb + 2], X[rt][ct][rb + 3]), pk2(X[rt][ct][rb + 4], X[rt][ct][rb + 5]), pk2(X[rt][ct][rb + 6], X[rt][ct][rb + 7])};
                Fr[ct][2 * rt + hf] = __builtin_bit_cast(bf16x8, u); }
}
__device__ __forceinline__ void rowfrag(const LAS unsigned char* img, int lane, Frag& Fr) {
    const int r32 = lane & 31, hi = lane >> 5;
#pragma unroll
    for (int tl = 0; tl < 2; ++tl)
#pragma unroll
        for (int ks = 0; ks < 4; ++ks) Fr[tl][ks] = *(const LAS bf16x8*)(img + (32 * tl + r32) * IMG_LD + (16 * ks + 8 * hi) * 2);
}
__device__ __forceinline__ void rowfrag_perm(const LAS unsigned char* img, int lane, Frag& Fr) {
    const int r32 = lane & 31, hi = lane >> 5;
#pragma unroll
    for (int tl = 0; tl < 2; ++tl)
#pragma unroll
        for (int ks = 0; ks < 4; ++ks) { const LAS unsigned char* p = img + (32 * tl + r32) * IMG_LD + (16 * ks + 4 * hi) * 2;
            const v2u a = *(const LAS v2u*)p, b = *(const LAS v2u*)(p + 16); const v4u u = {a.x, a.y, b.x, b.y}; Fr[tl][ks] = __builtin_bit_cast(bf16x8, u); }
}
__device__ __forceinline__ void colfrag_tr(const LAS unsigned char* img, int lane, Frag& Fr) {
    const int hi = lane >> 5, qq = (lane & 15) >> 2, p4 = lane & 3, cg = (lane >> 4) & 1;
    const LAS unsigned char* base = img + (4 * hi + qq) * IMG_LD + (16 * cg + 4 * p4) * 2;
#pragma unroll
    for (int tl = 0; tl < 2; ++tl)
#pragma unroll
        for (int ks = 0; ks < 4; ++ks) { const LAS unsigned char* p = base + (16 * ks) * IMG_LD + (32 * tl) * 2;
            const s16x4 lo = vtr(p), hh = vtr(p + 8 * IMG_LD); Fr[tl][ks] = (bf16x8){lo[0], lo[1], lo[2], lo[3], hh[0], hh[1], hh[2], hh[3]}; }
}
__device__ __forceinline__ void img_load(const bf16* g, LAS unsigned char* slot, int lane) {
    asm volatile("" ::: "memory");
    const unsigned char* gb = (const unsigned char*)g + (unsigned)(lane * 16);
    LAS unsigned char* sl_ = slot + (lane >> 3) * IMG_LD + (lane & 7) * 16;
#pragma unroll
    for (int hb = 0; hb < 2; ++hb) { v4u t[4];
#pragma unroll
        for (int k = 0; k < 4; ++k) t[k] = *(const v4u*)(gb + 1024 * (4 * hb + k));
#pragma unroll
        for (int k = 0; k < 4; ++k) *(LAS v4u*)(sl_ + (8 * (4 * hb + k)) * IMG_LD) = t[k];
        asm volatile("" ::: "memory"); }
}
__device__ __forceinline__ void acc_to_img(const f32x16 (&X)[2][2], LAS unsigned char* slot, int lane) {
    const int r32 = lane & 31, hi = lane >> 5; LAS unsigned char* lb = slot + (4 * hi) * IMG_LD + r32 * 2;
#pragma unroll
    for (int rt = 0; rt < 2; ++rt)
#pragma unroll
        for (int ct = 0; ct < 2; ++ct)
        { asm volatile("" ::: "memory");
#pragma unroll
            for (int r = 0; r < 16; ++r) *(LAS bf16*)(lb + (32 * rt + CRC(r)) * IMG_LD + (32 * ct) * 2) = (bf16)(pk2(X[rt][ct][r], 0.f) & 0xffffu); }
}
__device__ __forceinline__ void acc_to_gbf(const f32x16 (&X)[2][2], bf16* g, int lane) {
    const int r32 = lane & 31, hi = lane >> 5; bf16* gl = g + (4 * hi) * 64 + r32;
#pragma unroll
    for (int rt = 0; rt < 2; ++rt)
#pragma unroll
        for (int ct = 0; ct < 2; ++ct)
        { asm volatile("" ::: "memory");
#pragma unroll
            for (int r = 0; r < 16; ++r) gl[(32 * rt + CRC(r)) * 64 + 32 * ct] = (bf16)(pk2(X[rt][ct][r], 0.f) & 0xffffu); }
}
__device__ __forceinline__ void acc_to_gf32(const f32x16 (&X)[2][2], float* g, int lane) {
    const int r32 = lane & 31, hi = lane >> 5; float* gl = g + (4 * hi) * 64 + r32;
#pragma unroll
    for (int rt = 0; rt < 2; ++rt)
#pragma unroll
        for (int ct = 0; ct < 2; ++ct)
        { asm volatile("" ::: "memory");
#pragma unroll
            for (int r = 0; r < 16; ++r) gl[(32 * rt + CRC(r)) * 64 + 32 * ct] = X[rt][ct][r]; }
}
template <bool STRICT> __device__ __forceinline__ void mask_upper(f32x16 (&X)[2][2], int lane) {
    const int r32 = lane & 31, hi = lane >> 5, dl = 4 * hi - r32;
#pragma unroll
    for (int rt = 0; rt < 2; ++rt)
#pragma unroll
        for (int ct = 0; ct < 2; ++ct)
#pragma unroll
            for (int r = 0; r < 16; ++r) { const int dlt = dl + (32 * rt + CRC(r) - 32 * ct); const bool keep = STRICT ? (dlt < 0) : (dlt <= 0); if (!keep) X[rt][ct][r] = 0.f; }
}
template <int RT> __device__ __forceinline__ void mm_rt(const Frag& Af, const Frag& Bf, f32x16 (&D)[2]) {
#pragma unroll
    for (int ct = 0; ct < 2; ++ct)
#pragma unroll
        for (int ks = 0; ks < 4; ++ks) D[ct] = __builtin_amdgcn_mfma_f32_32x32x16_bf16(Af[RT][ks], Bf[ct][ks], D[ct], 0, 0, 0);
}
template <int RT> __device__ __forceinline__ void frag_rt(const f32x16 (&D)[2], Frag& Fr) {
#pragma unroll
    for (int ct = 0; ct < 2; ++ct)
#pragma unroll
        for (int hf = 0; hf < 2; ++hf) { const int rb = 8 * hf;
            const v4u u = {pk2(D[ct][rb], D[ct][rb + 1]), pk2(D[ct][rb + 2], D[ct][rb + 3]), pk2(D[ct][rb + 4], D[ct][rb + 5]), pk2(D[ct][rb + 6], D[ct][rb + 7])};
            Fr[ct][2 * RT + hf] = __builtin_bit_cast(bf16x8, u); }
}
template <int RT, bool STRICT> __device__ __forceinline__ void mask_rt(f32x16 (&D)[2], int lane) {
    const int dl = 4 * (lane >> 5) - (lane & 31);
#pragma unroll
    for (int ct = 0; ct < 2; ++ct)
#pragma unroll
        for (int r = 0; r < 16; ++r) { const int dlt = dl + (32 * RT + CRC(r) - 32 * ct); const bool keep = STRICT ? (dlt < 0) : (dlt <= 0); if (!keep) D[ct][r] = 0.f; }
}
template <int RT> __device__ __forceinline__ void st_f32_rt(const f32x16 (&D)[2], float* g, int lane) { float* gl = g + (4 * (lane >> 5)) * 64 + (lane & 31);
#pragma unroll
    for (int ct = 0; ct < 2; ++ct) { asm volatile("" ::: "memory");
#pragma unroll
        for (int r = 0; r < 16; ++r) gl[(32 * RT + CRC(r)) * 64 + 32 * ct] = D[ct][r]; } }
template <int RT> __device__ __forceinline__ void st_bf_rt(const f32x16 (&D)[2], bf16* g, int lane) { bf16* gl = g + (4 * (lane >> 5)) * 64 + (lane & 31);
#pragma unroll
    for (int ct = 0; ct < 2; ++ct) { asm volatile("" ::: "memory");
#pragma unroll
        for (int r = 0; r < 16; ++r) gl[(32 * RT + CRC(r)) * 64 + 32 * ct] = (bf16)(pk2(D[ct][r], 0.f) & 0xffffu); } }
template <int RT> __device__ __forceinline__ void ld_f32_rt(f32x16 (&D)[2], const float* g, int lane) { const float* gl = g + (4 * (lane >> 5)) * 64 + (lane & 31);
#pragma unroll
    for (int ct = 0; ct < 2; ++ct) { asm volatile("" ::: "memory");
#pragma unroll
        for (int r = 0; r < 16; ++r) D[ct][r] = gl[(32 * RT + CRC(r)) * 64 + 32 * ct]; } }
template <int RT> __device__ __forceinline__ void scale_rt(f32x16 (&D)[2], const float* gcl  ) {
#pragma unroll
    for (int ct = 0; ct < 2; ++ct)
#pragma unroll
        for (int r = 0; r < 16; ++r) D[ct][r] *= gcl[32 * RT + CRC(r)]; }
__device__ __forceinline__ void zero2(f32x16 (&D)[2]) { D[0] = (f32x16){}; D[1] = (f32x16){}; }
__device__ __forceinline__ void tfrag(const f32x16& T, bf16x8& f0, bf16x8& f1) {
    const v4u u0 = {pk2(T[0], T[1]), pk2(T[2], T[3]), pk2(T[4], T[5]), pk2(T[6], T[7])}, u1 = {pk2(T[8], T[9]), pk2(T[10], T[11]), pk2(T[12], T[13]), pk2(T[14], T[15])};
    f0 = __builtin_bit_cast(bf16x8, u0); f1 = __builtin_bit_cast(bf16x8, u1);
}
__device__ __forceinline__ void tmm(const bf16x8 (&a)[2], const bf16x8 (&b)[2], f32x16& d) {
    d = __builtin_amdgcn_mfma_f32_32x32x16_bf16(a[0], b[0], d, 0, 0, 0); d = __builtin_amdgcn_mfma_f32_32x32x16_bf16(a[1], b[1], d, 0, 0, 0);
}
__device__ __forceinline__ void tprod(const Frag& A_, int ra, const Frag& B_, int rb, f32x16& d) {
#pragma unroll
    for (int ks = 0; ks < 4; ++ks) d = __builtin_amdgcn_mfma_f32_32x32x16_bf16(A_[ra][ks], B_[rb][ks], d, 0, 0, 0);
}
template <bool WANT_ZT> __device__ __forceinline__ void diag_inv(f32x16& Q, f32x16& QT, f32x16& Z, f32x16& ZT, int lane) {
    const int dl = 4 * (lane >> 5) - (lane & 31);
#pragma unroll
    for (int r = 0; r < 16; ++r) { const int d = dl + CRC(r); Q[r] = d < 0 ? Q[r] : 0.f; QT[r] = d > 0 ? QT[r] : 0.f; const float id = d == 0 ? 1.f : 0.f; Z[r] = Q[r] + id; ZT[r] = QT[r] + id; }
#pragma unroll 1
    for (int lvl = 0; lvl < 4; ++lvl) {
        bf16x8 fq[2], fqt[2], fz[2];
        tfrag(Q, fq[0], fq[1]); tfrag(QT, fqt[0], fqt[1]);
        Q = (f32x16){}; QT = (f32x16){}; tmm(fqt, fq, Q); tmm(fq, fqt, QT);
        tfrag(Q, fq[0], fq[1]); tfrag(QT, fqt[0], fqt[1]);
        tfrag(Z, fz[0], fz[1]); tmm(fqt, fz, Z);
        if (WANT_ZT) { tfrag(ZT, fz[0], fz[1]); tmm(fq, fz, ZT); }
    }
}
constexpr int NCHK = SEQ / 64;
__device__ __forceinline__ void chunk_prescale(Frame& F, int hc) {
    const int lane = F.lane, bh = hc >> 6, c = hc & 63, h = bh & 7, row0 = (bh >> 3) * SEQ + c * 64;
    bf16* sc = (bf16*)(F.ws + WS_SC) + (size_t)hc * 5 * 4096 + lane;
    const size_t o0 = (size_t)row0 * 512 + h * 64 + lane;
    const float* aW = rk_arr(F, 1) + o0; const unsigned* pRK = rk_pair(F, 0) + o0; const unsigned* pVG = rk_pair(F, 2) + o0; const unsigned* pAB = rk_pair(F, 4) + o0;
    float lc = 0.f;
    float wA[16], wB[16]; unsigned rkA[16], rkB[16], vgA[16], vgB[16], abA[16], abB[16];
#define PS_LOAD(S, tb) do { _Pragma("unroll") for (int i = 0; i < 16; ++i) { const int t = 16 * (tb) + i; w##S[i] = aW[t * 512]; rk##S[i] = pRK[t * 512]; vg##S[i] = pVG[t * 512]; ab##S[i] = pAB[t * 512]; } } while (0)
#define PS_COMP(S, tb) do { _Pragma("unroll") for (int i = 0; i < 16; ++i) { const int t = 16 * (tb) + i; \
        const float em = __expf(lc); lc += __logf(w##S[i]); const float ei = __expf(-lc); \
        sc[0 * 4096 + t * 64] = (bf16)(pk2(bflo(ab##S[i]) * em, 0.f) & 0xffffu); \
        sc[1 * 4096 + t * 64] = (bf16)(pk2(bfhi(ab##S[i]) * ei, 0.f) & 0xffffu); \
        sc[2 * 4096 + t * 64] = (bf16)(pk2(bfhi(rk##S[i]) * ei, 0.f) & 0xffffu); \
        sc[3 * 4096 + t * 64] = (bf16)(pk2(bflo(rk##S[i]) * em, 0.f) & 0xffffu); \
        sc[4 * 4096 + t * 64] = (bf16)(vg##S[i] & 0xffffu); } } while (0)
    PS_LOAD(A, 0); PS_LOAD(B, 1);
    PS_COMP(A, 0); asm volatile("" ::: "memory"); PS_LOAD(A, 2);
    PS_COMP(B, 1); asm volatile("" ::: "memory"); PS_LOAD(B, 3);
    PS_COMP(A, 2); PS_COMP(B, 3);
#undef PS_LOAD
#undef PS_COMP
    ((float*)(F.ws + WS_GC))[(size_t)hc * 64 + lane] = __expf(lc);
}
__device__ __forceinline__ void chunk_unit(Frame& F, int hc) {
    const int lane = F.lane, r32 = lane & 31, hi = lane >> 5;
    LAS unsigned char* s0 = F.lds + RING_OFF + F.wave * (2 * IMG_BYTES); LAS unsigned char* s1 = s0 + IMG_BYTES; const LAS unsigned char* s1l = s1 + (4 * hi) * IMG_LD + r32 * 2;
    SUBM(0);
    const float* rho = (const float*)(F.ws + WS_HT) + (size_t)(((hc >> 9) * 64 + (hc & 63)) * 2) * 512 + ((hc >> 6) & 7) * 64; const float* sig = rho + 512;
    ((float*)(F.ws + WS_GC))[(size_t)hc * 64 + lane] = rho[lane] * sig[lane];
    SUBM(1);
    const bf16* sc = (const bf16*)(F.ws + WS_SC) + (size_t)hc * 5 * 4096;
    const bf16* gAb = sc; const bf16* gBb = sc + 4096; const bf16* gKb = sc + 2 * 4096; const bf16* gRb = sc + 3 * 4096; const bf16* gV = sc + 4 * 4096;
    Frag fa, fb, zf, uf, af;
    {
        f32x16 Q, QT, Z, ZT; bf16x8 zt11[2], z22[2], t0[2], t1[2];
        img_load(gAb, s0, lane); img_load(gBb, s1, lane);
        rowfrag(s1, lane, fa); rowfrag(s0, lane, fb);
        Q = (f32x16){}; QT = (f32x16){}; tprod(fa, 0, fb, 0, Q); tprod(fb, 0, fa, 0, QT); diag_inv<true>(Q, QT, Z, ZT, lane);
        tfrag(Z, zf[0][0], zf[0][1]); tfrag(ZT, zt11[0], zt11[1]);
        Q = (f32x16){}; QT = (f32x16){}; tprod(fa, 1, fb, 1, Q); tprod(fb, 1, fa, 1, QT); diag_inv<false>(Q, QT, Z, ZT, lane);
        tfrag(Z, z22[0], z22[1]); zf[1][2] = z22[0]; zf[1][3] = z22[1];
        QT = (f32x16){}; tprod(fb, 1, fa, 0, QT);
        tfrag(QT, t0[0], t0[1]); Q = (f32x16){}; tmm(t0, z22, Q);
        tfrag(Q, t1[0], t1[1]); Z = (f32x16){}; tmm(zt11, t1, Z);
        tfrag(Z, zf[1][0], zf[1][1]);
        zf[0][2] = (bf16x8){}; zf[0][3] = (bf16x8){};
    }
    SUBM(2);
    f32x16 D[2];
    img_load(gKb, s1, lane);
    rowfrag(s1, lane, fa); rowfrag(s0, lane, fb);
    zero2(D); mm_rt<0>(fa, fb, D); mask_rt<0, true>(D, lane); frag_rt<0>(D, uf);
    zero2(D); mm_rt<1>(fa, fb, D); mask_rt<1, true>(D, lane); frag_rt<1>(D, uf);
    img_load(gV, s1, lane); colfrag_tr(s1, lane, fb);
    zero2(D); mm_rt<0>(uf, fb, D); frag_rt<0>(D, fa);
    zero2(D); mm_rt<1>(uf, fb, D); frag_rt<1>(D, fa);
    zero2(D); mm_rt<0>(zf, fa, D); frag_rt<0>(D, uf);
    zero2(D); mm_rt<1>(zf, fa, D); frag_rt<1>(D, uf);
    colfrag_tr(s0, lane, fa);
    zero2(D); mm_rt<0>(zf, fa, D); frag_rt<0>(D, af);
    zero2(D); mm_rt<1>(zf, fa, D); frag_rt<1>(D, af);
    SUBM(3);
    const float* gcg = sig + 4 * hi; const float* rhg = rho + 4 * hi;
    img_load(gKb, s0, lane); colfrag_tr(s0, lane, zf);
    img_load(gBb, s0, lane); colfrag_tr(s0, lane, fa);
    { unsigned char* slfb = F.ws + WS_SL + (size_t)hc * 8192 + lane * 8; unsigned char* gpfb = F.ws + WS_GP + (size_t)hc * 8192 + lane * 16;
      zero2(D); mm_rt<0>(zf, fb, D); mm_rt<0>(fa, uf, D); scale_rt<0>(D, gcg);
#pragma unroll
      for (int ct = 0; ct < 2; ++ct)
#pragma unroll
          for (int q = 0; q < 4; ++q) *(v2u*)(slfb + ((ct * 2 + 0) * 4 + q) * 512) = (v2u){pk2(D[ct][4 * q], D[ct][4 * q + 1]), pk2(D[ct][4 * q + 2], D[ct][4 * q + 3])};
      zero2(D); mm_rt<1>(zf, fb, D); mm_rt<1>(fa, uf, D); scale_rt<1>(D, gcg);
#pragma unroll
      for (int ct = 0; ct < 2; ++ct)
#pragma unroll
          for (int q = 0; q < 4; ++q) *(v2u*)(slfb + ((ct * 2 + 1) * 4 + q) * 512) = (v2u){pk2(D[ct][4 * q], D[ct][4 * q + 1]), pk2(D[ct][4 * q + 2], D[ct][4 * q + 3])};
      const float gc0 = sig[r32], gc1 = sig[32 + r32];
      zero2(D); mm_rt<0>(af, fa, D); D[0] *= gc0; D[1] *= gc1; scale_rt<0>(D, rhg); frag_rt<0>(D, zf);
      zero2(D); mm_rt<1>(af, fa, D); D[0] *= gc0; D[1] *= gc1; scale_rt<1>(D, rhg); frag_rt<1>(D, zf);
#pragma unroll
      for (int tl = 0; tl < 2; ++tl)
#pragma unroll
          for (int ks = 0; ks < 4; ++ks) *(bf16x8*)(gpfb + (tl * 4 + ks) * 1024) = zf[tl][ks]; }
    SUBM(4);
    img_load(gRb, s1, lane);
    rowfrag(s0, lane, fa); rowfrag(s1, lane, fb);
    zero2(D); mm_rt<0>(fa, fb, D); mask_rt<0, false>(D, lane); frag_rt<0>(D, zf);
    zero2(D); mm_rt<1>(fa, fb, D); mask_rt<1, false>(D, lane); frag_rt<1>(D, zf);
    { const LAS unsigned char* s1t = s1 + r32 * IMG_LD + hi * 8;
      unsigned char* rhfb = F.ws + WS_RH + (size_t)hc * 8192 + lane * 16;
#pragma unroll
      for (int ct = 0; ct < 2; ++ct)
#pragma unroll
          for (int q = 0; q < 4; ++q) { const v2u w_ = *(const LAS v2u*)(s1t + (32 * ct) * IMG_LD + (8 * q) * 2);
              D[ct][4 * q] = bflo(w_.x); D[ct][4 * q + 1] = bfhi(w_.x); D[ct][4 * q + 2] = bflo(w_.y); D[ct][4 * q + 3] = bfhi(w_.y); }
      mm_rt<0>(af, zf, D); scale_rt<0>(D, rhg); frag_rt<0>(D, fa);
#pragma unroll
      for (int ct = 0; ct < 2; ++ct)
#pragma unroll
          for (int q = 0; q < 4; ++q) { const v2u w_ = *(const LAS v2u*)(s1t + (32 * ct) * IMG_LD + (32 + 8 * q) * 2);
              D[ct][4 * q] = bflo(w_.x); D[ct][4 * q + 1] = bfhi(w_.x); D[ct][4 * q + 2] = bflo(w_.y); D[ct][4 * q + 3] = bfhi(w_.y); }
      mm_rt<1>(af, zf, D); scale_rt<1>(D, rhg); frag_rt<1>(D, fa);
#pragma unroll
      for (int tl = 0; tl < 2; ++tl)
#pragma unroll
          for (int ks = 0; ks < 4; ++ks) *(bf16x8*)(rhfb + (tl * 4 + ks) * 1024) = fa[tl][ks]; }
    SUBM(5);
    img_load(gKb, s0, lane);
    rowfrag(s0, lane, fa); rowfrag(s1, lane, fb);
    zero2(D); mm_rt<0>(fa, fb, D); mask_rt<0, false>(D, lane); frag_rt<0>(D, af);
    zero2(D); mm_rt<1>(fa, fb, D); mask_rt<1, false>(D, lane); frag_rt<1>(D, af);
    img_load(gV, s1, lane); colfrag_tr(s1, lane, fb);
    { unsigned char* ylfb = F.ws + WS_YL + (size_t)hc * 8192 + lane * 8;
      zero2(D); mm_rt<0>(zf, uf, D); mm_rt<0>(af, fb, D);
#pragma unroll
      for (int ct = 0; ct < 2; ++ct)
#pragma unroll
          for (int q = 0; q < 4; ++q) *(v2u*)(ylfb + ((0 * 2 + ct) * 4 + q) * 512) = (v2u){pk2(D[ct][4 * q], D[ct][4 * q + 1]), pk2(D[ct][4 * q + 2], D[ct][4 * q + 3])};
      zero2(D); mm_rt<1>(zf, uf, D); mm_rt<1>(af, fb, D);
#pragma unroll
      for (int ct = 0; ct < 2; ++ct)
#pragma unroll
          for (int q = 0; q < 4; ++q) *(v2u*)(ylfb + ((1 * 2 + ct) * 4 + q) * 512) = (v2u){pk2(D[ct][4 * q], D[ct][4 * q + 1]), pk2(D[ct][4 * q + 2], D[ct][4 * q + 3])}; }
    SUBM(6);
}
__device__ __forceinline__ void chain_unit(Frame& F, int gwv) {
    const int lane = F.lane, r32 = lane & 31, hi = lane >> 5, bh = gwv >> 1, ct = gwv & 1;
    const unsigned char* gpf = F.ws + WS_GP + (size_t)bh * NCHK * 8192 + lane * 16;
    const unsigned char* slf = F.ws + WS_SL + (size_t)bh * NCHK * 8192 + ct * 4096 + lane * 8;
    const float* gcl = (const float*)(F.ws + WS_GC) + (size_t)bh * NCHK * 64 + lane;
    unsigned char* xcf = F.ws + WS_XC + (size_t)bh * NCHK * 8192 + ct * 4096 + lane * 16;
    f32x16 X[2]; X[0] = (f32x16){}; X[1] = (f32x16){};
    v4u gA[8], gB[8], gC[8]; v2u sA[8], sB[8], sC[8]; float mA, mB, mC; const int hb = 16 * hi;
#define CH_LOAD(S) do { _Pragma("unroll") for (int k = 0; k < 8; ++k) { g##S[k] = *(const v4u*)(gpf + k * 1024); s##S[k] = *(const v2u*)(slf + k * 512); } m##S = *gcl; gpf += 8192; slf += 8192; gcl += 64; } while (0)
#define CH_STEP(S) do { bf16x8 xh[4]; \
        _Pragma("unroll") for (int rt = 0; rt < 2; ++rt) _Pragma("unroll") for (int hf = 0; hf < 2; ++hf) { const int rb = 8 * hf; \
            const v4u u = {pk2(X[rt][rb], X[rt][rb + 1]), pk2(X[rt][rb + 2], X[rt][rb + 3]), pk2(X[rt][rb + 4], X[rt][rb + 5]), pk2(X[rt][rb + 6], X[rt][rb + 7])}; \
            xh[2 * rt + hf] = __builtin_bit_cast(bf16x8, u); } \
        _Pragma("unroll") for (int ks = 0; ks < 4; ++ks) *(bf16x8*)(xcf + ks * 1024) = xh[ks]; \
        xcf += 8192; \
        _Pragma("unroll") for (int rt = 0; rt < 2; ++rt) _Pragma("unroll") for (int q = 0; q < 4; ++q) _Pragma("unroll") for (int e = 0; e < 4; ++e) { \
            const float gm_ = __builtin_bit_cast(float, __builtin_amdgcn_ds_bpermute(4 * (32 * rt + 8 * q + e) + hb, __builtin_bit_cast(int, m##S)));     \
            const unsigned sw_ = (e < 2) ? s##S[rt * 4 + q].x : s##S[rt * 4 + q].y; \
            X[rt][4 * q + e] = gm_ * X[rt][4 * q + e] + ((e & 1) ? bfhi(sw_) : bflo(sw_)); } \
        _Pragma("unroll") for (int rt = 0; rt < 2; ++rt) _Pragma("unroll") for (int ks = 0; ks < 4; ++ks) \
            X[rt] = __builtin_amdgcn_mfma_f32_32x32x16_bf16(__builtin_bit_cast(bf16x8, g##S[rt * 4 + ks]), xh[ks], X[rt], 0, 0, 0); } while (0)
    static_assert(NCHK % 3 == 1, "chain_unit: 21 x 3 steps + 1");
    CH_LOAD(A); CH_LOAD(B);
#pragma unroll 1
    for (int c = 0; c < NCHK - 1; c += 3) {
        CH_LOAD(C); CH_STEP(A);
        CH_LOAD(A); CH_STEP(B);
        if (c + 4 < NCHK) CH_LOAD(B);
        CH_STEP(C);
    }
    CH_STEP(A);
#undef CH_LOAD
#undef CH_STEP
    float* so = F.out + O_WP + (size_t)bh * 4096 + (32 * ct + r32) * 64 + 4 * hi;
#pragma unroll
    for (int rt = 0; rt < 2; ++rt)
#pragma unroll
        for (int r = 0; r < 16; ++r) so[32 * rt + CRC(r)] = X[rt][r];
}
__device__ __forceinline__ void ypass_unit(Frame& F, const Args& A, int hc) {
    const int lane = F.lane, r32 = lane & 31, hi = lane >> 5, bh = hc >> 6, c = hc & 63, h = bh & 7, row0 = (bh >> 3) * SEQ + c * 64;
    Frag fa, fb;
    { const unsigned char* xcf = F.ws + WS_XC + (size_t)hc * 8192 + lane * 16;
#pragma unroll
      for (int ct = 0; ct < 2; ++ct)
#pragma unroll
          for (int ks = 0; ks < 4; ++ks) fb[ct][ks] = *(const bf16x8*)(xcf + (ct * 4 + ks) * 1024); }
    { const unsigned char* rhf = F.ws + WS_RH + (size_t)hc * 8192 + lane * 16;
#pragma unroll
      for (int tl = 0; tl < 2; ++tl)
#pragma unroll
          for (int ks = 0; ks < 4; ++ks) fa[tl][ks] = *(const bf16x8*)(rhf + (tl * 4 + ks) * 1024); }
    f32x16 Y[2][2];
    { const unsigned char* ylf = F.ws + WS_YL + (size_t)hc * 8192 + lane * 8;
#pragma unroll
      for (int rt = 0; rt < 2; ++rt)
#pragma unroll
          for (int ct = 0; ct < 2; ++ct)
#pragma unroll
              for (int q = 0; q < 4; ++q) { const v2u v_ = *(const v2u*)(ylf + ((rt * 2 + ct) * 4 + q) * 512);
                  Y[rt][ct][4 * q] = bflo(v_.x); Y[rt][ct][4 * q + 1] = bfhi(v_.x); Y[rt][ct][4 * q + 2] = bflo(v_.y); Y[rt][ct][4 * q + 3] = bfhi(v_.y); } }
    const float* BON = (const float*)(F.ws + WS_BON3) + (size_t)(row0 + 4 * hi) * 32 + h * 4; bf16* RW = (bf16*)(F.ws + WS_RW) + (size_t)(row0 + 4 * hi) * 512 + h * 64 + r32;
    const unsigned* VG = rk_pair(F, 2) + (size_t)(row0 + 4 * hi) * 512 + h * 64 + r32;
    unsigned vg0[2][16], vg1[2][16]; float bon[2][16];
#pragma unroll
    for (int rt = 0; rt < 2; ++rt)
#pragma unroll
        for (int r = 0; r < 16; ++r) { vg0[rt][r] = VG[(32 * rt + CRC(r)) * 512]; vg1[rt][r] = VG[(32 * rt + CRC(r)) * 512 + 32]; bon[rt][r] = BON[(32 * rt + CRC(r)) * 32]; }
    float gw[2], gb[2];
#pragma unroll
    for (int ct = 0; ct < 2; ++ct) { gw[ct] = A.in[I_GNW][h * 64 + 32 * ct + r32]; gb[ct] = A.in[I_GNB][h * 64 + 32 * ct + r32]; }
    mm64(fa, fb, Y);
#pragma unroll
    for (int rt = 0; rt < 2; ++rt)
#pragma unroll
        for (int r = 0; r < 16; ++r) {
            const float y0 = Y[rt][0][r], y1 = Y[rt][1][r];
            const float mean = sum32(y0 + y1) * (1.f / 64.f), e0 = y0 - mean, e1 = y1 - mean;
            const float rstd = rsqrtf(sum32(e0 * e0 + e1 * e1) * (1.f / 64.f) + 64e-5f);
            const unsigned a0 = vg0[rt][r], a1 = vg1[rt][r];
            const float o0 = (e0 * rstd * gw[0] + gb[0] + bon[rt][r] * bflo(a0)) * bfhi(a0), o1 = (e1 * rstd * gw[1] + gb[1] + bon[rt][r] * bflo(a1)) * bfhi(a1);
            RW[(32 * rt + CRC(r)) * 512] = (bf16)(pk2(o0, 0.f) & 0xffffu); RW[(32 * rt + CRC(r)) * 512 + 32] = (bf16)(pk2(o1, 0.f) & 0xffffu);
        }
}

constexpr int DP_STRIDE = 260;
__device__ __forceinline__ float half_sum32(float v) { v += __shfl_xor(v, 1); v += __shfl_xor(v, 2); v += __shfl_xor(v, 4); v += __shfl_xor(v, 8); v += __shfl_xor(v, 16); return v; }
__device__ __forceinline__ float sum16(float v) {
    v += __builtin_bit_cast(float, __builtin_amdgcn_update_dpp(0, __builtin_bit_cast(int, v), 0xB1, 0xF, 0xF, true));
    v += __builtin_bit_cast(float, __builtin_amdgcn_update_dpp(0, __builtin_bit_cast(int, v), 0x4E, 0xF, 0xF, true));
    v += __builtin_bit_cast(float, __builtin_amdgcn_update_dpp(0, __builtin_bit_cast(int, v), 0x141, 0xF, 0xF, true));
    v += dpp_rmir(v);
    return v;
}
__device__ __forceinline__ void glds16(const void* gsrc, unsigned lds_dst) { unsigned keep;
    asm volatile("s_mov_b32 %0, m0\n\ts_mov_b32 m0, %2\n\ts_nop 0\n\tglobal_load_lds_dwordx4 %1, off\n\ts_mov_b32 m0, %0" : "=&s"(keep) : "v"(gsrc), "s"(lds_dst) : "memory"); }
struct LdsRows { const LAS unsigned char* b; __device__ __forceinline__ f32x4 operator[](int j) const { return *(const LAS f32x4*)(b + j * 1024); } };
__device__ __forceinline__ void decode_unit(Frame& F, const Args& A, int unit) {
    const int seq = unit >> 5, h = F.wave & 3, lane = F.lane, w = F.wave, d4 = lane & 31, tk = lane >> 5;
    const bf16* QB = (const bf16*)(F.ws + WS_QB);
    const v2u qw = *(const v2u*)(QB + (size_t)(MP + seq) * 512 + h * 128 + 4 * d4);
    const f32x4 q4 = {bflo(qw.x), bfhi(qw.x), bflo(qw.y), bfhi(qw.y)};
    const float slope = exp2f(-2.f * (float)(h + 1)) * 1.4426950408889634f;
    const int pi = (unit & 31) * 2 + (w >> 2), page = ((const int*)A.in[I_PT])[seq * NPAGES + pi];
    const float* kp = A.in[I_CK] + ((size_t)page * PAGE * 4 + h) * 128 + (size_t)tk * 512 + 4 * d4;
    const float* vp = A.in[I_CV] + ((size_t)page * PAGE * 4 + h) * 128 + (size_t)tk * 512 + 4 * d4;
    float m0 = -INFINITY, l0 = 0.f, m1 = -INFINITY, l1 = 0.f; f32x4 o0 = {0.f, 0.f, 0.f, 0.f}, o1 = o0;
    const bool c0 = d4 < 16;
    constexpr int DNB = 8;
    f32x4 kA[DNB], vA[DNB], kB[DNB], vB[DNB];
#define DEC_LOAD(KX, VX, p_) do { _Pragma("unroll") for (int j = 0; j < DNB; ++j) { KX[j] = __builtin_nontemporal_load((const f32x4*)(kp + (size_t)((p_) + j) * 1024)); VX[j] = __builtin_nontemporal_load((const f32x4*)(vp + (size_t)((p_) + j) * 1024)); } } while (0)
#define DEC_COMP(KX, VX, p_) do { float s0[DNB], s1[DNB], mx0 = m0, mx1 = m1; \
        _Pragma("unroll") for (int j = 0; j < DNB; ++j) { const f32x4 kq = KX[j] * q4; \
            const float s = sum16((kq[0] + kq[1]) + (kq[2] + kq[3])) + slope * (float)(pi * PAGE + 2 * ((p_) + j) + tk - PAST), so = __shfl_xor(s, 16); \
            s0[j] = c0 ? s : so; s1[j] = c0 ? so : s; mx0 = fmaxf(mx0, s0[j]); mx1 = fmaxf(mx1, s1[j]); } \
        const float a0 = __builtin_amdgcn_exp2f(m0 - mx0), a1 = __builtin_amdgcn_exp2f(m1 - mx1); \
        l0 *= a0; l1 *= a1; o0 *= a0; o1 *= a1; m0 = mx0; m1 = mx1; \
        _Pragma("unroll") for (int j = 0; j < DNB; ++j) { const float e0 = __builtin_amdgcn_exp2f(s0[j] - m0), e1 = __builtin_amdgcn_exp2f(s1[j] - m1); l0 += e0; l1 += e1; o0 += e0 * VX[j]; o1 += e1 * VX[j]; } } while (0)
    DEC_LOAD(kA, vA, 0);
    for (int p0 = 0; p0 < PAGE / 2; p0 += 2 * DNB) {
        DEC_LOAD(kB, vB, p0 + DNB);
        DEC_COMP(kA, vA, p0);
        if (p0 + 2 * DNB < PAGE / 2) DEC_LOAD(kA, vA, p0 + 2 * DNB);
        DEC_COMP(kB, vB, p0 + DNB);
    }
#undef DEC_LOAD
#undef DEC_COMP
#define SWP(x) __uint_as_float(__builtin_amdgcn_permlane32_swap(__float_as_uint(x), __float_as_uint(x), false, false)[tk ? 0 : 1])
    { const float mb0 = SWP(m0), lb0 = SWP(l0), mb1 = SWP(m1), lb1 = SWP(l1);
      const float M0 = fmaxf(m0, mb0), M1 = fmaxf(m1, mb1);
      const float fa0 = __builtin_amdgcn_exp2f(m0 - M0), fb0 = __builtin_amdgcn_exp2f(mb0 - M0), fa1 = __builtin_amdgcn_exp2f(m1 - M1), fb1 = __builtin_amdgcn_exp2f(mb1 - M1);
      f32x4 r0, r1;
#pragma unroll
      for (int j = 0; j < 4; ++j) { const float ob0 = SWP(o0[j]), ob1 = SWP(o1[j]); r0[j] = o0[j] * fa0 + ob0 * fb0; r1[j] = o1[j] * fa1 + ob1 * fb1; }
      float* dp = (float*)(F.ws + WS_DP2) + (size_t)((seq * 4 + h) * NPAGES + pi) * DP_STRIDE;
      if (lane == 0) *(f32x4*)dp = (f32x4){M0, l0 * fa0 + lb0 * fb0, M1, l1 * fa1 + lb1 * fb1};
      if (tk == 0) { *(f32x4*)(dp + 4 + 4 * d4) = r0; *(f32x4*)(dp + 132 + 4 * d4) = r1; } }
#undef SWP
}
__device__ __forceinline__ void decode_combine(Frame& F, const Args& A, int sh, float lam) {
    const int seq = sh >> 2, h = sh & 3, lane = F.lane, w = F.wave; const size_t ro = (size_t)(MP + seq) * 512 + h * 128 + 2 * lane;
    const float* dp = (const float*)(F.ws + WS_DP2) + (size_t)(sh * NPAGES) * DP_STRIDE;
    const float* dpo = dp + 4 + 2 * lane + (size_t)(8 * w) * DP_STRIDE;
    const unsigned qw = *(const unsigned*)((const bf16*)(F.ws + WS_QB) + ro), kw = *(const unsigned*)((const bf16*)(F.ws + WS_KB) + ro), vw = *(const unsigned*)((const bf16*)(F.ws + WS_VB) + ro);
    const f32x4 ml = *(const f32x4*)(dp + (size_t)lane * DP_STRIDE);
    f32x2 o0[8], o1[8];
#pragma unroll
    for (int i = 0; i < 8; ++i) { o0[i] = *(const f32x2*)(dpo + (size_t)i * DP_STRIDE); o1[i] = *(const f32x2*)(dpo + (size_t)i * DP_STRIDE + 128); }
    const float s = half_sum32(bflo(qw) * bflo(kw) + bfhi(qw) * bfhi(kw)), so = __shfl_xor(s, 32);
    const float sn0 = lane < 32 ? s : so, sn1 = lane < 32 ? so : s;
    float mx0 = ml[0], mx1 = ml[2];
#pragma unroll
    for (int o = 1; o < 64; o <<= 1) { mx0 = fmaxf(mx0, __shfl_xor(mx0, o)); mx1 = fmaxf(mx1, __shfl_xor(mx1, o)); }
    const float M0 = fmaxf(mx0, sn0), M1 = fmaxf(mx1, sn1);
    const float e0 = exp2f(sn0 - M0), e1 = exp2f(sn1 - M1), f0 = exp2f(ml[0] - M0), f1 = exp2f(ml[2] - M1);
    const float L0 = e0 + wave_sum(f0 * ml[1]), L1 = e1 + wave_sum(f1 * ml[3]);
    f32x2 a = {0.f, 0.f}, b = {0.f, 0.f};
#pragma unroll
    for (int i = 0; i < 8; ++i) {
        const float g0 = __builtin_bit_cast(float, __builtin_amdgcn_readlane(__builtin_bit_cast(int, f0), 8 * w + i)), g1 = __builtin_bit_cast(float, __builtin_amdgcn_readlane(__builtin_bit_cast(int, f1), 8 * w + i));
        a.x += g0 * o0[i].x; a.y += g0 * o0[i].y; b.x += g1 * o1[i].x; b.y += g1 * o1[i].y; }
    LAS f32x4* red = (LAS f32x4*)(F.lds + RING_OFF);
    red[w * 64 + lane] = (f32x4){a.x, a.y, b.x, b.y};
    __syncthreads();
    if (w != 0) return;
    a = (f32x2){e0 * bflo(vw), e0 * bfhi(vw)}; b = (f32x2){e1 * bflo(vw), e1 * bfhi(vw)};
#pragma unroll
    for (int i = 0; i < 8; ++i) { const f32x4 t = red[i * 64 + lane]; a.x += t[0]; a.y += t[1]; b.x += t[2]; b.y += t[3]; }
    const float i0 = 1.f / L0, i1 = 1.f / L1;
    const float ox = a.x * i0 - lam * b.x * i1, oy = a.y * i0 - lam * b.y * i1;
    const float rn = rsqrtf(wave_sum(ox * ox + oy * oy) * (1.f / 128.f) + 1e-6f) * 0.8f;
    const float* aog = A.in[I_AOG];
    *(unsigned*)((bf16*)(F.ws + WS_ON) + ro) = pk2(ox * rn * aog[2 * lane], oy * rn * aog[2 * lane + 1]);
}

__device__ __forceinline__ void attn_naive_row(Frame& F, const Args& A, int row, int h, float lam) {
    const int lane = F.lane, t = row & (SEQ - 1), rb = row - t;
    const bf16* QB = (const bf16*)(F.ws + WS_QB); const bf16* KB = (const bf16*)(F.ws + WS_KB); const bf16* VB = (const bf16*)(F.ws + WS_VB);
    const float slope = exp2f(-2.f * (float)(h + 1)) * 1.4426950408889634f;
    float res[2][2];
    for (int c = 0; c < 2; ++c) {
        float q[64];
#pragma unroll
        for (int d = 0; d < 64; d += 2) { const unsigned w = *(const unsigned*)(QB + (size_t)row * 512 + h * 128 + c * 64 + d); q[d] = bflo(w); q[d + 1] = bfhi(w); }
        float m = -INFINITY, l = 0.f, o[128];
#pragma unroll
        for (int d = 0; d < 128; ++d) o[d] = 0.f;
        for (int j = lane; j <= t; j += 64) {
            const bf16* kr = KB + (size_t)(rb + j) * 512 + h * 128 + c * 64; const bf16* vr = VB + (size_t)(rb + j) * 512 + h * 128;
            float s = 0.f;
#pragma unroll
            for (int d = 0; d < 64; d += 8) { const v4u w = *(const v4u*)(kr + d);
                s += q[d] * bflo(w.x) + q[d + 1] * bfhi(w.x) + q[d + 2] * bflo(w.y) + q[d + 3] * bfhi(w.y) + q[d + 4] * bflo(w.z) + q[d + 5] * bfhi(w.z) + q[d + 6] * bflo(w.w) + q[d + 7] * bfhi(w.w); }
            s += slope * (float)(j - t);
            const float mn = fmaxf(m, s), al = exp2f(m - mn), e = exp2f(s - mn);
            l = l * al + e; m = mn;
#pragma unroll
            for (int d = 0; d < 128; d += 8) { const v4u w = *(const v4u*)(vr + d);
                o[d] = o[d] * al + e * bflo(w.x); o[d + 1] = o[d + 1] * al + e * bfhi(w.x); o[d + 2] = o[d + 2] * al + e * bflo(w.y); o[d + 3] = o[d + 3] * al + e * bfhi(w.y);
                o[d + 4] = o[d + 4] * al + e * bflo(w.z); o[d + 5] = o[d + 5] * al + e * bfhi(w.z); o[d + 6] = o[d + 6] * al + e * bflo(w.w); o[d + 7] = o[d + 7] * al + e * bfhi(w.w); }
        }
        float M = m;
#pragma unroll
        for (int x = 1; x < 64; x <<= 1) M = fmaxf(M, __shfl_xor(M, x));
        const float sc = exp2f(m - M);
        const float L = wave_sum(l * sc);
        float r0 = 0.f, r1 = 0.f;
#pragma unroll
        for (int d = 0; d < 128; ++d) { const float tot = wave_sum(o[d] * sc); if ((d & 63) == lane) { if (d < 64) r0 = tot; else r1 = tot; } }
        res[c][0] = r0 / L; res[c][1] = r1 / L;
    }
    const float ox = res[0][0] - lam * res[1][0], oy = res[0][1] - lam * res[1][1];
    const float rn = rsqrtf(wave_sum(ox * ox + oy * oy) * (1.f / 128.f) + 1e-6f) * 0.8f;
    const float* aog = A.in[I_AOG]; bf16* ON = (bf16*)(F.ws + WS_ON) + (size_t)row * 512 + h * 128;
    ON[lane] = (bf16)(pk2(ox * rn * aog[lane], 0.f) & 0xffffu); ON[64 + lane] = (bf16)(pk2(oy * rn * aog[64 + lane], 0.f) & 0xffffu);
}


__device__ __forceinline__ unsigned bfbits(float f) { return __builtin_bit_cast(unsigned, f) >> 16; }
__device__ __forceinline__ void attn_unit(Frame& F, const Args& A, int b, int h, int qb, float lam) {
    LAS unsigned char* Kt = F.lds + RING_OFF;
    LAS float* wsf = (LAS float*)(Kt + 98304) + F.wave * 64;
    LAS float* xch = (LAS float*)Kt;
    const bf16* QB = (const bf16*)(F.ws + WS_QB); const bf16* KB = (const bf16*)(F.ws + WS_KB); const bf16* VB = (const bf16*)(F.ws + WS_VB);
    const int tid = F.tid, lane = F.lane, w = F.wave, c = w >> 2, wq = w & 3, r32 = lane & 31, hi = lane >> 5;
    const int rowbase = b * SEQ, q0 = 128 * qb + 32 * wq, NT = 2 * (qb + 1);
    bf16x8 qr[4];
    { const bf16* Qp = QB + (size_t)(rowbase + q0 + r32) * 512 + (2 * h + c) * 64 + 8 * hi;
#pragma unroll
      for (int d0 = 0; d0 < 4; ++d0) qr[d0] = *(const bf16x8*)(Qp + 16 * d0); }
    asm volatile("" : "+v"(qr[0]), "+v"(qr[1]), "+v"(qr[2]), "+v"(qr[3]));
    const float sl = exp2f(-2.f * (float)(h + 1)) * 1.4426950408889634f;
    const unsigned c1 = __builtin_bit_cast(unsigned, sl) & 0xffff0000u; const float r1 = sl - __builtin_bit_cast(float, c1);
    const unsigned c2 = __builtin_bit_cast(unsigned, r1) & 0xffff0000u; const float r2 = r1 - __builtin_bit_cast(float, c2);
    const unsigned c3 = __builtin_bit_cast(unsigned, r2) & 0xffff0000u;
    const unsigned b1 = c1 >> 16, b2 = c2 >> 16, b3 = c3 >> 16, lo_mask = hi ? 0u : 0xffffffffu;
    const v4u qextu = {(b1 | (b2 << 16)) & lo_mask, (b3 | (b1 << 16)) & lo_mask, (b2 | (b3 << 16)) & lo_mask, 0u};
    const bf16x8 qext = __builtin_bit_cast(bf16x8, qextu);
    const unsigned J0 = bfbits((float)r32), J1 = bfbits((float)(32 + r32));
    const unsigned lds0 = (unsigned)(uintptr_t)(F.lds + RING_OFF);
    const bf16* kg0 = KB + (size_t)(rowbase + lane) * 512 + h * 128 + (2 * w) * 8;
    const bf16* vg0 = VB + (size_t)(rowbase + 32 * (w & 1) + (lane >> 2)) * 512 + h * 128 + (w >> 1) * 32 + (lane & 3) * 8;
    const unsigned kd0 = lds0 + (2 * w) * 1024, vd0 = lds0 + 16384 + (w >> 1) * 4096 + (2 * (w & 1)) * 1024;
#define ATT_DMA(t_, boff_) do { const size_t go_ = (size_t)(t_) * 64 * 512; const unsigned bo_ = (unsigned)(boff_); \
        glds16(kg0 + go_, (unsigned)__builtin_amdgcn_readfirstlane(kd0 + bo_)); glds16(kg0 + go_ + 8, (unsigned)__builtin_amdgcn_readfirstlane(kd0 + bo_ + 1024)); \
        glds16(vg0 + go_, (unsigned)__builtin_amdgcn_readfirstlane(vd0 + bo_)); glds16(vg0 + go_ + (size_t)16 * 512, (unsigned)__builtin_amdgcn_readfirstlane(vd0 + bo_ + 1024)); } while (0)
    ATT_DMA(NT - 1, 0);
    f32x16 o[4];
#pragma unroll
    for (int i = 0; i < 4; ++i) o[i] = (f32x16){};
    float m = -INFINITY, l = 0.f;
    bf16x8 pa[4];
    asm volatile("s_waitcnt vmcnt(0) lgkmcnt(0)\n\ts_barrier" ::: "memory");
#define ATT_QKSM(t, bo) do { \
        const LAS unsigned char* kfp = Kt + (bo) + (c * 8 + hi) * 1024 + r32 * 16; \
        const unsigned Tb = bfbits((float)(64 * (t) - 128 * qb)); \
        f32x16 p[2]; bf16x8 kfr[2][4]; \
        _Pragma("unroll") for (int half = 0; half < 2; ++half) _Pragma("unroll") for (int d0 = 0; d0 < 4; ++d0) kfr[half][d0] = *(const LAS bf16x8*)(kfp + d0 * 2048 + half * 512); \
        __builtin_amdgcn_sched_barrier(0); \
        _Pragma("unroll") for (int half = 0; half < 2; ++half) { f32x16 acc = (f32x16){}; \
            _Pragma("unroll") for (int d0 = 0; d0 < 4; ++d0) acc = __builtin_amdgcn_mfma_f32_32x32x16_bf16(kfr[half][d0], qr[d0], acc, 0, 0, 0); \
            const unsigned Jb = half ? J1 : J0; \
            const v4u ke = {(Tb | (Tb << 16)) & lo_mask, (Tb | (Jb << 16)) & lo_mask, (Jb | (Jb << 16)) & lo_mask, 0u}; \
            p[half] = __builtin_amdgcn_mfma_f32_32x32x16_bf16(__builtin_bit_cast(bf16x8, ke), qext, acc, 0, 0, 0); } \
        if (64 * (t) + 63 > q0) { const int qpos = q0 + r32; \
            _Pragma("unroll") for (int half = 0; half < 2; ++half) _Pragma("unroll") for (int r = 0; r < 16; ++r) { const int kv = 64 * (t) + 32 * half + crow16(r, hi); if (kv > qpos) p[half][r] = -INFINITY; } } \
        float mx = p[0][0]; \
        _Pragma("unroll") for (int r = 1; r < 16; ++r) mx = fmaxf(mx, p[0][r]); \
        _Pragma("unroll") for (int r = 0; r < 16; ++r) mx = fmaxf(mx, p[1][r]); \
        { const auto rr = __builtin_amdgcn_permlane32_swap(__float_as_uint(mx), __float_as_uint(mx), false, false); mx = fmaxf(__uint_as_float(rr[0]), __uint_as_float(rr[1])); } \
        const float mn = fmaxf(m, mx), alpha = __builtin_amdgcn_exp2f(m - mn); m = mn; \
        float ls = 0.f; \
        _Pragma("unroll") for (int half = 0; half < 2; ++half) _Pragma("unroll") for (int r = 0; r < 16; ++r) { const float e = __builtin_amdgcn_exp2f(p[half][r] - mn); p[half][r] = e; ls += e; } \
        { const auto rr = __builtin_amdgcn_permlane32_swap(__float_as_uint(ls), __float_as_uint(ls), false, false); ls = __uint_as_float(rr[0]) + __uint_as_float(rr[1]); } \
        l = l * alpha + ls; \
        if (__any(alpha != 1.f)) { if (hi == 0) wsf[r32] = alpha; LDS_WAIT(); \
            _Pragma("unroll") for (int r = 0; r < 16; ++r) { const float f = wsf[crow16(r, hi)]; _Pragma("unroll") for (int blk = 0; blk < 4; ++blk) o[blk][r] *= f; } } \
        _Pragma("unroll") for (int s = 0; s < 4; ++s) { const int hf = s >> 1, rb = 8 * (s & 1); \
            const v4u u = {pk2(p[hf][rb], p[hf][rb + 1]), pk2(p[hf][rb + 2], p[hf][rb + 3]), pk2(p[hf][rb + 4], p[hf][rb + 5]), pk2(p[hf][rb + 6], p[hf][rb + 7])}; \
            pa[s] = __builtin_bit_cast(bf16x8, u); } } while (0)
#define ATT_PV(bo) do { \
        const LAS unsigned char* vfp = Kt + (bo) + 16384 + ((lane >> 4) & 1) * 32 + (lane & 3) * 8 + (4 * hi + ((lane & 15) >> 2)) * 64; \
        s16x4 vlo[2][4], vhi[2][4]; \
        _Pragma("unroll") for (int s = 0; s < 4; ++s) { vlo[0][s] = vtr(vfp + s * 1024); vhi[0][s] = vtr(vfp + s * 1024 + 512); } \
        _Pragma("unroll") for (int blk = 0; blk < 4; ++blk) { \
            if (blk < 3) { _Pragma("unroll") for (int s = 0; s < 4; ++s) { vlo[(blk + 1) & 1][s] = vtr(vfp + (blk + 1) * 4096 + s * 1024); vhi[(blk + 1) & 1][s] = vtr(vfp + (blk + 1) * 4096 + s * 1024 + 512); } } \
            __builtin_amdgcn_sched_barrier(0); \
            _Pragma("unroll") for (int s = 0; s < 4; ++s) { const s16x4 lo = vlo[blk & 1][s], hh = vhi[blk & 1][s]; \
                const bf16x8 vf = {lo[0], lo[1], lo[2], lo[3], hh[0], hh[1], hh[2], hh[3]}; \
                o[blk] = __builtin_amdgcn_mfma_f32_32x32x16_bf16(pa[s], vf, o[blk], 0, 0, 0); } \
            __builtin_amdgcn_sched_barrier(0); } } while (0)
    bool pend = false; int pbo = 0, bo = 0;
    for (int it = 0; it <= NT; ++it) {
        const int t = NT - 1 - it, bn = (bo == 65536) ? 0 : bo + 32768;
        if (it + 1 < NT) ATT_DMA(t - 1, bn);
        const bool act = it < NT && 64 * t <= q0 + 31;
        if (c == 1 && pend) ATT_PV(pbo);
        if (act) ATT_QKSM(t, bo);
        if (c == 0 && act) ATT_PV(bo);
        if (c == 1) { pend = act; pbo = bo; }
        asm volatile("s_waitcnt vmcnt(0) lgkmcnt(0)\n\ts_barrier" ::: "memory");
        bo = bn;
    }
#undef ATT_QKSM
#undef ATT_PV
#undef ATT_DMA
    if (hi == 0) wsf[r32] = 1.f / l;
    LDS_WAIT();
#pragma unroll
    for (int r = 0; r < 16; ++r) { const float f = wsf[crow16(r, hi)];
#pragma unroll
        for (int blk = 0; blk < 4; ++blk) o[blk][r] *= f; }
    LAS float* xw = xch + wq * 4096;
    if (c == 1) {
#pragma unroll
        for (int blk = 0; blk < 4; ++blk)
#pragma unroll
            for (int r = 0; r < 16; ++r) xw[(blk * 16 + r) * 64 + lane] = o[blk][r];
    }
    __syncthreads();
    if (c == 0) {
        const float* aog = A.in[I_AOG]; bf16* ON = (bf16*)(F.ws + WS_ON);
        float g[4];
#pragma unroll
        for (int blk = 0; blk < 4; ++blk) g[blk] = aog[32 * blk + r32] * 0.8f;
#pragma unroll
        for (int r = 0; r < 16; ++r) {
            float v[4], ss = 0.f;
#pragma unroll
            for (int blk = 0; blk < 4; ++blk) { v[blk] = o[blk][r] - lam * xw[(blk * 16 + r) * 64 + lane]; ss += v[blk] * v[blk]; }
            ss += __shfl_xor(ss, 1); ss += __shfl_xor(ss, 2); ss += __shfl_xor(ss, 4); ss += __shfl_xor(ss, 8); ss += __shfl_xor(ss, 16);
            const float rn = rsqrtf(ss * (1.f / 128.f) + 1e-6f);
            bf16* op = ON + (size_t)(rowbase + q0 + crow16(r, hi)) * 512 + h * 128 + r32;
#pragma unroll
            for (int blk = 0; blk < 4; ++blk) op[32 * blk] = (bf16)(pk2(v[blk] * rn * g[blk], 0.f) & 0xffffu);
        }
    }
    __syncthreads();
}

__device__ __forceinline__ void skinny_tile(Frame& F, LAS float* red, const bf16* A, int lda, const bf16* Bt, int K, int n0) {
    const int lane = F.lane, r = lane & 31, hi = lane >> 5, w = F.wave, kw = K / 8;
    const bf16* ap = A + (size_t)r * lda + w * kw + 8 * hi; const bf16* bp = Bt + (size_t)(n0 + r) * K + w * kw + 8 * hi;
    f32x16 acc = {};
    const int nst = kw / 16;
    for (int s0 = 0; s0 < nst; s0 += 8) {
        bf16x8 av[8], bv[8];
#pragma unroll
        for (int j = 0; j < 8; ++j) { const int k = (s0 + j < nst ? s0 + j : nst - 1) * 16; av[j] = *(const bf16x8*)(ap + k); bv[j] = *(const bf16x8*)(bp + k); }
#pragma unroll
        for (int j = 0; j < 8; ++j) if (s0 + j < nst) acc = __builtin_amdgcn_mfma_f32_32x32x16_bf16(av[j], bv[j], acc, 0, 0, 0);
    }
    __syncthreads();
#pragma unroll
    for (int i = 0; i < 16; ++i) red[w * 1024 + i * 64 + lane] = acc[i];
    __syncthreads();
    for (int e = F.tid; e < 1024; e += 512) { float s = 0.f;
#pragma unroll
        for (int j = 0; j < 8; ++j) s += red[j * 1024 + e];
        red[8 * 1024 + e] = s; }
    __syncthreads();
}

#ifndef MK_N_LAUNCHES
#define MK_N_LAUNCHES 1
#endif
#ifndef MK_NAIVE_ATTN
#define MK_NAIVE_ATTN 0
#endif
constexpr int N_PHASES = 10;
__global__ void __launch_bounds__(NWAVES * 64, 2) mk_fwd(Args args) {
    extern __shared__ __attribute__((aligned(16))) unsigned char lds[];
    Frame F;
#ifdef MK_SUB
    F.pa = 0ull; F.pb = 0ull;
#endif
    F.lds = (LAS unsigned char*)lds;
    F.MISC = (volatile LAS unsigned*)(F.lds + MISC_OFF);
    F.tid = threadIdx.x; F.lane = F.tid & 63; F.wave = __builtin_amdgcn_readfirstlane(F.tid >> 6);
    F.G = gridDim.x; { const int bx = blockIdx.x; F.vcu = (F.G % 8 == 0) ? (bx % 8) * (F.G / 8) + bx / 8 : bx; }
    F.ws = args.ws; F.out = args.out; F.ctl = (gu32*)(args.ws + WS_CTL);
    const Args& A = args;
    for (int u = F.tid; u < (LDS_BYTES - LDSCTL_OFF) / 4; u += NWAVES * 64) ((LAS unsigned*)(F.lds + LDSCTL_OFF))[u] = 0u;
    __syncthreads();
    XcdBarrier bar; bar.bar = (unsigned*)(F.ctl + CW_BAR); bar.x = 0; bar.st = nullptr;
    if (MK_N_LAUNCHES == 1) bar = xcd_barrier_post((unsigned*)(F.ctl + CW_BAR), F.MISC + 8);
#define GRID_BAR() do { if (MK_N_LAUNCHES == 1) xcd_barrier(bar); } while (0)
    const int lo = args.ph_lo, hi = args.ph_hi;
#ifndef MK_PROF
#define MK_PROF -1
#endif
#ifndef MK_PROF_SCALE
#define MK_PROF_SCALE 1e-5f
#endif
    unsigned long long prof_a = 0ull, prof_b = 0ull;
#define PH_BEGIN(k) do { if (MK_PROF == (k)) prof_a = __builtin_amdgcn_s_memrealtime(); } while (0)
#define PH_END(k) do { if (MK_PROF == (k)) prof_b = __builtin_amdgcn_s_memrealtime(); } while (0)
#ifndef MK_DBG_STOP
#define MK_DBG_STOP 99
#endif
#define IN(k) (lo <= (k) && (k) < hi && (k) <= MK_DBG_STOP)
#define BOTH(k) (IN(k) && IN((k) + 1))
    bf16* XB = (bf16*)(F.ws + WS_XB); float* rs0 = (float*)(F.ws + WS_RS0);
    bf16* QB = (bf16*)(F.ws + WS_QB); bf16* KB = (bf16*)(F.ws + WS_KB); bf16* VB = (bf16*)(F.ws + WS_VB); bf16* PC = (bf16*)(F.ws + WS_PC); bf16* GT = (bf16*)(F.ws + WS_GT);
    bf16* ON = (bf16*)(F.ws + WS_ON); bf16* RW = (bf16*)(F.ws + WS_RW); bf16* MG = (bf16*)(F.ws + WS_MG); bf16* X1B = (bf16*)(F.ws + WS_X1B); bf16* HB = (bf16*)(F.ws + WS_HB);
    float* ssq = (float*)(F.ctl + CW_SSQ);
    const int bx = (int)blockIdx.x;

    PH_BEGIN(0);
    if (IN(0)) { for (int i = bx * 512 + F.tid; i < MTOT; i += F.G * 512) ssq[i] = 0.f;
        p0_prologue<0>(F, A, F.vcu * NWAVES + F.wave, F.G * NWAVES); if (BOTH(0)) GRID_BAR(); PH_END(0); }
    PH_BEGIN(1);
    if (IN(1)) {
        pg8::Gemm g{XB, (const bf16*)(F.ws + WS_WIN), nullptr, nullptr, MTOT, INW, DM}; pg8::StaticOrder S; S.init(MTOT, INW, F.G, bx);
        pg8::EpiProj E{rs0, A.in[I_QG], A.in[I_KG], QB, KB, VB, PC, GT, F.out};
        pg8::gemm_phase<pg8::EpiProj, pg8::StaticOrder, true, true>(F.lds + RING_OFF, g, S, E);
        { const int nlong = ((MTOT / 256 + (MTOT % 256 != 0)) * (INW / 256)) % F.G;
          if (nlong == 0) p0_prologue<1>(F, A, bx * NWAVES + F.wave, F.G * NWAVES);
          else if (bx >= nlong) p0_prologue<1>(F, A, (bx - nlong) * NWAVES + F.wave, (F.G - nlong) * NWAVES);
          __syncthreads(); }
        if (BOTH(1)) GRID_BAR(); PH_END(1);
    }
    PH_BEGIN(2);
    if (IN(2)) {
        SUBM(30);
        {
            const int grp = (bx + 2 * F.G >= MP / 32) ? bx % 3 : -1;
            int u = bx;
#pragma unroll 1
            for (int st = 0; ; ++st) {
                if (st == grp) {
                    LAS unsigned* qslot = (LAS unsigned*)(F.lds + LDSCTL_OFF);
                    if (F.tid == 0) qslot[0] = __hip_atomic_fetch_add((unsigned*)(F.ctl + CW_QDEC), 1u, __ATOMIC_RELAXED, __HIP_MEMORY_SCOPE_AGENT);
                    __syncthreads();
                    const unsigned k = qslot[0];
                    __syncthreads();
                    if (k < 1024u) decode_unit(F, A, (int)k);
                    __syncthreads();
                } else if (u < MP / 32) { rwkv_prep_unit(F, A, u); u += F.G; }
                else break;
            }
        }
        SUBM(31);
        SUBM(32);
        if (BOTH(2)) GRID_BAR(); PH_END(2);
    }
    PH_BEGIN(3);
    if (IN(3)) {
        SUBM(10);
        SUBM(11);
        for (int hc = bx * NWAVES + F.wave; hc < 32 * NCHK; hc += F.G * NWAVES) chunk_unit(F, hc);
        __syncthreads();
        if (BOTH(3)) GRID_BAR(); PH_END(3);
    }
    PH_BEGIN(4);
    if (IN(4)) {
        { int ln_ = F.lane, td_ = F.tid; asm volatile("" : "+v"(ln_), "+v"(td_)); F.lane = ln_; F.tid = td_; }
        SUBM(50);
        if (bx < 8) { chain_unit(F, bx * NWAVES + F.wave); __syncthreads(); }
        SUBM(51);
        const float lam = lam_value(F, A);
        LAS unsigned* qslot = (LAS unsigned*)(F.lds + LDSCTL_OFF);
        const unsigned dtail = __hip_atomic_load((unsigned*)(F.ctl + CW_QDEC), __ATOMIC_RELAXED, __HIP_MEMORY_SCOPE_AGENT) < 1024u ? __hip_atomic_load((unsigned*)(F.ctl + CW_QDEC), __ATOMIC_RELAXED, __HIP_MEMORY_SCOPE_AGENT) : 1024u;
        for (;;) {
            { int ln_ = F.lane, td_ = F.tid; asm volatile("" : "+v"(ln_), "+v"(td_)); F.lane = ln_; F.tid = td_; }
            if (F.tid == 0) qslot[0] = __hip_atomic_fetch_add((unsigned*)(F.ctl + CW_QUEUE), 1u, __ATOMIC_RELAXED, __HIP_MEMORY_SCOPE_AGENT);
            __syncthreads();
            const unsigned k = qslot[0];
            __syncthreads();
            if (k >= 1537u) break;
            if (k == 0u) { rwkv_prep_unit(F, A, MP / 32); continue; }
            const unsigned tr = (k - 1u) / 3u, r = (k - 1u) - 3u * tr;
#ifdef MK_SUB
            const unsigned long long t0_ = __builtin_amdgcn_s_memrealtime();
#endif
            if (r == 0u) attn_unit(F, A, (int)(tr & 15u) >> 2, (int)(tr & 3u), 31 - (int)(tr >> 4), lam);
            else { const unsigned d = dtail + 2u * tr + r - 1u; if (d < 1024u) decode_unit(F, A, (int)d); }
#ifdef MK_SUB
            if ((MK_SUB == 40 && r == 0u) || (MK_SUB == 41 && r != 0u)) F.pb += __builtin_amdgcn_s_memrealtime() - t0_;
#endif
        }
        if (BOTH(4)) GRID_BAR(); PH_END(4);
    }
    PH_BEGIN(5);
    if (IN(5)) {
        SUBM(20);
        { const float lam = lam_value(F, A);
          for (int it = bx; it < 128; it += F.G) { decode_combine(F, A, it, lam); if (it + F.G < 128) __syncthreads(); } }
        __syncthreads();
        for (int u = 256 + bx; u < 512; u += F.G) scan_seg_unit(F, A, u);
        SUBM(21);
        for (int hc = bx * NWAVES + F.wave; hc < 32 * NCHK; hc += F.G * NWAVES) ypass_unit(F, A, hc);
        SUBM(22);
        __syncthreads();
        if (BOTH(5)) GRID_BAR(); PH_END(5);
    }
    PH_BEGIN(6);
    if (IN(6)) {
        if (bx < 32) {
            LAS float* red = (LAS float*)(F.lds + RING_OFF); const int n0 = 32 * bx; float t1[2];
            skinny_tile(F, red, ON + (size_t)MP * 512, 512, (const bf16*)(F.ws + WS_WPA), 512, n0);
            t1[0] = red[8192 + F.tid]; t1[1] = red[8192 + 512 + F.tid];
            skinny_tile(F, red, RW + (size_t)MP * 512, 512, (const bf16*)(F.ws + WS_WPB), 512, n0);
#pragma unroll
            for (int i = 0; i < 2; ++i) { const int e = F.tid + 512 * i, reg = e >> 6, ln = e & 63, row = crow16(reg, ln >> 5), col = n0 + (ln & 31);
                const float g1 = bf2f(GT[(size_t)(MP + row) * 2048 + col]), g2 = bf2f(GT[(size_t)(MP + row) * 2048 + 1024 + col]);
                MG[(size_t)(MP + row) * 1024 + col] = (bf16)(pk2(g1 * t1[i] + g2 * red[8192 + e], 0.f) & 0xffffu); }
            __syncthreads();
        }
        pg8::Gemm g{ON, (const bf16*)(F.ws + WS_WPA), RW, (const bf16*)(F.ws + WS_WPB), MP, DM, 512}; pg8::PairOrder S; S.base.init(MP, DM, F.G, bx);
        pg8::EpiMerge E{GT, (float*)(F.ws + WS_TMP), MG};
        pg8::gemm_phase<pg8::EpiMerge, pg8::PairOrder, true, true>(F.lds + RING_OFF, g, S, E);
        if (BOTH(6)) GRID_BAR(); PH_END(6);
    }
    PH_BEGIN(7);
    if (IN(7)) {
        if (bx < 32) {
            LAS float* red = (LAS float*)(F.lds + RING_OFF); const int n0 = 32 * bx;
            skinny_tile(F, red, MG + (size_t)MP * 1024, 1024, (const bf16*)(F.ws + WS_WOUT), 1024, n0);
#pragma unroll
            for (int i = 0; i < 2; ++i) { const int e = F.tid + 512 * i, reg = e >> 6, ln = e & 63, row = crow16(reg, ln >> 5), col = n0 + (ln & 31);
                const float v = A.in[I_XS][(size_t)row * 1024 + col] + red[8192 + e];
                F.out[O_YS + (size_t)row * 1024 + col] = v; X1B[(size_t)(MP + row) * 1024 + col] = (bf16)(pk2(v, 0.f) & 0xffffu);
                float ss = v * v; ss += __shfl_xor(ss, 1); ss += __shfl_xor(ss, 2); ss += __shfl_xor(ss, 4); ss += __shfl_xor(ss, 8); ss += __shfl_xor(ss, 16);
                if ((ln & 31) == 0) atomicAdd(ssq + MP + row, ss); }
            __syncthreads();
        }
        pg8::Gemm g{MG, (const bf16*)(F.ws + WS_WOUT), nullptr, nullptr, MP, DM, DM}; pg8::StaticOrder S; S.init(MP, DM, F.G, bx);
        pg8::EpiOut E{XB, X1B, ssq};
        pg8::gemm_phase<pg8::EpiOut, pg8::StaticOrder, false, true>(F.lds + RING_OFF, g, S, E);
        if (BOTH(7)) GRID_BAR(); PH_END(7);
    }
    PH_BEGIN(8);
    if (IN(8)) {
        pg8::Gemm g{X1B, (const bf16*)(F.ws + WS_WGU), nullptr, nullptr, MTOT, NGU, DM}; pg8::StaticOrder S; S.init(MTOT, NGU, F.G, bx);
        pg8::EpiGateUp E{ssq, HB};
        pg8::gemm_phase<pg8::EpiGateUp, pg8::StaticOrder, true, true>(F.lds + RING_OFF, g, S, E);
        if (BOTH(8)) GRID_BAR(); PH_END(8);
    }
    PH_BEGIN(9);
    if (IN(9)) {
        if (bx < 32) {
            LAS float* red = (LAS float*)(F.lds + RING_OFF); const int n0 = 32 * bx;
            skinny_tile(F, red, HB + (size_t)MP * FF, FF, (const bf16*)(F.ws + WS_WDN), FF, n0);
#pragma unroll
            for (int i = 0; i < 2; ++i) { const int e = F.tid + 512 * i, reg = e >> 6, ln = e & 63, row = crow16(reg, ln >> 5), col = n0 + (ln & 31);
                float yv = F.out[O_YS + (size_t)row * 1024 + col] + red[8192 + e];
#ifdef MK_SUB
                prof_a = F.pa; prof_b = F.pb;
#endif
                if (MK_PROF >= 0 && MK_PROF != 9) yv *= 1.f + sqrtf((float)(prof_b - prof_a) * 0.01f * MK_PROF_SCALE);
                F.out[O_YS + (size_t)row * 1024 + col] = yv; }
            __syncthreads();
        }
        pg8::Gemm g{HB, (const bf16*)(F.ws + WS_WDN), nullptr, nullptr, MP, DM, FF}; pg8::StaticOrder S; S.init(MP, DM, F.G, bx);
        pg8::EpiDown E{F.out + O_YP, X1B};
        pg8::gemm_phase<pg8::EpiDown, pg8::StaticOrder, false, true>(F.lds + RING_OFF, g, S, E);
        if (MK_PROF == 9 && MK_N_LAUNCHES == 1) {
            xcd_barrier(bar); prof_b = __builtin_amdgcn_s_memrealtime();
            const float sc = 1.f + sqrtf((float)(prof_b - prof_a) * 0.01f * 1e-5f);
            for (int e = bx * 512 + F.tid; e < 32 * 1024; e += F.G * 512) F.out[O_YS + e] *= sc;
        }
    }
#undef IN
#undef BOTH
}

#if MK_NAIVE_ATTN
__global__ void __launch_bounds__(512, 2) attn_naive_kernel(Args args) {
    Frame F; F.tid = threadIdx.x; F.lane = F.tid & 63; F.wave = __builtin_amdgcn_readfirstlane(F.tid >> 6); F.G = gridDim.x; F.ws = args.ws; F.out = args.out;
    const Args& A = args;
    const float lam = lam_value(F, A);
    const int gw = (int)blockIdx.x * NWAVES + F.wave, NGW = F.G * NWAVES;
    for (int it = gw; it < MP * 4; it += NGW) attn_naive_row(F, A, it >> 2, it & 3, lam);
}
#endif
extern "C" void kernel_launch(void* const* d_in, const int* in_sizes, int n_in, void* d_out, int out_size, void* d_ws, size_t ws_size, hipStream_t stream) {
    static int grid = 0;
    if (grid == 0) {
        if (n_in != 34 || out_size != (int)O_END || ws_size < WS_END) { fprintf(stderr, "kernel_launch: unexpected shapes: n_in %d out %d ws %zu\n", n_in, out_size, ws_size); grid = -1; return; }
        int dev = 0, cus = 0, per_cu = 0;
        if (hipGetDevice(&dev) != hipSuccess || hipDeviceGetAttribute(&cus, hipDeviceAttributeMultiprocessorCount, dev) != hipSuccess) { grid = -1; return; }
        if (hipFuncSetAttribute((const void*)mk_fwd, hipFuncAttributeMaxDynamicSharedMemorySize, LDS_BYTES) != hipSuccess) { fprintf(stderr, "kernel_launch: hipFuncSetAttribute failed\n"); grid = -1; return; }
        if (hipOccupancyMaxActiveBlocksPerMultiprocessor(&per_cu, (const void*)mk_fwd, NWAVES * 64, LDS_BYTES) != hipSuccess || per_cu < 1) fprintf(stderr, "kernel_launch: occupancy query says %d\n", per_cu);
        (void)hipGetLastError();
        grid = cus;
    }
    if (grid < 0) return;
    if (hipMemsetAsync((char*)d_ws + WS_CTL, 0, CTL_ZERO_BYTES, stream) != hipSuccess) return;
    Args a{};
    for (int i = 0; i < 34; ++i) a.in[i] = (const float*)d_in[i];
    a.out = (float*)d_out; a.ws = (unsigned char*)d_ws;
    const int NL = MK_N_LAUNCHES;
    for (int li = 0; li < NL; ++li) {
        a.ph_lo = (NL == 1) ? 0 : li; a.ph_hi = (NL == 1) ? N_PHASES : li + 1; a.li = li; a.pad = 0;
        hipLaunchKernelGGL(mk_fwd, dim3(grid), dim3(NWAVES * 64), LDS_BYTES, stream, a);
        if (hipPeekAtLastError() != hipSuccess) { fprintf(stderr, "kernel_launch: launch %d failed\n", li); break; }
#if MK_NAIVE_ATTN
        if (NL != 1 && li == 3) hipLaunchKernelGGL(attn_naive_kernel, dim3(1024), dim3(512), 0, stream, a);
#endif
    }
}
```

```cpp
#include <hip/hip_runtime.h>
#include <cstdio>
#include <cstdint>

constexpr int MP = 16384, MS = 32, MVALID = MP + MS, MTOT = 16640;
constexpr int DM = 1024, INW = 5376, FF = 2816, NGU = 2 * FF, SEQ = 4096, NBATCH = 4, RSW = 1792;
constexpr int NPAGES = 64, PAGE = 128, PAST = 8192;
constexpr size_t O_YP = 0, O_YS = 16777216, O_KP = O_YS + 32768, O_VP = O_KP + 8388608, O_WP = O_VP + 8388608, O_SP = O_WP + 131072,
                 O_KS = O_SP + 7168, O_VS = O_KS + 16384, O_WS = O_VS + 16384, O_SS = O_WS + 1048576, O_END = O_SS + 57344;
constexpr float QK_C2 = 0.125f * 1.4426950408889634f;
namespace pg8 {
#define PG8_LAS __attribute__((address_space(3)))
typedef unsigned short bf16_t;
typedef short bf16x8 __attribute__((ext_vector_type(8)));
typedef float f32x4 __attribute__((ext_vector_type(4)));
typedef unsigned u32x4 __attribute__((ext_vector_type(4)));
constexpr int BM = 256, BK = 64, HALF = 128, HTB = HALF * BK * 2  , STAGE_BYTES = 8 * HTB, NXCD = 8, WGM = 8;

__host__ __device__ __forceinline__ int lds_byte(int r, int c) { const int st = (r >> 4) * 2 + (c >> 5), rr = r & 15, cc = c & 31, ob = rr * 64 + cc * 2; return st * 1024 + (ob ^ (((ob >> 9) & 1) << 5)); }
__host__ __device__ __forceinline__ void stage_rc(int b, int& R, int& C) { const int st = b / 1024, sb = b % 1024, swz = sb ^ (((sb >> 9) & 1) << 5); R = (st >> 1) * 16 + swz / 64; C = (st & 1) * 32 + (swz % 64) / 2; }
__host__ __device__ __forceinline__ int perm32(int rho) { const int n = rho >> 4, i = rho & 15; return 8 * (i >> 2) + 4 * n + (i & 3); }

struct Unit { int pm, pn, z; };
struct Gemm { const bf16_t* A; const bf16_t* Bt; const bf16_t* A2; const bf16_t* Bt2; int M, N, K; };

struct StaticOrder {
    int nM, nN, nwg, G, c;
    __host__ __device__ void init(int M, int N, int G_, int c_) { nM = M / BM; nN = N / BM; nwg = nM * nN; G = G_; c = c_; }
    __host__ __device__ bool next(int i, Unit& u) const {
        const long L = (long)i * G + c; if (L >= nwg) return false;
        int wgid = (int)L; { const int q = nwg / NXCD, r = nwg % NXCD, xcd = wgid % NXCD, off = wgid / NXCD; wgid = (xcd < r ? xcd * (q + 1) : r * (q + 1) + (xcd - r) * q) + off; }
        const int nig = WGM * nN, gid = wgid / nig, fm = gid * WGM, gsz = (nM - fm) < WGM ? (nM - fm) : WGM;
        u.pm = fm + ((wgid % nig) % gsz); u.pn = (wgid % nig) / gsz; u.z = 0; return true;
    }
    __device__ __forceinline__ void a_ready(const Unit&) const {}
    __device__ __forceinline__ void done(const Unit&) const {}
};

typedef float f32x2_cv __attribute__((ext_vector_type(2))); typedef __bf16 bf16x2_cv __attribute__((ext_vector_type(2)));
__device__ __forceinline__ unsigned cvt_pk_bf16(float lo, float hi) { const f32x2_cv v = {lo, hi}; const bf16x2_cv b = __builtin_convertvector(v, bf16x2_cv); return __builtin_bit_cast(unsigned, b); }
typedef float f32x2 __attribute__((ext_vector_type(2)));
__device__ __forceinline__ void st_bf16x8(bf16_t* p, const f32x4 a, const f32x4 b) {
    u32x4 w; w.x = cvt_pk_bf16(a[0], a[1]); w.y = cvt_pk_bf16(a[2], a[3]); w.z = cvt_pk_bf16(b[0], b[1]); w.w = cvt_pk_bf16(b[2], b[3]); *(u32x4*)p = w;
}
__device__ __forceinline__ float sigmoidf_(float x) { return __builtin_amdgcn_rcpf(1.f + __expf(-x)); }

struct EpiProj {
    static constexpr bool PERM = true, AFTER_DRAIN = false, KEEP_ACC = false;
    const float* rs0; const float* qg; const float* kg;
    bf16_t *QB, *KB, *VB, *PC, *GT; float* out;
    __device__ __forceinline__ void operator()(const f32x4 (&acc)[2][2][4][2], const Unit& u, int wr, int wc, int fr, int fq) const {
        const int pn = u.pn, rb = u.pm * BM + wr * 64 + fr, c8 = 64 * wc + 8 * fq;
        if (pn < 4) {
            const bool isq = pn < 2; const float* gain = isq ? qg : kg;
            f32x4 gv[2][2];
#pragma unroll
            for (int bj = 0; bj < 2; ++bj)
#pragma unroll
                for (int n = 0; n < 2; ++n) gv[bj][n] = *(const f32x4*)(gain + 32 * bj + 8 * fq + 4 * n);
            const int colg = 256 * (pn & 1) + c8;
#pragma unroll
            for (int ai = 0; ai < 2; ++ai)
#pragma unroll
                for (int m = 0; m < 4; ++m) {
                    const int row = rb + ai * HALF + m * 16; const bool ok = row < MVALID; const float rs = rs0[ok ? row : 0];
                    float ss = 0.f;
#pragma unroll
                    for (int bj = 0; bj < 2; ++bj)
#pragma unroll
                        for (int n = 0; n < 2; ++n) { const f32x4 x = acc[ai][bj][m][n] * rs; ss += (x[0] * x[0] + x[1] * x[1]) + (x[2] * x[2] + x[3] * x[3]); }
                    ss += __shfl_xor(ss, 16); ss += __shfl_xor(ss, 32);
                    const float rn = rsqrtf(ss * (1.f / 64.f) + 1e-6f) * rs;
#pragma unroll
                    for (int bj = 0; bj < 2; ++bj) {
                        const f32x4 v0 = acc[ai][bj][m][0] * rn * gv[bj][0], v1 = acc[ai][bj][m][1] * rn * gv[bj][1];
                        const size_t o = (size_t)row * 512 + colg + 32 * bj;
                        if (ok) {
                            if (isq) st_bf16x8(QB + o, v0 * QK_C2, v1 * QK_C2);
                            else { st_bf16x8(KB + o, v0, v1);
                                float* f = row < MP ? out + O_KP + o : out + O_KS + (size_t)(row - MP) * 512 + colg + 32 * bj;
                                *(f32x4*)f = v0; *(f32x4*)(f + 4) = v1; }
                        }
                    }
                }
        } else {
#pragma unroll
            for (int ai = 0; ai < 2; ++ai)
#pragma unroll
                for (int m = 0; m < 4; ++m) {
                    const int row = rb + ai * HALF + m * 16; const bool ok = row < MVALID; const float rs = rs0[ok ? row : 0];
                    if (!ok) continue;
#pragma unroll
                    for (int bj = 0; bj < 2; ++bj) {
                        f32x4 v0 = acc[ai][bj][m][0] * rs, v1 = acc[ai][bj][m][1] * rs;
                        if (pn < 6) {
                            const size_t c = (size_t)(256 * (pn - 4) + c8 + 32 * bj), o = (size_t)row * 512 + c;
                            st_bf16x8(VB + o, v0, v1);
                            float* f = row < MP ? out + O_VP + o : out + O_VS + (size_t)(row - MP) * 512 + c;
                            *(f32x4*)f = v0; *(f32x4*)(f + 4) = v1;
                        } else if (pn < 13) {
                            const size_t c = (size_t)(256 * (pn - 6) + c8 + 32 * bj);
                            st_bf16x8(PC + (size_t)row * RSW + c, v0, v1);
                            if (row >= MP) { float* f = out + O_SS + (size_t)(row - MP) * RSW + c; *(f32x4*)f = v0; *(f32x4*)(f + 4) = v1; }
                            else if ((row & (SEQ - 1)) == SEQ - 1) { float* f = out + O_SP + (size_t)(row >> 12) * RSW + c; *(f32x4*)f = v0; *(f32x4*)(f + 4) = v1; }
                        } else {
                            const size_t c = (size_t)(256 * (pn - 13) + c8 + 32 * bj);
#ifndef MK_DBG_NOSIG
#pragma unroll
                            for (int j = 0; j < 4; ++j) { v0[j] = sigmoidf_(v0[j]); v1[j] = sigmoidf_(v1[j]); }
#endif
                            st_bf16x8(GT + (size_t)row * 2048 + c, v0, v1);
                        }
                    }
                }
        }
    }
};

struct EpiMerge {
    static constexpr bool PERM = true, AFTER_DRAIN = false, KEEP_ACC = true;
    const bf16_t* GT; float* tmp; bf16_t* MG;
    __device__ __forceinline__ void operator()(const f32x4 (&acc_)[2][2][4][2], const Unit& u, int wr, int wc, int fr, int fq) const {
        f32x4 (&acc)[2][2][4][2] = const_cast<f32x4 (&)[2][2][4][2]>(acc_);
        const int rb = u.pm * BM + wr * 64 + fr, cb = u.pn * BM + wc * 32 + 8 * fq;
#pragma unroll
        for (int ai = 0; ai < 2; ++ai)
#pragma unroll
            for (int m = 0; m < 4; ++m) {
                const int row = rb + ai * HALF + m * 16;
#pragma unroll
                for (int bj = 0; bj < 2; ++bj) {
                    const int col = cb + bj * HALF;
                    const u32x4 gw = *(const u32x4*)(GT + (size_t)row * 2048 + 1024 + col);
                    f32x4 g0, g1;
                    g0[0] = __builtin_bit_cast(float, gw.x << 16); g0[1] = __builtin_bit_cast(float, gw.x & 0xffff0000u); g0[2] = __builtin_bit_cast(float, gw.y << 16); g0[3] = __builtin_bit_cast(float, gw.y & 0xffff0000u);
                    g1[0] = __builtin_bit_cast(float, gw.z << 16); g1[1] = __builtin_bit_cast(float, gw.z & 0xffff0000u); g1[2] = __builtin_bit_cast(float, gw.w << 16); g1[3] = __builtin_bit_cast(float, gw.w & 0xffff0000u);
                    if (!u.z) {
                        const u32x4 hw = *(const u32x4*)(GT + (size_t)row * 2048 + col);
                        f32x4 h0, h1;
                        h0[0] = __builtin_bit_cast(float, hw.x << 16); h0[1] = __builtin_bit_cast(float, hw.x & 0xffff0000u); h0[2] = __builtin_bit_cast(float, hw.y << 16); h0[3] = __builtin_bit_cast(float, hw.y & 0xffff0000u);
                        h1[0] = __builtin_bit_cast(float, hw.z << 16); h1[1] = __builtin_bit_cast(float, hw.z & 0xffff0000u); h1[2] = __builtin_bit_cast(float, hw.w << 16); h1[3] = __builtin_bit_cast(float, hw.w & 0xffff0000u);
#pragma unroll
                        for (int e = 0; e < 4; ++e) { acc[ai][bj][m][0][e] *= h0[e] / fmaxf(g0[e], 1e-30f); acc[ai][bj][m][1][e] *= h1[e] / fmaxf(g1[e], 1e-30f); }
                    } else {
                        const f32x4 v0 = acc[ai][bj][m][0] * g0, v1 = acc[ai][bj][m][1] * g1;
                        st_bf16x8(MG + (size_t)row * 1024 + col, v0, v1);
                    }
                }
            }
    }
};
struct EpiOut {
    static constexpr bool PERM = true, AFTER_DRAIN = false, KEEP_ACC = false;
    const bf16_t* xb; bf16_t* X1B; float* ssq;
    __device__ __forceinline__ void operator()(const f32x4 (&acc)[2][2][4][2], const Unit& u, int wr, int wc, int fr, int fq) const {
        const int rb = u.pm * BM + wr * 64 + fr, cb = u.pn * BM + wc * 32 + 8 * fq;
#pragma unroll
        for (int ai = 0; ai < 2; ++ai)
#pragma unroll
            for (int m = 0; m < 4; ++m) {
                const int row = rb + ai * HALF + m * 16; float ss = 0.f;
#pragma unroll
                for (int bj = 0; bj < 2; ++bj) {
                    const size_t o = (size_t)row * 1024 + cb + bj * HALF;
                    const u32x4 xw = *(const u32x4*)(xb + o); f32x4 v0 = acc[ai][bj][m][0], v1 = acc[ai][bj][m][1];
                    v0[0] += __builtin_bit_cast(float, xw.x << 16); v0[1] += __builtin_bit_cast(float, xw.x & 0xffff0000u); v0[2] += __builtin_bit_cast(float, xw.y << 16); v0[3] += __builtin_bit_cast(float, xw.y & 0xffff0000u);
                    v1[0] += __builtin_bit_cast(float, xw.z << 16); v1[1] += __builtin_bit_cast(float, xw.z & 0xffff0000u); v1[2] += __builtin_bit_cast(float, xw.w << 16); v1[3] += __builtin_bit_cast(float, xw.w & 0xffff0000u);
                    st_bf16x8(X1B + o, v0, v1);
                    ss += (v0[0] * v0[0] + v0[1] * v0[1]) + (v0[2] * v0[2] + v0[3] * v0[3]) + (v1[0] * v1[0] + v1[1] * v1[1]) + (v1[2] * v1[2] + v1[3] * v1[3]);
                }
                ss += __shfl_xor(ss, 16); ss += __shfl_xor(ss, 32);
                if (fq == 0) atomicAdd(ssq + row, ss);
            }
    }
};
struct EpiGateUp {
    static constexpr bool PERM = true, AFTER_DRAIN = false, KEEP_ACC = false;
    const float* ssq; bf16_t* HB;
    __device__ __forceinline__ void operator()(const f32x4 (&acc)[2][2][4][2], const Unit& u, int wr, int wc, int fr, int fq) const {
        const int rb = u.pm * BM + wr * 64 + fr, cb = u.pn * HALF + wc * 32 + 8 * fq;
#pragma unroll
        for (int ai = 0; ai < 2; ++ai)
#pragma unroll
            for (int m = 0; m < 4; ++m) {
                const int row = rb + ai * HALF + m * 16; if (row >= MVALID) continue;
                const float rs = rsqrtf(ssq[row] * (1.f / 1024.f) + 1e-6f);
                f32x4 h[2];
#pragma unroll
                for (int n = 0; n < 2; ++n)
#pragma unroll
                    for (int j = 0; j < 4; ++j) { const float g = acc[ai][0][m][n][j] * rs, uu = acc[ai][1][m][n][j] * rs; h[n][j] = g * sigmoidf_(g) * uu; }
                st_bf16x8(HB + (size_t)row * FF + cb, h[0], h[1]);
            }
    }
};
struct EpiDown {
    static constexpr bool PERM = true, AFTER_DRAIN = false, KEEP_ACC = false;
    float* y; const bf16_t* X1B;
    __device__ __forceinline__ void operator()(const f32x4 (&acc)[2][2][4][2], const Unit& u, int wr, int wc, int fr, int fq) const {
        const int rb = u.pm * BM + wr * 64 + fr, cb = u.pn * BM + wc * 32 + 8 * fq;
#pragma unroll
        for (int ai = 0; ai < 2; ++ai)
#pragma unroll
            for (int m = 0; m < 4; ++m) {
                const int row = rb + ai * HALF + m * 16;
#pragma unroll
                for (int bj = 0; bj < 2; ++bj) {
                    float* p = y + (size_t)row * 1024 + cb + bj * HALF; const u32x4 xw = *(const u32x4*)(X1B + (size_t)row * 1024 + cb + bj * HALF);
                    f32x4 v0 = acc[ai][bj][m][0], v1 = acc[ai][bj][m][1];
                    v0[0] += __builtin_bit_cast(float, xw.x << 16); v0[1] += __builtin_bit_cast(float, xw.x & 0xffff0000u); v0[2] += __builtin_bit_cast(float, xw.y << 16); v0[3] += __builtin_bit_cast(float, xw.y & 0xffff0000u);
                    v1[0] += __builtin_bit_cast(float, xw.z << 16); v1[1] += __builtin_bit_cast(float, xw.z & 0xffff0000u); v1[2] += __builtin_bit_cast(float, xw.w << 16); v1[3] += __builtin_bit_cast(float, xw.w & 0xffff0000u);
                    *(f32x4*)p = v0; *(f32x4*)(p + 4) = v1;
                }
            }
    }
};
struct PairOrder {
    StaticOrder base;
    __device__ __forceinline__ bool next(int i, Unit& u) const { if (!base.next(i >> 1, u)) return false; u.z = i & 1; return true; }
    __device__ __forceinline__ void a_ready(const Unit&) const {}
    __device__ __forceinline__ void done(const Unit&) const {}
};

template <class Epi, class Sched, bool ALIGN_EPI = false, bool SP2 = false>
__device__ __forceinline__ void gemm_phase(PG8_LAS unsigned char* lds, const Gemm g, const Sched& S, const Epi& E) {
    const int tid = threadIdx.x, wid = __builtin_amdgcn_readfirstlane(tid >> 6), lane = tid & 63, wr = wid >> 2, wc = wid & 3, fr = lane & 15, fq = lane >> 4;
    const int K = g.K, nt = K / BK;
    unsigned voffA[2], voffB[2];
#pragma unroll
    for (int i = 0; i < 2; ++i) { int R, C; stage_rc(tid * 16 + i * 8192, R, C); const int Rb = Epi::PERM ? ((R & ~31) + perm32(R & 31)) : R;
        voffA[i] = (unsigned)(R * K + C) * 2u; voffB[i] = (unsigned)(Rb * K + C) * 2u; }
    const size_t kstep = (size_t)(BK * 2);
    const size_t hstep = (size_t)HALF * K * 2;
    const size_t tstep = 2 * hstep;
    const unsigned ldsw = (unsigned)wid * 1024u;
    const int aoff = lds_byte(wr * 64 + fr, fq * 8), boff = lds_byte(wc * 32 + fr, fq * 8);
#define PG8_SA(b, h) (((b) * 2 + (h)) * HTB)
#define PG8_SB(b, h) ((4 + (b) * 2 + (h)) * HTB)
#define PG8_STAGE(bufoff, gbase, voff) do { _Pragma("unroll") for (int _i = 0; _i < 2; ++_i) \
        __builtin_amdgcn_global_load_lds((const unsigned*)((const char*)(gbase) + (voff)[_i]), (PG8_LAS unsigned*)(lds + (bufoff) + ldsw + _i * 8192), 16, 0, 0); } while (0)
#define PG8_LDA(dst, b, h) do { _Pragma("unroll") for (int m = 0; m < 4; ++m) _Pragma("unroll") for (int k = 0; k < 2; ++k) dst[m][k] = *(const PG8_LAS bf16x8*)(lds + PG8_SA(b, h) + aoff + m * 2048 + k * 1024); } while (0)
#define PG8_LDB(dst, b, h) do { _Pragma("unroll") for (int n = 0; n < 2; ++n) _Pragma("unroll") for (int k = 0; k < 2; ++k) dst[n][k] = *(const PG8_LAS bf16x8*)(lds + PG8_SB(b, h) + boff + n * 2048 + k * 1024); } while (0)
#define PG8_MMA(ai, bj, At, Bt) do { __builtin_amdgcn_s_setprio(1); _Pragma("unroll") for (int m = 0; m < 4; ++m) _Pragma("unroll") for (int n = 0; n < 2; ++n) _Pragma("unroll") for (int k = 0; k < 2; ++k) \
        acc[ai][bj][m][n] = __builtin_amdgcn_mfma_f32_16x16x32_bf16(Bt[n][k], At[m][k], acc[ai][bj][m][n], 0, 0, 0); __builtin_amdgcn_s_setprio(0); } while (0)
#define PG8_WAIT_V(n) asm volatile("s_waitcnt vmcnt(" #n ")" ::: "memory")
#define PG8_WAIT_L(n) asm volatile("s_waitcnt lgkmcnt(" #n ")" ::: "memory")
#define PG8_BAR __builtin_amdgcn_s_barrier()
#define PG8_SCHED __builtin_amdgcn_sched_barrier(0)
    Unit cur, nxt; int ui = 0;
    if (!S.next(0, cur)) return;
    f32x4 acc[2][2][4][2];
#pragma unroll
    for (int a = 0; a < 2; ++a)
#pragma unroll
        for (int b = 0; b < 2; ++b)
#pragma unroll
            for (int m = 0; m < 4; ++m)
#pragma unroll
                for (int n = 0; n < 2; ++n) acc[a][b][m][n] = (f32x4){0.f, 0.f, 0.f, 0.f};
    bf16x8 At[4][2], B0[2][2], B1[2][2];
    const char* cA = (const char*)(cur.z ? g.A2 : g.A) + (size_t)cur.pm * tstep; const char* cB = (const char*)(cur.z ? g.Bt2 : g.Bt) + (size_t)cur.pn * tstep;
    S.a_ready(cur);
    if constexpr (SP2) {
        PG8_STAGE(PG8_SB(0, 0), cB, voffB); PG8_STAGE(PG8_SB(0, 1), cB + hstep, voffB); PG8_STAGE(PG8_SA(0, 0), cA, voffA); PG8_STAGE(PG8_SA(0, 1), cA + hstep, voffA);
        if (wr == 1) PG8_BAR;
        PG8_WAIT_V(2); PG8_BAR;
        PG8_STAGE(PG8_SB(1, 0), cB + kstep, voffB); PG8_STAGE(PG8_SA(1, 0), cA + kstep, voffA); PG8_STAGE(PG8_SB(1, 1), cB + hstep + kstep, voffB);
        PG8_WAIT_V(6); PG8_BAR;
    } else {
        PG8_STAGE(PG8_SB(0, 0), cB, voffB); PG8_STAGE(PG8_SA(0, 0), cA, voffA); PG8_STAGE(PG8_SB(0, 1), cB + hstep, voffB); PG8_STAGE(PG8_SA(0, 1), cA + hstep, voffA);
        if (wr == 1) PG8_BAR;
        PG8_WAIT_V(4); PG8_BAR;
        PG8_STAGE(PG8_SB(1, 0), cB + kstep, voffB); PG8_STAGE(PG8_SA(1, 0), cA + kstep, voffA); PG8_STAGE(PG8_SB(1, 1), cB + hstep + kstep, voffB);
        PG8_WAIT_V(6); PG8_BAR;
    }
    for (;;) {
        const bool has_next = S.next(ui + 1, nxt);
        const char* nA = has_next ? (const char*)(nxt.z ? g.A2 : g.A) + (size_t)nxt.pm * tstep : cA; const char* nB = has_next ? (const char*)(nxt.z ? g.Bt2 : g.Bt) + (size_t)nxt.pn * tstep : cB;
        for (int t = 0; t < nt; t += 2) {
            const bool last = (t == nt - 2);
            const char* a1 = cA + (size_t)(t + 1) * kstep;
            const char* a2 = last ? nA : cA + (size_t)(t + 2) * kstep; const char* b2 = last ? nB : cB + (size_t)(t + 2) * kstep;
            const char* a3 = a2 + kstep; const char* b3 = b2 + kstep;
            if (last && has_next) S.a_ready(nxt);
            if constexpr (SP2) {
            PG8_LDB(B0, 0, 0); PG8_LDB(B1, 0, 1); PG8_SCHED; PG8_LDA(At, 0, 0); PG8_STAGE(PG8_SA(1, 1), a1 + hstep, voffA);
            PG8_WAIT_V(8); PG8_WAIT_L(0); PG8_BAR; PG8_MMA(0, 0, At, B0); PG8_MMA(0, 1, At, B1); PG8_BAR; PG8_SCHED;
            PG8_LDA(At, 0, 1); PG8_STAGE(PG8_SB(0, 0), b2, voffB); PG8_STAGE(PG8_SB(0, 1), b2 + hstep, voffB); PG8_STAGE(PG8_SA(0, 0), a2, voffA);
            PG8_WAIT_V(8); PG8_WAIT_L(0); PG8_BAR; PG8_MMA(1, 0, At, B0); PG8_MMA(1, 1, At, B1); PG8_BAR; PG8_SCHED;
            PG8_LDB(B0, 1, 0); PG8_LDB(B1, 1, 1); PG8_SCHED; PG8_LDA(At, 1, 0); PG8_STAGE(PG8_SA(0, 1), a2 + hstep, voffA);
            PG8_WAIT_V(8); PG8_WAIT_L(0); PG8_BAR; PG8_MMA(0, 0, At, B0); PG8_MMA(0, 1, At, B1); PG8_BAR; PG8_SCHED;
            PG8_LDA(At, 1, 1); PG8_STAGE(PG8_SB(1, 0), b3, voffB); PG8_STAGE(PG8_SB(1, 1), b3 + hstep, voffB); PG8_STAGE(PG8_SA(1, 0), a3, voffA);
            PG8_WAIT_V(8); PG8_WAIT_L(0); PG8_BAR; PG8_MMA(1, 0, At, B0); PG8_MMA(1, 1, At, B1); PG8_BAR; PG8_SCHED;
            } else {
            PG8_LDB(B0, 0, 0); PG8_SCHED; PG8_LDA(At, 0, 0); PG8_STAGE(PG8_SA(1, 1), a1 + hstep, voffA);
            PG8_WAIT_L(8); PG8_BAR; PG8_WAIT_L(0); PG8_MMA(0, 0, At, B0); PG8_BAR; PG8_SCHED;
            PG8_LDB(B1, 0, 1); PG8_STAGE(PG8_SB(0, 0), b2, voffB);
            PG8_BAR; PG8_WAIT_L(0); PG8_MMA(0, 1, At, B1); PG8_BAR;
            PG8_LDA(At, 0, 1); PG8_STAGE(PG8_SA(0, 0), a2, voffA);
            PG8_BAR; PG8_WAIT_L(0); PG8_MMA(1, 0, At, B0); PG8_BAR; PG8_SCHED;
            PG8_STAGE(PG8_SB(0, 1), b2 + hstep, voffB);
            PG8_WAIT_V(6); PG8_BAR; PG8_MMA(1, 1, At, B1); PG8_BAR;
            PG8_LDB(B0, 1, 0); PG8_SCHED; PG8_LDA(At, 1, 0); PG8_STAGE(PG8_SA(0, 1), a2 + hstep, voffA);
            PG8_WAIT_L(8); PG8_BAR; PG8_WAIT_L(0); PG8_MMA(0, 0, At, B0); PG8_BAR; PG8_SCHED;
            PG8_LDB(B1, 1, 1); PG8_STAGE(PG8_SB(1, 0), b3, voffB);
            PG8_BAR; PG8_WAIT_L(0); PG8_MMA(0, 1, At, B1); PG8_BAR;
            PG8_LDA(At, 1, 1); PG8_STAGE(PG8_SA(1, 0), a3, voffA);
            PG8_BAR; PG8_WAIT_L(0); PG8_MMA(1, 0, At, B0); PG8_BAR; PG8_SCHED;
            PG8_STAGE(PG8_SB(1, 1), b3 + hstep, voffB);
            PG8_WAIT_V(6); PG8_BAR; PG8_MMA(1, 1, At, B1); PG8_BAR;
            }
        }
        if constexpr (ALIGN_EPI) { if (wr == 0) PG8_BAR; }
        if constexpr (!Epi::AFTER_DRAIN) { E(acc, cur, wr, wc, fr, fq); S.done(cur); }
        if (!has_next) break;
        if (!(Epi::KEEP_ACC && cur.z == 0)) {
#pragma unroll
        for (int a = 0; a < 2; ++a)
#pragma unroll
            for (int b = 0; b < 2; ++b)
#pragma unroll
                for (int m = 0; m < 4; ++m)
#pragma unroll
                    for (int n = 0; n < 2; ++n) acc[a][b][m][n] = (f32x4){0.f, 0.f, 0.f, 0.f};
        }
        cur = nxt; cA = nA; cB = nB; ++ui;
        if constexpr (ALIGN_EPI) { if (wr == 1) PG8_BAR; }
    }
    PG8_WAIT_V(0);
    if constexpr (!ALIGN_EPI) { if (wr == 0) PG8_BAR; }
    PG8_BAR;
    if constexpr (Epi::AFTER_DRAIN) { E.fused(acc, cur, wr, wc, fr, fq, lds, wid, lane); S.done(cur); }
#undef PG8_SA
#undef PG8_SB
#undef PG8_STAGE
#undef PG8_LDA
#undef PG8_LDB
#undef PG8_MMA
#undef PG8_WAIT_V
#undef PG8_WAIT_L
#undef PG8_BAR
#undef PG8_SCHED
}
}

constexpr size_t MiB = 1u << 20;
constexpr size_t WS_CTL = 0, CTL_ZERO_BYTES = 1 * MiB;
constexpr size_t WS_WIN = 2 * MiB, WS_WPA = 13 * MiB, WS_WPB = 14 * MiB, WS_WOUT = 15 * MiB, WS_WGU = 17 * MiB, WS_WDN = 28 * MiB;
constexpr size_t WS_LORA = 28 * MiB + (size_t)DM * FF * 2;
static_assert(WS_LORA + 262144 <= 34 * MiB, "lora map");
constexpr size_t WS_XB = 34 * MiB, WS_RS0 = 67 * MiB, WS_QB = 68 * MiB, WS_KB = 85 * MiB, WS_VB = 102 * MiB, WS_PC = 119 * MiB, WS_GT = 176 * MiB;
constexpr size_t WS_ON = 241 * MiB, WS_RW = 258 * MiB, WS_MG = 275 * MiB, WS_TMP = 308 * MiB, WS_X1B = 373 * MiB, WS_HB = 406 * MiB;
constexpr size_t WS_RK = 496 * MiB, RK_STRIDE = 33 * MiB;
constexpr size_t WS_BON = 728 * MiB, WS_DP = 729 * MiB;
constexpr size_t WS_BON3 = 736 * MiB, WS_Y0 = 740 * MiB, WS_CC = 773 * MiB, WS_PSI = 806 * MiB, WS_PHI = 810 * MiB, WS_SST = 814 * MiB, WS_DP2 = 818 * MiB;
constexpr size_t WS_SC = 830 * MiB, WS_RH = 912 * MiB, WS_GP = 928 * MiB, WS_XC = 944 * MiB, WS_YL = 960 * MiB, WS_SL = 992 * MiB, WS_GC = 1024 * MiB, WS_HT = 1025 * MiB, WS_END = 1026 * MiB;
static_assert(WS_WIN + (size_t)INW * DM * 2 <= WS_WPA && WS_WGU + (size_t)NGU * DM * 2 <= WS_WDN && WS_WDN + (size_t)DM * FF * 2 <= WS_XB, "weights map");
static_assert(WS_XB + (size_t)MTOT * DM * 2 <= WS_RS0 && WS_QB + (size_t)MTOT * 512 * 2 <= WS_KB && WS_PC + (size_t)MTOT * RSW * 2 <= WS_GT && WS_GT + (size_t)MTOT * 2048 * 2 <= WS_ON, "act map 1");
static_assert(WS_MG + (size_t)MTOT * DM * 2 <= WS_TMP && WS_TMP + (size_t)MTOT * DM * 4 <= WS_X1B && WS_X1B + (size_t)MTOT * DM * 2 <= WS_HB && WS_HB + (size_t)MTOT * FF * 2 <= WS_RK, "act map 2");
static_assert((size_t)MTOT * 512 * 4 <= RK_STRIDE && WS_RK + 7 * RK_STRIDE <= WS_BON, "rwkv map");
constexpr int CW_TMO = 0, CW_CODE = 1;
constexpr int CW_BAR = 4096;
constexpr int CW_SSQ = 32768;
constexpr int CW_QUEUE = 2048;
constexpr int CW_QDEC = 2112;
constexpr int CW_DCNT = 65536;
static_assert((CW_DCNT + 128 * 64) * 4 <= (int)CTL_ZERO_BYTES, "CTL map");

constexpr int RING_OFF = 0, RING_BYTES = 139264;
constexpr int LDSCTL_OFF = RING_BYTES, MISC_OFF = LDSCTL_OFF + 320;
constexpr int LDS_BYTES = 155648;
constexpr int NWAVES = 8;

#define GAS __attribute__((address_space(1)))
#define LAS __attribute__((address_space(3)))
typedef unsigned short bf16;
typedef unsigned v4u __attribute__((ext_vector_type(4)));
typedef unsigned v2u __attribute__((ext_vector_type(2)));
typedef float f32x4 __attribute__((ext_vector_type(4)));
typedef float f32x2 __attribute__((ext_vector_type(2)));
typedef float f32x16 __attribute__((ext_vector_type(16)));
typedef short bf16x8 __attribute__((ext_vector_type(8)));
typedef short s16x4 __attribute__((ext_vector_type(4)));
typedef GAS unsigned gu32;
#define RLX_AGENT __ATOMIC_RELAXED, __HIP_MEMORY_SCOPE_AGENT
#define LDS_WAIT() asm volatile("s_waitcnt lgkmcnt(0)" ::: "memory")
#define VM_WAIT() asm volatile("s_waitcnt vmcnt(0)" ::: "memory")
__device__ __forceinline__ unsigned pk2(float lo, float hi) { return pg8::cvt_pk_bf16(lo, hi); }
using pg8::sigmoidf_;
__device__ __forceinline__ float bf2f(unsigned short b) { return __builtin_bit_cast(float, (unsigned)b << 16); }
__device__ __forceinline__ float bflo(unsigned w) { return __builtin_bit_cast(float, w << 16); }
__device__ __forceinline__ float bfhi(unsigned w) { return __builtin_bit_cast(float, w & 0xffff0000u); }

#define XB_TMO      128
#define XB_XCNT(j)  (256  + 64 * (j))
#define XB_XSUB(j)  (1280 + 64 * (j))
#define XB_XGEN(j)  (2304 + 64 * (j))
#define XB_TOP      3328
#define XB_TOPGEN   3392
#define XCD_BAR_WORDS 3456
#define XB_SPIN_CAP (1u << 18)

__device__ __forceinline__ unsigned xb_ld(unsigned* p)              { return __hip_atomic_load(p, __ATOMIC_RELAXED, __HIP_MEMORY_SCOPE_AGENT); }
__device__ __forceinline__ unsigned xb_add(unsigned* p, unsigned v) { return __hip_atomic_fetch_add(p, v, __ATOMIC_RELAXED, __HIP_MEMORY_SCOPE_AGENT); }
__device__ __forceinline__ unsigned xb_xcc_id() { return (unsigned)__builtin_amdgcn_s_getreg((3 << 11) | 20) & 0xFu; }
#define XB_SPIN(cond, bar) do { unsigned _sp = 0; while (cond) { __builtin_amdgcn_s_sleep(1); \
    if ((++_sp & 255u) == 0u) { if (xb_ld(&(bar)[XB_TMO])) break; if (_sp > XB_SPIN_CAP) { atomicAdd(&(bar)[XB_TMO], 1u); break; } } } } while (0)

struct XcdBarrier {
    unsigned* bar; unsigned x;
    volatile LAS unsigned* st;
};

__device__ __forceinline__ XcdBarrier xcd_barrier_post(unsigned* bar, volatile LAS unsigned* st) {
    XcdBarrier b; b.bar = bar; b.x = xb_xcc_id(); b.st = st;
    if (threadIdx.x == 0) (void)xb_add(&bar[XB_XCNT(b.x)], 1u);
    return b;
}
__device__ __forceinline__ void xcd_barrier_complete(unsigned* bar, unsigned x, unsigned& nloc, unsigned& nx) {
    const unsigned G = gridDim.x * gridDim.y * gridDim.z;
    unsigned sum, cnt, mine, sp = 0u;
    for (;;) {
        sum = 0u; cnt = 0u; mine = 0u;
#pragma unroll
        for (unsigned j = 0; j < 16; ++j) { const unsigned c = xb_ld(&bar[XB_XCNT(j)]); sum += c; cnt += (c > 0u) ? 1u : 0u; mine = (j == x) ? c : mine; }
        if (sum == G) break;
        __builtin_amdgcn_s_sleep(1);
        if ((++sp & 255u) == 0u) { if (xb_ld(&bar[XB_TMO])) break; if (sp > XB_SPIN_CAP) { atomicAdd(&bar[XB_TMO], 1u); break; } }
    }
    nloc = mine > 0u ? mine : 1u; nx = cnt > 0u ? cnt : 1u;
}

__device__ __forceinline__ void xcd_barrier(const XcdBarrier& b) {
    asm volatile("s_waitcnt vmcnt(0)" ::: "memory");
    __syncthreads();
    if (threadIdx.x == 0) {
        unsigned* bar = b.bar;
        __builtin_amdgcn_s_waitcnt(0);
        unsigned nloc = b.st[0], nx = b.st[1];
        if (nloc == 0u) { xcd_barrier_complete(bar, b.x, nloc, nx); b.st[0] = nloc; b.st[1] = nx; }
        const unsigned old = xb_add(&bar[XB_XSUB(b.x)], 1u);
        const unsigned gen = old / nloc;
        if (old + 1u == (gen + 1u) * nloc) {
            __builtin_amdgcn_fence(__ATOMIC_RELEASE, "agent");
            asm volatile("s_waitcnt vmcnt(0)" ::: "memory");
            const unsigned og = xb_add(&bar[XB_TOP], 1u);
            const unsigned tg = og / nx;
            if (og + 1u == (tg + 1u) * nx) xb_add(&bar[XB_TOPGEN], 1u);
            else XB_SPIN(xb_ld(&bar[XB_TOPGEN]) == tg, bar);
            __builtin_amdgcn_fence(__ATOMIC_ACQUIRE, "agent");
            xb_add(&bar[XB_XGEN(b.x)], 1u);
            asm volatile("s_waitcnt vmcnt(0)" ::: "memory");
        } else {
            XB_SPIN(xb_ld(&bar[XB_XGEN(b.x)]) == gen, bar);
            __builtin_amdgcn_fence(__ATOMIC_ACQUIRE, "agent");
            asm volatile("s_waitcnt vmcnt(0)" ::: "memory");
        }
    }
    __syncthreads();
}

struct Args { const float* in[34]; float* out; unsigned char* ws; int ph_lo, ph_hi, li, pad; };
struct Frame {
    LAS unsigned char* lds;
    volatile LAS unsigned* MISC;
    gu32* ctl;
    int tid, lane, wave, vcu, G;
    unsigned char* ws; float* out;
#ifdef MK_SUB
    unsigned long long pa, pb;
#endif
};
#ifdef MK_SUB
#define SUBM(k) do { if (MK_SUB == (k)) F.pa = __builtin_amdgcn_s_memrealtime(); if (MK_SUB + 1 == (k)) F.pb = __builtin_amdgcn_s_memrealtime(); } while (0)
#else
#define SUBM(k) do { } while (0)
#endif
enum { I_XP = 0, I_XS, I_CK, I_CV, I_PT, I_SWKV, I_SSH, I_NMIX, I_WIN, I_QG, I_KG, I_LQ1, I_LK1, I_LQ2, I_LK2, I_AOG, I_WPA, I_MU, I_W0, I_W2, I_A0, I_A2, I_G2,
       I_KK, I_KA, I_RK, I_GNW, I_GNB, I_WPB, I_WOUT, I_NFFN, I_WG, I_WU, I_WD };

__device__ __forceinline__ float wave_sum(float v) {
#pragma unroll
    for (int o = 1; o < 64; o <<= 1) v += __shfl_xor(v, o);
    return v;
}

__device__ __forceinline__ float dpp_rmir(float v) { return __builtin_bit_cast(float, __builtin_amdgcn_update_dpp(0, __builtin_bit_cast(int, v), 0x140, 0xF, 0xF, true)); }
__device__ __forceinline__ float sum32(float v) {
    v += __builtin_bit_cast(float, __builtin_amdgcn_update_dpp(0, __builtin_bit_cast(int, v), 0xB1, 0xF, 0xF, true));
    v += __builtin_bit_cast(float, __builtin_amdgcn_update_dpp(0, __builtin_bit_cast(int, v), 0x4E, 0xF, 0xF, true));
    v += __builtin_bit_cast(float, __builtin_amdgcn_update_dpp(0, __builtin_bit_cast(int, v), 0x141, 0xF, 0xF, true));
    v += dpp_rmir(v);
    v += __shfl_xor(v, 16);
    return v;
}
__device__ __forceinline__ void p0_transpose_item(const float* W, int K, int N, bf16* WT, int drow0, const float* kgain, LAS float* scr, int k0, int n0, int lane) {
    float v[32];
    const float* wp = W + (size_t)(k0 + (lane >> 5)) * N + n0 + (lane & 31);
#pragma unroll
    for (int i = 0; i < 32; ++i) v[i] = wp[(size_t)(2 * i) * N];
    const int c = lane & 7;
    f32x4 g0 = {1.f, 1.f, 1.f, 1.f}, g1 = g0;
    if (kgain) { g0 = *(const f32x4*)(kgain + k0 + 8 * c); g1 = *(const f32x4*)(kgain + k0 + 8 * c + 4); }
#pragma unroll
    for (int i = 0; i < 32; ++i) scr[(2 * i + (lane >> 5)) * 33 + (lane & 31)] = v[i];
    LDS_WAIT(); asm volatile("" ::: "memory");
#pragma unroll
    for (int j = 0; j < 4; ++j) { const int n = (lane >> 3) + 8 * j; const LAS float* s = scr + (8 * c) * 33 + n;
        v4u o; o.x = pk2(s[0 * 33] * g0[0], s[1 * 33] * g0[1]); o.y = pk2(s[2 * 33] * g0[2], s[3 * 33] * g0[3]); o.z = pk2(s[4 * 33] * g1[0], s[5 * 33] * g1[1]); o.w = pk2(s[6 * 33] * g1[2], s[7 * 33] * g1[3]);
        *(GAS v4u*)(WT + (size_t)(drow0 + n) * K + k0 + 8 * c) = o; }
    LDS_WAIT(); asm volatile("" ::: "memory");
}
template <int PART> __device__ __forceinline__ void p0_prologue(Frame& F, const Args& A, int gw, int NGW) {
    LAS float* scr = (LAS float*)(F.lds + RING_OFF + F.wave * 16384);
    bf16* Win_t = (bf16*)(F.ws + WS_WIN); bf16* Wpa_t = (bf16*)(F.ws + WS_WPA); bf16* Wpb_t = (bf16*)(F.ws + WS_WPB); bf16* Wout_t = (bf16*)(F.ws + WS_WOUT);
    bf16* Wgu_t = (bf16*)(F.ws + WS_WGU); bf16* Wdn_t = (bf16*)(F.ws + WS_WDN);
    constexpr int I_IN = (DM / 64) * (INW / 32), I_PA = (512 / 64) * (DM / 32), I_OUT = (DM / 64) * (DM / 32), I_G = (DM / 64) * (FF / 32), I_D = (FF / 64) * (DM / 32);
    constexpr int I_L = 16, NITEMS = I_IN + 2 * I_PA + I_OUT + 2 * I_G + I_D + 4 * I_L;
    constexpr int NP0 = I_IN + 4 * I_L, NP1 = NITEMS - NP0;
    for (int ix = gw; ix < (PART == 0 ? NP0 : NP1); ix += NGW) {
        int r = PART == 0 ? (ix < I_IN ? ix : ix - I_IN + (NITEMS - 4 * I_L)) : ix + I_IN;
        if (r < I_IN) { constexpr int nnb = INW / 32; const int kb = r / nnb, nb = r % nnb, pn = nb >> 3, q = nb & 7;
            p0_transpose_item(A.in[I_WIN], DM, INW, Win_t, 256 * pn + 32 * (4 * (q & 1) + (q >> 1)), A.in[I_NMIX], scr, 64 * kb, 32 * nb, F.lane); continue; } r -= I_IN;
        if (r < I_PA) { constexpr int nnb = DM / 32; const int kb = r / nnb, nb = r % nnb; p0_transpose_item(A.in[I_WPA], 512, DM, Wpa_t, 32 * nb, nullptr, scr, 64 * kb, 32 * nb, F.lane); continue; } r -= I_PA;
        if (r < I_PA) { constexpr int nnb = DM / 32; const int kb = r / nnb, nb = r % nnb; p0_transpose_item(A.in[I_WPB], 512, DM, Wpb_t, 32 * nb, nullptr, scr, 64 * kb, 32 * nb, F.lane); continue; } r -= I_PA;
        if (r < I_OUT) { constexpr int nnb = DM / 32; const int kb = r / nnb, nb = r % nnb; p0_transpose_item(A.in[I_WOUT], DM, DM, Wout_t, 32 * nb, nullptr, scr, 64 * kb, 32 * nb, F.lane); continue; } r -= I_OUT;
        if (r < I_G) { constexpr int nnb = FF / 32; const int kb = r / nnb, nb = r % nnb;
            p0_transpose_item(A.in[I_WG], DM, FF, Wgu_t, 256 * (nb >> 2) + 32 * (nb & 3), A.in[I_NFFN], scr, 64 * kb, 32 * nb, F.lane); continue; } r -= I_G;
        if (r < I_G) { constexpr int nnb = FF / 32; const int kb = r / nnb, nb = r % nnb;
            p0_transpose_item(A.in[I_WU], DM, FF, Wgu_t, 256 * (nb >> 2) + 128 + 32 * (nb & 3), A.in[I_NFFN], scr, 64 * kb, 32 * nb, F.lane); continue; } r -= I_G;
        if (r < I_D) { constexpr int nnb = DM / 32; const int kb = r / nnb, nb = r % nnb; p0_transpose_item(A.in[I_WD], FF, DM, Wdn_t, 32 * nb, nullptr, scr, 64 * kb, 32 * nb, F.lane); continue; } r -= I_D;
        { bf16* W2T = (bf16*)(F.ws + WS_LORA); bf16* A2T = W2T + 512 * 64; bf16* G2T = A2T + 512 * 64;
          if (r < I_L) p0_transpose_item(A.in[I_W2], 64, 512, W2T, 32 * r, nullptr, scr, 0, 32 * r, F.lane);
          else if (r < 2 * I_L) p0_transpose_item(A.in[I_A2], 64, 512, A2T, 32 * (r - I_L), nullptr, scr, 0, 32 * (r - I_L), F.lane);
          else { const int q = r - 2 * I_L; p0_transpose_item(A.in[I_G2], 128, 512, G2T, 32 * (q & 15), nullptr, scr, 64 * (q >> 4), 32 * (q & 15), F.lane); } }
    }
    if (PART != 0) return;
    bf16* XB = (bf16*)(F.ws + WS_XB); float* rs0 = (float*)(F.ws + WS_RS0);
    for (int m0 = gw; m0 < MTOT; m0 += 4 * NGW) {
        f32x4 v[4][4];
#pragma unroll
        for (int q = 0; q < 4; ++q) { const int m = m0 + q * NGW;
            if (m < MVALID) { const float* xrow = m < MP ? A.in[I_XP] + (size_t)m * DM : A.in[I_XS] + (size_t)(m - MP) * DM; const GAS f32x4* xr = (const GAS f32x4*)xrow + F.lane;
#pragma unroll
                for (int j = 0; j < 4; ++j) v[q][j] = xr[64 * j]; }
            else {
#pragma unroll
                for (int j = 0; j < 4; ++j) v[q][j] = (f32x4){0.f, 0.f, 0.f, 0.f}; } }
#pragma unroll
        for (int q = 0; q < 4; ++q) { const int m = m0 + q * NGW; if (m >= MTOT) continue;
            GAS unsigned long long* o8 = (GAS unsigned long long*)(XB + (size_t)m * DM) + F.lane; float s = 0.f;
#pragma unroll
            for (int j = 0; j < 4; ++j) { s += (v[q][j].x * v[q][j].x + v[q][j].y * v[q][j].y) + (v[q][j].z * v[q][j].z + v[q][j].w * v[q][j].w);
                o8[64 * j] = (unsigned long long)pk2(v[q][j].x, v[q][j].y) | ((unsigned long long)pk2(v[q][j].z, v[q][j].w) << 32); }
            s = sum32(s); { const auto rr = __builtin_amdgcn_permlane32_swap(__float_as_uint(s), __float_as_uint(s), false, false); s = __uint_as_float(rr[0]) + __uint_as_float(rr[1]); }
            if (F.lane == 0) rs0[m] = m < MVALID ? rsqrtf(s * (1.f / DM) + 1e-6f) : 0.f; }
    }
}

__device__ __forceinline__ int crow16(int r, int hi) { return (r & 3) + 8 * (r >> 2) + 4 * hi; }
__device__ __forceinline__ float lam_value(const Frame& F, const Args& A) {
    const int l = F.lane;
    const float a = wave_sum(A.in[I_LQ1][l] * A.in[I_LK1][l]), b = wave_sum(A.in[I_LQ2][l] * A.in[I_LK2][l]);
    return __expf(a) - __expf(b) + 0.2f;
}
__device__ __forceinline__ f32x4 ld_bf4(const bf16* p) { const v2u w = *(const v2u*)p; return (f32x4){bflo(w.x), bfhi(w.x), bflo(w.y), bfhi(w.y)}; }
__device__ __forceinline__ unsigned* rk_pair(const Frame& F, int i) { return (unsigned*)(F.ws + WS_RK + (size_t)i * RK_STRIDE); }
__device__ __forceinline__ bf16* rk_bf(const Frame& F, int i) { return (bf16*)(F.ws + WS_RK + (size_t)i * RK_STRIDE); }
__device__ __forceinline__ float* rk_arr(const Frame& F, int i) { return (float*)(F.ws + WS_RK + (size_t)i * RK_STRIDE); }

#define CRC(r) (((r) & 3) + 8 * ((r) >> 2))
constexpr int LIN_LD = 264, MS_LD = 1544;
__device__ __forceinline__ float tanh_fast(float x) { return 1.f - 2.f * __builtin_amdgcn_rcpf(1.f + __expf(2.f * x)); }
__device__ __forceinline__ void rwkv_prep_unit(Frame& F, const Args& A, int unit) {
    LAS bf16* msl = (LAS bf16*)(F.lds + RING_OFF);
    LAS bf16* lin = msl + 32 * MS_LD;
    const bf16* PC = (const bf16*)(F.ws + WS_PC);
    int r32_ = F.lane & 31, hi_ = F.lane >> 5; asm volatile("" : "+v"(r32_), "+v"(hi_));
    const int r0 = unit * 32, tid = F.tid, lane = F.lane, w = F.wave, r32 = r32_, hi = hi_;
    const float* mu = A.in[I_MU]; const float* ssh = A.in[I_SSH];
#pragma unroll 7
    for (int k = 0; k < 14; ++k) {
        const int p = tid + 512 * k, t = p / 224, c8 = p - 224 * t, row = r0 + t;
        const v4u cw = *(const v4u*)(PC + (size_t)row * RSW + 8 * c8);
        float cur[8] = {bflo(cw.x), bfhi(cw.x), bflo(cw.y), bfhi(cw.y), bflo(cw.z), bfhi(cw.z), bflo(cw.w), bfhi(cw.w)}, prv[8];
        if (row >= MP) { const f32x4 a = *(const f32x4*)(ssh + (size_t)(row - MP) * RSW + 8 * c8), b = *(const f32x4*)(ssh + (size_t)(row - MP) * RSW + 8 * c8 + 4);
#pragma unroll
            for (int j = 0; j < 4; ++j) { prv[j] = a[j]; prv[4 + j] = b[j]; } }
        else if ((row & (SEQ - 1)) == 0) {
#pragma unroll
            for (int j = 0; j < 8; ++j) prv[j] = 0.f; }
        else { const v4u pw = *(const v4u*)(PC + (size_t)(row - 1) * RSW + 8 * c8);
            prv[0] = bflo(pw.x); prv[1] = bfhi(pw.x); prv[2] = bflo(pw.y); prv[3] = bfhi(pw.y); prv[4] = bflo(pw.z); prv[5] = bfhi(pw.z); prv[6] = bflo(pw.w); prv[7] = bfhi(pw.w); }
        const f32x4 m0 = *(const f32x4*)(mu + 8 * c8), m1 = *(const f32x4*)(mu + 8 * c8 + 4);
        float m[8];
#pragma unroll
        for (int j = 0; j < 4; ++j) { m[j] = cur[j] + (prv[j] - cur[j]) * m0[j]; m[4 + j] = cur[4 + j] + (prv[4 + j] - cur[4 + j]) * m1[j]; }
        if (c8 >= 192) { const int ci = 8 * (c8 - 192);
#pragma unroll
            for (int j = 0; j < 8; ++j) { if (ci < 64) m[j] = tanh_fast(m[j]); else if (ci >= 128) m[j] = sigmoidf_(m[j]); }
            *(LAS v4u*)(lin + t * LIN_LD + ci) = (v4u){pk2(m[0], m[1]), pk2(m[2], m[3]), pk2(m[4], m[5]), pk2(m[6], m[7])}; }
        else *(LAS v4u*)(msl + t * MS_LD + 8 * c8) = (v4u){pk2(m[0], m[1]), pk2(m[2], m[3]), pk2(m[4], m[5]), pk2(m[6], m[7])};
    }
    __syncthreads();
    f32x16 wl[2], al[2], gg[2];
    const bf16* W2T = (const bf16*)(F.ws + WS_LORA); const bf16* A2T = W2T + 512 * 64; const bf16* G2T = A2T + 512 * 64;
#pragma unroll
    for (int ct = 0; ct < 2; ++ct) {
        const int ch = 64 * w + 2 * r32 + ct;
        f32x16 a0 = (f32x16){}, a1 = (f32x16){}, a2 = (f32x16){};
#pragma unroll
        for (int ks = 0; ks < 4; ++ks) {
            const bf16x8 x0 = *(const LAS bf16x8*)(lin + r32 * LIN_LD + 16 * ks + 8 * hi), x1 = *(const LAS bf16x8*)(lin + r32 * LIN_LD + 64 + 16 * ks + 8 * hi);
            const bf16x8 b0 = *(const bf16x8*)(W2T + (size_t)ch * 64 + 16 * ks + 8 * hi), b1 = *(const bf16x8*)(A2T + (size_t)ch * 64 + 16 * ks + 8 * hi);
            a0 = __builtin_amdgcn_mfma_f32_32x32x16_bf16(x0, b0, a0, 0, 0, 0); a1 = __builtin_amdgcn_mfma_f32_32x32x16_bf16(x1, b1, a1, 0, 0, 0);
        }
#pragma unroll
        for (int ks = 0; ks < 8; ++ks) {
            const bf16x8 x2 = *(const LAS bf16x8*)(lin + r32 * LIN_LD + 128 + 16 * ks + 8 * hi);
            const bf16x8 b2 = *(const bf16x8*)(G2T + (size_t)ch * 128 + 16 * ks + 8 * hi);
            a2 = __builtin_amdgcn_mfma_f32_32x32x16_bf16(x2, b2, a2, 0, 0, 0);
        }
        wl[ct] = a0; al[ct] = a1; gg[ct] = a2;
    }
    bf16* aR = rk_bf(F, 0); float* aW = rk_arr(F, 1); bf16* aK = rk_bf(F, 2); bf16* aV = rk_bf(F, 3); bf16* aA = rk_bf(F, 4); bf16* aB = rk_bf(F, 5); bf16* aG = rk_bf(F, 6);
    float* BON = (float*)(F.ws + WS_BON3);
    float w0c[2], a0c[2], kkc[2], kac[2], rkc[2];
#pragma unroll
    for (int ct = 0; ct < 2; ++ct) { const int ch = 64 * w + 2 * r32 + ct; w0c[ct] = A.in[I_W0][ch]; a0c[ct] = A.in[I_A0][ch]; kkc[ct] = A.in[I_KK][ch]; kac[ct] = A.in[I_KA][ch]; rkc[ct] = A.in[I_RK][ch]; }
    if (unit < MP / 32) {
        float lwv[2][16], pin[2][16], off[2];
        int r32o = r32; asm volatile("" : "+v"(r32o));
#pragma unroll
        for (int ct = 0; ct < 2; ++ct)
#pragma unroll
            for (int r = 0; r < 16; ++r) { const float x = -(w0c[ct] + wl[ct][r]), sp = fmaxf(x, 0.f) + __logf(1.f + __expf(-fabsf(x))); lwv[ct][r] = -__expf(-sp - 0.5f); }
#pragma unroll
        for (int ct = 0; ct < 2; ++ct) { float run = 0.f;
#pragma unroll
            for (int q = 0; q < 4; ++q) { const float c0 = lwv[ct][4 * q], c1 = c0 + lwv[ct][4 * q + 1], c2 = c1 + lwv[ct][4 * q + 2], c3 = c2 + lwv[ct][4 * q + 3];
                const float oth = __shfl_xor(c3, 32), base = run + (hi ? oth : 0.f);
                pin[ct][4 * q] = base + c0; pin[ct][4 * q + 1] = base + c1; pin[ct][4 * q + 2] = base + c2; pin[ct][4 * q + 3] = base + c3; run += c3 + oth; }
            off[ct] = (unit & 1) ? 0.f : run;
            if (hi == 0) ((float*)(F.ws + WS_HT))[(size_t)unit * 512 + 64 * w + 2 * r32o + ct] = __expf(run); }
        bf16* scb = (bf16*)(F.ws + WS_SC) + ((size_t)(((unit >> 7) * 8 + w) * 64 + ((unit >> 1) & 63)) * 5 * 64 + 32 * (unit & 1) + 4 * hi) * 64 + 2 * r32o;
#pragma unroll
        for (int r = 0; r < 16; ++r) {
            const int t = crow16(r, hi), row = r0 + t;
            float rr[2], kv[2], vv[2], kkv[2], av[2], wv[2];
            float ss = 0.f;
#pragma unroll
            for (int ct = 0; ct < 2; ++ct) { const int ch = 64 * w + 2 * r32 + ct;
                rr[ct] = bf2f(msl[t * MS_LD + ch]); kv[ct] = bf2f(msl[t * MS_LD + 512 + ch]); vv[ct] = bf2f(msl[t * MS_LD + 1024 + ch]);
                wv[ct] = __expf(lwv[ct][r]);
                av[ct] = sigmoidf_(a0c[ct] + al[ct][r]);
                kkv[ct] = kv[ct] * kkc[ct]; ss += kkv[ct] * kkv[ct];
            }
            ss = sum32(ss);
            const float rn = rsqrtf(fmaxf(ss, 1e-24f));
            float bon = 0.f, br = 0.f, kr = 0.f, kk[2], kp[2];
#pragma unroll
            for (int ct = 0; ct < 2; ++ct) { kk[ct] = kkv[ct] * rn; kp[ct] = kv[ct] * (1.f + (av[ct] - 1.f) * kac[ct]);
                bon += rr[ct] * kp[ct] * rkc[ct]; br += kk[ct] * av[ct] * rr[ct]; kr += kp[ct] * rr[ct]; }
            bon = sum32(bon); br = sum32(br); kr = sum32(kr);
            { float Fm[2], Fi[2];
#pragma unroll
              for (int ct = 0; ct < 2; ++ct) { Fm[ct] = __expf(pin[ct][r] - lwv[ct][r] - off[ct]); Fi[ct] = __expf(off[ct] - pin[ct][r]); }
              unsigned* sp_ = (unsigned*)(scb + CRC(r) * 64);
              sp_[0 * 2048] = pk2(-kk[0] * Fm[0], -kk[1] * Fm[1]);
              sp_[1 * 2048] = pk2(kk[0] * av[0] * Fi[0], kk[1] * av[1] * Fi[1]);
              sp_[2 * 2048] = pk2(kp[0] * Fi[0], kp[1] * Fi[1]);
              sp_[3 * 2048] = pk2(wv[0] * rr[0] * Fm[0], wv[1] * rr[1] * Fm[1]);
              sp_[4 * 2048] = pk2(vv[0], vv[1]);
              *(v2u*)(rk_pair(F, 2) + (size_t)row * 512 + 64 * w + 2 * r32o) = (v2u){pk2(vv[0], gg[0][r]), pk2(vv[1], gg[1][r])}; }
            if (r32 == 0) *(f32x4*)(BON + (size_t)(row * 8 + w) * 4) = (f32x4){bon, br, kr, 0.f};
        }
    } else {
#pragma unroll 4
    for (int r = 0; r < 16; ++r) {
        const int t = crow16(r, hi), row = r0 + t;
        float rr[2], kv[2], vv[2], kkv[2], av[2], wv[2];
        float ss = 0.f;
#pragma unroll
        for (int ct = 0; ct < 2; ++ct) { const int ch = 64 * w + 2 * r32 + ct;
            rr[ct] = bf2f(msl[t * MS_LD + ch]); kv[ct] = bf2f(msl[t * MS_LD + 512 + ch]); vv[ct] = bf2f(msl[t * MS_LD + 1024 + ch]);
            const float x = -(w0c[ct] + wl[ct][r]), sp = fmaxf(x, 0.f) + __logf(1.f + __expf(-fabsf(x)));
            const float e = __expf(-sp - 0.5f); wv[ct] = __expf(-e);
            av[ct] = sigmoidf_(a0c[ct] + al[ct][r]);
            kkv[ct] = kv[ct] * kkc[ct]; ss += kkv[ct] * kkv[ct];
        }
        ss = sum32(ss);
        const float rn = rsqrtf(fmaxf(ss, 1e-24f));
        float bon = 0.f, br = 0.f, kr = 0.f, kk[2], kp[2];
#pragma unroll
        for (int ct = 0; ct < 2; ++ct) { kk[ct] = kkv[ct] * rn; kp[ct] = kv[ct] * (1.f + (av[ct] - 1.f) * kac[ct]);
            bon += rr[ct] * kp[ct] * rkc[ct]; br += kk[ct] * av[ct] * rr[ct]; kr += kp[ct] * rr[ct]; }
        bon = sum32(bon); br = sum32(br); kr = sum32(kr);
#pragma unroll
        for (int ct = 0; ct < 2; ++ct) { const size_t o = (size_t)row * 512 + 64 * w + 2 * r32 + ct;
            aW[o] = wv[ct]; rk_pair(F, 0)[o] = pk2(wv[ct] * rr[ct], kp[ct]); rk_pair(F, 2)[o] = pk2(vv[ct], gg[ct][r]); rk_pair(F, 4)[o] = pk2(-kk[ct], kk[ct] * av[ct]); }
        if (r32 == 0) *(f32x4*)(BON + (size_t)(row * 8 + w) * 4) = (f32x4){bon, br, kr, 0.f};
    }
    }
    __syncthreads();
}

constexpr int NSEG = 8, SEGT = SEQ / NSEG;
__device__ __forceinline__ float dpp_xor1(float v) { return __builtin_bit_cast(float, __builtin_amdgcn_update_dpp(0, __builtin_bit_cast(int, v), 0xB1, 0xF, 0xF, true)); }
__device__ __forceinline__ float dpp_xor2(float v) { return __builtin_bit_cast(float, __builtin_amdgcn_update_dpp(0, __builtin_bit_cast(int, v), 0x4E, 0xF, 0xF, true)); }
__device__ __forceinline__ float dpp_hmir(float v) { return __builtin_bit_cast(float, __builtin_amdgcn_update_dpp(0, __builtin_bit_cast(int, v), 0x141, 0xF, 0xF, true)); }
__device__ __forceinline__ float red8(float v) { v += dpp_xor1(v); v += dpp_xor2(v); v += dpp_hmir(v); return v; }
__device__ __forceinline__ void gn_store(Frame& F, const Args& A, int row, int h, int q, f32x4 yv, f32x4 vv) {
    const float* BON = (const float*)(F.ws + WS_BON3); const bf16* aG = rk_bf(F, 6); bf16* RW = (bf16*)(F.ws + WS_RW);
    float s = (yv[0] + yv[1]) + (yv[2] + yv[3]);
    s += __shfl_xor(s, 1); s += __shfl_xor(s, 2); s += __shfl_xor(s, 4); s += __shfl_xor(s, 8);
    const float mean = s * (1.f / 64.f); const f32x4 d = yv - mean;
    float s2 = (d[0] * d[0] + d[1] * d[1]) + (d[2] * d[2] + d[3] * d[3]);
    s2 += __shfl_xor(s2, 1); s2 += __shfl_xor(s2, 2); s2 += __shfl_xor(s2, 4); s2 += __shfl_xor(s2, 8);
    const float rstd = rsqrtf(s2 * (1.f / 64.f) + 64e-5f), bon = BON[(row * 8 + h) * 4];
    const int cbase = h * 64 + 4 * q;
    const f32x4 gw = *(const f32x4*)(A.in[I_GNW] + cbase), gb = *(const f32x4*)(A.in[I_GNB] + cbase), gv = [&]{ const v4u pg = *(const v4u*)(rk_pair(F, 2) + (size_t)row * 512 + cbase); return (f32x4){bfhi(pg.x), bfhi(pg.y), bfhi(pg.z), bfhi(pg.w)}; }();
    const f32x4 o = (d * rstd * gw + gb + bon * vv) * gv;
    v2u w; w.x = pk2(o[0], o[1]); w.y = pk2(o[2], o[3]);
    *(v2u*)(RW + (size_t)row * 512 + cbase) = w;
}
struct ScanIn { f32x4 a0, a1, r0, r1, w0, w1, b0, b1, k0, k1; float vi, br, kr; };
__device__ __forceinline__ void scan_seg_unit(Frame& F, const Args& A, int u) {
    constexpr int TB = 32, VB = 6 * TB * 64 + 2 * TB;
    LAS float* vecs = (LAS float*)(F.lds + RING_OFF);
    LAS float* ybuf = vecs + 2 * VB;
    LAS float* cbuf = ybuf + TB * 64;
    const int tid = F.tid, i = tid >> 3, seg8 = tid & 7;
    const bool prompt = u < 256;
    int h, row0, T; bool useF; f32x2 S[4], Fm[4];
    if (prompt) { h = (u >> 3) & 7; row0 = (u >> 6) * SEQ + (u & 7) * SEGT; T = SEGT; useF = (u & 7) != 0;
#pragma unroll
        for (int c = 0; c < 4; ++c) { S[c] = (f32x2){0.f, 0.f}; Fm[c] = (f32x2){(8 * seg8 + 2 * c == i) ? 1.f : 0.f, (8 * seg8 + 2 * c + 1 == i) ? 1.f : 0.f}; } }
    else { const int su = u - 256; h = su & 7; row0 = MP + (su >> 3); T = 1; useF = false;
        const float* s0 = A.in[I_SWKV] + ((size_t)su * 64 + i) * 64 + 8 * seg8;
        const f32x4 a = *(const f32x4*)s0, b = *(const f32x4*)(s0 + 4);
        S[0] = (f32x2){a[0], a[1]}; S[1] = (f32x2){a[2], a[3]}; S[2] = (f32x2){b[0], b[1]}; S[3] = (f32x2){b[2], b[3]};
#pragma unroll
        for (int c = 0; c < 4; ++c) Fm[c] = (f32x2){0.f, 0.f}; }
    const float* BON = (const float*)(F.ws + WS_BON3);
    float* Y0 = (float*)(F.ws + WS_Y0); float* CC = (float*)(F.ws + WS_CC);
    f32x4 sg[6]; float sgs = 0.f;
    const int st = tid >> 4, sq = tid & 15;
#define SCAN_STAGE_LOAD(t0_) do { const int nb_ = (T - (t0_)) < TB ? (T - (t0_)) : TB; if (st < nb_) { const size_t go_ = (size_t)(row0 + (t0_) + st) * 512 + h * 64 + 4 * sq; \
        sg[1] = *(const f32x4*)(rk_arr(F, 1) + go_); const v4u p0_ = *(const v4u*)(rk_pair(F, 0) + go_), p2_ = *(const v4u*)(rk_pair(F, 2) + go_), p4_ = *(const v4u*)(rk_pair(F, 4) + go_); \
        sg[0] = (f32x4){bflo(p0_.x), bflo(p0_.y), bflo(p0_.z), bflo(p0_.w)}; sg[2] = (f32x4){bfhi(p0_.x), bfhi(p0_.y), bfhi(p0_.z), bfhi(p0_.w)}; sg[3] = (f32x4){bflo(p2_.x), bflo(p2_.y), bflo(p2_.z), bflo(p2_.w)}; \
        sg[4] = (f32x4){bflo(p4_.x), bflo(p4_.y), bflo(p4_.z), bflo(p4_.w)}; sg[5] = (f32x4){bfhi(p4_.x), bfhi(p4_.y), bfhi(p4_.z), bfhi(p4_.w)}; } \
        if (tid < 2 * TB && (tid >> 1) < nb_) sgs = BON[((row0 + (t0_) + (tid >> 1)) * 8 + h) * 4 + 1 + (tid & 1)]; } while (0)
#define SCAN_STAGE_STORE(buf_) do { LAS float* vb_ = vecs + (buf_) * VB; _Pragma("unroll") for (int a_ = 0; a_ < 6; ++a_) *(LAS f32x4*)(vb_ + (a_ * TB + st) * 64 + 4 * sq) = sg[a_]; \
        if (tid < 2 * TB) vb_[6 * TB * 64 + tid] = sgs; } while (0)
    SCAN_STAGE_LOAD(0); SCAN_STAGE_STORE(0);
    __syncthreads();
    int buf = 0;
    for (int t0 = 0; t0 < T; t0 += TB, buf ^= 1) {
        const int nb = (T - t0) < TB ? (T - t0) : TB;
        const bool more = t0 + TB < T;
        if (more) SCAN_STAGE_LOAD(t0 + TB);
        const LAS float* vec = vecs + buf * VB; const LAS float* scl = vec + 6 * TB * 64;
#define SCAN_LOADIN(X, t_) do { const LAS float* p_ = vec + (t_) * 64 + 8 * seg8; \
        X.r0 = *(const LAS f32x4*)(p_); X.r1 = *(const LAS f32x4*)(p_ + 4); X.w0 = *(const LAS f32x4*)(p_ + TB * 64); X.w1 = *(const LAS f32x4*)(p_ + TB * 64 + 4); \
        X.k0 = *(const LAS f32x4*)(p_ + 2 * TB * 64); X.k1 = *(const LAS f32x4*)(p_ + 2 * TB * 64 + 4); X.a0 = *(const LAS f32x4*)(p_ + 4 * TB * 64); X.a1 = *(const LAS f32x4*)(p_ + 4 * TB * 64 + 4); \
        X.b0 = *(const LAS f32x4*)(p_ + 5 * TB * 64); X.b1 = *(const LAS f32x4*)(p_ + 5 * TB * 64 + 4); X.vi = vec[(3 * TB + (t_)) * 64 + i]; X.br = scl[2 * (t_)]; X.kr = scl[2 * (t_) + 1]; } while (0)
#define LO2(v) ((f32x2){(v)[0], (v)[1]})
#define HI2(v) ((f32x2){(v)[2], (v)[3]})
#define SCAN_STEP(X, Y, t_) do { \
        const f32x2 a_[4] = {LO2(X.a0), HI2(X.a0), LO2(X.a1), HI2(X.a1)}, r_[4] = {LO2(X.r0), HI2(X.r0), LO2(X.r1), HI2(X.r1)}; \
        const f32x2 w_[4] = {LO2(X.w0), HI2(X.w0), LO2(X.w1), HI2(X.w1)}, b_[4] = {LO2(X.b0), HI2(X.b0), LO2(X.b1), HI2(X.b1)}, k_[4] = {LO2(X.k0), HI2(X.k0), LO2(X.k1), HI2(X.k1)}; \
        const float br_ = X.br, kr_ = X.kr, vi_ = X.vi; \
        f32x2 d1 = S[0] * a_[0], d2 = S[0] * r_[0], f1 = Fm[0] * a_[0], f2 = Fm[0] * r_[0]; \
        _Pragma("unroll") for (int c = 1; c < 4; ++c) { d1 += S[c] * a_[c]; d2 += S[c] * r_[c]; f1 += Fm[c] * a_[c]; f2 += Fm[c] * r_[c]; } \
        f32x2 tS[4], tF[4]; _Pragma("unroll") for (int c = 0; c < 4; ++c) { tS[c] = S[c] * w_[c] + vi_ * k_[c]; tF[c] = Fm[c] * w_[c]; } \
        { int tn_ = (t_) + 1;     \
          asm volatile("" : "+v"(tn_) : "v"(d1), "v"(d2), "v"(f1), "v"(f2), "v"(tS[0]), "v"(tS[1]), "v"(tS[2]), "v"(tS[3]), "v"(tF[0]), "v"(tF[1]), "v"(tF[2]), "v"(tF[3])); \
          if ((t_) + 1 < nb) SCAN_LOADIN(Y, tn_); } \
        float q0 = d1.x + d1.y, q1 = d2.x + d2.y, q2 = f1.x + f1.y, q3 = f2.x + f2.y; \
        q0 += dpp_xor1(q0); q1 += dpp_xor1(q1); q2 += dpp_xor1(q2); q3 += dpp_xor1(q3); \
        q0 += dpp_xor2(q0); q1 += dpp_xor2(q1); q2 += dpp_xor2(q2); q3 += dpp_xor2(q3); \
        q0 += dpp_hmir(q0); q1 += dpp_hmir(q1); q2 += dpp_hmir(q2); q3 += dpp_hmir(q3); \
        _Pragma("unroll") for (int c = 0; c < 4; ++c) { S[c] = tS[c] + q0 * b_[c]; Fm[c] = tF[c] + q2 * b_[c]; } \
        if (seg8 == 0) { ybuf[(t_) * 64 + i] = q1 + q0 * br_ + vi_ * kr_; cbuf[(t_) * 64 + i] = q3 + q2 * br_; } } while (0)
        ScanIn IA, IB;
        SCAN_LOADIN(IA, 0);
        for (int t = 0; t < nb; t += 2) {
            SCAN_STEP(IA, IB, t);
            if (t + 1 < nb) SCAN_STEP(IB, IA, t + 1);
        }
        if (more) SCAN_STAGE_STORE(buf ^ 1);
        __syncthreads();
        { const int t = tid >> 4, q = tid & 15;
          if (t < nb) { const int row = row0 + t0 + t;
            const f32x4 yv = *(const LAS f32x4*)(ybuf + t * 64 + 4 * q);
            if (prompt) { *(f32x4*)(Y0 + (size_t)row * 512 + h * 64 + 4 * q) = yv; if (useF) *(f32x4*)(CC + (size_t)row * 512 + h * 64 + 4 * q) = *(const LAS f32x4*)(cbuf + t * 64 + 4 * q); }
            else gn_store(F, A, row, h, q, yv, *(const LAS f32x4*)(vec + (3 * TB + t) * 64 + 4 * q)); } }
        __syncthreads();
    }
#undef SCAN_STAGE_LOAD
#undef SCAN_STAGE_STORE
#undef SCAN_LOADIN
#undef SCAN_STEP
#undef LO2
#undef HI2
    const f32x4 s0v = {S[0].x, S[0].y, S[1].x, S[1].y}, s1v = {S[2].x, S[2].y, S[3].x, S[3].y};
    if (prompt) { float* ps = (float*)(F.ws + WS_PSI) + ((size_t)u * 64 + i) * 64 + 8 * seg8; *(f32x4*)ps = s0v; *(f32x4*)(ps + 4) = s1v;
        if (useF) { float* ph = (float*)(F.ws + WS_PHI) + ((size_t)u * 64 + i) * 64 + 8 * seg8; *(f32x4*)ph = (f32x4){Fm[0].x, Fm[0].y, Fm[1].x, Fm[1].y}; *(f32x4*)(ph + 4) = (f32x4){Fm[2].x, Fm[2].y, Fm[3].x, Fm[3].y}; } }
    else { float* so = F.out + O_WS + ((size_t)(u - 256) * 64 + i) * 64 + 8 * seg8; *(f32x4*)so = s0v; *(f32x4*)(so + 4) = s1v; }
    __syncthreads();
}
__device__ __forceinline__ void carry_unit(Frame& F, const Args& A, int bh) {
    LAS float* X = (LAS float*)(F.lds + RING_OFF);
    LAS float* P = X + 4096;
    const int tid = F.tid, i = tid >> 3, seg8 = tid & 7;
    float* SST = (float*)(F.ws + WS_SST); const float* PSI = (const float*)(F.ws + WS_PSI); const float* PHI = (const float*)(F.ws + WS_PHI);
    float cur[8];
#pragma unroll
    for (int c = 0; c < 8; ++c) cur[c] = 0.f;
    for (int k = 0; k < NSEG; ++k) {
        const size_t uo = ((size_t)(bh * NSEG + k) * 64 + i) * 64 + 8 * seg8;
        *(f32x4*)(SST + uo) = (f32x4){cur[0], cur[1], cur[2], cur[3]}; *(f32x4*)(SST + uo + 4) = (f32x4){cur[4], cur[5], cur[6], cur[7]};
        const f32x4 p0 = *(const f32x4*)(PSI + uo), p1 = *(const f32x4*)(PSI + uo + 4);
        float nx[8] = {p0[0], p0[1], p0[2], p0[3], p1[0], p1[1], p1[2], p1[3]};
        if (k > 0) {
            __syncthreads();
            *(LAS f32x4*)(X + i * 64 + 8 * seg8) = (f32x4){cur[0], cur[1], cur[2], cur[3]}; *(LAS f32x4*)(X + i * 64 + 8 * seg8 + 4) = (f32x4){cur[4], cur[5], cur[6], cur[7]};
            *(LAS f32x4*)(P + i * 64 + 8 * seg8) = *(const f32x4*)(PHI + uo); *(LAS f32x4*)(P + i * 64 + 8 * seg8 + 4) = *(const f32x4*)(PHI + uo + 4);
            __syncthreads();
#pragma unroll 4
            for (int l = 0; l < 64; ++l) { const float x = X[i * 64 + l]; const f32x4 q0 = *(const LAS f32x4*)(P + l * 64 + 8 * seg8), q1 = *(const LAS f32x4*)(P + l * 64 + 8 * seg8 + 4);
#pragma unroll
                for (int c = 0; c < 4; ++c) { nx[c] += x * q0[c]; nx[4 + c] += x * q1[c]; } }
        }
#pragma unroll
        for (int c = 0; c < 8; ++c) cur[c] = nx[c];
    }
    float* so = F.out + O_WP + ((size_t)bh * 64 + i) * 64 + 8 * seg8; *(f32x4*)so = (f32x4){cur[0], cur[1], cur[2], cur[3]}; *(f32x4*)(so + 4) = (f32x4){cur[4], cur[5], cur[6], cur[7]};
    __syncthreads();
}
__device__ __forceinline__ void corr_unit(Frame& F, const Args& A, int u) {
    const int lane = F.lane, w = F.wave, r32 = lane & 31, hi = lane >> 5, seg = u & 7, bh = u >> 3, h = bh & 7, rowseg = (bh >> 3) * SEQ + seg * SEGT;
    const float* SST = (const float*)(F.ws + WS_SST) + (size_t)u * 4096; const float* CC = (const float*)(F.ws + WS_CC); const float* Y0 = (const float*)(F.ws + WS_Y0);
    const float* BON = (const float*)(F.ws + WS_BON3); const bf16* aG = rk_bf(F, 6); const bf16* aV = rk_bf(F, 3); bf16* RW = (bf16*)(F.ws + WS_RW);
    bf16x8 sb[2][4];
    if (seg > 0) {
#pragma unroll
        for (int ct = 0; ct < 2; ++ct)
#pragma unroll
            for (int ks = 0; ks < 4; ++ks) { const float* p = SST + (size_t)(32 * ct + r32) * 64 + 16 * ks + 8 * hi; const f32x4 x = *(const f32x4*)p, y = *(const f32x4*)(p + 4);
                const v4u t = {pk2(x[0], x[1]), pk2(x[2], x[3]), pk2(y[0], y[1]), pk2(y[2], y[3])}; sb[ct][ks] = __builtin_bit_cast(bf16x8, t); }
    }
    float gw[2], gb[2];
#pragma unroll
    for (int ct = 0; ct < 2; ++ct) { gw[ct] = A.in[I_GNW][h * 64 + 32 * ct + r32]; gb[ct] = A.in[I_GNB][h * 64 + 32 * ct + r32]; }
    for (int blk = w; blk < SEGT / 32; blk += NWAVES) {
        const int row0 = rowseg + 32 * blk;
        f32x16 d[2]; d[0] = (f32x16){}; d[1] = (f32x16){};
        float yv0[16], yv1[16], bnv[16]; unsigned vgv0[16], vgv1[16];
#pragma unroll
        for (int r = 0; r < 16; ++r) { const int row = row0 + crow16(r, hi); const size_t o = (size_t)row * 512 + h * 64 + r32;
            yv0[r] = Y0[o]; yv1[r] = Y0[o + 32]; vgv0[r] = rk_pair(F, 2)[o]; vgv1[r] = rk_pair(F, 2)[o + 32]; bnv[r] = BON[(row * 8 + h) * 4]; }
        if (seg > 0) {
#pragma unroll
            for (int ks = 0; ks < 4; ++ks) { const float* p = CC + (size_t)(row0 + r32) * 512 + h * 64 + 16 * ks + 8 * hi; const f32x4 x = *(const f32x4*)p, y = *(const f32x4*)(p + 4);
                const v4u t = {pk2(x[0], x[1]), pk2(x[2], x[3]), pk2(y[0], y[1]), pk2(y[2], y[3])}; const bf16x8 cf = __builtin_bit_cast(bf16x8, t);
                d[0] = __builtin_amdgcn_mfma_f32_32x32x16_bf16(cf, sb[0][ks], d[0], 0, 0, 0); d[1] = __builtin_amdgcn_mfma_f32_32x32x16_bf16(cf, sb[1][ks], d[1], 0, 0, 0); }
        }
#pragma unroll
        for (int r = 0; r < 16; ++r) {
            const int row = row0 + crow16(r, hi); const size_t o = (size_t)row * 512 + h * 64 + r32;
            const float y0 = yv0[r] + d[0][r], y1 = yv1[r] + d[1][r];
            const float mean = sum32(y0 + y1) * (1.f / 64.f), e0 = y0 - mean, e1 = y1 - mean;
            const float rstd = rsqrtf(sum32(e0 * e0 + e1 * e1) * (1.f / 64.f) + 64e-5f), bon = bnv[r];
            const unsigned vg0 = vgv0[r], vg1 = vgv1[r];
            const float o0 = (e0 * rstd * gw[0] + gb[0] + bon * bflo(vg0)) * bfhi(vg0), o1 = (e1 * rstd * gw[1] + gb[1] + bon * bflo(vg1)) * bfhi(vg1);
            RW[o] = (bf16)(pk2(o0, 0.f) & 0xffffu); RW[o + 32] = (bf16)(pk2(o1, 0.f) & 0xffffu);
        }
    }
}

typedef short v4i16_t __attribute__((ext_vector_type(4)));
__device__ __forceinline__ s16x4 vtr(const LAS unsigned char* p) { return __builtin_bit_cast(s16x4, __builtin_amdgcn_ds_read_tr16_b64_v4i16((LAS v4i16_t*)p)); }
constexpr int IMG_LD = 136;
constexpr int IMG_BYTES = 64 * IMG_LD;
typedef bf16x8 Frag[2][4];
__device__ __forceinline__ void mm64(const Frag& Af, const Frag& Bf, f32x16 (&D)[2][2]) {
#pragma unroll
    for (int rt = 0; rt < 2; ++rt)
#pragma unroll
        for (int ct = 0; ct < 2; ++ct)
#pragma unroll
            for (int ks = 0; ks < 4; ++ks) D[rt][ct] = __builtin_amdgcn_mfma_f32_32x32x16_bf16(Af[rt][ks], Bf[ct][ks], D[rt][ct], 0, 0, 0);
}
__device__ __forceinline__ void acc_zero(f32x16 (&D)[2][2]) {
#pragma unroll
    for (int a = 0; a < 2; ++a)
#pragma unroll
        for (int b = 0; b < 2; ++b) D[a][b] = (f32x16){};
}
__device__ __forceinline__ void acc_frag(const f32x16 (&X)[2][2], Frag& Fr) {
#pragma unroll
    for (int rt = 0; rt < 2; ++rt)
#pragma unroll
        for (int ct = 0; ct < 2; ++ct)
#pragma unroll
            for (int hf = 0; hf < 2; ++hf) { const int rb = 8 * hf;
                const v4u u = {pk2(X[rt][ct][rb], X[rt][ct][rb + 1]), pk2(X[rt][ct][rb + 2], X[rt][ct][rb + 3]), pk2(X[rt][ct][rb + 4], X[rt][ct][rb + 5]), pk2(X[rt][ct][rb + 6], X[rt][ct][rb + 7])};
                Fr[ct][2 * rt + hf] = __builtin_bit_cast(bf16x8, u); }
}
__device__ __forceinline__ void rowfrag(const LAS unsigned char* img, int lane, Frag& Fr) {
    const int r32 = lane & 31, hi = lane >> 5;
#pragma unroll
    for (int tl = 0; tl < 2; ++tl)
#pragma unroll
        for (int ks = 0; ks < 4; ++ks) Fr[tl][ks] = *(const LAS bf16x8*)(img + (32 * tl + r32) * IMG_LD + (16 * ks + 8 * hi) * 2);
}
__device__ __forceinline__ void rowfrag_perm(const LAS unsigned char* img, int lane, Frag& Fr) {
    const int r32 = lane & 31, hi = lane >> 5;
#pragma unroll
    for (int tl = 0; tl < 2; ++tl)
#pragma unroll
        for (int ks = 0; ks < 4; ++ks) { const LAS unsigned char* p = img + (32 * tl + r32) * IMG_LD + (16 * ks + 4 * hi) * 2;
            const v2u a = *(const LAS v2u*)p, b = *(const LAS v2u*)(p + 16); const v4u u = {a.x, a.y, b.x, b.y}; Fr[tl][ks] = __builtin_bit_cast(bf16x8, u); }
}
__device__ __forceinline__ void colfrag_tr(const LAS unsigned char* img, int lane, Frag& Fr) {
    const int hi = lane >> 5, qq = (lane & 15) >> 2, p4 = lane & 3, cg = (lane >> 4) & 1;
    const LAS unsigned char* base = img + (4 * hi + qq) * IMG_LD + (16 * cg + 4 * p4) * 2;
#pragma unroll
    for (int tl = 0; tl < 2; ++tl)
#pragma unroll
        for (int ks = 0; ks < 4; ++ks) { const LAS unsigned char* p = base + (16 * ks) * IMG_LD + (32 * tl) * 2;
            const s16x4 lo = vtr(p), hh = vtr(p + 8 * IMG_LD); Fr[tl][ks] = (bf16x8){lo[0], lo[1], lo[2], lo[3], hh[0], hh[1], hh[2], hh[3]}; }
}
__device__ __forceinline__ void img_load(const bf16* g, LAS unsigned char* slot, int lane) {
    asm volatile("" ::: "memory");
    const unsigned char* gb = (const unsigned char*)g + (unsigned)(lane * 16);
    LAS unsigned char* sl_ = slot + (lane >> 3) * IMG_LD + (lane & 7) * 16;
    v4u t[8];
#pragma unroll
    for (int k = 0; k < 8; ++k) t[k] = *(const v4u*)(gb + 1024 * k);
#pragma unroll
    for (int k = 0; k < 8; ++k) *(LAS v4u*)(sl_ + (8 * k) * IMG_LD) = t[k];
    asm volatile("" ::: "memory");
}
__device__ __forceinline__ void img_load2(const bf16* ga, LAS unsigned char* slota, const bf16* gb_, LAS unsigned char* slotb, int lane) {
    asm volatile("" ::: "memory");
    const unsigned char* pa = (const unsigned char*)ga + (unsigned)(lane * 16); const unsigned char* pb = (const unsigned char*)gb_ + (unsigned)(lane * 16);
    const int lo_ = (lane >> 3) * IMG_LD + (lane & 7) * 16;
    v4u ta[8], tb[8];
#pragma unroll
    for (int k = 0; k < 8; ++k) ta[k] = *(const v4u*)(pa + 1024 * k);
#pragma unroll
    for (int k = 0; k < 8; ++k) tb[k] = *(const v4u*)(pb + 1024 * k);
#pragma unroll
    for (int k = 0; k < 8; ++k) *(LAS v4u*)(slota + lo_ + (8 * k) * IMG_LD) = ta[k];
#pragma unroll
    for (int k = 0; k < 8; ++k) *(LAS v4u*)(slotb + lo_ + (8 * k) * IMG_LD) = tb[k];
    asm volatile("" ::: "memory");
}
__device__ __forceinline__ void acc_to_img(const f32x16 (&X)[2][2], LAS unsigned char* slot, int lane) {
    const int r32 = lane & 31, hi = lane >> 5; LAS unsigned char* lb = slot + (4 * hi) * IMG_LD + r32 * 2;
#pragma unroll
    for (int rt = 0; rt < 2; ++rt)
#pragma unroll
        for (int ct = 0; ct < 2; ++ct)
        { asm volatile("" ::: "memory");
#pragma unroll
            for (int r = 0; r < 16; ++r) *(LAS bf16*)(lb + (32 * rt + CRC(r)) * IMG_LD + (32 * ct) * 2) = (bf16)(pk2(X[rt][ct][r], 0.f) & 0xffffu); }
}
__device__ __forceinline__ void acc_to_gbf(const f32x16 (&X)[2][2], bf16* g, int lane) {
    const int r32 = lane & 31, hi = lane >> 5; bf16* gl = g + (4 * hi) * 64 + r32;
#pragma unroll
    for (int rt = 0; rt < 2; ++rt)
#pragma unroll
        for (int ct = 0; ct < 2; ++ct)
        { asm volatile("" ::: "memory");
#pragma unroll
            for (int r = 0; r < 16; ++r) gl[(32 * rt + CRC(r)) * 64 + 32 * ct] = (bf16)(pk2(X[rt][ct][r], 0.f) & 0xffffu); }
}
__device__ __forceinline__ void acc_to_gf32(const f32x16 (&X)[2][2], float* g, int lane) {
    const int r32 = lane & 31, hi = lane >> 5; float* gl = g + (4 * hi) * 64 + r32;
#pragma unroll
    for (int rt = 0; rt < 2; ++rt)
#pragma unroll
        for (int ct = 0; ct < 2; ++ct)
        { asm volatile("" ::: "memory");
#pragma unroll
            for (int r = 0; r < 16; ++r) gl[(32 * rt + CRC(r)) * 64 + 32 * ct] = X[rt][ct][r]; }
}
template <bool STRICT> __device__ __forceinline__ void mask_upper(f32x16 (&X)[2][2], int lane) {
    const int r32 = lane & 31, hi = lane >> 5, dl = 4 * hi - r32;
#pragma unroll
    for (int rt = 0; rt < 2; ++rt)
#pragma unroll
        for (int ct = 0; ct < 2; ++ct)
#pragma unroll
            for (int r = 0; r < 16; ++r) { const int dlt = dl + (32 * rt + CRC(r) - 32 * ct); const bool keep = STRICT ? (dlt < 0) : (dlt <= 0); if (!keep) X[rt][ct][r] = 0.f; }
}
template <int RT> __device__ __forceinline__ void mm_rt(const Frag& Af, const Frag& Bf, f32x16 (&D)[2]) {
#pragma unroll
    for (int ct = 0; ct < 2; ++ct)
#pragma unroll
        for (int ks = 0; ks < 4; ++ks) D[ct] = __builtin_amdgcn_mfma_f32_32x32x16_bf16(Af[RT][ks], Bf[ct][ks], D[ct], 0, 0, 0);
}
template <int RT> __device__ __forceinline__ void frag_rt(const f32x16 (&D)[2], Frag& Fr) {
#pragma unroll
    for (int ct = 0; ct < 2; ++ct)
#pragma unroll
        for (int hf = 0; hf < 2; ++hf) { const int rb = 8 * hf;
            const v4u u = {pk2(D[ct][rb], D[ct][rb + 1]), pk2(D[ct][rb + 2], D[ct][rb + 3]), pk2(D[ct][rb + 4], D[ct][rb + 5]), pk2(D[ct][rb + 6], D[ct][rb + 7])};
            Fr[ct][2 * RT + hf] = __builtin_bit_cast(bf16x8, u); }
}
template <int RT, bool STRICT> __device__ __forceinline__ void mask_rt(f32x16 (&D)[2], int lane) {
    const int dl = 4 * (lane >> 5) - (lane & 31);
#pragma unroll
    for (int ct = 0; ct < 2; ++ct)
#pragma unroll
        for (int r = 0; r < 16; ++r) { const int dlt = dl + (32 * RT + CRC(r) - 32 * ct); const bool keep = STRICT ? (dlt < 0) : (dlt <= 0); if (!keep) D[ct][r] = 0.f; }
}
template <int RT> __device__ __forceinline__ void st_f32_rt(const f32x16 (&D)[2], float* g, int lane) { float* gl = g + (4 * (lane >> 5)) * 64 + (lane & 31);
#pragma unroll
    for (int ct = 0; ct < 2; ++ct) { asm volatile("" ::: "memory");
#pragma unroll
        for (int r = 0; r < 16; ++r) gl[(32 * RT + CRC(r)) * 64 + 32 * ct] = D[ct][r]; } }
template <int RT> __device__ __forceinline__ void st_bf_rt(const f32x16 (&D)[2], bf16* g, int lane) { bf16* gl = g + (4 * (lane >> 5)) * 64 + (lane & 31);
#pragma unroll
    for (int ct = 0; ct < 2; ++ct) { asm volatile("" ::: "memory");
#pragma unroll
        for (int r = 0; r < 16; ++r) gl[(32 * RT + CRC(r)) * 64 + 32 * ct] = (bf16)(pk2(D[ct][r], 0.f) & 0xffffu); } }
template <int RT> __device__ __forceinline__ void ld_f32_rt(f32x16 (&D)[2], const float* g, int lane) { const float* gl = g + (4 * (lane >> 5)) * 64 + (lane & 31);
#pragma unroll
    for (int ct = 0; ct < 2; ++ct) { asm volatile("" ::: "memory");
#pragma unroll
        for (int r = 0; r < 16; ++r) D[ct][r] = gl[(32 * RT + CRC(r)) * 64 + 32 * ct]; } }
template <int RT> __device__ __forceinline__ void scale_rt(f32x16 (&D)[2], const float* gcl  ) {
#pragma unroll
    for (int ct = 0; ct < 2; ++ct)
#pragma unroll
        for (int r = 0; r < 16; ++r) D[ct][r] *= gcl[32 * RT + CRC(r)]; }
__device__ __forceinline__ void zero2(f32x16 (&D)[2]) { D[0] = (f32x16){}; D[1] = (f32x16){}; }
__device__ __forceinline__ void tfrag(const f32x16& T, bf16x8& f0, bf16x8& f1) {
    const v4u u0 = {pk2(T[0], T[1]), pk2(T[2], T[3]), pk2(T[4], T[5]), pk2(T[6], T[7])}, u1 = {pk2(T[8], T[9]), pk2(T[10], T[11]), pk2(T[12], T[13]), pk2(T[14], T[15])};
    f0 = __builtin_bit_cast(bf16x8, u0); f1 = __builtin_bit_cast(bf16x8, u1);
}
__device__ __forceinline__ void tmm(const bf16x8 (&a)[2], const bf16x8 (&b)[2], f32x16& d) {
    d = __builtin_amdgcn_mfma_f32_32x32x16_bf16(a[0], b[0], d, 0, 0, 0); d = __builtin_amdgcn_mfma_f32_32x32x16_bf16(a[1], b[1], d, 0, 0, 0);
}
__device__ __forceinline__ void tprod(const Frag& A_, int ra, const Frag& B_, int rb, f32x16& d) {
#pragma unroll
    for (int ks = 0; ks < 4; ++ks) d = __builtin_amdgcn_mfma_f32_32x32x16_bf16(A_[ra][ks], B_[rb][ks], d, 0, 0, 0);
}
template <bool WANT_ZT> __device__ __forceinline__ void diag_inv(f32x16& Q, f32x16& QT, f32x16& Z, f32x16& ZT, int lane) {
    const int dl = 4 * (lane >> 5) - (lane & 31);
#pragma unroll
    for (int r = 0; r < 16; ++r) { const int d = dl + CRC(r); Q[r] = d < 0 ? Q[r] : 0.f; QT[r] = d > 0 ? QT[r] : 0.f; const float id = d == 0 ? 1.f : 0.f; Z[r] = Q[r] + id; ZT[r] = QT[r] + id; }
#pragma unroll 1
    for (int lvl = 0; lvl < 4; ++lvl) {
        bf16x8 fq[2], fqt[2], fz[2];
        tfrag(Q, fq[0], fq[1]); tfrag(QT, fqt[0], fqt[1]);
        Q = (f32x16){}; QT = (f32x16){}; tmm(fqt, fq, Q); tmm(fq, fqt, QT);
        tfrag(Q, fq[0], fq[1]); tfrag(QT, fqt[0], fqt[1]);
        tfrag(Z, fz[0], fz[1]); tmm(fqt, fz, Z);
        if (WANT_ZT) { tfrag(ZT, fz[0], fz[1]); tmm(fq, fz, ZT); }
    }
}
constexpr int NCHK = SEQ / 64;
__device__ __forceinline__ void chunk_prescale(Frame& F, int hc) {
    const int lane = F.lane, bh = hc >> 6, c = hc & 63, h = bh & 7, row0 = (bh >> 3) * SEQ + c * 64;
    bf16* sc = (bf16*)(F.ws + WS_SC) + (size_t)hc * 5 * 4096 + lane;
    const size_t o0 = (size_t)row0 * 512 + h * 64 + lane;
    const float* aW = rk_arr(F, 1) + o0; const unsigned* pRK = rk_pair(F, 0) + o0; const unsigned* pVG = rk_pair(F, 2) + o0; const unsigned* pAB = rk_pair(F, 4) + o0;
    float lc = 0.f;
    float wA[16], wB[16]; unsigned rkA[16], rkB[16], vgA[16], vgB[16], abA[16], abB[16];
#define PS_LOAD(S, tb) do { _Pragma("unroll") for (int i = 0; i < 16; ++i) { const int t = 16 * (tb) + i; w##S[i] = aW[t * 512]; rk##S[i] = pRK[t * 512]; vg##S[i] = pVG[t * 512]; ab##S[i] = pAB[t * 512]; } } while (0)
#define PS_COMP(S, tb) do { _Pragma("unroll") for (int i = 0; i < 16; ++i) { const int t = 16 * (tb) + i; \
        const float em = __expf(lc); lc += __logf(w##S[i]); const float ei = __expf(-lc); \
        sc[0 * 4096 + t * 64] = (bf16)(pk2(bflo(ab##S[i]) * em, 0.f) & 0xffffu); \
        sc[1 * 4096 + t * 64] = (bf16)(pk2(bfhi(ab##S[i]) * ei, 0.f) & 0xffffu); \
        sc[2 * 4096 + t * 64] = (bf16)(pk2(bfhi(rk##S[i]) * ei, 0.f) & 0xffffu); \
        sc[3 * 4096 + t * 64] = (bf16)(pk2(bflo(rk##S[i]) * em, 0.f) & 0xffffu); \
        sc[4 * 4096 + t * 64] = (bf16)(vg##S[i] & 0xffffu); } } while (0)
    PS_LOAD(A, 0); PS_LOAD(B, 1);
    PS_COMP(A, 0); asm volatile("" ::: "memory"); PS_LOAD(A, 2);
    PS_COMP(B, 1); asm volatile("" ::: "memory"); PS_LOAD(B, 3);
    PS_COMP(A, 2); PS_COMP(B, 3);
#undef PS_LOAD
#undef PS_COMP
    ((float*)(F.ws + WS_GC))[(size_t)hc * 64 + lane] = __expf(lc);
}
__device__ __forceinline__ void chunk_unit(Frame& F, int hc) {
    const int lane = F.lane, r32 = lane & 31, hi = lane >> 5;
    LAS unsigned char* s0 = F.lds + RING_OFF + F.wave * (2 * IMG_BYTES); LAS unsigned char* s1 = s0 + IMG_BYTES; const LAS unsigned char* s1l = s1 + (4 * hi) * IMG_LD + r32 * 2;
    SUBM(0);
    const float* rho = (const float*)(F.ws + WS_HT) + (size_t)(((hc >> 9) * 64 + (hc & 63)) * 2) * 512 + ((hc >> 6) & 7) * 64; const float* sig = rho + 512;
    ((float*)(F.ws + WS_GC))[(size_t)hc * 64 + lane] = rho[lane] * sig[lane];
    SUBM(1);
    const bf16* sc = (const bf16*)(F.ws + WS_SC) + (size_t)hc * 5 * 4096;
    const bf16* gAb = sc; const bf16* gBb = sc + 4096; const bf16* gKb = sc + 2 * 4096; const bf16* gRb = sc + 3 * 4096; const bf16* gV = sc + 4 * 4096;
    Frag fa, fb, zf, uf, af, vf;
    {
        f32x16 Q, QT, Z, ZT; bf16x8 zt11[2], z22[2], t0[2], t1[2];
        img_load2(gAb, s0, gBb, s1, lane);
        rowfrag(s1, lane, fa); rowfrag(s0, lane, fb);
        Q = (f32x16){}; QT = (f32x16){}; tprod(fa, 0, fb, 0, Q); tprod(fb, 0, fa, 0, QT); diag_inv<true>(Q, QT, Z, ZT, lane);
        tfrag(Z, zf[0][0], zf[0][1]); tfrag(ZT, zt11[0], zt11[1]);
        Q = (f32x16){}; QT = (f32x16){}; tprod(fa, 1, fb, 1, Q); tprod(fb, 1, fa, 1, QT); diag_inv<false>(Q, QT, Z, ZT, lane);
        tfrag(Z, z22[0], z22[1]); zf[1][2] = z22[0]; zf[1][3] = z22[1];
        QT = (f32x16){}; tprod(fb, 1, fa, 0, QT);
        tfrag(QT, t0[0], t0[1]); Q = (f32x16){}; tmm(t0, z22, Q);
        tfrag(Q, t1[0], t1[1]); Z = (f32x16){}; tmm(zt11, t1, Z);
        tfrag(Z, zf[1][0], zf[1][1]);
        zf[0][2] = (bf16x8){}; zf[0][3] = (bf16x8){};
    }
    SUBM(2);
    f32x16 D[2];
    colfrag_tr(s0, lane, uf);
    zero2(D); mm_rt<0>(zf, uf, D); frag_rt<0>(D, af);
    zero2(D); mm_rt<1>(zf, uf, D); frag_rt<1>(D, af);
    img_load2(gKb, s1, gV, s0, lane);
    rowfrag(s1, lane, fa);
    zero2(D); mm_rt<0>(fa, fb, D); mask_rt<0, true>(D, lane); frag_rt<0>(D, uf);
    zero2(D); mm_rt<1>(fa, fb, D); mask_rt<1, true>(D, lane); frag_rt<1>(D, uf);
    colfrag_tr(s0, lane, vf);
    zero2(D); mm_rt<0>(uf, vf, D); frag_rt<0>(D, fa);
    zero2(D); mm_rt<1>(uf, vf, D); frag_rt<1>(D, fa);
    zero2(D); mm_rt<0>(zf, fa, D); frag_rt<0>(D, uf);
    zero2(D); mm_rt<1>(zf, fa, D); frag_rt<1>(D, uf);
    SUBM(3);
    const float* gcg = sig + 4 * hi; const float* rhg = rho + 4 * hi;
    colfrag_tr(s1, lane, zf);
    img_load(gBb, s0, lane); colfrag_tr(s0, lane, fa);
    { unsigned char* slfb = F.ws + WS_SL + (size_t)hc * 8192 + lane * 8; unsigned char* gpfb = F.ws + WS_GP + (size_t)hc * 8192 + lane * 16;
      zero2(D); mm_rt<0>(zf, vf, D); mm_rt<0>(fa, uf, D); scale_rt<0>(D, gcg);
#pragma unroll
      for (int ct = 0; ct < 2; ++ct)
#pragma unroll
          for (int q = 0; q < 4; ++q) *(v2u*)(slfb + ((ct * 2 + 0) * 4 + q) * 512) = (v2u){pk2(D[ct][4 * q], D[ct][4 * q + 1]), pk2(D[ct][4 * q + 2], D[ct][4 * q + 3])};
      zero2(D); mm_rt<1>(zf, vf, D); mm_rt<1>(fa, uf, D); scale_rt<1>(D, gcg);
#pragma unroll
      for (int ct = 0; ct < 2; ++ct)
#pragma unroll
          for (int q = 0; q < 4; ++q) *(v2u*)(slfb + ((ct * 2 + 1) * 4 + q) * 512) = (v2u){pk2(D[ct][4 * q], D[ct][4 * q + 1]), pk2(D[ct][4 * q + 2], D[ct][4 * q + 3])};
      const float gc0 = sig[r32], gc1 = sig[32 + r32];
      zero2(D); mm_rt<0>(af, fa, D); D[0] *= gc0; D[1] *= gc1; scale_rt<0>(D, rhg); frag_rt<0>(D, zf);
      zero2(D); mm_rt<1>(af, fa, D); D[0] *= gc0; D[1] *= gc1; scale_rt<1>(D, rhg); frag_rt<1>(D, zf);
#pragma unroll
      for (int tl = 0; tl < 2; ++tl)
#pragma unroll
          for (int ks = 0; ks < 4; ++ks) *(bf16x8*)(gpfb + (tl * 4 + ks) * 1024) = zf[tl][ks]; }
    SUBM(4);
    img_load(gRb, s1, lane);
    rowfrag(s0, lane, fa); rowfrag(s1, lane, fb);
    zero2(D); mm_rt<0>(fa, fb, D); mask_rt<0, false>(D, lane); frag_rt<0>(D, zf);
    zero2(D); mm_rt<1>(fa, fb, D); mask_rt<1, false>(D, lane); frag_rt<1>(D, zf);
    { const LAS unsigned char* s1t = s1 + r32 * IMG_LD + hi * 8;
      unsigned char* rhfb = F.ws + WS_RH + (size_t)hc * 8192 + lane * 16;
#pragma unroll
      for (int ct = 0; ct < 2; ++ct)
#pragma unroll
          for (int q = 0; q < 4; ++q) { const v2u w_ = *(const LAS v2u*)(s1t + (32 * ct) * IMG_LD + (8 * q) * 2);
              D[ct][4 * q] = bflo(w_.x); D[ct][4 * q + 1] = bfhi(w_.x); D[ct][4 * q + 2] = bflo(w_.y); D[ct][4 * q + 3] = bfhi(w_.y); }
      mm_rt<0>(af, zf, D); scale_rt<0>(D, rhg); frag_rt<0>(D, fa);
#pragma unroll
      for (int ct = 0; ct < 2; ++ct)
#pragma unroll
          for (int q = 0; q < 4; ++q) { const v2u w_ = *(const LAS v2u*)(s1t + (32 * ct) * IMG_LD + (32 + 8 * q) * 2);
              D[ct][4 * q] = bflo(w_.x); D[ct][4 * q + 1] = bfhi(w_.x); D[ct][4 * q + 2] = bflo(w_.y); D[ct][4 * q + 3] = bfhi(w_.y); }
      mm_rt<1>(af, zf, D); scale_rt<1>(D, rhg); frag_rt<1>(D, fa);
#pragma unroll
      for (int tl = 0; tl < 2; ++tl)
#pragma unroll
          for (int ks = 0; ks < 4; ++ks) *(bf16x8*)(rhfb + (tl * 4 + ks) * 1024) = fa[tl][ks]; }
    SUBM(5);
    img_load(gKb, s0, lane);
    rowfrag(s0, lane, fa);
    zero2(D); mm_rt<0>(fa, fb, D); mask_rt<0, false>(D, lane); frag_rt<0>(D, af);
    zero2(D); mm_rt<1>(fa, fb, D); mask_rt<1, false>(D, lane); frag_rt<1>(D, af);
    { unsigned char* ylfb = F.ws + WS_YL + (size_t)hc * 8192 + lane * 8;
      zero2(D); mm_rt<0>(zf, uf, D); mm_rt<0>(af, vf, D);
#pragma unroll
      for (int ct = 0; ct < 2; ++ct)
#pragma unroll
          for (int q = 0; q < 4; ++q) *(v2u*)(ylfb + ((0 * 2 + ct) * 4 + q) * 512) = (v2u){pk2(D[ct][4 * q], D[ct][4 * q + 1]), pk2(D[ct][4 * q + 2], D[ct][4 * q + 3])};
      zero2(D); mm_rt<1>(zf, uf, D); mm_rt<1>(af, vf, D);
#pragma unroll
      for (int ct = 0; ct < 2; ++ct)
#pragma unroll
          for (int q = 0; q < 4; ++q) *(v2u*)(ylfb + ((1 * 2 + ct) * 4 + q) * 512) = (v2u){pk2(D[ct][4 * q], D[ct][4 * q + 1]), pk2(D[ct][4 * q + 2], D[ct][4 * q + 3])}; }
    SUBM(6);
}
__device__ __forceinline__ void chain_unit(Frame& F, int gwv) {
    const int lane = F.lane, r32 = lane & 31, hi = lane >> 5, bh = gwv >> 1, ct = gwv & 1;
    const unsigned char* gpf = F.ws + WS_GP + (size_t)bh * NCHK * 8192 + lane * 16;
    const unsigned char* slf = F.ws + WS_SL + (size_t)bh * NCHK * 8192 + ct * 4096 + lane * 8;
    const float* gcl = (const float*)(F.ws + WS_GC) + (size_t)bh * NCHK * 64 + lane;
    unsigned char* xcf = F.ws + WS_XC + (size_t)bh * NCHK * 8192 + ct * 4096 + lane * 16;
    f32x16 X[2]; X[0] = (f32x16){}; X[1] = (f32x16){};
    v4u gA[8], gB[8], gC[8]; v2u sA[8], sB[8], sC[8]; float mA, mB, mC; const int hb = 16 * hi;
#define CH_LOAD(S) do { _Pragma("unroll") for (int k = 0; k < 8; ++k) { g##S[k] = *(const v4u*)(gpf + k * 1024); s##S[k] = *(const v2u*)(slf + k * 512); } m##S = *gcl; gpf += 8192; slf += 8192; gcl += 64; } while (0)
#define CH_STEP(S) do { bf16x8 xh[4]; \
        _Pragma("unroll") for (int rt = 0; rt < 2; ++rt) _Pragma("unroll") for (int hf = 0; hf < 2; ++hf) { const int rb = 8 * hf; \
            const v4u u = {pk2(X[rt][rb], X[rt][rb + 1]), pk2(X[rt][rb + 2], X[rt][rb + 3]), pk2(X[rt][rb + 4], X[rt][rb + 5]), pk2(X[rt][rb + 6], X[rt][rb + 7])}; \
            xh[2 * rt + hf] = __builtin_bit_cast(bf16x8, u); } \
        _Pragma("unroll") for (int ks = 0; ks < 4; ++ks) *(bf16x8*)(xcf + ks * 1024) = xh[ks]; \
        xcf += 8192; \
        _Pragma("unroll") for (int rt = 0; rt < 2; ++rt) _Pragma("unroll") for (int q = 0; q < 4; ++q) _Pragma("unroll") for (int e = 0; e < 4; ++e) { \
            const float gm_ = __builtin_bit_cast(float, __builtin_amdgcn_ds_bpermute(4 * (32 * rt + 8 * q + e) + hb, __builtin_bit_cast(int, m##S)));     \
            const unsigned sw_ = (e < 2) ? s##S[rt * 4 + q].x : s##S[rt * 4 + q].y; \
            X[rt][4 * q + e] = gm_ * X[rt][4 * q + e] + ((e & 1) ? bfhi(sw_) : bflo(sw_)); } \
        _Pragma("unroll") for (int rt = 0; rt < 2; ++rt) _Pragma("unroll") for (int ks = 0; ks < 4; ++ks) \
            X[rt] = __builtin_amdgcn_mfma_f32_32x32x16_bf16(__builtin_bit_cast(bf16x8, g##S[rt * 4 + ks]), xh[ks], X[rt], 0, 0, 0); } while (0)
    static_assert(NCHK % 3 == 1, "chain_unit: 21 x 3 steps + 1");
    CH_LOAD(A); CH_LOAD(B);
#pragma unroll 1
    for (int c = 0; c < NCHK - 1; c += 3) {
        CH_LOAD(C); CH_STEP(A);
        CH_LOAD(A); CH_STEP(B);
        if (c + 4 < NCHK) CH_LOAD(B);
        CH_STEP(C);
    }
    CH_STEP(A);
#undef CH_LOAD
#undef CH_STEP
    float* so = F.out + O_WP + (size_t)bh * 4096 + (32 * ct + r32) * 64 + 4 * hi;
#pragma unroll
    for (int rt = 0; rt < 2; ++rt)
#pragma unroll
        for (int r = 0; r < 16; ++r) so[32 * rt + CRC(r)] = X[rt][r];
}
__device__ __forceinline__ void ypass_unit(Frame& F, const Args& A, int hc) {
    const int lane = F.lane, r32 = lane & 31, hi = lane >> 5, bh = hc >> 6, c = hc & 63, h = bh & 7, row0 = (bh >> 3) * SEQ + c * 64;
    Frag fa, fb;
    { const unsigned char* xcf = F.ws + WS_XC + (size_t)hc * 8192 + lane * 16;
#pragma unroll
      for (int ct = 0; ct < 2; ++ct)
#pragma unroll
          for (int ks = 0; ks < 4; ++ks) fb[ct][ks] = *(const bf16x8*)(xcf + (ct * 4 + ks) * 1024); }
    { const unsigned char* rhf = F.ws + WS_RH + (size_t)hc * 8192 + lane * 16;
#pragma unroll
      for (int tl = 0; tl < 2; ++tl)
#pragma unroll
          for (int ks = 0; ks < 4; ++ks) fa[tl][ks] = *(const bf16x8*)(rhf + (tl * 4 + ks) * 1024); }
    f32x16 Y[2][2];
    { const unsigned char* ylf = F.ws + WS_YL + (size_t)hc * 8192 + lane * 8;
#pragma unroll
      for (int rt = 0; rt < 2; ++rt)
#pragma unroll
          for (int ct = 0; ct < 2; ++ct)
#pragma unroll
              for (int q = 0; q < 4; ++q) { const v2u v_ = *(const v2u*)(ylf + ((rt * 2 + ct) * 4 + q) * 512);
                  Y[rt][ct][4 * q] = bflo(v_.x); Y[rt][ct][4 * q + 1] = bfhi(v_.x); Y[rt][ct][4 * q + 2] = bflo(v_.y); Y[rt][ct][4 * q + 3] = bfhi(v_.y); } }
    const float* BON = (const float*)(F.ws + WS_BON3) + (size_t)(row0 + 4 * hi) * 32 + h * 4; bf16* RW = (bf16*)(F.ws + WS_RW) + (size_t)(row0 + 4 * hi) * 512 + h * 64 + r32;
    const unsigned* VG = rk_pair(F, 2) + (size_t)(row0 + 4 * hi) * 512 + h * 64 + r32;
    unsigned vg0[2][16], vg1[2][16]; float bon[2][16];
#pragma unroll
    for (int rt = 0; rt < 2; ++rt)
#pragma unroll
        for (int r = 0; r < 16; ++r) { vg0[rt][r] = VG[(32 * rt + CRC(r)) * 512]; vg1[rt][r] = VG[(32 * rt + CRC(r)) * 512 + 32]; bon[rt][r] = BON[(32 * rt + CRC(r)) * 32]; }
    float gw[2], gb[2];
#pragma unroll
    for (int ct = 0; ct < 2; ++ct) { gw[ct] = A.in[I_GNW][h * 64 + 32 * ct + r32]; gb[ct] = A.in[I_GNB][h * 64 + 32 * ct + r32]; }
    mm64(fa, fb, Y);
#pragma unroll
    for (int rt = 0; rt < 2; ++rt)
#pragma unroll
        for (int r = 0; r < 16; ++r) {
            const float y0 = Y[rt][0][r], y1 = Y[rt][1][r];
            const float mean = sum32(y0 + y1) * (1.f / 64.f), e0 = y0 - mean, e1 = y1 - mean;
            const float rstd = rsqrtf(sum32(e0 * e0 + e1 * e1) * (1.f / 64.f) + 64e-5f);
            const unsigned a0 = vg0[rt][r], a1 = vg1[rt][r];
            const float o0 = (e0 * rstd * gw[0] + gb[0] + bon[rt][r] * bflo(a0)) * bfhi(a0), o1 = (e1 * rstd * gw[1] + gb[1] + bon[rt][r] * bflo(a1)) * bfhi(a1);
            RW[(32 * rt + CRC(r)) * 512] = (bf16)(pk2(o0, 0.f) & 0xffffu); RW[(32 * rt + CRC(r)) * 512 + 32] = (bf16)(pk2(o1, 0.f) & 0xffffu);
        }
}

constexpr int DP_STRIDE = 260;
__device__ __forceinline__ float half_sum32(float v) { v += __shfl_xor(v, 1); v += __shfl_xor(v, 2); v += __shfl_xor(v, 4); v += __shfl_xor(v, 8); v += __shfl_xor(v, 16); return v; }
__device__ __forceinline__ float sum16(float v) {
    v += __builtin_bit_cast(float, __builtin_amdgcn_update_dpp(0, __builtin_bit_cast(int, v), 0xB1, 0xF, 0xF, true));
    v += __builtin_bit_cast(float, __builtin_amdgcn_update_dpp(0, __builtin_bit_cast(int, v), 0x4E, 0xF, 0xF, true));
    v += __builtin_bit_cast(float, __builtin_amdgcn_update_dpp(0, __builtin_bit_cast(int, v), 0x141, 0xF, 0xF, true));
    v += dpp_rmir(v);
    return v;
}
__device__ __forceinline__ void glds16(const void* gsrc, unsigned lds_dst) { unsigned keep;
    asm volatile("s_mov_b32 %0, m0\n\ts_mov_b32 m0, %2\n\ts_nop 0\n\tglobal_load_lds_dwordx4 %1, off\n\ts_mov_b32 m0, %0" : "=&s"(keep) : "v"(gsrc), "s"(lds_dst) : "memory"); }
struct LdsRows { const LAS unsigned char* b; __device__ __forceinline__ f32x4 operator[](int j) const { return *(const LAS f32x4*)(b + j * 1024); } };
__device__ __forceinline__ void decode_unit(Frame& F, const Args& A, int unit) {
    const int seq = unit >> 5, h = F.wave & 3, lane = F.lane, w = F.wave, d4 = lane & 31, tk = lane >> 5;
    const bf16* QB = (const bf16*)(F.ws + WS_QB);
    const v2u qw = *(const v2u*)(QB + (size_t)(MP + seq) * 512 + h * 128 + 4 * d4);
    const f32x4 q4 = {bflo(qw.x), bfhi(qw.x), bflo(qw.y), bfhi(qw.y)};
    const float slope = exp2f(-2.f * (float)(h + 1)) * 1.4426950408889634f;
    const int pi = (unit & 31) * 2 + (w >> 2), page = ((const int*)A.in[I_PT])[seq * NPAGES + pi];
    const float* kp = A.in[I_CK] + ((size_t)page * PAGE * 4 + h) * 128 + (size_t)tk * 512 + 4 * d4;
    const float* vp = A.in[I_CV] + ((size_t)page * PAGE * 4 + h) * 128 + (size_t)tk * 512 + 4 * d4;
    float m0 = -INFINITY, l0 = 0.f, m1 = -INFINITY, l1 = 0.f; f32x4 o0 = {0.f, 0.f, 0.f, 0.f}, o1 = o0;
    const bool c0 = d4 < 16;
    constexpr int DNB = 8;
    f32x4 kA[DNB], vA[DNB], kB[DNB], vB[DNB];
#define DEC_LOAD(KX, VX, p_) do { _Pragma("unroll") for (int j = 0; j < DNB; ++j) { KX[j] = __builtin_nontemporal_load((const f32x4*)(kp + (size_t)((p_) + j) * 1024)); VX[j] = __builtin_nontemporal_load((const f32x4*)(vp + (size_t)((p_) + j) * 1024)); } } while (0)
#define DEC_COMP(KX, VX, p_) do { float s0[DNB], s1[DNB], mx0 = m0, mx1 = m1; \
        _Pragma("unroll") for (int j = 0; j < DNB; ++j) { const f32x4 kq = KX[j] * q4; \
            const float s = sum16((kq[0] + kq[1]) + (kq[2] + kq[3])) + slope * (float)(pi * PAGE + 2 * ((p_) + j) + tk - PAST), so = __shfl_xor(s, 16); \
            s0[j] = c0 ? s : so; s1[j] = c0 ? so : s; mx0 = fmaxf(mx0, s0[j]); mx1 = fmaxf(mx1, s1[j]); } \
        const float a0 = __builtin_amdgcn_exp2f(m0 - mx0), a1 = __builtin_amdgcn_exp2f(m1 - mx1); \
        l0 *= a0; l1 *= a1; o0 *= a0; o1 *= a1; m0 = mx0; m1 = mx1; \
        _Pragma("unroll") for (int j = 0; j < DNB; ++j) { const float e0 = __builtin_amdgcn_exp2f(s0[j] - m0), e1 = __builtin_amdgcn_exp2f(s1[j] - m1); l0 += e0; l1 += e1; o0 += e0 * VX[j]; o1 += e1 * VX[j]; } } while (0)
    DEC_LOAD(kA, vA, 0);
    for (int p0 = 0; p0 < PAGE / 2; p0 += 2 * DNB) {
        DEC_LOAD(kB, vB, p0 + DNB);
        DEC_COMP(kA, vA, p0);
        if (p0 + 2 * DNB < PAGE / 2) DEC_LOAD(kA, vA, p0 + 2 * DNB);
        DEC_COMP(kB, vB, p0 + DNB);
    }
#undef DEC_LOAD
#undef DEC_COMP
#define SWP(x) __uint_as_float(__builtin_amdgcn_permlane32_swap(__float_as_uint(x), __float_as_uint(x), false, false)[tk ? 0 : 1])
    { const float mb0 = SWP(m0), lb0 = SWP(l0), mb1 = SWP(m1), lb1 = SWP(l1);
      const float M0 = fmaxf(m0, mb0), M1 = fmaxf(m1, mb1);
      const float fa0 = __builtin_amdgcn_exp2f(m0 - M0), fb0 = __builtin_amdgcn_exp2f(mb0 - M0), fa1 = __builtin_amdgcn_exp2f(m1 - M1), fb1 = __builtin_amdgcn_exp2f(mb1 - M1);
      f32x4 r0, r1;
#pragma unroll
      for (int j = 0; j < 4; ++j) { const float ob0 = SWP(o0[j]), ob1 = SWP(o1[j]); r0[j] = o0[j] * fa0 + ob0 * fb0; r1[j] = o1[j] * fa1 + ob1 * fb1; }
      float* dp = (float*)(F.ws + WS_DP2) + (size_t)((seq * 4 + h) * NPAGES + pi) * DP_STRIDE;
      if (lane == 0) *(f32x4*)dp = (f32x4){M0, l0 * fa0 + lb0 * fb0, M1, l1 * fa1 + lb1 * fb1};
      if (tk == 0) { *(f32x4*)(dp + 4 + 4 * d4) = r0; *(f32x4*)(dp + 132 + 4 * d4) = r1; } }
#undef SWP
}
__device__ __forceinline__ void decode_combine(Frame& F, const Args& A, int sh, float lam) {
    const int seq = sh >> 2, h = sh & 3, lane = F.lane, w = F.wave; const size_t ro = (size_t)(MP + seq) * 512 + h * 128 + 2 * lane;
    const float* dp = (const float*)(F.ws + WS_DP2) + (size_t)(sh * NPAGES) * DP_STRIDE;
    const float* dpo = dp + 4 + 2 * lane + (size_t)(8 * w) * DP_STRIDE;
    const unsigned qw = *(const unsigned*)((const bf16*)(F.ws + WS_QB) + ro), kw = *(const unsigned*)((const bf16*)(F.ws + WS_KB) + ro), vw = *(const unsigned*)((const bf16*)(F.ws + WS_VB) + ro);
    const f32x4 ml = *(const f32x4*)(dp + (size_t)lane * DP_STRIDE);
    f32x2 o0[8], o1[8];
#pragma unroll
    for (int i = 0; i < 8; ++i) { o0[i] = *(const f32x2*)(dpo + (size_t)i * DP_STRIDE); o1[i] = *(const f32x2*)(dpo + (size_t)i * DP_STRIDE + 128); }
    const float s = half_sum32(bflo(qw) * bflo(kw) + bfhi(qw) * bfhi(kw)), so = __shfl_xor(s, 32);
    const float sn0 = lane < 32 ? s : so, sn1 = lane < 32 ? so : s;
    float mx0 = ml[0], mx1 = ml[2];
#pragma unroll
    for (int o = 1; o < 64; o <<= 1) { mx0 = fmaxf(mx0, __shfl_xor(mx0, o)); mx1 = fmaxf(mx1, __shfl_xor(mx1, o)); }
    const float M0 = fmaxf(mx0, sn0), M1 = fmaxf(mx1, sn1);
    const float e0 = exp2f(sn0 - M0), e1 = exp2f(sn1 - M1), f0 = exp2f(ml[0] - M0), f1 = exp2f(ml[2] - M1);
    const float L0 = e0 + wave_sum(f0 * ml[1]), L1 = e1 + wave_sum(f1 * ml[3]);
    f32x2 a = {0.f, 0.f}, b = {0.f, 0.f};
#pragma unroll
    for (int i = 0; i < 8; ++i) {
        const float g0 = __builtin_bit_cast(float, __builtin_amdgcn_readlane(__builtin_bit_cast(int, f0), 8 * w + i)), g1 = __builtin_bit_cast(float, __builtin_amdgcn_readlane(__builtin_bit_cast(int, f1), 8 * w + i));
        a.x += g0 * o0[i].x; a.y += g0 * o0[i].y; b.x += g1 * o1[i].x; b.y += g1 * o1[i].y; }
    LAS f32x4* red = (LAS f32x4*)(F.lds + RING_OFF);
    red[w * 64 + lane] = (f32x4){a.x, a.y, b.x, b.y};
    __syncthreads();
    if (w != 0) return;
    a = (f32x2){e0 * bflo(vw), e0 * bfhi(vw)}; b = (f32x2){e1 * bflo(vw), e1 * bfhi(vw)};
#pragma unroll
    for (int i = 0; i < 8; ++i) { const f32x4 t = red[i * 64 + lane]; a.x += t[0]; a.y += t[1]; b.x += t[2]; b.y += t[3]; }
    const float i0 = 1.f / L0, i1 = 1.f / L1;
    const float ox = a.x * i0 - lam * b.x * i1, oy = a.y * i0 - lam * b.y * i1;
    const float rn = rsqrtf(wave_sum(ox * ox + oy * oy) * (1.f / 128.f) + 1e-6f) * 0.8f;
    const float* aog = A.in[I_AOG];
    *(unsigned*)((bf16*)(F.ws + WS_ON) + ro) = pk2(ox * rn * aog[2 * lane], oy * rn * aog[2 * lane + 1]);
}

__device__ __forceinline__ void attn_naive_row(Frame& F, const Args& A, int row, int h, float lam) {
    const int lane = F.lane, t = row & (SEQ - 1), rb = row - t;
    const bf16* QB = (const bf16*)(F.ws + WS_QB); const bf16* KB = (const bf16*)(F.ws + WS_KB); const bf16* VB = (const bf16*)(F.ws + WS_VB);
    const float slope = exp2f(-2.f * (float)(h + 1)) * 1.4426950408889634f;
    float res[2][2];
    for (int c = 0; c < 2; ++c) {
        float q[64];
#pragma unroll
        for (int d = 0; d < 64; d += 2) { const unsigned w = *(const unsigned*)(QB + (size_t)row * 512 + h * 128 + c * 64 + d); q[d] = bflo(w); q[d + 1] = bfhi(w); }
        float m = -INFINITY, l = 0.f, o[128];
#pragma unroll
        for (int d = 0; d < 128; ++d) o[d] = 0.f;
        for (int j = lane; j <= t; j += 64) {
            const bf16* kr = KB + (size_t)(rb + j) * 512 + h * 128 + c * 64; const bf16* vr = VB + (size_t)(rb + j) * 512 + h * 128;
            float s = 0.f;
#pragma unroll
            for (int d = 0; d < 64; d += 8) { const v4u w = *(const v4u*)(kr + d);
                s += q[d] * bflo(w.x) + q[d + 1] * bfhi(w.x) + q[d + 2] * bflo(w.y) + q[d + 3] * bfhi(w.y) + q[d + 4] * bflo(w.z) + q[d + 5] * bfhi(w.z) + q[d + 6] * bflo(w.w) + q[d + 7] * bfhi(w.w); }
            s += slope * (float)(j - t);
            const float mn = fmaxf(m, s), al = exp2f(m - mn), e = exp2f(s - mn);
            l = l * al + e; m = mn;
#pragma unroll
            for (int d = 0; d < 128; d += 8) { const v4u w = *(const v4u*)(vr + d);
                o[d] = o[d] * al + e * bflo(w.x); o[d + 1] = o[d + 1] * al + e * bfhi(w.x); o[d + 2] = o[d + 2] * al + e * bflo(w.y); o[d + 3] = o[d + 3] * al + e * bfhi(w.y);
                o[d + 4] = o[d + 4] * al + e * bflo(w.z); o[d + 5] = o[d + 5] * al + e * bfhi(w.z); o[d + 6] = o[d + 6] * al + e * bflo(w.w); o[d + 7] = o[d + 7] * al + e * bfhi(w.w); }
        }
        float M = m;
#pragma unroll
        for (int x = 1; x < 64; x <<= 1) M = fmaxf(M, __shfl_xor(M, x));
        const float sc = exp2f(m - M);
        const float L = wave_sum(l * sc);
        float r0 = 0.f, r1 = 0.f;
#pragma unroll
        for (int d = 0; d < 128; ++d) { const float tot = wave_sum(o[d] * sc); if ((d & 63) == lane) { if (d < 64) r0 = tot; else r1 = tot; } }
        res[c][0] = r0 / L; res[c][1] = r1 / L;
    }
    const float ox = res[0][0] - lam * res[1][0], oy = res[0][1] - lam * res[1][1];
    const float rn = rsqrtf(wave_sum(ox * ox + oy * oy) * (1.f / 128.f) + 1e-6f) * 0.8f;
    const float* aog = A.in[I_AOG]; bf16* ON = (bf16*)(F.ws + WS_ON) + (size_t)row * 512 + h * 128;
    ON[lane] = (bf16)(pk2(ox * rn * aog[lane], 0.f) & 0xffffu); ON[64 + lane] = (bf16)(pk2(oy * rn * aog[64 + lane], 0.f) & 0xffffu);
}


__device__ __forceinline__ unsigned bfbits(float f) { return __builtin_bit_cast(unsigned, f) >> 16; }
__device__ __forceinline__ void attn_unit(Frame& F, const Args& A, int b, int h, int qb, float lam) {
    LAS unsigned char* Kt = F.lds + RING_OFF;
    LAS float* wsf = (LAS float*)(Kt + 98304) + F.wave * 64;
    LAS float* xch = (LAS float*)Kt;
    const bf16* QB = (const bf16*)(F.ws + WS_QB); const bf16* KB = (const bf16*)(F.ws + WS_KB); const bf16* VB = (const bf16*)(F.ws + WS_VB);
    const int tid = F.tid, lane = F.lane, w = F.wave, c = w >> 2, wq = w & 3, r32 = lane & 31, hi = lane >> 5;
    const int rowbase = b * SEQ, q0 = 128 * qb + 32 * wq, NT = 2 * (qb + 1);
    bf16x8 qr[4];
    { const bf16* Qp = QB + (size_t)(rowbase + q0 + r32) * 512 + (2 * h + c) * 64 + 8 * hi;
#pragma unroll
      for (int d0 = 0; d0 < 4; ++d0) qr[d0] = *(const bf16x8*)(Qp + 16 * d0); }
    asm volatile("" : "+v"(qr[0]), "+v"(qr[1]), "+v"(qr[2]), "+v"(qr[3]));
    const float sl = exp2f(-2.f * (float)(h + 1)) * 1.4426950408889634f;
    const unsigned c1 = __builtin_bit_cast(unsigned, sl) & 0xffff0000u; const float r1 = sl - __builtin_bit_cast(float, c1);
    const unsigned c2 = __builtin_bit_cast(unsigned, r1) & 0xffff0000u; const float r2 = r1 - __builtin_bit_cast(float, c2);
    const unsigned c3 = __builtin_bit_cast(unsigned, r2) & 0xffff0000u;
    const unsigned b1 = c1 >> 16, b2 = c2 >> 16, b3 = c3 >> 16, lo_mask = hi ? 0u : 0xffffffffu;
    const v4u qextu = {(b1 | (b2 << 16)) & lo_mask, (b3 | (b1 << 16)) & lo_mask, (b2 | (b3 << 16)) & lo_mask, 0u};
    const bf16x8 qext = __builtin_bit_cast(bf16x8, qextu);
    const unsigned J0 = bfbits((float)r32), J1 = bfbits((float)(32 + r32));
    const unsigned lds0 = (unsigned)(uintptr_t)(F.lds + RING_OFF);
    const bf16* kg0 = KB + (size_t)(rowbase + lane) * 512 + h * 128 + (2 * w) * 8;
    const bf16* vg0 = VB + (size_t)(rowbase + 32 * (w & 1) + (lane >> 2)) * 512 + h * 128 + (w >> 1) * 32 + (lane & 3) * 8;
    const unsigned kd0 = lds0 + (2 * w) * 1024, vd0 = lds0 + 16384 + (w >> 1) * 4096 + (2 * (w & 1)) * 1024;
#define ATT_DMA(t_, boff_) do { const size_t go_ = (size_t)(t_) * 64 * 512; const unsigned bo_ = (unsigned)(boff_); \
        glds16(kg0 + go_, (unsigned)__builtin_amdgcn_readfirstlane(kd0 + bo_)); glds16(kg0 + go_ + 8, (unsigned)__builtin_amdgcn_readfirstlane(kd0 + bo_ + 1024)); \
        glds16(vg0 + go_, (unsigned)__builtin_amdgcn_readfirstlane(vd0 + bo_)); glds16(vg0 + go_ + (size_t)16 * 512, (unsigned)__builtin_amdgcn_readfirstlane(vd0 + bo_ + 1024)); } while (0)
    ATT_DMA(NT - 1, 0);
    f32x16 o[4];
#pragma unroll
    for (int i = 0; i < 4; ++i) o[i] = (f32x16){};
    float m = -INFINITY, l = 0.f;
    bf16x8 pa[4];
    asm volatile("s_waitcnt vmcnt(0) lgkmcnt(0)\n\ts_barrier" ::: "memory");
#define ATT_QKSM(t, bo) do { \
        const LAS unsigned char* kfp = Kt + (bo) + (c * 8 + hi) * 1024 + r32 * 16; \
        const unsigned Tb = bfbits((float)(64 * (t) - 128 * qb)); \
        f32x16 p[2]; bf16x8 kfr[2][4]; \
        _Pragma("unroll") for (int half = 0; half < 2; ++half) _Pragma("unroll") for (int d0 = 0; d0 < 4; ++d0) kfr[half][d0] = *(const LAS bf16x8*)(kfp + d0 * 2048 + half * 512); \
        __builtin_amdgcn_sched_barrier(0); \
        _Pragma("unroll") for (int half = 0; half < 2; ++half) { f32x16 acc = (f32x16){}; \
            _Pragma("unroll") for (int d0 = 0; d0 < 4; ++d0) acc = __builtin_amdgcn_mfma_f32_32x32x16_bf16(kfr[half][d0], qr[d0], acc, 0, 0, 0); \
            const unsigned Jb = half ? J1 : J0; \
            const v4u ke = {(Tb | (Tb << 16)) & lo_mask, (Tb | (Jb << 16)) & lo_mask, (Jb | (Jb << 16)) & lo_mask, 0u}; \
            p[half] = __builtin_amdgcn_mfma_f32_32x32x16_bf16(__builtin_bit_cast(bf16x8, ke), qext, acc, 0, 0, 0); } \
        if (64 * (t) + 63 > q0) { const int qpos = q0 + r32; \
            _Pragma("unroll") for (int half = 0; half < 2; ++half) _Pragma("unroll") for (int r = 0; r < 16; ++r) { const int kv = 64 * (t) + 32 * half + crow16(r, hi); if (kv > qpos) p[half][r] = -INFINITY; } } \
        float mx = p[0][0]; \
        _Pragma("unroll") for (int r = 1; r < 16; ++r) mx = fmaxf(mx, p[0][r]); \
        _Pragma("unroll") for (int r = 0; r < 16; ++r) mx = fmaxf(mx, p[1][r]); \
        { const auto rr = __builtin_amdgcn_permlane32_swap(__float_as_uint(mx), __float_as_uint(mx), false, false); mx = fmaxf(__uint_as_float(rr[0]), __uint_as_float(rr[1])); } \
        const float mn = fmaxf(m, mx), alpha = __builtin_amdgcn_exp2f(m - mn); m = mn; \
        float ls = 0.f; \
        _Pragma("unroll") for (int half = 0; half < 2; ++half) _Pragma("unroll") for (int r = 0; r < 16; ++r) { const float e = __builtin_amdgcn_exp2f(p[half][r] - mn); p[half][r] = e; ls += e; } \
        { const auto rr = __builtin_amdgcn_permlane32_swap(__float_as_uint(ls), __float_as_uint(ls), false, false); ls = __uint_as_float(rr[0]) + __uint_as_float(rr[1]); } \
        l = l * alpha + ls; \
        if (__any(alpha != 1.f)) { if (hi == 0) wsf[r32] = alpha; LDS_WAIT(); \
            _Pragma("unroll") for (int r = 0; r < 16; ++r) { const float f = wsf[crow16(r, hi)]; _Pragma("unroll") for (int blk = 0; blk < 4; ++blk) o[blk][r] *= f; } } \
        _Pragma("unroll") for (int s = 0; s < 4; ++s) { const int hf = s >> 1, rb = 8 * (s & 1); \
            const v4u u = {pk2(p[hf][rb], p[hf][rb + 1]), pk2(p[hf][rb + 2], p[hf][rb + 3]), pk2(p[hf][rb + 4], p[hf][rb + 5]), pk2(p[hf][rb + 6], p[hf][rb + 7])}; \
            pa[s] = __builtin_bit_cast(bf16x8, u); } } while (0)
#define ATT_PV(bo) do { \
        const LAS unsigned char* vfp = Kt + (bo) + 16384 + ((lane >> 4) & 1) * 32 + (lane & 3) * 8 + (4 * hi + ((lane & 15) >> 2)) * 64; \
        s16x4 vlo[2][4], vhi[2][4]; \
        _Pragma("unroll") for (int s = 0; s < 4; ++s) { vlo[0][s] = vtr(vfp + s * 1024); vhi[0][s] = vtr(vfp + s * 1024 + 512); } \
        _Pragma("unroll") for (int blk = 0; blk < 4; ++blk) { \
            if (blk < 3) { _Pragma("unroll") for (int s = 0; s < 4; ++s) { vlo[(blk + 1) & 1][s] = vtr(vfp + (blk + 1) * 4096 + s * 1024); vhi[(blk + 1) & 1][s] = vtr(vfp + (blk + 1) * 4096 + s * 1024 + 512); } } \
            __builtin_amdgcn_sched_barrier(0); \
            _Pragma("unroll") for (int s = 0; s < 4; ++s) { const s16x4 lo = vlo[blk & 1][s], hh = vhi[blk & 1][s]; \
                const bf16x8 vf = {lo[0], lo[1], lo[2], lo[3], hh[0], hh[1], hh[2], hh[3]}; \
                o[blk] = __builtin_amdgcn_mfma_f32_32x32x16_bf16(pa[s], vf, o[blk], 0, 0, 0); } \
            __builtin_amdgcn_sched_barrier(0); } } while (0)
    bool pend = false; int pbo = 0, bo = 0;
    for (int it = 0; it <= NT; ++it) {
        const int t = NT - 1 - it, bn = (bo == 65536) ? 0 : bo + 32768;
        if (it + 1 < NT) ATT_DMA(t - 1, bn);
        const bool act = it < NT && 64 * t <= q0 + 31;
        if (c == 1 && pend) ATT_PV(pbo);
        if (act) ATT_QKSM(t, bo);
        if (c == 0 && act) ATT_PV(bo);
        if (c == 1) { pend = act; pbo = bo; }
        asm volatile("s_waitcnt vmcnt(0) lgkmcnt(0)\n\ts_barrier" ::: "memory");
        bo = bn;
    }
#undef ATT_QKSM
#undef ATT_PV
#undef ATT_DMA
    if (hi == 0) wsf[r32] = 1.f / l;
    LDS_WAIT();
#pragma unroll
    for (int r = 0; r < 16; ++r) { const float f = wsf[crow16(r, hi)];
#pragma unroll
        for (int blk = 0; blk < 4; ++blk) o[blk][r] *= f; }
    LAS float* xw = xch + wq * 4096;
    if (c == 1) {
#pragma unroll
        for (int blk = 0; blk < 4; ++blk)
#pragma unroll
            for (int r = 0; r < 16; ++r) xw[(blk * 16 + r) * 64 + lane] = o[blk][r];
    }
    __syncthreads();
    if (c == 0) {
        const float* aog = A.in[I_AOG]; bf16* ON = (bf16*)(F.ws + WS_ON);
        float g[4];
#pragma unroll
        for (int blk = 0; blk < 4; ++blk) g[blk] = aog[32 * blk + r32] * 0.8f;
#pragma unroll
        for (int r = 0; r < 16; ++r) {
            float v[4], ss = 0.f;
#pragma unroll
            for (int blk = 0; blk < 4; ++blk) { v[blk] = o[blk][r] - lam * xw[(blk * 16 + r) * 64 + lane]; ss += v[blk] * v[blk]; }
            ss += __shfl_xor(ss, 1); ss += __shfl_xor(ss, 2); ss += __shfl_xor(ss, 4); ss += __shfl_xor(ss, 8); ss += __shfl_xor(ss, 16);
            const float rn = rsqrtf(ss * (1.f / 128.f) + 1e-6f);
            bf16* op = ON + (size_t)(rowbase + q0 + crow16(r, hi)) * 512 + h * 128 + r32;
#pragma unroll
            for (int blk = 0; blk < 4; ++blk) op[32 * blk] = (bf16)(pk2(v[blk] * rn * g[blk], 0.f) & 0xffffu);
        }
    }
    __syncthreads();
}

__device__ __forceinline__ void skinny_tile(Frame& F, LAS float* red, const bf16* A, int lda, const bf16* Bt, int K, int n0) {
    const int lane = F.lane, r = lane & 31, hi = lane >> 5, w = F.wave, kw = K / 8;
    const bf16* ap = A + (size_t)r * lda + w * kw + 8 * hi; const bf16* bp = Bt + (size_t)(n0 + r) * K + w * kw + 8 * hi;
    f32x16 acc = {};
    const int nst = kw / 16;
    for (int s0 = 0; s0 < nst; s0 += 8) {
        bf16x8 av[8], bv[8];
#pragma unroll
        for (int j = 0; j < 8; ++j) { const int k = (s0 + j < nst ? s0 + j : nst - 1) * 16; av[j] = *(const bf16x8*)(ap + k); bv[j] = *(const bf16x8*)(bp + k); }
#pragma unroll
        for (int j = 0; j < 8; ++j) if (s0 + j < nst) acc = __builtin_amdgcn_mfma_f32_32x32x16_bf16(av[j], bv[j], acc, 0, 0, 0);
    }
    __syncthreads();
#pragma unroll
    for (int i = 0; i < 16; ++i) red[w * 1024 + i * 64 + lane] = acc[i];
    __syncthreads();
    for (int e = F.tid; e < 1024; e += 512) { float s = 0.f;
#pragma unroll
        for (int j = 0; j < 8; ++j) s += red[j * 1024 + e];
        red[8 * 1024 + e] = s; }
    __syncthreads();
}

#ifndef MK_N_LAUNCHES
#define MK_N_LAUNCHES 1
#endif
#ifndef MK_NAIVE_ATTN
#define MK_NAIVE_ATTN 0
#endif
constexpr int N_PHASES = 10;
__global__ void __launch_bounds__(NWAVES * 64, 2) mk_fwd(Args args) {
    extern __shared__ __attribute__((aligned(16))) unsigned char lds[];
    Frame F;
#ifdef MK_SUB
    F.pa = 0ull; F.pb = 0ull;
#endif
    F.lds = (LAS unsigned char*)lds;
    F.MISC = (volatile LAS unsigned*)(F.lds + MISC_OFF);
    F.tid = threadIdx.x; F.lane = F.tid & 63; F.wave = __builtin_amdgcn_readfirstlane(F.tid >> 6);
    F.G = gridDim.x; { const int bx = blockIdx.x; F.vcu = (F.G % 8 == 0) ? (bx % 8) * (F.G / 8) + bx / 8 : bx; }
    F.ws = args.ws; F.out = args.out; F.ctl = (gu32*)(args.ws + WS_CTL);
    const Args& A = args;
    for (int u = F.tid; u < (LDS_BYTES - LDSCTL_OFF) / 4; u += NWAVES * 64) ((LAS unsigned*)(F.lds + LDSCTL_OFF))[u] = 0u;
    __syncthreads();
    XcdBarrier bar; bar.bar = (unsigned*)(F.ctl + CW_BAR); bar.x = 0; bar.st = nullptr;
    if (MK_N_LAUNCHES == 1) bar = xcd_barrier_post((unsigned*)(F.ctl + CW_BAR), F.MISC + 8);
#define GRID_BAR() do { if (MK_N_LAUNCHES == 1) xcd_barrier(bar); } while (0)
    const int lo = args.ph_lo, hi = args.ph_hi;
#ifndef MK_PROF
#define MK_PROF -1
#endif
#ifndef MK_PROF_SCALE
#define MK_PROF_SCALE 1e-5f
#endif
    unsigned long long prof_a = 0ull, prof_b = 0ull;
#define PH_BEGIN(k) do { if (MK_PROF == (k)) prof_a = __builtin_amdgcn_s_memrealtime(); } while (0)
#define PH_END(k) do { if (MK_PROF == (k)) prof_b = __builtin_amdgcn_s_memrealtime(); } while (0)
#ifndef MK_DBG_STOP
#define MK_DBG_STOP 99
#endif
#define IN(k) (lo <= (k) && (k) < hi && (k) <= MK_DBG_STOP)
#define BOTH(k) (IN(k) && IN((k) + 1))
    bf16* XB = (bf16*)(F.ws + WS_XB); float* rs0 = (float*)(F.ws + WS_RS0);
    bf16* QB = (bf16*)(F.ws + WS_QB); bf16* KB = (bf16*)(F.ws + WS_KB); bf16* VB = (bf16*)(F.ws + WS_VB); bf16* PC = (bf16*)(F.ws + WS_PC); bf16* GT = (bf16*)(F.ws + WS_GT);
    bf16* ON = (bf16*)(F.ws + WS_ON); bf16* RW = (bf16*)(F.ws + WS_RW); bf16* MG = (bf16*)(F.ws + WS_MG); bf16* X1B = (bf16*)(F.ws + WS_X1B); bf16* HB = (bf16*)(F.ws + WS_HB);
    float* ssq = (float*)(F.ctl + CW_SSQ);
    const int bx = (int)blockIdx.x;

    PH_BEGIN(0);
    if (IN(0)) { for (int i = bx * 512 + F.tid; i < MTOT; i += F.G * 512) ssq[i] = 0.f;
        p0_prologue<0>(F, A, F.vcu * NWAVES + F.wave, F.G * NWAVES); if (BOTH(0)) GRID_BAR(); PH_END(0); }
    PH_BEGIN(1);
    if (IN(1)) {
        pg8::Gemm g{XB, (const bf16*)(F.ws + WS_WIN), nullptr, nullptr, MTOT, INW, DM}; pg8::StaticOrder S; S.init(MTOT, INW, F.G, bx);
        pg8::EpiProj E{rs0, A.in[I_QG], A.in[I_KG], QB, KB, VB, PC, GT, F.out};
        pg8::gemm_phase<pg8::EpiProj, pg8::StaticOrder, true, true>(F.lds + RING_OFF, g, S, E);
        { const int nlong = ((MTOT / 256 + (MTOT % 256 != 0)) * (INW / 256)) % F.G;
          if (nlong == 0) p0_prologue<1>(F, A, bx * NWAVES + F.wave, F.G * NWAVES);
          else if (bx >= nlong) p0_prologue<1>(F, A, (bx - nlong) * NWAVES + F.wave, (F.G - nlong) * NWAVES);
          __syncthreads(); }
        if (BOTH(1)) GRID_BAR(); PH_END(1);
    }
    PH_BEGIN(2);
    if (IN(2)) {
        SUBM(30);
        {
            const int grp = (bx + 2 * F.G >= MP / 32) ? bx % 3 : -1;
            int u = bx;
#pragma unroll 1
            for (int st = 0; ; ++st) {
                if (st == grp) {
                    LAS unsigned* qslot = (LAS unsigned*)(F.lds + LDSCTL_OFF);
                    if (F.tid == 0) qslot[0] = __hip_atomic_fetch_add((unsigned*)(F.ctl + CW_QDEC), 1u, __ATOMIC_RELAXED, __HIP_MEMORY_SCOPE_AGENT);
                    __syncthreads();
                    const unsigned k = qslot[0];
                    __syncthreads();
                    if (k < 1024u) decode_unit(F, A, (int)k);
                    __syncthreads();
                } else if (u < MP / 32) { rwkv_prep_unit(F, A, u); u += F.G; }
                else break;
            }
        }
        SUBM(31);
        SUBM(32);
        if (BOTH(2)) GRID_BAR(); PH_END(2);
    }
    PH_BEGIN(3);
    if (IN(3)) {
        SUBM(10);
        SUBM(11);
        for (int hc = bx * NWAVES + F.wave; hc < 32 * NCHK; hc += F.G * NWAVES) chunk_unit(F, hc);
        __syncthreads();
        if (BOTH(3)) GRID_BAR(); PH_END(3);
    }
    PH_BEGIN(4);
    if (IN(4)) {
        { int ln_ = F.lane, td_ = F.tid; asm volatile("" : "+v"(ln_), "+v"(td_)); F.lane = ln_; F.tid = td_; }
        SUBM(50);
        if (bx < 8) { chain_unit(F, bx * NWAVES + F.wave); __syncthreads(); }
        SUBM(51);
        const float lam = lam_value(F, A);
        LAS unsigned* qslot = (LAS unsigned*)(F.lds + LDSCTL_OFF);
        const unsigned dtail = __hip_atomic_load((unsigned*)(F.ctl + CW_QDEC), __ATOMIC_RELAXED, __HIP_MEMORY_SCOPE_AGENT) < 1024u ? __hip_atomic_load((unsigned*)(F.ctl + CW_QDEC), __ATOMIC_RELAXED, __HIP_MEMORY_SCOPE_AGENT) : 1024u;
        for (;;) {
            { int ln_ = F.lane, td_ = F.tid; asm volatile("" : "+v"(ln_), "+v"(td_)); F.lane = ln_; F.tid = td_; }
            if (F.tid == 0) qslot[0] = __hip_atomic_fetch_add((unsigned*)(F.ctl + CW_QUEUE), 1u, __ATOMIC_RELAXED, __HIP_MEMORY_SCOPE_AGENT);
            __syncthreads();
            const unsigned k = qslot[0];
            __syncthreads();
            if (k >= 1537u) break;
            if (k == 0u) { rwkv_prep_unit(F, A, MP / 32); continue; }
            const unsigned tr = (k - 1u) / 3u, r = (k - 1u) - 3u * tr;
#ifdef MK_SUB
            const unsigned long long t0_ = __builtin_amdgcn_s_memrealtime();
#endif
            if (r == 0u) attn_unit(F, A, (int)(tr & 15u) >> 2, (int)(tr & 3u), 31 - (int)(tr >> 4), lam);
            else { const unsigned d = dtail + 2u * tr + r - 1u; if (d < 1024u) decode_unit(F, A, (int)d); }
#ifdef MK_SUB
            if ((MK_SUB == 40 && r == 0u) || (MK_SUB == 41 && r != 0u)) F.pb += __builtin_amdgcn_s_memrealtime() - t0_;
#endif
        }
        if (BOTH(4)) GRID_BAR(); PH_END(4);
    }
    PH_BEGIN(5);
    if (IN(5)) {
        SUBM(20);
        { const float lam = lam_value(F, A);
          for (int it = bx; it < 128; it += F.G) { decode_combine(F, A, it, lam); if (it + F.G < 128) __syncthreads(); } }
        __syncthreads();
        for (int u = 256 + bx; u < 512; u += F.G) scan_seg_unit(F, A, u);
        SUBM(21);
        for (int hc = bx * NWAVES + F.wave; hc < 32 * NCHK; hc += F.G * NWAVES) ypass_unit(F, A, hc);
        SUBM(22);
        __syncthreads();
        if (BOTH(5)) GRID_BAR(); PH_END(5);
    }
    PH_BEGIN(6);
    if (IN(6)) {
        if (bx < 32) {
            LAS float* red = (LAS float*)(F.lds + RING_OFF); const int n0 = 32 * bx; float t1[2];
            skinny_tile(F, red, ON + (size_t)MP * 512, 512, (const bf16*)(F.ws + WS_WPA), 512, n0);
            t1[0] = red[8192 + F.tid]; t1[1] = red[8192 + 512 + F.tid];
            skinny_tile(F, red, RW + (size_t)MP * 512, 512, (const bf16*)(F.ws + WS_WPB), 512, n0);
#pragma unroll
            for (int i = 0; i < 2; ++i) { const int e = F.tid + 512 * i, reg = e >> 6, ln = e & 63, row = crow16(reg, ln >> 5), col = n0 + (ln & 31);
                const float g1 = bf2f(GT[(size_t)(MP + row) * 2048 + col]), g2 = bf2f(GT[(size_t)(MP + row) * 2048 + 1024 + col]);
                MG[(size_t)(MP + row) * 1024 + col] = (bf16)(pk2(g1 * t1[i] + g2 * red[8192 + e], 0.f) & 0xffffu); }
            __syncthreads();
        }
        pg8::Gemm g{ON, (const bf16*)(F.ws + WS_WPA), RW, (const bf16*)(F.ws + WS_WPB), MP, DM, 512}; pg8::PairOrder S; S.base.init(MP, DM, F.G, bx);
        pg8::EpiMerge E{GT, (float*)(F.ws + WS_TMP), MG};
        pg8::gemm_phase<pg8::EpiMerge, pg8::PairOrder, true, true>(F.lds + RING_OFF, g, S, E);
        if (BOTH(6)) GRID_BAR(); PH_END(6);
    }
    PH_BEGIN(7);
    if (IN(7)) {
        if (bx < 32) {
            LAS float* red = (LAS float*)(F.lds + RING_OFF); const int n0 = 32 * bx;
            skinny_tile(F, red, MG + (size_t)MP * 1024, 1024, (const bf16*)(F.ws + WS_WOUT), 1024, n0);
#pragma unroll
            for (int i = 0; i < 2; ++i) { const int e = F.tid + 512 * i, reg = e >> 6, ln = e & 63, row = crow16(reg, ln >> 5), col = n0 + (ln & 31);
                const float v = A.in[I_XS][(size_t)row * 1024 + col] + red[8192 + e];
                F.out[O_YS + (size_t)row * 1024 + col] = v; X1B[(size_t)(MP + row) * 1024 + col] = (bf16)(pk2(v, 0.f) & 0xffffu);
                float ss = v * v; ss += __shfl_xor(ss, 1); ss += __shfl_xor(ss, 2); ss += __shfl_xor(ss, 4); ss += __shfl_xor(ss, 8); ss += __shfl_xor(ss, 16);
                if ((ln & 31) == 0) atomicAdd(ssq + MP + row, ss); }
            __syncthreads();
        }
        pg8::Gemm g{MG, (const bf16*)(F.ws + WS_WOUT), nullptr, nullptr, MP, DM, DM}; pg8::StaticOrder S; S.init(MP, DM, F.G, bx);
        pg8::EpiOut E{XB, X1B, ssq};
        pg8::gemm_phase<pg8::EpiOut, pg8::StaticOrder, false, true>(F.lds + RING_OFF, g, S, E);
        if (BOTH(7)) GRID_BAR(); PH_END(7);
    }
    PH_BEGIN(8);
    if (IN(8)) {
        pg8::Gemm g{X1B, (const bf16*)(F.ws + WS_WGU), nullptr, nullptr, MTOT, NGU, DM}; pg8::StaticOrder S; S.init(MTOT, NGU, F.G, bx);
        pg8::EpiGateUp E{ssq, HB};
        pg8::gemm_phase<pg8::EpiGateUp, pg8::StaticOrder, true, true>(F.lds + RING_OFF, g, S, E);
        if (BOTH(8)) GRID_BAR(); PH_END(8);
    }
    PH_BEGIN(9);
    if (IN(9)) {
        if (bx < 32) {
            LAS float* red = (LAS float*)(F.lds + RING_OFF); const int n0 = 32 * bx;
            skinny_tile(F, red, HB + (size_t)MP * FF, FF, (const bf16*)(F.ws + WS_WDN), FF, n0);
#pragma unroll
            for (int i = 0; i < 2; ++i) { const int e = F.tid + 512 * i, reg = e >> 6, ln = e & 63, row = crow16(reg, ln >> 5), col = n0 + (ln & 31);
                float yv = F.out[O_YS + (size_t)row * 1024 + col] + red[8192 + e];
#ifdef MK_SUB
                prof_a = F.pa; prof_b = F.pb;
#endif
                if (MK_PROF >= 0 && MK_PROF != 9) yv *= 1.f + sqrtf((float)(prof_b - prof_a) * 0.01f * MK_PROF_SCALE);
                F.out[O_YS + (size_t)row * 1024 + col] = yv; }
            __syncthreads();
        }
        pg8::Gemm g{HB, (const bf16*)(F.ws + WS_WDN), nullptr, nullptr, MP, DM, FF}; pg8::StaticOrder S; S.init(MP, DM, F.G, bx);
        pg8::EpiDown E{F.out + O_YP, X1B};
        pg8::gemm_phase<pg8::EpiDown, pg8::StaticOrder, false, true>(F.lds + RING_OFF, g, S, E);
        if (MK_PROF == 9 && MK_N_LAUNCHES == 1) {
            xcd_barrier(bar); prof_b = __builtin_amdgcn_s_memrealtime();
            const float sc = 1.f + sqrtf((float)(prof_b - prof_a) * 0.01f * 1e-5f);
            for (int e = bx * 512 + F.tid; e < 32 * 1024; e += F.G * 512) F.out[O_YS + e] *= sc;
        }
    }
#undef IN
#undef BOTH
}

#if MK_NAIVE_ATTN
__global__ void __launch_bounds__(512, 2) attn_naive_kernel(Args args) {
    Frame F; F.tid = threadIdx.x; F.lane = F.tid & 63; F.wave = __builtin_amdgcn_readfirstlane(F.tid >> 6); F.G = gridDim.x; F.ws = args.ws; F.out = args.out;
    const Args& A = args;
    const float lam = lam_value(F, A);
    const int gw = (int)blockIdx.x * NWAVES + F.wave, NGW = F.G * NWAVES;
    for (int it = gw; it < MP * 4; it += NGW) attn_naive_row(F, A, it >> 2, it & 3, lam);
}
#endif
extern "C" void kernel_launch(void* const* d_in, const int* in_sizes, int n_in, void* d_out, int out_size, void* d_ws, size_t ws_size, hipStream_t stream) {
    static int grid = 0;
    if (grid == 0) {
        if (n_in != 34 || out_size != (int)O_END || ws_size < WS_END) { fprintf(stderr, "kernel_launch: unexpected shapes: n_in %d out %d ws %zu\n", n_in, out_size, ws_size); grid = -1; return; }
        int dev = 0, cus = 0, per_cu = 0;
        if (hipGetDevice(&dev) != hipSuccess || hipDeviceGetAttribute(&cus, hipDeviceAttributeMultiprocessorCount, dev) != hipSuccess) { grid = -1; return; }
        if (hipFuncSetAttribute((const void*)mk_fwd, hipFuncAttributeMaxDynamicSharedMemorySize, LDS_BYTES) != hipSuccess) { fprintf(stderr, "kernel_launch: hipFuncSetAttribute failed\n"); grid = -1; return; }
        if (hipOccupancyMaxActiveBlocksPerMultiprocessor(&per_cu, (const void*)mk_fwd, NWAVES * 64, LDS_BYTES) != hipSuccess || per_cu < 1) fprintf(stderr, "kernel_launch: occupancy query says %d\n", per_cu);
        (void)hipGetLastError();
        grid = cus;
    }
    if (grid < 0) return;
    if (hipMemsetAsync((char*)d_ws + WS_CTL, 0, CTL_ZERO_BYTES, stream) != hipSuccess) return;
    Args a{};
    for (int i = 0; i < 34; ++i) a.in[i] = (const float*)d_in[i];
    a.out = (float*)d_out; a.ws = (unsigned char*)d_ws;
    const int NL = MK_N_LAUNCHES;
    for (int li = 0; li < NL; ++li) {
        a.ph_lo = (NL == 1) ? 0 : li; a.ph_hi = (NL == 1) ? N_PHASES : li + 1; a.li = li; a.pad = 0;
        hipLaunchKernelGGL(mk_fwd, dim3(grid), dim3(NWAVES * 64), LDS_BYTES, stream, a);
        if (hipPeekAtLastError() != hipSuccess) { fprintf(stderr, "kernel_launch: launch %d failed\n", li); break; }
#if MK_NAIVE_ATTN
        if (NL != 1 && li == 3) hipLaunchKernelGGL(attn_naive_kernel, dim3(1024), dim3(512), 0, stream, a);
#endif
    }
}
```

```cpp
#include <hip/hip_runtime.h>
#include <cstdio>
#include <cstdint>

constexpr int MP = 16384, MS = 32, MVALID = MP + MS, MTOT = 16640;
constexpr int DM = 1024, INW = 5376, FF = 2816, NGU = 2 * FF, SEQ = 4096, NBATCH = 4, RSW = 1792;
constexpr int NPAGES = 64, PAGE = 128, PAST = 8192;
constexpr size_t O_YP = 0, O_YS = 16777216, O_KP = O_YS + 32768, O_VP = O_KP + 8388608, O_WP = O_VP + 8388608, O_SP = O_WP + 131072,
                 O_KS = O_SP + 7168, O_VS = O_KS + 16384, O_WS = O_VS + 16384, O_SS = O_WS + 1048576, O_END = O_SS + 57344;
constexpr float QK_C2 = 0.125f * 1.4426950408889634f;
namespace pg8 {
#define PG8_LAS __attribute__((address_space(3)))
typedef unsigned short bf16_t;
typedef short bf16x8 __attribute__((ext_vector_type(8)));
typedef float f32x4 __attribute__((ext_vector_type(4)));
typedef unsigned u32x4 __attribute__((ext_vector_type(4)));
constexpr int BM = 256, BK = 64, HALF = 128, HTB = HALF * BK * 2  , STAGE_BYTES = 8 * HTB, NXCD = 8, WGM = 8;

__host__ __device__ __forceinline__ int lds_byte(int r, int c) { const int st = (r >> 4) * 2 + (c >> 5), rr = r & 15, cc = c & 31, ob = rr * 64 + cc * 2; return st * 1024 + (ob ^ (((ob >> 9) & 1) << 5)); }
__host__ __device__ __forceinline__ void stage_rc(int b, int& R, int& C) { const int st = b / 1024, sb = b % 1024, swz = sb ^ (((sb >> 9) & 1) << 5); R = (st >> 1) * 16 + swz / 64; C = (st & 1) * 32 + (swz % 64) / 2; }
__host__ __device__ __forceinline__ int perm32(int rho) { const int n = rho >> 4, i = rho & 15; return 8 * (i >> 2) + 4 * n + (i & 3); }

struct Unit { int pm, pn, z; };
struct Gemm { const bf16_t* A; const bf16_t* Bt; const bf16_t* A2; const bf16_t* Bt2; int M, N, K; };

struct StaticOrder {
    int nM, nN, nwg, G, c;
    __host__ __device__ void init(int M, int N, int G_, int c_) { nM = M / BM; nN = N / BM; nwg = nM * nN; G = G_; c = c_; }
    __host__ __device__ bool next(int i, Unit& u) const {
        const long L = (long)i * G + c; if (L >= nwg) return false;
        int wgid = (int)L; { const int q = nwg / NXCD, r = nwg % NXCD, xcd = wgid % NXCD, off = wgid / NXCD; wgid = (xcd < r ? xcd * (q + 1) : r * (q + 1) + (xcd - r) * q) + off; }
        const int nig = WGM * nN, gid = wgid / nig, fm = gid * WGM, gsz = (nM - fm) < WGM ? (nM - fm) : WGM;
        u.pm = fm + ((wgid % nig) % gsz); u.pn = (wgid % nig) / gsz; u.z = 0; return true;
    }
    __device__ __forceinline__ void a_ready(const Unit&) const {}
    __device__ __forceinline__ void done(const Unit&) const {}
};

typedef float f32x2_cv __attribute__((ext_vector_type(2))); typedef __bf16 bf16x2_cv __attribute__((ext_vector_type(2)));
__device__ __forceinline__ unsigned cvt_pk_bf16(float lo, float hi) { const f32x2_cv v = {lo, hi}; const bf16x2_cv b = __builtin_convertvector(v, bf16x2_cv); return __builtin_bit_cast(unsigned, b); }
typedef float f32x2 __attribute__((ext_vector_type(2)));
__device__ __forceinline__ void st_bf16x8(bf16_t* p, const f32x4 a, const f32x4 b) {
    u32x4 w; w.x = cvt_pk_bf16(a[0], a[1]); w.y = cvt_pk_bf16(a[2], a[3]); w.z = cvt_pk_bf16(b[0], b[1]); w.w = cvt_pk_bf16(b[2], b[3]); *(u32x4*)p = w;
}
__device__ __forceinline__ float sigmoidf_(float x) { return __builtin_amdgcn_rcpf(1.f + __expf(-x)); }

struct EpiProj {
    static constexpr bool PERM = true, AFTER_DRAIN = false, KEEP_ACC = false;
    const float* rs0; const float* qg; const float* kg;
    bf16_t *QB, *KB, *VB, *PC, *GT; float* out;
    __device__ __forceinline__ void operator()(const f32x4 (&acc)[2][2][4][2], const Unit& u, int wr, int wc, int fr, int fq) const {
        const int pn = u.pn, rb = u.pm * BM + wr * 64 + fr, c8 = 64 * wc + 8 * fq;
        if (pn < 4) {
            const bool isq = pn < 2; const float* gain = isq ? qg : kg;
            f32x4 gv[2][2];
#pragma unroll
            for (int bj = 0; bj < 2; ++bj)
#pragma unroll
                for (int n = 0; n < 2; ++n) gv[bj][n] = *(const f32x4*)(gain + 32 * bj + 8 * fq + 4 * n);
            const int colg = 256 * (pn & 1) + c8;
#pragma unroll
            for (int ai = 0; ai < 2; ++ai)
#pragma unroll
                for (int m = 0; m < 4; ++m) {
                    const int row = rb + ai * HALF + m * 16; const bool ok = row < MVALID; const float rs = rs0[ok ? row : 0];
                    float ss = 0.f;
#pragma unroll
                    for (int bj = 0; bj < 2; ++bj)
#pragma unroll
                        for (int n = 0; n < 2; ++n) { const f32x4 x = acc[ai][bj][m][n] * rs; ss += (x[0] * x[0] + x[1] * x[1]) + (x[2] * x[2] + x[3] * x[3]); }
                    ss += __shfl_xor(ss, 16); ss += __shfl_xor(ss, 32);
                    const float rn = rsqrtf(ss * (1.f / 64.f) + 1e-6f) * rs;
#pragma unroll
                    for (int bj = 0; bj < 2; ++bj) {
                        const f32x4 v0 = acc[ai][bj][m][0] * rn * gv[bj][0], v1 = acc[ai][bj][m][1] * rn * gv[bj][1];
                        const size_t o = (size_t)row * 512 + colg + 32 * bj;
                        if (ok) {
                            if (isq) st_bf16x8(QB + o, v0 * QK_C2, v1 * QK_C2);
                            else { st_bf16x8(KB + o, v0, v1);
                                float* f = row < MP ? out + O_KP + o : out + O_KS + (size_t)(row - MP) * 512 + colg + 32 * bj;
                                *(f32x4*)f = v0; *(f32x4*)(f + 4) = v1; }
                        }
                    }
                }
        } else {
#pragma unroll
            for (int ai = 0; ai < 2; ++ai)
#pragma unroll
                for (int m = 0; m < 4; ++m) {
                    const int row = rb + ai * HALF + m * 16; const bool ok = row < MVALID; const float rs = rs0[ok ? row : 0];
                    if (!ok) continue;
#pragma unroll
                    for (int bj = 0; bj < 2; ++bj) {
                        f32x4 v0 = acc[ai][bj][m][0] * rs, v1 = acc[ai][bj][m][1] * rs;
                        if (pn < 6) {
                            const size_t c = (size_t)(256 * (pn - 4) + c8 + 32 * bj), o = (size_t)row * 512 + c;
                            st_bf16x8(VB + o, v0, v1);
                            float* f = row < MP ? out + O_VP + o : out + O_VS + (size_t)(row - MP) * 512 + c;
                            *(f32x4*)f = v0; *(f32x4*)(f + 4) = v1;
                        } else if (pn < 13) {
                            const size_t c = (size_t)(256 * (pn - 6) + c8 + 32 * bj);
                            st_bf16x8(PC + (size_t)row * RSW + c, v0, v1);
                            if (row >= MP) { float* f = out + O_SS + (size_t)(row - MP) * RSW + c; *(f32x4*)f = v0; *(f32x4*)(f + 4) = v1; }
                            else if ((row & (SEQ - 1)) == SEQ - 1) { float* f = out + O_SP + (size_t)(row >> 12) * RSW + c; *(f32x4*)f = v0; *(f32x4*)(f + 4) = v1; }
                        } else {
                            const size_t c = (size_t)(256 * (pn - 13) + c8 + 32 * bj);
#ifndef MK_DBG_NOSIG
#pragma unroll
                            for (int j = 0; j < 4; ++j) { v0[j] = sigmoidf_(v0[j]); v1[j] = sigmoidf_(v1[j]); }
#endif
                            st_bf16x8(GT + (size_t)row * 2048 + c, v0, v1);
                        }
                    }
                }
        }
    }
};

struct EpiMerge {
    static constexpr bool PERM = true, AFTER_DRAIN = false, KEEP_ACC = true;
    const bf16_t* GT; float* tmp; bf16_t* MG;
    __device__ __forceinline__ void operator()(const f32x4 (&acc_)[2][2][4][2], const Unit& u, int wr, int wc, int fr, int fq) const {
        f32x4 (&acc)[2][2][4][2] = const_cast<f32x4 (&)[2][2][4][2]>(acc_);
        const int rb = u.pm * BM + wr * 64 + fr, cb = u.pn * BM + wc * 32 + 8 * fq;
#pragma unroll
        for (int ai = 0; ai < 2; ++ai)
#pragma unroll
            for (int m = 0; m < 4; ++m) {
                const int row = rb + ai * HALF + m * 16;
#pragma unroll
                for (int bj = 0; bj < 2; ++bj) {
                    const int col = cb + bj * HALF;
                    const u32x4 gw = *(const u32x4*)(GT + (size_t)row * 2048 + 1024 + col);
                    f32x4 g0, g1;
                    g0[0] = __builtin_bit_cast(float, gw.x << 16); g0[1] = __builtin_bit_cast(float, gw.x & 0xffff0000u); g0[2] = __builtin_bit_cast(float, gw.y << 16); g0[3] = __builtin_bit_cast(float, gw.y & 0xffff0000u);
                    g1[0] = __builtin_bit_cast(float, gw.z << 16); g1[1] = __builtin_bit_cast(float, gw.z & 0xffff0000u); g1[2] = __builtin_bit_cast(float, gw.w << 16); g1[3] = __builtin_bit_cast(float, gw.w & 0xffff0000u);
                    if (!u.z) {
                        const u32x4 hw = *(const u32x4*)(GT + (size_t)row * 2048 + col);
                        f32x4 h0, h1;
                        h0[0] = __builtin_bit_cast(float, hw.x << 16); h0[1] = __builtin_bit_cast(float, hw.x & 0xffff0000u); h0[2] = __builtin_bit_cast(float, hw.y << 16); h0[3] = __builtin_bit_cast(float, hw.y & 0xffff0000u);
                        h1[0] = __builtin_bit_cast(float, hw.z << 16); h1[1] = __builtin_bit_cast(float, hw.z & 0xffff0000u); h1[2] = __builtin_bit_cast(float, hw.w << 16); h1[3] = __builtin_bit_cast(float, hw.w & 0xffff0000u);
#pragma unroll
                        for (int e = 0; e < 4; ++e) { acc[ai][bj][m][0][e] *= h0[e] / fmaxf(g0[e], 1e-30f); acc[ai][bj][m][1][e] *= h1[e] / fmaxf(g1[e], 1e-30f); }
                    } else {
                        const f32x4 v0 = acc[ai][bj][m][0] * g0, v1 = acc[ai][bj][m][1] * g1;
                        st_bf16x8(MG + (size_t)row * 1024 + col, v0, v1);
                    }
                }
            }
    }
};
struct EpiOut {
    static constexpr bool PERM = true, AFTER_DRAIN = false, KEEP_ACC = false;
    const bf16_t* xb; bf16_t* X1B; float* ssq;
    __device__ __forceinline__ void operator()(const f32x4 (&acc)[2][2][4][2], const Unit& u, int wr, int wc, int fr, int fq) const {
        const int rb = u.pm * BM + wr * 64 + fr, cb = u.pn * BM + wc * 32 + 8 * fq;
#pragma unroll
        for (int ai = 0; ai < 2; ++ai)
#pragma unroll
            for (int m = 0; m < 4; ++m) {
                const int row = rb + ai * HALF + m * 16; float ss = 0.f;
#pragma unroll
                for (int bj = 0; bj < 2; ++bj) {
                    const size_t o = (size_t)row * 1024 + cb + bj * HALF;
                    const u32x4 xw = *(const u32x4*)(xb + o); f32x4 v0 = acc[ai][bj][m][0], v1 = acc[ai][bj][m][1];
                    v0[0] += __builtin_bit_cast(float, xw.x << 16); v0[1] += __builtin_bit_cast(float, xw.x & 0xffff0000u); v0[2] += __builtin_bit_cast(float, xw.y << 16); v0[3] += __builtin_bit_cast(float, xw.y & 0xffff0000u);
                    v1[0] += __builtin_bit_cast(float, xw.z << 16); v1[1] += __builtin_bit_cast(float, xw.z & 0xffff0000u); v1[2] += __builtin_bit_cast(float, xw.w << 16); v1[3] += __builtin_bit_cast(float, xw.w & 0xffff0000u);
                    st_bf16x8(X1B + o, v0, v1);
                    ss += (v0[0] * v0[0] + v0[1] * v0[1]) + (v0[2] * v0[2] + v0[3] * v0[3]) + (v1[0] * v1[0] + v1[1] * v1[1]) + (v1[2] * v1[2] + v1[3] * v1[3]);
                }
                ss += __shfl_xor(ss, 16); ss += __shfl_xor(ss, 32);
                if (fq == 0) atomicAdd(ssq + row, ss);
            }
    }
};
struct EpiGateUp {
    static constexpr bool PERM = true, AFTER_DRAIN = false, KEEP_ACC = false;
    const float* ssq; bf16_t* HB;
    __device__ __forceinline__ void operator()(const f32x4 (&acc)[2][2][4][2], const Unit& u, int wr, int wc, int fr, int fq) const {
        const int rb = u.pm * BM + wr * 64 + fr, cb = u.pn * HALF + wc * 32 + 8 * fq;
#pragma unroll
        for (int ai = 0; ai < 2; ++ai)
#pragma unroll
            for (int m = 0; m < 4; ++m) {
                const int row = rb + ai * HALF + m * 16; if (row >= MVALID) continue;
                const float rs = rsqrtf(ssq[row] * (1.f / 1024.f) + 1e-6f);
                f32x4 h[2];
#pragma unroll
                for (int n = 0; n < 2; ++n)
#pragma unroll
                    for (int j = 0; j < 4; ++j) { const float g = acc[ai][0][m][n][j] * rs, uu = acc[ai][1][m][n][j] * rs; h[n][j] = g * sigmoidf_(g) * uu; }
                st_bf16x8(HB + (size_t)row * FF + cb, h[0], h[1]);
            }
    }
};
struct EpiDown {
    static constexpr bool PERM = true, AFTER_DRAIN = false, KEEP_ACC = false;
    float* y; const bf16_t* X1B;
    __device__ __forceinline__ void operator()(const f32x4 (&acc)[2][2][4][2], const Unit& u, int wr, int wc, int fr, int fq) const {
        const int rb = u.pm * BM + wr * 64 + fr, cb = u.pn * BM + wc * 32 + 8 * fq;
#pragma unroll
        for (int ai = 0; ai < 2; ++ai)
#pragma unroll
            for (int m = 0; m < 4; ++m) {
                const int row = rb + ai * HALF + m * 16;
#pragma unroll
                for (int bj = 0; bj < 2; ++bj) {
                    float* p = y + (size_t)row * 1024 + cb + bj * HALF; const u32x4 xw = *(const u32x4*)(X1B + (size_t)row * 1024 + cb + bj * HALF);
                    f32x4 v0 = acc[ai][bj][m][0], v1 = acc[ai][bj][m][1];
                    v0[0] += __builtin_bit_cast(float, xw.x << 16); v0[1] += __builtin_bit_cast(float, xw.x & 0xffff0000u); v0[2] += __builtin_bit_cast(float, xw.y << 16); v0[3] += __builtin_bit_cast(float, xw.y & 0xffff0000u);
                    v1[0] += __builtin_bit_cast(float, xw.z << 16); v1[1] += __builtin_bit_cast(float, xw.z & 0xffff0000u); v1[2] += __builtin_bit_cast(float, xw.w << 16); v1[3] += __builtin_bit_cast(float, xw.w & 0xffff0000u);
                    *(f32x4*)p = v0; *(f32x4*)(p + 4) = v1;
                }
            }
    }
};
struct PairOrder {
    StaticOrder base;
    __device__ __forceinline__ bool next(int i, Unit& u) const { if (!base.next(i >> 1, u)) return false; u.z = i & 1; return true; }
    __device__ __forceinline__ void a_ready(const Unit&) const {}
    __device__ __forceinline__ void done(const Unit&) const {}
};

template <class Epi, class Sched, bool ALIGN_EPI = false, bool SP2 = false>
__device__ __forceinline__ void gemm_phase(PG8_LAS unsigned char* lds, const Gemm g, const Sched& S, const Epi& E) {
    const int tid = threadIdx.x, wid = __builtin_amdgcn_readfirstlane(tid >> 6), lane = tid & 63, wr = wid >> 2, wc = wid & 3, fr = lane & 15, fq = lane >> 4;
    const int K = g.K, nt = K / BK;
    unsigned voffA[2], voffB[2];
#pragma unroll
    for (int i = 0; i < 2; ++i) { int R, C; stage_rc(tid * 16 + i * 8192, R, C); const int Rb = Epi::PERM ? ((R & ~31) + perm32(R & 31)) : R;
        voffA[i] = (unsigned)(R * K + C) * 2u; voffB[i] = (unsigned)(Rb * K + C) * 2u; }
    const size_t kstep = (size_t)(BK * 2);
    const size_t hstep = (size_t)HALF * K * 2;
    const size_t tstep = 2 * hstep;
    const unsigned ldsw = (unsigned)wid * 1024u;
    const int aoff = lds_byte(wr * 64 + fr, fq * 8), boff = lds_byte(wc * 32 + fr, fq * 8);
#define PG8_SA(b, h) (((b) * 2 + (h)) * HTB)
#define PG8_SB(b, h) ((4 + (b) * 2 + (h)) * HTB)
#define PG8_STAGE(bufoff, gbase, voff) do { _Pragma("unroll") for (int _i = 0; _i < 2; ++_i) \
        __builtin_amdgcn_global_load_lds((const unsigned*)((const char*)(gbase) + (voff)[_i]), (PG8_LAS unsigned*)(lds + (bufoff) + ldsw + _i * 8192), 16, 0, 0); } while (0)
#define PG8_LDA(dst, b, h) do { _Pragma("unroll") for (int m = 0; m < 4; ++m) _Pragma("unroll") for (int k = 0; k < 2; ++k) dst[m][k] = *(const PG8_LAS bf16x8*)(lds + PG8_SA(b, h) + aoff + m * 2048 + k * 1024); } while (0)
#define PG8_LDB(dst, b, h) do { _Pragma("unroll") for (int n = 0; n < 2; ++n) _Pragma("unroll") for (int k = 0; k < 2; ++k) dst[n][k] = *(const PG8_LAS bf16x8*)(lds + PG8_SB(b, h) + boff + n * 2048 + k * 1024); } while (0)
#define PG8_MMA(ai, bj, At, Bt) do { __builtin_amdgcn_s_setprio(1); _Pragma("unroll") for (int m = 0; m < 4; ++m) _Pragma("unroll") for (int n = 0; n < 2; ++n) _Pragma("unroll") for (int k = 0; k < 2; ++k) \
        acc[ai][bj][m][n] = __builtin_amdgcn_mfma_f32_16x16x32_bf16(Bt[n][k], At[m][k], acc[ai][bj][m][n], 0, 0, 0); __builtin_amdgcn_s_setprio(0); } while (0)
#define PG8_WAIT_V(n) asm volatile("s_waitcnt vmcnt(" #n ")" ::: "memory")
#define PG8_WAIT_L(n) asm volatile("s_waitcnt lgkmcnt(" #n ")" ::: "memory")
#define PG8_BAR __builtin_amdgcn_s_barrier()
#define PG8_SCHED __builtin_amdgcn_sched_barrier(0)
    Unit cur, nxt; int ui = 0;
    if (!S.next(0, cur)) return;
    f32x4 acc[2][2][4][2];
#pragma unroll
    for (int a = 0; a < 2; ++a)
#pragma unroll
        for (int b = 0; b < 2; ++b)
#pragma unroll
            for (int m = 0; m < 4; ++m)
#pragma unroll
                for (int n = 0; n < 2; ++n) acc[a][b][m][n] = (f32x4){0.f, 0.f, 0.f, 0.f};
    bf16x8 At[4][2], B0[2][2], B1[2][2];
    const char* cA = (const char*)(cur.z ? g.A2 : g.A) + (size_t)cur.pm * tstep; const char* cB = (const char*)(cur.z ? g.Bt2 : g.Bt) + (size_t)cur.pn * tstep;
    S.a_ready(cur);
    if constexpr (SP2) {
        PG8_STAGE(PG8_SB(0, 0), cB, voffB); PG8_STAGE(PG8_SB(0, 1), cB + hstep, voffB); PG8_STAGE(PG8_SA(0, 0), cA, voffA); PG8_STAGE(PG8_SA(0, 1), cA + hstep, voffA);
        if (wr == 1) PG8_BAR;
        PG8_WAIT_V(2); PG8_BAR;
        PG8_STAGE(PG8_SB(1, 0), cB + kstep, voffB); PG8_STAGE(PG8_SA(1, 0), cA + kstep, voffA); PG8_STAGE(PG8_SB(1, 1), cB + hstep + kstep, voffB);
        PG8_WAIT_V(6); PG8_BAR;
    } else {
        PG8_STAGE(PG8_SB(0, 0), cB, voffB); PG8_STAGE(PG8_SA(0, 0), cA, voffA); PG8_STAGE(PG8_SB(0, 1), cB + hstep, voffB); PG8_STAGE(PG8_SA(0, 1), cA + hstep, voffA);
        if (wr == 1) PG8_BAR;
        PG8_WAIT_V(4); PG8_BAR;
        PG8_STAGE(PG8_SB(1, 0), cB + kstep, voffB); PG8_STAGE(PG8_SA(1, 0), cA + kstep, voffA); PG8_STAGE(PG8_SB(1, 1), cB + hstep + kstep, voffB);
        PG8_WAIT_V(6); PG8_BAR;
    }
    for (;;) {
        const bool has_next = S.next(ui + 1, nxt);
        const char* nA = has_next ? (const char*)(nxt.z ? g.A2 : g.A) + (size_t)nxt.pm * tstep : cA; const char* nB = has_next ? (const char*)(nxt.z ? g.Bt2 : g.Bt) + (size_t)nxt.pn * tstep : cB;
        for (int t = 0; t < nt; t += 2) {
            const bool last = (t == nt - 2);
            const char* a1 = cA + (size_t)(t + 1) * kstep;
            const char* a2 = last ? nA : cA + (size_t)(t + 2) * kstep; const char* b2 = last ? nB : cB + (size_t)(t + 2) * kstep;
            const char* a3 = a2 + kstep; const char* b3 = b2 + kstep;
            if (last && has_next) S.a_ready(nxt);
            if constexpr (SP2) {
            PG8_LDB(B0, 0, 0); PG8_LDB(B1, 0, 1); PG8_SCHED; PG8_LDA(At, 0, 0); PG8_STAGE(PG8_SA(1, 1), a1 + hstep, voffA);
            PG8_WAIT_V(8); PG8_WAIT_L(0); PG8_BAR; PG8_MMA(0, 0, At, B0); PG8_MMA(0, 1, At, B1); PG8_BAR; PG8_SCHED;
            PG8_LDA(At, 0, 1); PG8_STAGE(PG8_SB(0, 0), b2, voffB); PG8_STAGE(PG8_SB(0, 1), b2 + hstep, voffB); PG8_STAGE(PG8_SA(0, 0), a2, voffA);
            PG8_WAIT_V(8); PG8_WAIT_L(0); PG8_BAR; PG8_MMA(1, 0, At, B0); PG8_MMA(1, 1, At, B1); PG8_BAR; PG8_SCHED;
            PG8_LDB(B0, 1, 0); PG8_LDB(B1, 1, 1); PG8_SCHED; PG8_LDA(At, 1, 0); PG8_STAGE(PG8_SA(0, 1), a2 + hstep, voffA);
            PG8_WAIT_V(8); PG8_WAIT_L(0); PG8_BAR; PG8_MMA(0, 0, At, B0); PG8_MMA(0, 1, At, B1); PG8_BAR; PG8_SCHED;
            PG8_LDA(At, 1, 1); PG8_STAGE(PG8_SB(1, 0), b3, voffB); PG8_STAGE(PG8_SB(1, 1), b3 + hstep, voffB); PG8_STAGE(PG8_SA(1, 0), a3, voffA);
            PG8_WAIT_V(8); PG8_WAIT_L(0); PG8_BAR; PG8_MMA(1, 0, At, B0); PG8_MMA(1, 1, At, B1); PG8_BAR; PG8_SCHED;
            } else {
            PG8_LDB(B0, 0, 0); PG8_SCHED; PG8_LDA(At, 0, 0); PG8_STAGE(PG8_SA(1, 1), a1 + hstep, voffA);
            PG8_WAIT_L(8); PG8_BAR; PG8_WAIT_L(0); PG8_MMA(0, 0, At, B0); PG8_BAR; PG8_SCHED;
            PG8_LDB(B1, 0, 1); PG8_STAGE(PG8_SB(0, 0), b2, voffB);
            PG8_BAR; PG8_WAIT_L(0); PG8_MMA(0, 1, At, B1); PG8_BAR;
            PG8_LDA(At, 0, 1); PG8_STAGE(PG8_SA(0, 0), a2, voffA);
            PG8_BAR; PG8_WAIT_L(0); PG8_MMA(1, 0, At, B0); PG8_BAR; PG8_SCHED;
            PG8_STAGE(PG8_SB(0, 1), b2 + hstep, voffB);
            PG8_WAIT_V(6); PG8_BAR; PG8_MMA(1, 1, At, B1); PG8_BAR;
            PG8_LDB(B0, 1, 0); PG8_SCHED; PG8_LDA(At, 1, 0); PG8_STAGE(PG8_SA(0, 1), a2 + hstep, voffA);
            PG8_WAIT_L(8); PG8_BAR; PG8_WAIT_L(0); PG8_MMA(0, 0, At, B0); PG8_BAR; PG8_SCHED;
            PG8_LDB(B1, 1, 1); PG8_STAGE(PG8_SB(1, 0), b3, voffB);
            PG8_BAR; PG8_WAIT_L(0); PG8_MMA(0, 1, At, B1); PG8_BAR;
            PG8_LDA(At, 1, 1); PG8_STAGE(PG8_SA(1, 0), a3, voffA);
            PG8_BAR; PG8_WAIT_L(0); PG8_MMA(1, 0, At, B0); PG8_BAR; PG8_SCHED;
            PG8_STAGE(PG8_SB(1, 1), b3 + hstep, voffB);
            PG8_WAIT_V(6); PG8_BAR; PG8_MMA(1, 1, At, B1); PG8_BAR;
            }
        }
        if constexpr (ALIGN_EPI) { if (wr == 0) PG8_BAR; }
        if constexpr (!Epi::AFTER_DRAIN) { E(acc, cur, wr, wc, fr, fq); S.done(cur); }
        if (!has_next) break;
        if (!(Epi::KEEP_ACC && cur.z == 0)) {
#pragma unroll
        for (int a = 0; a < 2; ++a)
#pragma unroll
            for (int b = 0; b < 2; ++b)
#pragma unroll
                for (int m = 0; m < 4; ++m)
#pragma unroll
                    for (int n = 0; n < 2; ++n) acc[a][b][m][n] = (f32x4){0.f, 0.f, 0.f, 0.f};
        }
        cur = nxt; cA = nA; cB = nB; ++ui;
        if constexpr (ALIGN_EPI) { if (wr == 1) PG8_BAR; }
    }
    PG8_WAIT_V(0);
    if constexpr (!ALIGN_EPI) { if (wr == 0) PG8_BAR; }
    PG8_BAR;
    if constexpr (Epi::AFTER_DRAIN) { E.fused(acc, cur, wr, wc, fr, fq, lds, wid, lane); S.done(cur); }
#undef PG8_SA
#undef PG8_SB
#undef PG8_STAGE
#undef PG8_LDA
#undef PG8_LDB
#undef PG8_MMA
#undef PG8_WAIT_V
#undef PG8_WAIT_L
#undef PG8_BAR
#undef PG8_SCHED
}
}

constexpr size_t MiB = 1u << 20;
constexpr size_t WS_CTL = 0, CTL_ZERO_BYTES = 1 * MiB;
constexpr size_t WS_WIN = 2 * MiB, WS_WPA = 13 * MiB, WS_WPB = 14 * MiB, WS_WOUT = 15 * MiB, WS_WGU = 17 * MiB, WS_WDN = 28 * MiB;
constexpr size_t WS_LORA = 28 * MiB + (size_t)DM * FF * 2;
static_assert(WS_LORA + 262144 <= 34 * MiB, "lora map");
constexpr size_t WS_XB = 34 * MiB, WS_RS0 = 67 * MiB, WS_QB = 68 * MiB, WS_KB = 85 * MiB, WS_VB = 102 * MiB, WS_PC = 119 * MiB, WS_GT = 176 * MiB;
constexpr size_t WS_ON = 241 * MiB, WS_RW = 258 * MiB, WS_MG = 275 * MiB, WS_TMP = 308 * MiB, WS_X1B = 373 * MiB, WS_HB = 406 * MiB;
constexpr size_t WS_RK = 496 * MiB, RK_STRIDE = 33 * MiB;
constexpr size_t WS_BON = 728 * MiB, WS_DP = 729 * MiB;
constexpr size_t WS_BON3 = 736 * MiB, WS_Y0 = 740 * MiB, WS_CC = 773 * MiB, WS_PSI = 806 * MiB, WS_PHI = 810 * MiB, WS_SST = 814 * MiB, WS_DP2 = 818 * MiB;
constexpr size_t WS_SC = 830 * MiB, WS_RH = 912 * MiB, WS_GP = 928 * MiB, WS_XC = 944 * MiB, WS_YL = 960 * MiB, WS_SL = 992 * MiB, WS_GC = 1024 * MiB, WS_HT = 1025 * MiB, WS_END = 1026 * MiB;
static_assert(WS_WIN + (size_t)INW * DM * 2 <= WS_WPA && WS_WGU + (size_t)NGU * DM * 2 <= WS_WDN && WS_WDN + (size_t)DM * FF * 2 <= WS_XB, "weights map");
static_assert(WS_XB + (size_t)MTOT * DM * 2 <= WS_RS0 && WS_QB + (size_t)MTOT * 512 * 2 <= WS_KB && WS_PC + (size_t)MTOT * RSW * 2 <= WS_GT && WS_GT + (size_t)MTOT * 2048 * 2 <= WS_ON, "act map 1");
static_assert(WS_MG + (size_t)MTOT * DM * 2 <= WS_TMP && WS_TMP + (size_t)MTOT * DM * 4 <= WS_X1B && WS_X1B + (size_t)MTOT * DM * 2 <= WS_HB && WS_HB + (size_t)MTOT * FF * 2 <= WS_RK, "act map 2");
static_assert((size_t)MTOT * 512 * 4 <= RK_STRIDE && WS_RK + 7 * RK_STRIDE <= WS_BON, "rwkv map");
constexpr int CW_TMO = 0, CW_CODE = 1;
constexpr int CW_BAR = 4096;
constexpr int CW_SSQ = 32768;
constexpr int CW_QUEUE = 2048;
constexpr int CW_QDEC = 2112;
constexpr int CW_DCNT = 65536;
static_assert((CW_DCNT + 128 * 64) * 4 <= (int)CTL_ZERO_BYTES, "CTL map");

constexpr int RING_OFF = 0, RING_BYTES = 139264;
constexpr int LDSCTL_OFF = RING_BYTES, MISC_OFF = LDSCTL_OFF + 320;
constexpr int LDS_BYTES = 155648;
constexpr int NWAVES = 8;

#define GAS __attribute__((address_space(1)))
#define LAS __attribute__((address_space(3)))
typedef unsigned short bf16;
typedef unsigned v4u __attribute__((ext_vector_type(4)));
typedef unsigned v2u __attribute__((ext_vector_type(2)));
typedef float f32x4 __attribute__((ext_vector_type(4)));
typedef float f32x2 __attribute__((ext_vector_type(2)));
typedef float f32x16 __attribute__((ext_vector_type(16)));
typedef short bf16x8 __attribute__((ext_vector_type(8)));
typedef short s16x4 __attribute__((ext_vector_type(4)));
typedef GAS unsigned gu32;
#define RLX_AGENT __ATOMIC_RELAXED, __HIP_MEMORY_SCOPE_AGENT
#define LDS_WAIT() asm volatile("s_waitcnt lgkmcnt(0)" ::: "memory")
#define VM_WAIT() asm volatile("s_waitcnt vmcnt(0)" ::: "memory")
__device__ __forceinline__ unsigned pk2(float lo, float hi) { return pg8::cvt_pk_bf16(lo, hi); }
using pg8::sigmoidf_;
__device__ __forceinline__ float bf2f(unsigned short b) { return __builtin_bit_cast(float, (unsigned)b << 16); }
__device__ __forceinline__ float bflo(unsigned w) { return __builtin_bit_cast(float, w << 16); }
__device__ __forceinline__ float bfhi(unsigned w) { return __builtin_bit_cast(float, w & 0xffff0000u); }

#define XB_TMO      128
#define XB_XCNT(j)  (256  + 64 * (j))
#define XB_XSUB(j)  (1280 + 64 * (j))
#define XB_XGEN(j)  (2304 + 64 * (j))
#define XB_TOP      3328
#define XB_TOPGEN   3392
#define XCD_BAR_WORDS 3456
#define XB_SPIN_CAP (1u << 18)

__device__ __forceinline__ unsigned xb_ld(unsigned* p)              { return __hip_atomic_load(p, __ATOMIC_RELAXED, __HIP_MEMORY_SCOPE_AGENT); }
__device__ __forceinline__ unsigned xb_add(unsigned* p, unsigned v) { return __hip_atomic_fetch_add(p, v, __ATOMIC_RELAXED, __HIP_MEMORY_SCOPE_AGENT); }
__device__ __forceinline__ unsigned xb_xcc_id() { return (unsigned)__builtin_amdgcn_s_getreg((3 << 11) | 20) & 0xFu; }
#define XB_SPIN(cond, bar) do { unsigned _sp = 0; while (cond) { __builtin_amdgcn_s_sleep(1); \
    if ((++_sp & 255u) == 0u) { if (xb_ld(&(bar)[XB_TMO])) break; if (_sp > XB_SPIN_CAP) { atomicAdd(&(bar)[XB_TMO], 1u); break; } } } } while (0)

struct XcdBarrier {
    unsigned* bar; unsigned x;
    volatile LAS unsigned* st;
};

__device__ __forceinline__ XcdBarrier xcd_barrier_post(unsigned* bar, volatile LAS unsigned* st) {
    XcdBarrier b; b.bar = bar; b.x = xb_xcc_id(); b.st = st;
    if (threadIdx.x == 0) (void)xb_add(&bar[XB_XCNT(b.x)], 1u);
    return b;
}
__device__ __forceinline__ void xcd_barrier_complete(unsigned* bar, unsigned x, unsigned& nloc, unsigned& nx) {
    const unsigned G = gridDim.x * gridDim.y * gridDim.z;
    unsigned sum, cnt, mine, sp = 0u;
    for (;;) {
        sum = 0u; cnt = 0u; mine = 0u;
#pragma unroll
        for (unsigned j = 0; j < 16; ++j) { const unsigned c = xb_ld(&bar[XB_XCNT(j)]); sum += c; cnt += (c > 0u) ? 1u : 0u; mine = (j == x) ? c : mine; }
        if (sum == G) break;
        __builtin_amdgcn_s_sleep(1);
        if ((++sp & 255u) == 0u) { if (xb_ld(&bar[XB_TMO])) break; if (sp > XB_SPIN_CAP) { atomicAdd(&bar[XB_TMO], 1u); break; } }
    }
    nloc = mine > 0u ? mine : 1u; nx = cnt > 0u ? cnt : 1u;
}

__device__ __forceinline__ void xcd_barrier(const XcdBarrier& b) {
    asm volatile("s_waitcnt vmcnt(0)" ::: "memory");
    __syncthreads();
    if (threadIdx.x == 0) {
        unsigned* bar = b.bar;
        __builtin_amdgcn_s_waitcnt(0);
        unsigned nloc = b.st[0], nx = b.st[1];
        if (nloc == 0u) { xcd_barrier_complete(bar, b.x, nloc, nx); b.st[0] = nloc; b.st[1] = nx; }
        const unsigned old = xb_add(&bar[XB_XSUB(b.x)], 1u);
        const unsigned gen = old / nloc;
        if (old + 1u == (gen + 1u) * nloc) {
            __builtin_amdgcn_fence(__ATOMIC_RELEASE, "agent");
            asm volatile("s_waitcnt vmcnt(0)" ::: "memory");
            const unsigned og = xb_add(&bar[XB_TOP], 1u);
            const unsigned tg = og / nx;
            if (og + 1u == (tg + 1u) * nx) xb_add(&bar[XB_TOPGEN], 1u);
            else XB_SPIN(xb_ld(&bar[XB_TOPGEN]) == tg, bar);
            __builtin_amdgcn_fence(__ATOMIC_ACQUIRE, "agent");
            xb_add(&bar[XB_XGEN(b.x)], 1u);
            asm volatile("s_waitcnt vmcnt(0)" ::: "memory");
        } else {
            XB_SPIN(xb_ld(&bar[XB_XGEN(b.x)]) == gen, bar);
            __builtin_amdgcn_fence(__ATOMIC_ACQUIRE, "agent");
            asm volatile("s_waitcnt vmcnt(0)" ::: "memory");
        }
    }
    __syncthreads();
}

struct Args { const float* in[34]; float* out; unsigned char* ws; int ph_lo, ph_hi, li, pad; };
struct Frame {
    LAS unsigned char* lds;
    volatile LAS unsigned* MISC;
    gu32* ctl;
    int tid, lane, wave, vcu, G;
    unsigned char* ws; float* out;
#ifdef MK_SUB
    unsigned long long pa, pb;
#endif
};
#ifdef MK_SUB
#define SUBM(k) do { if (MK_SUB == (k)) F.pa = __builtin_amdgcn_s_memrealtime(); if (MK_SUB + 1 == (k)) F.pb = __builtin_amdgcn_s_memrealtime(); } while (0)
#else
#define SUBM(k) do { } while (0)
#endif
enum { I_XP = 0, I_XS, I_CK, I_CV, I_PT, I_SWKV, I_SSH, I_NMIX, I_WIN, I_QG, I_KG, I_LQ1, I_LK1, I_LQ2, I_LK2, I_AOG, I_WPA, I_MU, I_W0, I_W2, I_A0, I_A2, I_G2,
       I_KK, I_KA, I_RK, I_GNW, I_GNB, I_WPB, I_WOUT, I_NFFN, I_WG, I_WU, I_WD };

__device__ __forceinline__ float wave_sum(float v) {
#pragma unroll
    for (int o = 1; o < 64; o <<= 1) v += __shfl_xor(v, o);
    return v;
}

__device__ __forceinline__ float dpp_rmir(float v) { return __builtin_bit_cast(float, __builtin_amdgcn_update_dpp(0, __builtin_bit_cast(int, v), 0x140, 0xF, 0xF, true)); }
__device__ __forceinline__ float sum32(float v) {
    v += __builtin_bit_cast(float, __builtin_amdgcn_update_dpp(0, __builtin_bit_cast(int, v), 0xB1, 0xF, 0xF, true));
    v += __builtin_bit_cast(float, __builtin_amdgcn_update_dpp(0, __builtin_bit_cast(int, v), 0x4E, 0xF, 0xF, true));
    v += __builtin_bit_cast(float, __builtin_amdgcn_update_dpp(0, __builtin_bit_cast(int, v), 0x141, 0xF, 0xF, true));
    v += dpp_rmir(v);
    v += __shfl_xor(v, 16);
    return v;
}
__device__ __forceinline__ void p0_transpose_item(const float* W, int K, int N, bf16* WT, int drow0, const float* kgain, LAS float* scr, int k0, int n0, int lane) {
    float v[32];
    const float* wp = W + (size_t)(k0 + (lane >> 5)) * N + n0 + (lane & 31);
#pragma unroll
    for (int i = 0; i < 32; ++i) v[i] = wp[(size_t)(2 * i) * N];
    const int c = lane & 7;
    f32x4 g0 = {1.f, 1.f, 1.f, 1.f}, g1 = g0;
    if (kgain) { g0 = *(const f32x4*)(kgain + k0 + 8 * c); g1 = *(const f32x4*)(kgain + k0 + 8 * c + 4); }
#pragma unroll
    for (int i = 0; i < 32; ++i) scr[(2 * i + (lane >> 5)) * 33 + (lane & 31)] = v[i];
    LDS_WAIT(); asm volatile("" ::: "memory");
#pragma unroll
    for (int j = 0; j < 4; ++j) { const int n = (lane >> 3) + 8 * j; const LAS float* s = scr + (8 * c) * 33 + n;
        v4u o; o.x = pk2(s[0 * 33] * g0[0], s[1 * 33] * g0[1]); o.y = pk2(s[2 * 33] * g0[2], s[3 * 33] * g0[3]); o.z = pk2(s[4 * 33] * g1[0], s[5 * 33] * g1[1]); o.w = pk2(s[6 * 33] * g1[2], s[7 * 33] * g1[3]);
        *(GAS v4u*)(WT + (size_t)(drow0 + n) * K + k0 + 8 * c) = o; }
    LDS_WAIT(); asm volatile("" ::: "memory");
}
template <int PART> __device__ __forceinline__ void p0_prologue(Frame& F, const Args& A, int gw, int NGW) {
    LAS float* scr = (LAS float*)(F.lds + RING_OFF + F.wave * 16384);
    bf16* Win_t = (bf16*)(F.ws + WS_WIN); bf16* Wpa_t = (bf16*)(F.ws + WS_WPA); bf16* Wpb_t = (bf16*)(F.ws + WS_WPB); bf16* Wout_t = (bf16*)(F.ws + WS_WOUT);
    bf16* Wgu_t = (bf16*)(F.ws + WS_WGU); bf16* Wdn_t = (bf16*)(F.ws + WS_WDN);
    constexpr int I_IN = (DM / 64) * (INW / 32), I_PA = (512 / 64) * (DM / 32), I_OUT = (DM / 64) * (DM / 32), I_G = (DM / 64) * (FF / 32), I_D = (FF / 64) * (DM / 32);
    constexpr int I_L = 16, NITEMS = I_IN + 2 * I_PA + I_OUT + 2 * I_G + I_D + 4 * I_L;
    constexpr int NP0 = I_IN + 4 * I_L, NP1 = NITEMS - NP0;
    for (int ix = gw; ix < (PART == 0 ? NP0 : NP1); ix += NGW) {
        int r = PART == 0 ? (ix < I_IN ? ix : ix - I_IN + (NITEMS - 4 * I_L)) : ix + I_IN;
        if (r < I_IN) { constexpr int nnb = INW / 32; const int kb = r / nnb, nb = r % nnb, pn = nb >> 3, q = nb & 7;
            p0_transpose_item(A.in[I_WIN], DM, INW, Win_t, 256 * pn + 32 * (4 * (q & 1) + (q >> 1)), A.in[I_NMIX], scr, 64 * kb, 32 * nb, F.lane); continue; } r -= I_IN;
        if (r < I_PA) { constexpr int nnb = DM / 32; const int kb = r / nnb, nb = r % nnb; p0_transpose_item(A.in[I_WPA], 512, DM, Wpa_t, 32 * nb, nullptr, scr, 64 * kb, 32 * nb, F.lane); continue; } r -= I_PA;
        if (r < I_PA) { constexpr int nnb = DM / 32; const int kb = r / nnb, nb = r % nnb; p0_transpose_item(A.in[I_WPB], 512, DM, Wpb_t, 32 * nb, nullptr, scr, 64 * kb, 32 * nb, F.lane); continue; } r -= I_PA;
        if (r < I_OUT) { constexpr int nnb = DM / 32; const int kb = r / nnb, nb = r % nnb; p0_transpose_item(A.in[I_WOUT], DM, DM, Wout_t, 32 * nb, nullptr, scr, 64 * kb, 32 * nb, F.lane); continue; } r -= I_OUT;
        if (r < I_G) { constexpr int nnb = FF / 32; const int kb = r / nnb, nb = r % nnb;
            p0_transpose_item(A.in[I_WG], DM, FF, Wgu_t, 256 * (nb >> 2) + 32 * (nb & 3), A.in[I_NFFN], scr, 64 * kb, 32 * nb, F.lane); continue; } r -= I_G;
        if (r < I_G) { constexpr int nnb = FF / 32; const int kb = r / nnb, nb = r % nnb;
            p0_transpose_item(A.in[I_WU], DM, FF, Wgu_t, 256 * (nb >> 2) + 128 + 32 * (nb & 3), A.in[I_NFFN], scr, 64 * kb, 32 * nb, F.lane); continue; } r -= I_G;
        if (r < I_D) { constexpr int nnb = DM / 32; const int kb = r / nnb, nb = r % nnb; p0_transpose_item(A.in[I_WD], FF, DM, Wdn_t, 32 * nb, nullptr, scr, 64 * kb, 32 * nb, F.lane); continue; } r -= I_D;
        { bf16* W2T = (bf16*)(F.ws + WS_LORA); bf16* A2T = W2T + 512 * 64; bf16* G2T = A2T + 512 * 64;
          if (r < I_L) p0_transpose_item(A.in[I_W2], 64, 512, W2T, 32 * r, nullptr, scr, 0, 32 * r, F.lane);
          else if (r < 2 * I_L) p0_transpose_item(A.in[I_A2], 64, 512, A2T, 32 * (r - I_L), nullptr, scr, 0, 32 * (r - I_L), F.lane);
          else { const int q = r - 2 * I_L; p0_transpose_item(A.in[I_G2], 128, 512, G2T, 32 * (q & 15), nullptr, scr, 64 * (q >> 4), 32 * (q & 15), F.lane); } }
    }
    if (PART != 0) return;
    bf16* XB = (bf16*)(F.ws + WS_XB); float* rs0 = (float*)(F.ws + WS_RS0);
    for (int m0 = gw; m0 < MTOT; m0 += 4 * NGW) {
        f32x4 v[4][4];
#pragma unroll
        for (int q = 0; q < 4; ++q) { const int m = m0 + q * NGW;
            if (m < MVALID) { const float* xrow = m < MP ? A.in[I_XP] + (size_t)m * DM : A.in[I_XS] + (size_t)(m - MP) * DM; const GAS f32x4* xr = (const GAS f32x4*)xrow + F.lane;
#pragma unroll
                for (int j = 0; j < 4; ++j) v[q][j] = xr[64 * j]; }
            else {
#pragma unroll
                for (int j = 0; j < 4; ++j) v[q][j] = (f32x4){0.f, 0.f, 0.f, 0.f}; } }
#pragma unroll
        for (int q = 0; q < 4; ++q) { const int m = m0 + q * NGW; if (m >= MTOT) continue;
            GAS unsigned long long* o8 = (GAS unsigned long long*)(XB + (size_t)m * DM) + F.lane; float s = 0.f;
#pragma unroll
            for (int j = 0; j < 4; ++j) { s += (v[q][j].x * v[q][j].x + v[q][j].y * v[q][j].y) + (v[q][j].z * v[q][j].z + v[q][j].w * v[q][j].w);
                o8[64 * j] = (unsigned long long)pk2(v[q][j].x, v[q][j].y) | ((unsigned long long)pk2(v[q][j].z, v[q][j].w) << 32); }
            s = sum32(s); { const auto rr = __builtin_amdgcn_permlane32_swap(__float_as_uint(s), __float_as_uint(s), false, false); s = __uint_as_float(rr[0]) + __uint_as_float(rr[1]); }
            if (F.lane == 0) rs0[m] = m < MVALID ? rsqrtf(s * (1.f / DM) + 1e-6f) : 0.f; }
    }
}

__device__ __forceinline__ int crow16(int r, int hi) { return (r & 3) + 8 * (r >> 2) + 4 * hi; }
__device__ __forceinline__ float lam_value(const Frame& F, const Args& A) {
    const int l = F.lane;
    const float a = wave_sum(A.in[I_LQ1][l] * A.in[I_LK1][l]), b = wave_sum(A.in[I_LQ2][l] * A.in[I_LK2][l]);
    return __expf(a) - __expf(b) + 0.2f;
}
__device__ __forceinline__ f32x4 ld_bf4(const bf16* p) { const v2u w = *(const v2u*)p; return (f32x4){bflo(w.x), bfhi(w.x), bflo(w.y), bfhi(w.y)}; }
__device__ __forceinline__ unsigned* rk_pair(const Frame& F, int i) { return (unsigned*)(F.ws + WS_RK + (size_t)i * RK_STRIDE); }
__device__ __forceinline__ bf16* rk_bf(const Frame& F, int i) { return (bf16*)(F.ws + WS_RK + (size_t)i * RK_STRIDE); }
__device__ __forceinline__ float* rk_arr(const Frame& F, int i) { return (float*)(F.ws + WS_RK + (size_t)i * RK_STRIDE); }

#define CRC(r) (((r) & 3) + 8 * ((r) >> 2))
constexpr int LIN_LD = 264, MS_LD = 1544;
__device__ __forceinline__ float tanh_fast(float x) { return 1.f - 2.f * __builtin_amdgcn_rcpf(1.f + __expf(2.f * x)); }
__device__ __forceinline__ void rwkv_prep_unit(Frame& F, const Args& A, int unit) {
    LAS bf16* msl = (LAS bf16*)(F.lds + RING_OFF);
    LAS bf16* lin = msl + 32 * MS_LD;
    const bf16* PC = (const bf16*)(F.ws + WS_PC);
    int r32_ = F.lane & 31, hi_ = F.lane >> 5; asm volatile("" : "+v"(r32_), "+v"(hi_));
    const int r0 = unit * 32, tid = F.tid, lane = F.lane, w = F.wave, r32 = r32_, hi = hi_;
    const float* mu = A.in[I_MU]; const float* ssh = A.in[I_SSH];
    if (unit < MP / 32) {
        f32x4 mu0[7], mu1[7];
#pragma unroll
        for (int k = 0; k < 7; ++k) { const int p = tid + 512 * k, c8 = p % 224; const unsigned om = (unsigned)(c8 * 32); mu0[k] = *(const f32x4*)((const unsigned char*)mu + om); mu1[k] = *(const f32x4*)((const unsigned char*)mu + om + 16); }
#pragma unroll 1
        for (int hb = 0; hb < 2; ++hb) {
            v4u cw[7], pw[7];
#pragma unroll
            for (int kk = 0; kk < 7; ++kk) { const int p = tid + 512 * (7 * hb + kk), t = p / 224, c8 = p - 224 * t, row = r0 + t; const bool first = (row & (SEQ - 1)) == 0;
                const unsigned oc = (unsigned)((row * RSW + 8 * c8) * 2), op = first ? oc : oc - (unsigned)(RSW * 2);
                cw[kk] = *(const v4u*)((const unsigned char*)PC + oc); pw[kk] = *(const v4u*)((const unsigned char*)PC + op); }
#pragma unroll
            for (int kk = 0; kk < 7; ++kk) {
                const int p = tid + 512 * (7 * hb + kk), t = p / 224, c8 = p - 224 * t, row = r0 + t; const bool first = (row & (SEQ - 1)) == 0;
                const v4u c_ = cw[kk], q_ = pw[kk]; const f32x4 m0 = mu0[kk], m1 = mu1[kk];
                float cur[8] = {bflo(c_.x), bfhi(c_.x), bflo(c_.y), bfhi(c_.y), bflo(c_.z), bfhi(c_.z), bflo(c_.w), bfhi(c_.w)};
                float prv[8] = {bflo(q_.x), bfhi(q_.x), bflo(q_.y), bfhi(q_.y), bflo(q_.z), bfhi(q_.z), bflo(q_.w), bfhi(q_.w)};
                float m[8];
#pragma unroll
                for (int j = 0; j < 8; ++j) prv[j] = first ? 0.f : prv[j];
#pragma unroll
                for (int j = 0; j < 4; ++j) { m[j] = cur[j] + (prv[j] - cur[j]) * m0[j]; m[4 + j] = cur[4 + j] + (prv[4 + j] - cur[4 + j]) * m1[j]; }
                if (c8 >= 192) { const int ci = 8 * (c8 - 192);
#pragma unroll
                    for (int j = 0; j < 8; ++j) { if (ci < 64) m[j] = tanh_fast(m[j]); else if (ci >= 128) m[j] = sigmoidf_(m[j]); }
                    *(LAS v4u*)(lin + t * LIN_LD + ci) = (v4u){pk2(m[0], m[1]), pk2(m[2], m[3]), pk2(m[4], m[5]), pk2(m[6], m[7])}; }
                else *(LAS v4u*)(msl + t * MS_LD + 8 * c8) = (v4u){pk2(m[0], m[1]), pk2(m[2], m[3]), pk2(m[4], m[5]), pk2(m[6], m[7])};
            }
        }
    } else {
#pragma unroll 7
    for (int k = 0; k < 14; ++k) {
        const int p = tid + 512 * k, t = p / 224, c8 = p - 224 * t, row = r0 + t;
        const v4u cw = *(const v4u*)(PC + (size_t)row * RSW + 8 * c8);
        float cur[8] = {bflo(cw.x), bfhi(cw.x), bflo(cw.y), bfhi(cw.y), bflo(cw.z), bfhi(cw.z), bflo(cw.w), bfhi(cw.w)}, prv[8];
        if (row >= MP) { const f32x4 a = *(const f32x4*)(ssh + (size_t)(row - MP) * RSW + 8 * c8), b = *(const f32x4*)(ssh + (size_t)(row - MP) * RSW + 8 * c8 + 4);
#pragma unroll
            for (int j = 0; j < 4; ++j) { prv[j] = a[j]; prv[4 + j] = b[j]; } }
        else if ((row & (SEQ - 1)) == 0) {
#pragma unroll
            for (int j = 0; j < 8; ++j) prv[j] = 0.f; }
        else { const v4u pw = *(const v4u*)(PC + (size_t)(row - 1) * RSW + 8 * c8);
            prv[0] = bflo(pw.x); prv[1] = bfhi(pw.x); prv[2] = bflo(pw.y); prv[3] = bfhi(pw.y); prv[4] = bflo(pw.z); prv[5] = bfhi(pw.z); prv[6] = bflo(pw.w); prv[7] = bfhi(pw.w); }
        const f32x4 m0 = *(const f32x4*)(mu + 8 * c8), m1 = *(const f32x4*)(mu + 8 * c8 + 4);
        float m[8];
#pragma unroll
        for (int j = 0; j < 4; ++j) { m[j] = cur[j] + (prv[j] - cur[j]) * m0[j]; m[4 + j] = cur[4 + j] + (prv[4 + j] - cur[4 + j]) * m1[j]; }
        if (c8 >= 192) { const int ci = 8 * (c8 - 192);
#pragma unroll
            for (int j = 0; j < 8; ++j) { if (ci < 64) m[j] = tanh_fast(m[j]); else if (ci >= 128) m[j] = sigmoidf_(m[j]); }
            *(LAS v4u*)(lin + t * LIN_LD + ci) = (v4u){pk2(m[0], m[1]), pk2(m[2], m[3]), pk2(m[4], m[5]), pk2(m[6], m[7])}; }
        else *(LAS v4u*)(msl + t * MS_LD + 8 * c8) = (v4u){pk2(m[0], m[1]), pk2(m[2], m[3]), pk2(m[4], m[5]), pk2(m[6], m[7])};
    }
    }
    __syncthreads();
    f32x16 wl[2], al[2], gg[2];
    const bf16* W2T = (const bf16*)(F.ws + WS_LORA); const bf16* A2T = W2T + 512 * 64; const bf16* G2T = A2T + 512 * 64;
#pragma unroll
    for (int ct = 0; ct < 2; ++ct) {
        const int ch = 64 * w + 2 * r32 + ct;
        f32x16 a0 = (f32x16){}, a1 = (f32x16){}, a2 = (f32x16){};
#pragma unroll
        for (int ks = 0; ks < 4; ++ks) {
            const bf16x8 x0 = *(const LAS bf16x8*)(lin + r32 * LIN_LD + 16 * ks + 8 * hi), x1 = *(const LAS bf16x8*)(lin + r32 * LIN_LD + 64 + 16 * ks + 8 * hi);
            const bf16x8 b0 = *(const bf16x8*)(W2T + (size_t)ch * 64 + 16 * ks + 8 * hi), b1 = *(const bf16x8*)(A2T + (size_t)ch * 64 + 16 * ks + 8 * hi);
            a0 = __builtin_amdgcn_mfma_f32_32x32x16_bf16(x0, b0, a0, 0, 0, 0); a1 = __builtin_amdgcn_mfma_f32_32x32x16_bf16(x1, b1, a1, 0, 0, 0);
        }
#pragma unroll
        for (int ks = 0; ks < 8; ++ks) {
            const bf16x8 x2 = *(const LAS bf16x8*)(lin + r32 * LIN_LD + 128 + 16 * ks + 8 * hi);
            const bf16x8 b2 = *(const bf16x8*)(G2T + (size_t)ch * 128 + 16 * ks + 8 * hi);
            a2 = __builtin_amdgcn_mfma_f32_32x32x16_bf16(x2, b2, a2, 0, 0, 0);
        }
        wl[ct] = a0; al[ct] = a1; gg[ct] = a2;
    }
    bf16* aR = rk_bf(F, 0); float* aW = rk_arr(F, 1); bf16* aK = rk_bf(F, 2); bf16* aV = rk_bf(F, 3); bf16* aA = rk_bf(F, 4); bf16* aB = rk_bf(F, 5); bf16* aG = rk_bf(F, 6);
    float* BON = (float*)(F.ws + WS_BON3);
    float w0c[2], a0c[2], kkc[2], kac[2], rkc[2];
#pragma unroll
    for (int ct = 0; ct < 2; ++ct) { const int ch = 64 * w + 2 * r32 + ct; w0c[ct] = A.in[I_W0][ch]; a0c[ct] = A.in[I_A0][ch]; kkc[ct] = A.in[I_KK][ch]; kac[ct] = A.in[I_KA][ch]; rkc[ct] = A.in[I_RK][ch]; }
    if (unit < MP / 32) {
        float lwv[2][16], pin[2][16], off[2];
        int r32o = r32; asm volatile("" : "+v"(r32o));
#pragma unroll
        for (int ct = 0; ct < 2; ++ct)
#pragma unroll
            for (int r = 0; r < 16; ++r) { const float x = -(w0c[ct] + wl[ct][r]), sp = fmaxf(x, 0.f) + __logf(1.f + __expf(-fabsf(x))); lwv[ct][r] = -__expf(-sp - 0.5f); }
#pragma unroll
        for (int ct = 0; ct < 2; ++ct) { float run = 0.f;
#pragma unroll
            for (int q = 0; q < 4; ++q) { const float c0 = lwv[ct][4 * q], c1 = c0 + lwv[ct][4 * q + 1], c2 = c1 + lwv[ct][4 * q + 2], c3 = c2 + lwv[ct][4 * q + 3];
                const float oth = __shfl_xor(c3, 32), base = run + (hi ? oth : 0.f);
                pin[ct][4 * q] = base + c0; pin[ct][4 * q + 1] = base + c1; pin[ct][4 * q + 2] = base + c2; pin[ct][4 * q + 3] = base + c3; run += c3 + oth; }
            off[ct] = (unit & 1) ? 0.f : run;
            if (hi == 0) ((float*)(F.ws + WS_HT))[(size_t)unit * 512 + 64 * w + 2 * r32o + ct] = __expf(run); }
        bf16* scb = (bf16*)(F.ws + WS_SC) + ((size_t)(((unit >> 7) * 8 + w) * 64 + ((unit >> 1) & 63)) * 5 * 64 + 32 * (unit & 1) + 4 * hi) * 64 + 2 * r32o;
#pragma unroll
        for (int r = 0; r < 16; ++r) {
            const int t = crow16(r, hi), row = r0 + t;
            float rr[2], kv[2], vv[2], kkv[2], av[2], wv[2];
            float ss = 0.f;
#pragma unroll
            for (int ct = 0; ct < 2; ++ct) { const int ch = 64 * w + 2 * r32 + ct;
                rr[ct] = bf2f(msl[t * MS_LD + ch]); kv[ct] = bf2f(msl[t * MS_LD + 512 + ch]); vv[ct] = bf2f(msl[t * MS_LD + 1024 + ch]);
                wv[ct] = __expf(lwv[ct][r]);
                av[ct] = sigmoidf_(a0c[ct] + al[ct][r]);
                kkv[ct] = kv[ct] * kkc[ct]; ss += kkv[ct] * kkv[ct];
            }
            ss = sum32(ss);
            const float rn = rsqrtf(fmaxf(ss, 1e-24f));
            float bon = 0.f, br = 0.f, kr = 0.f, kk[2], kp[2];
#pragma unroll
            for (int ct = 0; ct < 2; ++ct) { kk[ct] = kkv[ct] * rn; kp[ct] = kv[ct] * (1.f + (av[ct] - 1.f) * kac[ct]);
                bon += rr[ct] * kp[ct] * rkc[ct]; br += kk[ct] * av[ct] * rr[ct]; kr += kp[ct] * rr[ct]; }
            bon = sum32(bon); br = sum32(br); kr = sum32(kr);
            { float Fm[2], Fi[2];
#pragma unroll
              for (int ct = 0; ct < 2; ++ct) { Fm[ct] = __expf(pin[ct][r] - lwv[ct][r] - off[ct]); Fi[ct] = __expf(off[ct] - pin[ct][r]); }
              unsigned* sp_ = (unsigned*)(scb + CRC(r) * 64);
              sp_[0 * 2048] = pk2(-kk[0] * Fm[0], -kk[1] * Fm[1]);
              sp_[1 * 2048] = pk2(kk[0] * av[0] * Fi[0], kk[1] * av[1] * Fi[1]);
              sp_[2 * 2048] = pk2(kp[0] * Fi[0], kp[1] * Fi[1]);
              sp_[3 * 2048] = pk2(wv[0] * rr[0] * Fm[0], wv[1] * rr[1] * Fm[1]);
              sp_[4 * 2048] = pk2(vv[0], vv[1]);
              *(v2u*)(rk_pair(F, 2) + (size_t)row * 512 + 64 * w + 2 * r32o) = (v2u){pk2(vv[0], gg[0][r]), pk2(vv[1], gg[1][r])}; }
            if (r32 == 0) *(f32x4*)(BON + (size_t)(row * 8 + w) * 4) = (f32x4){bon, br, kr, 0.f};
        }
    } else {
#pragma unroll 4
    for (int r = 0; r < 16; ++r) {
        const int t = crow16(r, hi), row = r0 + t;
        float rr[2], kv[2], vv[2], kkv[2], av[2], wv[2];
        float ss = 0.f;
#pragma unroll
        for (int ct = 0; ct < 2; ++ct) { const int ch = 64 * w + 2 * r32 + ct;
            rr[ct] = bf2f(msl[t * MS_LD + ch]); kv[ct] = bf2f(msl[t * MS_LD + 512 + ch]); vv[ct] = bf2f(msl[t * MS_LD + 1024 + ch]);
            const float x = -(w0c[ct] + wl[ct][r]), sp = fmaxf(x, 0.f) + __logf(1.f + __expf(-fabsf(x)));
            const float e = __expf(-sp - 0.5f); wv[ct] = __expf(-e);
            av[ct] = sigmoidf_(a0c[ct] + al[ct][r]);
            kkv[ct] = kv[ct] * kkc[ct]; ss += kkv[ct] * kkv[ct];
        }
        ss = sum32(ss);
        const float rn = rsqrtf(fmaxf(ss, 1e-24f));
        float bon = 0.f, br = 0.f, kr = 0.f, kk[2], kp[2];
#pragma unroll
        for (int ct = 0; ct < 2; ++ct) { kk[ct] = kkv[ct] * rn; kp[ct] = kv[ct] * (1.f + (av[ct] - 1.f) * kac[ct]);
            bon += rr[ct] * kp[ct] * rkc[ct]; br += kk[ct] * av[ct] * rr[ct]; kr += kp[ct] * rr[ct]; }
        bon = sum32(bon); br = sum32(br); kr = sum32(kr);
#pragma unroll
        for (int ct = 0; ct < 2; ++ct) { const size_t o = (size_t)row * 512 + 64 * w + 2 * r32 + ct;
            aW[o] = wv[ct]; rk_pair(F, 0)[o] = pk2(wv[ct] * rr[ct], kp[ct]); rk_pair(F, 2)[o] = pk2(vv[ct], gg[ct][r]); rk_pair(F, 4)[o] = pk2(-kk[ct], kk[ct] * av[ct]); }
        if (r32 == 0) *(f32x4*)(BON + (size_t)(row * 8 + w) * 4) = (f32x4){bon, br, kr, 0.f};
    }
    }
    __syncthreads();
}

constexpr int NSEG = 8, SEGT = SEQ / NSEG;
__device__ __forceinline__ float dpp_xor1(float v) { return __builtin_bit_cast(float, __builtin_amdgcn_update_dpp(0, __builtin_bit_cast(int, v), 0xB1, 0xF, 0xF, true)); }
__device__ __forceinline__ float dpp_xor2(float v) { return __builtin_bit_cast(float, __builtin_amdgcn_update_dpp(0, __builtin_bit_cast(int, v), 0x4E, 0xF, 0xF, true)); }
__device__ __forceinline__ float dpp_hmir(float v) { return __builtin_bit_cast(float, __builtin_amdgcn_update_dpp(0, __builtin_bit_cast(int, v), 0x141, 0xF, 0xF, true)); }
__device__ __forceinline__ float red8(float v) { v += dpp_xor1(v); v += dpp_xor2(v); v += dpp_hmir(v); return v; }
__device__ __forceinline__ void gn_store(Frame& F, const Args& A, int row, int h, int q, f32x4 yv, f32x4 vv) {
    const float* BON = (const float*)(F.ws + WS_BON3); const bf16* aG = rk_bf(F, 6); bf16* RW = (bf16*)(F.ws + WS_RW);
    float s = (yv[0] + yv[1]) + (yv[2] + yv[3]);
    s += __shfl_xor(s, 1); s += __shfl_xor(s, 2); s += __shfl_xor(s, 4); s += __shfl_xor(s, 8);
    const float mean = s * (1.f / 64.f); const f32x4 d = yv - mean;
    float s2 = (d[0] * d[0] + d[1] * d[1]) + (d[2] * d[2] + d[3] * d[3]);
    s2 += __shfl_xor(s2, 1); s2 += __shfl_xor(s2, 2); s2 += __shfl_xor(s2, 4); s2 += __shfl_xor(s2, 8);
    const float rstd = rsqrtf(s2 * (1.f / 64.f) + 64e-5f), bon = BON[(row * 8 + h) * 4];
    const int cbase = h * 64 + 4 * q;
    const f32x4 gw = *(const f32x4*)(A.in[I_GNW] + cbase), gb = *(const f32x4*)(A.in[I_GNB] + cbase), gv = [&]{ const v4u pg = *(const v4u*)(rk_pair(F, 2) + (size_t)row * 512 + cbase); return (f32x4){bfhi(pg.x), bfhi(pg.y), bfhi(pg.z), bfhi(pg.w)}; }();
    const f32x4 o = (d * rstd * gw + gb + bon * vv) * gv;
    v2u w; w.x = pk2(o[0], o[1]); w.y = pk2(o[2], o[3]);
    *(v2u*)(RW + (size_t)row * 512 + cbase) = w;
}
struct ScanIn { f32x4 a0, a1, r0, r1, w0, w1, b0, b1, k0, k1; float vi, br, kr; };
__device__ __forceinline__ void scan_seg_unit(Frame& F, const Args& A, int u) {
    constexpr int TB = 32, VB = 6 * TB * 64 + 2 * TB;
    LAS float* vecs = (LAS float*)(F.lds + RING_OFF);
    LAS float* ybuf = vecs + 2 * VB;
    LAS float* cbuf = ybuf + TB * 64;
    const int tid = F.tid, i = tid >> 3, seg8 = tid & 7;
    const bool prompt = u < 256;
    int h, row0, T; bool useF; f32x2 S[4], Fm[4];
    if (prompt) { h = (u >> 3) & 7; row0 = (u >> 6) * SEQ + (u & 7) * SEGT; T = SEGT; useF = (u & 7) != 0;
#pragma unroll
        for (int c = 0; c < 4; ++c) { S[c] = (f32x2){0.f, 0.f}; Fm[c] = (f32x2){(8 * seg8 + 2 * c == i) ? 1.f : 0.f, (8 * seg8 + 2 * c + 1 == i) ? 1.f : 0.f}; } }
    else { const int su = u - 256; h = su & 7; row0 = MP + (su >> 3); T = 1; useF = false;
        const float* s0 = A.in[I_SWKV] + ((size_t)su * 64 + i) * 64 + 8 * seg8;
        const f32x4 a = *(const f32x4*)s0, b = *(const f32x4*)(s0 + 4);
        S[0] = (f32x2){a[0], a[1]}; S[1] = (f32x2){a[2], a[3]}; S[2] = (f32x2){b[0], b[1]}; S[3] = (f32x2){b[2], b[3]};
#pragma unroll
        for (int c = 0; c < 4; ++c) Fm[c] = (f32x2){0.f, 0.f}; }
    const float* BON = (const float*)(F.ws + WS_BON3);
    float* Y0 = (float*)(F.ws + WS_Y0); float* CC = (float*)(F.ws + WS_CC);
    f32x4 sg[6]; float sgs = 0.f;
    const int st = tid >> 4, sq = tid & 15;
#define SCAN_STAGE_LOAD(t0_) do { const int nb_ = (T - (t0_)) < TB ? (T - (t0_)) : TB; if (st < nb_) { const size_t go_ = (size_t)(row0 + (t0_) + st) * 512 + h * 64 + 4 * sq; \
        sg[1] = *(const f32x4*)(rk_arr(F, 1) + go_); const v4u p0_ = *(const v4u*)(rk_pair(F, 0) + go_), p2_ = *(const v4u*)(rk_pair(F, 2) + go_), p4_ = *(const v4u*)(rk_pair(F, 4) + go_); \
        sg[0] = (f32x4){bflo(p0_.x), bflo(p0_.y), bflo(p0_.z), bflo(p0_.w)}; sg[2] = (f32x4){bfhi(p0_.x), bfhi(p0_.y), bfhi(p0_.z), bfhi(p0_.w)}; sg[3] = (f32x4){bflo(p2_.x), bflo(p2_.y), bflo(p2_.z), bflo(p2_.w)}; \
        sg[4] = (f32x4){bflo(p4_.x), bflo(p4_.y), bflo(p4_.z), bflo(p4_.w)}; sg[5] = (f32x4){bfhi(p4_.x), bfhi(p4_.y), bfhi(p4_.z), bfhi(p4_.w)}; } \
        if (tid < 2 * TB && (tid >> 1) < nb_) sgs = BON[((row0 + (t0_) + (tid >> 1)) * 8 + h) * 4 + 1 + (tid & 1)]; } while (0)
#define SCAN_STAGE_STORE(buf_) do { LAS float* vb_ = vecs + (buf_) * VB; _Pragma("unroll") for (int a_ = 0; a_ < 6; ++a_) *(LAS f32x4*)(vb_ + (a_ * TB + st) * 64 + 4 * sq) = sg[a_]; \
        if (tid < 2 * TB) vb_[6 * TB * 64 + tid] = sgs; } while (0)
    SCAN_STAGE_LOAD(0); SCAN_STAGE_STORE(0);
    __syncthreads();
    int buf = 0;
    for (int t0 = 0; t0 < T; t0 += TB, buf ^= 1) {
        const int nb = (T - t0) < TB ? (T - t0) : TB;
        const bool more = t0 + TB < T;
        if (more) SCAN_STAGE_LOAD(t0 + TB);
        const LAS float* vec = vecs + buf * VB; const LAS float* scl = vec + 6 * TB * 64;
#define SCAN_LOADIN(X, t_) do { const LAS float* p_ = vec + (t_) * 64 + 8 * seg8; \
        X.r0 = *(const LAS f32x4*)(p_); X.r1 = *(const LAS f32x4*)(p_ + 4); X.w0 = *(const LAS f32x4*)(p_ + TB * 64); X.w1 = *(const LAS f32x4*)(p_ + TB * 64 + 4); \
        X.k0 = *(const LAS f32x4*)(p_ + 2 * TB * 64); X.k1 = *(const LAS f32x4*)(p_ + 2 * TB * 64 + 4); X.a0 = *(const LAS f32x4*)(p_ + 4 * TB * 64); X.a1 = *(const LAS f32x4*)(p_ + 4 * TB * 64 + 4); \
        X.b0 = *(const LAS f32x4*)(p_ + 5 * TB * 64); X.b1 = *(const LAS f32x4*)(p_ + 5 * TB * 64 + 4); X.vi = vec[(3 * TB + (t_)) * 64 + i]; X.br = scl[2 * (t_)]; X.kr = scl[2 * (t_) + 1]; } while (0)
#define LO2(v) ((f32x2){(v)[0], (v)[1]})
#define HI2(v) ((f32x2){(v)[2], (v)[3]})
#define SCAN_STEP(X, Y, t_) do { \
        const f32x2 a_[4] = {LO2(X.a0), HI2(X.a0), LO2(X.a1), HI2(X.a1)}, r_[4] = {LO2(X.r0), HI2(X.r0), LO2(X.r1), HI2(X.r1)}; \
        const f32x2 w_[4] = {LO2(X.w0), HI2(X.w0), LO2(X.w1), HI2(X.w1)}, b_[4] = {LO2(X.b0), HI2(X.b0), LO2(X.b1), HI2(X.b1)}, k_[4] = {LO2(X.k0), HI2(X.k0), LO2(X.k1), HI2(X.k1)}; \
        const float br_ = X.br, kr_ = X.kr, vi_ = X.vi; \
        f32x2 d1 = S[0] * a_[0], d2 = S[0] * r_[0], f1 = Fm[0] * a_[0], f2 = Fm[0] * r_[0]; \
        _Pragma("unroll") for (int c = 1; c < 4; ++c) { d1 += S[c] * a_[c]; d2 += S[c] * r_[c]; f1 += Fm[c] * a_[c]; f2 += Fm[c] * r_[c]; } \
        f32x2 tS[4], tF[4]; _Pragma("unroll") for (int c = 0; c < 4; ++c) { tS[c] = S[c] * w_[c] + vi_ * k_[c]; tF[c] = Fm[c] * w_[c]; } \
        { int tn_ = (t_) + 1;     \
          asm volatile("" : "+v"(tn_) : "v"(d1), "v"(d2), "v"(f1), "v"(f2), "v"(tS[0]), "v"(tS[1]), "v"(tS[2]), "v"(tS[3]), "v"(tF[0]), "v"(tF[1]), "v"(tF[2]), "v"(tF[3])); \
          if ((t_) + 1 < nb) SCAN_LOADIN(Y, tn_); } \
        float q0 = d1.x + d1.y, q1 = d2.x + d2.y, q2 = f1.x + f1.y, q3 = f2.x + f2.y; \
        q0 += dpp_xor1(q0); q1 += dpp_xor1(q1); q2 += dpp_xor1(q2); q3 += dpp_xor1(q3); \
        q0 += dpp_xor2(q0); q1 += dpp_xor2(q1); q2 += dpp_xor2(q2); q3 += dpp_xor2(q3); \
        q0 += dpp_hmir(q0); q1 += dpp_hmir(q1); q2 += dpp_hmir(q2); q3 += dpp_hmir(q3); \
        _Pragma("unroll") for (int c = 0; c < 4; ++c) { S[c] = tS[c] + q0 * b_[c]; Fm[c] = tF[c] + q2 * b_[c]; } \
        if (seg8 == 0) { ybuf[(t_) * 64 + i] = q1 + q0 * br_ + vi_ * kr_; cbuf[(t_) * 64 + i] = q3 + q2 * br_; } } while (0)
        ScanIn IA, IB;
        SCAN_LOADIN(IA, 0);
        for (int t = 0; t < nb; t += 2) {
            SCAN_STEP(IA, IB, t);
            if (t + 1 < nb) SCAN_STEP(IB, IA, t + 1);
        }
        if (more) SCAN_STAGE_STORE(buf ^ 1);
        __syncthreads();
        { const int t = tid >> 4, q = tid & 15;
          if (t < nb) { const int row = row0 + t0 + t;
            const f32x4 yv = *(const LAS f32x4*)(ybuf + t * 64 + 4 * q);
            if (prompt) { *(f32x4*)(Y0 + (size_t)row * 512 + h * 64 + 4 * q) = yv; if (useF) *(f32x4*)(CC + (size_t)row * 512 + h * 64 + 4 * q) = *(const LAS f32x4*)(cbuf + t * 64 + 4 * q); }
            else gn_store(F, A, row, h, q, yv, *(const LAS f32x4*)(vec + (3 * TB + t) * 64 + 4 * q)); } }
        __syncthreads();
    }
#undef SCAN_STAGE_LOAD
#undef SCAN_STAGE_STORE
#undef SCAN_LOADIN
#undef SCAN_STEP
#undef LO2
#undef HI2
    const f32x4 s0v = {S[0].x, S[0].y, S[1].x, S[1].y}, s1v = {S[2].x, S[2].y, S[3].x, S[3].y};
    if (prompt) { float* ps = (float*)(F.ws + WS_PSI) + ((size_t)u * 64 + i) * 64 + 8 * seg8; *(f32x4*)ps = s0v; *(f32x4*)(ps + 4) = s1v;
        if (useF) { float* ph = (float*)(F.ws + WS_PHI) + ((size_t)u * 64 + i) * 64 + 8 * seg8; *(f32x4*)ph = (f32x4){Fm[0].x, Fm[0].y, Fm[1].x, Fm[1].y}; *(f32x4*)(ph + 4) = (f32x4){Fm[2].x, Fm[2].y, Fm[3].x, Fm[3].y}; } }
    else { float* so = F.out + O_WS + ((size_t)(u - 256) * 64 + i) * 64 + 8 * seg8; *(f32x4*)so = s0v; *(f32x4*)(so + 4) = s1v; }
    __syncthreads();
}
__device__ __forceinline__ void carry_unit(Frame& F, const Args& A, int bh) {
    LAS float* X = (LAS float*)(F.lds + RING_OFF);
    LAS float* P = X + 4096;
    const int tid = F.tid, i = tid >> 3, seg8 = tid & 7;
    float* SST = (float*)(F.ws + WS_SST); const float* PSI = (const float*)(F.ws + WS_PSI); const float* PHI = (const float*)(F.ws + WS_PHI);
    float cur[8];
#pragma unroll
    for (int c = 0; c < 8; ++c) cur[c] = 0.f;
    for (int k = 0; k < NSEG; ++k) {
        const size_t uo = ((size_t)(bh * NSEG + k) * 64 + i) * 64 + 8 * seg8;
        *(f32x4*)(SST + uo) = (f32x4){cur[0], cur[1], cur[2], cur[3]}; *(f32x4*)(SST + uo + 4) = (f32x4){cur[4], cur[5], cur[6], cur[7]};
        const f32x4 p0 = *(const f32x4*)(PSI + uo), p1 = *(const f32x4*)(PSI + uo + 4);
        float nx[8] = {p0[0], p0[1], p0[2], p0[3], p1[0], p1[1], p1[2], p1[3]};
        if (k > 0) {
            __syncthreads();
            *(LAS f32x4*)(X + i * 64 + 8 * seg8) = (f32x4){cur[0], cur[1], cur[2], cur[3]}; *(LAS f32x4*)(X + i * 64 + 8 * seg8 + 4) = (f32x4){cur[4], cur[5], cur[6], cur[7]};
            *(LAS f32x4*)(P + i * 64 + 8 * seg8) = *(const f32x4*)(PHI + uo); *(LAS f32x4*)(P + i * 64 + 8 * seg8 + 4) = *(const f32x4*)(PHI + uo + 4);
            __syncthreads();
#pragma unroll 4
            for (int l = 0; l < 64; ++l) { const float x = X[i * 64 + l]; const f32x4 q0 = *(const LAS f32x4*)(P + l * 64 + 8 * seg8), q1 = *(const LAS f32x4*)(P + l * 64 + 8 * seg8 + 4);
#pragma unroll
                for (int c = 0; c < 4; ++c) { nx[c] += x * q0[c]; nx[4 + c] += x * q1[c]; } }
        }
#pragma unroll
        for (int c = 0; c < 8; ++c) cur[c] = nx[c];
    }
    float* so = F.out + O_WP + ((size_t)bh * 64 + i) * 64 + 8 * seg8; *(f32x4*)so = (f32x4){cur[0], cur[1], cur[2], cur[3]}; *(f32x4*)(so + 4) = (f32x4){cur[4], cur[5], cur[6], cur[7]};
    __syncthreads();
}
__device__ __forceinline__ void corr_unit(Frame& F, const Args& A, int u) {
    const int lane = F.lane, w = F.wave, r32 = lane & 31, hi = lane >> 5, seg = u & 7, bh = u >> 3, h = bh & 7, rowseg = (bh >> 3) * SEQ + seg * SEGT;
    const float* SST = (const float*)(F.ws + WS_SST) + (size_t)u * 4096; const float* CC = (const float*)(F.ws + WS_CC); const float* Y0 = (const float*)(F.ws + WS_Y0);
    const float* BON = (const float*)(F.ws + WS_BON3); const bf16* aG = rk_bf(F, 6); const bf16* aV = rk_bf(F, 3); bf16* RW = (bf16*)(F.ws + WS_RW);
    bf16x8 sb[2][4];
    if (seg > 0) {
#pragma unroll
        for (int ct = 0; ct < 2; ++ct)
#pragma unroll
            for (int ks = 0; ks < 4; ++ks) { const float* p = SST + (size_t)(32 * ct + r32) * 64 + 16 * ks + 8 * hi; const f32x4 x = *(const f32x4*)p, y = *(const f32x4*)(p + 4);
                const v4u t = {pk2(x[0], x[1]), pk2(x[2], x[3]), pk2(y[0], y[1]), pk2(y[2], y[3])}; sb[ct][ks] = __builtin_bit_cast(bf16x8, t); }
    }
    float gw[2], gb[2];
#pragma unroll
    for (int ct = 0; ct < 2; ++ct) { gw[ct] = A.in[I_GNW][h * 64 + 32 * ct + r32]; gb[ct] = A.in[I_GNB][h * 64 + 32 * ct + r32]; }
    for (int blk = w; blk < SEGT / 32; blk += NWAVES) {
        const int row0 = rowseg + 32 * blk;
        f32x16 d[2]; d[0] = (f32x16){}; d[1] = (f32x16){};
        float yv0[16], yv1[16], bnv[16]; unsigned vgv0[16], vgv1[16];
#pragma unroll
        for (int r = 0; r < 16; ++r) { const int row = row0 + crow16(r, hi); const size_t o = (size_t)row * 512 + h * 64 + r32;
            yv0[r] = Y0[o]; yv1[r] = Y0[o + 32]; vgv0[r] = rk_pair(F, 2)[o]; vgv1[r] = rk_pair(F, 2)[o + 32]; bnv[r] = BON[(row * 8 + h) * 4]; }
        if (seg > 0) {
#pragma unroll
            for (int ks = 0; ks < 4; ++ks) { const float* p = CC + (size_t)(row0 + r32) * 512 + h * 64 + 16 * ks + 8 * hi; const f32x4 x = *(const f32x4*)p, y = *(const f32x4*)(p + 4);
                const v4u t = {pk2(x[0], x[1]), pk2(x[2], x[3]), pk2(y[0], y[1]), pk2(y[2], y[3])}; const bf16x8 cf = __builtin_bit_cast(bf16x8, t);
                d[0] = __builtin_amdgcn_mfma_f32_32x32x16_bf16(cf, sb[0][ks], d[0], 0, 0, 0); d[1] = __builtin_amdgcn_mfma_f32_32x32x16_bf16(cf, sb[1][ks], d[1], 0, 0, 0); }
        }
#pragma unroll
        for (int r = 0; r < 16; ++r) {
            const int row = row0 + crow16(r, hi); const size_t o = (size_t)row * 512 + h * 64 + r32;
            const float y0 = yv0[r] + d[0][r], y1 = yv1[r] + d[1][r];
            const float mean = sum32(y0 + y1) * (1.f / 64.f), e0 = y0 - mean, e1 = y1 - mean;
            const float rstd = rsqrtf(sum32(e0 * e0 + e1 * e1) * (1.f / 64.f) + 64e-5f), bon = bnv[r];
            const unsigned vg0 = vgv0[r], vg1 = vgv1[r];
            const float o0 = (e0 * rstd * gw[0] + gb[0] + bon * bflo(vg0)) * bfhi(vg0), o1 = (e1 * rstd * gw[1] + gb[1] + bon * bflo(vg1)) * bfhi(vg1);
            RW[o] = (bf16)(pk2(o0, 0.f) & 0xffffu); RW[o + 32] = (bf16)(pk2(o1, 0.f) & 0xffffu);
        }
    }
}

typedef short v4i16_t __attribute__((ext_vector_type(4)));
__device__ __forceinline__ s16x4 vtr(const LAS unsigned char* p) { return __builtin_bit_cast(s16x4, __builtin_amdgcn_ds_read_tr16_b64_v4i16((LAS v4i16_t*)p)); }
constexpr int IMG_LD = 136;
constexpr int IMG_BYTES = 64 * IMG_LD;
typedef bf16x8 Frag[2][4];
__device__ __forceinline__ void mm64(const Frag& Af, const Frag& Bf, f32x16 (&D)[2][2]) {
#pragma unroll
    for (int rt = 0; rt < 2; ++rt)
#pragma unroll
        for (int ct = 0; ct < 2; ++ct)
#pragma unroll
            for (int ks = 0; ks < 4; ++ks) D[rt][ct] = __builtin_amdgcn_mfma_f32_32x32x16_bf16(Af[rt][ks], Bf[ct][ks], D[rt][ct], 0, 0, 0);
}
__device__ __forceinline__ void acc_zero(f32x16 (&D)[2][2]) {
#pragma unroll
    for (int a = 0; a < 2; ++a)
#pragma unroll
        for (int b = 0; b < 2; ++b) D[a][b] = (f32x16){};
}
__device__ __forceinline__ void acc_frag(const f32x16 (&X)[2][2], Frag& Fr) {
#pragma unroll
    for (int rt = 0; rt < 2; ++rt)
#pragma unroll
        for (int ct = 0; ct < 2; ++ct)
#pragma unroll
            for (int hf = 0; hf < 2; ++hf) { const int rb = 8 * hf;
                const v4u u = {pk2(X[rt][ct][rb], X[rt][ct][rb + 1]), pk2(X[rt][ct][rb + 2], X[rt][ct][rb + 3]), pk2(X[rt][ct][rb + 4], X[rt][ct][rb + 5]), pk2(X[rt][ct][rb + 6], X[rt][ct][rb + 7])};
                Fr[ct][2 * rt + hf] = __builtin_bit_cast(bf16x8, u); }
}
__device__ __forceinline__ void rowfrag(const LAS unsigned char* img, int lane, Frag& Fr) {
    const int r32 = lane & 31, hi = lane >> 5;
#pragma unroll
    for (int tl = 0; tl < 2; ++tl)
#pragma unroll
        for (int ks = 0; ks < 4; ++ks) Fr[tl][ks] = *(const LAS bf16x8*)(img + (32 * tl + r32) * IMG_LD + (16 * ks + 8 * hi) * 2);
}
__device__ __forceinline__ void rowfrag_perm(const LAS unsigned char* img, int lane, Frag& Fr) {
    const int r32 = lane & 31, hi = lane >> 5;
#pragma unroll
    for (int tl = 0; tl < 2; ++tl)
#pragma unroll
        for (int ks = 0; ks < 4; ++ks) { const LAS unsigned char* p = img + (32 * tl + r32) * IMG_LD + (16 * ks + 4 * hi) * 2;
            const v2u a = *(const LAS v2u*)p, b = *(const LAS v2u*)(p + 16); const v4u u = {a.x, a.y, b.x, b.y}; Fr[tl][ks] = __builtin_bit_cast(bf16x8, u); }
}
__device__ __forceinline__ void colfrag_tr(const LAS unsigned char* img, int lane, Frag& Fr) {
    const int hi = lane >> 5, qq = (lane & 15) >> 2, p4 = lane & 3, cg = (lane >> 4) & 1;
    const LAS unsigned char* base = img + (4 * hi + qq) * IMG_LD + (16 * cg + 4 * p4) * 2;
#pragma unroll
    for (int tl = 0; tl < 2; ++tl)
#pragma unroll
        for (int ks = 0; ks < 4; ++ks) { const LAS unsigned char* p = base + (16 * ks) * IMG_LD + (32 * tl) * 2;
            const s16x4 lo = vtr(p), hh = vtr(p + 8 * IMG_LD); Fr[tl][ks] = (bf16x8){lo[0], lo[1], lo[2], lo[3], hh[0], hh[1], hh[2], hh[3]}; }
}
__device__ __forceinline__ void img_load(const bf16* g, LAS unsigned char* slot, int lane) {
    asm volatile("" ::: "memory");
    const unsigned char* gb = (const unsigned char*)g + (unsigned)(lane * 16);
    LAS unsigned char* sl_ = slot + (lane >> 3) * IMG_LD + (lane & 7) * 16;
    v4u t[8];
#pragma unroll
    for (int k = 0; k < 8; ++k) t[k] = *(const v4u*)(gb + 1024 * k);
#pragma unroll
    for (int k = 0; k < 8; ++k) *(LAS v4u*)(sl_ + (8 * k) * IMG_LD) = t[k];
    asm volatile("" ::: "memory");
}
__device__ __forceinline__ void img_load2(const bf16* ga, LAS unsigned char* slota, const bf16* gb_, LAS unsigned char* slotb, int lane) {
    asm volatile("" ::: "memory");
    const unsigned char* pa = (const unsigned char*)ga + (unsigned)(lane * 16); const unsigned char* pb = (const unsigned char*)gb_ + (unsigned)(lane * 16);
    const int lo_ = (lane >> 3) * IMG_LD + (lane & 7) * 16;
    v4u ta[8], tb[8];
#pragma unroll
    for (int k = 0; k < 8; ++k) ta[k] = *(const v4u*)(pa + 1024 * k);
#pragma unroll
    for (int k = 0; k < 8; ++k) tb[k] = *(const v4u*)(pb + 1024 * k);
#pragma unroll
    for (int k = 0; k < 8; ++k) *(LAS v4u*)(slota + lo_ + (8 * k) * IMG_LD) = ta[k];
#pragma unroll
    for (int k = 0; k < 8; ++k) *(LAS v4u*)(slotb + lo_ + (8 * k) * IMG_LD) = tb[k];
    asm volatile("" ::: "memory");
}
__device__ __forceinline__ void acc_to_img(const f32x16 (&X)[2][2], LAS unsigned char* slot, int lane) {
    const int r32 = lane & 31, hi = lane >> 5; LAS unsigned char* lb = slot + (4 * hi) * IMG_LD + r32 * 2;
#pragma unroll
    for (int rt = 0; rt < 2; ++rt)
#pragma unroll
        for (int ct = 0; ct < 2; ++ct)
        { asm volatile("" ::: "memory");
#pragma unroll
            for (int r = 0; r < 16; ++r) *(LAS bf16*)(lb + (32 * rt + CRC(r)) * IMG_LD + (32 * ct) * 2) = (bf16)(pk2(X[rt][ct][r], 0.f) & 0xffffu); }
}
__device__ __forceinline__ void acc_to_gbf(const f32x16 (&X)[2][2], bf16* g, int lane) {
    const int r32 = lane & 31, hi = lane >> 5; bf16* gl = g + (4 * hi) * 64 + r32;
#pragma unroll
    for (int rt = 0; rt < 2; ++rt)
#pragma unroll
        for (int ct = 0; ct < 2; ++ct)
        { asm volatile("" ::: "memory");
#pragma unroll
            for (int r = 0; r < 16; ++r) gl[(32 * rt + CRC(r)) * 64 + 32 * ct] = (bf16)(pk2(X[rt][ct][r], 0.f) & 0xffffu); }
}
__device__ __forceinline__ void acc_to_gf32(const f32x16 (&X)[2][2], float* g, int lane) {
    const int r32 = lane & 31, hi = lane >> 5; float* gl = g + (4 * hi) * 64 + r32;
#pragma unroll
    for (int rt = 0; rt < 2; ++rt)
#pragma unroll
        for (int ct = 0; ct < 2; ++ct)
        { asm volatile("" ::: "memory");
#pragma unroll
            for (int r = 0; r < 16; ++r) gl[(32 * rt + CRC(r)) * 64 + 32 * ct] = X[rt][ct][r]; }
}
template <bool STRICT> __device__ __forceinline__ void mask_upper(f32x16 (&X)[2][2], int lane) {
    const int r32 = lane & 31, hi = lane >> 5, dl = 4 * hi - r32;
#pragma unroll
    for (int rt = 0; rt < 2; ++rt)
#pragma unroll
        for (int ct = 0; ct < 2; ++ct)
#pragma unroll
            for (int r = 0; r < 16; ++r) { const int dlt = dl + (32 * rt + CRC(r) - 32 * ct); const bool keep = STRICT ? (dlt < 0) : (dlt <= 0); if (!keep) X[rt][ct][r] = 0.f; }
}
template <int RT> __device__ __forceinline__ void mm_rt(const Frag& Af, const Frag& Bf, f32x16 (&D)[2]) {
#pragma unroll
    for (int ct = 0; ct < 2; ++ct)
#pragma unroll
        for (int ks = 0; ks < 4; ++ks) D[ct] = __builtin_amdgcn_mfma_f32_32x32x16_bf16(Af[RT][ks], Bf[ct][ks], D[ct], 0, 0, 0);
}
template <int RT> __device__ __forceinline__ void frag_rt(const f32x16 (&D)[2], Frag& Fr) {
#pragma unroll
    for (int ct = 0; ct < 2; ++ct)
#pragma unroll
        for (int hf = 0; hf < 2; ++hf) { const int rb = 8 * hf;
            const v4u u = {pk2(D[ct][rb], D[ct][rb + 1]), pk2(D[ct][rb + 2], D[ct][rb + 3]), pk2(D[ct][rb + 4], D[ct][rb + 5]), pk2(D[ct][rb + 6], D[ct][rb + 7])};
            Fr[ct][2 * RT + hf] = __builtin_bit_cast(bf16x8, u); }
}
template <int RT, bool STRICT> __device__ __forceinline__ void mask_rt(f32x16 (&D)[2], int lane) {
    const int dl = 4 * (lane >> 5) - (lane & 31);
#pragma unroll
    for (int ct = 0; ct < 2; ++ct)
#pragma unroll
        for (int r = 0; r < 16; ++r) { const int dlt = dl + (32 * RT + CRC(r) - 32 * ct); const bool keep = STRICT ? (dlt < 0) : (dlt <= 0); if (!keep) D[ct][r] = 0.f; }
}
template <int RT> __device__ __forceinline__ void st_f32_rt(const f32x16 (&D)[2], float* g, int lane) { float* gl = g + (4 * (lane >> 5)) * 64 + (lane & 31);
#pragma unroll
    for (int ct = 0; ct < 2; ++ct) { asm volatile("" ::: "memory");
#pragma unroll
        for (int r = 0; r < 16; ++r) gl[(32 * RT + CRC(r)) * 64 + 32 * ct] = D[ct][r]; } }
template <int RT> __device__ __forceinline__ void st_bf_rt(const f32x16 (&D)[2], bf16* g, int lane) { bf16* gl = g + (4 * (lane >> 5)) * 64 + (lane & 31);
#pragma unroll
    for (int ct = 0; ct < 2; ++ct) { asm volatile("" ::: "memory");
#pragma unroll
        for (int r = 0; r < 16; ++r) gl[(32 * RT + CRC(r)) * 64 + 32 * ct] = (bf16)(pk2(D[ct][r], 0.f) & 0xffffu); } }
template <int RT> __device__ __forceinline__ void ld_f32_rt(f32x16 (&D)[2], const float* g, int lane) { const float* gl = g + (4 * (lane >> 5)) * 64 + (lane & 31);
#pragma unroll
    for (int ct = 0; ct < 2; ++ct) { asm volatile("" ::: "memory");
#pragma unroll
        for (int r = 0; r < 16; ++r) D[ct][r] = gl[(32 * RT + CRC(r)) * 64 + 32 * ct]; } }
template <int RT> __device__ __forceinline__ void scale_rt(f32x16 (&D)[2], const float* gcl  ) {
#pragma unroll
    for (int ct = 0; ct < 2; ++ct)
#pragma unroll
        for (int r = 0; r < 16; ++r) D[ct][r] *= gcl[32 * RT + CRC(r)]; }
__device__ __forceinline__ void zero2(f32x16 (&D)[2]) { D[0] = (f32x16){}; D[1] = (f32x16){}; }
__device__ __forceinline__ void tfrag(const f32x16& T, bf16x8& f0, bf16x8& f1) {
    const v4u u0 = {pk2(T[0], T[1]), pk2(T[2], T[3]), pk2(T[4], T[5]), pk2(T[6], T[7])}, u1 = {pk2(T[8], T[9]), pk2(T[10], T[11]), pk2(T[12], T[13]), pk2(T[14], T[15])};
    f0 = __builtin_bit_cast(bf16x8, u0); f1 = __builtin_bit_cast(bf16x8, u1);
}
__device__ __forceinline__ void tmm(const bf16x8 (&a)[2], const bf16x8 (&b)[2], f32x16& d) {
    d = __builtin_amdgcn_mfma_f32_32x32x16_bf16(a[0], b[0], d, 0, 0, 0); d = __builtin_amdgcn_mfma_f32_32x32x16_bf16(a[1], b[1], d, 0, 0, 0);
}
__device__ __forceinline__ void tprod(const Frag& A_, int ra, const Frag& B_, int rb, f32x16& d) {
#pragma unroll
    for (int ks = 0; ks < 4; ++ks) d = __builtin_amdgcn_mfma_f32_32x32x16_bf16(A_[ra][ks], B_[rb][ks], d, 0, 0, 0);
}
template <bool WANT_ZT> __device__ __forceinline__ void diag_inv(f32x16& Q, f32x16& QT, f32x16& Z, f32x16& ZT, int lane) {
    const int dl = 4 * (lane >> 5) - (lane & 31);
#pragma unroll
    for (int r = 0; r < 16; ++r) { const int d = dl + CRC(r); Q[r] = d < 0 ? Q[r] : 0.f; QT[r] = d > 0 ? QT[r] : 0.f; const float id = d == 0 ? 1.f : 0.f; Z[r] = Q[r] + id; ZT[r] = QT[r] + id; }
#pragma unroll 1
    for (int lvl = 0; lvl < 4; ++lvl) {
        bf16x8 fq[2], fqt[2], fz[2];
        tfrag(Q, fq[0], fq[1]); tfrag(QT, fqt[0], fqt[1]);
        Q = (f32x16){}; QT = (f32x16){}; tmm(fqt, fq, Q); tmm(fq, fqt, QT);
        tfrag(Q, fq[0], fq[1]); tfrag(QT, fqt[0], fqt[1]);
        tfrag(Z, fz[0], fz[1]); tmm(fqt, fz, Z);
        if (WANT_ZT) { tfrag(ZT, fz[0], fz[1]); tmm(fq, fz, ZT); }
    }
}
constexpr int NCHK = SEQ / 64;
__device__ __forceinline__ void chunk_prescale(Frame& F, int hc) {
    const int lane = F.lane, bh = hc >> 6, c = hc & 63, h = bh & 7, row0 = (bh >> 3) * SEQ + c * 64;
    bf16* sc = (bf16*)(F.ws + WS_SC) + (size_t)hc * 5 * 4096 + lane;
    const size_t o0 = (size_t)row0 * 512 + h * 64 + lane;
    const float* aW = rk_arr(F, 1) + o0; const unsigned* pRK = rk_pair(F, 0) + o0; const unsigned* pVG = rk_pair(F, 2) + o0; const unsigned* pAB = rk_pair(F, 4) + o0;
    float lc = 0.f;
    float wA[16], wB[16]; unsigned rkA[16], rkB[16], vgA[16], vgB[16], abA[16], abB[16];
#define PS_LOAD(S, tb) do { _Pragma("unroll") for (int i = 0; i < 16; ++i) { const int t = 16 * (tb) + i; w##S[i] = aW[t * 512]; rk##S[i] = pRK[t * 512]; vg##S[i] = pVG[t * 512]; ab##S[i] = pAB[t * 512]; } } while (0)
#define PS_COMP(S, tb) do { _Pragma("unroll") for (int i = 0; i < 16; ++i) { const int t = 16 * (tb) + i; \
        const float em = __expf(lc); lc += __logf(w##S[i]); const float ei = __expf(-lc); \
        sc[0 * 4096 + t * 64] = (bf16)(pk2(bflo(ab##S[i]) * em, 0.f) & 0xffffu); \
        sc[1 * 4096 + t * 64] = (bf16)(pk2(bfhi(ab##S[i]) * ei, 0.f) & 0xffffu); \
        sc[2 * 4096 + t * 64] = (bf16)(pk2(bfhi(rk##S[i]) * ei, 0.f) & 0xffffu); \
        sc[3 * 4096 + t * 64] = (bf16)(pk2(bflo(rk##S[i]) * em, 0.f) & 0xffffu); \
        sc[4 * 4096 + t * 64] = (bf16)(vg##S[i] & 0xffffu); } } while (0)
    PS_LOAD(A, 0); PS_LOAD(B, 1);
    PS_COMP(A, 0); asm volatile("" ::: "memory"); PS_LOAD(A, 2);
    PS_COMP(B, 1); asm volatile("" ::: "memory"); PS_LOAD(B, 3);
    PS_COMP(A, 2); PS_COMP(B, 3);
#undef PS_LOAD
#undef PS_COMP
    ((float*)(F.ws + WS_GC))[(size_t)hc * 64 + lane] = __expf(lc);
}
__device__ __forceinline__ void chunk_unit(Frame& F, int hc) {
    const int lane = F.lane, r32 = lane & 31, hi = lane >> 5;
    LAS unsigned char* s0 = F.lds + RING_OFF + F.wave * (2 * IMG_BYTES); LAS unsigned char* s1 = s0 + IMG_BYTES; const LAS unsigned char* s1l = s1 + (4 * hi) * IMG_LD + r32 * 2;
    SUBM(0);
    const float* rho = (const float*)(F.ws + WS_HT) + (size_t)(((hc >> 9) * 64 + (hc & 63)) * 2) * 512 + ((hc >> 6) & 7) * 64; const float* sig = rho + 512;
    ((float*)(F.ws + WS_GC))[(size_t)hc * 64 + lane] = rho[lane] * sig[lane];
    SUBM(1);
    const bf16* sc = (const bf16*)(F.ws + WS_SC) + (size_t)hc * 5 * 4096;
    const bf16* gAb = sc; const bf16* gBb = sc + 4096; const bf16* gKb = sc + 2 * 4096; const bf16* gRb = sc + 3 * 4096; const bf16* gV = sc + 4 * 4096;
    Frag fa, fb, zf, uf, af, vf;
    {
        f32x16 Q, QT, Z, ZT; bf16x8 zt11[2], z22[2], t0[2], t1[2];
        img_load2(gAb, s0, gBb, s1, lane);
        rowfrag(s1, lane, fa); rowfrag(s0, lane, fb);
        Q = (f32x16){}; QT = (f32x16){}; tprod(fa, 0, fb, 0, Q); tprod(fb, 0, fa, 0, QT); diag_inv<true>(Q, QT, Z, ZT, lane);
        tfrag(Z, zf[0][0], zf[0][1]); tfrag(ZT, zt11[0], zt11[1]);
        Q = (f32x16){}; QT = (f32x16){}; tprod(fa, 1, fb, 1, Q); tprod(fb, 1, fa, 1, QT); diag_inv<false>(Q, QT, Z, ZT, lane);
        tfrag(Z, z22[0], z22[1]); zf[1][2] = z22[0]; zf[1][3] = z22[1];
        QT = (f32x16){}; tprod(fb, 1, fa, 0, QT);
        tfrag(QT, t0[0], t0[1]); Q = (f32x16){}; tmm(t0, z22, Q);
        tfrag(Q, t1[0], t1[1]); Z = (f32x16){}; tmm(zt11, t1, Z);
        tfrag(Z, zf[1][0], zf[1][1]);
        zf[0][2] = (bf16x8){}; zf[0][3] = (bf16x8){};
    }
    SUBM(2);
    f32x16 D[2];
    colfrag_tr(s0, lane, uf);
    zero2(D); mm_rt<0>(zf, uf, D); frag_rt<0>(D, af);
    zero2(D); mm_rt<1>(zf, uf, D); frag_rt<1>(D, af);
    img_load2(gKb, s1, gV, s0, lane);
    rowfrag(s1, lane, fa);
    zero2(D); mm_rt<0>(fa, fb, D); mask_rt<0, true>(D, lane); frag_rt<0>(D, uf);
    zero2(D); mm_rt<1>(fa, fb, D); mask_rt<1, true>(D, lane); frag_rt<1>(D, uf);
    colfrag_tr(s0, lane, vf);
    zero2(D); mm_rt<0>(uf, vf, D); frag_rt<0>(D, fa);
    zero2(D); mm_rt<1>(uf, vf, D); frag_rt<1>(D, fa);
    zero2(D); mm_rt<0>(zf, fa, D); frag_rt<0>(D, uf);
    zero2(D); mm_rt<1>(zf, fa, D); frag_rt<1>(D, uf);
    SUBM(3);
    const float* gcg = sig + 4 * hi; const float* rhg = rho + 4 * hi;
    colfrag_tr(s1, lane, zf);
    img_load(gBb, s0, lane); colfrag_tr(s0, lane, fa);
    { unsigned char* slfb = F.ws + WS_SL + (size_t)hc * 8192 + lane * 8; unsigned char* gpfb = F.ws + WS_GP + (size_t)hc * 8192 + lane * 16;
      zero2(D); mm_rt<0>(zf, vf, D); mm_rt<0>(fa, uf, D); scale_rt<0>(D, gcg);
#pragma unroll
      for (int ct = 0; ct < 2; ++ct)
#pragma unroll
          for (int q = 0; q < 4; ++q) *(v2u*)(slfb + ((ct * 2 + 0) * 4 + q) * 512) = (v2u){pk2(D[ct][4 * q], D[ct][4 * q + 1]), pk2(D[ct][4 * q + 2], D[ct][4 * q + 3])};
      zero2(D); mm_rt<1>(zf, vf, D); mm_rt<1>(fa, uf, D); scale_rt<1>(D, gcg);
#pragma unroll
      for (int ct = 0; ct < 2; ++ct)
#pragma unroll
          for (int q = 0; q < 4; ++q) *(v2u*)(slfb + ((ct * 2 + 1) * 4 + q) * 512) = (v2u){pk2(D[ct][4 * q], D[ct][4 * q + 1]), pk2(D[ct][4 * q + 2], D[ct][4 * q + 3])};
      const float gc0 = sig[r32], gc1 = sig[32 + r32];
      zero2(D); mm_rt<0>(af, fa, D); D[0] *= gc0; D[1] *= gc1; scale_rt<0>(D, rhg); frag_rt<0>(D, zf);
      zero2(D); mm_rt<1>(af, fa, D); D[0] *= gc0; D[1] *= gc1; scale_rt<1>(D, rhg); frag_rt<1>(D, zf);
#pragma unroll
      for (int tl = 0; tl < 2; ++tl)
#pragma unroll
          for (int ks = 0; ks < 4; ++ks) *(bf16x8*)(gpfb + (tl * 4 + ks) * 1024) = zf[tl][ks]; }
    SUBM(4);
    img_load(gRb, s1, lane);
    rowfrag(s0, lane, fa); rowfrag(s1, lane, fb);
    zero2(D); mm_rt<0>(fa, fb, D); mask_rt<0, false>(D, lane); frag_rt<0>(D, zf);
    zero2(D); mm_rt<1>(fa, fb, D); mask_rt<1, false>(D, lane); frag_rt<1>(D, zf);
    { const LAS unsigned char* s1t = s1 + r32 * IMG_LD + hi * 8;
      unsigned char* rhfb = F.ws + WS_RH + (size_t)hc * 8192 + lane * 16;
#pragma unroll
      for (int ct = 0; ct < 2; ++ct)
#pragma unroll
          for (int q = 0; q < 4; ++q) { const v2u w_ = *(const LAS v2u*)(s1t + (32 * ct) * IMG_LD + (8 * q) * 2);
              D[ct][4 * q] = bflo(w_.x); D[ct][4 * q + 1] = bfhi(w_.x); D[ct][4 * q + 2] = bflo(w_.y); D[ct][4 * q + 3] = bfhi(w_.y); }
      mm_rt<0>(af, zf, D); scale_rt<0>(D, rhg); frag_rt<0>(D, fa);
#pragma unroll
      for (int ct = 0; ct < 2; ++ct)
#pragma unroll
          for (int q = 0; q < 4; ++q) { const v2u w_ = *(const LAS v2u*)(s1t + (32 * ct) * IMG_LD + (32 + 8 * q) * 2);
              D[ct][4 * q] = bflo(w_.x); D[ct][4 * q + 1] = bfhi(w_.x); D[ct][4 * q + 2] = bflo(w_.y); D[ct][4 * q + 3] = bfhi(w_.y); }
      mm_rt<1>(af, zf, D); scale_rt<1>(D, rhg); frag_rt<1>(D, fa);
#pragma unroll
      for (int tl = 0; tl < 2; ++tl)
#pragma unroll
          for (int ks = 0; ks < 4; ++ks) *(bf16x8*)(rhfb + (tl * 4 + ks) * 1024) = fa[tl][ks]; }
    SUBM(5);
    img_load(gKb, s0, lane);
    rowfrag(s0, lane, fa);
    zero2(D); mm_rt<0>(fa, fb, D); mask_rt<0, false>(D, lane); frag_rt<0>(D, af);
    zero2(D); mm_rt<1>(fa, fb, D); mask_rt<1, false>(D, lane); frag_rt<1>(D, af);
    { unsigned char* ylfb = F.ws + WS_YL + (size_t)hc * 8192 + lane * 8;
      zero2(D); mm_rt<0>(zf, uf, D); mm_rt<0>(af, vf, D);
#pragma unroll
      for (int ct = 0; ct < 2; ++ct)
#pragma unroll
          for (int q = 0; q < 4; ++q) *(v2u*)(ylfb + ((0 * 2 + ct) * 4 + q) * 512) = (v2u){pk2(D[ct][4 * q], D[ct][4 * q + 1]), pk2(D[ct][4 * q + 2], D[ct][4 * q + 3])};
      zero2(D); mm_rt<1>(zf, uf, D); mm_rt<1>(af, vf, D);
#pragma unroll
      for (int ct = 0; ct < 2; ++ct)
#pragma unroll
          for (int q = 0; q < 4; ++q) *(v2u*)(ylfb + ((1 * 2 + ct) * 4 + q) * 512) = (v2u){pk2(D[ct][4 * q], D[ct][4 * q + 1]), pk2(D[ct][4 * q + 2], D[ct][4 * q + 3])}; }
    SUBM(6);
}
__device__ __forceinline__ void chain_unit(Frame& F, int gwv) {
    const int lane = F.lane, r32 = lane & 31, hi = lane >> 5, bh = gwv >> 1, ct = gwv & 1;
    const unsigned char* gpf = F.ws + WS_GP + (size_t)bh * NCHK * 8192 + lane * 16;
    const unsigned char* slf = F.ws + WS_SL + (size_t)bh * NCHK * 8192 + ct * 4096 + lane * 8;
    const float* gcl = (const float*)(F.ws + WS_GC) + (size_t)bh * NCHK * 64 + lane;
    unsigned char* xcf = F.ws + WS_XC + (size_t)bh * NCHK * 8192 + ct * 4096 + lane * 16;
    f32x16 X[2]; X[0] = (f32x16){}; X[1] = (f32x16){};
    v4u gA[8], gB[8], gC[8]; v2u sA[8], sB[8], sC[8]; float mA, mB, mC; const int hb = 16 * hi;
#define CH_LOAD(S) do { _Pragma("unroll") for (int k = 0; k < 8; ++k) { g##S[k] = *(const v4u*)(gpf + k * 1024); s##S[k] = *(const v2u*)(slf + k * 512); } m##S = *gcl; gpf += 8192; slf += 8192; gcl += 64; } while (0)
#define CH_STEP(S) do { bf16x8 xh[4]; \
        _Pragma("unroll") for (int rt = 0; rt < 2; ++rt) _Pragma("unroll") for (int hf = 0; hf < 2; ++hf) { const int rb = 8 * hf; \
            const v4u u = {pk2(X[rt][rb], X[rt][rb + 1]), pk2(X[rt][rb + 2], X[rt][rb + 3]), pk2(X[rt][rb + 4], X[rt][rb + 5]), pk2(X[rt][rb + 6], X[rt][rb + 7])}; \
            xh[2 * rt + hf] = __builtin_bit_cast(bf16x8, u); } \
        _Pragma("unroll") for (int ks = 0; ks < 4; ++ks) *(bf16x8*)(xcf + ks * 1024) = xh[ks]; \
        xcf += 8192; \
        _Pragma("unroll") for (int rt = 0; rt < 2; ++rt) _Pragma("unroll") for (int q = 0; q < 4; ++q) _Pragma("unroll") for (int e = 0; e < 4; ++e) { \
            const float gm_ = __builtin_bit_cast(float, __builtin_amdgcn_ds_bpermute(4 * (32 * rt + 8 * q + e) + hb, __builtin_bit_cast(int, m##S)));     \
            const unsigned sw_ = (e < 2) ? s##S[rt * 4 + q].x : s##S[rt * 4 + q].y; \
            X[rt][4 * q + e] = gm_ * X[rt][4 * q + e] + ((e & 1) ? bfhi(sw_) : bflo(sw_)); } \
        _Pragma("unroll") for (int rt = 0; rt < 2; ++rt) _Pragma("unroll") for (int ks = 0; ks < 4; ++ks) \
            X[rt] = __builtin_amdgcn_mfma_f32_32x32x16_bf16(__builtin_bit_cast(bf16x8, g##S[rt * 4 + ks]), xh[ks], X[rt], 0, 0, 0); } while (0)
    static_assert(NCHK % 3 == 1, "chain_unit: 21 x 3 steps + 1");
    CH_LOAD(A); CH_LOAD(B);
#pragma unroll 1
    for (int c = 0; c < NCHK - 1; c += 3) {
        CH_LOAD(C); CH_STEP(A);
        CH_LOAD(A); CH_STEP(B);
        if (c + 4 < NCHK) CH_LOAD(B);
        CH_STEP(C);
    }
    CH_STEP(A);
#undef CH_LOAD
#undef CH_STEP
    float* so = F.out + O_WP + (size_t)bh * 4096 + (32 * ct + r32) * 64 + 4 * hi;
#pragma unroll
    for (int rt = 0; rt < 2; ++rt)
#pragma unroll
        for (int r = 0; r < 16; ++r) so[32 * rt + CRC(r)] = X[rt][r];
}
__device__ __forceinline__ void ypass_unit(Frame& F, const Args& A, int hc) {
    const int lane = F.lane, r32 = lane & 31, hi = lane >> 5, bh = hc >> 6, c = hc & 63, h = bh & 7, row0 = (bh >> 3) * SEQ + c * 64;
    Frag fa, fb;
    { const unsigned char* xcf = F.ws + WS_XC + (size_t)hc * 8192 + lane * 16;
#pragma unroll
      for (int ct = 0; ct < 2; ++ct)
#pragma unroll
          for (int ks = 0; ks < 4; ++ks) fb[ct][ks] = *(const bf16x8*)(xcf + (ct * 4 + ks) * 1024); }
    { const unsigned char* rhf = F.ws + WS_RH + (size_t)hc * 8192 + lane * 16;
#pragma unroll
      for (int tl = 0; tl < 2; ++tl)
#pragma unroll
          for (int ks = 0; ks < 4; ++ks) fa[tl][ks] = *(const bf16x8*)(rhf + (tl * 4 + ks) * 1024); }
    f32x16 Y[2][2];
    { const unsigned char* ylf = F.ws + WS_YL + (size_t)hc * 8192 + lane * 8;
#pragma unroll
      for (int rt = 0; rt < 2; ++rt)
#pragma unroll
          for (int ct = 0; ct < 2; ++ct)
#pragma unroll
              for (int q = 0; q < 4; ++q) { const v2u v_ = *(const v2u*)(ylf + ((rt * 2 + ct) * 4 + q) * 512);
                  Y[rt][ct][4 * q] = bflo(v_.x); Y[rt][ct][4 * q + 1] = bfhi(v_.x); Y[rt][ct][4 * q + 2] = bflo(v_.y); Y[rt][ct][4 * q + 3] = bfhi(v_.y); } }
    const float* BON = (const float*)(F.ws + WS_BON3) + (size_t)(row0 + 4 * hi) * 32 + h * 4; bf16* RW = (bf16*)(F.ws + WS_RW) + (size_t)(row0 + 4 * hi) * 512 + h * 64 + r32;
    const unsigned* VG = rk_pair(F, 2) + (size_t)(row0 + 4 * hi) * 512 + h * 64 + r32;
    unsigned vg0[2][16], vg1[2][16]; float bon[2][16];
#pragma unroll
    for (int rt = 0; rt < 2; ++rt)
#pragma unroll
        for (int r = 0; r < 16; ++r) { vg0[rt][r] = VG[(32 * rt + CRC(r)) * 512]; vg1[rt][r] = VG[(32 * rt + CRC(r)) * 512 + 32]; bon[rt][r] = BON[(32 * rt + CRC(r)) * 32]; }
    float gw[2], gb[2];
#pragma unroll
    for (int ct = 0; ct < 2; ++ct) { gw[ct] = A.in[I_GNW][h * 64 + 32 * ct + r32]; gb[ct] = A.in[I_GNB][h * 64 + 32 * ct + r32]; }
    mm64(fa, fb, Y);
#pragma unroll
    for (int rt = 0; rt < 2; ++rt)
#pragma unroll
        for (int r = 0; r < 16; ++r) {
            const float y0 = Y[rt][0][r], y1 = Y[rt][1][r];
            const float mean = sum32(y0 + y1) * (1.f / 64.f), e0 = y0 - mean, e1 = y1 - mean;
            const float rstd = rsqrtf(sum32(e0 * e0 + e1 * e1) * (1.f / 64.f) + 64e-5f);
            const unsigned a0 = vg0[rt][r], a1 = vg1[rt][r];
            const float o0 = (e0 * rstd * gw[0] + gb[0] + bon[rt][r] * bflo(a0)) * bfhi(a0), o1 = (e1 * rstd * gw[1] + gb[1] + bon[rt][r] * bflo(a1)) * bfhi(a1);
            RW[(32 * rt + CRC(r)) * 512] = (bf16)(pk2(o0, 0.f) & 0xffffu); RW[(32 * rt + CRC(r)) * 512 + 32] = (bf16)(pk2(o1, 0.f) & 0xffffu);
        }
}

constexpr int DP_STRIDE = 260;
__device__ __forceinline__ float half_sum32(float v) { v += __shfl_xor(v, 1); v += __shfl_xor(v, 2); v += __shfl_xor(v, 4); v += __shfl_xor(v, 8); v += __shfl_xor(v, 16); return v; }
__device__ __forceinline__ float sum16(float v) {
    v += __builtin_bit_cast(float, __builtin_amdgcn_update_dpp(0, __builtin_bit_cast(int, v), 0xB1, 0xF, 0xF, true));
    v += __builtin_bit_cast(float, __builtin_amdgcn_update_dpp(0, __builtin_bit_cast(int, v), 0x4E, 0xF, 0xF, true));
    v += __builtin_bit_cast(float, __builtin_amdgcn_update_dpp(0, __builtin_bit_cast(int, v), 0x141, 0xF, 0xF, true));
    v += dpp_rmir(v);
    return v;
}
__device__ __forceinline__ void glds16(const void* gsrc, unsigned lds_dst) { unsigned keep;
    asm volatile("s_mov_b32 %0, m0\n\ts_mov_b32 m0, %2\n\ts_nop 0\n\tglobal_load_lds_dwordx4 %1, off\n\ts_mov_b32 m0, %0" : "=&s"(keep) : "v"(gsrc), "s"(lds_dst) : "memory"); }
struct LdsRows { const LAS unsigned char* b; __device__ __forceinline__ f32x4 operator[](int j) const { return *(const LAS f32x4*)(b + j * 1024); } };
__device__ __forceinline__ void decode_unit(Frame& F, const Args& A, int unit) {
    const int seq = unit >> 5, h = F.wave & 3, lane = F.lane, w = F.wave, d4 = lane & 31, tk = lane >> 5;
    const bf16* QB = (const bf16*)(F.ws + WS_QB);
    const v2u qw = *(const v2u*)(QB + (size_t)(MP + seq) * 512 + h * 128 + 4 * d4);
    const f32x4 q4 = {bflo(qw.x), bfhi(qw.x), bflo(qw.y), bfhi(qw.y)};
    const float slope = exp2f(-2.f * (float)(h + 1)) * 1.4426950408889634f;
    const int pi = (unit & 31) * 2 + (w >> 2), page = ((const int*)A.in[I_PT])[seq * NPAGES + pi];
    const float* kp = A.in[I_CK] + ((size_t)page * PAGE * 4 + h) * 128 + (size_t)tk * 512 + 4 * d4;
    const float* vp = A.in[I_CV] + ((size_t)page * PAGE * 4 + h) * 128 + (size_t)tk * 512 + 4 * d4;
    float m0 = -INFINITY, l0 = 0.f, m1 = -INFINITY, l1 = 0.f; f32x4 o0 = {0.f, 0.f, 0.f, 0.f}, o1 = o0;
    const bool c0 = d4 < 16;
    constexpr int DNB = 8;
    f32x4 kA[DNB], vA[DNB], kB[DNB], vB[DNB];
#define DEC_LOAD(KX, VX, p_) do { _Pragma("unroll") for (int j = 0; j < DNB; ++j) { KX[j] = __builtin_nontemporal_load((const f32x4*)(kp + (size_t)((p_) + j) * 1024)); VX[j] = __builtin_nontemporal_load((const f32x4*)(vp + (size_t)((p_) + j) * 1024)); } } while (0)
#define DEC_COMP(KX, VX, p_) do { float s0[DNB], s1[DNB], mx0 = m0, mx1 = m1; \
        _Pragma("unroll") for (int j = 0; j < DNB; ++j) { const f32x4 kq = KX[j] * q4; \
            const float s = sum16((kq[0] + kq[1]) + (kq[2] + kq[3])) + slope * (float)(pi * PAGE + 2 * ((p_) + j) + tk - PAST), so = __shfl_xor(s, 16); \
            s0[j] = c0 ? s : so; s1[j] = c0 ? so : s; mx0 = fmaxf(mx0, s0[j]); mx1 = fmaxf(mx1, s1[j]); } \
        const float a0 = __builtin_amdgcn_exp2f(m0 - mx0), a1 = __builtin_amdgcn_exp2f(m1 - mx1); \
        l0 *= a0; l1 *= a1; o0 *= a0; o1 *= a1; m0 = mx0; m1 = mx1; \
        _Pragma("unroll") for (int j = 0; j < DNB; ++j) { const float e0 = __builtin_amdgcn_exp2f(s0[j] - m0), e1 = __builtin_amdgcn_exp2f(s1[j] - m1); l0 += e0; l1 += e1; o0 += e0 * VX[j]; o1 += e1 * VX[j]; } } while (0)
    DEC_LOAD(kA, vA, 0);
    for (int p0 = 0; p0 < PAGE / 2; p0 += 2 * DNB) {
        DEC_LOAD(kB, vB, p0 + DNB);
        DEC_COMP(kA, vA, p0);
        if (p0 + 2 * DNB < PAGE / 2) DEC_LOAD(kA, vA, p0 + 2 * DNB);
        DEC_COMP(kB, vB, p0 + DNB);
    }
#undef DEC_LOAD
#undef DEC_COMP
#define SWP(x) __uint_as_float(__builtin_amdgcn_permlane32_swap(__float_as_uint(x), __float_as_uint(x), false, false)[tk ? 0 : 1])
    { const float mb0 = SWP(m0), lb0 = SWP(l0), mb1 = SWP(m1), lb1 = SWP(l1);
      const float M0 = fmaxf(m0, mb0), M1 = fmaxf(m1, mb1);
      const float fa0 = __builtin_amdgcn_exp2f(m0 - M0), fb0 = __builtin_amdgcn_exp2f(mb0 - M0), fa1 = __builtin_amdgcn_exp2f(m1 - M1), fb1 = __builtin_amdgcn_exp2f(mb1 - M1);
      f32x4 r0, r1;
#pragma unroll
      for (int j = 0; j < 4; ++j) { const float ob0 = SWP(o0[j]), ob1 = SWP(o1[j]); r0[j] = o0[j] * fa0 + ob0 * fb0; r1[j] = o1[j] * fa1 + ob1 * fb1; }
      float* dp = (float*)(F.ws + WS_DP2) + (size_t)((seq * 4 + h) * NPAGES + pi) * DP_STRIDE;
      if (lane == 0) *(f32x4*)dp = (f32x4){M0, l0 * fa0 + lb0 * fb0, M1, l1 * fa1 + lb1 * fb1};
      if (tk == 0) { *(f32x4*)(dp + 4 + 4 * d4) = r0; *(f32x4*)(dp + 132 + 4 * d4) = r1; } }
#undef SWP
}
__device__ __forceinline__ void decode_combine(Frame& F, const Args& A, int sh, float lam) {
    const int seq = sh >> 2, h = sh & 3, lane = F.lane, w = F.wave; const size_t ro = (size_t)(MP + seq) * 512 + h * 128 + 2 * lane;
    const float* dp = (const float*)(F.ws + WS_DP2) + (size_t)(sh * NPAGES) * DP_STRIDE;
    const float* dpo = dp + 4 + 2 * lane + (size_t)(8 * w) * DP_STRIDE;
    const unsigned qw = *(const unsigned*)((const bf16*)(F.ws + WS_QB) + ro), kw = *(const unsigned*)((const bf16*)(F.ws + WS_KB) + ro), vw = *(const unsigned*)((const bf16*)(F.ws + WS_VB) + ro);
    const f32x4 ml = *(const f32x4*)(dp + (size_t)lane * DP_STRIDE);
    f32x2 o0[8], o1[8];
#pragma unroll
    for (int i = 0; i < 8; ++i) { o0[i] = *(const f32x2*)(dpo + (size_t)i * DP_STRIDE); o1[i] = *(const f32x2*)(dpo + (size_t)i * DP_STRIDE + 128); }
    const float s = half_sum32(bflo(qw) * bflo(kw) + bfhi(qw) * bfhi(kw)), so = __shfl_xor(s, 32);
    const float sn0 = lane < 32 ? s : so, sn1 = lane < 32 ? so : s;
    float mx0 = ml[0], mx1 = ml[2];
#pragma unroll
    for (int o = 1; o < 64; o <<= 1) { mx0 = fmaxf(mx0, __shfl_xor(mx0, o)); mx1 = fmaxf(mx1, __shfl_xor(mx1, o)); }
    const float M0 = fmaxf(mx0, sn0), M1 = fmaxf(mx1, sn1);
    const float e0 = exp2f(sn0 - M0), e1 = exp2f(sn1 - M1), f0 = exp2f(ml[0] - M0), f1 = exp2f(ml[2] - M1);
    const float L0 = e0 + wave_sum(f0 * ml[1]), L1 = e1 + wave_sum(f1 * ml[3]);
    f32x2 a = {0.f, 0.f}, b = {0.f, 0.f};
#pragma unroll
    for (int i = 0; i < 8; ++i) {
        const float g0 = __builtin_bit_cast(float, __builtin_amdgcn_readlane(__builtin_bit_cast(int, f0), 8 * w + i)), g1 = __builtin_bit_cast(float, __builtin_amdgcn_readlane(__builtin_bit_cast(int, f1), 8 * w + i));
        a.x += g0 * o0[i].x; a.y += g0 * o0[i].y; b.x += g1 * o1[i].x; b.y += g1 * o1[i].y; }
    LAS f32x4* red = (LAS f32x4*)(F.lds + RING_OFF);
    red[w * 64 + lane] = (f32x4){a.x, a.y, b.x, b.y};
    __syncthreads();
    if (w != 0) return;
    a = (f32x2){e0 * bflo(vw), e0 * bfhi(vw)}; b = (f32x2){e1 * bflo(vw), e1 * bfhi(vw)};
#pragma unroll
    for (int i = 0; i < 8; ++i) { const f32x4 t = red[i * 64 + lane]; a.x += t[0]; a.y += t[1]; b.x += t[2]; b.y += t[3]; }
    const float i0 = 1.f / L0, i1 = 1.f / L1;
    const float ox = a.x * i0 - lam * b.x * i1, oy = a.y * i0 - lam * b.y * i1;
    const float rn = rsqrtf(wave_sum(ox * ox + oy * oy) * (1.f / 128.f) + 1e-6f) * 0.8f;
    const float* aog = A.in[I_AOG];
    *(unsigned*)((bf16*)(F.ws + WS_ON) + ro) = pk2(ox * rn * aog[2 * lane], oy * rn * aog[2 * lane + 1]);
}

__device__ __forceinline__ void attn_naive_row(Frame& F, const Args& A, int row, int h, float lam) {
    const int lane = F.lane, t = row & (SEQ - 1), rb = row - t;
    const bf16* QB = (const bf16*)(F.ws + WS_QB); const bf16* KB = (const bf16*)(F.ws + WS_KB); const bf16* VB = (const bf16*)(F.ws + WS_VB);
    const float slope = exp2f(-2.f * (float)(h + 1)) * 1.4426950408889634f;
    float res[2][2];
    for (int c = 0; c < 2; ++c) {
        float q[64];
#pragma unroll
        for (int d = 0; d < 64; d += 2) { const unsigned w = *(const unsigned*)(QB + (size_t)row * 512 + h * 128 + c * 64 + d); q[d] = bflo(w); q[d + 1] = bfhi(w); }
        float m = -INFINITY, l = 0.f, o[128];
#pragma unroll
        for (int d = 0; d < 128; ++d) o[d] = 0.f;
        for (int j = lane; j <= t; j += 64) {
            const bf16* kr = KB + (size_t)(rb + j) * 512 + h * 128 + c * 64; const bf16* vr = VB + (size_t)(rb + j) * 512 + h * 128;
            float s = 0.f;
#pragma unroll
            for (int d = 0; d < 64; d += 8) { const v4u w = *(const v4u*)(kr + d);
                s += q[d] * bflo(w.x) + q[d + 1] * bfhi(w.x) + q[d + 2] * bflo(w.y) + q[d + 3] * bfhi(w.y) + q[d + 4] * bflo(w.z) + q[d + 5] * bfhi(w.z) + q[d + 6] * bflo(w.w) + q[d + 7] * bfhi(w.w); }
            s += slope * (float)(j - t);
            const float mn = fmaxf(m, s), al = exp2f(m - mn), e = exp2f(s - mn);
            l = l * al + e; m = mn;
#pragma unroll
            for (int d = 0; d < 128; d += 8) { const v4u w = *(const v4u*)(vr + d);
                o[d] = o[d] * al + e * bflo(w.x); o[d + 1] = o[d + 1] * al + e * bfhi(w.x); o[d + 2] = o[d + 2] * al + e * bflo(w.y); o[d + 3] = o[d + 3] * al + e * bfhi(w.y);
                o[d + 4] = o[d + 4] * al + e * bflo(w.z); o[d + 5] = o[d + 5] * al + e * bfhi(w.z); o[d + 6] = o[d + 6] * al + e * bflo(w.w); o[d + 7] = o[d + 7] * al + e * bfhi(w.w); }
        }
        float M = m;
#pragma unroll
        for (int x = 1; x < 64; x <<= 1) M = fmaxf(M, __shfl_xor(M, x));
        const float sc = exp2f(m - M);
        const float L = wave_sum(l * sc);
        float r0 = 0.f, r1 = 0.f;
#pragma unroll
        for (int d = 0; d < 128; ++d) { const float tot = wave_sum(o[d] * sc); if ((d & 63) == lane) { if (d < 64) r0 = tot; else r1 = tot; } }
        res[c][0] = r0 / L; res[c][1] = r1 / L;
    }
    const float ox = res[0][0] - lam * res[1][0], oy = res[0][1] - lam * res[1][1];
    const float rn = rsqrtf(wave_sum(ox * ox + oy * oy) * (1.f / 128.f) + 1e-6f) * 0.8f;
    const float* aog = A.in[I_AOG]; bf16* ON = (bf16*)(F.ws + WS_ON) + (size_t)row * 512 + h * 128;
    ON[lane] = (bf16)(pk2(ox * rn * aog[lane], 0.f) & 0xffffu); ON[64 + lane] = (bf16)(pk2(oy * rn * aog[64 + lane], 0.f) & 0xffffu);
}


__device__ __forceinline__ unsigned bfbits(float f) { return __builtin_bit_cast(unsigned, f) >> 16; }
__device__ __forceinline__ void attn_unit(Frame& F, const Args& A, int b, int h, int qb, float lam) {
    LAS unsigned char* Kt = F.lds + RING_OFF;
    LAS float* wsf = (LAS float*)(Kt + 98304) + F.wave * 64;
    LAS float* xch = (LAS float*)Kt;
    const bf16* QB = (const bf16*)(F.ws + WS_QB); const bf16* KB = (const bf16*)(F.ws + WS_KB); const bf16* VB = (const bf16*)(F.ws + WS_VB);
    const int tid = F.tid, lane = F.lane, w = F.wave, c = w >> 2, wq = w & 3, r32 = lane & 31, hi = lane >> 5;
    const int rowbase = b * SEQ, q0 = 128 * qb + 32 * wq, NT = 2 * (qb + 1);
    bf16x8 qr[4];
    { const bf16* Qp = QB + (size_t)(rowbase + q0 + r32) * 512 + (2 * h + c) * 64 + 8 * hi;
#pragma unroll
      for (int d0 = 0; d0 < 4; ++d0) qr[d0] = *(const bf16x8*)(Qp + 16 * d0); }
    asm volatile("" : "+v"(qr[0]), "+v"(qr[1]), "+v"(qr[2]), "+v"(qr[3]));
    const float sl = exp2f(-2.f * (float)(h + 1)) * 1.4426950408889634f;
    const unsigned c1 = __builtin_bit_cast(unsigned, sl) & 0xffff0000u; const float r1 = sl - __builtin_bit_cast(float, c1);
    const unsigned c2 = __builtin_bit_cast(unsigned, r1) & 0xffff0000u; const float r2 = r1 - __builtin_bit_cast(float, c2);
    const unsigned c3 = __builtin_bit_cast(unsigned, r2) & 0xffff0000u;
    const unsigned b1 = c1 >> 16, b2 = c2 >> 16, b3 = c3 >> 16, lo_mask = hi ? 0u : 0xffffffffu;
    const v4u qextu = {(b1 | (b2 << 16)) & lo_mask, (b3 | (b1 << 16)) & lo_mask, (b2 | (b3 << 16)) & lo_mask, 0u};
    const bf16x8 qext = __builtin_bit_cast(bf16x8, qextu);
    const unsigned J0 = bfbits((float)r32), J1 = bfbits((float)(32 + r32));
    const unsigned lds0 = (unsigned)(uintptr_t)(F.lds + RING_OFF);
    const bf16* kg0 = KB + (size_t)(rowbase + lane) * 512 + h * 128 + (2 * w) * 8;
    const bf16* vg0 = VB + (size_t)(rowbase + 32 * (w & 1) + (lane >> 2)) * 512 + h * 128 + (w >> 1) * 32 + (lane & 3) * 8;
    const unsigned kd0 = lds0 + (2 * w) * 1024, vd0 = lds0 + 16384 + (w >> 1) * 4096 + (2 * (w & 1)) * 1024;
#define ATT_DMA(t_, boff_) do { const size_t go_ = (size_t)(t_) * 64 * 512; const unsigned bo_ = (unsigned)(boff_); \
        glds16(kg0 + go_, (unsigned)__builtin_amdgcn_readfirstlane(kd0 + bo_)); glds16(kg0 + go_ + 8, (unsigned)__builtin_amdgcn_readfirstlane(kd0 + bo_ + 1024)); \
        glds16(vg0 + go_, (unsigned)__builtin_amdgcn_readfirstlane(vd0 + bo_)); glds16(vg0 + go_ + (size_t)16 * 512, (unsigned)__builtin_amdgcn_readfirstlane(vd0 + bo_ + 1024)); } while (0)
    ATT_DMA(NT - 1, 0);
    f32x16 o[4];
#pragma unroll
    for (int i = 0; i < 4; ++i) o[i] = (f32x16){};
    float m = -INFINITY, l = 0.f;
    bf16x8 pa[4];
    asm volatile("s_waitcnt vmcnt(0) lgkmcnt(0)\n\ts_barrier" ::: "memory");
#define ATT_QKSM(t, bo) do { \
        const LAS unsigned char* kfp = Kt + (bo) + (c * 8 + hi) * 1024 + r32 * 16; \
        const unsigned Tb = bfbits((float)(64 * (t) - 128 * qb)); \
        f32x16 p[2]; bf16x8 kfr[2][4]; \
        _Pragma("unroll") for (int half = 0; half < 2; ++half) _Pragma("unroll") for (int d0 = 0; d0 < 4; ++d0) kfr[half][d0] = *(const LAS bf16x8*)(kfp + d0 * 2048 + half * 512); \
        __builtin_amdgcn_sched_barrier(0); \
        _Pragma("unroll") for (int half = 0; half < 2; ++half) { f32x16 acc = (f32x16){}; \
            _Pragma("unroll") for (int d0 = 0; d0 < 4; ++d0) acc = __builtin_amdgcn_mfma_f32_32x32x16_bf16(kfr[half][d0], qr[d0], acc, 0, 0, 0); \
            const unsigned Jb = half ? J1 : J0; \
            const v4u ke = {(Tb | (Tb << 16)) & lo_mask, (Tb | (Jb << 16)) & lo_mask, (Jb | (Jb << 16)) & lo_mask, 0u}; \
            p[half] = __builtin_amdgcn_mfma_f32_32x32x16_bf16(__builtin_bit_cast(bf16x8, ke), qext, acc, 0, 0, 0); } \
        if (64 * (t) + 63 > q0) { const int qpos = q0 + r32; \
            _Pragma("unroll") for (int half = 0; half < 2; ++half) _Pragma("unroll") for (int r = 0; r < 16; ++r) { const int kv = 64 * (t) + 32 * half + crow16(r, hi); if (kv > qpos) p[half][r] = -INFINITY; } } \
        float mx = p[0][0]; \
        _Pragma("unroll") for (int r = 1; r < 16; ++r) mx = fmaxf(mx, p[0][r]); \
        _Pragma("unroll") for (int r = 0; r < 16; ++r) mx = fmaxf(mx, p[1][r]); \
        { const auto rr = __builtin_amdgcn_permlane32_swap(__float_as_uint(mx), __float_as_uint(mx), false, false); mx = fmaxf(__uint_as_float(rr[0]), __uint_as_float(rr[1])); } \
        const float mn = fmaxf(m, mx), alpha = __builtin_amdgcn_exp2f(m - mn); m = mn; \
        float ls = 0.f; \
        _Pragma("unroll") for (int half = 0; half < 2; ++half) _Pragma("unroll") for (int r = 0; r < 16; ++r) { const float e = __builtin_amdgcn_exp2f(p[half][r] - mn); p[half][r] = e; ls += e; } \
        { const auto rr = __builtin_amdgcn_permlane32_swap(__float_as_uint(ls), __float_as_uint(ls), false, false); ls = __uint_as_float(rr[0]) + __uint_as_float(rr[1]); } \
        l = l * alpha + ls; \
        if (__any(alpha != 1.f)) { if (hi == 0) wsf[r32] = alpha; LDS_WAIT(); \
            _Pragma("unroll") for (int r = 0; r < 16; ++r) { const float f = wsf[crow16(r, hi)]; _Pragma("unroll") for (int blk = 0; blk < 4; ++blk) o[blk][r] *= f; } } \
        _Pragma("unroll") for (int s = 0; s < 4; ++s) { const int hf = s >> 1, rb = 8 * (s & 1); \
            const v4u u = {pk2(p[hf][rb], p[hf][rb + 1]), pk2(p[hf][rb + 2], p[hf][rb + 3]), pk2(p[hf][rb + 4], p[hf][rb + 5]), pk2(p[hf][rb + 6], p[hf][rb + 7])}; \
            pa[s] = __builtin_bit_cast(bf16x8, u); } } while (0)
#define ATT_PV(bo) do { \
        const LAS unsigned char* vfp = Kt + (bo) + 16384 + ((lane >> 4) & 1) * 32 + (lane & 3) * 8 + (4 * hi + ((lane & 15) >> 2)) * 64; \
        s16x4 vlo[2][4], vhi[2][4]; \
        _Pragma("unroll") for (int s = 0; s < 4; ++s) { vlo[0][s] = vtr(vfp + s * 1024); vhi[0][s] = vtr(vfp + s * 1024 + 512); } \
        _Pragma("unroll") for (int blk = 0; blk < 4; ++blk) { \
            if (blk < 3) { _Pragma("unroll") for (int s = 0; s < 4; ++s) { vlo[(blk + 1) & 1][s] = vtr(vfp + (blk + 1) * 4096 + s * 1024); vhi[(blk + 1) & 1][s] = vtr(vfp + (blk + 1) * 4096 + s * 1024 + 512); } } \
            __builtin_amdgcn_sched_barrier(0); \
            _Pragma("unroll") for (int s = 0; s < 4; ++s) { const s16x4 lo = vlo[blk & 1][s], hh = vhi[blk & 1][s]; \
                const bf16x8 vf = {lo[0], lo[1], lo[2], lo[3], hh[0], hh[1], hh[2], hh[3]}; \
                o[blk] = __builtin_amdgcn_mfma_f32_32x32x16_bf16(pa[s], vf, o[blk], 0, 0, 0); } \
            __builtin_amdgcn_sched_barrier(0); } } while (0)
    bool pend = false; int pbo = 0, bo = 0;
    for (int it = 0; it <= NT; ++it) {
        const int t = NT - 1 - it, bn = (bo == 65536) ? 0 : bo + 32768;
        if (it + 1 < NT) ATT_DMA(t - 1, bn);
        const bool act = it < NT && 64 * t <= q0 + 31;
        if (c == 1 && pend) ATT_PV(pbo);
        if (act) ATT_QKSM(t, bo);
        if (c == 0 && act) ATT_PV(bo);
        if (c == 1) { pend = act; pbo = bo; }
        asm volatile("s_waitcnt vmcnt(0) lgkmcnt(0)\n\ts_barrier" ::: "memory");
        bo = bn;
    }
#undef ATT_QKSM
#undef ATT_PV
#undef ATT_DMA
    if (hi == 0) wsf[r32] = 1.f / l;
    LDS_WAIT();
#pragma unroll
    for (int r = 0; r < 16; ++r) { const float f = wsf[crow16(r, hi)];
#pragma unroll
        for (int blk = 0; blk < 4; ++blk) o[blk][r] *= f; }
    LAS float* xw = xch + wq * 4096;
    if (c == 1) {
#pragma unroll
        for (int blk = 0; blk < 4; ++blk)
#pragma unroll
            for (int r = 0; r < 16; ++r) xw[(blk * 16 + r) * 64 + lane] = o[blk][r];
    }
    __syncthreads();
    if (c == 0) {
        const float* aog = A.in[I_AOG]; bf16* ON = (bf16*)(F.ws + WS_ON);
        float g[4];
#pragma unroll
        for (int blk = 0; blk < 4; ++blk) g[blk] = aog[32 * blk + r32] * 0.8f;
#pragma unroll
        for (int r = 0; r < 16; ++r) {
            float v[4], ss = 0.f;
#pragma unroll
            for (int blk = 0; blk < 4; ++blk) { v[blk] = o[blk][r] - lam * xw[(blk * 16 + r) * 64 + lane]; ss += v[blk] * v[blk]; }
            ss += __shfl_xor(ss, 1); ss += __shfl_xor(ss, 2); ss += __shfl_xor(ss, 4); ss += __shfl_xor(ss, 8); ss += __shfl_xor(ss, 16);
            const float rn = rsqrtf(ss * (1.f / 128.f) + 1e-6f);
            bf16* op = ON + (size_t)(rowbase + q0 + crow16(r, hi)) * 512 + h * 128 + r32;
#pragma unroll
            for (int blk = 0; blk < 4; ++blk) op[32 * blk] = (bf16)(pk2(v[blk] * rn * g[blk], 0.f) & 0xffffu);
        }
    }
    __syncthreads();
}

__device__ __forceinline__ void skinny_tile(Frame& F, LAS float* red, const bf16* A, int lda, const bf16* Bt, int K, int n0) {
    const int lane = F.lane, r = lane & 31, hi = lane >> 5, w = F.wave, kw = K / 8;
    const bf16* ap = A + (size_t)r * lda + w * kw + 8 * hi; const bf16* bp = Bt + (size_t)(n0 + r) * K + w * kw + 8 * hi;
    f32x16 acc = {};
    const int nst = kw / 16;
    for (int s0 = 0; s0 < nst; s0 += 8) {
        bf16x8 av[8], bv[8];
#pragma unroll
        for (int j = 0; j < 8; ++j) { const int k = (s0 + j < nst ? s0 + j : nst - 1) * 16; av[j] = *(const bf16x8*)(ap + k); bv[j] = *(const bf16x8*)(bp + k); }
#pragma unroll
        for (int j = 0; j < 8; ++j) if (s0 + j < nst) acc = __builtin_amdgcn_mfma_f32_32x32x16_bf16(av[j], bv[j], acc, 0, 0, 0);
    }
    __syncthreads();
#pragma unroll
    for (int i = 0; i < 16; ++i) red[w * 1024 + i * 64 + lane] = acc[i];
    __syncthreads();
    for (int e = F.tid; e < 1024; e += 512) { float s = 0.f;
#pragma unroll
        for (int j = 0; j < 8; ++j) s += red[j * 1024 + e];
        red[8 * 1024 + e] = s; }
    __syncthreads();
}

#ifndef MK_N_LAUNCHES
#define MK_N_LAUNCHES 1
#endif
#ifndef MK_NAIVE_ATTN
#define MK_NAIVE_ATTN 0
#endif
constexpr int N_PHASES = 10;
__global__ void __launch_bounds__(NWAVES * 64, 2) mk_fwd(Args args) {
    extern __shared__ __attribute__((aligned(16))) unsigned char lds[];
    Frame F;
#ifdef MK_SUB
    F.pa = 0ull; F.pb = 0ull;
#endif
    F.lds = (LAS unsigned char*)lds;
    F.MISC = (volatile LAS unsigned*)(F.lds + MISC_OFF);
    F.tid = threadIdx.x; F.lane = F.tid & 63; F.wave = __builtin_amdgcn_readfirstlane(F.tid >> 6);
    F.G = gridDim.x; { const int bx = blockIdx.x; F.vcu = (F.G % 8 == 0) ? (bx % 8) * (F.G / 8) + bx / 8 : bx; }
    F.ws = args.ws; F.out = args.out; F.ctl = (gu32*)(args.ws + WS_CTL);
    const Args& A = args;
    for (int u = F.tid; u < (LDS_BYTES - LDSCTL_OFF) / 4; u += NWAVES * 64) ((LAS unsigned*)(F.lds + LDSCTL_OFF))[u] = 0u;
    __syncthreads();
    XcdBarrier bar; bar.bar = (unsigned*)(F.ctl + CW_BAR); bar.x = 0; bar.st = nullptr;
    if (MK_N_LAUNCHES == 1) bar = xcd_barrier_post((unsigned*)(F.ctl + CW_BAR), F.MISC + 8);
#define GRID_BAR() do { if (MK_N_LAUNCHES == 1) xcd_barrier(bar); } while (0)
    const int lo = args.ph_lo, hi = args.ph_hi;
#ifndef MK_PROF
#define MK_PROF -1
#endif
#ifndef MK_PROF_SCALE
#define MK_PROF_SCALE 1e-5f
#endif
    unsigned long long prof_a = 0ull, prof_b = 0ull;
#define PH_BEGIN(k) do { if (MK_PROF == (k)) prof_a = __builtin_amdgcn_s_memrealtime(); } while (0)
#define PH_END(k) do { if (MK_PROF == (k)) prof_b = __builtin_amdgcn_s_memrealtime(); } while (0)
#ifndef MK_DBG_STOP
#define MK_DBG_STOP 99
#endif
#define IN(k) (lo <= (k) && (k) < hi && (k) <= MK_DBG_STOP)
#define BOTH(k) (IN(k) && IN((k) + 1))
    bf16* XB = (bf16*)(F.ws + WS_XB); float* rs0 = (float*)(F.ws + WS_RS0);
    bf16* QB = (bf16*)(F.ws + WS_QB); bf16* KB = (bf16*)(F.ws + WS_KB); bf16* VB = (bf16*)(F.ws + WS_VB); bf16* PC = (bf16*)(F.ws + WS_PC); bf16* GT = (bf16*)(F.ws + WS_GT);
    bf16* ON = (bf16*)(F.ws + WS_ON); bf16* RW = (bf16*)(F.ws + WS_RW); bf16* MG = (bf16*)(F.ws + WS_MG); bf16* X1B = (bf16*)(F.ws + WS_X1B); bf16* HB = (bf16*)(F.ws + WS_HB);
    float* ssq = (float*)(F.ctl + CW_SSQ);
    const int bx = (int)blockIdx.x;

    PH_BEGIN(0);
    if (IN(0)) { for (int i = bx * 512 + F.tid; i < MTOT; i += F.G * 512) ssq[i] = 0.f;
        p0_prologue<0>(F, A, F.vcu * NWAVES + F.wave, F.G * NWAVES); if (BOTH(0)) GRID_BAR(); PH_END(0); }
    PH_BEGIN(1);
    if (IN(1)) {
        pg8::Gemm g{XB, (const bf16*)(F.ws + WS_WIN), nullptr, nullptr, MTOT, INW, DM}; pg8::StaticOrder S; S.init(MTOT, INW, F.G, bx);
        pg8::EpiProj E{rs0, A.in[I_QG], A.in[I_KG], QB, KB, VB, PC, GT, F.out};
        pg8::gemm_phase<pg8::EpiProj, pg8::StaticOrder, true, true>(F.lds + RING_OFF, g, S, E);
        { const int nlong = ((MTOT / 256 + (MTOT % 256 != 0)) * (INW / 256)) % F.G;
          if (nlong == 0) p0_prologue<1>(F, A, bx * NWAVES + F.wave, F.G * NWAVES);
          else if (bx >= nlong) p0_prologue<1>(F, A, (bx - nlong) * NWAVES + F.wave, (F.G - nlong) * NWAVES);
          __syncthreads(); }
        if (BOTH(1)) GRID_BAR(); PH_END(1);
    }
    PH_BEGIN(2);
    if (IN(2)) {
        SUBM(30);
        {
            const int grp = (bx + 2 * F.G >= MP / 32) ? bx % 3 : -1;
            int u = bx;
#pragma unroll 1
            for (int st = 0; ; ++st) {
                if (st == grp) {
                    LAS unsigned* qslot = (LAS unsigned*)(F.lds + LDSCTL_OFF);
                    if (F.tid == 0) qslot[0] = __hip_atomic_fetch_add((unsigned*)(F.ctl + CW_QDEC), 1u, __ATOMIC_RELAXED, __HIP_MEMORY_SCOPE_AGENT);
                    __syncthreads();
                    const unsigned k = qslot[0];
                    __syncthreads();
                    if (k < 1024u) decode_unit(F, A, (int)k);
                    __syncthreads();
                } else if (u < MP / 32) { rwkv_prep_unit(F, A, u); u += F.G; }
                else break;
            }
        }
        SUBM(31);
        SUBM(32);
        if (BOTH(2)) GRID_BAR(); PH_END(2);
    }
    PH_BEGIN(3);
    if (IN(3)) {
        SUBM(10);
        SUBM(11);
        for (int hc = bx * NWAVES + F.wave; hc < 32 * NCHK; hc += F.G * NWAVES) chunk_unit(F, hc);
        __syncthreads();
        if (BOTH(3)) GRID_BAR(); PH_END(3);
    }
    PH_BEGIN(4);
    if (IN(4)) {
        { int ln_ = F.lane, td_ = F.tid; asm volatile("" : "+v"(ln_), "+v"(td_)); F.lane = ln_; F.tid = td_; }
        SUBM(50);
        if (bx < 8) { chain_unit(F, bx * NWAVES + F.wave); __syncthreads(); }
        SUBM(51);
        const float lam = lam_value(F, A);
        LAS unsigned* qslot = (LAS unsigned*)(F.lds + LDSCTL_OFF);
        const unsigned dtail = __hip_atomic_load((unsigned*)(F.ctl + CW_QDEC), __ATOMIC_RELAXED, __HIP_MEMORY_SCOPE_AGENT) < 1024u ? __hip_atomic_load((unsigned*)(F.ctl + CW_QDEC), __ATOMIC_RELAXED, __HIP_MEMORY_SCOPE_AGENT) : 1024u;
        for (;;) {
            { int ln_ = F.lane, td_ = F.tid; asm volatile("" : "+v"(ln_), "+v"(td_)); F.lane = ln_; F.tid = td_; }
            if (F.tid == 0) qslot[0] = __hip_atomic_fetch_add((unsigned*)(F.ctl + CW_QUEUE), 1u, __ATOMIC_RELAXED, __HIP_MEMORY_SCOPE_AGENT);
            __syncthreads();
            const unsigned k = qslot[0];
            __syncthreads();
            if (k >= 1537u) break;
            if (k == 0u) { rwkv_prep_unit(F, A, MP / 32); continue; }
            const unsigned tr = (k - 1u) / 3u, r = (k - 1u) - 3u * tr;
#ifdef MK_SUB
            const unsigned long long t0_ = __builtin_amdgcn_s_memrealtime();
#endif
            if (r == 0u) attn_unit(F, A, (int)(tr & 15u) >> 2, (int)(tr & 3u), 31 - (int)(tr >> 4), lam);
            else { const unsigned d = dtail + 2u * tr + r - 1u; if (d < 1024u) decode_unit(F, A, (int)d); }
#ifdef MK_SUB
            if ((MK_SUB == 40 && r == 0u) || (MK_SUB == 41 && r != 0u)) F.pb += __builtin_amdgcn_s_memrealtime() - t0_;
#endif
        }
        if (BOTH(4)) GRID_BAR(); PH_END(4);
    }
    PH_BEGIN(5);
    if (IN(5)) {
        SUBM(20);
        { const float lam = lam_value(F, A);
          for (int it = bx; it < 128; it += F.G) { decode_combine(F, A, it, lam); if (it + F.G < 128) __syncthreads(); } }
        __syncthreads();
        for (int u = 256 + bx; u < 512; u += F.G) scan_seg_unit(F, A, u);
        SUBM(21);
        for (int hc = bx * NWAVES + F.wave; hc < 32 * NCHK; hc += F.G * NWAVES) ypass_unit(F, A, hc);
        SUBM(22);
        __syncthreads();
        if (BOTH(5)) GRID_BAR(); PH_END(5);
    }
    PH_BEGIN(6);
    if (IN(6)) {
        if (bx < 32) {
            LAS float* red = (LAS float*)(F.lds + RING_OFF); const int n0 = 32 * bx; float t1[2];
            skinny_tile(F, red, ON + (size_t)MP * 512, 512, (const bf16*)(F.ws + WS_WPA), 512, n0);
            t1[0] = red[8192 + F.tid]; t1[1] = red[8192 + 512 + F.tid];
            skinny_tile(F, red, RW + (size_t)MP * 512, 512, (const bf16*)(F.ws + WS_WPB), 512, n0);
#pragma unroll
            for (int i = 0; i < 2; ++i) { const int e = F.tid + 512 * i, reg = e >> 6, ln = e & 63, row = crow16(reg, ln >> 5), col = n0 + (ln & 31);
                const float g1 = bf2f(GT[(size_t)(MP + row) * 2048 + col]), g2 = bf2f(GT[(size_t)(MP + row) * 2048 + 1024 + col]);
                MG[(size_t)(MP + row) * 1024 + col] = (bf16)(pk2(g1 * t1[i] + g2 * red[8192 + e], 0.f) & 0xffffu); }
            __syncthreads();
        }
        pg8::Gemm g{ON, (const bf16*)(F.ws + WS_WPA), RW, (const bf16*)(F.ws + WS_WPB), MP, DM, 512}; pg8::PairOrder S; S.base.init(MP, DM, F.G, bx);
        pg8::EpiMerge E{GT, (float*)(F.ws + WS_TMP), MG};
        pg8::gemm_phase<pg8::EpiMerge, pg8::PairOrder, true, true>(F.lds + RING_OFF, g, S, E);
        if (BOTH(6)) GRID_BAR(); PH_END(6);
    }
    PH_BEGIN(7);
    if (IN(7)) {
        if (bx < 32) {
            LAS float* red = (LAS float*)(F.lds + RING_OFF); const int n0 = 32 * bx;
            skinny_tile(F, red, MG + (size_t)MP * 1024, 1024, (const bf16*)(F.ws + WS_WOUT), 1024, n0);
#pragma unroll
            for (int i = 0; i < 2; ++i) { const int e = F.tid + 512 * i, reg = e >> 6, ln = e & 63, row = crow16(reg, ln >> 5), col = n0 + (ln & 31);
                const float v = A.in[I_XS][(size_t)row * 1024 + col] + red[8192 + e];
                F.out[O_YS + (size_t)row * 1024 + col] = v; X1B[(size_t)(MP + row) * 1024 + col] = (bf16)(pk2(v, 0.f) & 0xffffu);
                float ss = v * v; ss += __shfl_xor(ss, 1); ss += __shfl_xor(ss, 2); ss += __shfl_xor(ss, 4); ss += __shfl_xor(ss, 8); ss += __shfl_xor(ss, 16);
                if ((ln & 31) == 0) atomicAdd(ssq + MP + row, ss); }
            __syncthreads();
        }
        pg8::Gemm g{MG, (const bf16*)(F.ws + WS_WOUT), nullptr, nullptr, MP, DM, DM}; pg8::StaticOrder S; S.init(MP, DM, F.G, bx);
        pg8::EpiOut E{XB, X1B, ssq};
        pg8::gemm_phase<pg8::EpiOut, pg8::StaticOrder, false, true>(F.lds + RING_OFF, g, S, E);
        if (BOTH(7)) GRID_BAR(); PH_END(7);
    }
    PH_BEGIN(8);
    if (IN(8)) {
        pg8::Gemm g{X1B, (const bf16*)(F.ws + WS_WGU), nullptr, nullptr, MTOT, NGU, DM}; pg8::StaticOrder S; S.init(MTOT, NGU, F.G, bx);
        pg8::EpiGateUp E{ssq, HB};
        pg8::gemm_phase<pg8::EpiGateUp, pg8::StaticOrder, true, true>(F.lds + RING_OFF, g, S, E);
        if (BOTH(8)) GRID_BAR(); PH_END(8);
    }
    PH_BEGIN(9);
    if (IN(9)) {
        if (bx < 32) {
            LAS float* red = (LAS float*)(F.lds + RING_OFF); const int n0 = 32 * bx;
            skinny_tile(F, red, HB + (size_t)MP * FF, FF, (const bf16*)(F.ws + WS_WDN), FF, n0);
#pragma unroll
            for (int i = 0; i < 2; ++i) { const int e = F.tid + 512 * i, reg = e >> 6, ln = e & 63, row = crow16(reg, ln >> 5), col = n0 + (ln & 31);
                float yv = F.out[O_YS + (size_t)row * 1024 + col] + red[8192 + e];
#ifdef MK_SUB
                prof_a = F.pa; prof_b = F.pb;
#endif
                if (MK_PROF >= 0 && MK_PROF != 9) yv *= 1.f + sqrtf((float)(prof_b - prof_a) * 0.01f * MK_PROF_SCALE);
                F.out[O_YS + (size_t)row * 1024 + col] = yv; }
            __syncthreads();
        }
        pg8::Gemm g{HB, (const bf16*)(F.ws + WS_WDN), nullptr, nullptr, MP, DM, FF}; pg8::StaticOrder S; S.init(MP, DM, F.G, bx);
        pg8::EpiDown E{F.out + O_YP, X1B};
        pg8::gemm_phase<pg8::EpiDown, pg8::StaticOrder, false, true>(F.lds + RING_OFF, g, S, E);
        if (MK_PROF == 9 && MK_N_LAUNCHES == 1) {
            xcd_barrier(bar); prof_b = __builtin_amdgcn_s_memrealtime();
            const float sc = 1.f + sqrtf((float)(prof_b - prof_a) * 0.01f * 1e-5f);
            for (int e = bx * 512 + F.tid; e < 32 * 1024; e += F.G * 512) F.out[O_YS + e] *= sc;
        }
    }
#undef IN
#undef BOTH
}

#if MK_NAIVE_ATTN
__global__ void __launch_bounds__(512, 2) attn_naive_kernel(Args args) {
    Frame F; F.tid = threadIdx.x; F.lane = F.tid & 63; F.wave = __builtin_amdgcn_readfirstlane(F.tid >> 6); F.G = gridDim.x; F.ws = args.ws; F.out = args.out;
    const Args& A = args;
    const float lam = lam_value(F, A);
    const int gw = (int)blockIdx.x * NWAVES + F.wave, NGW = F.G * NWAVES;
    for (int it = gw; it < MP * 4; it += NGW) attn_naive_row(F, A, it >> 2, it & 3, lam);
}
#endif
extern "C" void kernel_launch(void* const* d_in, const int* in_sizes, int n_in, void* d_out, int out_size, void* d_ws, size_t ws_size, hipStream_t stream) {
    static int grid = 0;
    if (grid == 0) {
        if (n_in != 34 || out_size != (int)O_END || ws_size < WS_END) { fprintf(stderr, "kernel_launch: unexpected shapes: n_in %d out %d ws %zu\n", n_in, out_size, ws_size); grid = -1; return; }
        int dev = 0, cus = 0, per_cu = 0;
        if (hipGetDevice(&dev) != hipSuccess || hipDeviceGetAttribute(&cus, hipDeviceAttributeMultiprocessorCount, dev) != hipSuccess) { grid = -1; return; }
        if (hipFuncSetAttribute((const void*)mk_fwd, hipFuncAttributeMaxDynamicSharedMemorySize, LDS_BYTES) != hipSuccess) { fprintf(stderr, "kernel_launch: hipFuncSetAttribute failed\n"); grid = -1; return; }
        if (hipOccupancyMaxActiveBlocksPerMultiprocessor(&per_cu, (const void*)mk_fwd, NWAVES * 64, LDS_BYTES) != hipSuccess || per_cu < 1) fprintf(stderr, "kernel_launch: occupancy query says %d\n", per_cu);
        (void)hipGetLastError();
        grid = cus;
    }
    if (grid < 0) return;
    if (hipMemsetAsync((char*)d_ws + WS_CTL, 0, CTL_ZERO_BYTES, stream) != hipSuccess) return;
    Args a{};
    for (int i = 0; i < 34; ++i) a.in[i] = (const float*)d_in[i];
    a.out = (float*)d_out; a.ws = (unsigned char*)d_ws;
    const int NL = MK_N_LAUNCHES;
    for (int li = 0; li < NL; ++li) {
        a.ph_lo = (NL == 1) ? 0 : li; a.ph_hi = (NL == 1) ? N_PHASES : li + 1; a.li = li; a.pad = 0;
        hipLaunchKernelGGL(mk_fwd, dim3(grid), dim3(NWAVES * 64), LDS_BYTES, stream, a);
        if (hipPeekAtLastError() != hipSuccess) { fprintf(stderr, "kernel_launch: launch %d failed\n", li); break; }
#if MK_NAIVE_ATTN
        if (NL != 1 && li == 3) hipLaunchKernelGGL(attn_naive_kernel, dim3(1024), dim3(512), 0, stream, a);
#endif
    }
}
```
